# Optimizing an MI355X kernel written in HIP

```python
import jax, jax.numpy as jnp
from jax import lax
import numpy as np

D_MODEL = 1024
BATCH = 4
SEQ = 4096
DEPTH = 2

GRID_W = 64
CTX_LEN = 256
HEAD_DIM = 64
AXIS_DIM = HEAD_DIM // 2
ROPE_THETA = 10000.0
EPS = 1e-6
Q_BLOCK = 128
N_MOD = 6

GLA_HEADS = 4
GLA_DK = 64
GLA_DV = 128
GLA_GATE_RANK = 16
GLA_GATE_NORM = 16.0
GLA_CHUNK = 64
ATT_HEADS = 8
ATT_KV_HEADS = 2
SWA_HEADS = 16
SWA_KV_HEADS = 2
SWA_WINDOW = 128
MOE_GROUPS = 4
MOE_EXPERTS_PER_GROUP = 4
MOE_TOPK = 2
D_EXPERT = 256

EVEN_WIDTHS = (GLA_HEADS * GLA_DK, GLA_HEADS * GLA_DK, GLA_HEADS * GLA_DV, GLA_HEADS * GLA_DV,
               2 * GLA_GATE_RANK, ATT_HEADS * HEAD_DIM, ATT_KV_HEADS * HEAD_DIM, ATT_KV_HEADS * HEAD_DIM)
EVEN_IN = sum(EVEN_WIDTHS)
EVEN_MIX = GLA_HEADS * GLA_DV + ATT_HEADS * HEAD_DIM
ODD_Q = SWA_HEADS * HEAD_DIM
ODD_KV = SWA_KV_HEADS * HEAD_DIM
ODD_IN = ODD_Q + 2 * ODD_KV
ODD_MIX = ODD_Q
N_EVEN = (DEPTH + 1) // 2
N_ODD = DEPTH // 2

kernel_name = 'hybrid_gla_gqa_swa_hmoe_diffusion_block'


def _split(z, widths):
    return jnp.split(z, np.cumsum(widths)[:-1].tolist(), axis=-1)


def rms_norm(x, gain):
    xf = x.astype(jnp.float32)
    y = xf * lax.rsqrt(jnp.mean(xf * xf, axis=-1, keepdims=True) + EPS)
    return (y * gain.astype(jnp.float32)).astype(x.dtype)


def modulate(x, gain, shift, scale):
    return rms_norm(x, gain) * (1 + scale) + shift


def axial_rope_tables(n):
    rows = n // GRID_W
    row = jnp.repeat(jnp.arange(rows, dtype=jnp.int32), GRID_W)
    col = jnp.tile(jnp.arange(GRID_W, dtype=jnp.int32), rows)
    inv_freq = ROPE_THETA ** (-jnp.arange(0, AXIS_DIM, 2, dtype=jnp.float32) / AXIS_DIM)
    ang = jnp.stack([row[:, None] * inv_freq, col[:, None] * inv_freq], axis=1)
    return jnp.cos(ang), jnp.sin(ang)


def apply_axial_rope(x, cos, sin):
    B, n, H, _ = x.shape
    xs = x.reshape(B, n, H, 2, 2, AXIS_DIM // 2)
    x1, x2 = xs[..., 0, :], xs[..., 1, :]
    c = cos[None, :, None].astype(x.dtype)
    s = sin[None, :, None].astype(x.dtype)
    out = jnp.stack([x1 * c - x2 * s, x2 * c + x1 * s], axis=-2)
    return out.reshape(B, n, H, HEAD_DIM)


def heads(z, n_heads, gain):
    B, L, _ = z.shape
    return rms_norm(z.reshape(B, L, n_heads, HEAD_DIM), gain)


def group_q(q, n_kv):
    B, L, H, Dh = q.shape
    return q.reshape(B, L, n_kv, H // n_kv, Dh)


def softmax_attend(q, k, v, mask=None, sink=None):
    B, Q, KV, G, Dh = q.shape
    s = jnp.einsum('bqhgd,bkhd->bhgqk', q, k).astype(jnp.float32) * (Dh ** -0.5)
    if mask is not None:
        s = jnp.where(mask, s, -jnp.inf)
    if sink is not None:
        sink_col = jnp.broadcast_to(sink.reshape(1, KV, G, 1, 1).astype(jnp.float32), s.shape[:-1] + (1,))
        p = jax.nn.softmax(jnp.concatenate([s, sink_col], axis=-1), axis=-1)[..., :-1]
    else:
        p = jax.nn.softmax(s, axis=-1)
    o = jnp.einsum('bhgqk,bkhd->bqhgd', p.astype(v.dtype), v)
    return o.reshape(B, Q, KV * G * Dh)


def blocked_dense_attention(q, k, v):
    B, S = q.shape[:2]
    nb = S // Q_BLOCK
    qb = jnp.moveaxis(q.reshape(B, nb, Q_BLOCK, *q.shape[2:]), 1, 0)
    ob = lax.map(lambda qi: softmax_attend(qi, k, v), qb)
    return jnp.moveaxis(ob, 0, 1).reshape(B, S, -1)


def banded_window_attention(q, k, v, k_ctx, v_ctx, sink):
    B, S = q.shape[:2]
    nb = S // Q_BLOCK
    span = Q_BLOCK + 2 * SWA_WINDOW
    pad = ((0, 0), (SWA_WINDOW, SWA_WINDOW), (0, 0), (0, 0))
    kp = jnp.pad(k, pad)
    vp = jnp.pad(v, pad)
    qb = jnp.moveaxis(q.reshape(B, nb, Q_BLOCK, *q.shape[2:]), 1, 0)
    ctx_ok = jnp.ones((Q_BLOCK, k_ctx.shape[1]), dtype=bool)

    def block(args):
        qi, bi = args
        start = bi * Q_BLOCK
        kb = lax.dynamic_slice_in_dim(kp, start, span, axis=1)
        vb = lax.dynamic_slice_in_dim(vp, start, span, axis=1)
        qpos = start + jnp.arange(Q_BLOCK, dtype=jnp.int32)
        kpos = start - SWA_WINDOW + jnp.arange(span, dtype=jnp.int32)
        band = (kpos[None, :] >= 0) & (kpos[None, :] < S) & (jnp.abs(kpos[None, :] - qpos[:, None]) <= SWA_WINDOW)
        mask = jnp.concatenate([band, ctx_ok], axis=1)
        return softmax_attend(qi, jnp.concatenate([kb, k_ctx], axis=1), jnp.concatenate([vb, v_ctx], axis=1), mask, sink)

    ob = lax.map(block, (qb, jnp.arange(nb, dtype=jnp.int32)))
    return jnp.moveaxis(ob, 0, 1).reshape(B, S, -1)


def gla_chunk_scan(q, k, v, g, s0):
    B, H, L, DK = q.shape
    DV = v.shape[-1]
    n = L // GLA_CHUNK

    def chunks(t):
        return jnp.moveaxis(t.reshape(B, H, n, GLA_CHUNK, t.shape[-1]), 2, 0)

    lower_tri = jnp.tril(jnp.ones((GLA_CHUNK, GLA_CHUNK), dtype=bool))[:, :, None]

    def step(s, blk):
        qc, kc, vc, gc = blk
        b = jnp.cumsum(gc, axis=2)
        o = jnp.einsum('bhtk,bhkv->bhtv', qc * jnp.exp(b), s)
        diff = b[:, :, :, None, :] - b[:, :, None, :, :]
        decay = jnp.exp(jnp.where(lower_tri, diff, -jnp.inf))
        att = jnp.einsum('bhtk,bhsk,bhtsk->bhts', qc, kc, decay)
        o = o + jnp.einsum('bhts,bhsv->bhtv', att, vc)
        b_end = b[:, :, -1:, :]
        s = jnp.exp(b_end[:, :, 0, :, None]) * s + jnp.einsum('bhsk,bhsv->bhkv', kc * jnp.exp(b_end - b), vc)
        return s, o

    s_fin, o = lax.scan(step, s0, (chunks(q), chunks(k), chunks(v), chunks(g)))
    return jnp.moveaxis(o, 0, 2).reshape(B, H, L, DV), s_fin


def gla_inputs(q, k, v, lr, gate_w, gate_b):
    B, L, _ = q.shape

    def hd(t, d):
        return t.reshape(B, L, GLA_HEADS, d).transpose(0, 2, 1, 3).astype(jnp.float32)

    z = jnp.einsum('blzr,zrk->zblk', lr.reshape(B, L, 2, GLA_GATE_RANK), gate_w) + gate_b[:, None, None, :]
    g = jax.nn.log_sigmoid(z.astype(jnp.float32)) / GLA_GATE_NORM
    g = g.reshape(2, B, L, GLA_HEADS, GLA_DK).transpose(0, 1, 3, 2, 4)
    return hd(q, GLA_DK) * (GLA_DK ** -0.5), hd(k, GLA_DK), hd(v, GLA_DV), g


def gla_bidirectional(lat, ctx):
    ql, kl, vl, gl = lat
    qc, kc, vc, gc = ctx
    B = ql.shape[0]
    s0 = jnp.zeros((B, GLA_HEADS, GLA_DK, GLA_DV), jnp.float32)

    def rev(t):
        return jnp.flip(t, axis=2)

    oc_f, sc_f = gla_chunk_scan(qc, kc, vc, gc[0], s0)
    oc_b, sc_b = gla_chunk_scan(rev(qc), rev(kc), rev(vc), rev(gc[1]), s0)
    ol_f, _ = gla_chunk_scan(ql, kl, vl, gl[0], sc_f)
    ol_b, _ = gla_chunk_scan(rev(ql), rev(kl), rev(vl), rev(gl[1]), sc_b)
    return ol_f + rev(ol_b), oc_f + rev(oc_b)


def gla_output(o, r, gain):
    B, H, L, _ = o.shape
    o = rms_norm(o.transpose(0, 2, 1, 3), gain).astype(r.dtype)
    return (o * jax.nn.silu(r.reshape(B, L, H, GLA_DV))).reshape(B, L, H * GLA_DV)


def even_mixer(h_lat, h_ctx, w_in, w_out, gate_w, gate_b, gla_norm, q_norm, k_norm, cos, sin):
    B, S, _ = h_lat.shape
    Lc = h_ctx.shape[1]
    z_l = _split(h_lat @ w_in, EVEN_WIDTHS)
    z_c = _split(h_ctx @ w_in, EVEN_WIDTHS)
    o_gla_l, o_gla_c = gla_bidirectional(gla_inputs(z_l[0], z_l[1], z_l[2], z_l[4], gate_w, gate_b),
                                         gla_inputs(z_c[0], z_c[1], z_c[2], z_c[4], gate_w, gate_b))
    a_l = gla_output(o_gla_l, z_l[3], gla_norm)
    a_c = gla_output(o_gla_c, z_c[3], gla_norm)
    q_l = group_q(apply_axial_rope(heads(z_l[5], ATT_HEADS, q_norm), cos, sin), ATT_KV_HEADS)
    k_l = apply_axial_rope(heads(z_l[6], ATT_KV_HEADS, k_norm), cos, sin)
    v_l = z_l[7].reshape(B, S, ATT_KV_HEADS, HEAD_DIM)
    q_c = group_q(heads(z_c[5], ATT_HEADS, q_norm), ATT_KV_HEADS)
    k_c = heads(z_c[6], ATT_KV_HEADS, k_norm)
    v_c = z_c[7].reshape(B, Lc, ATT_KV_HEADS, HEAD_DIM)
    b_l = blocked_dense_attention(q_l, jnp.concatenate([k_l, k_c], axis=1), jnp.concatenate([v_l, v_c], axis=1))
    b_c = softmax_attend(q_c, k_c, v_c)
    return jnp.concatenate([a_l, b_l], axis=-1) @ w_out, jnp.concatenate([a_c, b_c], axis=-1) @ w_out


def odd_mixer(h_lat, h_ctx, w_in, w_out, sink, q_norm, k_norm, cos, sin, need_ctx):
    B, S, _ = h_lat.shape
    Lc = h_ctx.shape[1]
    q_l, k_l, v_l = _split(h_lat @ w_in, (ODD_Q, ODD_KV, ODD_KV))
    k_c, v_c = _split(h_ctx @ w_in[:, ODD_Q:], (ODD_KV, ODD_KV))
    q = group_q(apply_axial_rope(heads(q_l, SWA_HEADS, q_norm), cos, sin), SWA_KV_HEADS)
    k = apply_axial_rope(heads(k_l, SWA_KV_HEADS, k_norm), cos, sin)
    v = v_l.reshape(B, S, SWA_KV_HEADS, HEAD_DIM)
    kc = heads(k_c, SWA_KV_HEADS, k_norm)
    vc = v_c.reshape(B, Lc, SWA_KV_HEADS, HEAD_DIM)
    m_l = banded_window_attention(q, k, v, kc, vc, sink) @ w_out
    if not need_ctx:
        return m_l, None
    qc = group_q(heads(h_ctx @ w_in[:, :ODD_Q], SWA_HEADS, q_norm), SWA_KV_HEADS)
    return m_l, softmax_attend(qc, kc, vc, None, sink) @ w_out


def hier_moe(h, wg, bg, we, be, w_gate, w_up, w_down):
    N = h.shape[0]
    g_logits = (h @ wg + bg).astype(jnp.float32)
    g_prob = jax.nn.softmax(g_logits, axis=-1)
    g_idx = jnp.argmax(g_logits, axis=-1)
    g_weight = jnp.take_along_axis(g_prob, g_idx[:, None], axis=-1)
    e_logits = (h @ we + be).astype(jnp.float32).reshape(N, MOE_GROUPS, MOE_EXPERTS_PER_GROUP)
    e_sel = jnp.take_along_axis(e_logits, g_idx[:, None, None], axis=1)[:, 0]
    top_p, top_i = lax.top_k(jax.nn.softmax(e_sel, axis=-1), MOE_TOPK)
    top_p = top_p / jnp.sum(top_p, axis=-1, keepdims=True)
    e_weight = jnp.sum(jax.nn.one_hot(top_i, MOE_EXPERTS_PER_GROUP, dtype=jnp.float32) * top_p[..., None], axis=1)
    combine = (jax.nn.one_hot(g_idx, MOE_GROUPS, dtype=jnp.float32)[:, :, None]
               * (g_weight * e_weight)[:, None, :]).astype(h.dtype)
    out = jnp.zeros_like(h)
    for g in range(MOE_GROUPS):
        a = jnp.einsum('nd,edf->nef', h, w_gate[g])
        u = jnp.einsum('nd,edf->nef', h, w_up[g])
        hid = jax.nn.silu(a) * u * combine[:, g, :, None]
        out = out + jnp.einsum('nef,efd->nd', hid, w_down[g])
    return out


def setup_inputs(seed: int = 0) -> dict:
    key = jax.random.key(seed)
    ks = iter(jax.random.split(key, 32))
    D = D_MODEL
    G, E = MOE_GROUPS, MOE_EXPERTS_PER_GROUP

    def nrm(shape, scale):
        return scale * jax.random.normal(next(ks), shape, jnp.float32)

    def gain(shape):
        return 1.0 + 0.02 * jax.random.normal(next(ks), shape, jnp.float32)

    return {
        'x': nrm((BATCH, SEQ, D), 1.0),
        'c': nrm((BATCH, D), 1.0),
        'ctx': nrm((BATCH, CTX_LEN, D), 1.0),
        'c_ctx': nrm((D,), 1.0),
        'mod_w': nrm((DEPTH, D, N_MOD * D), 0.5 * D ** -0.5),
        'mod_b': nrm((DEPTH, N_MOD * D), 0.02),
        'norm_mix': gain((DEPTH, D)),
        'norm_ffn': gain((DEPTH, D)),
        'ev_w_in': nrm((N_EVEN, D, EVEN_IN), D ** -0.5),
        'ev_w_out': nrm((N_EVEN, EVEN_MIX, D), EVEN_MIX ** -0.5),
        'gla_gate_w': nrm((N_EVEN, 2, GLA_GATE_RANK, GLA_HEADS * GLA_DK), GLA_GATE_RANK ** -0.5),
        'gla_gate_b': nrm((N_EVEN, 2, GLA_HEADS * GLA_DK), 0.1),
        'gla_out_norm': gain((N_EVEN, GLA_DV)),
        'att_q_norm': gain((N_EVEN, HEAD_DIM)),
        'att_k_norm': gain((N_EVEN, HEAD_DIM)),
        'od_w_in': nrm((N_ODD, D, ODD_IN), D ** -0.5),
        'od_w_out': nrm((N_ODD, ODD_MIX, D), ODD_MIX ** -0.5),
        'swa_sink': nrm((N_ODD, SWA_HEADS), 1.0),
        'swa_q_norm': gain((N_ODD, HEAD_DIM)),
        'swa_k_norm': gain((N_ODD, HEAD_DIM)),
        'router_group_w': nrm((DEPTH, D, G), D ** -0.5),
        'router_group_b': nrm((DEPTH, G), 0.01),
        'router_expert_w': nrm((DEPTH, D, G * E), D ** -0.5),
        'router_expert_b': nrm((DEPTH, G * E), 0.01),
        'exp_w_gate': nrm((DEPTH, G, E, D, D_EXPERT), D ** -0.5),
        'exp_w_up': nrm((DEPTH, G, E, D, D_EXPERT), D ** -0.5),
        'exp_w_down': nrm((DEPTH, G, E, D_EXPERT, D), D_EXPERT ** -0.5),
    }


def reference(x, c, ctx, c_ctx, mod_w, mod_b, norm_mix, norm_ffn, ev_w_in, ev_w_out, gla_gate_w, gla_gate_b,
              gla_out_norm, att_q_norm, att_k_norm, od_w_in, od_w_out, swa_sink, swa_q_norm, swa_k_norm,
              router_group_w, router_group_b, router_expert_w, router_expert_b, exp_w_gate, exp_w_up, exp_w_down):
    B, S, D = x.shape
    cos, sin = axial_rope_tables(S)
    sc = jax.nn.silu(c)
    scc = jax.nn.silu(c_ctx)[None]
    for i in range(DEPTH):
        last = i == DEPTH - 1
        j = i // 2
        mod_l = jnp.split((sc @ mod_w[i] + mod_b[i])[:, None, :], N_MOD, axis=-1)
        mod_c = jnp.split((scc @ mod_w[i] + mod_b[i])[:, None, :], N_MOD, axis=-1)
        h_l = modulate(x, norm_mix[i], mod_l[0], mod_l[1])
        h_c = modulate(ctx, norm_mix[i], mod_c[0], mod_c[1])
        if i % 2 == 0:
            m_l, m_c = even_mixer(h_l, h_c, ev_w_in[j], ev_w_out[j], gla_gate_w[j], gla_gate_b[j],
                                  gla_out_norm[j], att_q_norm[j], att_k_norm[j], cos, sin)
        else:
            m_l, m_c = odd_mixer(h_l, h_c, od_w_in[j], od_w_out[j], swa_sink[j], swa_q_norm[j],
                                 swa_k_norm[j], cos, sin, not last)
        x = x + mod_l[2] * m_l
        moe_p = (router_group_w[i], router_group_b[i], router_expert_w[i], router_expert_b[i],
                 exp_w_gate[i], exp_w_up[i], exp_w_down[i])
        if last:
            f_l = hier_moe(modulate(x, norm_ffn[i], mod_l[3], mod_l[4]).reshape(B * S, D), *moe_p)
            x = x + mod_l[5] * f_l.reshape(B, S, D)
        else:
            ctx = ctx + mod_c[2] * m_c
            tok = jnp.concatenate([modulate(x, norm_ffn[i], mod_l[3], mod_l[4]).reshape(B * S, D),
                                   modulate(ctx, norm_ffn[i], mod_c[3], mod_c[4]).reshape(-1, D)], axis=0)
            f = hier_moe(tok, *moe_p)
            x = x + mod_l[5] * f[:B * S].reshape(B, S, D)
            ctx = ctx + mod_c[5] * f[B * S:].reshape(ctx.shape)
    return x
```

```cpp
#include <hip/hip_runtime.h>
#include <stdint.h>

typedef unsigned short bf16;
__device__ __forceinline__ float bf2f(bf16 v) { return __uint_as_float(((unsigned)v) << 16); }
__device__ __forceinline__ bf16 f2bf(float f) { unsigned u = __float_as_uint(f); return (bf16)((u + 0x7fffu + ((u >> 16) & 1u)) >> 16); }

constexpr int D = 1024, NB = 4, S = 4096, CL = 256, NL = NB * S, NC = NB * CL, NT = NL + NC;
constexpr int EVEN_IN = 2336, ODD_IN = 1280;
constexpr float EPS = 1e-6f;

__device__ __forceinline__ float silu(float x) { return x / (1.f + expf(-x)); }
__device__ __forceinline__ float wave_sum(float v) {
#pragma unroll
    for (int o = 1; o < 64; o <<= 1) v += __shfl_xor(v, o);
    return v;
}
__device__ __forceinline__ float block_sum256(float v, float* scr) {
    v = wave_sum(v);
    __syncthreads();
    if ((threadIdx.x & 63) == 0) scr[threadIdx.x >> 6] = v;
    __syncthreads();
    return scr[0] + scr[1] + scr[2] + scr[3];
}

__global__ void n_mod(const float* c, const float* c_ctx, const float* mod_w, const float* mod_b, float* modv) {
    int col = blockIdx.x * 256 + threadIdx.x;
    int row = blockIdx.y, layer = blockIdx.z;
    const float* cv = row < 4 ? c + row * D : c_ctx;
    const float* w = mod_w + (size_t)layer * D * 6144;
    float acc = 0.f;
    for (int k = 0; k < D; ++k) acc += silu(cv[k]) * w[(size_t)k * 6144 + col];
    modv[((size_t)layer * 5 + row) * 6144 + col] = acc + mod_b[layer * 6144 + col];
}

__device__ __forceinline__ void rope64(float* y, int t) {
    int pos[2] = {t / 64, t % 64};
    for (int ax = 0; ax < 2; ++ax)
        for (int f = 0; f < 16; ++f) {
            float inv = powf(10000.f, -(float)(2 * f) / 32.f);
            float ang = (float)pos[ax] * inv;
            float cs = cosf(ang), sn = sinf(ang);
            float x1 = y[ax * 32 + f], x2 = y[ax * 32 + 16 + f];
            y[ax * 32 + f] = x1 * cs - x2 * sn;
            y[ax * 32 + 16 + f] = x2 * cs + x1 * sn;
        }
}

__device__ __forceinline__ void load_modulate4(const float* xlat, const float* xctx, const float* modv_layer, const float* gain, int which,
                                               int m0, float (*hs)[1024], float* scr) {
    for (int r = 0; r < 4; ++r) {
        int m = m0 + r;
        const float* xr = m < NL ? xlat + (size_t)m * D : xctx + (size_t)(m - NL) * D;
        int mrow = m < NL ? m / S : 4;
        const float* mv = modv_layer + (size_t)mrow * 6144;
        float v[4]; float ss = 0.f;
        for (int i = 0; i < 4; ++i) { v[i] = xr[threadIdx.x + 256 * i]; ss += v[i] * v[i]; }
        float tot = block_sum256(ss, scr);
        float rstd = rsqrtf(tot / D + EPS);
        for (int i = 0; i < 4; ++i) {
            int k = threadIdx.x + 256 * i;
            hs[r][k] = v[i] * rstd * gain[k] * (1.f + mv[(which + 1) * 1024 + k]) + mv[which * 1024 + k];
        }
    }
    __syncthreads();
}

__global__ void __launch_bounds__(256) n_even_inproj(const float* x, const float* ctx, const float* modv_layer, const float* norm_mix, const float* w_in,
                                                     const float* qn, const float* kn, bf16* GQ, bf16* GK, bf16* GV, bf16* GR, float* LR, bf16* AQ, bf16* AK, bf16* AV) {
    __shared__ float hs[4][1024];
    __shared__ float zs[4][EVEN_IN];
    __shared__ float scr[4];
    int m0 = blockIdx.x * 4, tid = threadIdx.x;
    load_modulate4(x, ctx, modv_layer, norm_mix, 0, m0, hs, scr);
    for (int n = tid; n < EVEN_IN; n += 256) {
        float a0 = 0, a1 = 0, a2 = 0, a3 = 0;
        for (int k = 0; k < D; ++k) { float w = w_in[(size_t)k * EVEN_IN + n]; a0 += hs[0][k] * w; a1 += hs[1][k] * w; a2 += hs[2][k] * w; a3 += hs[3][k] * w; }
        zs[0][n] = a0; zs[1][n] = a1; zs[2][n] = a2; zs[3][n] = a3;
    }
    __syncthreads();
    for (int job = tid; job < 40; job += 256) {
        int r = job / 10, hh = job % 10; int m = m0 + r;
        float* y = &zs[r][1568 + hh * 64];
        const float* g = hh < 8 ? qn : kn;
        float ss = 0.f; for (int d = 0; d < 64; ++d) ss += y[d] * y[d];
        float rstd = rsqrtf(ss / 64.f + EPS);
        for (int d = 0; d < 64; ++d) y[d] = y[d] * rstd * g[d];
        if (m < NL) rope64(y, m % S);
    }
    __syncthreads();
    for (int r = 0; r < 4; ++r) {
        size_t m = m0 + r;
        for (int n = tid; n < EVEN_IN; n += 256) {
            float z = zs[r][n];
            if (n < 256) GQ[m * 256 + n] = f2bf(z);
            else if (n < 512) GK[m * 256 + n - 256] = f2bf(z);
            else if (n < 1024) GV[m * 512 + n - 512] = f2bf(z);
            else if (n < 1536) GR[m * 512 + n - 1024] = f2bf(z);
            else if (n < 1568) LR[m * 32 + n - 1536] = z;
            else if (n < 2080) AQ[m * 512 + n - 1568] = f2bf(z);
            else if (n < 2208) AK[m * 128 + n - 2080] = f2bf(z);
            else AV[m * 128 + n - 2208] = f2bf(z);
        }
    }
}

__global__ void __launch_bounds__(128) n_gla_scan(const bf16* GQ, const bf16* GK, const bf16* GV, const float* LR, const float* gate_w, const float* gate_b, float* GO) {
    __shared__ float eg[64], qs[64], ks[64];
    int dir = blockIdx.x & 1, h = (blockIdx.x >> 1) & 3, b = blockIdx.x >> 3, v = threadIdx.x;
    float Sr[64];
#pragma unroll
    for (int k = 0; k < 64; ++k) Sr[k] = 0.f;
    for (int i = 0; i < CL + S; ++i) {
        size_t m;
        if (i < CL) m = NL + b * CL + (dir ? CL - 1 - i : i);
        else { int ii = i - CL; m = (size_t)b * S + (dir ? S - 1 - ii : ii); }
        if (v < 64) {
            int k = v;
            float z = gate_b[dir * 256 + h * 64 + k];
            for (int r = 0; r < 16; ++r) z += LR[m * 32 + dir * 16 + r] * gate_w[(dir * 16 + r) * 256 + h * 64 + k];
            float ls = fminf(z, 0.f) - log1pf(expf(-fabsf(z)));
            eg[k] = expf(ls / 16.f);
            qs[k] = bf2f(GQ[m * 256 + h * 64 + k]) * 0.125f;
            ks[k] = bf2f(GK[m * 256 + h * 64 + k]);
        }
        __syncthreads();
        float vv = bf2f(GV[m * 512 + h * 128 + v]);
        float o = 0.f;
#pragma unroll
        for (int k = 0; k < 64; ++k) { Sr[k] = eg[k] * Sr[k] + ks[k] * vv; o += qs[k] * Sr[k]; }
        GO[((size_t)dir * NT + m) * 512 + h * 128 + v] = o;
        __syncthreads();
    }
}

__global__ void n_gla_out(const float* GO, const bf16* GR, const float* gnorm, bf16* MIX) {
    int wave = threadIdx.x >> 6, lane = threadIdx.x & 63;
    size_t job = (size_t)blockIdx.x * 4 + wave;
    size_t m = job / 4; int h = job % 4;
    float o[2]; float ss = 0.f;
    for (int i = 0; i < 2; ++i) {
        int v = lane + 64 * i;
        o[i] = GO[m * 512 + h * 128 + v] + GO[((size_t)NT + m) * 512 + h * 128 + v];
        ss += o[i] * o[i];
    }
    ss = wave_sum(ss);
    float rstd = rsqrtf(ss / 128.f + EPS);
    for (int i = 0; i < 2; ++i) {
        int v = lane + 64 * i;
        float r = bf2f(GR[m * 512 + h * 128 + v]);
        MIX[m * 1024 + h * 128 + v] = f2bf(o[i] * rstd * gnorm[v] * silu(r));
    }
}

__global__ void __launch_bounds__(128) n_dense_attn(const bf16* AQ, const bf16* AK, const bf16* AV, bf16* MIX) {
    int qb = blockIdx.x % 34, bh = blockIdx.x / 34, hq = bh % 8, b = bh / 8, kv = hq / 4;
    bool isctx = qb >= 32;
    size_t m = isctx ? (size_t)NL + b * CL + (qb - 32) * 128 + threadIdx.x : (size_t)b * S + qb * 128 + threadIdx.x;
    float q[64], o[64];
#pragma unroll
    for (int d = 0; d < 64; ++d) { q[d] = bf2f(AQ[m * 512 + hq * 64 + d]) * 0.125f; o[d] = 0.f; }
    float mx = -INFINITY, l = 0.f;
    for (int seg = isctx ? 1 : 0; seg < 2; ++seg) {
        int nk = seg == 0 ? S : CL;
        size_t base = seg == 0 ? (size_t)b * S : (size_t)NL + b * CL;
        for (int j = 0; j < nk; ++j) {
            const bf16* kr = AK + (base + j) * 128 + kv * 64;
            const bf16* vr = AV + (base + j) * 128 + kv * 64;
            float s = 0.f;
#pragma unroll
            for (int d = 0; d < 64; ++d) s += q[d] * bf2f(kr[d]);
            float mn = fmaxf(mx, s), corr = expf(mx - mn), p = expf(s - mn);
            l = l * corr + p; mx = mn;
#pragma unroll
            for (int d = 0; d < 64; ++d) o[d] = o[d] * corr + p * bf2f(vr[d]);
        }
    }
    float inv = 1.f / l;
#pragma unroll
    for (int d = 0; d < 64; ++d) MIX[m * 1024 + 512 + hq * 64 + d] = f2bf(o[d] * inv);
}

__global__ void __launch_bounds__(256) n_outproj(const bf16* MIX, const float* w_out, const float* modv_layer, const float* xin_lat, const float* xin_ctx,
                                                 float* xout_lat, float* xout_ctx) {
    __shared__ float hs[4][1024];
    int m0 = blockIdx.x * 4, tid = threadIdx.x;
    for (int r = 0; r < 4; ++r) for (int i = 0; i < 4; ++i) hs[r][tid + 256 * i] = bf2f(MIX[(size_t)(m0 + r) * 1024 + tid + 256 * i]);
    __syncthreads();
    for (int i = 0; i < 4; ++i) {
        int n = tid + 256 * i;
        float a0 = 0, a1 = 0, a2 = 0, a3 = 0;
        for (int k = 0; k < D; ++k) { float w = w_out[(size_t)k * D + n]; a0 += hs[0][k] * w; a1 += hs[1][k] * w; a2 += hs[2][k] * w; a3 += hs[3][k] * w; }
        float acc[4] = {a0, a1, a2, a3};
        for (int r = 0; r < 4; ++r) {
            int m = m0 + r;
            int mrow = m < NL ? m / S : 4;
            float g = modv_layer[(size_t)mrow * 6144 + 2 * 1024 + n];
            if (m < NL) xout_lat[(size_t)m * D + n] = xin_lat[(size_t)m * D + n] + g * acc[r];
            else xout_ctx[(size_t)(m - NL) * D + n] = xin_ctx[(size_t)(m - NL) * D + n] + g * acc[r];
        }
    }
}

__global__ void __launch_bounds__(256) n_moe(float* xlat, float* xctx, const float* modv_layer, const float* norm_ffn, const float* wg, const float* bg, const float* we,
                                             const float* be, const float* w_gate, const float* w_up, const float* w_down) {
    __shared__ float hs[1024];
    __shared__ float hid[256];
    __shared__ float red[4][20];
    __shared__ float logit[20];
    __shared__ int sel[2];
    __shared__ float selw[2];
    __shared__ float scr[4];
    int m = blockIdx.x, tid = threadIdx.x;
    float* xr = m < NL ? xlat + (size_t)m * D : xctx + (size_t)(m - NL) * D;
    int mrow = m < NL ? m / S : 4;
    const float* mv = modv_layer + (size_t)mrow * 6144;
    float xv[4]; float ss = 0.f;
    for (int i = 0; i < 4; ++i) { xv[i] = xr[tid + 256 * i]; ss += xv[i] * xv[i]; }
    float tot = block_sum256(ss, scr);
    float rstd = rsqrtf(tot / D + EPS);
    for (int i = 0; i < 4; ++i) { int k = tid + 256 * i; hs[k] = xv[i] * rstd * norm_ffn[k] * (1.f + mv[4 * 1024 + k]) + mv[3 * 1024 + k]; }
    __syncthreads();
    float part[20];
    for (int j = 0; j < 20; ++j) part[j] = 0.f;
    for (int i = 0; i < 4; ++i) {
        int k = tid + 256 * i; float hv = hs[k];
        for (int j = 0; j < 4; ++j) part[j] += hv * wg[k * 4 + j];
        for (int j = 0; j < 16; ++j) part[4 + j] += hv * we[k * 16 + j];
    }
    for (int j = 0; j < 20; ++j) { float v = wave_sum(part[j]); if ((tid & 63) == 0) red[tid >> 6][j] = v; }
    __syncthreads();
    if (tid < 20) logit[tid] = red[0][tid] + red[1][tid] + red[2][tid] + red[3][tid] + (tid < 4 ? bg[tid] : be[tid - 4]);
    __syncthreads();
    if (tid == 0) {
        int gi = 0; float gm = logit[0];
        for (int j = 1; j < 4; ++j) if (logit[j] > gm) { gm = logit[j]; gi = j; }
        float gs = 0.f; for (int j = 0; j < 4; ++j) gs += expf(logit[j] - gm);
        float gw = 1.f / gs;
        float el[4]; for (int j = 0; j < 4; ++j) el[j] = logit[4 + gi * 4 + j];
        int i0 = 0; for (int j = 1; j < 4; ++j) if (el[j] > el[i0]) i0 = j;
        int i1 = -1; for (int j = 0; j < 4; ++j) if (j != i0 && (i1 < 0 || el[j] > el[i1])) i1 = j;
        float p1 = expf(el[i1] - el[i0]);
        float w0 = 1.f / (1.f + p1), w1 = p1 / (1.f + p1);
        sel[0] = gi * 4 + i0; sel[1] = gi * 4 + i1; selw[0] = gw * w0; selw[1] = gw * w1;
    }
    __syncthreads();
    float out[4] = {0.f, 0.f, 0.f, 0.f};
    for (int sl = 0; sl < 2; ++sl) {
        int e = sel[sl]; float cw = selw[sl];
        const float* Wg = w_gate + (size_t)e * D * 256; const float* Wu = w_up + (size_t)e * D * 256; const float* Wd = w_down + (size_t)e * 256 * D;
        float a = 0.f, u = 0.f;
        for (int k = 0; k < D; ++k) { float hv = hs[k]; a += hv * Wg[(size_t)k * 256 + tid]; u += hv * Wu[(size_t)k * 256 + tid]; }
        __syncthreads();
        hid[tid] = silu(a) * u * cw;
        __syncthreads();
        for (int i = 0; i < 4; ++i) { int n = tid + 256 * i; float acc = 0.f; for (int f = 0; f < 256; ++f) acc += hid[f] * Wd[(size_t)f * D + n]; out[i] += acc; }
    }
    for (int i = 0; i < 4; ++i) { int n = tid + 256 * i; xr[n] = xv[i] + mv[5 * 1024 + n] * out[i]; }
}

__global__ void __launch_bounds__(256) n_odd_inproj(const float* x, const float* ctx, const float* modv_layer, const float* norm_mix, const float* w_in,
                                                    const float* qn, const float* kn, bf16* OQ, bf16* OK, bf16* OV) {
    __shared__ float hs[4][1024];
    __shared__ float zs[4][ODD_IN];
    __shared__ float scr[4];
    int m0 = blockIdx.x * 4, tid = threadIdx.x;
    load_modulate4(x, ctx, modv_layer, norm_mix, 0, m0, hs, scr);
    for (int n = tid; n < ODD_IN; n += 256) {
        float a0 = 0, a1 = 0, a2 = 0, a3 = 0;
        for (int k = 0; k < D; ++k) { float w = w_in[(size_t)k * ODD_IN + n]; a0 += hs[0][k] * w; a1 += hs[1][k] * w; a2 += hs[2][k] * w; a3 += hs[3][k] * w; }
        zs[0][n] = a0; zs[1][n] = a1; zs[2][n] = a2; zs[3][n] = a3;
    }
    __syncthreads();
    for (int job = tid; job < 72; job += 256) {
        int r = job / 18, hh = job % 18; int m = m0 + r;
        float* y = &zs[r][hh * 64];
        const float* g = hh < 16 ? qn : kn;
        float ss = 0.f; for (int d = 0; d < 64; ++d) ss += y[d] * y[d];
        float rstd = rsqrtf(ss / 64.f + EPS);
        for (int d = 0; d < 64; ++d) y[d] = y[d] * rstd * g[d];
        if (m < NL) rope64(y, m % S);
    }
    __syncthreads();
    for (int r = 0; r < 4; ++r) {
        size_t m = m0 + r;
        for (int n = tid; n < ODD_IN; n += 256) {
            float z = zs[r][n];
            if (n < 1024) { if (m < NL) OQ[m * 1024 + n] = f2bf(z); }
            else if (n < 1152) OK[m * 128 + n - 1024] = f2bf(z);
            else OV[m * 128 + n - 1152] = f2bf(z);
        }
    }
}

__global__ void __launch_bounds__(128) n_swa_attn(const bf16* OQ, const bf16* OK, const bf16* OV, const float* sink, bf16* MIX) {
    int qb = blockIdx.x % 32, bh = blockIdx.x / 32, hq = bh % 16, b = bh / 16, kv = hq / 8;
    int t = qb * 128 + threadIdx.x;
    size_t m = (size_t)b * S + t;
    float q[64], o[64];
#pragma unroll
    for (int d = 0; d < 64; ++d) { q[d] = bf2f(OQ[m * 1024 + hq * 64 + d]) * 0.125f; o[d] = 0.f; }
    float mx = -INFINITY, l = 0.f;
    int jlo = qb * 128 - 128, jhi = qb * 128 + 127 + 128;
    if (jlo < 0) jlo = 0;
    if (jhi > S - 1) jhi = S - 1;
    for (int seg = 0; seg < 2; ++seg) {
        int j0 = seg == 0 ? jlo : 0, j1 = seg == 0 ? jhi : CL - 1;
        size_t base = seg == 0 ? (size_t)b * S : (size_t)NL + b * CL;
        for (int j = j0; j <= j1; ++j) {
            const bf16* kr = OK + (base + j) * 128 + kv * 64;
            const bf16* vr = OV + (base + j) * 128 + kv * 64;
            float s = 0.f;
#pragma unroll
            for (int d = 0; d < 64; ++d) s += q[d] * bf2f(kr[d]);
            bool ok = seg == 1 || (j - t <= 128 && t - j <= 128);
            if (ok) {
                float mn = fmaxf(mx, s), corr = expf(mx - mn), p = expf(s - mn);
                l = l * corr + p; mx = mn;
#pragma unroll
                for (int d = 0; d < 64; ++d) o[d] = o[d] * corr + p * bf2f(vr[d]);
            }
        }
    }
    l += expf(sink[hq] - mx);
    float inv = 1.f / l;
#pragma unroll
    for (int d = 0; d < 64; ++d) MIX[m * 1024 + hq * 64 + d] = f2bf(o[d] * inv);
}

extern "C" void kernel_launch(void* const* d_in, const int* in_sizes, int n_in, void* d_out, int out_size, void* d_ws, size_t ws_size, hipStream_t stream) {
    const float* x = (const float*)d_in[0]; const float* c = (const float*)d_in[1]; const float* ctx = (const float*)d_in[2]; const float* c_ctx = (const float*)d_in[3];
    const float* mod_w = (const float*)d_in[4]; const float* mod_b = (const float*)d_in[5]; const float* norm_mix = (const float*)d_in[6]; const float* norm_ffn = (const float*)d_in[7];
    const float* ev_w_in = (const float*)d_in[8]; const float* ev_w_out = (const float*)d_in[9]; const float* gate_w = (const float*)d_in[10]; const float* gate_b = (const float*)d_in[11];
    const float* gla_norm = (const float*)d_in[12]; const float* att_qn = (const float*)d_in[13]; const float* att_kn = (const float*)d_in[14];
    const float* od_w_in = (const float*)d_in[15]; const float* od_w_out = (const float*)d_in[16]; const float* sink = (const float*)d_in[17];
    const float* swa_qn = (const float*)d_in[18]; const float* swa_kn = (const float*)d_in[19];
    const float* rgw = (const float*)d_in[20]; const float* rgb = (const float*)d_in[21]; const float* rew = (const float*)d_in[22]; const float* reb = (const float*)d_in[23];
    const float* ewg = (const float*)d_in[24]; const float* ewu = (const float*)d_in[25]; const float* ewd = (const float*)d_in[26];
    float* out = (float*)d_out;
    char* ws = (char*)d_ws;
    size_t off = 0;
    auto take = [&](size_t bytes) { char* p = ws + off; off += (bytes + 255) & ~(size_t)255; return p; };
    float* modv = (float*)take((size_t)2 * 5 * 6144 * 4);
    float* CTXS = (float*)take((size_t)NC * D * 4);
    bf16* GQ = (bf16*)take((size_t)NT * 256 * 2); bf16* GK = (bf16*)take((size_t)NT * 256 * 2);
    bf16* GV = (bf16*)take((size_t)NT * 512 * 2); bf16* GR = (bf16*)take((size_t)NT * 512 * 2);
    float* LR = (float*)take((size_t)NT * 32 * 4);
    bf16* AQ = (bf16*)take((size_t)NT * 512 * 2); bf16* AK = (bf16*)take((size_t)NT * 128 * 2); bf16* AV = (bf16*)take((size_t)NT * 128 * 2);
    bf16* MIX = (bf16*)take((size_t)NT * 1024 * 2);
    float* GO = (float*)take((size_t)2 * NT * 512 * 4);
    bf16* OQ = GV;   bf16* OK = AK; bf16* OV = AV;

    n_mod<<<dim3(24, 5, 2), 256, 0, stream>>>(c, c_ctx, mod_w, mod_b, modv);
    const float* mv0 = modv; const float* mv1 = modv + 5 * 6144;
    n_even_inproj<<<NT / 4, 256, 0, stream>>>(x, ctx, mv0, norm_mix, ev_w_in, att_qn, att_kn, GQ, GK, GV, GR, LR, AQ, AK, AV);
    n_gla_scan<<<32, 128, 0, stream>>>(GQ, GK, GV, LR, gate_w, gate_b, GO);
    n_gla_out<<<NT, 256, 0, stream>>>(GO, GR, gla_norm, MIX);
    n_dense_attn<<<NB * 8 * 34, 128, 0, stream>>>(AQ, AK, AV, MIX);
    n_outproj<<<NT / 4, 256, 0, stream>>>(MIX, ev_w_out, mv0, x, ctx, out, CTXS);
    n_moe<<<NT, 256, 0, stream>>>(out, CTXS, mv0, norm_ffn, rgw, rgb, rew, reb, ewg, ewu, ewd);
    n_odd_inproj<<<NT / 4, 256, 0, stream>>>(out, CTXS, mv1, norm_mix + D, od_w_in, swa_qn, swa_kn, OQ, OK, OV);
    n_swa_attn<<<NB * 16 * 32, 128, 0, stream>>>(OQ, OK, OV, sink, MIX);
    n_outproj<<<NL / 4, 256, 0, stream>>>(MIX, od_w_out, mv1, out, CTXS, out, CTXS);
    n_moe<<<NL, 256, 0, stream>>>(out, CTXS, mv1, norm_ffn + D, rgw + D * 4, rgb + 4, rew + D * 16, reb + 16, ewg + (size_t)16 * D * 256, ewu + (size_t)16 * D * 256, ewd + (size_t)16 * 256 * D);
}
```

```cpp
#include <hip/hip_runtime.h>
#include <stdint.h>

typedef unsigned short bf16;
__device__ __forceinline__ float bf2f(bf16 v) { return __uint_as_float(((unsigned)v) << 16); }
__device__ __forceinline__ bf16 f2bf(float f) { unsigned u = __float_as_uint(f); return (bf16)((u + 0x7fffu + ((u >> 16) & 1u)) >> 16); }

constexpr int D = 1024, NB = 4, S = 4096, CL = 256, NL = NB * S, NC = NB * CL, NT = NL + NC;
constexpr int EVEN_IN = 2336, ODD_IN = 1280;
constexpr float EPS = 1e-6f;

__device__ __forceinline__ float silu(float x) { return x / (1.f + expf(-x)); }
__device__ __forceinline__ float wave_sum(float v) {
#pragma unroll
    for (int o = 1; o < 64; o <<= 1) v += __shfl_xor(v, o);
    return v;
}
__device__ __forceinline__ float block_sum256(float v, float* scr) {
    v = wave_sum(v);
    __syncthreads();
    if ((threadIdx.x & 63) == 0) scr[threadIdx.x >> 6] = v;
    __syncthreads();
    return scr[0] + scr[1] + scr[2] + scr[3];
}

__global__ void n_mod(const float* c, const float* c_ctx, const float* mod_w, const float* mod_b, float* modv) {
    int col = blockIdx.x * 256 + threadIdx.x;
    int row = blockIdx.y, layer = blockIdx.z;
    const float* cv = row < 4 ? c + row * D : c_ctx;
    const float* w = mod_w + (size_t)layer * D * 6144;
    float acc = 0.f;
    for (int k = 0; k < D; ++k) acc += silu(cv[k]) * w[(size_t)k * 6144 + col];
    modv[((size_t)layer * 5 + row) * 6144 + col] = acc + mod_b[layer * 6144 + col];
}

__device__ __forceinline__ void rope64(float* y, int t) {
    int pos[2] = {t / 64, t % 64};
    for (int ax = 0; ax < 2; ++ax)
        for (int f = 0; f < 16; ++f) {
            float inv = powf(10000.f, -(float)(2 * f) / 32.f);
            float ang = (float)pos[ax] * inv;
            float cs = cosf(ang), sn = sinf(ang);
            float x1 = y[ax * 32 + f], x2 = y[ax * 32 + 16 + f];
            y[ax * 32 + f] = x1 * cs - x2 * sn;
            y[ax * 32 + 16 + f] = x2 * cs + x1 * sn;
        }
}

__device__ __forceinline__ void load_modulate4(const float* xlat, const float* xctx, const float* modv_layer, const float* gain, int which,
                                               int m0, float (*hs)[1024], float* scr) {
    for (int r = 0; r < 4; ++r) {
        int m = m0 + r;
        const float* xr = m < NL ? xlat + (size_t)m * D : xctx + (size_t)(m - NL) * D;
        int mrow = m < NL ? m / S : 4;
        const float* mv = modv_layer + (size_t)mrow * 6144;
        float v[4]; float ss = 0.f;
        for (int i = 0; i < 4; ++i) { v[i] = xr[threadIdx.x + 256 * i]; ss += v[i] * v[i]; }
        float tot = block_sum256(ss, scr);
        float rstd = rsqrtf(tot / D + EPS);
        for (int i = 0; i < 4; ++i) {
            int k = threadIdx.x + 256 * i;
            hs[r][k] = v[i] * rstd * gain[k] * (1.f + mv[(which + 1) * 1024 + k]) + mv[which * 1024 + k];
        }
    }
    __syncthreads();
}

__global__ void __launch_bounds__(256) n_even_inproj(const float* x, const float* ctx, const float* modv_layer, const float* norm_mix, const float* w_in,
                                                     const float* qn, const float* kn, bf16* GQ, bf16* GK, bf16* GV, bf16* GR, float* LR, bf16* AQ, bf16* AK, bf16* AV) {
    __shared__ float hs[4][1024];
    __shared__ float zs[4][EVEN_IN];
    __shared__ float scr[4];
    int m0 = blockIdx.x * 4, tid = threadIdx.x;
    load_modulate4(x, ctx, modv_layer, norm_mix, 0, m0, hs, scr);
    for (int n = tid; n < EVEN_IN; n += 256) {
        float a0 = 0, a1 = 0, a2 = 0, a3 = 0;
        for (int k = 0; k < D; ++k) { float w = w_in[(size_t)k * EVEN_IN + n]; a0 += hs[0][k] * w; a1 += hs[1][k] * w; a2 += hs[2][k] * w; a3 += hs[3][k] * w; }
        zs[0][n] = a0; zs[1][n] = a1; zs[2][n] = a2; zs[3][n] = a3;
    }
    __syncthreads();
    for (int job = tid; job < 40; job += 256) {
        int r = job / 10, hh = job % 10; int m = m0 + r;
        float* y = &zs[r][1568 + hh * 64];
        const float* g = hh < 8 ? qn : kn;
        float ss = 0.f; for (int d = 0; d < 64; ++d) ss += y[d] * y[d];
        float rstd = rsqrtf(ss / 64.f + EPS);
        for (int d = 0; d < 64; ++d) y[d] = y[d] * rstd * g[d];
        if (m < NL) rope64(y, m % S);
    }
    __syncthreads();
    for (int r = 0; r < 4; ++r) {
        size_t m = m0 + r;
        for (int n = tid; n < EVEN_IN; n += 256) {
            float z = zs[r][n];
            if (n < 256) GQ[m * 256 + n] = f2bf(z);
            else if (n < 512) GK[m * 256 + n - 256] = f2bf(z);
            else if (n < 1024) GV[m * 512 + n - 512] = f2bf(z);
            else if (n < 1536) GR[m * 512 + n - 1024] = f2bf(z);
            else if (n < 1568) LR[m * 32 + n - 1536] = z;
            else if (n < 2080) AQ[m * 512 + n - 1568] = f2bf(z);
            else if (n < 2208) AK[m * 128 + n - 2080] = f2bf(z);
            else AV[m * 128 + n - 2208] = f2bf(z);
        }
    }
}

__global__ void __launch_bounds__(128) n_gla_scan(const bf16* GQ, const bf16* GK, const bf16* GV, const float* LR, const float* gate_w, const float* gate_b, float* GO) {
    __shared__ float eg[64], qs[64], ks[64];
    int dir = blockIdx.x & 1, h = (blockIdx.x >> 1) & 3, b = blockIdx.x >> 3, v = threadIdx.x;
    float Sr[64];
#pragma unroll
    for (int k = 0; k < 64; ++k) Sr[k] = 0.f;
    for (int i = 0; i < CL + S; ++i) {
        size_t m;
        if (i < CL) m = NL + b * CL + (dir ? CL - 1 - i : i);
        else { int ii = i - CL; m = (size_t)b * S + (dir ? S - 1 - ii : ii); }
        if (v < 64) {
            int k = v;
            float z = gate_b[dir * 256 + h * 64 + k];
            for (int r = 0; r < 16; ++r) z += LR[m * 32 + dir * 16 + r] * gate_w[(dir * 16 + r) * 256 + h * 64 + k];
            float ls = fminf(z, 0.f) - log1pf(expf(-fabsf(z)));
            eg[k] = expf(ls / 16.f);
            qs[k] = bf2f(GQ[m * 256 + h * 64 + k]) * 0.125f;
            ks[k] = bf2f(GK[m * 256 + h * 64 + k]);
        }
        __syncthreads();
        float vv = bf2f(GV[m * 512 + h * 128 + v]);
        float o = 0.f;
#pragma unroll
        for (int k = 0; k < 64; ++k) { Sr[k] = eg[k] * Sr[k] + ks[k] * vv; o += qs[k] * Sr[k]; }
        GO[((size_t)dir * NT + m) * 512 + h * 128 + v] = o;
        __syncthreads();
    }
}

__global__ void n_gla_out(const float* GO, const bf16* GR, const float* gnorm, bf16* MIX) {
    int wave = threadIdx.x >> 6, lane = threadIdx.x & 63;
    size_t job = (size_t)blockIdx.x * 4 + wave;
    size_t m = job / 4; int h = job % 4;
    float o[2]; float ss = 0.f;
    for (int i = 0; i < 2; ++i) {
        int v = lane + 64 * i;
        o[i] = GO[m * 512 + h * 128 + v] + GO[((size_t)NT + m) * 512 + h * 128 + v];
        ss += o[i] * o[i];
    }
    ss = wave_sum(ss);
    float rstd = rsqrtf(ss / 128.f + EPS);
    for (int i = 0; i < 2; ++i) {
        int v = lane + 64 * i;
        float r = bf2f(GR[m * 512 + h * 128 + v]);
        MIX[m * 1024 + h * 128 + v] = f2bf(o[i] * rstd * gnorm[v] * silu(r));
    }
}

__global__ void __launch_bounds__(128) n_dense_attn(const bf16* AQ, const bf16* AK, const bf16* AV, bf16* MIX) {
    int qb = blockIdx.x % 34, bh = blockIdx.x / 34, hq = bh % 8, b = bh / 8, kv = hq / 4;
    bool isctx = qb >= 32;
    size_t m = isctx ? (size_t)NL + b * CL + (qb - 32) * 128 + threadIdx.x : (size_t)b * S + qb * 128 + threadIdx.x;
    float q[64], o[64];
#pragma unroll
    for (int d = 0; d < 64; ++d) { q[d] = bf2f(AQ[m * 512 + hq * 64 + d]) * 0.125f; o[d] = 0.f; }
    float mx = -INFINITY, l = 0.f;
    for (int seg = isctx ? 1 : 0; seg < 2; ++seg) {
        int nk = seg == 0 ? S : CL;
        size_t base = seg == 0 ? (size_t)b * S : (size_t)NL + b * CL;
        for (int j = 0; j < nk; ++j) {
            const bf16* kr = AK + (base + j) * 128 + kv * 64;
            const bf16* vr = AV + (base + j) * 128 + kv * 64;
            float s = 0.f;
#pragma unroll
            for (int d = 0; d < 64; ++d) s += q[d] * bf2f(kr[d]);
            float mn = fmaxf(mx, s), corr = expf(mx - mn), p = expf(s - mn);
            l = l * corr + p; mx = mn;
#pragma unroll
            for (int d = 0; d < 64; ++d) o[d] = o[d] * corr + p * bf2f(vr[d]);
        }
    }
    float inv = 1.f / l;
#pragma unroll
    for (int d = 0; d < 64; ++d) MIX[m * 1024 + 512 + hq * 64 + d] = f2bf(o[d] * inv);
}

__global__ void __launch_bounds__(256) n_outproj(const bf16* MIX, const float* w_out, const float* modv_layer, const float* xin_lat, const float* xin_ctx,
                                                 float* xout_lat, float* xout_ctx) {
    __shared__ float hs[4][1024];
    int m0 = blockIdx.x * 4, tid = threadIdx.x;
    for (int r = 0; r < 4; ++r) for (int i = 0; i < 4; ++i) hs[r][tid + 256 * i] = bf2f(MIX[(size_t)(m0 + r) * 1024 + tid + 256 * i]);
    __syncthreads();
    for (int i = 0; i < 4; ++i) {
        int n = tid + 256 * i;
        float a0 = 0, a1 = 0, a2 = 0, a3 = 0;
        for (int k = 0; k < D; ++k) { float w = w_out[(size_t)k * D + n]; a0 += hs[0][k] * w; a1 += hs[1][k] * w; a2 += hs[2][k] * w; a3 += hs[3][k] * w; }
        float acc[4] = {a0, a1, a2, a3};
        for (int r = 0; r < 4; ++r) {
            int m = m0 + r;
            int mrow = m < NL ? m / S : 4;
            float g = modv_layer[(size_t)mrow * 6144 + 2 * 1024 + n];
            if (m < NL) xout_lat[(size_t)m * D + n] = xin_lat[(size_t)m * D + n] + g * acc[r];
            else xout_ctx[(size_t)(m - NL) * D + n] = xin_ctx[(size_t)(m - NL) * D + n] + g * acc[r];
        }
    }
}

__global__ void __launch_bounds__(256) n_moe(float* xlat, float* xctx, const float* modv_layer, const float* norm_ffn, const float* wg, const float* bg, const float* we,
                                             const float* be, const float* w_gate, const float* w_up, const float* w_down) {
    __shared__ float hs[1024];
    __shared__ float hid[256];
    __shared__ float red[4][20];
    __shared__ float logit[20];
    __shared__ int sel[2];
    __shared__ float selw[2];
    __shared__ float scr[4];
    int m = blockIdx.x, tid = threadIdx.x;
    float* xr = m < NL ? xlat + (size_t)m * D : xctx + (size_t)(m - NL) * D;
    int mrow = m < NL ? m / S : 4;
    const float* mv = modv_layer + (size_t)mrow * 6144;
    float xv[4]; float ss = 0.f;
    for (int i = 0; i < 4; ++i) { xv[i] = xr[tid + 256 * i]; ss += xv[i] * xv[i]; }
    float tot = block_sum256(ss, scr);
    float rstd = rsqrtf(tot / D + EPS);
    for (int i = 0; i < 4; ++i) { int k = tid + 256 * i; hs[k] = xv[i] * rstd * norm_ffn[k] * (1.f + mv[4 * 1024 + k]) + mv[3 * 1024 + k]; }
    __syncthreads();
    float part[20];
    for (int j = 0; j < 20; ++j) part[j] = 0.f;
    for (int i = 0; i < 4; ++i) {
        int k = tid + 256 * i; float hv = hs[k];
        for (int j = 0; j < 4; ++j) part[j] += hv * wg[k * 4 + j];
        for (int j = 0; j < 16; ++j) part[4 + j] += hv * we[k * 16 + j];
    }
    for (int j = 0; j < 20; ++j) { float v = wave_sum(part[j]); if ((tid & 63) == 0) red[tid >> 6][j] = v; }
    __syncthreads();
    if (tid < 20) logit[tid] = red[0][tid] + red[1][tid] + red[2][tid] + red[3][tid] + (tid < 4 ? bg[tid] : be[tid - 4]);
    __syncthreads();
    if (tid == 0) {
        int gi = 0; float gm = logit[0];
        for (int j = 1; j < 4; ++j) if (logit[j] > gm) { gm = logit[j]; gi = j; }
        float gs = 0.f; for (int j = 0; j < 4; ++j) gs += expf(logit[j] - gm);
        float gw = 1.f / gs;
        float el[4]; for (int j = 0; j < 4; ++j) el[j] = logit[4 + gi * 4 + j];
        int i0 = 0; for (int j = 1; j < 4; ++j) if (el[j] > el[i0]) i0 = j;
        int i1 = -1; for (int j = 0; j < 4; ++j) if (j != i0 && (i1 < 0 || el[j] > el[i1])) i1 = j;
        float p1 = expf(el[i1] - el[i0]);
        float w0 = 1.f / (1.f + p1), w1 = p1 / (1.f + p1);
        sel[0] = gi * 4 + i0; sel[1] = gi * 4 + i1; selw[0] = gw * w0; selw[1] = gw * w1;
    }
    __syncthreads();
    float out[4] = {0.f, 0.f, 0.f, 0.f};
    for (int sl = 0; sl < 2; ++sl) {
        int e = sel[sl]; float cw = selw[sl];
        const float* Wg = w_gate + (size_t)e * D * 256; const float* Wu = w_up + (size_t)e * D * 256; const float* Wd = w_down + (size_t)e * 256 * D;
        float a = 0.f, u = 0.f;
        for (int k = 0; k < D; ++k) { float hv = hs[k]; a += hv * Wg[(size_t)k * 256 + tid]; u += hv * Wu[(size_t)k * 256 + tid]; }
        __syncthreads();
        hid[tid] = silu(a) * u * cw;
        __syncthreads();
        for (int i = 0; i < 4; ++i) { int n = tid + 256 * i; float acc = 0.f; for (int f = 0; f < 256; ++f) acc += hid[f] * Wd[(size_t)f * D + n]; out[i] += acc; }
    }
    for (int i = 0; i < 4; ++i) { int n = tid + 256 * i; xr[n] = xv[i] + mv[5 * 1024 + n] * out[i]; }
}

__global__ void __launch_bounds__(256) n_odd_inproj(const float* x, const float* ctx, const float* modv_layer, const float* norm_mix, const float* w_in,
                                                    const float* qn, const float* kn, bf16* OQ, bf16* OK, bf16* OV) {
    __shared__ float hs[4][1024];
    __shared__ float zs[4][ODD_IN];
    __shared__ float scr[4];
    int m0 = blockIdx.x * 4, tid = threadIdx.x;
    load_modulate4(x, ctx, modv_layer, norm_mix, 0, m0, hs, scr);
    for (int n = tid; n < ODD_IN; n += 256) {
        float a0 = 0, a1 = 0, a2 = 0, a3 = 0;
        for (int k = 0; k < D; ++k) { float w = w_in[(size_t)k * ODD_IN + n]; a0 += hs[0][k] * w; a1 += hs[1][k] * w; a2 += hs[2][k] * w; a3 += hs[3][k] * w; }
        zs[0][n] = a0; zs[1][n] = a1; zs[2][n] = a2; zs[3][n] = a3;
    }
    __syncthreads();
    for (int job = tid; job < 72; job += 256) {
        int r = job / 18, hh = job % 18; int m = m0 + r;
        float* y = &zs[r][hh * 64];
        const float* g = hh < 16 ? qn : kn;
        float ss = 0.f; for (int d = 0; d < 64; ++d) ss += y[d] * y[d];
        float rstd = rsqrtf(ss / 64.f + EPS);
        for (int d = 0; d < 64; ++d) y[d] = y[d] * rstd * g[d];
        if (m < NL) rope64(y, m % S);
    }
    __syncthreads();
    for (int r = 0; r < 4; ++r) {
        size_t m = m0 + r;
        for (int n = tid; n < ODD_IN; n += 256) {
            float z = zs[r][n];
            if (n < 1024) { if (m < NL) OQ[m * 1024 + n] = f2bf(z); }
            else if (n < 1152) OK[m * 128 + n - 1024] = f2bf(z);
            else OV[m * 128 + n - 1152] = f2bf(z);
        }
    }
}

__global__ void __launch_bounds__(128) n_swa_attn(const bf16* OQ, const bf16* OK, const bf16* OV, const float* sink, bf16* MIX) {
    int qb = blockIdx.x % 32, bh = blockIdx.x / 32, hq = bh % 16, b = bh / 16, kv = hq / 8;
    int t = qb * 128 + threadIdx.x;
    size_t m = (size_t)b * S + t;
    float q[64], o[64];
#pragma unroll
    for (int d = 0; d < 64; ++d) { q[d] = bf2f(OQ[m * 1024 + hq * 64 + d]) * 0.125f; o[d] = 0.f; }
    float mx = -INFINITY, l = 0.f;
    int jlo = qb * 128 - 128, jhi = qb * 128 + 127 + 128;
    if (jlo < 0) jlo = 0;
    if (jhi > S - 1) jhi = S - 1;
    for (int seg = 0; seg < 2; ++seg) {
        int j0 = seg == 0 ? jlo : 0, j1 = seg == 0 ? jhi : CL - 1;
        size_t base = seg == 0 ? (size_t)b * S : (size_t)NL + b * CL;
        for (int j = j0; j <= j1; ++j) {
            const bf16* kr = OK + (base + j) * 128 + kv * 64;
            const bf16* vr = OV + (base + j) * 128 + kv * 64;
            float s = 0.f;
#pragma unroll
            for (int d = 0; d < 64; ++d) s += q[d] * bf2f(kr[d]);
            bool ok = seg == 1 || (j - t <= 128 && t - j <= 128);
            if (ok) {
                float mn = fmaxf(mx, s), corr = expf(mx - mn), p = expf(s - mn);
                l = l * corr + p; mx = mn;
#pragma unroll
                for (int d = 0; d < 64; ++d) o[d] = o[d] * corr + p * bf2f(vr[d]);
            }
        }
    }
    l += expf(sink[hq] - mx);
    float inv = 1.f / l;
#pragma unroll
    for (int d = 0; d < 64; ++d) MIX[m * 1024 + hq * 64 + d] = f2bf(o[d] * inv);
}


#define LAS __attribute__((address_space(3)))
typedef short bf16x8 __attribute__((ext_vector_type(8)));
typedef float f32x16 __attribute__((ext_vector_type(16)));
typedef float f32x4 __attribute__((ext_vector_type(4)));
typedef unsigned u32x4 __attribute__((ext_vector_type(4)));
typedef unsigned u32x2 __attribute__((ext_vector_type(2)));
typedef __bf16 bf16x2_t __attribute__((ext_vector_type(2)));
typedef float f32x2_t __attribute__((ext_vector_type(2)));
__device__ __forceinline__ unsigned pk2(float lo, float hi) { f32x2_t v = {lo, hi}; bf16x2_t b = __builtin_convertvector(v, bf16x2_t); return __builtin_bit_cast(unsigned, b); }
__device__ __forceinline__ float xhalf_sum(float x) {
    auto t = __builtin_amdgcn_permlane32_swap(__float_as_uint(x), __float_as_uint(x), false, false);
    return __uint_as_float(t[0]) + __uint_as_float(t[1]);
}

constexpr int NPAD_E = 2432;
constexpr int LDSP = 144;
constexpr int TILE_LDS = 128 * LDSP;
constexpr int GEMM_LDS = 4 * TILE_LDS;

__device__ __forceinline__ void transpose_item(const float* W, int K, int N, bf16* WT, int dst_row0, int k0, int n0, LAS float* scr, int lane) {
#pragma unroll 8
    for (int i = 0; i < 32; ++i) { const int kk = 2 * i + (lane >> 5); scr[kk * 33 + (lane & 31)] = W[(size_t)(k0 + kk) * N + n0 + (lane & 31)]; }
    asm volatile("s_waitcnt lgkmcnt(0)" ::: "memory");
    const int c = lane & 7;
#pragma unroll
    for (int j = 0; j < 4; ++j) {
        const int n = (lane >> 3) + 8 * j; const LAS float* s = scr + (8 * c) * 33 + n;
        u32x4 o; o.x = pk2(s[0 * 33], s[1 * 33]); o.y = pk2(s[2 * 33], s[3 * 33]); o.z = pk2(s[4 * 33], s[5 * 33]); o.w = pk2(s[6 * 33], s[7 * 33]);
        *(u32x4*)(WT + (size_t)(dst_row0 + n) * K + k0 + 8 * c) = o;
    }
    asm volatile("s_waitcnt lgkmcnt(0)" ::: "memory");
}

struct Ptrs {
    const float* in[27];
    float* out;
    unsigned char* ws;
};

constexpr size_t MiB = 1u << 20;
constexpr size_t WS_CTL = 0;
constexpr size_t WS_MODV = 1 * MiB;
constexpr size_t WS_ROPE = WS_MODV + 256 * 1024;
constexpr size_t WS_WINE = 2 * MiB;
constexpr size_t WS_WOUTE = WS_WINE + (size_t)NPAD_E * 1024 * 2;
constexpr size_t WS_WINO = WS_WOUTE + 2 * MiB;
constexpr size_t WS_WOUTO = WS_WINO + (size_t)1280 * 1024 * 2;
constexpr size_t WS_WGU = WS_WOUTO + 2 * MiB;
constexpr size_t WS_WD = WS_WGU + 32 * MiB;
constexpr size_t WS_CTXS = WS_WD + 16 * MiB;
constexpr size_t WS_R1 = 66 * MiB;
constexpr size_t WS_R4 = WS_R1 + 34 * MiB;
constexpr size_t WS_R2 = WS_R4 + 34 * MiB;
constexpr size_t WS_R3 = WS_R2 + 34 * MiB;
static_assert(WS_CTXS + 4 * MiB <= WS_R1, "ws map");
constexpr size_t R3_GQ = 0, R3_GK = R3_GQ + (size_t)NT * 256 * 2, R3_GV = R3_GK + (size_t)NT * 256 * 2, R3_GR = R3_GV + (size_t)NT * 512 * 2,
                 R3_LR = R3_GR + (size_t)NT * 512 * 2, R3_AQ = R3_LR + (size_t)NT * 32 * 4, R3_AK = R3_AQ + (size_t)NT * 512 * 2, R3_AV = R3_AK + (size_t)NT * 128 * 2,
                 R3_END = R3_AV + (size_t)NT * 128 * 2;
static_assert(WS_R3 + R3_END <= 256 * MiB, "ws map end");
constexpr size_t R3_OQ = 0, R3_OK = R3_OQ + (size_t)NL * 1024 * 2, R3_OV = R3_OK + (size_t)NT * 128 * 2;

__global__ void __launch_bounds__(256) k_prologue(Ptrs P) {
    __shared__ float scr_all[4 * 64 * 33];
    const int lane = threadIdx.x & 63, wave = threadIdx.x >> 6;
    LAS float* scr = (LAS float*)scr_all + wave * 64 * 33;
    const int gw = blockIdx.x * 4 + wave, NGW = gridDim.x * 4;
    unsigned char* ws = P.ws;
    constexpr int I_WINE = 16 * 73, I_SQ = 16 * 32, I_WINO = 16 * 40, I_EXP_GU = 16 * 8, I_EXP_D = 4 * 32;
    constexpr int T_WINE = I_WINE, T_WOUTE = T_WINE + I_SQ, T_WINO = T_WOUTE + I_WINO, T_WOUTO = T_WINO + I_SQ,
                  T_G = T_WOUTO + 32 * I_EXP_GU, T_U = T_G + 32 * I_EXP_GU, T_D = T_U + 32 * I_EXP_D;
    for (int it = gw; it < T_D; it += NGW) {
        if (it < T_WINE) {
            int kb = it / 73, nb = it % 73, n0 = nb * 32;
            int dst = n0 < 1536 ? n0 : (n0 < 1568 ? n0 + 768 : n0 - 32);
            transpose_item(P.in[8], 1024, EVEN_IN, (bf16*)(ws + WS_WINE), dst, kb * 64, n0, scr, lane);
        } else if (it < T_WOUTE) { int r = it - T_WINE; transpose_item(P.in[9], 1024, 1024, (bf16*)(ws + WS_WOUTE), (r % 32) * 32, (r / 32) * 64, (r % 32) * 32, scr, lane); }
        else if (it < T_WINO) { int r = it - T_WOUTE; transpose_item(P.in[15], 1024, 1280, (bf16*)(ws + WS_WINO), (r % 40) * 32, (r / 40) * 64, (r % 40) * 32, scr, lane); }
        else if (it < T_WOUTO) { int r = it - T_WINO; transpose_item(P.in[16], 1024, 1024, (bf16*)(ws + WS_WOUTO), (r % 32) * 32, (r / 32) * 64, (r % 32) * 32, scr, lane); }
        else if (it < T_U) {
            bool up = it >= T_G; int r = it - (up ? T_G : T_WOUTO); int le = r / I_EXP_GU; r %= I_EXP_GU; int kb = r / 8, hb = r % 8;
            const float* W = (up ? P.in[25] : P.in[24]) + (size_t)le * 1024 * 256;
            transpose_item(W, 1024, 256, (bf16*)(ws + WS_WGU) + (size_t)le * 512 * 1024, 64 * hb + (up ? 32 : 0), kb * 64, hb * 32, scr, lane);
        } else {
            int r = it - T_U; int le = r / I_EXP_D; r %= I_EXP_D; int kb = r / 32, nb = r % 32;
            transpose_item(P.in[26] + (size_t)le * 256 * 1024, 256, 1024, (bf16*)(ws + WS_WD) + (size_t)le * 1024 * 256, nb * 32, kb * 64, nb * 32, scr, lane);
        }
    }
    { u32x4 z = {0, 0, 0, 0}; u32x4* p = (u32x4*)((bf16*)(ws + WS_WINE) + (size_t)EVEN_IN * 1024);
      for (int i = blockIdx.x * 256 + threadIdx.x; i < 96 * 1024 * 2 / 16; i += gridDim.x * 256) p[i] = z; }
    for (int i = blockIdx.x * 256 + threadIdx.x; i < 1024; i += gridDim.x * 256) {
        int pos = i >> 4, f = i & 15; float inv = powf(10000.f, -(float)(2 * f) / 32.f); float ang = (float)pos * inv;
        ((float2*)(ws + WS_ROPE))[i] = make_float2(cosf(ang), sinf(ang));
    }
}

__device__ __forceinline__ void modulate_rows(const float* xlat, const float* xctx, const float* modv_layer, const float* gain, int which, bf16* H, int nrows, int gw, int NGW, int lane) {
    for (int row = gw; row < nrows; row += NGW) {
        const float* xr = row < NL ? xlat + (size_t)row * D : xctx + (size_t)(row - NL) * D;
        const float* mv = modv_layer + (size_t)(row < NL ? row / S : 4) * 6144;
        f32x4 v[4]; float ss = 0.f;
#pragma unroll
        for (int j = 0; j < 4; ++j) { v[j] = *(const f32x4*)(xr + 4 * lane + 256 * j); ss += v[j].x * v[j].x + v[j].y * v[j].y + v[j].z * v[j].z + v[j].w * v[j].w; }
        float rstd = rsqrtf(wave_sum(ss) / D + EPS);
#pragma unroll
        for (int j = 0; j < 4; ++j) {
            int k = 4 * lane + 256 * j;
            f32x4 g = *(const f32x4*)(gain + k), sc = *(const f32x4*)(mv + (which + 1) * 1024 + k), sh = *(const f32x4*)(mv + which * 1024 + k);
            float h0 = v[j].x * rstd * g.x * (1.f + sc.x) + sh.x, h1 = v[j].y * rstd * g.y * (1.f + sc.y) + sh.y;
            float h2 = v[j].z * rstd * g.z * (1.f + sc.z) + sh.z, h3 = v[j].w * rstd * g.w * (1.f + sc.w) + sh.w;
            u32x2 o = {pk2(h0, h1), pk2(h2, h3)};
            *(u32x2*)(H + (size_t)row * D + k) = o;
        }
    }
}
__global__ void __launch_bounds__(256) k_modulate(const float* xlat, const float* xctx, const float* modv_layer, const float* gain, int which, bf16* H, int nrows) {
    modulate_rows(xlat, xctx, modv_layer, gain, which, H, nrows, blockIdx.x * 4 + (threadIdx.x >> 6), gridDim.x * 4, threadIdx.x & 63);
}

struct AffineRows {
    const bf16* p; size_t stride32;
    __device__ __forceinline__ AffineRows(const bf16* base, size_t ld, int lrow, int kc) : p(base + (size_t)lrow * ld + kc * 8), stride32(32 * ld) {}
    __device__ __forceinline__ const bf16* ptr(int i, int kt) const { return p + i * stride32 + kt * 64; }
};
template <class AF, class BF, class Epi>
__device__ __forceinline__ void gemm_tile(const AF& af, const BF& bf, int nk, LAS unsigned char* smem, const Epi& epi) {
    const int tid = threadIdx.x, lane = tid & 63, wave = tid >> 6, wn = wave & 1, wm = wave >> 1;
    const int lrow = tid >> 3, kc = tid & 7, l31 = lane & 31, hh = lane >> 5;
    u32x4 ra[4], rb[4];
    const bool swp = epi.swapped();
#pragma unroll
    for (int i = 0; i < 4; ++i) { ra[i] = *(const u32x4*)af.ptr(i, 0); rb[i] = *(const u32x4*)bf.ptr(i, 0); }
    const int woff = lrow * LDSP + kc * 16;
#pragma unroll
    for (int i = 0; i < 4; ++i) { *(LAS u32x4*)(smem + woff + i * 32 * LDSP) = ra[i]; *(LAS u32x4*)(smem + 2 * TILE_LDS + woff + i * 32 * LDSP) = rb[i]; }
    __syncthreads();
    f32x16 acc[2][2];
#pragma unroll
    for (int i = 0; i < 2; ++i)
#pragma unroll
        for (int j = 0; j < 2; ++j)
#pragma unroll
            for (int r = 0; r < 16; ++r) acc[i][j][r] = 0.f;
    const int xoff = (wm * 64 + l31) * LDSP + hh * 16;
    const int woffr = 2 * TILE_LDS + (wn * 64 + l31) * LDSP + hh * 16;
    for (int kt = 0; kt < nk; ++kt) {
        const int st = kt & 1;
        if (kt + 1 < nk) {
#pragma unroll
            for (int i = 0; i < 4; ++i) { ra[i] = *(const u32x4*)af.ptr(i, kt + 1); rb[i] = *(const u32x4*)bf.ptr(i, kt + 1); }
        }
        LAS unsigned char* sb = smem + st * TILE_LDS;
#pragma unroll
        for (int s = 0; s < 4; ++s) {
            bf16x8 wf[2], xf[2];
#pragma unroll
            for (int i = 0; i < 2; ++i) wf[i] = *(LAS bf16x8*)(sb + woffr + i * 32 * LDSP + s * 32);
#pragma unroll
            for (int j = 0; j < 2; ++j) xf[j] = *(LAS bf16x8*)(sb + xoff + j * 32 * LDSP + s * 32);
#pragma unroll
            for (int i = 0; i < 2; ++i)
#pragma unroll
                for (int j = 0; j < 2; ++j) acc[i][j] = swp ? __builtin_amdgcn_mfma_f32_32x32x16_bf16(xf[j], wf[i], acc[i][j], 0, 0, 0)
                                                            : __builtin_amdgcn_mfma_f32_32x32x16_bf16(wf[i], xf[j], acc[i][j], 0, 0, 0);
        }
        if (kt + 1 < nk) {
            LAS unsigned char* sn = smem + (st ^ 1) * TILE_LDS;
#pragma unroll
            for (int i = 0; i < 4; ++i) { *(LAS u32x4*)(sn + woff + i * 32 * LDSP) = ra[i]; *(LAS u32x4*)(sn + 2 * TILE_LDS + woff + i * 32 * LDSP) = rb[i]; }
        }
        __syncthreads();
    }
    epi(acc, wn * 64, wm * 64, l31, hh);
}

__device__ __forceinline__ void store_bf16_T(const f32x16 (&acc)[2][2], bf16* out, size_t ld, size_t trow0, int col0, int l31, int hh) {
#pragma unroll
    for (int j = 0; j < 2; ++j) {
        bf16* rp = out + (trow0 + j * 32 + l31) * ld + col0 + 4 * hh;
#pragma unroll
        for (int i = 0; i < 2; ++i)
#pragma unroll
            for (int g = 0; g < 4; ++g) { u32x2 v = {pk2(acc[i][j][4 * g], acc[i][j][4 * g + 1]), pk2(acc[i][j][4 * g + 2], acc[i][j][4 * g + 3])}; *(u32x2*)(rp + i * 32 + 8 * g) = v; }
    }
}
__device__ __forceinline__ void qknorm_rope_T(f32x16 (&acc)[2][2], const float* gain, const float2* ropeT, bool latent, int tok0  , int l31, int hh) {
#pragma unroll
    for (int j = 0; j < 2; ++j) {
        float ss = 0.f;
#pragma unroll
        for (int i = 0; i < 2; ++i)
#pragma unroll
            for (int r = 0; r < 16; ++r) ss += acc[i][j][r] * acc[i][j][r];
        ss = xhalf_sum(ss);
        const float rstd = rsqrtf(ss * (1.f / 64.f) + EPS);
#pragma unroll
        for (int i = 0; i < 2; ++i)
#pragma unroll
            for (int r = 0; r < 16; ++r) acc[i][j][r] *= rstd * gain[i * 32 + (r & 3) + 8 * (r >> 2) + 4 * hh];
        if (latent) {
            const int t = tok0 + j * 32 + l31;
#pragma unroll
            for (int i = 0; i < 2; ++i) {
                const int pos = i == 0 ? (t >> 6) : (t & 63);
#pragma unroll
                for (int r = 0; r < 8; ++r) {
                    const int f = (r & 3) + 8 * (r >> 2) + 4 * hh;
                    const float2 cs = ropeT[pos * 16 + f];
                    const float x1 = acc[i][j][r], x2 = acc[i][j][r + 8];
                    acc[i][j][r] = x1 * cs.x - x2 * cs.y; acc[i][j][r + 8] = x2 * cs.x + x1 * cs.y;
                }
            }
        }
    }
}

constexpr int VT_LD = S + CL;
__device__ __forceinline__ void store_vt_swapped(const f32x16 (&acc)[2][2], bf16* vt_head  , int key0, int l31, int hh) {
#pragma unroll
    for (int i = 0; i < 2; ++i) {
        bf16* rp = vt_head + (size_t)(i * 32 + l31) * VT_LD + key0 + 4 * hh;
#pragma unroll
        for (int j = 0; j < 2; ++j)
#pragma unroll
            for (int g = 0; g < 4; ++g) { u32x2 v = {pk2(acc[i][j][4 * g], acc[i][j][4 * g + 1]), pk2(acc[i][j][4 * g + 2], acc[i][j][4 * g + 3])}; *(u32x2*)(rp + j * 32 + 8 * g) = v; }
    }
}
struct EpiEvenIn {
    unsigned char* r3; const float* qn; const float* kn; const float2* ropeT; int mt, nt;
    __device__ __forceinline__ bool swapped() const { return nt == 17 || (nt >= 4 && nt < 8); }
    __device__ __forceinline__ void operator()(f32x16 (&acc)[2][2], int fb, int tb, int l31, int hh) const {
        const size_t trow0 = (size_t)mt * 128 + tb; const bool latent = mt < NL / 128; const int tok0 = (int)(trow0 & (S - 1));
        if (nt < 2) store_bf16_T(acc, (bf16*)(r3 + R3_GQ), 256, trow0, nt * 128 + fb, l31, hh);
        else if (nt < 4) store_bf16_T(acc, (bf16*)(r3 + R3_GK), 256, trow0, (nt - 2) * 128 + fb, l31, hh);
        else if (nt < 8) {
            const int b = latent ? (int)(trow0 / S) : (int)((trow0 - NL) / CL); const int key0 = latent ? tok0 : S + (int)((trow0 - NL) % CL);
            store_vt_swapped(acc, (bf16*)(r3 + R3_GV) + ((size_t)(b * 4 + nt - 4) * 128 + fb) * VT_LD, key0, l31, hh);
        }
        else if (nt < 12) store_bf16_T(acc, (bf16*)(r3 + R3_GR), 512, trow0, (nt - 8) * 128 + fb, l31, hh);
        else if (nt < 16) { qknorm_rope_T(acc, qn, ropeT, latent, tok0, l31, hh); store_bf16_T(acc, (bf16*)(r3 + R3_AQ), 512, trow0, (nt - 12) * 128 + fb, l31, hh); }
        else if (nt == 16) { qknorm_rope_T(acc, kn, ropeT, latent, tok0, l31, hh); store_bf16_T(acc, (bf16*)(r3 + R3_AK), 128, trow0, fb, l31, hh); }
        else if (nt == 17) {
            const int b = latent ? (int)(trow0 / S) : (int)((trow0 - NL) / CL); const int key0 = latent ? tok0 : S + (int)((trow0 - NL) % CL);
            store_vt_swapped(acc, (bf16*)(r3 + R3_AV) + (size_t)(b * 2 + fb / 64) * 64 * VT_LD, key0, l31, hh);
        }
        else if (fb == 0) {
            float* LR = (float*)(r3 + R3_LR);
#pragma unroll
            for (int j = 0; j < 2; ++j)
#pragma unroll
                for (int g = 0; g < 4; ++g) { f32x4 v = {acc[0][j][4 * g], acc[0][j][4 * g + 1], acc[0][j][4 * g + 2], acc[0][j][4 * g + 3]}; *(f32x4*)(LR + (trow0 + j * 32 + l31) * 32 + 8 * g + 4 * hh) = v; }
        }
    }
};
__device__ __forceinline__ int xcd_vid(int bid, int nb) { return (nb % 8 == 0) ? (bid % 8) * (nb / 8) + bid / 8 : bid; }

__global__ void __launch_bounds__(256, 2) k_even_inproj(Ptrs P) {
    __shared__ __attribute__((aligned(16))) unsigned char smem_raw[GEMM_LDS];
    LAS unsigned char* smem = (LAS unsigned char*)smem_raw;
    unsigned char* ws = P.ws;
    const int lrow = threadIdx.x >> 3, kc = threadIdx.x & 7;
    const int vid = xcd_vid(blockIdx.x, gridDim.x);
    for (int tile = vid; tile < (NT / 128) * 19; tile += gridDim.x) {
        const int mt = tile / 19, nt = tile % 19;
        AffineRows af((const bf16*)(ws + WS_R1) + (size_t)mt * 128 * D, D, lrow, kc);
        AffineRows bf_((const bf16*)(ws + WS_WINE) + (size_t)nt * 128 * D, D, lrow, kc);
        EpiEvenIn epi{ws + WS_R3, P.in[13], P.in[14], (const float2*)(ws + WS_ROPE), mt, nt};
        gemm_tile(af, bf_, D / 64, smem, epi);
    }
}

struct EpiOutProj {
    const float* modv_layer; const float* xin_lat; const float* xin_ctx; float* xout_lat; float* xout_ctx; int mt, nt;
    __device__ __forceinline__ bool swapped() const { return false; }
    __device__ __forceinline__ void operator()(f32x16 (&acc)[2][2], int fb, int tb, int l31, int hh) const {
        const size_t trow0 = (size_t)mt * 128 + tb; const bool latent = mt < NL / 128;
        const float* gate = modv_layer + (size_t)(latent ? trow0 / S : 4) * 6144 + 2 * 1024 + nt * 128 + fb + 4 * hh;
        const float* xin = latent ? xin_lat + trow0 * D : xin_ctx + (trow0 - NL) * D;
        float* xout = latent ? xout_lat + trow0 * D : xout_ctx + (trow0 - NL) * D;
        const int c0 = nt * 128 + fb + 4 * hh;
#pragma unroll
        for (int j = 0; j < 2; ++j)
#pragma unroll
            for (int i = 0; i < 2; ++i)
#pragma unroll
                for (int g = 0; g < 4; ++g) {
                    const size_t o = (size_t)(j * 32 + l31) * D + c0 + i * 32 + 8 * g;
                    const f32x4 gt = *(const f32x4*)(gate + i * 32 + 8 * g); const f32x4 xi = *(const f32x4*)(xin + o);
                    f32x4 v = {xi.x + gt.x * acc[i][j][4 * g], xi.y + gt.y * acc[i][j][4 * g + 1], xi.z + gt.z * acc[i][j][4 * g + 2], xi.w + gt.w * acc[i][j][4 * g + 3]};
                    *(f32x4*)(xout + o) = v;
                }
    }
};
__global__ void __launch_bounds__(256, 2) k_outproj(Ptrs P, int layer, int nrows) {
    __shared__ __attribute__((aligned(16))) unsigned char smem_raw[GEMM_LDS];
    LAS unsigned char* smem = (LAS unsigned char*)smem_raw;
    unsigned char* ws = P.ws;
    const int lrow = threadIdx.x >> 3, kc = threadIdx.x & 7;
    const int vid = xcd_vid(blockIdx.x, gridDim.x);
    const float* modv_layer = (const float*)(ws + WS_MODV) + (size_t)layer * 5 * 6144;
    for (int tile = vid; tile < (nrows / 128) * 8; tile += gridDim.x) {
        const int mt = tile / 8, nt = tile % 8;
        AffineRows af((const bf16*)(ws + WS_R2) + (size_t)mt * 128 * D, D, lrow, kc);
        AffineRows bf_((const bf16*)(ws + (layer ? WS_WOUTO : WS_WOUTE)) + (size_t)nt * 128 * D, D, lrow, kc);
        EpiOutProj epi{modv_layer, layer ? P.out : P.in[0], layer ? (const float*)(ws + WS_CTXS) : P.in[2], P.out, (float*)(ws + WS_CTXS), mt, nt};
        gemm_tile(af, bf_, D / 64, smem, epi);
    }
}

struct EpiOddIn {
    unsigned char* r3; const float* qn; const float* kn; const float2* ropeT; int mt, nt;
    __device__ __forceinline__ bool swapped() const { return nt == 9; }
    __device__ __forceinline__ void operator()(f32x16 (&acc)[2][2], int fb, int tb, int l31, int hh) const {
        const size_t trow0 = (size_t)mt * 128 + tb; const bool latent = mt < NL / 128; const int tok0 = (int)(trow0 & (S - 1));
        if (nt < 8) { if (latent) { qknorm_rope_T(acc, qn, ropeT, true, tok0, l31, hh); store_bf16_T(acc, (bf16*)(r3 + R3_OQ), 1024, trow0, nt * 128 + fb, l31, hh); } }
        else if (nt == 8) { qknorm_rope_T(acc, kn, ropeT, latent, tok0, l31, hh); store_bf16_T(acc, (bf16*)(r3 + R3_OK), 128, trow0, fb, l31, hh); }
        else {
            const int b = latent ? (int)(trow0 / S) : (int)((trow0 - NL) / CL); const int key0 = latent ? tok0 : S + (int)((trow0 - NL) % CL);
            store_vt_swapped(acc, (bf16*)(r3 + R3_OV) + (size_t)(b * 2 + fb / 64) * 64 * VT_LD, key0, l31, hh);
        }
    }
};
__global__ void __launch_bounds__(256, 2) k_odd_inproj(Ptrs P) {
    __shared__ __attribute__((aligned(16))) unsigned char smem_raw[GEMM_LDS];
    LAS unsigned char* smem = (LAS unsigned char*)smem_raw;
    unsigned char* ws = P.ws;
    const int lrow = threadIdx.x >> 3, kc = threadIdx.x & 7;
    const int vid = xcd_vid(blockIdx.x, gridDim.x);
    constexpr int T_LAT = (NL / 128) * 10, T_ALL = T_LAT + (NC / 128) * 2;
    for (int tile = vid; tile < T_ALL; tile += gridDim.x) {
        int mt, nt;
        if (tile < T_LAT) { mt = tile / 10; nt = tile % 10; } else { mt = NL / 128 + (tile - T_LAT) / 2; nt = 8 + (tile - T_LAT) % 2; }
        AffineRows af((const bf16*)(ws + WS_R1) + (size_t)mt * 128 * D, D, lrow, kc);
        AffineRows bf_((const bf16*)(ws + WS_WINO) + (size_t)nt * 128 * D, D, lrow, kc);
        EpiOddIn epi{ws + WS_R3, P.in[18], P.in[19], (const float2*)(ws + WS_ROPE), mt, nt};
        gemm_tile(af, bf_, D / 64, smem, epi);
    }
}

constexpr int AT_KP = 144, AT_VP = 136;
constexpr int AT_STAGE = 64 * AT_KP + 64 * AT_VP;
constexpr int ATTN_LDS = 2 * AT_STAGE;
struct AttnArgs {
    const bf16* Q; int ldq; size_t qrow0; int qcol;
    const bf16* K; size_t klat0, kctx0;
    const bf16* Vt;
    int nctx, tlo, nlat;
    int banded, tq0;
    float sink_l2;
    bf16* out;
};
__device__ __forceinline__ float xhalf_max(float x) {
    auto t = __builtin_amdgcn_permlane32_swap(__float_as_uint(x), __float_as_uint(x), false, false);
    return fmaxf(__uint_as_float(t[0]), __uint_as_float(t[1]));
}
__device__ __forceinline__ void attn_block(const AttnArgs& a, LAS unsigned char* smem) {
    const int tid = threadIdx.x, lane = tid & 63, wave = tid >> 6, l31 = lane & 31, hh = lane >> 5;
    constexpr float C = 0.125f * 1.4426950408889634f;
    bf16x8 qf[4];
    { const bf16* qp = a.Q + (a.qrow0 + wave * 32 + l31) * a.ldq + a.qcol + hh * 8;
#pragma unroll
      for (int s = 0; s < 4; ++s) qf[s] = *(const bf16x8*)(qp + 16 * s); }
    f32x16 o[2];
#pragma unroll
    for (int dt = 0; dt < 2; ++dt)
#pragma unroll
        for (int r = 0; r < 16; ++r) o[dt][r] = 0.f;
    float m = -1e30f, lsum = 0.f;
    const int ntile = a.nctx + a.nlat;
    const int lr0 = tid >> 3, kc = tid & 7;
    u32x4 rk[2], rv[2];
#define AT_ISSUE(n) do { const int t_ = (n) < a.nctx ? 64 + (n) : a.tlo + (n) - a.nctx; \
        const bf16* kb_ = a.K + (t_ < 64 ? a.klat0 + 64 * t_ : a.kctx0 + 64 * (t_ - 64)) * 128 + kc * 8; const bf16* vb_ = a.Vt + 64 * t_ + kc * 8; \
        _Pragma("unroll") for (int i = 0; i < 2; ++i) { rk[i] = *(const u32x4*)(kb_ + (size_t)(lr0 + 32 * i) * 128); rv[i] = *(const u32x4*)(vb_ + (size_t)(lr0 + 32 * i) * VT_LD); } } while (0)
#define AT_COMMIT(st) do { LAS unsigned char* sb_ = smem + (st) * AT_STAGE; \
        _Pragma("unroll") for (int i = 0; i < 2; ++i) { *(LAS u32x4*)(sb_ + (lr0 + 32 * i) * AT_KP + kc * 16) = rk[i]; \
            LAS unsigned char* vp_ = sb_ + 64 * AT_KP + (lr0 + 32 * i) * AT_VP + kc * 16; u32x2 lo_ = {rv[i].x, rv[i].y}, hi_ = {rv[i].z, rv[i].w}; *(LAS u32x2*)vp_ = lo_; *(LAS u32x2*)(vp_ + 8) = hi_; } } while (0)
    AT_ISSUE(0); AT_COMMIT(0);
    __syncthreads();
    const int tq = a.tq0 + wave * 32 + l31;
    for (int n = 0; n < ntile; ++n) {
        const int st = n & 1;
        if (n + 1 < ntile) AT_ISSUE(n + 1);
        LAS unsigned char* sb = smem + st * AT_STAGE;
        f32x16 sc[2];
#pragma unroll
        for (int kt = 0; kt < 2; ++kt) {
#pragma unroll
            for (int r = 0; r < 16; ++r) sc[kt][r] = 0.f;
#pragma unroll
            for (int s = 0; s < 4; ++s) {
                const bf16x8 kf = *(LAS bf16x8*)(sb + (32 * kt + l31) * AT_KP + s * 32 + hh * 16);
                sc[kt] = __builtin_amdgcn_mfma_f32_32x32x16_bf16(kf, qf[s], sc[kt], 0, 0, 0);
            }
        }
        if (a.banded && n >= a.nctx) {
            const int t_ = a.tlo + n - a.nctx; const int dbase = 64 * t_ + 4 * hh - tq;
#pragma unroll
            for (int kt = 0; kt < 2; ++kt)
#pragma unroll
                for (int r = 0; r < 16; ++r) { const int df = dbase + 32 * kt + (r & 3) + 8 * (r >> 2); if (df > 128 || df < -128) sc[kt][r] = -1e30f; }
        }
        float mx = sc[0][0];
#pragma unroll
        for (int kt = 0; kt < 2; ++kt)
#pragma unroll
            for (int r = 0; r < 16; ++r) mx = fmaxf(mx, sc[kt][r]);
        mx = xhalf_max(mx);
        const float mnew = fmaxf(m, mx * C);
        const float alpha = __builtin_amdgcn_exp2f(m - mnew);
        m = mnew;
        float ps = 0.f;
#pragma unroll
        for (int kt = 0; kt < 2; ++kt)
#pragma unroll
            for (int r = 0; r < 16; ++r) { sc[kt][r] = __builtin_amdgcn_exp2f(fmaf(sc[kt][r], C, -mnew)); ps += sc[kt][r]; }
        lsum = lsum * alpha + ps;
#pragma unroll
        for (int dt = 0; dt < 2; ++dt)
#pragma unroll
            for (int r = 0; r < 16; ++r) o[dt][r] *= alpha;
#pragma unroll
        for (int kt = 0; kt < 2; ++kt)
#pragma unroll
            for (int s2 = 0; s2 < 2; ++s2) {
                u32x4 pw = {pk2(sc[kt][8 * s2], sc[kt][8 * s2 + 1]), pk2(sc[kt][8 * s2 + 2], sc[kt][8 * s2 + 3]), pk2(sc[kt][8 * s2 + 4], sc[kt][8 * s2 + 5]), pk2(sc[kt][8 * s2 + 6], sc[kt][8 * s2 + 7])};
                const bf16x8 pf = __builtin_bit_cast(bf16x8, pw);
#pragma unroll
                for (int dt = 0; dt < 2; ++dt) {
                    LAS unsigned char* vp = sb + 64 * AT_KP + (32 * dt + l31) * AT_VP + (32 * kt + 16 * s2 + 4 * hh) * 2;
                    const u32x2 v0 = *(LAS u32x2*)vp, v1 = *(LAS u32x2*)(vp + 16);
                    u32x4 vw = {v0.x, v0.y, v1.x, v1.y};
                    o[dt] = __builtin_amdgcn_mfma_f32_32x32x16_bf16(__builtin_bit_cast(bf16x8, vw), pf, o[dt], 0, 0, 0);
                }
            }
        if (n + 1 < ntile) AT_COMMIT(st ^ 1);
        __syncthreads();
    }
#undef AT_ISSUE
#undef AT_COMMIT
    float l = xhalf_sum(lsum) + __builtin_amdgcn_exp2f(a.sink_l2 - m);
    const float inv = 1.f / l;
    bf16* op = a.out + (a.qrow0 + wave * 32 + l31) * 1024 + 4 * hh;
#pragma unroll
    for (int dt = 0; dt < 2; ++dt)
#pragma unroll
        for (int g = 0; g < 4; ++g) { u32x2 v = {pk2(o[dt][4 * g] * inv, o[dt][4 * g + 1] * inv), pk2(o[dt][4 * g + 2] * inv, o[dt][4 * g + 3] * inv)}; *(u32x2*)(op + dt * 32 + 8 * g) = v; }
}

__global__ void __launch_bounds__(256, 2) k_dense_attn(Ptrs P) {
    __shared__ __attribute__((aligned(16))) unsigned char smem_raw[ATTN_LDS];
    LAS unsigned char* smem = (LAS unsigned char*)smem_raw;
    unsigned char* r3 = P.ws + WS_R3;
    const int vid = xcd_vid(blockIdx.x, gridDim.x);
    for (int item = vid; item < 1024 + 64; item += gridDim.x) {
        AttnArgs a;
        int bh, qb; bool isctx = item >= 1024;
        if (!isctx) { bh = item >> 5; qb = item & 31; } else { bh = (item - 1024) >> 1; qb = (item - 1024) & 1; }
        const int hq = bh & 7, b = bh >> 3, kv = hq >> 2;
        a.Q = (const bf16*)(r3 + R3_AQ); a.ldq = 512; a.qcol = hq * 64;
        a.qrow0 = isctx ? (size_t)NL + b * CL + qb * 128 : (size_t)b * S + qb * 128;
        a.K = (const bf16*)(r3 + R3_AK) + kv * 64; a.klat0 = (size_t)b * S; a.kctx0 = (size_t)NL + b * CL;
        a.Vt = (const bf16*)(r3 + R3_AV) + (size_t)(b * 2 + kv) * 64 * VT_LD;
        a.nctx = 4; a.tlo = 0; a.nlat = isctx ? 0 : 64; a.banded = 0; a.tq0 = 0; a.sink_l2 = -INFINITY;
        a.out = (bf16*)(P.ws + WS_R2) + 512 + hq * 64;
        attn_block(a, smem);
    }
}
__global__ void __launch_bounds__(256, 2) k_swa_attn(Ptrs P) {
    __shared__ __attribute__((aligned(16))) unsigned char smem_raw[ATTN_LDS];
    LAS unsigned char* smem = (LAS unsigned char*)smem_raw;
    unsigned char* r3 = P.ws + WS_R3;
    const int vid = xcd_vid(blockIdx.x, gridDim.x);
    for (int item = vid; item < 2048; item += gridDim.x) {
        AttnArgs a;
        const int bh = item >> 5, qb = item & 31, hq = bh & 15, b = bh >> 4, kv = hq >> 3;
        a.Q = (const bf16*)(r3 + R3_OQ); a.ldq = 1024; a.qcol = hq * 64; a.qrow0 = (size_t)b * S + qb * 128;
        a.K = (const bf16*)(r3 + R3_OK) + kv * 64; a.klat0 = (size_t)b * S; a.kctx0 = (size_t)NL + b * CL;
        a.Vt = (const bf16*)(r3 + R3_OV) + (size_t)(b * 2 + kv) * 64 * VT_LD;
        const int tlo = qb * 2 - 2 < 0 ? 0 : qb * 2 - 2, thi = qb * 2 + 3 > 63 ? 63 : qb * 2 + 3;
        a.nctx = 4; a.tlo = tlo; a.nlat = thi - tlo + 1; a.banded = 1; a.tq0 = qb * 128; a.sink_l2 = P.in[17][hq] * 1.4426950408889634f;
        a.out = (bf16*)(P.ws + WS_R2) + hq * 64;
        attn_block(a, smem);
    }
}

constexpr size_t WS_LIST = 247 * MiB;
constexpr size_t WS_WTS = WS_LIST + (size_t)24 * NT * 4;
constexpr size_t WS_END_ALL = WS_WTS + (size_t)NT * 2 * 4;
static_assert(WS_R3 + R3_END <= WS_LIST && WS_END_ALL <= 256 * MiB, "ws map tail");
constexpr int CTL_CNT = 1024;
constexpr int MOE_MAXT = NT / 128 + 24;

__global__ void __launch_bounds__(256, 2) k_moe_route(Ptrs P, int layer, int nrows) {
    __shared__ f32x4 we_lds[4 * 4 * 4 * 64];
    unsigned char* ws = P.ws;
    const int tid = threadIdx.x, lane = tid & 63, wave = tid >> 6;
    const float* wg = P.in[20] + (size_t)layer * D * 4; const float* bg = P.in[21] + layer * 4;
    const float* we = P.in[22] + (size_t)layer * D * 16; const float* be = P.in[23] + layer * 16;
    for (int i = tid; i < 4096; i += 256) { const int ln = i & 63, c = (i >> 6) & 3, jj = (i >> 8) & 3, j4 = i >> 10; const int k = 4 * ln + 256 * jj + c; we_lds[i] = *(const f32x4*)(we + k * 16 + 4 * j4); }
    __syncthreads();
    const float* modv_layer = (const float*)(ws + WS_MODV) + (size_t)layer * 5 * 6144;
    const float* gain = P.in[7] + layer * D;
    const float* xlat = P.out; const float* xctx = (const float*)(ws + WS_CTXS);
    bf16* H = (bf16*)(ws + WS_R1);
    int* cnt = (int*)(ws + WS_CTL) + CTL_CNT + layer * 32; int* list = (int*)(ws + WS_LIST); float* wts = (float*)(ws + WS_WTS);
    const int gw = blockIdx.x * 4 + wave, NGW = gridDim.x * 4;
    int pend_pos = 0, pend_cls = -1, pend_row = 0;
    for (int row = gw; row < nrows; row += NGW) {
        const float* xr = row < NL ? xlat + (size_t)row * D : xctx + (size_t)(row - NL) * D;
        const float* mv = modv_layer + (size_t)(row < NL ? row / S : 4) * 6144;
        float ss = 0.f;
#pragma unroll
        for (int j = 0; j < 4; ++j) { const f32x4 t = *(const f32x4*)(xr + 4 * lane + 256 * j); ss += t.x * t.x + t.y * t.y + t.z * t.z + t.w * t.w; }
        const float rstd = rsqrtf(wave_sum(ss) / D + EPS);
        float part[20];
#pragma unroll
        for (int j = 0; j < 20; ++j) part[j] = 0.f;
#pragma unroll 1
        for (int jj = 0; jj < 4; ++jj) {
            const int k = 4 * lane + 256 * jj;
            const f32x4 xv = *(const f32x4*)(xr + k);
            const f32x4 g = *(const f32x4*)(gain + k), sc = *(const f32x4*)(mv + 4 * 1024 + k), sh = *(const f32x4*)(mv + 3 * 1024 + k);
            const float h0 = xv.x * rstd * g.x * (1.f + sc.x) + sh.x, h1 = xv.y * rstd * g.y * (1.f + sc.y) + sh.y, h2 = xv.z * rstd * g.z * (1.f + sc.z) + sh.z, h3 = xv.w * rstd * g.w * (1.f + sc.w) + sh.w;
            u32x2 o = {pk2(h0, h1), pk2(h2, h3)};
            *(u32x2*)(H + (size_t)row * D + k) = o;
#pragma unroll
            for (int c = 0; c < 4; ++c) {
                const float hc = c == 0 ? h0 : c == 1 ? h1 : c == 2 ? h2 : h3;
                const f32x4 w4 = *(const f32x4*)(wg + (k + c) * 4);
                part[0] += hc * w4.x; part[1] += hc * w4.y; part[2] += hc * w4.z; part[3] += hc * w4.w;
#pragma unroll
                for (int j4 = 0; j4 < 4; ++j4) { const f32x4 e4 = we_lds[((j4 * 4 + jj) * 4 + c) * 64 + lane]; part[4 + 4 * j4] += hc * e4.x; part[5 + 4 * j4] += hc * e4.y; part[6 + 4 * j4] += hc * e4.z; part[7 + 4 * j4] += hc * e4.w; }
            }
        }
#pragma unroll
        for (int j = 0; j < 20; ++j) part[j] = wave_sum(part[j]);
        float gl[4];
#pragma unroll
        for (int j = 0; j < 4; ++j) gl[j] = part[j] + bg[j];
        int gi = 0; float gm = gl[0];
#pragma unroll
        for (int j = 1; j < 4; ++j) if (gl[j] > gm) { gm = gl[j]; gi = j; }
        float gs = 0.f;
#pragma unroll
        for (int j = 0; j < 4; ++j) gs += expf(gl[j] - gm);
        const float gwt = 1.f / gs;
        float el[4];
#pragma unroll
        for (int j = 0; j < 4; ++j) el[j] = (gi == 0 ? part[4 + j] : gi == 1 ? part[8 + j] : gi == 2 ? part[12 + j] : part[16 + j]) + be[gi * 4 + j];
        int i0 = 0; float e0 = el[0];
#pragma unroll
        for (int j = 1; j < 4; ++j) if (el[j] > e0) { e0 = el[j]; i0 = j; }
        int i1 = -1; float e1 = -INFINITY;
#pragma unroll
        for (int j = 0; j < 4; ++j) if (j != i0 && el[j] > e1) { e1 = el[j]; i1 = j; }
        const float p1 = expf(e1 - e0); const float w0 = gwt / (1.f + p1), w1 = gwt * p1 / (1.f + p1);
        const int ea = i0 < i1 ? i0 : i1, eb = i0 < i1 ? i1 : i0;
        const float wA = i0 < i1 ? w0 : w1, wB = i0 < i1 ? w1 : w0;
        const int pidx = ea == 0 ? eb - 1 : (ea == 1 ? eb + 1 : 5);
        const int cls = gi * 6 + pidx;
        if (lane == 0) {
            if (pend_cls >= 0) list[(size_t)pend_cls * NT + pend_pos] = pend_row;
            wts[(size_t)row * 2] = wA; wts[(size_t)row * 2 + 1] = wB;
            pend_pos = atomicAdd(&cnt[cls], 1); pend_cls = cls; pend_row = row;
        }
    }
    if (lane == 0 && pend_cls >= 0) list[(size_t)pend_cls * NT + pend_pos] = pend_row;
}

__device__ __forceinline__ void moe_tiles_init(const int* cnt, LAS int* tile0) {
    if (threadIdx.x == 0) { int a = 0; for (int c = 0; c < 24; ++c) { tile0[c] = a; a += (cnt[c] + 127) >> 7; } tile0[24] = a; }
    __syncthreads();
}
struct GatherRows {
    const bf16* p[4];
    __device__ __forceinline__ const bf16* ptr(int i, int kt) const { return p[i] + kt * 64; }
};
struct SplitKRows {
    const bf16* p0; const bf16* p1; size_t stride32; int ksplit;
    __device__ __forceinline__ SplitKRows(const bf16* b0, const bf16* b1, size_t ld, int ksplit_, int lrow, int kc) : p0(b0 + (size_t)lrow * ld + kc * 8), p1(b1 + (size_t)lrow * ld + kc * 8), stride32(32 * ld), ksplit(ksplit_) {}
    __device__ __forceinline__ const bf16* ptr(int i, int kt) const { return (kt < ksplit ? p0 + kt * 64 : p1 + (kt - ksplit) * 64) + i * stride32; }
};
struct EpiMoe1 {
    bf16* hid; const int* lst; int n; const float* wts; int nt;
    __device__ __forceinline__ bool swapped() const { return false; }
    __device__ __forceinline__ void operator()(f32x16 (&acc)[2][2], int fb, int tb, int l31, int hh) const {
        const int col = (nt >> 2) * 256 + 32 * (2 * (nt & 3) + (fb >> 6)) + 4 * hh;
#pragma unroll
        for (int j = 0; j < 2; ++j) {
            const int r = tb + j * 32 + l31;
            const int tok = lst[r < n ? r : 0];
            const float w = wts[(size_t)tok * 2 + (nt >> 2)];
            bf16* rp = hid + (size_t)r * 512 + col;
#pragma unroll
            for (int g = 0; g < 4; ++g) {
                float hv[4];
#pragma unroll
                for (int e = 0; e < 4; ++e) { const float a_ = acc[0][j][4 * g + e], u_ = acc[1][j][4 * g + e]; hv[e] = a_ / (1.f + __expf(-a_)) * u_ * w; }
                u32x2 v = {pk2(hv[0], hv[1]), pk2(hv[2], hv[3])}; *(u32x2*)(rp + 8 * g) = v;
            }
        }
    }
};
__global__ void __launch_bounds__(256, 2) k_moe_stage1(Ptrs P, int layer) {
    __shared__ __attribute__((aligned(16))) unsigned char smem_raw[GEMM_LDS];
    LAS unsigned char* smem = (LAS unsigned char*)smem_raw;
    unsigned char* ws = P.ws;
    const int* cnt = (const int*)(ws + WS_CTL) + CTL_CNT + layer * 32; const int* list = (const int*)(ws + WS_LIST);
    __shared__ int tile0_raw[25];
    LAS int* tile0 = (LAS int*)tile0_raw;
    moe_tiles_init(cnt, tile0);
    const int lrow = threadIdx.x >> 3, kc = threadIdx.x & 7;
    const bf16* H = (const bf16*)(ws + WS_R1);
    const int nitems = tile0[24] * 8;
    for (int item = blockIdx.x; item < nitems; item += gridDim.x) {
        const int tt = item >> 3, nt = item & 7;
        int c = 0; while (tile0[c + 1] <= tt) ++c;
        const int lt = tt - tile0[c], n = min(128, cnt[c] - lt * 128);
        const int* lst = list + (size_t)c * NT + lt * 128;
        const int g = c / 6, pidx = c % 6; const int ea = pidx < 3 ? 0 : (pidx < 5 ? 1 : 2), eb = pidx < 3 ? pidx + 1 : (pidx < 5 ? pidx - 1 : 3);
        const int expert = g * 4 + (nt < 4 ? ea : eb);
        GatherRows af;
#pragma unroll
        for (int i = 0; i < 4; ++i) { const int r = lrow + 32 * i; af.p[i] = H + (size_t)lst[r < n ? r : 0] * D + kc * 8; }
        AffineRows bf_((const bf16*)(ws + WS_WGU) + ((size_t)(layer * 16 + expert) * 512 + (nt & 3) * 128) * D, D, lrow, kc);
        EpiMoe1 epi{(bf16*)(ws + WS_R3) + (size_t)tt * 128 * 512, lst, n, (const float*)(ws + WS_WTS), nt};
        gemm_tile(af, bf_, D / 64, smem, epi);
    }
}
struct EpiMoe2 {
    float* xlat; float* xctx; const float* modv_layer; const int* lst; int n; int nt;
    __device__ __forceinline__ bool swapped() const { return false; }
    __device__ __forceinline__ void operator()(f32x16 (&acc)[2][2], int fb, int tb, int l31, int hh) const {
        const int c0 = nt * 128 + fb + 4 * hh;
#pragma unroll
        for (int j = 0; j < 2; ++j) {
            const int r = tb + j * 32 + l31;
            if (r < n) {
                const int tok = lst[r];
                float* xr = (tok < NL ? xlat + (size_t)tok * D : xctx + (size_t)(tok - NL) * D) + c0;
                const float* gt = modv_layer + (size_t)(tok < NL ? tok / S : 4) * 6144 + 5 * 1024 + c0;
#pragma unroll
                for (int i = 0; i < 2; ++i)
#pragma unroll
                    for (int g = 0; g < 4; ++g) {
                        const f32x4 gg = *(const f32x4*)(gt + i * 32 + 8 * g); f32x4 xv = *(f32x4*)(xr + i * 32 + 8 * g);
                        xv.x += gg.x * acc[i][j][4 * g]; xv.y += gg.y * acc[i][j][4 * g + 1]; xv.z += gg.z * acc[i][j][4 * g + 2]; xv.w += gg.w * acc[i][j][4 * g + 3];
                        *(f32x4*)(xr + i * 32 + 8 * g) = xv;
                    }
            }
        }
    }
};
__global__ void __launch_bounds__(256, 2) k_moe_stage2(Ptrs P, int layer) {
    __shared__ __attribute__((aligned(16))) unsigned char smem_raw[GEMM_LDS];
    LAS unsigned char* smem = (LAS unsigned char*)smem_raw;
    unsigned char* ws = P.ws;
    const int* cnt = (const int*)(ws + WS_CTL) + CTL_CNT + layer * 32; const int* list = (const int*)(ws + WS_LIST);
    __shared__ int tile0_raw[25];
    LAS int* tile0 = (LAS int*)tile0_raw;
    moe_tiles_init(cnt, tile0);
    const int lrow = threadIdx.x >> 3, kc = threadIdx.x & 7;
    const int nitems = tile0[24] * 8;
    for (int item = blockIdx.x; item < nitems; item += gridDim.x) {
        const int tt = item >> 3, nt = item & 7;
        int c = 0; while (tile0[c + 1] <= tt) ++c;
        const int lt = tt - tile0[c], n = min(128, cnt[c] - lt * 128);
        const int* lst = list + (size_t)c * NT + lt * 128;
        const int g = c / 6, pidx = c % 6; const int ea = pidx < 3 ? 0 : (pidx < 5 ? 1 : 2), eb = pidx < 3 ? pidx + 1 : (pidx < 5 ? pidx - 1 : 3);
        AffineRows af((const bf16*)(ws + WS_R3) + (size_t)tt * 128 * 512, 512, lrow, kc);
        const bf16* wd = (const bf16*)(ws + WS_WD);
        SplitKRows bf_(wd + ((size_t)(layer * 16 + g * 4 + ea) * 1024 + nt * 128) * 256, wd + ((size_t)(layer * 16 + g * 4 + eb) * 1024 + nt * 128) * 256, 256, 4, lrow, kc);
        EpiMoe2 epi{P.out, (float*)(ws + WS_CTXS), (const float*)(ws + WS_MODV) + (size_t)layer * 5 * 6144, lst, n, nt};
        gemm_tile(af, bf_, 8, smem, epi);
    }
}

constexpr size_t GLA_ST = 8192;
constexpr size_t WS_DEC = WS_WTS + (size_t)NT * 2 * 4;
static_assert(WS_DEC + (size_t)32 * 68 * 64 * 4 <= 256 * MiB, "ws dec");
__device__ __forceinline__ void gla_chunk_geom(int b, int M, size_t& row0, int& vcol0, int& c0, int& c1) {
    if (M < 4) { row0 = (size_t)NL + b * CL + 64 * M; vcol0 = S + 64 * M; c0 = M; c1 = 3 - M; }
    else { const int Ml = M - 4; row0 = (size_t)b * S + 64 * Ml; vcol0 = 64 * Ml; c0 = 4 + Ml; c1 = 4 + 63 - Ml; }
}
template <bool PASS_C>
__device__ __forceinline__ float gla_prep(const Ptrs& P, int h, int dir, size_t row0, LAS unsigned char* lds, int off_lrs, int off_tot) {
    const int tid = threadIdx.x, k = tid & 63, grp = tid >> 6;
    const unsigned char* r3 = P.ws + WS_R3;
    LAS float* lrs = (LAS float*)(lds + off_lrs); LAS float* tot = (LAS float*)(lds + off_tot);
    { const float* LR = (const float*)(r3 + R3_LR); *(LAS f32x4*)(lrs + tid * 4) = *(const f32x4*)(LR + (row0 + (tid >> 2)) * 32 + dir * 16 + (tid & 3) * 4); }
    float gw[16];
#pragma unroll
    for (int r = 0; r < 16; ++r) gw[r] = P.in[10][(dir * 16 + r) * 256 + h * 64 + k];
    const float gb = P.in[11][dir * 256 + h * 64 + k];
    __syncthreads();
    float gl[16];
#pragma unroll
    for (int j = 0; j < 16; ++j) {
        const int p = 16 * grp + j; float z = gb;
#pragma unroll
        for (int r4 = 0; r4 < 4; ++r4) { const f32x4 l4 = *(LAS f32x4*)(lrs + p * 16 + r4 * 4); z += l4.x * gw[4 * r4] + l4.y * gw[4 * r4 + 1] + l4.z * gw[4 * r4 + 2] + l4.w * gw[4 * r4 + 3]; }
        gl[j] = (fminf(z, 0.f) - __logf(1.f + __expf(-fabsf(z)))) * (1.f / 16.f);
    }
    if (dir == 0) {
#pragma unroll
        for (int j = 1; j < 16; ++j) gl[j] += gl[j - 1];
        tot[grp * 64 + k] = gl[15];
    } else {
#pragma unroll
        for (int j = 14; j >= 0; --j) gl[j] += gl[j + 1];
        tot[grp * 64 + k] = gl[0];
    }
    __syncthreads();
    const float t0 = tot[k], t1 = tot[64 + k], t2 = tot[128 + k], t3 = tot[192 + k];
    const float bend = t0 + t1 + t2 + t3;
    float offs;
    if (dir == 0) offs = grp == 0 ? 0.f : grp == 1 ? t0 : grp == 2 ? t0 + t1 : t0 + t1 + t2;
    else offs = grp == 3 ? 0.f : grp == 2 ? t3 : grp == 1 ? t3 + t2 : t3 + t2 + t1;
    const bf16* GQ = (const bf16*)(r3 + R3_GQ); const bf16* GK = (const bf16*)(r3 + R3_GK);
    if (PASS_C) {
#pragma unroll
        for (int j = 0; j < 16; ++j) {
            const int p = 16 * grp + j; const float bp = gl[j] + offs;
            const float q = bf2f(GQ[(row0 + p) * 256 + h * 64 + k]) * 0.125f, kk = bf2f(GK[(row0 + p) * 256 + h * 64 + k]);
            *(LAS bf16*)(lds + p * 144 + k * 2) = f2bf(q * __expf(bp));
            *(LAS bf16*)(lds + 9216 + p * 144 + k * 2) = f2bf(q * __expf(bp - bend));
            *(LAS bf16*)(lds + 18432 + p * 144 + k * 2) = f2bf(kk * __expf(bend - bp));
        }
    } else {
        float kt[16];
#pragma unroll
        for (int j = 0; j < 16; ++j) { const int p = 16 * grp + j; const float bp = gl[j] + offs; kt[j] = bf2f(GK[(row0 + p) * 256 + h * 64 + k]) * __expf(bend - bp); }
        u32x4 w0 = {pk2(kt[0], kt[1]), pk2(kt[2], kt[3]), pk2(kt[4], kt[5]), pk2(kt[6], kt[7])}, w1 = {pk2(kt[8], kt[9]), pk2(kt[10], kt[11]), pk2(kt[12], kt[13]), pk2(kt[14], kt[15])};
        *(LAS u32x4*)(lds + k * 144 + grp * 32) = w0; *(LAS u32x4*)(lds + k * 144 + grp * 32 + 16) = w1;
    }
    return __expf(bend);
}

constexpr int GA_KTT = 0, GA_VT = 9216, GA_LRS = GA_VT + 128 * 144, GA_TOT = GA_LRS + 4096, GLA_A_LDS = GA_TOT + 1024;
__device__ __forceinline__ void gla_pass_a_item(const Ptrs& P, int item, LAS unsigned char* lds) {
    const int tid = threadIdx.x, lane = tid & 63, wave = tid >> 6, l31 = lane & 31, hh = lane >> 5;
    const int M = item % 68, dir = (item / 68) & 1, h = (item / 136) & 3, b = item / 544;
    size_t row0; int vcol0, c0, c1; gla_chunk_geom(b, M, row0, vcol0, c0, c1);
    const int sidx = ((b * 4 + h) * 2 + dir) * 68 + (dir ? c1 : c0);
    { const bf16* gvt = (const bf16*)(P.ws + WS_R3 + R3_GV) + (size_t)(b * 4 + h) * 128 * VT_LD + vcol0;
#pragma unroll
      for (int i = 0; i < 4; ++i) { const int c = tid + 256 * i, v = c >> 3, kc = c & 7; *(LAS u32x4*)(lds + GA_VT + v * 144 + kc * 16) = *(const u32x4*)(gvt + (size_t)v * VT_LD + kc * 8); } }
    const float dec = gla_prep<false>(P, h, dir, row0, lds, GA_LRS, GA_TOT);
    if (tid < 64) ((float*)(P.ws + WS_DEC))[(size_t)sidx * 64 + tid] = dec;
    __syncthreads();
    f32x16 acc[2];
#pragma unroll
    for (int kt = 0; kt < 2; ++kt)
#pragma unroll
        for (int r = 0; r < 16; ++r) acc[kt][r] = 0.f;
#pragma unroll
    for (int ps = 0; ps < 4; ++ps) {
        const bf16x8 vf = *(LAS bf16x8*)(lds + GA_VT + (32 * wave + l31) * 144 + ps * 32 + hh * 16);
#pragma unroll
        for (int kt = 0; kt < 2; ++kt) { const bf16x8 kf = *(LAS bf16x8*)(lds + GA_KTT + (32 * kt + l31) * 144 + ps * 32 + hh * 16); acc[kt] = __builtin_amdgcn_mfma_f32_32x32x16_bf16(kf, vf, acc[kt], 0, 0, 0); }
    }
    bf16* ds = (bf16*)(P.ws + WS_R1) + (size_t)sidx * GLA_ST + (size_t)(32 * wave + l31) * 64 + 4 * hh;
#pragma unroll
    for (int kt = 0; kt < 2; ++kt)
#pragma unroll
        for (int g = 0; g < 4; ++g) { u32x2 v = {pk2(acc[kt][4 * g], acc[kt][4 * g + 1]), pk2(acc[kt][4 * g + 2], acc[kt][4 * g + 3])}; *(u32x2*)(ds + kt * 32 + 8 * g) = v; }
    __syncthreads();
}
__global__ void __launch_bounds__(256, 2) k_gla_a(Ptrs P) {
    __shared__ __attribute__((aligned(16))) unsigned char smem_raw[GLA_A_LDS];
    for (int item = blockIdx.x; item < 4 * 4 * 2 * 68; item += gridDim.x) gla_pass_a_item(P, item, (LAS unsigned char*)smem_raw);
}
__device__ __forceinline__ void gla_pass_b(const Ptrs& P, int gtid, int nthreads) {
    const bf16* DS = (const bf16*)(P.ws + WS_R1); bf16* SIN = (bf16*)(P.ws + WS_R4); const float* DEC = (const float*)(P.ws + WS_DEC);
    for (int idx = gtid; idx < 32 * 2048; idx += nthreads) {
        const int bhd = idx >> 11, e4 = idx & 2047, k4 = (e4 & 15) * 4;
        float s0 = 0.f, s1 = 0.f, s2 = 0.f, s3 = 0.f;
#pragma unroll 4
        for (int c = 0; c < 68; ++c) {
            const size_t sidx = (size_t)bhd * 68 + c;
            u32x2 o = {pk2(s0, s1), pk2(s2, s3)};
            *(u32x2*)(SIN + sidx * GLA_ST + e4 * 4) = o;
            const f32x4 d = *(const f32x4*)(DEC + sidx * 64 + k4);
            const u32x2 w = *(const u32x2*)(DS + sidx * GLA_ST + e4 * 4);
            s0 = s0 * d.x + __uint_as_float(w.x << 16); s1 = s1 * d.y + __uint_as_float(w.x & 0xffff0000u);
            s2 = s2 * d.z + __uint_as_float(w.y << 16); s3 = s3 * d.w + __uint_as_float(w.y & 0xffff0000u);
        }
    }
}
__global__ void __launch_bounds__(256, 2) k_gla_b(Ptrs P) { gla_pass_b(P, blockIdx.x * 256 + threadIdx.x, gridDim.x * 256); }
constexpr int GC_QT = 0, GC_QA = 9216, GC_KT = 18432, GC_VT = 27648, GC_LRS = GC_VT + 128 * 136, GC_TOT = GC_LRS + 4096, GC_XCH = GC_TOT + 1024, GLA_C_LDS = GC_XCH + 512;
__device__ __forceinline__ void gla_pass_c_item(const Ptrs& P, int item, LAS unsigned char* lds) {
    const int tid = threadIdx.x, lane = tid & 63, wave = tid >> 6, l31 = lane & 31, hh = lane >> 5, pt = wave & 1, vh = wave >> 1;
    const int M = item % 68, h = (item / 68) & 3, b = item / 272;
    size_t row0; int vcol0, c0, c1; gla_chunk_geom(b, M, row0, vcol0, c0, c1);
    { const bf16* gvt = (const bf16*)(P.ws + WS_R3 + R3_GV) + (size_t)(b * 4 + h) * 128 * VT_LD + vcol0;
#pragma unroll
      for (int i = 0; i < 4; ++i) { const int c = tid + 256 * i, v = c >> 3, kc = c & 7; const u32x4 w = *(const u32x4*)(gvt + (size_t)v * VT_LD + kc * 8);
          LAS unsigned char* vp = lds + GC_VT + v * 136 + kc * 16; u32x2 lo = {w.x, w.y}, hi = {w.z, w.w}; *(LAS u32x2*)vp = lo; *(LAS u32x2*)(vp + 8) = hi; } }
    f32x16 o[2];
#pragma unroll
    for (int i = 0; i < 2; ++i)
#pragma unroll
        for (int r = 0; r < 16; ++r) o[i][r] = 0.f;
    const bf16* SIN = (const bf16*)(P.ws + WS_R4);
#pragma unroll 1
    for (int dir = 0; dir < 2; ++dir) {
        const int sidx = ((b * 4 + h) * 2 + dir) * 68 + (dir ? c1 : c0);
        bf16x8 sf[2][4];
#pragma unroll
        for (int i = 0; i < 2; ++i)
#pragma unroll
            for (int ks = 0; ks < 4; ++ks) sf[i][ks] = *(const bf16x8*)(SIN + (size_t)sidx * GLA_ST + (size_t)(64 * vh + 32 * i + l31) * 64 + 16 * ks + 8 * hh);
        (void)gla_prep<true>(P, h, dir, row0, lds, GC_LRS, GC_TOT);
        __syncthreads();
        f32x16 at[2];
#pragma unroll
        for (int st = 0; st < 2; ++st) {
#pragma unroll
            for (int r = 0; r < 16; ++r) at[st][r] = 0.f;
#pragma unroll
            for (int ks = 0; ks < 4; ++ks) {
                const bf16x8 ka = *(LAS bf16x8*)(lds + GC_KT + (32 * st + l31) * 144 + ks * 32 + hh * 16);
                const bf16x8 qa = *(LAS bf16x8*)(lds + GC_QA + (32 * pt + l31) * 144 + ks * 32 + hh * 16);
                at[st] = __builtin_amdgcn_mfma_f32_32x32x16_bf16(ka, qa, at[st], 0, 0, 0);
            }
            const int pq = 32 * pt + l31;
#pragma unroll
            for (int r = 0; r < 16; ++r) { const int s_ = 32 * st + (r & 3) + 8 * (r >> 2) + 4 * hh; const bool ok = dir ? (s_ >= pq) : (s_ <= pq); if (!ok) at[st][r] = 0.f; }
        }
#pragma unroll
        for (int ks = 0; ks < 4; ++ks) {
            const bf16x8 qt = *(LAS bf16x8*)(lds + GC_QT + (32 * pt + l31) * 144 + ks * 32 + hh * 16);
#pragma unroll
            for (int i = 0; i < 2; ++i) o[i] = __builtin_amdgcn_mfma_f32_32x32x16_bf16(sf[i][ks], qt, o[i], 0, 0, 0);
        }
#pragma unroll
        for (int st = 0; st < 2; ++st)
#pragma unroll
            for (int s2 = 0; s2 < 2; ++s2) {
                u32x4 pw = {pk2(at[st][8 * s2], at[st][8 * s2 + 1]), pk2(at[st][8 * s2 + 2], at[st][8 * s2 + 3]), pk2(at[st][8 * s2 + 4], at[st][8 * s2 + 5]), pk2(at[st][8 * s2 + 6], at[st][8 * s2 + 7])};
                const bf16x8 pf = __builtin_bit_cast(bf16x8, pw);
#pragma unroll
                for (int i = 0; i < 2; ++i) {
                    LAS unsigned char* vp = lds + GC_VT + (64 * vh + 32 * i + l31) * 136 + (32 * st + 16 * s2 + 4 * hh) * 2;
                    const u32x2 v0 = *(LAS u32x2*)vp, v1 = *(LAS u32x2*)(vp + 16);
                    u32x4 vw = {v0.x, v0.y, v1.x, v1.y};
                    o[i] = __builtin_amdgcn_mfma_f32_32x32x16_bf16(__builtin_bit_cast(bf16x8, vw), pf, o[i], 0, 0, 0);
                }
            }
        __syncthreads();
    }
    float ss = 0.f;
#pragma unroll
    for (int i = 0; i < 2; ++i)
#pragma unroll
        for (int r = 0; r < 16; ++r) ss += o[i][r] * o[i][r];
    ss = xhalf_sum(ss);
    LAS float* xch = (LAS float*)(lds + GC_XCH);
    if (hh == 0) xch[(pt * 2 + vh) * 32 + l31] = ss;
    __syncthreads();
    ss += xch[(pt * 2 + (1 - vh)) * 32 + l31];
    const float rstd = rsqrtf(ss * (1.f / 128.f) + EPS);
    const size_t trow = row0 + 32 * pt + l31;
    const bf16* gr = (const bf16*)(P.ws + WS_R3 + R3_GR) + trow * 512 + h * 128 + 64 * vh + 4 * hh;
    bf16* mx = (bf16*)(P.ws + WS_R2) + trow * 1024 + h * 128 + 64 * vh + 4 * hh;
    const float* gn = P.in[12] + 64 * vh + 4 * hh;
#pragma unroll
    for (int i = 0; i < 2; ++i)
#pragma unroll
        for (int g = 0; g < 4; ++g) {
            const u32x2 rw = *(const u32x2*)(gr + i * 32 + 8 * g); const f32x4 gg = *(const f32x4*)(gn + i * 32 + 8 * g);
            const float r0 = __uint_as_float(rw.x << 16), r1 = __uint_as_float(rw.x & 0xffff0000u), r2 = __uint_as_float(rw.y << 16), r3_ = __uint_as_float(rw.y & 0xffff0000u);
            const float y0 = o[i][4 * g] * rstd * gg.x * (r0 / (1.f + __expf(-r0))), y1 = o[i][4 * g + 1] * rstd * gg.y * (r1 / (1.f + __expf(-r1)));
            const float y2 = o[i][4 * g + 2] * rstd * gg.z * (r2 / (1.f + __expf(-r2))), y3 = o[i][4 * g + 3] * rstd * gg.w * (r3_ / (1.f + __expf(-r3_)));
            u32x2 v = {pk2(y0, y1), pk2(y2, y3)}; *(u32x2*)(mx + i * 32 + 8 * g) = v;
        }
    __syncthreads();
}
__global__ void __launch_bounds__(256, 2) k_gla_c(Ptrs P) {
    __shared__ __attribute__((aligned(16))) unsigned char smem_raw[GLA_C_LDS];
    for (int item = blockIdx.x; item < 4 * 4 * 68; item += gridDim.x) gla_pass_c_item(P, item, (LAS unsigned char*)smem_raw);
}

extern "C" void kernel_launch(void* const* d_in, const int* in_sizes, int n_in, void* d_out, int out_size, void* d_ws, size_t ws_size, hipStream_t stream) {
    const float* x = (const float*)d_in[0]; const float* c = (const float*)d_in[1]; const float* ctx = (const float*)d_in[2]; const float* c_ctx = (const float*)d_in[3];
    const float* mod_w = (const float*)d_in[4]; const float* mod_b = (const float*)d_in[5]; const float* norm_mix = (const float*)d_in[6]; const float* norm_ffn = (const float*)d_in[7];
    const float* gate_w = (const float*)d_in[10]; const float* gate_b = (const float*)d_in[11];
    const float* gla_norm = (const float*)d_in[12];
    const float* od_w_in = (const float*)d_in[15]; const float* sink = (const float*)d_in[17];
    const float* swa_qn = (const float*)d_in[18]; const float* swa_kn = (const float*)d_in[19];
    const float* rgw = (const float*)d_in[20]; const float* rgb = (const float*)d_in[21]; const float* rew = (const float*)d_in[22]; const float* reb = (const float*)d_in[23];
    const float* ewg = (const float*)d_in[24]; const float* ewu = (const float*)d_in[25]; const float* ewd = (const float*)d_in[26];
    float* out = (float*)d_out;
    unsigned char* ws = (unsigned char*)d_ws;
    Ptrs P{}; for (int i = 0; i < 27; ++i) P.in[i] = (const float*)d_in[i]; P.out = out; P.ws = ws;
    float* modv = (float*)(ws + WS_MODV); float* CTXS = (float*)(ws + WS_CTXS);
    bf16* H = (bf16*)(ws + WS_R1); bf16* MIX = (bf16*)(ws + WS_R2); float* GO = (float*)(ws + WS_R1);
    unsigned char* r3 = ws + WS_R3;
    bf16* GQ = (bf16*)(r3 + R3_GQ); bf16* GK = (bf16*)(r3 + R3_GK); bf16* GV = (bf16*)(r3 + R3_GV); bf16* GR = (bf16*)(r3 + R3_GR); float* LR = (float*)(r3 + R3_LR);
    bf16* AQ = (bf16*)(r3 + R3_AQ); bf16* AK = (bf16*)(r3 + R3_AK); bf16* AV = (bf16*)(r3 + R3_AV);
    bf16* OQ = (bf16*)(r3 + R3_OQ); bf16* OK = (bf16*)(r3 + R3_OK); bf16* OV = (bf16*)(r3 + R3_OV);
    const int G = 512;

    hipMemsetAsync(ws + WS_CTL, 0, 65536, stream);
    n_mod<<<dim3(24, 5, 2), 256, 0, stream>>>(c, c_ctx, mod_w, mod_b, modv);
    k_prologue<<<G, 256, 0, stream>>>(P);
    const float* mv0 = modv; const float* mv1 = modv + 5 * 6144;
    k_modulate<<<G, 256, 0, stream>>>(x, ctx, mv0, norm_mix, 0, H, NT);
    k_even_inproj<<<G, 256, 0, stream>>>(P);
    k_gla_a<<<G, 256, 0, stream>>>(P);
    k_gla_b<<<G, 256, 0, stream>>>(P);
    k_gla_c<<<G, 256, 0, stream>>>(P);
    k_dense_attn<<<G, 256, 0, stream>>>(P);
    k_outproj<<<G, 256, 0, stream>>>(P, 0, NT);
    k_moe_route<<<G, 256, 0, stream>>>(P, 0, NT);
    k_moe_stage1<<<G, 256, 0, stream>>>(P, 0);
    k_moe_stage2<<<G, 256, 0, stream>>>(P, 0);
    k_modulate<<<G, 256, 0, stream>>>(out, CTXS, mv1, norm_mix + D, 0, H, NT);
    k_odd_inproj<<<G, 256, 0, stream>>>(P);
    k_swa_attn<<<G, 256, 0, stream>>>(P);
    k_outproj<<<G, 256, 0, stream>>>(P, 1, NL);
    k_moe_route<<<G, 256, 0, stream>>>(P, 1, NL);
    k_moe_stage1<<<G, 256, 0, stream>>>(P, 1);
    k_moe_stage2<<<G, 256, 0, stream>>>(P, 1);
}
```

```cpp
#include <hip/hip_runtime.h>
#include <stdint.h>

typedef unsigned short bf16;
__device__ __forceinline__ float bf2f(bf16 v) { return __uint_as_float(((unsigned)v) << 16); }
__device__ __forceinline__ bf16 f2bf(float f) { unsigned u = __float_as_uint(f); return (bf16)((u + 0x7fffu + ((u >> 16) & 1u)) >> 16); }

constexpr int D = 1024, NB = 4, S = 4096, CL = 256, NL = NB * S, NC = NB * CL, NT = NL + NC;
constexpr int EVEN_IN = 2336, ODD_IN = 1280;
constexpr float EPS = 1e-6f;

__device__ __forceinline__ float silu(float x) { return x / (1.f + expf(-x)); }
__device__ __forceinline__ float wave_sum(float v) {
#pragma unroll
    for (int o = 1; o < 64; o <<= 1) v += __shfl_xor(v, o);
    return v;
}

#define LAS __attribute__((address_space(3)))
typedef short bf16x8 __attribute__((ext_vector_type(8)));
typedef float f32x16 __attribute__((ext_vector_type(16)));
typedef float f32x4 __attribute__((ext_vector_type(4)));
typedef unsigned u32x4 __attribute__((ext_vector_type(4)));
typedef unsigned u32x2 __attribute__((ext_vector_type(2)));
typedef __bf16 bf16x2_t __attribute__((ext_vector_type(2)));
typedef float f32x2_t __attribute__((ext_vector_type(2)));
__device__ __forceinline__ unsigned pk2(float lo, float hi) { f32x2_t v = {lo, hi}; bf16x2_t b = __builtin_convertvector(v, bf16x2_t); return __builtin_bit_cast(unsigned, b); }
__device__ __forceinline__ float xhalf_sum(float x) {
    auto t = __builtin_amdgcn_permlane32_swap(__float_as_uint(x), __float_as_uint(x), false, false);
    return __uint_as_float(t[0]) + __uint_as_float(t[1]);
}

constexpr int NPAD_E = 2432;
constexpr int LDSP = 144;
constexpr int TILE_LDS = 128 * LDSP;
constexpr int GEMM_LDS = 4 * TILE_LDS;

__device__ __forceinline__ void transpose_item(const float* W, int K, int N, bf16* WT, int dst_row0, int k0, int n0, LAS float* scr, int lane) {
#pragma unroll 8
    for (int i = 0; i < 32; ++i) { const int kk = 2 * i + (lane >> 5); scr[kk * 33 + (lane & 31)] = W[(size_t)(k0 + kk) * N + n0 + (lane & 31)]; }
    asm volatile("s_waitcnt lgkmcnt(0)" ::: "memory");
    const int c = lane & 7;
#pragma unroll
    for (int j = 0; j < 4; ++j) {
        const int n = (lane >> 3) + 8 * j; const LAS float* s = scr + (8 * c) * 33 + n;
        u32x4 o; o.x = pk2(s[0 * 33], s[1 * 33]); o.y = pk2(s[2 * 33], s[3 * 33]); o.z = pk2(s[4 * 33], s[5 * 33]); o.w = pk2(s[6 * 33], s[7 * 33]);
        *(u32x4*)(WT + (size_t)(dst_row0 + n) * K + k0 + 8 * c) = o;
    }
    asm volatile("s_waitcnt lgkmcnt(0)" ::: "memory");
}

struct Ptrs {
    const float* in[27];
    float* out;
    unsigned char* ws;
};

constexpr size_t MiB = 1u << 20;
constexpr size_t WS_CTL = 0;
constexpr size_t WS_MODV = 1 * MiB;
constexpr size_t WS_ROPE = WS_MODV + 256 * 1024;
constexpr size_t WS_WINE = 2 * MiB;
constexpr size_t WS_WOUTE = WS_WINE + (size_t)NPAD_E * 1024 * 2;
constexpr size_t WS_WINO = WS_WOUTE + 2 * MiB;
constexpr size_t WS_WOUTO = WS_WINO + (size_t)1280 * 1024 * 2;
constexpr size_t WS_WGU = WS_WOUTO + 2 * MiB;
constexpr size_t WS_WD = WS_WGU + 32 * MiB;
constexpr size_t WS_CTXS = WS_WD + 16 * MiB;
constexpr size_t WS_R1 = 66 * MiB;
constexpr size_t WS_R4 = WS_R1 + 34 * MiB;
constexpr size_t WS_R2 = WS_R4 + 34 * MiB;
constexpr size_t WS_R3 = WS_R2 + 34 * MiB;
static_assert(WS_CTXS + 4 * MiB <= WS_R1, "ws map");
constexpr size_t R3_GQ = 0, R3_GK = R3_GQ + (size_t)NT * 256 * 2, R3_GV = R3_GK + (size_t)NT * 256 * 2, R3_GR = R3_GV + (size_t)NT * 512 * 2,
                 R3_LR = R3_GR + (size_t)NT * 512 * 2, R3_AQ = R3_LR + (size_t)NT * 32 * 4, R3_AK = R3_AQ + (size_t)NT * 512 * 2, R3_AV = R3_AK + (size_t)NT * 128 * 2,
                 R3_END = R3_AV + (size_t)NT * 128 * 2;
static_assert(WS_R3 + R3_END <= 256 * MiB, "ws map end");
constexpr size_t R3_OQ = 0, R3_OK = R3_OQ + (size_t)NL * 1024 * 2, R3_OV = R3_OK + (size_t)NT * 128 * 2;

__device__ __forceinline__ void ph_prologue(const Ptrs& P, LAS unsigned char* smem, int bid, int nblk) {
    const int lane = threadIdx.x & 63, wave = threadIdx.x >> 6;
    LAS float* scr = (LAS float*)smem + wave * 64 * 33;
    const int gw = bid * 4 + wave, NGW = nblk * 4;
    unsigned char* ws = P.ws;
    constexpr int I_WINE = 16 * 73, I_SQ = 16 * 32, I_WINO = 16 * 40, I_EXP_GU = 16 * 8, I_EXP_D = 4 * 32;
    constexpr int T_WINE = I_WINE, T_WOUTE = T_WINE + I_SQ, T_WINO = T_WOUTE + I_WINO, T_WOUTO = T_WINO + I_SQ,
                  T_G = T_WOUTO + 32 * I_EXP_GU, T_U = T_G + 32 * I_EXP_GU, T_D = T_U + 32 * I_EXP_D;
    for (int it = gw; it < T_D; it += NGW) {
        if (it < T_WINE) {
            int kb = it / 73, nb = it % 73, n0 = nb * 32;
            int dst = n0 < 1536 ? n0 : (n0 < 1568 ? n0 + 768 : n0 - 32);
            transpose_item(P.in[8], 1024, EVEN_IN, (bf16*)(ws + WS_WINE), dst, kb * 64, n0, scr, lane);
        } else if (it < T_WOUTE) { int r = it - T_WINE; transpose_item(P.in[9], 1024, 1024, (bf16*)(ws + WS_WOUTE), (r % 32) * 32, (r / 32) * 64, (r % 32) * 32, scr, lane); }
        else if (it < T_WINO) { int r = it - T_WOUTE; transpose_item(P.in[15], 1024, 1280, (bf16*)(ws + WS_WINO), (r % 40) * 32, (r / 40) * 64, (r % 40) * 32, scr, lane); }
        else if (it < T_WOUTO) { int r = it - T_WINO; transpose_item(P.in[16], 1024, 1024, (bf16*)(ws + WS_WOUTO), (r % 32) * 32, (r / 32) * 64, (r % 32) * 32, scr, lane); }
        else if (it < T_U) {
            bool up = it >= T_G; int r = it - (up ? T_G : T_WOUTO); int le = r / I_EXP_GU; r %= I_EXP_GU; int kb = r / 8, hb = r % 8;
            const float* W = (up ? P.in[25] : P.in[24]) + (size_t)le * 1024 * 256;
            transpose_item(W, 1024, 256, (bf16*)(ws + WS_WGU) + (size_t)le * 512 * 1024, 64 * hb + (up ? 32 : 0), kb * 64, hb * 32, scr, lane);
        } else {
            int r = it - T_U; int le = r / I_EXP_D; r %= I_EXP_D; int kb = r / 32, nb = r % 32;
            transpose_item(P.in[26] + (size_t)le * 256 * 1024, 256, 1024, (bf16*)(ws + WS_WD) + (size_t)le * 1024 * 256, nb * 32, kb * 64, nb * 32, scr, lane);
        }
    }
    { u32x4 z = {0, 0, 0, 0}; u32x4* p = (u32x4*)((bf16*)(ws + WS_WINE) + (size_t)EVEN_IN * 1024);
      for (int i = bid * 256 + threadIdx.x; i < 96 * 1024 * 2 / 16; i += nblk * 256) p[i] = z; }
    for (int i = bid * 256 + threadIdx.x; i < 1024; i += nblk * 256) {
        int pos = i >> 4, f = i & 15; float inv = powf(10000.f, -(float)(2 * f) / 32.f); float ang = (float)pos * inv;
        ((float2*)(ws + WS_ROPE))[i] = make_float2(cosf(ang), sinf(ang));
    }
    __syncthreads();
    {
        LAS float* sc = (LAS float*)smem;
        LAS float* red = (LAS float*)smem + 5 * 1024;
        for (int i = threadIdx.x; i < 5 * 1024; i += 256) { const float cv = i < 4096 ? P.in[1][i] : P.in[3][i - 4096]; sc[i] = cv / (1.f + expf(-cv)); }
        __syncthreads();
        for (int it = bid; it < 2 * 96; it += nblk) {
            const int layer = it / 96, col = (it % 96) * 64 + lane;
            const float* w = P.in[4] + (size_t)layer * D * 6144 + col;
            float a0 = 0.f, a1 = 0.f, a2 = 0.f, a3 = 0.f, a4 = 0.f;
#pragma unroll 8
            for (int k = 256 * wave; k < 256 * wave + 256; ++k) { const float wv = w[(size_t)k * 6144]; a0 += sc[k] * wv; a1 += sc[1024 + k] * wv; a2 += sc[2048 + k] * wv; a3 += sc[3072 + k] * wv; a4 += sc[4096 + k] * wv; }
            red[(wave * 5 + 0) * 64 + lane] = a0; red[(wave * 5 + 1) * 64 + lane] = a1; red[(wave * 5 + 2) * 64 + lane] = a2; red[(wave * 5 + 3) * 64 + lane] = a3; red[(wave * 5 + 4) * 64 + lane] = a4;
            __syncthreads();
            for (int i = threadIdx.x; i < 320; i += 256) { const int row = i >> 6, cl = i & 63;
                ((float*)(ws + WS_MODV))[((size_t)layer * 5 + row) * 6144 + (it % 96) * 64 + cl] = red[row * 64 + cl] + red[(5 + row) * 64 + cl] + red[(10 + row) * 64 + cl] + red[(15 + row) * 64 + cl] + P.in[5][layer * 6144 + (it % 96) * 64 + cl]; }
            __syncthreads();
        }
    }
}

__device__ __forceinline__ void modulate_rows(const float* xlat, const float* xctx, const float* modv_layer, const float* gain, int which, bf16* H, int nrows, int gw, int NGW, int lane) {
    for (int row = gw; row < nrows; row += NGW) {
        const float* xr = row < NL ? xlat + (size_t)row * D : xctx + (size_t)(row - NL) * D;
        const float* mv = modv_layer + (size_t)(row < NL ? row / S : 4) * 6144;
        f32x4 v[4]; float ss = 0.f;
#pragma unroll
        for (int j = 0; j < 4; ++j) { v[j] = *(const f32x4*)(xr + 4 * lane + 256 * j); ss += v[j].x * v[j].x + v[j].y * v[j].y + v[j].z * v[j].z + v[j].w * v[j].w; }
        float rstd = rsqrtf(wave_sum(ss) / D + EPS);
#pragma unroll
        for (int j = 0; j < 4; ++j) {
            int k = 4 * lane + 256 * j;
            f32x4 g = *(const f32x4*)(gain + k), sc = *(const f32x4*)(mv + (which + 1) * 1024 + k), sh = *(const f32x4*)(mv + which * 1024 + k);
            float h0 = v[j].x * rstd * g.x * (1.f + sc.x) + sh.x, h1 = v[j].y * rstd * g.y * (1.f + sc.y) + sh.y;
            float h2 = v[j].z * rstd * g.z * (1.f + sc.z) + sh.z, h3 = v[j].w * rstd * g.w * (1.f + sc.w) + sh.w;
            u32x2 o = {pk2(h0, h1), pk2(h2, h3)};
            *(u32x2*)(H + (size_t)row * D + k) = o;
        }
    }
}
__device__ __forceinline__ void ph_modulate(const Ptrs& P, int layer, int bid, int nblk) {
    modulate_rows(layer ? P.out : P.in[0], layer ? (const float*)(P.ws + WS_CTXS) : P.in[2], (const float*)(P.ws + WS_MODV) + (size_t)layer * 5 * 6144, P.in[6] + layer * D, 0,
                  (bf16*)(P.ws + WS_R1), NT, bid * 4 + (threadIdx.x >> 6), nblk * 4, threadIdx.x & 63);
}

struct AffineRows {
    const bf16* p; size_t stride32;
    __device__ __forceinline__ AffineRows(const bf16* base, size_t ld, int lrow, int kc) : p(base + (size_t)lrow * ld + kc * 8), stride32(32 * ld) {}
    __device__ __forceinline__ const bf16* ptr(int i, int kt) const { return p + i * stride32 + kt * 64; }
};
template <class AF, class BF, class Epi>
__device__ __forceinline__ void gemm_tile(const AF& af, const BF& bf, int nk, LAS unsigned char* smem, const Epi& epi) {
    const int tid = threadIdx.x, lane = tid & 63, wave = tid >> 6, wn = wave & 1, wm = wave >> 1;
    const int lrow = tid >> 3, kc = tid & 7, l31 = lane & 31, hh = lane >> 5;
    u32x4 ra[4], rb[4];
    const bool swp = epi.swapped();
#pragma unroll
    for (int i = 0; i < 4; ++i) { ra[i] = *(const u32x4*)af.ptr(i, 0); rb[i] = *(const u32x4*)bf.ptr(i, 0); }
    const int woff = lrow * LDSP + kc * 16;
#pragma unroll
    for (int i = 0; i < 4; ++i) { *(LAS u32x4*)(smem + woff + i * 32 * LDSP) = ra[i]; *(LAS u32x4*)(smem + 2 * TILE_LDS + woff + i * 32 * LDSP) = rb[i]; }
    __syncthreads();
    f32x16 acc[2][2];
#pragma unroll
    for (int i = 0; i < 2; ++i)
#pragma unroll
        for (int j = 0; j < 2; ++j)
#pragma unroll
            for (int r = 0; r < 16; ++r) acc[i][j][r] = 0.f;
    const int xoff = (wm * 64 + l31) * LDSP + hh * 16;
    const int woffr = 2 * TILE_LDS + (wn * 64 + l31) * LDSP + hh * 16;
    for (int kt = 0; kt < nk; ++kt) {
        const int st = kt & 1;
        if (kt + 1 < nk) {
#pragma unroll
            for (int i = 0; i < 4; ++i) { ra[i] = *(const u32x4*)af.ptr(i, kt + 1); rb[i] = *(const u32x4*)bf.ptr(i, kt + 1); }
        }
        LAS unsigned char* sb = smem + st * TILE_LDS;
#pragma unroll
        for (int s = 0; s < 4; ++s) {
            bf16x8 wf[2], xf[2];
#pragma unroll
            for (int i = 0; i < 2; ++i) wf[i] = *(LAS bf16x8*)(sb + woffr + i * 32 * LDSP + s * 32);
#pragma unroll
            for (int j = 0; j < 2; ++j) xf[j] = *(LAS bf16x8*)(sb + xoff + j * 32 * LDSP + s * 32);
#pragma unroll
            for (int i = 0; i < 2; ++i)
#pragma unroll
                for (int j = 0; j < 2; ++j) acc[i][j] = swp ? __builtin_amdgcn_mfma_f32_32x32x16_bf16(xf[j], wf[i], acc[i][j], 0, 0, 0)
                                                            : __builtin_amdgcn_mfma_f32_32x32x16_bf16(wf[i], xf[j], acc[i][j], 0, 0, 0);
        }
        if (kt + 1 < nk) {
            LAS unsigned char* sn = smem + (st ^ 1) * TILE_LDS;
#pragma unroll
            for (int i = 0; i < 4; ++i) { *(LAS u32x4*)(sn + woff + i * 32 * LDSP) = ra[i]; *(LAS u32x4*)(sn + 2 * TILE_LDS + woff + i * 32 * LDSP) = rb[i]; }
        }
        __syncthreads();
    }
    epi(acc, wn * 64, wm * 64, l31, hh);
}

__device__ __forceinline__ void store_bf16_T(const f32x16 (&acc)[2][2], bf16* out, size_t ld, size_t trow0, int col0, int l31, int hh) {
#pragma unroll
    for (int j = 0; j < 2; ++j) {
        bf16* rp = out + (trow0 + j * 32 + l31) * ld + col0 + 4 * hh;
#pragma unroll
        for (int i = 0; i < 2; ++i)
#pragma unroll
            for (int g = 0; g < 4; ++g) { u32x2 v = {pk2(acc[i][j][4 * g], acc[i][j][4 * g + 1]), pk2(acc[i][j][4 * g + 2], acc[i][j][4 * g + 3])}; *(u32x2*)(rp + i * 32 + 8 * g) = v; }
    }
}
__device__ __forceinline__ void qknorm_rope_T(f32x16 (&acc)[2][2], const float* gain, const float2* ropeT, bool latent, int tok0  , int l31, int hh) {
#pragma unroll
    for (int j = 0; j < 2; ++j) {
        float ss = 0.f;
#pragma unroll
        for (int i = 0; i < 2; ++i)
#pragma unroll
            for (int r = 0; r < 16; ++r) ss += acc[i][j][r] * acc[i][j][r];
        ss = xhalf_sum(ss);
        const float rstd = rsqrtf(ss * (1.f / 64.f) + EPS);
#pragma unroll
        for (int i = 0; i < 2; ++i)
#pragma unroll
            for (int r = 0; r < 16; ++r) acc[i][j][r] *= rstd * gain[i * 32 + (r & 3) + 8 * (r >> 2) + 4 * hh];
        if (latent) {
            const int t = tok0 + j * 32 + l31;
#pragma unroll
            for (int i = 0; i < 2; ++i) {
                const int pos = i == 0 ? (t >> 6) : (t & 63);
#pragma unroll
                for (int r = 0; r < 8; ++r) {
                    const int f = (r & 3) + 8 * (r >> 2) + 4 * hh;
                    const float2 cs = ropeT[pos * 16 + f];
                    const float x1 = acc[i][j][r], x2 = acc[i][j][r + 8];
                    acc[i][j][r] = x1 * cs.x - x2 * cs.y; acc[i][j][r + 8] = x2 * cs.x + x1 * cs.y;
                }
            }
        }
    }
}

constexpr int VT_LD = S + CL;
__device__ __forceinline__ void store_vt_swapped(const f32x16 (&acc)[2][2], bf16* vt_head  , int key0, int l31, int hh) {
#pragma unroll
    for (int i = 0; i < 2; ++i) {
        bf16* rp = vt_head + (size_t)(i * 32 + l31) * VT_LD + key0 + 4 * hh;
#pragma unroll
        for (int j = 0; j < 2; ++j)
#pragma unroll
            for (int g = 0; g < 4; ++g) { u32x2 v = {pk2(acc[i][j][4 * g], acc[i][j][4 * g + 1]), pk2(acc[i][j][4 * g + 2], acc[i][j][4 * g + 3])}; *(u32x2*)(rp + j * 32 + 8 * g) = v; }
    }
}
struct EpiEvenIn {
    unsigned char* r3; const float* qn; const float* kn; const float2* ropeT; int mt, nt;
    __device__ __forceinline__ bool swapped() const { return nt == 17 || (nt >= 4 && nt < 8); }
    __device__ __forceinline__ void operator()(f32x16 (&acc)[2][2], int fb, int tb, int l31, int hh) const {
        const size_t trow0 = (size_t)mt * 128 + tb; const bool latent = mt < NL / 128; const int tok0 = (int)(trow0 & (S - 1));
        if (nt < 2) store_bf16_T(acc, (bf16*)(r3 + R3_GQ), 256, trow0, nt * 128 + fb, l31, hh);
        else if (nt < 4) store_bf16_T(acc, (bf16*)(r3 + R3_GK), 256, trow0, (nt - 2) * 128 + fb, l31, hh);
        else if (nt < 8) {
            const int b = latent ? (int)(trow0 / S) : (int)((trow0 - NL) / CL); const int key0 = latent ? tok0 : S + (int)((trow0 - NL) % CL);
            store_vt_swapped(acc, (bf16*)(r3 + R3_GV) + ((size_t)(b * 4 + nt - 4) * 128 + fb) * VT_LD, key0, l31, hh);
        }
        else if (nt < 12) store_bf16_T(acc, (bf16*)(r3 + R3_GR), 512, trow0, (nt - 8) * 128 + fb, l31, hh);
        else if (nt < 16) { qknorm_rope_T(acc, qn, ropeT, latent, tok0, l31, hh); store_bf16_T(acc, (bf16*)(r3 + R3_AQ), 512, trow0, (nt - 12) * 128 + fb, l31, hh); }
        else if (nt == 16) { qknorm_rope_T(acc, kn, ropeT, latent, tok0, l31, hh); store_bf16_T(acc, (bf16*)(r3 + R3_AK), 128, trow0, fb, l31, hh); }
        else if (nt == 17) {
            const int b = latent ? (int)(trow0 / S) : (int)((trow0 - NL) / CL); const int key0 = latent ? tok0 : S + (int)((trow0 - NL) % CL);
            store_vt_swapped(acc, (bf16*)(r3 + R3_AV) + (size_t)(b * 2 + fb / 64) * 64 * VT_LD, key0, l31, hh);
        }
        else if (fb == 0) {
            float* LR = (float*)(r3 + R3_LR);
#pragma unroll
            for (int j = 0; j < 2; ++j)
#pragma unroll
                for (int g = 0; g < 4; ++g) { f32x4 v = {acc[0][j][4 * g], acc[0][j][4 * g + 1], acc[0][j][4 * g + 2], acc[0][j][4 * g + 3]}; *(f32x4*)(LR + (trow0 + j * 32 + l31) * 32 + 8 * g + 4 * hh) = v; }
        }
    }
};
__device__ __forceinline__ int xcd_vid(int bid, int nb) { return (nb % 8 == 0) ? (bid % 8) * (nb / 8) + bid / 8 : bid; }

__device__ __forceinline__ void ph_even_inproj(const Ptrs& P, LAS unsigned char* smem, int bid, int nblk) {
    unsigned char* ws = P.ws;
    const int lrow = threadIdx.x >> 3, kc = threadIdx.x & 7;
    const int vid = xcd_vid(bid, nblk);
    for (int tile = vid; tile < (NT / 128) * 19; tile += nblk) {
        const int mt = tile / 19, nt = tile % 19;
        AffineRows af((const bf16*)(ws + WS_R1) + (size_t)mt * 128 * D, D, lrow, kc);
        AffineRows bf_((const bf16*)(ws + WS_WINE) + (size_t)nt * 128 * D, D, lrow, kc);
        EpiEvenIn epi{ws + WS_R3, P.in[13], P.in[14], (const float2*)(ws + WS_ROPE), mt, nt};
        gemm_tile(af, bf_, D / 64, smem, epi);
    }
}

struct EpiOutProj {
    const float* modv_layer; const float* xin_lat; const float* xin_ctx; float* xout_lat; float* xout_ctx; int mt, nt;
    __device__ __forceinline__ bool swapped() const { return false; }
    __device__ __forceinline__ void operator()(f32x16 (&acc)[2][2], int fb, int tb, int l31, int hh) const {
        const size_t trow0 = (size_t)mt * 128 + tb; const bool latent = mt < NL / 128;
        const float* gate = modv_layer + (size_t)(latent ? trow0 / S : 4) * 6144 + 2 * 1024 + nt * 128 + fb + 4 * hh;
        const float* xin = latent ? xin_lat + trow0 * D : xin_ctx + (trow0 - NL) * D;
        float* xout = latent ? xout_lat + trow0 * D : xout_ctx + (trow0 - NL) * D;
        const int c0 = nt * 128 + fb + 4 * hh;
#pragma unroll
        for (int j = 0; j < 2; ++j)
#pragma unroll
            for (int i = 0; i < 2; ++i)
#pragma unroll
                for (int g = 0; g < 4; ++g) {
                    const size_t o = (size_t)(j * 32 + l31) * D + c0 + i * 32 + 8 * g;
                    const f32x4 gt = *(const f32x4*)(gate + i * 32 + 8 * g); const f32x4 xi = *(const f32x4*)(xin + o);
                    f32x4 v = {xi.x + gt.x * acc[i][j][4 * g], xi.y + gt.y * acc[i][j][4 * g + 1], xi.z + gt.z * acc[i][j][4 * g + 2], xi.w + gt.w * acc[i][j][4 * g + 3]};
                    *(f32x4*)(xout + o) = v;
                }
    }
};
__device__ __forceinline__ void ph_outproj(const Ptrs& P, LAS unsigned char* smem, int bid, int nblk, int layer, int nrows) {
    unsigned char* ws = P.ws;
    const int lrow = threadIdx.x >> 3, kc = threadIdx.x & 7;
    const int vid = xcd_vid(bid, nblk);
    const float* modv_layer = (const float*)(ws + WS_MODV) + (size_t)layer * 5 * 6144;
    for (int tile = vid; tile < (nrows / 128) * 8; tile += nblk) {
        const int mt = tile / 8, nt = tile % 8;
        AffineRows af((const bf16*)(ws + WS_R2) + (size_t)mt * 128 * D, D, lrow, kc);
        AffineRows bf_((const bf16*)(ws + (layer ? WS_WOUTO : WS_WOUTE)) + (size_t)nt * 128 * D, D, lrow, kc);
        EpiOutProj epi{modv_layer, layer ? P.out : P.in[0], layer ? (const float*)(ws + WS_CTXS) : P.in[2], P.out, (float*)(ws + WS_CTXS), mt, nt};
        gemm_tile(af, bf_, D / 64, smem, epi);
    }
}

struct EpiOddIn {
    unsigned char* r3; const float* qn; const float* kn; const float2* ropeT; int mt, nt;
    __device__ __forceinline__ bool swapped() const { return nt == 9; }
    __device__ __forceinline__ void operator()(f32x16 (&acc)[2][2], int fb, int tb, int l31, int hh) const {
        const size_t trow0 = (size_t)mt * 128 + tb; const bool latent = mt < NL / 128; const int tok0 = (int)(trow0 & (S - 1));
        if (nt < 8) { if (latent) { qknorm_rope_T(acc, qn, ropeT, true, tok0, l31, hh); store_bf16_T(acc, (bf16*)(r3 + R3_OQ), 1024, trow0, nt * 128 + fb, l31, hh); } }
        else if (nt == 8) { qknorm_rope_T(acc, kn, ropeT, latent, tok0, l31, hh); store_bf16_T(acc, (bf16*)(r3 + R3_OK), 128, trow0, fb, l31, hh); }
        else {
            const int b = latent ? (int)(trow0 / S) : (int)((trow0 - NL) / CL); const int key0 = latent ? tok0 : S + (int)((trow0 - NL) % CL);
            store_vt_swapped(acc, (bf16*)(r3 + R3_OV) + (size_t)(b * 2 + fb / 64) * 64 * VT_LD, key0, l31, hh);
        }
    }
};
__device__ __forceinline__ void ph_odd_inproj(const Ptrs& P, LAS unsigned char* smem, int bid, int nblk) {
    unsigned char* ws = P.ws;
    const int lrow = threadIdx.x >> 3, kc = threadIdx.x & 7;
    const int vid = xcd_vid(bid, nblk);
    constexpr int T_LAT = (NL / 128) * 10, T_ALL = T_LAT + (NC / 128) * 2;
    for (int tile = vid; tile < T_ALL; tile += nblk) {
        int mt, nt;
        if (tile < T_LAT) { mt = tile / 10; nt = tile % 10; } else { mt = NL / 128 + (tile - T_LAT) / 2; nt = 8 + (tile - T_LAT) % 2; }
        AffineRows af((const bf16*)(ws + WS_R1) + (size_t)mt * 128 * D, D, lrow, kc);
        AffineRows bf_((const bf16*)(ws + WS_WINO) + (size_t)nt * 128 * D, D, lrow, kc);
        EpiOddIn epi{ws + WS_R3, P.in[18], P.in[19], (const float2*)(ws + WS_ROPE), mt, nt};
        gemm_tile(af, bf_, D / 64, smem, epi);
    }
}

constexpr int AT_KP = 144, AT_VP = 136;
constexpr int AT_STAGE = 64 * AT_KP + 64 * AT_VP;
constexpr int ATTN_LDS = 2 * AT_STAGE;
struct AttnArgs {
    const bf16* Q; int ldq; size_t qrow0; int qcol;
    const bf16* K; size_t klat0, kctx0;
    const bf16* Vt;
    int nctx, tlo, nlat;
    int banded, tq0;
    float sink_l2;
    bf16* out;
};
__device__ __forceinline__ float xhalf_max(float x) {
    auto t = __builtin_amdgcn_permlane32_swap(__float_as_uint(x), __float_as_uint(x), false, false);
    return fmaxf(__uint_as_float(t[0]), __uint_as_float(t[1]));
}
__device__ __forceinline__ void attn_block(const AttnArgs& a, LAS unsigned char* smem) {
    const int tid = threadIdx.x, lane = tid & 63, wave = tid >> 6, l31 = lane & 31, hh = lane >> 5;
    constexpr float C = 0.125f * 1.4426950408889634f;
    bf16x8 qf[4];
    { const bf16* qp = a.Q + (a.qrow0 + wave * 32 + l31) * a.ldq + a.qcol + hh * 8;
#pragma unroll
      for (int s = 0; s < 4; ++s) qf[s] = *(const bf16x8*)(qp + 16 * s); }
    f32x16 o[2];
#pragma unroll
    for (int dt = 0; dt < 2; ++dt)
#pragma unroll
        for (int r = 0; r < 16; ++r) o[dt][r] = 0.f;
    float m = -1e30f, lsum = 0.f;
    const int ntile = a.nctx + a.nlat;
    const int lr0 = tid >> 3, kc = tid & 7;
    u32x4 rk[2], rv[2];
#define AT_ISSUE(n) do { const int t_ = (n) < a.nctx ? 64 + (n) : a.tlo + (n) - a.nctx; \
        const bf16* kb_ = a.K + (t_ < 64 ? a.klat0 + 64 * t_ : a.kctx0 + 64 * (t_ - 64)) * 128 + kc * 8; const bf16* vb_ = a.Vt + 64 * t_ + kc * 8; \
        _Pragma("unroll") for (int i = 0; i < 2; ++i) { rk[i] = *(const u32x4*)(kb_ + (size_t)(lr0 + 32 * i) * 128); rv[i] = *(const u32x4*)(vb_ + (size_t)(lr0 + 32 * i) * VT_LD); } } while (0)
#define AT_COMMIT(st) do { LAS unsigned char* sb_ = smem + (st) * AT_STAGE; \
        _Pragma("unroll") for (int i = 0; i < 2; ++i) { *(LAS u32x4*)(sb_ + (lr0 + 32 * i) * AT_KP + kc * 16) = rk[i]; \
            LAS unsigned char* vp_ = sb_ + 64 * AT_KP + (lr0 + 32 * i) * AT_VP + kc * 16; u32x2 lo_ = {rv[i].x, rv[i].y}, hi_ = {rv[i].z, rv[i].w}; *(LAS u32x2*)vp_ = lo_; *(LAS u32x2*)(vp_ + 8) = hi_; } } while (0)
    AT_ISSUE(0); AT_COMMIT(0);
    __syncthreads();
    const int tq = a.tq0 + wave * 32 + l31;
    for (int n = 0; n < ntile; ++n) {
        const int st = n & 1;
        if (n + 1 < ntile) AT_ISSUE(n + 1);
        LAS unsigned char* sb = smem + st * AT_STAGE;
        f32x16 sc[2];
#pragma unroll
        for (int kt = 0; kt < 2; ++kt) {
#pragma unroll
            for (int r = 0; r < 16; ++r) sc[kt][r] = 0.f;
#pragma unroll
            for (int s = 0; s < 4; ++s) {
                const bf16x8 kf = *(LAS bf16x8*)(sb + (32 * kt + l31) * AT_KP + s * 32 + hh * 16);
                sc[kt] = __builtin_amdgcn_mfma_f32_32x32x16_bf16(kf, qf[s], sc[kt], 0, 0, 0);
            }
        }
        if (a.banded && n >= a.nctx) {
            const int t_ = a.tlo + n - a.nctx; const int dbase = 64 * t_ + 4 * hh - tq;
#pragma unroll
            for (int kt = 0; kt < 2; ++kt)
#pragma unroll
                for (int r = 0; r < 16; ++r) { const int df = dbase + 32 * kt + (r & 3) + 8 * (r >> 2); if (df > 128 || df < -128) sc[kt][r] = -1e30f; }
        }
        float mx = sc[0][0];
#pragma unroll
        for (int kt = 0; kt < 2; ++kt)
#pragma unroll
            for (int r = 0; r < 16; ++r) mx = fmaxf(mx, sc[kt][r]);
        mx = xhalf_max(mx);
        const float mnew = fmaxf(m, mx * C);
        const float alpha = __builtin_amdgcn_exp2f(m - mnew);
        m = mnew;
        float ps = 0.f;
#pragma unroll
        for (int kt = 0; kt < 2; ++kt)
#pragma unroll
            for (int r = 0; r < 16; ++r) { sc[kt][r] = __builtin_amdgcn_exp2f(fmaf(sc[kt][r], C, -mnew)); ps += sc[kt][r]; }
        lsum = lsum * alpha + ps;
#pragma unroll
        for (int dt = 0; dt < 2; ++dt)
#pragma unroll
            for (int r = 0; r < 16; ++r) o[dt][r] *= alpha;
#pragma unroll
        for (int kt = 0; kt < 2; ++kt)
#pragma unroll
            for (int s2 = 0; s2 < 2; ++s2) {
                u32x4 pw = {pk2(sc[kt][8 * s2], sc[kt][8 * s2 + 1]), pk2(sc[kt][8 * s2 + 2], sc[kt][8 * s2 + 3]), pk2(sc[kt][8 * s2 + 4], sc[kt][8 * s2 + 5]), pk2(sc[kt][8 * s2 + 6], sc[kt][8 * s2 + 7])};
                const bf16x8 pf = __builtin_bit_cast(bf16x8, pw);
#pragma unroll
                for (int dt = 0; dt < 2; ++dt) {
                    LAS unsigned char* vp = sb + 64 * AT_KP + (32 * dt + l31) * AT_VP + (32 * kt + 16 * s2 + 4 * hh) * 2;
                    const u32x2 v0 = *(LAS u32x2*)vp, v1 = *(LAS u32x2*)(vp + 16);
                    u32x4 vw = {v0.x, v0.y, v1.x, v1.y};
                    o[dt] = __builtin_amdgcn_mfma_f32_32x32x16_bf16(__builtin_bit_cast(bf16x8, vw), pf, o[dt], 0, 0, 0);
                }
            }
        if (n + 1 < ntile) AT_COMMIT(st ^ 1);
        __syncthreads();
    }
#undef AT_ISSUE
#undef AT_COMMIT
    float l = xhalf_sum(lsum) + __builtin_amdgcn_exp2f(a.sink_l2 - m);
    const float inv = 1.f / l;
    bf16* op = a.out + (a.qrow0 + wave * 32 + l31) * 1024 + 4 * hh;
#pragma unroll
    for (int dt = 0; dt < 2; ++dt)
#pragma unroll
        for (int g = 0; g < 4; ++g) { u32x2 v = {pk2(o[dt][4 * g] * inv, o[dt][4 * g + 1] * inv), pk2(o[dt][4 * g + 2] * inv, o[dt][4 * g + 3] * inv)}; *(u32x2*)(op + dt * 32 + 8 * g) = v; }
}

__device__ __forceinline__ void ph_dense_attn(const Ptrs& P, LAS unsigned char* smem, int bid, int nblk) {
    unsigned char* r3 = P.ws + WS_R3;
    const int vid = xcd_vid(bid, nblk);
    for (int item = vid; item < 1024 + 64; item += nblk) {
        AttnArgs a;
        int bh, qb; bool isctx = item >= 1024;
        if (!isctx) { bh = item >> 5; qb = item & 31; } else { bh = (item - 1024) >> 1; qb = (item - 1024) & 1; }
        const int hq = bh & 7, b = bh >> 3, kv = hq >> 2;
        a.Q = (const bf16*)(r3 + R3_AQ); a.ldq = 512; a.qcol = hq * 64;
        a.qrow0 = isctx ? (size_t)NL + b * CL + qb * 128 : (size_t)b * S + qb * 128;
        a.K = (const bf16*)(r3 + R3_AK) + kv * 64; a.klat0 = (size_t)b * S; a.kctx0 = (size_t)NL + b * CL;
        a.Vt = (const bf16*)(r3 + R3_AV) + (size_t)(b * 2 + kv) * 64 * VT_LD;
        a.nctx = 4; a.tlo = 0; a.nlat = isctx ? 0 : 64; a.banded = 0; a.tq0 = 0; a.sink_l2 = -INFINITY;
        a.out = (bf16*)(P.ws + WS_R2) + 512 + hq * 64;
        attn_block(a, smem);
    }
}
__device__ __forceinline__ void ph_swa_attn(const Ptrs& P, LAS unsigned char* smem, int bid, int nblk) {
    unsigned char* r3 = P.ws + WS_R3;
    const int vid = xcd_vid(bid, nblk);
    for (int item = vid; item < 2048; item += nblk) {
        AttnArgs a;
        const int bh = item >> 5, qb = item & 31, hq = bh & 15, b = bh >> 4, kv = hq >> 3;
        a.Q = (const bf16*)(r3 + R3_OQ); a.ldq = 1024; a.qcol = hq * 64; a.qrow0 = (size_t)b * S + qb * 128;
        a.K = (const bf16*)(r3 + R3_OK) + kv * 64; a.klat0 = (size_t)b * S; a.kctx0 = (size_t)NL + b * CL;
        a.Vt = (const bf16*)(r3 + R3_OV) + (size_t)(b * 2 + kv) * 64 * VT_LD;
        const int tlo = qb * 2 - 2 < 0 ? 0 : qb * 2 - 2, thi = qb * 2 + 3 > 63 ? 63 : qb * 2 + 3;
        a.nctx = 4; a.tlo = tlo; a.nlat = thi - tlo + 1; a.banded = 1; a.tq0 = qb * 128; a.sink_l2 = P.in[17][hq] * 1.4426950408889634f;
        a.out = (bf16*)(P.ws + WS_R2) + hq * 64;
        attn_block(a, smem);
    }
}

constexpr size_t WS_LIST = 247 * MiB;
constexpr size_t WS_WTS = WS_LIST + (size_t)24 * NT * 4;
constexpr size_t WS_END_ALL = WS_WTS + (size_t)NT * 2 * 4;
static_assert(WS_R3 + R3_END <= WS_LIST && WS_END_ALL <= 256 * MiB, "ws map tail");
constexpr int CTL_CNT = 1024;
constexpr int MOE_MAXT = NT / 128 + 24;

__device__ __forceinline__ void ph_moe_route(const Ptrs& P, LAS unsigned char* smem, int bid, int nblk, int layer, int nrows) {
    LAS f32x4* we_lds = (LAS f32x4*)smem;
    unsigned char* ws = P.ws;
    const int tid = threadIdx.x, lane = tid & 63, wave = tid >> 6;
    const float* wg = P.in[20] + (size_t)layer * D * 4; const float* bg = P.in[21] + layer * 4;
    const float* we = P.in[22] + (size_t)layer * D * 16; const float* be = P.in[23] + layer * 16;
    for (int i = tid; i < 4096; i += 256) { const int ln = i & 63, c = (i >> 6) & 3, jj = (i >> 8) & 3, j4 = i >> 10; const int k = 4 * ln + 256 * jj + c; we_lds[i] = *(const f32x4*)(we + k * 16 + 4 * j4); }
    __syncthreads();
    const float* modv_layer = (const float*)(ws + WS_MODV) + (size_t)layer * 5 * 6144;
    const float* gain = P.in[7] + layer * D;
    const float* xlat = P.out; const float* xctx = (const float*)(ws + WS_CTXS);
    bf16* H = (bf16*)(ws + WS_R1);
    int* cnt = (int*)(ws + WS_CTL) + CTL_CNT + layer * 32; int* list = (int*)(ws + WS_LIST); float* wts = (float*)(ws + WS_WTS);
    const int gw = bid * 4 + wave, NGW = nblk * 4;
    int pend_pos = 0, pend_cls = -1, pend_row = 0;
    for (int row = gw; row < nrows; row += NGW) {
        const float* xr = row < NL ? xlat + (size_t)row * D : xctx + (size_t)(row - NL) * D;
        const float* mv = modv_layer + (size_t)(row < NL ? row / S : 4) * 6144;
        float ss = 0.f;
#pragma unroll
        for (int j = 0; j < 4; ++j) { const f32x4 t = *(const f32x4*)(xr + 4 * lane + 256 * j); ss += t.x * t.x + t.y * t.y + t.z * t.z + t.w * t.w; }
        const float rstd = rsqrtf(wave_sum(ss) / D + EPS);
        float part[20];
#pragma unroll
        for (int j = 0; j < 20; ++j) part[j] = 0.f;
#pragma unroll 1
        for (int jj = 0; jj < 4; ++jj) {
            const int k = 4 * lane + 256 * jj;
            const f32x4 xv = *(const f32x4*)(xr + k);
            const f32x4 g = *(const f32x4*)(gain + k), sc = *(const f32x4*)(mv + 4 * 1024 + k), sh = *(const f32x4*)(mv + 3 * 1024 + k);
            const float h0 = xv.x * rstd * g.x * (1.f + sc.x) + sh.x, h1 = xv.y * rstd * g.y * (1.f + sc.y) + sh.y, h2 = xv.z * rstd * g.z * (1.f + sc.z) + sh.z, h3 = xv.w * rstd * g.w * (1.f + sc.w) + sh.w;
            u32x2 o = {pk2(h0, h1), pk2(h2, h3)};
            *(u32x2*)(H + (size_t)row * D + k) = o;
#pragma unroll
            for (int c = 0; c < 4; ++c) {
                const float hc = c == 0 ? h0 : c == 1 ? h1 : c == 2 ? h2 : h3;
                const f32x4 w4 = *(const f32x4*)(wg + (k + c) * 4);
                part[0] += hc * w4.x; part[1] += hc * w4.y; part[2] += hc * w4.z; part[3] += hc * w4.w;
#pragma unroll
                for (int j4 = 0; j4 < 4; ++j4) { const f32x4 e4 = we_lds[((j4 * 4 + jj) * 4 + c) * 64 + lane]; part[4 + 4 * j4] += hc * e4.x; part[5 + 4 * j4] += hc * e4.y; part[6 + 4 * j4] += hc * e4.z; part[7 + 4 * j4] += hc * e4.w; }
            }
        }
#pragma unroll
        for (int j = 0; j < 20; ++j) part[j] = wave_sum(part[j]);
        float gl[4];
#pragma unroll
        for (int j = 0; j < 4; ++j) gl[j] = part[j] + bg[j];
        int gi = 0; float gm = gl[0];
#pragma unroll
        for (int j = 1; j < 4; ++j) if (gl[j] > gm) { gm = gl[j]; gi = j; }
        float gs = 0.f;
#pragma unroll
        for (int j = 0; j < 4; ++j) gs += expf(gl[j] - gm);
        const float gwt = 1.f / gs;
        float el[4];
#pragma unroll
        for (int j = 0; j < 4; ++j) el[j] = (gi == 0 ? part[4 + j] : gi == 1 ? part[8 + j] : gi == 2 ? part[12 + j] : part[16 + j]) + be[gi * 4 + j];
        int i0 = 0; float e0 = el[0];
#pragma unroll
        for (int j = 1; j < 4; ++j) if (el[j] > e0) { e0 = el[j]; i0 = j; }
        int i1 = -1; float e1 = -INFINITY;
#pragma unroll
        for (int j = 0; j < 4; ++j) if (j != i0 && el[j] > e1) { e1 = el[j]; i1 = j; }
        const float p1 = expf(e1 - e0); const float w0 = gwt / (1.f + p1), w1 = gwt * p1 / (1.f + p1);
        const int ea = i0 < i1 ? i0 : i1, eb = i0 < i1 ? i1 : i0;
        const float wA = i0 < i1 ? w0 : w1, wB = i0 < i1 ? w1 : w0;
        const int pidx = ea == 0 ? eb - 1 : (ea == 1 ? eb + 1 : 5);
        const int cls = gi * 6 + pidx;
        if (lane == 0) {
            if (pend_cls >= 0) list[(size_t)pend_cls * NT + pend_pos] = pend_row;
            wts[(size_t)row * 2] = wA; wts[(size_t)row * 2 + 1] = wB;
            pend_pos = atomicAdd(&cnt[cls], 1); pend_cls = cls; pend_row = row;
        }
    }
    if (lane == 0 && pend_cls >= 0) list[(size_t)pend_cls * NT + pend_pos] = pend_row;
    __syncthreads();
}

__device__ __forceinline__ void moe_tiles_init(const int* cnt, LAS int* tile0) {
    if (threadIdx.x == 0) { int a = 0; for (int c = 0; c < 24; ++c) { tile0[c] = a; a += (cnt[c] + 127) >> 7; } tile0[24] = a; }
    __syncthreads();
}
struct GatherRows {
    const bf16* p[4];
    __device__ __forceinline__ const bf16* ptr(int i, int kt) const { return p[i] + kt * 64; }
};
struct SplitKRows {
    const bf16* p0; const bf16* p1; size_t stride32; int ksplit;
    __device__ __forceinline__ SplitKRows(const bf16* b0, const bf16* b1, size_t ld, int ksplit_, int lrow, int kc) : p0(b0 + (size_t)lrow * ld + kc * 8), p1(b1 + (size_t)lrow * ld + kc * 8), stride32(32 * ld), ksplit(ksplit_) {}
    __device__ __forceinline__ const bf16* ptr(int i, int kt) const { return (kt < ksplit ? p0 + kt * 64 : p1 + (kt - ksplit) * 64) + i * stride32; }
};
struct EpiMoe1 {
    bf16* hid; const int* lst; int n; const float* wts; int nt;
    __device__ __forceinline__ bool swapped() const { return false; }
    __device__ __forceinline__ void operator()(f32x16 (&acc)[2][2], int fb, int tb, int l31, int hh) const {
        const int col = (nt >> 2) * 256 + 32 * (2 * (nt & 3) + (fb >> 6)) + 4 * hh;
#pragma unroll
        for (int j = 0; j < 2; ++j) {
            const int r = tb + j * 32 + l31;
            const int tok = lst[r < n ? r : 0];
            const float w = wts[(size_t)tok * 2 + (nt >> 2)];
            bf16* rp = hid + (size_t)r * 512 + col;
#pragma unroll
            for (int g = 0; g < 4; ++g) {
                float hv[4];
#pragma unroll
                for (int e = 0; e < 4; ++e) { const float a_ = acc[0][j][4 * g + e], u_ = acc[1][j][4 * g + e]; hv[e] = a_ / (1.f + __expf(-a_)) * u_ * w; }
                u32x2 v = {pk2(hv[0], hv[1]), pk2(hv[2], hv[3])}; *(u32x2*)(rp + 8 * g) = v;
            }
        }
    }
};
__device__ __forceinline__ void ph_moe_stage1(const Ptrs& P, LAS unsigned char* smem, int bid, int nblk, int layer) {
    unsigned char* ws = P.ws;
    const int* cnt = (const int*)(ws + WS_CTL) + CTL_CNT + layer * 32; const int* list = (const int*)(ws + WS_LIST);
    LAS int* tile0 = (LAS int*)(smem + GEMM_LDS);
    moe_tiles_init(cnt, tile0);
    const int lrow = threadIdx.x >> 3, kc = threadIdx.x & 7;
    const bf16* H = (const bf16*)(ws + WS_R1);
    const int nitems = tile0[24] * 8;
    for (int item = bid; item < nitems; item += nblk) {
        const int tt = item >> 3, nt = item & 7;
        int c = 0; while (tile0[c + 1] <= tt) ++c;
        const int lt = tt - tile0[c], n = min(128, cnt[c] - lt * 128);
        const int* lst = list + (size_t)c * NT + lt * 128;
        const int g = c / 6, pidx = c % 6; const int ea = pidx < 3 ? 0 : (pidx < 5 ? 1 : 2), eb = pidx < 3 ? pidx + 1 : (pidx < 5 ? pidx - 1 : 3);
        const int expert = g * 4 + (nt < 4 ? ea : eb);
        GatherRows af;
#pragma unroll
        for (int i = 0; i < 4; ++i) { const int r = lrow + 32 * i; af.p[i] = H + (size_t)lst[r < n ? r : 0] * D + kc * 8; }
        AffineRows bf_((const bf16*)(ws + WS_WGU) + ((size_t)(layer * 16 + expert) * 512 + (nt & 3) * 128) * D, D, lrow, kc);
        EpiMoe1 epi{(bf16*)(ws + WS_R3) + (size_t)tt * 128 * 512, lst, n, (const float*)(ws + WS_WTS), nt};
        gemm_tile(af, bf_, D / 64, smem, epi);
    }
}
struct EpiMoe2 {
    float* xlat; float* xctx; const float* modv_layer; const int* lst; int n; int nt;
    __device__ __forceinline__ bool swapped() const { return false; }
    __device__ __forceinline__ void operator()(f32x16 (&acc)[2][2], int fb, int tb, int l31, int hh) const {
        const int c0 = nt * 128 + fb + 4 * hh;
#pragma unroll
        for (int j = 0; j < 2; ++j) {
            const int r = tb + j * 32 + l31;
            if (r < n) {
                const int tok = lst[r];
                float* xr = (tok < NL ? xlat + (size_t)tok * D : xctx + (size_t)(tok - NL) * D) + c0;
                const float* gt = modv_layer + (size_t)(tok < NL ? tok / S : 4) * 6144 + 5 * 1024 + c0;
#pragma unroll
                for (int i = 0; i < 2; ++i)
#pragma unroll
                    for (int g = 0; g < 4; ++g) {
                        const f32x4 gg = *(const f32x4*)(gt + i * 32 + 8 * g); f32x4 xv = *(f32x4*)(xr + i * 32 + 8 * g);
                        xv.x += gg.x * acc[i][j][4 * g]; xv.y += gg.y * acc[i][j][4 * g + 1]; xv.z += gg.z * acc[i][j][4 * g + 2]; xv.w += gg.w * acc[i][j][4 * g + 3];
                        *(f32x4*)(xr + i * 32 + 8 * g) = xv;
                    }
            }
        }
    }
};
__device__ __forceinline__ void ph_moe_stage2(const Ptrs& P, LAS unsigned char* smem, int bid, int nblk, int layer) {
    unsigned char* ws = P.ws;
    const int* cnt = (const int*)(ws + WS_CTL) + CTL_CNT + layer * 32; const int* list = (const int*)(ws + WS_LIST);
    LAS int* tile0 = (LAS int*)(smem + GEMM_LDS);
    moe_tiles_init(cnt, tile0);
    const int lrow = threadIdx.x >> 3, kc = threadIdx.x & 7;
    const int nitems = tile0[24] * 8;
    for (int item = bid; item < nitems; item += nblk) {
        const int tt = item >> 3, nt = item & 7;
        int c = 0; while (tile0[c + 1] <= tt) ++c;
        const int lt = tt - tile0[c], n = min(128, cnt[c] - lt * 128);
        const int* lst = list + (size_t)c * NT + lt * 128;
        const int g = c / 6, pidx = c % 6; const int ea = pidx < 3 ? 0 : (pidx < 5 ? 1 : 2), eb = pidx < 3 ? pidx + 1 : (pidx < 5 ? pidx - 1 : 3);
        AffineRows af((const bf16*)(ws + WS_R3) + (size_t)tt * 128 * 512, 512, lrow, kc);
        const bf16* wd = (const bf16*)(ws + WS_WD);
        SplitKRows bf_(wd + ((size_t)(layer * 16 + g * 4 + ea) * 1024 + nt * 128) * 256, wd + ((size_t)(layer * 16 + g * 4 + eb) * 1024 + nt * 128) * 256, 256, 4, lrow, kc);
        EpiMoe2 epi{P.out, (float*)(ws + WS_CTXS), (const float*)(ws + WS_MODV) + (size_t)layer * 5 * 6144, lst, n, nt};
        gemm_tile(af, bf_, 8, smem, epi);
    }
}

constexpr size_t GLA_ST = 8192;
constexpr size_t WS_DEC = WS_WTS + (size_t)NT * 2 * 4;
static_assert(WS_DEC + (size_t)32 * 68 * 64 * 4 <= 256 * MiB, "ws dec");
__device__ __forceinline__ void gla_chunk_geom(int b, int M, size_t& row0, int& vcol0, int& c0, int& c1) {
    if (M < 4) { row0 = (size_t)NL + b * CL + 64 * M; vcol0 = S + 64 * M; c0 = M; c1 = 3 - M; }
    else { const int Ml = M - 4; row0 = (size_t)b * S + 64 * Ml; vcol0 = 64 * Ml; c0 = 4 + Ml; c1 = 4 + 63 - Ml; }
}
template <bool PASS_C>
__device__ __forceinline__ float gla_prep(const Ptrs& P, int h, int dir, size_t row0, LAS unsigned char* lds, int off_lrs, int off_tot) {
    const int tid = threadIdx.x, k = tid & 63, grp = tid >> 6;
    const unsigned char* r3 = P.ws + WS_R3;
    LAS float* lrs = (LAS float*)(lds + off_lrs); LAS float* tot = (LAS float*)(lds + off_tot);
    { const float* LR = (const float*)(r3 + R3_LR); *(LAS f32x4*)(lrs + tid * 4) = *(const f32x4*)(LR + (row0 + (tid >> 2)) * 32 + dir * 16 + (tid & 3) * 4); }
    float gw[16];
#pragma unroll
    for (int r = 0; r < 16; ++r) gw[r] = P.in[10][(dir * 16 + r) * 256 + h * 64 + k];
    const float gb = P.in[11][dir * 256 + h * 64 + k];
    __syncthreads();
    float gl[16];
#pragma unroll
    for (int j = 0; j < 16; ++j) {
        const int p = 16 * grp + j; float z = gb;
#pragma unroll
        for (int r4 = 0; r4 < 4; ++r4) { const f32x4 l4 = *(LAS f32x4*)(lrs + p * 16 + r4 * 4); z += l4.x * gw[4 * r4] + l4.y * gw[4 * r4 + 1] + l4.z * gw[4 * r4 + 2] + l4.w * gw[4 * r4 + 3]; }
        gl[j] = (fminf(z, 0.f) - __logf(1.f + __expf(-fabsf(z)))) * (1.f / 16.f);
    }
    if (dir == 0) {
#pragma unroll
        for (int j = 1; j < 16; ++j) gl[j] += gl[j - 1];
        tot[grp * 64 + k] = gl[15];
    } else {
#pragma unroll
        for (int j = 14; j >= 0; --j) gl[j] += gl[j + 1];
        tot[grp * 64 + k] = gl[0];
    }
    __syncthreads();
    const float t0 = tot[k], t1 = tot[64 + k], t2 = tot[128 + k], t3 = tot[192 + k];
    const float bend = t0 + t1 + t2 + t3;
    float offs;
    if (dir == 0) offs = grp == 0 ? 0.f : grp == 1 ? t0 : grp == 2 ? t0 + t1 : t0 + t1 + t2;
    else offs = grp == 3 ? 0.f : grp == 2 ? t3 : grp == 1 ? t3 + t2 : t3 + t2 + t1;
    const bf16* GQ = (const bf16*)(r3 + R3_GQ); const bf16* GK = (const bf16*)(r3 + R3_GK);
    if (PASS_C) {
#pragma unroll
        for (int j = 0; j < 16; ++j) {
            const int p = 16 * grp + j; const float bp = gl[j] + offs;
            const float q = bf2f(GQ[(row0 + p) * 256 + h * 64 + k]) * 0.125f, kk = bf2f(GK[(row0 + p) * 256 + h * 64 + k]);
            *(LAS bf16*)(lds + p * 144 + k * 2) = f2bf(q * __expf(bp));
            *(LAS bf16*)(lds + 9216 + p * 144 + k * 2) = f2bf(q * __expf(bp - bend));
            *(LAS bf16*)(lds + 18432 + p * 144 + k * 2) = f2bf(kk * __expf(bend - bp));
        }
    } else {
        float kt[16];
#pragma unroll
        for (int j = 0; j < 16; ++j) { const int p = 16 * grp + j; const float bp = gl[j] + offs; kt[j] = bf2f(GK[(row0 + p) * 256 + h * 64 + k]) * __expf(bend - bp); }
        u32x4 w0 = {pk2(kt[0], kt[1]), pk2(kt[2], kt[3]), pk2(kt[4], kt[5]), pk2(kt[6], kt[7])}, w1 = {pk2(kt[8], kt[9]), pk2(kt[10], kt[11]), pk2(kt[12], kt[13]), pk2(kt[14], kt[15])};
        *(LAS u32x4*)(lds + k * 144 + grp * 32) = w0; *(LAS u32x4*)(lds + k * 144 + grp * 32 + 16) = w1;
    }
    return __expf(bend);
}

constexpr int GA_KTT = 0, GA_VT = 9216, GA_LRS = GA_VT + 128 * 144, GA_TOT = GA_LRS + 4096, GLA_A_LDS = GA_TOT + 1024;
__device__ __forceinline__ void gla_pass_a_item(const Ptrs& P, int item, LAS unsigned char* lds) {
    const int tid = threadIdx.x, lane = tid & 63, wave = tid >> 6, l31 = lane & 31, hh = lane >> 5;
    const int M = item % 68, dir = (item / 68) & 1, h = (item / 136) & 3, b = item / 544;
    size_t row0; int vcol0, c0, c1; gla_chunk_geom(b, M, row0, vcol0, c0, c1);
    const int sidx = ((b * 4 + h) * 2 + dir) * 68 + (dir ? c1 : c0);
    { const bf16* gvt = (const bf16*)(P.ws + WS_R3 + R3_GV) + (size_t)(b * 4 + h) * 128 * VT_LD + vcol0;
#pragma unroll
      for (int i = 0; i < 4; ++i) { const int c = tid + 256 * i, v = c >> 3, kc = c & 7; *(LAS u32x4*)(lds + GA_VT + v * 144 + kc * 16) = *(const u32x4*)(gvt + (size_t)v * VT_LD + kc * 8); } }
    const float dec = gla_prep<false>(P, h, dir, row0, lds, GA_LRS, GA_TOT);
    if (tid < 64) ((float*)(P.ws + WS_DEC))[(size_t)sidx * 64 + tid] = dec;
    __syncthreads();
    f32x16 acc[2];
#pragma unroll
    for (int kt = 0; kt < 2; ++kt)
#pragma unroll
        for (int r = 0; r < 16; ++r) acc[kt][r] = 0.f;
#pragma unroll
    for (int ps = 0; ps < 4; ++ps) {
        const bf16x8 vf = *(LAS bf16x8*)(lds + GA_VT + (32 * wave + l31) * 144 + ps * 32 + hh * 16);
#pragma unroll
        for (int kt = 0; kt < 2; ++kt) { const bf16x8 kf = *(LAS bf16x8*)(lds + GA_KTT + (32 * kt + l31) * 144 + ps * 32 + hh * 16); acc[kt] = __builtin_amdgcn_mfma_f32_32x32x16_bf16(kf, vf, acc[kt], 0, 0, 0); }
    }
    bf16* ds = (bf16*)(P.ws + WS_R1) + (size_t)sidx * GLA_ST + (size_t)(32 * wave + l31) * 64 + 4 * hh;
#pragma unroll
    for (int kt = 0; kt < 2; ++kt)
#pragma unroll
        for (int g = 0; g < 4; ++g) { u32x2 v = {pk2(acc[kt][4 * g], acc[kt][4 * g + 1]), pk2(acc[kt][4 * g + 2], acc[kt][4 * g + 3])}; *(u32x2*)(ds + kt * 32 + 8 * g) = v; }
    __syncthreads();
}
__device__ __forceinline__ void ph_gla_a(const Ptrs& P, LAS unsigned char* smem, int bid, int nblk) {
    for (int item = bid; item < 4 * 4 * 2 * 68; item += nblk) gla_pass_a_item(P, item, smem);
}
__device__ __forceinline__ void gla_pass_b(const Ptrs& P, int gtid, int nthreads) {
    const bf16* DS = (const bf16*)(P.ws + WS_R1); bf16* SIN = (bf16*)(P.ws + WS_R4); const float* DEC = (const float*)(P.ws + WS_DEC);
    for (int idx = gtid; idx < 32 * 2048; idx += nthreads) {
        const int bhd = idx >> 11, e4 = idx & 2047, k4 = (e4 & 15) * 4;
        float s0 = 0.f, s1 = 0.f, s2 = 0.f, s3 = 0.f;
#pragma unroll 4
        for (int c = 0; c < 68; ++c) {
            const size_t sidx = (size_t)bhd * 68 + c;
            u32x2 o = {pk2(s0, s1), pk2(s2, s3)};
            *(u32x2*)(SIN + sidx * GLA_ST + e4 * 4) = o;
            const f32x4 d = *(const f32x4*)(DEC + sidx * 64 + k4);
            const u32x2 w = *(const u32x2*)(DS + sidx * GLA_ST + e4 * 4);
            s0 = s0 * d.x + __uint_as_float(w.x << 16); s1 = s1 * d.y + __uint_as_float(w.x & 0xffff0000u);
            s2 = s2 * d.z + __uint_as_float(w.y << 16); s3 = s3 * d.w + __uint_as_float(w.y & 0xffff0000u);
        }
    }
}

constexpr int GC_QT = 0, GC_QA = 9216, GC_KT = 18432, GC_VT = 27648, GC_LRS = GC_VT + 128 * 136, GC_TOT = GC_LRS + 4096, GC_XCH = GC_TOT + 1024, GLA_C_LDS = GC_XCH + 512;
__device__ __forceinline__ void gla_pass_c_item(const Ptrs& P, int item, LAS unsigned char* lds) {
    const int tid = threadIdx.x, lane = tid & 63, wave = tid >> 6, l31 = lane & 31, hh = lane >> 5, pt = wave & 1, vh = wave >> 1;
    const int M = item % 68, h = (item / 68) & 3, b = item / 272;
    size_t row0; int vcol0, c0, c1; gla_chunk_geom(b, M, row0, vcol0, c0, c1);
    { const bf16* gvt = (const bf16*)(P.ws + WS_R3 + R3_GV) + (size_t)(b * 4 + h) * 128 * VT_LD + vcol0;
#pragma unroll
      for (int i = 0; i < 4; ++i) { const int c = tid + 256 * i, v = c >> 3, kc = c & 7; const u32x4 w = *(const u32x4*)(gvt + (size_t)v * VT_LD + kc * 8);
          LAS unsigned char* vp = lds + GC_VT + v * 136 + kc * 16; u32x2 lo = {w.x, w.y}, hi = {w.z, w.w}; *(LAS u32x2*)vp = lo; *(LAS u32x2*)(vp + 8) = hi; } }
    f32x16 o[2];
#pragma unroll
    for (int i = 0; i < 2; ++i)
#pragma unroll
        for (int r = 0; r < 16; ++r) o[i][r] = 0.f;
    const bf16* SIN = (const bf16*)(P.ws + WS_R4);
#pragma unroll 1
    for (int dir = 0; dir < 2; ++dir) {
        const int sidx = ((b * 4 + h) * 2 + dir) * 68 + (dir ? c1 : c0);
        bf16x8 sf[2][4];
#pragma unroll
        for (int i = 0; i < 2; ++i)
#pragma unroll
            for (int ks = 0; ks < 4; ++ks) sf[i][ks] = *(const bf16x8*)(SIN + (size_t)sidx * GLA_ST + (size_t)(64 * vh + 32 * i + l31) * 64 + 16 * ks + 8 * hh);
        (void)gla_prep<true>(P, h, dir, row0, lds, GC_LRS, GC_TOT);
        __syncthreads();
        f32x16 at[2];
#pragma unroll
        for (int st = 0; st < 2; ++st) {
#pragma unroll
            for (int r = 0; r < 16; ++r) at[st][r] = 0.f;
#pragma unroll
            for (int ks = 0; ks < 4; ++ks) {
                const bf16x8 ka = *(LAS bf16x8*)(lds + GC_KT + (32 * st + l31) * 144 + ks * 32 + hh * 16);
                const bf16x8 qa = *(LAS bf16x8*)(lds + GC_QA + (32 * pt + l31) * 144 + ks * 32 + hh * 16);
                at[st] = __builtin_amdgcn_mfma_f32_32x32x16_bf16(ka, qa, at[st], 0, 0, 0);
            }
            const int pq = 32 * pt + l31;
#pragma unroll
            for (int r = 0; r < 16; ++r) { const int s_ = 32 * st + (r & 3) + 8 * (r >> 2) + 4 * hh; const bool ok = dir ? (s_ >= pq) : (s_ <= pq); if (!ok) at[st][r] = 0.f; }
        }
#pragma unroll
        for (int ks = 0; ks < 4; ++ks) {
            const bf16x8 qt = *(LAS bf16x8*)(lds + GC_QT + (32 * pt + l31) * 144 + ks * 32 + hh * 16);
#pragma unroll
            for (int i = 0; i < 2; ++i) o[i] = __builtin_amdgcn_mfma_f32_32x32x16_bf16(sf[i][ks], qt, o[i], 0, 0, 0);
        }
#pragma unroll
        for (int st = 0; st < 2; ++st)
#pragma unroll
            for (int s2 = 0; s2 < 2; ++s2) {
                u32x4 pw = {pk2(at[st][8 * s2], at[st][8 * s2 + 1]), pk2(at[st][8 * s2 + 2], at[st][8 * s2 + 3]), pk2(at[st][8 * s2 + 4], at[st][8 * s2 + 5]), pk2(at[st][8 * s2 + 6], at[st][8 * s2 + 7])};
                const bf16x8 pf = __builtin_bit_cast(bf16x8, pw);
#pragma unroll
                for (int i = 0; i < 2; ++i) {
                    LAS unsigned char* vp = lds + GC_VT + (64 * vh + 32 * i + l31) * 136 + (32 * st + 16 * s2 + 4 * hh) * 2;
                    const u32x2 v0 = *(LAS u32x2*)vp, v1 = *(LAS u32x2*)(vp + 16);
                    u32x4 vw = {v0.x, v0.y, v1.x, v1.y};
                    o[i] = __builtin_amdgcn_mfma_f32_32x32x16_bf16(__builtin_bit_cast(bf16x8, vw), pf, o[i], 0, 0, 0);
                }
            }
        __syncthreads();
    }
    float ss = 0.f;
#pragma unroll
    for (int i = 0; i < 2; ++i)
#pragma unroll
        for (int r = 0; r < 16; ++r) ss += o[i][r] * o[i][r];
    ss = xhalf_sum(ss);
    LAS float* xch = (LAS float*)(lds + GC_XCH);
    if (hh == 0) xch[(pt * 2 + vh) * 32 + l31] = ss;
    __syncthreads();
    ss += xch[(pt * 2 + (1 - vh)) * 32 + l31];
    const float rstd = rsqrtf(ss * (1.f / 128.f) + EPS);
    const size_t trow = row0 + 32 * pt + l31;
    const bf16* gr = (const bf16*)(P.ws + WS_R3 + R3_GR) + trow * 512 + h * 128 + 64 * vh + 4 * hh;
    bf16* mx = (bf16*)(P.ws + WS_R2) + trow * 1024 + h * 128 + 64 * vh + 4 * hh;
    const float* gn = P.in[12] + 64 * vh + 4 * hh;
#pragma unroll
    for (int i = 0; i < 2; ++i)
#pragma unroll
        for (int g = 0; g < 4; ++g) {
            const u32x2 rw = *(const u32x2*)(gr + i * 32 + 8 * g); const f32x4 gg = *(const f32x4*)(gn + i * 32 + 8 * g);
            const float r0 = __uint_as_float(rw.x << 16), r1 = __uint_as_float(rw.x & 0xffff0000u), r2 = __uint_as_float(rw.y << 16), r3_ = __uint_as_float(rw.y & 0xffff0000u);
            const float y0 = o[i][4 * g] * rstd * gg.x * (r0 / (1.f + __expf(-r0))), y1 = o[i][4 * g + 1] * rstd * gg.y * (r1 / (1.f + __expf(-r1)));
            const float y2 = o[i][4 * g + 2] * rstd * gg.z * (r2 / (1.f + __expf(-r2))), y3 = o[i][4 * g + 3] * rstd * gg.w * (r3_ / (1.f + __expf(-r3_)));
            u32x2 v = {pk2(y0, y1), pk2(y2, y3)}; *(u32x2*)(mx + i * 32 + 8 * g) = v;
        }
    __syncthreads();
}
__device__ __forceinline__ void ph_gla_c(const Ptrs& P, LAS unsigned char* smem, int bid, int nblk) {
    for (int item = bid; item < 4 * 4 * 68; item += nblk) gla_pass_c_item(P, item, smem);
}

#define XB_TMO      128
#define XB_XCNT(j)  (256  + 64 * (j))
#define XB_XSUB(j)  (1280 + 64 * (j))
#define XB_XGEN(j)  (2304 + 64 * (j))
#define XB_TOP      3328
#define XB_TOPGEN   3392
#define XB_SPIN_CAP (1u << 20)
constexpr int CTL_BAR = 4096;
__device__ __forceinline__ unsigned xb_ld(unsigned* p) { return __hip_atomic_load(p, __ATOMIC_RELAXED, __HIP_MEMORY_SCOPE_AGENT); }
__device__ __forceinline__ unsigned xb_add(unsigned* p, unsigned v) { return __hip_atomic_fetch_add(p, v, __ATOMIC_RELAXED, __HIP_MEMORY_SCOPE_AGENT); }
__device__ __forceinline__ unsigned xb_xcc_id() { return (unsigned)__builtin_amdgcn_s_getreg((3 << 11) | 20) & 0xFu; }
#define XB_SPIN(cond, bar) do { unsigned _sp = 0; while (cond) { __builtin_amdgcn_s_sleep(1); \
    if ((++_sp & 255u) == 0u) { if (xb_ld(&(bar)[XB_TMO])) break; if (_sp > XB_SPIN_CAP) { atomicAdd(&(bar)[XB_TMO], 1u); break; } } } } while (0)
struct XcdBarrier { unsigned* bar; unsigned x; volatile LAS unsigned* st; };
__device__ __forceinline__ XcdBarrier xcd_barrier_post(unsigned* bar, volatile LAS unsigned* st) {
    XcdBarrier b; b.bar = bar; b.x = xb_xcc_id(); b.st = st;
    if (threadIdx.x == 0) (void)xb_add(&bar[XB_XCNT(b.x)], 1u);
    return b;
}
__device__ __forceinline__ void xcd_barrier_complete(unsigned* bar, unsigned x, unsigned& nloc, unsigned& nx) {
    const unsigned G = gridDim.x * gridDim.y * gridDim.z;
    unsigned sum, cnt, mine, sp = 0u;
    for (;;) {
        sum = 0u; cnt = 0u; mine = 0u;
#pragma unroll
        for (unsigned j = 0; j < 16; ++j) { const unsigned c = xb_ld(&bar[XB_XCNT(j)]); sum += c; cnt += (c > 0u) ? 1u : 0u; mine = (j == x) ? c : mine; }
        if (sum == G) break;
        __builtin_amdgcn_s_sleep(1);
        if ((++sp & 255u) == 0u) { if (xb_ld(&bar[XB_TMO])) break; if (sp > XB_SPIN_CAP) { atomicAdd(&bar[XB_TMO], 1u); break; } }
    }
    nloc = mine > 0u ? mine : 1u; nx = cnt > 0u ? cnt : 1u;
}
__device__ __forceinline__ void xcd_barrier(const XcdBarrier& b) {
    asm volatile("s_waitcnt vmcnt(0)" ::: "memory");
    __syncthreads();
    if (threadIdx.x == 0) {
        unsigned* bar = b.bar;
        __builtin_amdgcn_s_waitcnt(0);
        unsigned nloc = b.st[0], nx = b.st[1];
        if (nloc == 0u) { xcd_barrier_complete(bar, b.x, nloc, nx); b.st[0] = nloc; b.st[1] = nx; }
        const unsigned old = xb_add(&bar[XB_XSUB(b.x)], 1u);
        const unsigned gen = old / nloc;
        if (old + 1u == (gen + 1u) * nloc) {
            __builtin_amdgcn_fence(__ATOMIC_RELEASE, "agent");
            asm volatile("s_waitcnt vmcnt(0)" ::: "memory");
            const unsigned og = xb_add(&bar[XB_TOP], 1u);
            const unsigned tg = og / nx;
            if (og + 1u == (tg + 1u) * nx) xb_add(&bar[XB_TOPGEN], 1u);
            else XB_SPIN(xb_ld(&bar[XB_TOPGEN]) == tg, bar);
            __builtin_amdgcn_fence(__ATOMIC_ACQUIRE, "agent");
            xb_add(&bar[XB_XGEN(b.x)], 1u);
            asm volatile("s_waitcnt vmcnt(0)" ::: "memory");
        } else {
            XB_SPIN(xb_ld(&bar[XB_XGEN(b.x)]) == gen, bar);
            __builtin_amdgcn_fence(__ATOMIC_ACQUIRE, "agent");
            asm volatile("s_waitcnt vmcnt(0)" ::: "memory");
        }
    }
    __syncthreads();
}

constexpr int N_PHASES = 18;
constexpr int SMEM_BYTES = GEMM_LDS + 256;
struct Args { Ptrs P; int ph_lo, ph_hi; };
__global__ void __launch_bounds__(256, 2) fwd_megakernel(Args args) {
    __shared__ __attribute__((aligned(16))) unsigned char smem_raw[SMEM_BYTES];
    LAS unsigned char* smem = (LAS unsigned char*)smem_raw;
    const Ptrs& P = args.P;
    const int bid = blockIdx.x, nblk = gridDim.x;
    volatile LAS unsigned* bst = (volatile LAS unsigned*)(smem + GEMM_LDS + 128);
    if (threadIdx.x < 2) bst[threadIdx.x] = 0u;
    __syncthreads();
    XcdBarrier bar; bar.bar = (unsigned*)(P.ws + WS_CTL) + CTL_BAR; bar.x = 0; bar.st = bst;
    const bool multi = args.ph_hi - args.ph_lo > 1;
    if (multi) bar = xcd_barrier_post((unsigned*)(P.ws + WS_CTL) + CTL_BAR, bst);
    const int lo = args.ph_lo, hi = args.ph_hi;
#define PHASE(k, call) if (lo <= (k) && (k) < hi) { if ((k) > lo) xcd_barrier(bar); call; }
    PHASE(0, ph_prologue(P, smem, bid, nblk))
    PHASE(1, ph_modulate(P, 0, bid, nblk))
    PHASE(2, ph_even_inproj(P, smem, bid, nblk))
    PHASE(3, ph_gla_a(P, smem, bid, nblk))
    PHASE(4, gla_pass_b(P, bid * 256 + threadIdx.x, nblk * 256))
    PHASE(5, ph_gla_c(P, smem, bid, nblk))
    PHASE(6, ph_dense_attn(P, smem, bid, nblk))
    PHASE(7, ph_outproj(P, smem, bid, nblk, 0, NT))
    PHASE(8, ph_moe_route(P, smem, bid, nblk, 0, NT))
    PHASE(9, ph_moe_stage1(P, smem, bid, nblk, 0))
    PHASE(10, ph_moe_stage2(P, smem, bid, nblk, 0))
    PHASE(11, ph_modulate(P, 1, bid, nblk))
    PHASE(12, ph_odd_inproj(P, smem, bid, nblk))
    PHASE(13, ph_swa_attn(P, smem, bid, nblk))
    PHASE(14, ph_outproj(P, smem, bid, nblk, 1, NL))
    PHASE(15, ph_moe_route(P, smem, bid, nblk, 1, NL))
    PHASE(16, ph_moe_stage1(P, smem, bid, nblk, 1))
    PHASE(17, ph_moe_stage2(P, smem, bid, nblk, 1))
#undef PHASE
}

#ifndef MK_LAUNCHES
#define MK_LAUNCHES 1
#endif
extern "C" void kernel_launch(void* const* d_in, const int* in_sizes, int n_in, void* d_out, int out_size, void* d_ws, size_t ws_size, hipStream_t stream) {
    static int grid = 0;
    if (grid == 0) {
        int dev = 0, cus = 0, per_cu = 0;
        hipGetDevice(&dev);
        hipDeviceGetAttribute(&cus, hipDeviceAttributeMultiprocessorCount, dev);
        hipOccupancyMaxActiveBlocksPerMultiprocessor(&per_cu, (const void*)fwd_megakernel, 256, 0);
        if (per_cu > 2) per_cu = 2;
        if (per_cu < 1) per_cu = 1;
        grid = cus * per_cu;
    }
    hipMemsetAsync((unsigned char*)d_ws + WS_CTL, 0, 65536, stream);
    Args a{};
    for (int i = 0; i < 27; ++i) a.P.in[i] = (const float*)d_in[i];
    a.P.out = (float*)d_out; a.P.ws = (unsigned char*)d_ws;
#if MK_LAUNCHES == 1
    a.ph_lo = 0; a.ph_hi = N_PHASES;
    void* kargs[] = {&a};
    hipLaunchCooperativeKernel((const void*)fwd_megakernel, dim3(grid), dim3(256), kargs, 0, stream);
#else
    for (int ph = 0; ph < N_PHASES; ++ph) { a.ph_lo = ph; a.ph_hi = ph + 1; hipLaunchKernelGGL(fwd_megakernel, dim3(grid), dim3(256), 0, stream, a); }
#endif
}
```

```cpp
#include <hip/hip_runtime.h>
#include <stdint.h>

typedef unsigned short bf16;
__device__ __forceinline__ float bf2f(bf16 v) { return __uint_as_float(((unsigned)v) << 16); }
__device__ __forceinline__ bf16 f2bf(float f) { unsigned u = __float_as_uint(f); return (bf16)((u + 0x7fffu + ((u >> 16) & 1u)) >> 16); }

constexpr int D = 1024, NB = 4, S = 4096, CL = 256, NL = NB * S, NC = NB * CL, NT = NL + NC;
constexpr int EVEN_IN = 2336, ODD_IN = 1280;
constexpr float EPS = 1e-6f;

__device__ __forceinline__ float silu(float x) { return x / (1.f + expf(-x)); }
__device__ __forceinline__ float wave_sum(float v) {
#pragma unroll
    for (int o = 1; o < 64; o <<= 1) v += __shfl_xor(v, o);
    return v;
}

#define LAS __attribute__((address_space(3)))
typedef short bf16x8 __attribute__((ext_vector_type(8)));
typedef float f32x16 __attribute__((ext_vector_type(16)));
typedef float f32x4 __attribute__((ext_vector_type(4)));
typedef unsigned u32x4 __attribute__((ext_vector_type(4)));
typedef unsigned u32x2 __attribute__((ext_vector_type(2)));
typedef __bf16 bf16x2_t __attribute__((ext_vector_type(2)));
typedef float f32x2_t __attribute__((ext_vector_type(2)));
__device__ __forceinline__ unsigned pk2(float lo, float hi) { f32x2_t v = {lo, hi}; bf16x2_t b = __builtin_convertvector(v, bf16x2_t); return __builtin_bit_cast(unsigned, b); }
__device__ __forceinline__ float xhalf_sum(float x) {
    auto t = __builtin_amdgcn_permlane32_swap(__float_as_uint(x), __float_as_uint(x), false, false);
    return __uint_as_float(t[0]) + __uint_as_float(t[1]);
}

constexpr int NPAD_E = 2432;
constexpr int TILE_LDS = 128 * 128;
constexpr int GEMM_LDS = 4 * TILE_LDS;

__device__ __forceinline__ void transpose_item(const float* W, int K, int N, bf16* WT, int dst_row0, int k0, int n0, LAS float* scr, int lane) {
#pragma unroll 8
    for (int i = 0; i < 32; ++i) { const int kk = 2 * i + (lane >> 5); scr[kk * 33 + (lane & 31)] = W[(size_t)(k0 + kk) * N + n0 + (lane & 31)]; }
    asm volatile("s_waitcnt lgkmcnt(0)" ::: "memory");
    const int c = lane & 7;
#pragma unroll
    for (int j = 0; j < 4; ++j) {
        const int n = (lane >> 3) + 8 * j; const LAS float* s = scr + (8 * c) * 33 + n;
        u32x4 o; o.x = pk2(s[0 * 33], s[1 * 33]); o.y = pk2(s[2 * 33], s[3 * 33]); o.z = pk2(s[4 * 33], s[5 * 33]); o.w = pk2(s[6 * 33], s[7 * 33]);
        *(u32x4*)(WT + (size_t)(dst_row0 + n) * K + k0 + 8 * c) = o;
    }
    asm volatile("s_waitcnt lgkmcnt(0)" ::: "memory");
}

struct Ptrs {
    const float* in[27];
    float* out;
    unsigned char* ws;
};

constexpr size_t MiB = 1u << 20;
constexpr size_t WS_CTL = 0;
constexpr size_t WS_MODV = 1 * MiB;
constexpr size_t WS_ROPE = WS_MODV + 256 * 1024;
constexpr size_t WS_WINE = 2 * MiB;
constexpr size_t WS_WOUTE = WS_WINE + (size_t)NPAD_E * 1024 * 2;
constexpr size_t WS_WINO = WS_WOUTE + 2 * MiB;
constexpr size_t WS_WOUTO = WS_WINO + (size_t)1280 * 1024 * 2;
constexpr size_t WS_WGU = WS_WOUTO + 2 * MiB;
constexpr size_t WS_WD = WS_WGU + 32 * MiB;
constexpr size_t WS_CTXS = WS_WD + 16 * MiB;
constexpr size_t WS_R1 = 66 * MiB;
constexpr size_t WS_R4 = WS_R1 + 34 * MiB;
constexpr size_t WS_R2 = WS_R4 + 34 * MiB;
constexpr size_t WS_R3 = WS_R2 + 34 * MiB;
static_assert(WS_CTXS + 4 * MiB <= WS_R1, "ws map");
constexpr size_t R3_GQ = 0, R3_GK = R3_GQ + (size_t)NT * 256 * 2, R3_GV = R3_GK + (size_t)NT * 256 * 2, R3_GR = R3_GV + (size_t)NT * 512 * 2,
                 R3_LR = R3_GR + (size_t)NT * 512 * 2, R3_AQ = R3_LR + (size_t)NT * 32 * 4, R3_AK = R3_AQ + (size_t)NT * 512 * 2, R3_AV = R3_AK + (size_t)NT * 128 * 2,
                 R3_END = R3_AV + (size_t)NT * 128 * 2;
static_assert(WS_R3 + R3_END <= 256 * MiB, "ws map end");
constexpr size_t R3_OQ = 0, R3_OK = R3_OQ + (size_t)NL * 1024 * 2, R3_OV = R3_OK + (size_t)NT * 128 * 2;

__device__ __forceinline__ void ph_prologue(const Ptrs& P, LAS unsigned char* smem, int bid, int nblk) {
    const int lane = threadIdx.x & 63, wave = threadIdx.x >> 6;
    LAS float* scr = (LAS float*)smem + wave * 64 * 33;
    const int gw = bid * 4 + wave, NGW = nblk * 4;
    unsigned char* ws = P.ws;
    constexpr int I_WINE = 16 * 73, I_SQ = 16 * 32, I_WINO = 16 * 40, I_EXP_GU = 16 * 8, I_EXP_D = 4 * 32;
    constexpr int T_WINE = I_WINE, T_WOUTE = T_WINE + I_SQ, T_WINO = T_WOUTE + I_WINO, T_WOUTO = T_WINO + I_SQ,
                  T_G = T_WOUTO + 32 * I_EXP_GU, T_U = T_G + 32 * I_EXP_GU, T_D = T_U + 32 * I_EXP_D;
    for (int it = gw; it < T_D; it += NGW) {
        if (it < T_WINE) {
            int kb = it / 73, nb = it % 73, n0 = nb * 32;
            int dst = n0 < 1536 ? n0 : (n0 < 1568 ? n0 + 768 : n0 - 32);
            transpose_item(P.in[8], 1024, EVEN_IN, (bf16*)(ws + WS_WINE), dst, kb * 64, n0, scr, lane);
        } else if (it < T_WOUTE) { int r = it - T_WINE; transpose_item(P.in[9], 1024, 1024, (bf16*)(ws + WS_WOUTE), (r % 32) * 32, (r / 32) * 64, (r % 32) * 32, scr, lane); }
        else if (it < T_WINO) { int r = it - T_WOUTE; transpose_item(P.in[15], 1024, 1280, (bf16*)(ws + WS_WINO), (r % 40) * 32, (r / 40) * 64, (r % 40) * 32, scr, lane); }
        else if (it < T_WOUTO) { int r = it - T_WINO; transpose_item(P.in[16], 1024, 1024, (bf16*)(ws + WS_WOUTO), (r % 32) * 32, (r / 32) * 64, (r % 32) * 32, scr, lane); }
        else if (it < T_U) {
            bool up = it >= T_G; int r = it - (up ? T_G : T_WOUTO); int le = r / I_EXP_GU; r %= I_EXP_GU; int kb = r / 8, hb = r % 8;
            const float* W = (up ? P.in[25] : P.in[24]) + (size_t)le * 1024 * 256;
            transpose_item(W, 1024, 256, (bf16*)(ws + WS_WGU) + (size_t)le * 512 * 1024, 64 * hb + (up ? 32 : 0), kb * 64, hb * 32, scr, lane);
        } else {
            int r = it - T_U; int le = r / I_EXP_D; r %= I_EXP_D; int kb = r / 32, nb = r % 32;
            transpose_item(P.in[26] + (size_t)le * 256 * 1024, 256, 1024, (bf16*)(ws + WS_WD) + (size_t)le * 1024 * 256, nb * 32, kb * 64, nb * 32, scr, lane);
        }
    }
    { u32x4 z = {0, 0, 0, 0}; u32x4* p = (u32x4*)((bf16*)(ws + WS_WINE) + (size_t)EVEN_IN * 1024);
      for (int i = bid * 256 + threadIdx.x; i < 96 * 1024 * 2 / 16; i += nblk * 256) p[i] = z; }
    for (int i = bid * 256 + threadIdx.x; i < 1024; i += nblk * 256) {
        int pos = i >> 4, f = i & 15; float inv = powf(10000.f, -(float)(2 * f) / 32.f); float ang = (float)pos * inv;
        ((float2*)(ws + WS_ROPE))[i] = make_float2(cosf(ang), sinf(ang));
    }
    __syncthreads();
    {
        LAS float* sc = (LAS float*)smem;
        LAS float* red = (LAS float*)smem + 5 * 1024;
        for (int i = threadIdx.x; i < 5 * 1024; i += 256) { const float cv = i < 4096 ? P.in[1][i] : P.in[3][i - 4096]; sc[i] = cv / (1.f + expf(-cv)); }
        __syncthreads();
        for (int it = bid; it < 2 * 96; it += nblk) {
            const int layer = it / 96, col = (it % 96) * 64 + lane;
            const float* w = P.in[4] + (size_t)layer * D * 6144 + col;
            float a0 = 0.f, a1 = 0.f, a2 = 0.f, a3 = 0.f, a4 = 0.f;
#pragma unroll 8
            for (int k = 256 * wave; k < 256 * wave + 256; ++k) { const float wv = w[(size_t)k * 6144]; a0 += sc[k] * wv; a1 += sc[1024 + k] * wv; a2 += sc[2048 + k] * wv; a3 += sc[3072 + k] * wv; a4 += sc[4096 + k] * wv; }
            red[(wave * 5 + 0) * 64 + lane] = a0; red[(wave * 5 + 1) * 64 + lane] = a1; red[(wave * 5 + 2) * 64 + lane] = a2; red[(wave * 5 + 3) * 64 + lane] = a3; red[(wave * 5 + 4) * 64 + lane] = a4;
            __syncthreads();
            for (int i = threadIdx.x; i < 320; i += 256) { const int row = i >> 6, cl = i & 63;
                ((float*)(ws + WS_MODV))[((size_t)layer * 5 + row) * 6144 + (it % 96) * 64 + cl] = red[row * 64 + cl] + red[(5 + row) * 64 + cl] + red[(10 + row) * 64 + cl] + red[(15 + row) * 64 + cl] + P.in[5][layer * 6144 + (it % 96) * 64 + cl]; }
            __syncthreads();
        }
    }
}

__device__ __forceinline__ void modulate_rows(const float* xlat, const float* xctx, const float* modv_layer, const float* gain, int which, bf16* H, int nrows, int gw, int NGW, int lane) {
    for (int row = gw; row < nrows; row += NGW) {
        const float* xr = row < NL ? xlat + (size_t)row * D : xctx + (size_t)(row - NL) * D;
        const float* mv = modv_layer + (size_t)(row < NL ? row / S : 4) * 6144;
        f32x4 v[4]; float ss = 0.f;
#pragma unroll
        for (int j = 0; j < 4; ++j) { v[j] = *(const f32x4*)(xr + 4 * lane + 256 * j); ss += v[j].x * v[j].x + v[j].y * v[j].y + v[j].z * v[j].z + v[j].w * v[j].w; }
        float rstd = rsqrtf(wave_sum(ss) / D + EPS);
#pragma unroll
        for (int j = 0; j < 4; ++j) {
            int k = 4 * lane + 256 * j;
            f32x4 g = *(const f32x4*)(gain + k), sc = *(const f32x4*)(mv + (which + 1) * 1024 + k), sh = *(const f32x4*)(mv + which * 1024 + k);
            float h0 = v[j].x * rstd * g.x * (1.f + sc.x) + sh.x, h1 = v[j].y * rstd * g.y * (1.f + sc.y) + sh.y;
            float h2 = v[j].z * rstd * g.z * (1.f + sc.z) + sh.z, h3 = v[j].w * rstd * g.w * (1.f + sc.w) + sh.w;
            u32x2 o = {pk2(h0, h1), pk2(h2, h3)};
            *(u32x2*)(H + (size_t)row * D + k) = o;
        }
    }
}
__device__ __forceinline__ void route_tables(const Ptrs& P, int layer, int bid, int nblk);
__device__ __forceinline__ void ph_modulate(const Ptrs& P, int layer, int bid, int nblk) {
    route_tables(P, layer, bid, nblk);
    modulate_rows(layer ? P.out : P.in[0], layer ? (const float*)(P.ws + WS_CTXS) : P.in[2], (const float*)(P.ws + WS_MODV) + (size_t)layer * 5 * 6144, P.in[6] + layer * D, 0,
                  (bf16*)(P.ws + WS_R1), NT, bid * 4 + (threadIdx.x >> 6), nblk * 4, threadIdx.x & 63);
}

struct AffineRows {
    const bf16* base; size_t ld; const bf16* p0;
    __device__ __forceinline__ AffineRows(const bf16* b, size_t ld_) : base(b), ld(ld_), p0(b) {}
    __device__ __forceinline__ void init(int r0) { p0 = base + (size_t)r0 * ld; }
    __device__ __forceinline__ const bf16* ptr(int i, int kt) const { return p0 + (size_t)i * 8 * ld + kt * 64; }
};
template <bool SWP, class AF, class BF, class Epi>
__device__ __forceinline__ void gemm_tile(AF af, BF bf, int nk, LAS unsigned char* smem, const Epi& epi) {
    const int tid = threadIdx.x, lane = tid & 63, wave = tid >> 6, wn = wave & 1, wm = wave >> 1, l31 = lane & 31, hh = lane >> 5;
    const int r0 = wave * 32 + (lane >> 3);
    af.init(r0); bf.init(r0);
    __syncthreads();
    int coff[4];
#pragma unroll
    for (int i = 0; i < 4; ++i) coff[i] = ((lane & 7) ^ (((r0 >> 1) + 4 * i) & 7)) * 8;
#define GT_STAGE(st, kt) do { _Pragma("unroll") for (int i = 0; i < 4; ++i) { \
        __builtin_amdgcn_global_load_lds((const unsigned*)(af.ptr(i, (kt)) + coff[i]), (LAS unsigned*)(smem + (st) * 2 * TILE_LDS + (wave * 4 + i) * 1024), 16, 0, 0); \
        __builtin_amdgcn_global_load_lds((const unsigned*)(bf.ptr(i, (kt)) + coff[i]), (LAS unsigned*)(smem + (st) * 2 * TILE_LDS + TILE_LDS + (wave * 4 + i) * 1024), 16, 0, 0); } } while (0)
    GT_STAGE(0, 0);
    f32x16 acc[2][2];
#pragma unroll
    for (int i = 0; i < 2; ++i)
#pragma unroll
        for (int j = 0; j < 2; ++j)
#pragma unroll
            for (int r = 0; r < 16; ++r) acc[i][j][r] = 0.f;
    const int sw = (l31 >> 1) & 7;
    int xo[4], wo[4];
#pragma unroll
    for (int s = 0; s < 4; ++s) { const int cs = ((2 * s + hh) ^ sw) * 16; xo[s] = (wm * 64 + l31) * 128 + cs; wo[s] = TILE_LDS + (wn * 64 + l31) * 128 + cs; }
    asm volatile("s_waitcnt vmcnt(0)" ::: "memory");
    __syncthreads();
    for (int kt = 0; kt < nk; ++kt) {
        const int st = kt & 1;
        if (kt + 1 < nk) GT_STAGE(st ^ 1, kt + 1);
        LAS unsigned char* sb = smem + st * 2 * TILE_LDS;
#pragma unroll
        for (int s = 0; s < 4; ++s) {
            bf16x8 wf[2], xf[2];
#pragma unroll
            for (int i = 0; i < 2; ++i) wf[i] = *(LAS bf16x8*)(sb + wo[s] + i * 4096);
#pragma unroll
            for (int j = 0; j < 2; ++j) xf[j] = *(LAS bf16x8*)(sb + xo[s] + j * 4096);
#pragma unroll
            for (int i = 0; i < 2; ++i)
#pragma unroll
                for (int j = 0; j < 2; ++j) acc[i][j] = SWP ? __builtin_amdgcn_mfma_f32_32x32x16_bf16(xf[j], wf[i], acc[i][j], 0, 0, 0)
                                                            : __builtin_amdgcn_mfma_f32_32x32x16_bf16(wf[i], xf[j], acc[i][j], 0, 0, 0);
        }
        asm volatile("s_waitcnt vmcnt(0)" ::: "memory");
        __syncthreads();
    }
#undef GT_STAGE
    { int l31e = l31, hhe = hh, we = wave; asm volatile("" : "+v"(l31e), "+v"(hhe), "+v"(we));
      epi(acc, (we & 1) * 64, (we >> 1) * 64, l31e, hhe, smem + we * 16384); }
}

constexpr int SG_P = 144;
__device__ __forceinline__ void store_bf16_T(const f32x16 (&acc)[2][2], bf16* out, size_t ld, size_t trow0, int col0, int l31, int hh, LAS unsigned char* wl) {
#pragma unroll
    for (int j = 0; j < 2; ++j)
#pragma unroll
        for (int i = 0; i < 2; ++i)
#pragma unroll
            for (int g = 0; g < 4; ++g) { u32x2 v = {pk2(acc[i][j][4 * g], acc[i][j][4 * g + 1]), pk2(acc[i][j][4 * g + 2], acc[i][j][4 * g + 3])}; *(LAS u32x2*)(wl + (32 * j + l31) * SG_P + (32 * i + 8 * g + 4 * hh) * 2) = v; }
    const int lane = l31 + 32 * hh, rr = lane >> 3, ch = lane & 7;
#pragma unroll
    for (int q = 0; q < 8; ++q) { const int R = 8 * q + rr; const u32x4 v = *(LAS u32x4*)(wl + R * SG_P + ch * 16); *(u32x4*)(out + (trow0 + R) * ld + col0 + ch * 8) = v; }
}
__device__ __forceinline__ void qknorm_rope_T(f32x16 (&acc)[2][2], const float* gain, const float2* ropeT, bool latent, int tok0  , int l31, int hh) {
#pragma unroll
    for (int j = 0; j < 2; ++j) {
        float ss = 0.f;
#pragma unroll
        for (int i = 0; i < 2; ++i)
#pragma unroll
            for (int r = 0; r < 16; ++r) ss += acc[i][j][r] * acc[i][j][r];
        ss = xhalf_sum(ss);
        const float rstd = rsqrtf(ss * (1.f / 64.f) + EPS);
#pragma unroll
        for (int i = 0; i < 2; ++i)
#pragma unroll
            for (int r = 0; r < 16; ++r) acc[i][j][r] *= rstd * gain[i * 32 + (r & 3) + 8 * (r >> 2) + 4 * hh];
        if (latent) {
            const int t = tok0 + j * 32 + l31;
#pragma unroll
            for (int i = 0; i < 2; ++i) {
                const int pos = i == 0 ? (t >> 6) : (t & 63);
#pragma unroll
                for (int r = 0; r < 8; ++r) {
                    const int f = (r & 3) + 8 * (r >> 2) + 4 * hh;
                    const float2 cs = ropeT[pos * 16 + f];
                    const float x1 = acc[i][j][r], x2 = acc[i][j][r + 8];
                    acc[i][j][r] = x1 * cs.x - x2 * cs.y; acc[i][j][r + 8] = x2 * cs.x + x1 * cs.y;
                }
            }
        }
    }
}

constexpr int VT_LD = S + CL;
__device__ __forceinline__ void store_vt_swapped(const f32x16 (&acc)[2][2], bf16* vt_head  , int key0, int l31, int hh, LAS unsigned char* wl) {
#pragma unroll
    for (int i = 0; i < 2; ++i)
#pragma unroll
        for (int j = 0; j < 2; ++j)
#pragma unroll
            for (int g = 0; g < 4; ++g) { u32x2 v = {pk2(acc[i][j][4 * g], acc[i][j][4 * g + 1]), pk2(acc[i][j][4 * g + 2], acc[i][j][4 * g + 3])}; *(LAS u32x2*)(wl + (32 * i + l31) * SG_P + (32 * j + 8 * g + 4 * hh) * 2) = v; }
    const int lane = l31 + 32 * hh, rr = lane >> 3, ch = lane & 7;
#pragma unroll
    for (int q = 0; q < 8; ++q) { const int R = 8 * q + rr; const u32x4 v = *(LAS u32x4*)(wl + R * SG_P + ch * 16); *(u32x4*)(vt_head + (size_t)R * VT_LD + key0 + ch * 8) = v; }
}
template <class RowF>
__device__ __forceinline__ void rmw_f32_T(const f32x16 (&acc)[2][2], const RowF& rowf  , int l31, int hh, LAS unsigned char* wl) {
    const int lane = l31 + 32 * hh, rr = lane >> 4, ch = lane & 15;
#pragma unroll
    for (int j = 0; j < 2; ++j) {
#pragma unroll
        for (int i = 0; i < 2; ++i)
#pragma unroll
            for (int g = 0; g < 4; ++g) { f32x4 v = {acc[i][j][4 * g], acc[i][j][4 * g + 1], acc[i][j][4 * g + 2], acc[i][j][4 * g + 3]}; *(LAS f32x4*)(wl + l31 * 272 + (32 * i + 8 * g + 4 * hh) * 4) = v; }
#pragma unroll
        for (int q = 0; q < 8; ++q) {
            const int R = 4 * q + rr; const f32x4 a = *(LAS f32x4*)(wl + R * 272 + ch * 16);
            const float* sp; float* dp; const float* gp;
            if (rowf(32 * j + R, sp, dp, gp)) {
                const f32x4 xi = *(const f32x4*)(sp + ch * 4), gt = *(const f32x4*)(gp + ch * 4);
                f32x4 v = {xi.x + gt.x * a.x, xi.y + gt.y * a.y, xi.z + gt.z * a.z, xi.w + gt.w * a.w};
                *(f32x4*)(dp + ch * 4) = v;
            }
        }
    }
}
struct EpiEvenIn {
    unsigned char* r3; const float* qn; const float* kn; const float2* ropeT; int mt, nt;
    __device__ __forceinline__ bool swapped() const { return nt == 17 || (nt >= 4 && nt < 8); }
    __device__ __forceinline__ void operator()(f32x16 (&acc)[2][2], int fb, int tb, int l31, int hh, LAS unsigned char* wl) const {
        const size_t trow0 = (size_t)mt * 128 + tb; const bool latent = mt < NL / 128; const int tok0 = (int)(trow0 & (S - 1));
        if (swapped()) {
            const int b = latent ? (int)(trow0 / S) : (int)((trow0 - NL) / CL); const int key0 = latent ? tok0 : S + (int)((trow0 - NL) % CL);
            const size_t off = nt == 17 ? R3_AV + (size_t)(b * 2 + fb / 64) * 64 * VT_LD * 2 : R3_GV + ((size_t)(b * 4 + nt - 4) * 128 + fb) * VT_LD * 2;
            store_vt_swapped(acc, (bf16*)(r3 + off), key0, l31, hh, wl);
        } else if (nt == 18) {
            if (fb == 0) {
                float* LR = (float*)(r3 + R3_LR);
#pragma unroll
                for (int j = 0; j < 2; ++j)
#pragma unroll
                    for (int g = 0; g < 4; ++g) { f32x4 v = {acc[0][j][4 * g], acc[0][j][4 * g + 1], acc[0][j][4 * g + 2], acc[0][j][4 * g + 3]}; *(f32x4*)(LR + (trow0 + j * 32 + l31) * 32 + 8 * g + 4 * hh) = v; }
            }
        } else {
            size_t off; int ld, col;
            if (nt < 2) { off = R3_GQ; ld = 256; col = nt * 128; }
            else if (nt < 4) { off = R3_GK; ld = 256; col = (nt - 2) * 128; }
            else if (nt < 12) { off = R3_GR; ld = 512; col = (nt - 8) * 128; }
            else if (nt < 16) { off = R3_AQ; ld = 512; col = (nt - 12) * 128; }
            else { off = R3_AK; ld = 128; col = 0; }
            if (nt >= 12) qknorm_rope_T(acc, nt < 16 ? qn : kn, ropeT, latent, tok0, l31, hh);
            store_bf16_T(acc, (bf16*)(r3 + off), ld, trow0, col + fb, l31, hh, wl);
        }
    }
};
__device__ __forceinline__ int xcd_vid(int bid, int nb) { return (nb % 8 == 0) ? (bid % 8) * (nb / 8) + bid / 8 : bid; }

__device__ __forceinline__ void ph_even_inproj(const Ptrs& P, LAS unsigned char* smem, int bid, int nblk) {
    unsigned char* ws = P.ws;
    const int lrow = threadIdx.x >> 3, kc = threadIdx.x & 7;
    const int vid = xcd_vid(bid, nblk);
    for (int tile = vid; tile < (NT / 128) * 19; tile += nblk) {
        const int mt = tile / 19, nt = tile % 19;
        AffineRows af((const bf16*)(ws + WS_R1) + (size_t)mt * 128 * D, D);
        AffineRows bf_((const bf16*)(ws + WS_WINE) + (size_t)nt * 128 * D, D);
        EpiEvenIn epi{ws + WS_R3, P.in[13], P.in[14], (const float2*)(ws + WS_ROPE), mt, nt};
        if (epi.swapped()) gemm_tile<true>(af, bf_, D / 64, smem, epi); else gemm_tile<false>(af, bf_, D / 64, smem, epi);
    }
}

struct EpiOutProj {
    const float* modv_layer; const float* xin_lat; const float* xin_ctx; float* xout_lat; float* xout_ctx; int mt, nt;
    __device__ __forceinline__ bool swapped() const { return false; }
    __device__ __forceinline__ void operator()(f32x16 (&acc)[2][2], int fb, int tb, int l31, int hh, LAS unsigned char* wl) const {
        const size_t trow0 = (size_t)mt * 128 + tb; const bool latent = mt < NL / 128;
        const int c0 = nt * 128 + fb;
        const float* gate = modv_layer + (size_t)(latent ? trow0 / S : 4) * 6144 + 2 * 1024 + c0;
        const float* xin = (latent ? xin_lat + trow0 * D : xin_ctx + (trow0 - NL) * D) + c0;
        float* xout = (latent ? xout_lat + trow0 * D : xout_ctx + (trow0 - NL) * D) + c0;
        rmw_f32_T(acc, [&](int R, const float*& sp, float*& dp, const float*& gp) { sp = xin + (size_t)R * D; dp = xout + (size_t)R * D; gp = gate; return true; }, l31, hh, wl);
    }
};
__device__ __forceinline__ void ph_outproj(const Ptrs& P, LAS unsigned char* smem, int bid, int nblk, int layer, int nrows) {
    unsigned char* ws = P.ws;
    const int lrow = threadIdx.x >> 3, kc = threadIdx.x & 7;
    const int vid = xcd_vid(bid, nblk);
    const float* modv_layer = (const float*)(ws + WS_MODV) + (size_t)layer * 5 * 6144;
    for (int tile = vid; tile < (nrows / 128) * 8; tile += nblk) {
        const int mt = tile / 8, nt = tile % 8;
        AffineRows af((const bf16*)(ws + WS_R2) + (size_t)mt * 128 * D, D);
        AffineRows bf_((const bf16*)(ws + (layer ? WS_WOUTO : WS_WOUTE)) + (size_t)nt * 128 * D, D);
        EpiOutProj epi{modv_layer, layer ? P.out : P.in[0], layer ? (const float*)(ws + WS_CTXS) : P.in[2], P.out, (float*)(ws + WS_CTXS), mt, nt};
        gemm_tile<false>(af, bf_, D / 64, smem, epi);
    }
}

struct EpiOddIn {
    unsigned char* r3; const float* qn; const float* kn; const float2* ropeT; int mt, nt;
    __device__ __forceinline__ bool swapped() const { return nt == 9; }
    __device__ __forceinline__ void operator()(f32x16 (&acc)[2][2], int fb, int tb, int l31, int hh, LAS unsigned char* wl) const {
        const size_t trow0 = (size_t)mt * 128 + tb; const bool latent = mt < NL / 128; const int tok0 = (int)(trow0 & (S - 1));
        if (nt < 8) { if (latent) { qknorm_rope_T(acc, qn, ropeT, true, tok0, l31, hh); store_bf16_T(acc, (bf16*)(r3 + R3_OQ), 1024, trow0, nt * 128 + fb, l31, hh, wl); } }
        else if (nt == 8) { qknorm_rope_T(acc, kn, ropeT, latent, tok0, l31, hh); store_bf16_T(acc, (bf16*)(r3 + R3_OK), 128, trow0, fb, l31, hh, wl); }
        else {
            const int b = latent ? (int)(trow0 / S) : (int)((trow0 - NL) / CL); const int key0 = latent ? tok0 : S + (int)((trow0 - NL) % CL);
            store_vt_swapped(acc, (bf16*)(r3 + R3_OV) + (size_t)(b * 2 + fb / 64) * 64 * VT_LD, key0, l31, hh, wl);
        }
    }
};
__device__ __forceinline__ void ph_odd_inproj(const Ptrs& P, LAS unsigned char* smem, int bid, int nblk) {
    unsigned char* ws = P.ws;
    const int lrow = threadIdx.x >> 3, kc = threadIdx.x & 7;
    const int vid = xcd_vid(bid, nblk);
    constexpr int T_LAT = (NL / 128) * 10, T_ALL = T_LAT + (NC / 128) * 2;
    for (int tile = vid; tile < T_ALL; tile += nblk) {
        int mt, nt;
        if (tile < T_LAT) { mt = tile / 10; nt = tile % 10; } else { mt = NL / 128 + (tile - T_LAT) / 2; nt = 8 + (tile - T_LAT) % 2; }
        AffineRows af((const bf16*)(ws + WS_R1) + (size_t)mt * 128 * D, D);
        AffineRows bf_((const bf16*)(ws + WS_WINO) + (size_t)nt * 128 * D, D);
        EpiOddIn epi{ws + WS_R3, P.in[18], P.in[19], (const float2*)(ws + WS_ROPE), mt, nt};
        if (epi.swapped()) gemm_tile<true>(af, bf_, D / 64, smem, epi); else gemm_tile<false>(af, bf_, D / 64, smem, epi);
    }
}

constexpr int AT_KP = 144, AT_VP = 136;
constexpr int AT_STAGE = 64 * AT_KP + 64 * AT_VP;
constexpr int ATTN_LDS = 2 * AT_STAGE;
struct AttnArgs {
    const bf16* Q; int ldq; size_t qrow0; int qcol;
    const bf16* K; size_t klat0, kctx0;
    const bf16* Vt;
    int nctx, tlo, nlat;
    int banded, tq0;
    float sink_l2;
    bf16* out;
};
__device__ __forceinline__ float xhalf_max(float x) {
    auto t = __builtin_amdgcn_permlane32_swap(__float_as_uint(x), __float_as_uint(x), false, false);
    return fmaxf(__uint_as_float(t[0]), __uint_as_float(t[1]));
}
__device__ __forceinline__ void attn_block(const AttnArgs& a, LAS unsigned char* smem) {
    const int tid = threadIdx.x, lane = tid & 63, wave = tid >> 6, l31 = lane & 31, hh = lane >> 5;
    constexpr float C = 0.125f * 1.4426950408889634f;
    bf16x8 qf[4];
    { const bf16* qp = a.Q + (a.qrow0 + wave * 32 + l31) * a.ldq + a.qcol + hh * 8;
#pragma unroll
      for (int s = 0; s < 4; ++s) qf[s] = *(const bf16x8*)(qp + 16 * s); }
    f32x16 o[2];
#pragma unroll
    for (int dt = 0; dt < 2; ++dt)
#pragma unroll
        for (int r = 0; r < 16; ++r) o[dt][r] = 0.f;
    float m = -1e30f, lsum = 0.f;
    const int ntile = a.nctx + a.nlat;
    const int lr0 = tid >> 3, kc = tid & 7;
    u32x4 rk[2], rv[2];
#define AT_ISSUE(n) do { const int t_ = (n) < a.nctx ? 64 + (n) : a.tlo + (n) - a.nctx; \
        const bf16* kb_ = a.K + (t_ < 64 ? a.klat0 + 64 * t_ : a.kctx0 + 64 * (t_ - 64)) * 128 + kc * 8; const bf16* vb_ = a.Vt + 64 * t_ + kc * 8; \
        _Pragma("unroll") for (int i = 0; i < 2; ++i) { rk[i] = *(const u32x4*)(kb_ + (size_t)(lr0 + 32 * i) * 128); rv[i] = *(const u32x4*)(vb_ + (size_t)(lr0 + 32 * i) * VT_LD); } } while (0)
#define AT_COMMIT(st) do { LAS unsigned char* sb_ = smem + (st) * AT_STAGE; \
        _Pragma("unroll") for (int i = 0; i < 2; ++i) { *(LAS u32x4*)(sb_ + (lr0 + 32 * i) * AT_KP + kc * 16) = rk[i]; \
            LAS unsigned char* vp_ = sb_ + 64 * AT_KP + (lr0 + 32 * i) * AT_VP + kc * 16; u32x2 lo_ = {rv[i].x, rv[i].y}, hi_ = {rv[i].z, rv[i].w}; *(LAS u32x2*)vp_ = lo_; *(LAS u32x2*)(vp_ + 8) = hi_; } } while (0)
    AT_ISSUE(0); AT_COMMIT(0);
    __syncthreads();
    const int tq = a.tq0 + wave * 32 + l31;
    for (int n = 0; n < ntile; ++n) {
        const int st = n & 1;
        if (n + 1 < ntile) AT_ISSUE(n + 1);
        __builtin_amdgcn_sched_barrier(0);
        LAS unsigned char* sb = smem + st * AT_STAGE;
        f32x16 sc[2];
#pragma unroll
        for (int kt = 0; kt < 2; ++kt) {
#pragma unroll
            for (int r = 0; r < 16; ++r) sc[kt][r] = 0.f;
#pragma unroll
            for (int s = 0; s < 4; ++s) {
                const bf16x8 kf = *(LAS bf16x8*)(sb + (32 * kt + l31) * AT_KP + s * 32 + hh * 16);
                sc[kt] = __builtin_amdgcn_mfma_f32_32x32x16_bf16(kf, qf[s], sc[kt], 0, 0, 0);
            }
        }
        if (a.banded && n >= a.nctx) {
            const int t_ = a.tlo + n - a.nctx; const int dbase = 64 * t_ + 4 * hh - tq;
#pragma unroll
            for (int kt = 0; kt < 2; ++kt)
#pragma unroll
                for (int r = 0; r < 16; ++r) { const int df = dbase + 32 * kt + (r & 3) + 8 * (r >> 2); if (df > 128 || df < -128) sc[kt][r] = -1e30f; }
        }
        float mx = sc[0][0];
#pragma unroll
        for (int kt = 0; kt < 2; ++kt)
#pragma unroll
            for (int r = 0; r < 16; ++r) mx = fmaxf(mx, sc[kt][r]);
        mx = xhalf_max(mx);
        const float mnew = fmaxf(m, mx * C);
        const float alpha = __builtin_amdgcn_exp2f(m - mnew);
        m = mnew;
        float ps = 0.f;
#pragma unroll
        for (int kt = 0; kt < 2; ++kt)
#pragma unroll
            for (int r = 0; r < 16; ++r) { sc[kt][r] = __builtin_amdgcn_exp2f(fmaf(sc[kt][r], C, -mnew)); ps += sc[kt][r]; }
        lsum = lsum * alpha + ps;
#pragma unroll
        for (int dt = 0; dt < 2; ++dt)
#pragma unroll
            for (int r = 0; r < 16; ++r) o[dt][r] *= alpha;
#pragma unroll
        for (int kt = 0; kt < 2; ++kt)
#pragma unroll
            for (int s2 = 0; s2 < 2; ++s2) {
                u32x4 pw = {pk2(sc[kt][8 * s2], sc[kt][8 * s2 + 1]), pk2(sc[kt][8 * s2 + 2], sc[kt][8 * s2 + 3]), pk2(sc[kt][8 * s2 + 4], sc[kt][8 * s2 + 5]), pk2(sc[kt][8 * s2 + 6], sc[kt][8 * s2 + 7])};
                const bf16x8 pf = __builtin_bit_cast(bf16x8, pw);
#pragma unroll
                for (int dt = 0; dt < 2; ++dt) {
                    LAS unsigned char* vp = sb + 64 * AT_KP + (32 * dt + l31) * AT_VP + (32 * kt + 16 * s2 + 4 * hh) * 2;
                    const u32x2 v0 = *(LAS u32x2*)vp, v1 = *(LAS u32x2*)(vp + 16);
                    u32x4 vw = {v0.x, v0.y, v1.x, v1.y};
                    o[dt] = __builtin_amdgcn_mfma_f32_32x32x16_bf16(__builtin_bit_cast(bf16x8, vw), pf, o[dt], 0, 0, 0);
                }
            }
        __builtin_amdgcn_sched_barrier(0);
        if (n + 1 < ntile) AT_COMMIT(st ^ 1);
        __syncthreads();
    }
#undef AT_ISSUE
#undef AT_COMMIT
    float l = xhalf_sum(lsum) + __builtin_amdgcn_exp2f(a.sink_l2 - m);
    const float inv = 1.f / l;
    bf16* op = a.out + (a.qrow0 + wave * 32 + l31) * 1024 + 4 * hh;
#pragma unroll
    for (int dt = 0; dt < 2; ++dt)
#pragma unroll
        for (int g = 0; g < 4; ++g) { u32x2 v = {pk2(o[dt][4 * g] * inv, o[dt][4 * g + 1] * inv), pk2(o[dt][4 * g + 2] * inv, o[dt][4 * g + 3] * inv)}; *(u32x2*)(op + dt * 32 + 8 * g) = v; }
}

__device__ __forceinline__ void ph_dense_attn(const Ptrs& P, LAS unsigned char* smem, int bid, int nblk) {
    unsigned char* r3 = P.ws + WS_R3;
    const int vid = xcd_vid(bid, nblk);
    for (int item = vid; item < 1024 + 64; item += nblk) {
        AttnArgs a;
        int bh, qb; bool isctx = item >= 1024;
        if (!isctx) { bh = item >> 5; qb = item & 31; } else { bh = (item - 1024) >> 1; qb = (item - 1024) & 1; }
        const int hq = bh & 7, b = bh >> 3, kv = hq >> 2;
        a.Q = (const bf16*)(r3 + R3_AQ); a.ldq = 512; a.qcol = hq * 64;
        a.qrow0 = isctx ? (size_t)NL + b * CL + qb * 128 : (size_t)b * S + qb * 128;
        a.K = (const bf16*)(r3 + R3_AK) + kv * 64; a.klat0 = (size_t)b * S; a.kctx0 = (size_t)NL + b * CL;
        a.Vt = (const bf16*)(r3 + R3_AV) + (size_t)(b * 2 + kv) * 64 * VT_LD;
        a.nctx = 4; a.tlo = 0; a.nlat = isctx ? 0 : 64; a.banded = 0; a.tq0 = 0; a.sink_l2 = -INFINITY;
        a.out = (bf16*)(P.ws + WS_R2) + 512 + hq * 64;
        attn_block(a, smem);
    }
}
__device__ __forceinline__ void ph_swa_attn(const Ptrs& P, LAS unsigned char* smem, int bid, int nblk) {
    unsigned char* r3 = P.ws + WS_R3;
    const int vid = xcd_vid(bid, nblk);
    for (int item = vid; item < 2048; item += nblk) {
        AttnArgs a;
        const int bh = item >> 5, qb = item & 31, hq = bh & 15, b = bh >> 4, kv = hq >> 3;
        a.Q = (const bf16*)(r3 + R3_OQ); a.ldq = 1024; a.qcol = hq * 64; a.qrow0 = (size_t)b * S + qb * 128;
        a.K = (const bf16*)(r3 + R3_OK) + kv * 64; a.klat0 = (size_t)b * S; a.kctx0 = (size_t)NL + b * CL;
        a.Vt = (const bf16*)(r3 + R3_OV) + (size_t)(b * 2 + kv) * 64 * VT_LD;
        const int tlo = qb * 2 - 2 < 0 ? 0 : qb * 2 - 2, thi = qb * 2 + 3 > 63 ? 63 : qb * 2 + 3;
        a.nctx = 4; a.tlo = tlo; a.nlat = thi - tlo + 1; a.banded = 1; a.tq0 = qb * 128; a.sink_l2 = P.in[17][hq] * 1.4426950408889634f;
        a.out = (bf16*)(P.ws + WS_R2) + hq * 64;
        attn_block(a, smem);
    }
}

constexpr size_t WS_LIST = 247 * MiB;
constexpr size_t WS_WTS = WS_LIST + (size_t)24 * NT * 4;
constexpr size_t WS_END_ALL = WS_WTS + (size_t)NT * 2 * 4;
static_assert(WS_R3 + R3_END <= WS_LIST && WS_END_ALL <= 256 * MiB, "ws map tail");
constexpr int CTL_CNT = 8192;
constexpr int MOE_MAXT = NT / 128 + 24;

constexpr size_t WS_WRT = 250 * MiB, WS_SL = 251 * MiB;
typedef float f32x4v __attribute__((ext_vector_type(4)));
__device__ __forceinline__ void route_tables(const Ptrs& P, int layer, int bid, int nblk) {
    unsigned char* ws = P.ws;
    const float* mvl = (const float*)(ws + WS_MODV) + (size_t)layer * 5 * 6144;
    const float* gain = P.in[7] + layer * D;
    const float* wg = P.in[20] + (size_t)layer * D * 4; const float* bg = P.in[21] + layer * 4;
    const float* we = P.in[22] + (size_t)layer * D * 16; const float* be = P.in[23] + layer * 16;
    bf16* wrt = (bf16*)(ws + WS_WRT);
    for (int e = bid * 256 + threadIdx.x; e < 5 * 32 * 1024; e += nblk * 256) {
        const int k = e & 1023, r = (e >> 10) & 31, br = e >> 15;
        const float a = gain[k] * (1.f + mvl[(size_t)br * 6144 + 4 * 1024 + k]);
        const float w = (r < 16 ? wg[k * 4 + (r & 3)] : we[k * 16 + r - 16]) * a;
        const bf16 hi = f2bf(w); const bf16 lo = f2bf(w - bf2f(hi));
        wrt[((size_t)(br * 2 + 0) * 32 + r) * 1024 + k] = hi; wrt[((size_t)(br * 2 + 1) * 32 + r) * 1024 + k] = lo;
    }
    const int gw = bid * 4 + (threadIdx.x >> 6), lane = threadIdx.x & 63;
    if (gw < 160) {
        const int r = gw & 31, br = gw >> 5; float s = 0.f;
        for (int k = lane; k < 1024; k += 64) s += mvl[(size_t)br * 6144 + 3 * 1024 + k] * (r < 16 ? wg[k * 4 + (r & 3)] : we[k * 16 + r - 16]);
        s = wave_sum(s);
        if (lane == 0) ((float*)(ws + WS_SL))[br * 32 + r] = s + (r < 16 ? bg[r & 3] : be[r - 16]);
    }
}
typedef float f32x4a __attribute__((ext_vector_type(4)));
__device__ __forceinline__ float xq_sum(float x) {
    x += __shfl_xor(x, 16); x += __shfl_xor(x, 32); return x;
}
__device__ __forceinline__ void ph_moe_route(const Ptrs& P, LAS unsigned char* smem, int bid, int nblk, int layer, int nrows) {
    unsigned char* ws = P.ws;
    const int tid = threadIdx.x, lane = tid & 63, wave = tid >> 6, tk = lane & 15, kq = lane >> 4;
    const float* modv_layer = (const float*)(ws + WS_MODV) + (size_t)layer * 5 * 6144;
    const float* gain = P.in[7] + layer * D;
    const float* xlat = P.out; const float* xctx = (const float*)(ws + WS_CTXS);
    bf16* H = (bf16*)(ws + WS_R1);
    int* cnt = (int*)(ws + WS_CTL) + CTL_CNT + layer * 2048; int* list = (int*)(ws + WS_LIST); float* wts = (float*)(ws + WS_WTS);
    LAS float* part = (LAS float*)smem;
    for (int task = xcd_vid(bid, nblk); task < nrows / 16; task += nblk) {
        const int row0 = task * 16; const int row = row0 + tk;
        const int br = row0 < NL ? row0 / S : 4;
        const float* xr = row < NL ? xlat + (size_t)row * D : xctx + (size_t)(row - NL) * D;
        const bf16* wt = (const bf16*)(ws + WS_WRT) + (size_t)br * 2 * 32 * 1024;
        f32x4a acc0 = {0.f, 0.f, 0.f, 0.f}, acc1 = {0.f, 0.f, 0.f, 0.f};
        float ss = 0.f;
#pragma unroll 4
        for (int s = 8 * wave; s < 8 * wave + 8; ++s) {
            const int k = 32 * s + 8 * kq;
            const f32x4 x0 = *(const f32x4*)(xr + k), x1 = *(const f32x4*)(xr + k + 4);
            ss += x0.x * x0.x + x0.y * x0.y + x0.z * x0.z + x0.w * x0.w + x1.x * x1.x + x1.y * x1.y + x1.z * x1.z + x1.w * x1.w;
            const unsigned h0 = pk2(x0.x, x0.y), h1 = pk2(x0.z, x0.w), h2 = pk2(x1.x, x1.y), h3 = pk2(x1.z, x1.w);
            const unsigned l0 = pk2(x0.x - __uint_as_float(h0 << 16), x0.y - __uint_as_float(h0 & 0xffff0000u)), l1 = pk2(x0.z - __uint_as_float(h1 << 16), x0.w - __uint_as_float(h1 & 0xffff0000u));
            const unsigned l2 = pk2(x1.x - __uint_as_float(h2 << 16), x1.y - __uint_as_float(h2 & 0xffff0000u)), l3 = pk2(x1.z - __uint_as_float(h3 << 16), x1.w - __uint_as_float(h3 & 0xffff0000u));
            u32x4 xh = {h0, h1, h2, h3}, xl = {l0, l1, l2, l3};
            const bf16x8 bh = __builtin_bit_cast(bf16x8, xh), bl = __builtin_bit_cast(bf16x8, xl);
            const bf16x8 a0h = *(const bf16x8*)(wt + (size_t)tk * 1024 + k), a1h = *(const bf16x8*)(wt + (size_t)(16 + tk) * 1024 + k);
            const bf16x8 a0l = *(const bf16x8*)(wt + (size_t)(32 + tk) * 1024 + k), a1l = *(const bf16x8*)(wt + (size_t)(48 + tk) * 1024 + k);
            acc0 = __builtin_amdgcn_mfma_f32_16x16x32_bf16(a0h, bh, acc0, 0, 0, 0); acc1 = __builtin_amdgcn_mfma_f32_16x16x32_bf16(a1h, bh, acc1, 0, 0, 0);
            acc0 = __builtin_amdgcn_mfma_f32_16x16x32_bf16(a0h, bl, acc0, 0, 0, 0); acc1 = __builtin_amdgcn_mfma_f32_16x16x32_bf16(a1h, bl, acc1, 0, 0, 0);
            acc0 = __builtin_amdgcn_mfma_f32_16x16x32_bf16(a0l, bh, acc0, 0, 0, 0); acc1 = __builtin_amdgcn_mfma_f32_16x16x32_bf16(a1l, bh, acc1, 0, 0, 0);
        }
#pragma unroll
        for (int j = 0; j < 4; ++j) { part[(wave * 9 + j) * 64 + lane] = acc0[j]; part[(wave * 9 + 4 + j) * 64 + lane] = acc1[j]; }
        part[(wave * 9 + 8) * 64 + lane] = ss;
        __syncthreads();
        float tot[9];
#pragma unroll
        for (int j = 0; j < 9; ++j) tot[j] = (part[j * 64 + lane] + part[(9 + j) * 64 + lane]) + (part[(18 + j) * 64 + lane] + part[(27 + j) * 64 + lane]);
        const float rstd = rsqrtf(xq_sum(tot[8]) * (1.f / D) + EPS);
        if (wave == 0) {
            const float* sl = (const float*)(ws + WS_SL) + br * 32;
            float gl[4], el[4];
#pragma unroll
            for (int j = 0; j < 4; ++j) { gl[j] = tot[j] * rstd + sl[j]; el[j] = tot[4 + j] * rstd + sl[16 + 4 * kq + j]; }
            int gi = 0; float gm = gl[0];
#pragma unroll
            for (int j = 1; j < 4; ++j) if (gl[j] > gm) { gm = gl[j]; gi = j; }
            if (gi == kq) {
                float gs = 0.f;
#pragma unroll
                for (int j = 0; j < 4; ++j) gs += expf(gl[j] - gm);
                const float gwt = 1.f / gs;
                int i0 = 0; float e0 = el[0];
#pragma unroll
                for (int j = 1; j < 4; ++j) if (el[j] > e0) { e0 = el[j]; i0 = j; }
                int i1 = -1; float e1 = -INFINITY;
#pragma unroll
                for (int j = 0; j < 4; ++j) if (j != i0 && el[j] > e1) { e1 = el[j]; i1 = j; }
                const float p1 = expf(e1 - e0); const float w0 = gwt / (1.f + p1), w1 = gwt * p1 / (1.f + p1);
                const int ea = i0 < i1 ? i0 : i1, eb = i0 < i1 ? i1 : i0;
                const int pidx = ea == 0 ? eb - 1 : (ea == 1 ? eb + 1 : 5);
                const int cls = gi * 6 + pidx;
                wts[(size_t)row * 2] = i0 < i1 ? w0 : w1; wts[(size_t)row * 2 + 1] = i0 < i1 ? w1 : w0;
                const int pos = atomicAdd(&cnt[cls * 64], 1);
                list[(size_t)cls * NT + pos] = row;
            }
        }
        const float* mv = modv_layer + (size_t)br * 6144;
        float rs[4];
#pragma unroll
        for (int r = 0; r < 4; ++r) rs[r] = __shfl(rstd, 4 * wave + r);
        f32x4 xv[4][4];
#pragma unroll
        for (int r = 0; r < 4; ++r) {
            const int rr = row0 + 4 * wave + r;
            const float* xp = (rr < NL ? xlat + (size_t)rr * D : xctx + (size_t)(rr - NL) * D) + 4 * lane;
#pragma unroll
            for (int jq = 0; jq < 4; ++jq) xv[r][jq] = *(const f32x4*)(xp + 256 * jq);
        }
#pragma unroll
        for (int jq = 0; jq < 4; ++jq) {
            const int k = 4 * lane + 256 * jq;
            const f32x4 g = *(const f32x4*)(gain + k), sc = *(const f32x4*)(mv + 4 * 1024 + k), sh = *(const f32x4*)(mv + 3 * 1024 + k);
            const f32x4 a = {g.x * (1.f + sc.x), g.y * (1.f + sc.y), g.z * (1.f + sc.z), g.w * (1.f + sc.w)};
#pragma unroll
            for (int r = 0; r < 4; ++r) {
                const f32x4 x = xv[r][jq];
                u32x2 o = {pk2(x.x * rs[r] * a.x + sh.x, x.y * rs[r] * a.y + sh.y), pk2(x.z * rs[r] * a.z + sh.z, x.w * rs[r] * a.w + sh.w)};
                *(u32x2*)(H + (size_t)(row0 + 4 * wave + r) * D + k) = o;
            }
        }
        __syncthreads();
    }
}

__device__ __forceinline__ void moe_tiles_init(const int* cnt, LAS int* tile0) {
    if (threadIdx.x == 0) { int a = 0; for (int c = 0; c < 24; ++c) { tile0[c] = a; a += (cnt[c * 64] + 127) >> 7; } tile0[24] = a; }
    __syncthreads();
}
struct GatherRows {
    const bf16* H; const int* lst; int n; const bf16* p[4];
    __device__ __forceinline__ void init(int r0) {
#pragma unroll
        for (int i = 0; i < 4; ++i) { const int r = r0 + 8 * i; p[i] = H + (size_t)lst[r < n ? r : 0] * D; }
    }
    __device__ __forceinline__ const bf16* ptr(int i, int kt) const { return p[i] + kt * 64; }
};
struct SplitKRows {
    const bf16* b0; const bf16* b1; size_t ld; int ksplit; const bf16* p0; const bf16* p1;
    __device__ __forceinline__ SplitKRows(const bf16* b0_, const bf16* b1_, size_t ld_, int ksplit_) : b0(b0_), b1(b1_), ld(ld_), ksplit(ksplit_), p0(b0_), p1(b1_) {}
    __device__ __forceinline__ void init(int r0) { p0 = b0 + (size_t)r0 * ld; p1 = b1 + (size_t)r0 * ld; }
    __device__ __forceinline__ const bf16* ptr(int i, int kt) const { return (kt < ksplit ? p0 + kt * 64 : p1 + (kt - ksplit) * 64) + (size_t)i * 8 * ld; }
};
struct EpiMoe1 {
    bf16* hid; const int* lst; int n; const float* wts; int nt;
    __device__ __forceinline__ bool swapped() const { return false; }
    __device__ __forceinline__ void operator()(f32x16 (&acc)[2][2], int fb, int tb, int l31, int hh, LAS unsigned char* wl) const {
        const int col = (nt >> 2) * 256 + 32 * (2 * (nt & 3) + (fb >> 6));
#pragma unroll
        for (int j = 0; j < 2; ++j) {
            const int r = tb + j * 32 + l31;
            const int tok = lst[r < n ? r : 0];
            const float w = wts[(size_t)tok * 2 + (nt >> 2)];
#pragma unroll
            for (int g = 0; g < 4; ++g) {
                float hv[4];
#pragma unroll
                for (int e = 0; e < 4; ++e) { const float a_ = acc[0][j][4 * g + e], u_ = acc[1][j][4 * g + e]; hv[e] = a_ / (1.f + __expf(-a_)) * u_ * w; }
                u32x2 v = {pk2(hv[0], hv[1]), pk2(hv[2], hv[3])}; *(LAS u32x2*)(wl + (32 * j + l31) * 80 + (8 * g + 4 * hh) * 2) = v;
            }
        }
        const int lane = l31 + 32 * hh, rr = lane >> 2, ch = lane & 3;
#pragma unroll
        for (int q = 0; q < 4; ++q) { const int R = 16 * q + rr; const u32x4 v = *(LAS u32x4*)(wl + R * 80 + ch * 16); *(u32x4*)(hid + (size_t)(tb + R) * 512 + col + ch * 8) = v; }
    }
};
__device__ __forceinline__ void ph_moe_stage1(const Ptrs& P, LAS unsigned char* smem, int bid, int nblk, int layer) {
    unsigned char* ws = P.ws;
    const int* cnt = (const int*)(ws + WS_CTL) + CTL_CNT + layer * 2048; const int* list = (const int*)(ws + WS_LIST);
    LAS int* tile0 = (LAS int*)(smem + GEMM_LDS);
    moe_tiles_init(cnt, tile0);
    const int lrow = threadIdx.x >> 3, kc = threadIdx.x & 7;
    const bf16* H = (const bf16*)(ws + WS_R1);
    const int nitems = tile0[24] * 8;
    for (int item = bid; item < nitems; item += nblk) {
        const int tt = item >> 3, nt = item & 7;
        int c = 0; while (tile0[c + 1] <= tt) ++c;
        const int lt = tt - tile0[c], n = min(128, cnt[c * 64] - lt * 128);
        const int* lst = list + (size_t)c * NT + lt * 128;
        const int g = c / 6, pidx = c % 6; const int ea = pidx < 3 ? 0 : (pidx < 5 ? 1 : 2), eb = pidx < 3 ? pidx + 1 : (pidx < 5 ? pidx - 1 : 3);
        const int expert = g * 4 + (nt < 4 ? ea : eb);
        GatherRows af{H, lst, n, {nullptr, nullptr, nullptr, nullptr}};
        AffineRows bf_((const bf16*)(ws + WS_WGU) + ((size_t)(layer * 16 + expert) * 512 + (nt & 3) * 128) * D, D);
        EpiMoe1 epi{(bf16*)(ws + WS_R3) + (size_t)tt * 128 * 512, lst, n, (const float*)(ws + WS_WTS), nt};
        gemm_tile<false>(af, bf_, D / 64, smem, epi);
    }
}
struct EpiMoe2 {
    float* xlat; float* xctx; const float* modv_layer; const int* lst; int n; int nt;
    __device__ __forceinline__ bool swapped() const { return false; }
    __device__ __forceinline__ void operator()(f32x16 (&acc)[2][2], int fb, int tb, int l31, int hh, LAS unsigned char* wl) const {
        const int c0 = nt * 128 + fb;
        rmw_f32_T(acc, [&](int R, const float*& sp, float*& dp, const float*& gp) {
            const int r = tb + R; if (r >= n) return false;
            const int tok = lst[r];
            float* xr = (tok < NL ? xlat + (size_t)tok * D : xctx + (size_t)(tok - NL) * D) + c0;
            sp = xr; dp = xr; gp = modv_layer + (size_t)(tok < NL ? tok / S : 4) * 6144 + 5 * 1024 + c0; return true; }, l31, hh, wl);
    }
};
__device__ __forceinline__ void ph_moe_stage2(const Ptrs& P, LAS unsigned char* smem, int bid, int nblk, int layer) {
    unsigned char* ws = P.ws;
    const int* cnt = (const int*)(ws + WS_CTL) + CTL_CNT + layer * 2048; const int* list = (const int*)(ws + WS_LIST);
    LAS int* tile0 = (LAS int*)(smem + GEMM_LDS);
    moe_tiles_init(cnt, tile0);
    const int lrow = threadIdx.x >> 3, kc = threadIdx.x & 7;
    const int nitems = tile0[24] * 8;
    for (int item = bid; item < nitems; item += nblk) {
        const int tt = item >> 3, nt = item & 7;
        int c = 0; while (tile0[c + 1] <= tt) ++c;
        const int lt = tt - tile0[c], n = min(128, cnt[c * 64] - lt * 128);
        const int* lst = list + (size_t)c * NT + lt * 128;
        const int g = c / 6, pidx = c % 6; const int ea = pidx < 3 ? 0 : (pidx < 5 ? 1 : 2), eb = pidx < 3 ? pidx + 1 : (pidx < 5 ? pidx - 1 : 3);
        AffineRows af((const bf16*)(ws + WS_R3) + (size_t)tt * 128 * 512, 512);
        const bf16* wd = (const bf16*)(ws + WS_WD);
        SplitKRows bf_(wd + ((size_t)(layer * 16 + g * 4 + ea) * 1024 + nt * 128) * 256, wd + ((size_t)(layer * 16 + g * 4 + eb) * 1024 + nt * 128) * 256, 256, 4);
        EpiMoe2 epi{P.out, (float*)(ws + WS_CTXS), (const float*)(ws + WS_MODV) + (size_t)layer * 5 * 6144, lst, n, nt};
        gemm_tile<false>(af, bf_, 8, smem, epi);
    }
}

constexpr size_t GLA_ST = 8192;
constexpr size_t WS_DEC = WS_WTS + (size_t)NT * 2 * 4;
static_assert(WS_DEC + (size_t)32 * 68 * 64 * 4 <= 256 * MiB, "ws dec");
__device__ __forceinline__ void gla_chunk_geom(int b, int M, size_t& row0, int& vcol0, int& c0, int& c1) {
    if (M < 4) { row0 = (size_t)NL + b * CL + 64 * M; vcol0 = S + 64 * M; c0 = M; c1 = 3 - M; }
    else { const int Ml = M - 4; row0 = (size_t)b * S + 64 * Ml; vcol0 = 64 * Ml; c0 = 4 + Ml; c1 = 4 + 63 - Ml; }
}
template <bool PASS_C>
__device__ __forceinline__ float gla_prep(const Ptrs& P, int h, int dir, size_t row0, LAS unsigned char* lds, int off_lrs, int off_tot) {
    const int tid = threadIdx.x, k = tid & 63, grp = tid >> 6;
    const unsigned char* r3 = P.ws + WS_R3;
    LAS float* lrs = (LAS float*)(lds + off_lrs); LAS float* tot = (LAS float*)(lds + off_tot);
    { const float* LR = (const float*)(r3 + R3_LR); *(LAS f32x4*)(lrs + tid * 4) = *(const f32x4*)(LR + (row0 + (tid >> 2)) * 32 + dir * 16 + (tid & 3) * 4); }
    float gw[16];
#pragma unroll
    for (int r = 0; r < 16; ++r) gw[r] = P.in[10][(dir * 16 + r) * 256 + h * 64 + k];
    const float gb = P.in[11][dir * 256 + h * 64 + k];
    __syncthreads();
    float gl[16];
#pragma unroll
    for (int j = 0; j < 16; ++j) {
        const int p = 16 * grp + j; float z = gb;
#pragma unroll
        for (int r4 = 0; r4 < 4; ++r4) { const f32x4 l4 = *(LAS f32x4*)(lrs + p * 16 + r4 * 4); z += l4.x * gw[4 * r4] + l4.y * gw[4 * r4 + 1] + l4.z * gw[4 * r4 + 2] + l4.w * gw[4 * r4 + 3]; }
        gl[j] = (fminf(z, 0.f) - __logf(1.f + __expf(-fabsf(z)))) * (1.f / 16.f);
    }
    if (dir == 0) {
#pragma unroll
        for (int j = 1; j < 16; ++j) gl[j] += gl[j - 1];
        tot[grp * 64 + k] = gl[15];
    } else {
#pragma unroll
        for (int j = 14; j >= 0; --j) gl[j] += gl[j + 1];
        tot[grp * 64 + k] = gl[0];
    }
    __syncthreads();
    const float t0 = tot[k], t1 = tot[64 + k], t2 = tot[128 + k], t3 = tot[192 + k];
    const float bend = t0 + t1 + t2 + t3;
    float offs;
    if (dir == 0) offs = grp == 0 ? 0.f : grp == 1 ? t0 : grp == 2 ? t0 + t1 : t0 + t1 + t2;
    else offs = grp == 3 ? 0.f : grp == 2 ? t3 : grp == 1 ? t3 + t2 : t3 + t2 + t1;
    const bf16* GQ = (const bf16*)(r3 + R3_GQ); const bf16* GK = (const bf16*)(r3 + R3_GK);
    if (PASS_C) {
#pragma unroll
        for (int j = 0; j < 16; ++j) {
            const int p = 16 * grp + j; const float bp = gl[j] + offs;
            const float q = bf2f(GQ[(row0 + p) * 256 + h * 64 + k]) * 0.125f, kk = bf2f(GK[(row0 + p) * 256 + h * 64 + k]);
            *(LAS bf16*)(lds + p * 144 + k * 2) = f2bf(q * __expf(bp));
            *(LAS bf16*)(lds + 9216 + p * 144 + k * 2) = f2bf(q * __expf(bp - bend));
            *(LAS bf16*)(lds + 18432 + p * 144 + k * 2) = f2bf(kk * __expf(bend - bp));
        }
    } else {
        float kt[16];
#pragma unroll
        for (int j = 0; j < 16; ++j) { const int p = 16 * grp + j; const float bp = gl[j] + offs; kt[j] = bf2f(GK[(row0 + p) * 256 + h * 64 + k]) * __expf(bend - bp); }
        u32x4 w0 = {pk2(kt[0], kt[1]), pk2(kt[2], kt[3]), pk2(kt[4], kt[5]), pk2(kt[6], kt[7])}, w1 = {pk2(kt[8], kt[9]), pk2(kt[10], kt[11]), pk2(kt[12], kt[13]), pk2(kt[14], kt[15])};
        *(LAS u32x4*)(lds + k * 144 + grp * 32) = w0; *(LAS u32x4*)(lds + k * 144 + grp * 32 + 16) = w1;
    }
    return __expf(bend);
}

constexpr int GA_KTT = 0, GA_VT = 9216, GA_LRS = GA_VT + 128 * 144, GA_TOT = GA_LRS + 4096, GLA_A_LDS = GA_TOT + 1024;
__device__ __forceinline__ void gla_pass_a_item(const Ptrs& P, int item, LAS unsigned char* lds) {
    const int tid = threadIdx.x, lane = tid & 63, wave = tid >> 6, l31 = lane & 31, hh = lane >> 5;
    const int M = item % 68, dir = (item / 68) & 1, h = (item / 136) & 3, b = item / 544;
    size_t row0; int vcol0, c0, c1; gla_chunk_geom(b, M, row0, vcol0, c0, c1);
    const int sidx = ((b * 4 + h) * 2 + dir) * 68 + (dir ? c1 : c0);
    { const bf16* gvt = (const bf16*)(P.ws + WS_R3 + R3_GV) + (size_t)(b * 4 + h) * 128 * VT_LD + vcol0;
#pragma unroll
      for (int i = 0; i < 4; ++i) { const int c = tid + 256 * i, v = c >> 3, kc = c & 7; *(LAS u32x4*)(lds + GA_VT + v * 144 + kc * 16) = *(const u32x4*)(gvt + (size_t)v * VT_LD + kc * 8); } }
    const float dec = gla_prep<false>(P, h, dir, row0, lds, GA_LRS, GA_TOT);
    if (tid < 64) ((float*)(P.ws + WS_DEC))[(size_t)sidx * 64 + tid] = dec;
    __syncthreads();
    f32x16 acc[2];
#pragma unroll
    for (int kt = 0; kt < 2; ++kt)
#pragma unroll
        for (int r = 0; r < 16; ++r) acc[kt][r] = 0.f;
#pragma unroll
    for (int ps = 0; ps < 4; ++ps) {
        const bf16x8 vf = *(LAS bf16x8*)(lds + GA_VT + (32 * wave + l31) * 144 + ps * 32 + hh * 16);
#pragma unroll
        for (int kt = 0; kt < 2; ++kt) { const bf16x8 kf = *(LAS bf16x8*)(lds + GA_KTT + (32 * kt + l31) * 144 + ps * 32 + hh * 16); acc[kt] = __builtin_amdgcn_mfma_f32_32x32x16_bf16(kf, vf, acc[kt], 0, 0, 0); }
    }
    bf16* ds = (bf16*)(P.ws + WS_R1) + (size_t)sidx * GLA_ST + (size_t)(32 * wave + l31) * 64 + 4 * hh;
#pragma unroll
    for (int kt = 0; kt < 2; ++kt)
#pragma unroll
        for (int g = 0; g < 4; ++g) { u32x2 v = {pk2(acc[kt][4 * g], acc[kt][4 * g + 1]), pk2(acc[kt][4 * g + 2], acc[kt][4 * g + 3])}; *(u32x2*)(ds + kt * 32 + 8 * g) = v; }
    __syncthreads();
}
__device__ __forceinline__ void ph_gla_a(const Ptrs& P, LAS unsigned char* smem, int bid, int nblk) {
    for (int item = bid; item < 4 * 4 * 2 * 68; item += nblk) gla_pass_a_item(P, item, smem);
}
__device__ __forceinline__ void gla_pass_b(const Ptrs& P, int gtid, int nthreads) {
    const bf16* DS = (const bf16*)(P.ws + WS_R1); bf16* SIN = (bf16*)(P.ws + WS_R4); const float* DEC = (const float*)(P.ws + WS_DEC);
    for (int idx = gtid; idx < 32 * 2048; idx += nthreads) {
        const int bhd = idx >> 11, e4 = idx & 2047, k4 = (e4 & 15) * 4;
        float s0 = 0.f, s1 = 0.f, s2 = 0.f, s3 = 0.f;
#pragma unroll 4
        for (int c = 0; c < 68; ++c) {
            const size_t sidx = (size_t)bhd * 68 + c;
            u32x2 o = {pk2(s0, s1), pk2(s2, s3)};
            *(u32x2*)(SIN + sidx * GLA_ST + e4 * 4) = o;
            const f32x4 d = *(const f32x4*)(DEC + sidx * 64 + k4);
            const u32x2 w = *(const u32x2*)(DS + sidx * GLA_ST + e4 * 4);
            s0 = s0 * d.x + __uint_as_float(w.x << 16); s1 = s1 * d.y + __uint_as_float(w.x & 0xffff0000u);
            s2 = s2 * d.z + __uint_as_float(w.y << 16); s3 = s3 * d.w + __uint_as_float(w.y & 0xffff0000u);
        }
    }
}

constexpr int GC_QT = 0, GC_QA = 9216, GC_KT = 18432, GC_VT = 27648, GC_LRS = GC_VT + 128 * 136, GC_TOT = GC_LRS + 4096, GC_XCH = GC_TOT + 1024, GLA_C_LDS = GC_XCH + 512;
__device__ __forceinline__ void gla_pass_c_item(const Ptrs& P, int item, LAS unsigned char* lds) {
    const int tid = threadIdx.x, lane = tid & 63, wave = tid >> 6, l31 = lane & 31, hh = lane >> 5, pt = wave & 1, vh = wave >> 1;
    const int M = item % 68, h = (item / 68) & 3, b = item / 272;
    size_t row0; int vcol0, c0, c1; gla_chunk_geom(b, M, row0, vcol0, c0, c1);
    { const bf16* gvt = (const bf16*)(P.ws + WS_R3 + R3_GV) + (size_t)(b * 4 + h) * 128 * VT_LD + vcol0;
#pragma unroll
      for (int i = 0; i < 4; ++i) { const int c = tid + 256 * i, v = c >> 3, kc = c & 7; const u32x4 w = *(const u32x4*)(gvt + (size_t)v * VT_LD + kc * 8);
          LAS unsigned char* vp = lds + GC_VT + v * 136 + kc * 16; u32x2 lo = {w.x, w.y}, hi = {w.z, w.w}; *(LAS u32x2*)vp = lo; *(LAS u32x2*)(vp + 8) = hi; } }
    f32x16 o[2];
#pragma unroll
    for (int i = 0; i < 2; ++i)
#pragma unroll
        for (int r = 0; r < 16; ++r) o[i][r] = 0.f;
    const bf16* SIN = (const bf16*)(P.ws + WS_R4);
#pragma unroll 1
    for (int dir = 0; dir < 2; ++dir) {
        const int sidx = ((b * 4 + h) * 2 + dir) * 68 + (dir ? c1 : c0);
        bf16x8 sf[2][4];
#pragma unroll
        for (int i = 0; i < 2; ++i)
#pragma unroll
            for (int ks = 0; ks < 4; ++ks) sf[i][ks] = *(const bf16x8*)(SIN + (size_t)sidx * GLA_ST + (size_t)(64 * vh + 32 * i + l31) * 64 + 16 * ks + 8 * hh);
        (void)gla_prep<true>(P, h, dir, row0, lds, GC_LRS, GC_TOT);
        __syncthreads();
        f32x16 at[2];
#pragma unroll
        for (int st = 0; st < 2; ++st) {
#pragma unroll
            for (int r = 0; r < 16; ++r) at[st][r] = 0.f;
#pragma unroll
            for (int ks = 0; ks < 4; ++ks) {
                const bf16x8 ka = *(LAS bf16x8*)(lds + GC_KT + (32 * st + l31) * 144 + ks * 32 + hh * 16);
                const bf16x8 qa = *(LAS bf16x8*)(lds + GC_QA + (32 * pt + l31) * 144 + ks * 32 + hh * 16);
                at[st] = __builtin_amdgcn_mfma_f32_32x32x16_bf16(ka, qa, at[st], 0, 0, 0);
            }
            const int pq = 32 * pt + l31;
#pragma unroll
            for (int r = 0; r < 16; ++r) { const int s_ = 32 * st + (r & 3) + 8 * (r >> 2) + 4 * hh; const bool ok = dir ? (s_ >= pq) : (s_ <= pq); if (!ok) at[st][r] = 0.f; }
        }
#pragma unroll
        for (int ks = 0; ks < 4; ++ks) {
            const bf16x8 qt = *(LAS bf16x8*)(lds + GC_QT + (32 * pt + l31) * 144 + ks * 32 + hh * 16);
#pragma unroll
            for (int i = 0; i < 2; ++i) o[i] = __builtin_amdgcn_mfma_f32_32x32x16_bf16(sf[i][ks], qt, o[i], 0, 0, 0);
        }
#pragma unroll
        for (int st = 0; st < 2; ++st)
#pragma unroll
            for (int s2 = 0; s2 < 2; ++s2) {
                u32x4 pw = {pk2(at[st][8 * s2], at[st][8 * s2 + 1]), pk2(at[st][8 * s2 + 2], at[st][8 * s2 + 3]), pk2(at[st][8 * s2 + 4], at[st][8 * s2 + 5]), pk2(at[st][8 * s2 + 6], at[st][8 * s2 + 7])};
                const bf16x8 pf = __builtin_bit_cast(bf16x8, pw);
#pragma unroll
                for (int i = 0; i < 2; ++i) {
                    LAS unsigned char* vp = lds + GC_VT + (64 * vh + 32 * i + l31) * 136 + (32 * st + 16 * s2 + 4 * hh) * 2;
                    const u32x2 v0 = *(LAS u32x2*)vp, v1 = *(LAS u32x2*)(vp + 16);
                    u32x4 vw = {v0.x, v0.y, v1.x, v1.y};
                    o[i] = __builtin_amdgcn_mfma_f32_32x32x16_bf16(__builtin_bit_cast(bf16x8, vw), pf, o[i], 0, 0, 0);
                }
            }
        __syncthreads();
    }
    float ss = 0.f;
#pragma unroll
    for (int i = 0; i < 2; ++i)
#pragma unroll
        for (int r = 0; r < 16; ++r) ss += o[i][r] * o[i][r];
    ss = xhalf_sum(ss);
    LAS float* xch = (LAS float*)(lds + GC_XCH);
    if (hh == 0) xch[(pt * 2 + vh) * 32 + l31] = ss;
    __syncthreads();
    ss += xch[(pt * 2 + (1 - vh)) * 32 + l31];
    const float rstd = rsqrtf(ss * (1.f / 128.f) + EPS);
    const size_t trow = row0 + 32 * pt + l31;
    const bf16* gr = (const bf16*)(P.ws + WS_R3 + R3_GR) + trow * 512 + h * 128 + 64 * vh + 4 * hh;
    bf16* mx = (bf16*)(P.ws + WS_R2) + trow * 1024 + h * 128 + 64 * vh + 4 * hh;
    const float* gn = P.in[12] + 64 * vh + 4 * hh;
#pragma unroll
    for (int i = 0; i < 2; ++i)
#pragma unroll
        for (int g = 0; g < 4; ++g) {
            const u32x2 rw = *(const u32x2*)(gr + i * 32 + 8 * g); const f32x4 gg = *(const f32x4*)(gn + i * 32 + 8 * g);
            const float r0 = __uint_as_float(rw.x << 16), r1 = __uint_as_float(rw.x & 0xffff0000u), r2 = __uint_as_float(rw.y << 16), r3_ = __uint_as_float(rw.y & 0xffff0000u);
            const float y0 = o[i][4 * g] * rstd * gg.x * (r0 / (1.f + __expf(-r0))), y1 = o[i][4 * g + 1] * rstd * gg.y * (r1 / (1.f + __expf(-r1)));
            const float y2 = o[i][4 * g + 2] * rstd * gg.z * (r2 / (1.f + __expf(-r2))), y3 = o[i][4 * g + 3] * rstd * gg.w * (r3_ / (1.f + __expf(-r3_)));
            u32x2 v = {pk2(y0, y1), pk2(y2, y3)}; *(u32x2*)(mx + i * 32 + 8 * g) = v;
        }
    __syncthreads();
}
__device__ __forceinline__ void ph_gla_c(const Ptrs& P, LAS unsigned char* smem, int bid, int nblk) {
    for (int item = bid; item < 4 * 4 * 68; item += nblk) gla_pass_c_item(P, item, smem);
}

#define XB_TMO      128
#define XB_XCNT(j)  (256  + 64 * (j))
#define XB_XSUB(j)  (1280 + 64 * (j))
#define XB_XGEN(j)  (2304 + 64 * (j))
#define XB_TOP      3328
#define XB_TOPGEN   3392
#define XB_SPIN_CAP (1u << 20)
constexpr int CTL_BAR = 4096;
__device__ __forceinline__ unsigned xb_ld(unsigned* p) { return __hip_atomic_load(p, __ATOMIC_RELAXED, __HIP_MEMORY_SCOPE_AGENT); }
__device__ __forceinline__ unsigned xb_add(unsigned* p, unsigned v) { return __hip_atomic_fetch_add(p, v, __ATOMIC_RELAXED, __HIP_MEMORY_SCOPE_AGENT); }
__device__ __forceinline__ unsigned xb_xcc_id() { return (unsigned)__builtin_amdgcn_s_getreg((3 << 11) | 20) & 0xFu; }
#define XB_SPIN(cond, bar) do { unsigned _sp = 0; while (cond) { __builtin_amdgcn_s_sleep(1); \
    if ((++_sp & 255u) == 0u) { if (xb_ld(&(bar)[XB_TMO])) break; if (_sp > XB_SPIN_CAP) { atomicAdd(&(bar)[XB_TMO], 1u); break; } } } } while (0)
struct XcdBarrier { unsigned* bar; unsigned x; volatile LAS unsigned* st; };
__device__ __forceinline__ XcdBarrier xcd_barrier_post(unsigned* bar, volatile LAS unsigned* st) {
    XcdBarrier b; b.bar = bar; b.x = xb_xcc_id(); b.st = st;
    if (threadIdx.x == 0) (void)xb_add(&bar[XB_XCNT(b.x)], 1u);
    return b;
}
__device__ __forceinline__ void xcd_barrier_complete(unsigned* bar, unsigned x, unsigned& nloc, unsigned& nx) {
    const unsigned G = gridDim.x * gridDim.y * gridDim.z;
    unsigned sum, cnt, mine, sp = 0u;
    for (;;) {
        sum = 0u; cnt = 0u; mine = 0u;
#pragma unroll
        for (unsigned j = 0; j < 16; ++j) { const unsigned c = xb_ld(&bar[XB_XCNT(j)]); sum += c; cnt += (c > 0u) ? 1u : 0u; mine = (j == x) ? c : mine; }
        if (sum == G) break;
        __builtin_amdgcn_s_sleep(1);
        if ((++sp & 255u) == 0u) { if (xb_ld(&bar[XB_TMO])) break; if (sp > XB_SPIN_CAP) { atomicAdd(&bar[XB_TMO], 1u); break; } }
    }
    nloc = mine > 0u ? mine : 1u; nx = cnt > 0u ? cnt : 1u;
}
__device__ __forceinline__ void xcd_barrier(const XcdBarrier& b) {
    asm volatile("s_waitcnt vmcnt(0)" ::: "memory");
    __syncthreads();
    if (threadIdx.x == 0) {
        unsigned* bar = b.bar;
        __builtin_amdgcn_s_waitcnt(0);
        unsigned nloc = b.st[0], nx = b.st[1];
        if (nloc == 0u) { xcd_barrier_complete(bar, b.x, nloc, nx); b.st[0] = nloc; b.st[1] = nx; }
        const unsigned old = xb_add(&bar[XB_XSUB(b.x)], 1u);
        const unsigned gen = old / nloc;
        if (old + 1u == (gen + 1u) * nloc) {
            __builtin_amdgcn_fence(__ATOMIC_RELEASE, "agent");
            asm volatile("s_waitcnt vmcnt(0)" ::: "memory");
            const unsigned og = xb_add(&bar[XB_TOP], 1u);
            const unsigned tg = og / nx;
            if (og + 1u == (tg + 1u) * nx) xb_add(&bar[XB_TOPGEN], 1u);
            else XB_SPIN(xb_ld(&bar[XB_TOPGEN]) == tg, bar);
            __builtin_amdgcn_fence(__ATOMIC_ACQUIRE, "agent");
            xb_add(&bar[XB_XGEN(b.x)], 1u);
            asm volatile("s_waitcnt vmcnt(0)" ::: "memory");
        } else {
            XB_SPIN(xb_ld(&bar[XB_XGEN(b.x)]) == gen, bar);
            __builtin_amdgcn_fence(__ATOMIC_ACQUIRE, "agent");
            asm volatile("s_waitcnt vmcnt(0)" ::: "memory");
        }
    }
    __syncthreads();
}

constexpr int N_PHASES = 18;
constexpr int SMEM_BYTES = GEMM_LDS + 256;
struct Args { Ptrs P; int ph_lo, ph_hi; };
__global__ void __launch_bounds__(256, 2) fwd_megakernel(Args args) {
    __shared__ __attribute__((aligned(16))) unsigned char smem_raw[SMEM_BYTES];
    LAS unsigned char* smem = (LAS unsigned char*)smem_raw;
    const Ptrs& P = args.P;
    const int bid = blockIdx.x, nblk = gridDim.x;
    volatile LAS unsigned* bst = (volatile LAS unsigned*)(smem + GEMM_LDS + 128);
    if (threadIdx.x < 2) bst[threadIdx.x] = 0u;
    __syncthreads();
    XcdBarrier bar; bar.bar = (unsigned*)(P.ws + WS_CTL) + CTL_BAR; bar.x = 0; bar.st = bst;
    const bool multi = args.ph_hi - args.ph_lo > 1;
    if (multi) bar = xcd_barrier_post((unsigned*)(P.ws + WS_CTL) + CTL_BAR, bst);
    const int lo = args.ph_lo, hi = args.ph_hi;
#define PHASE(k, call) if (lo <= (k) && (k) < hi) { if ((k) > lo) xcd_barrier(bar); call; }
    PHASE(0, ph_prologue(P, smem, bid, nblk))
    PHASE(1, ph_modulate(P, 0, bid, nblk))
    PHASE(2, ph_even_inproj(P, smem, bid, nblk))
    PHASE(3, ph_gla_a(P, smem, bid, nblk))
    PHASE(4, gla_pass_b(P, bid * 256 + threadIdx.x, nblk * 256))
    PHASE(5, ph_gla_c(P, smem, bid, nblk))
    PHASE(6, ph_dense_attn(P, smem, bid, nblk))
    PHASE(7, ph_outproj(P, smem, bid, nblk, 0, NT))
    PHASE(8, ph_moe_route(P, smem, bid, nblk, 0, NT))
    PHASE(9, ph_moe_stage1(P, smem, bid, nblk, 0))
    PHASE(10, ph_moe_stage2(P, smem, bid, nblk, 0))
    PHASE(11, ph_modulate(P, 1, bid, nblk))
    PHASE(12, ph_odd_inproj(P, smem, bid, nblk))
    PHASE(13, ph_swa_attn(P, smem, bid, nblk))
    PHASE(14, ph_outproj(P, smem, bid, nblk, 1, NL))
    PHASE(15, ph_moe_route(P, smem, bid, nblk, 1, NL))
    PHASE(16, ph_moe_stage1(P, smem, bid, nblk, 1))
    PHASE(17, ph_moe_stage2(P, smem, bid, nblk, 1))
#undef PHASE
}

#ifndef MK_LAUNCHES
#define MK_LAUNCHES 1
#endif
extern "C" void kernel_launch(void* const* d_in, const int* in_sizes, int n_in, void* d_out, int out_size, void* d_ws, size_t ws_size, hipStream_t stream) {
    static int grid = 0;
    if (grid == 0) {
        int dev = 0, cus = 0, per_cu = 0;
        hipGetDevice(&dev);
        hipDeviceGetAttribute(&cus, hipDeviceAttributeMultiprocessorCount, dev);
        hipOccupancyMaxActiveBlocksPerMultiprocessor(&per_cu, (const void*)fwd_megakernel, 256, 0);
        if (per_cu > 2) per_cu = 2;
        if (per_cu < 1) per_cu = 1;
        grid = cus * per_cu;
    }
    hipMemsetAsync((unsigned char*)d_ws + WS_CTL, 0, 65536, stream);
    Args a{};
    for (int i = 0; i < 27; ++i) a.P.in[i] = (const float*)d_in[i];
    a.P.out = (float*)d_out; a.P.ws = (unsigned char*)d_ws;
#if MK_LAUNCHES == 1
    a.ph_lo = 0; a.ph_hi = N_PHASES;
    void* kargs[] = {&a};
    hipLaunchCooperativeKernel((const void*)fwd_megakernel, dim3(grid), dim3(256), kargs, 0, stream);
#else
    for (int ph = 0; ph < N_PHASES; ++ph) { a.ph_lo = ph; a.ph_hi = ph + 1; hipLaunchKernelGGL(fwd_megakernel, dim3(grid), dim3(256), 0, stream, a); }
#endif
}
```

```cpp
#include <hip/hip_runtime.h>
#include <stdint.h>

typedef unsigned short bf16;
__device__ __forceinline__ float bf2f(bf16 v) { return __uint_as_float(((unsigned)v) << 16); }
__device__ __forceinline__ bf16 f2bf(float f) { unsigned u = __float_as_uint(f); return (bf16)((u + 0x7fffu + ((u >> 16) & 1u)) >> 16); }

constexpr int D = 1024, NB = 4, S = 4096, CL = 256, NL = NB * S, NC = NB * CL, NT = NL + NC;
constexpr int EVEN_IN = 2336, ODD_IN = 1280;
constexpr float EPS = 1e-6f;

__device__ __forceinline__ float silu(float x) { return x / (1.f + expf(-x)); }
__device__ __forceinline__ float wave_sum(float v) {
#pragma unroll
    for (int o = 1; o < 64; o <<= 1) v += __shfl_xor(v, o);
    return v;
}

#define LAS __attribute__((address_space(3)))
typedef short bf16x8 __attribute__((ext_vector_type(8)));
typedef float f32x16 __attribute__((ext_vector_type(16)));
typedef float f32x4 __attribute__((ext_vector_type(4)));
typedef unsigned u32x4 __attribute__((ext_vector_type(4)));
typedef unsigned u32x2 __attribute__((ext_vector_type(2)));
typedef __bf16 bf16x2_t __attribute__((ext_vector_type(2)));
typedef float f32x2_t __attribute__((ext_vector_type(2)));
__device__ __forceinline__ unsigned pk2(float lo, float hi) { f32x2_t v = {lo, hi}; bf16x2_t b = __builtin_convertvector(v, bf16x2_t); return __builtin_bit_cast(unsigned, b); }
__device__ __forceinline__ float xhalf_sum(float x) {
    auto t = __builtin_amdgcn_permlane32_swap(__float_as_uint(x), __float_as_uint(x), false, false);
    return __uint_as_float(t[0]) + __uint_as_float(t[1]);
}

constexpr int NPAD_E = 2432;
constexpr int TILE_LDS = 128 * 128;
constexpr int GEMM_LDS = 4 * TILE_LDS;

__device__ __forceinline__ void transpose_item(const float* W, int K, int N, bf16* WT, int dst_row0, int k0, int n0, LAS float* scr, int lane) {
    float tv[32];
#pragma unroll
    for (int i = 0; i < 32; ++i) tv[i] = W[(size_t)(k0 + 2 * i + (lane >> 5)) * N + n0 + (lane & 31)];
#pragma unroll
    for (int i = 0; i < 32; ++i) scr[(2 * i + (lane >> 5)) * 33 + (lane & 31)] = tv[i];
    asm volatile("s_waitcnt lgkmcnt(0)" ::: "memory");
    const int c = lane & 7;
#pragma unroll
    for (int j = 0; j < 4; ++j) {
        const int n = (lane >> 3) + 8 * j; const LAS float* s = scr + (8 * c) * 33 + n;
        u32x4 o; o.x = pk2(s[0 * 33], s[1 * 33]); o.y = pk2(s[2 * 33], s[3 * 33]); o.z = pk2(s[4 * 33], s[5 * 33]); o.w = pk2(s[6 * 33], s[7 * 33]);
        *(u32x4*)(WT + (size_t)(dst_row0 + n) * K + k0 + 8 * c) = o;
    }
    asm volatile("s_waitcnt lgkmcnt(0)" ::: "memory");
}

struct Ptrs {
    const float* in[27];
    float* out;
    unsigned char* ws;
};

constexpr size_t MiB = 1u << 20;
constexpr size_t WS_CTL = 0;
constexpr size_t WS_MODV = 1 * MiB;
constexpr size_t WS_ROPE = WS_MODV + 256 * 1024;
constexpr size_t WS_WINE = 2 * MiB;
constexpr size_t WS_WOUTE = WS_WINE + (size_t)NPAD_E * 1024 * 2;
constexpr size_t WS_WINO = WS_WOUTE + 2 * MiB;
constexpr size_t WS_WOUTO = WS_WINO + (size_t)1280 * 1024 * 2;
constexpr size_t WS_WGU = WS_WOUTO + 2 * MiB;
constexpr size_t WS_WD = WS_WGU + 32 * MiB;
constexpr size_t WS_CTXS = WS_WD + 16 * MiB;
constexpr size_t WS_R1 = 66 * MiB;
constexpr size_t WS_R4 = WS_R1 + 34 * MiB;
constexpr size_t WS_R2 = WS_R4 + 34 * MiB;
constexpr size_t WS_R3 = WS_R2 + 34 * MiB;
static_assert(WS_CTXS + 4 * MiB <= WS_R1, "ws map");
constexpr size_t R3_GQ = 0, R3_GK = R3_GQ + (size_t)NT * 256 * 2, R3_GV = R3_GK + (size_t)NT * 256 * 2, R3_GR = R3_GV + (size_t)NT * 512 * 2,
                 R3_LR = R3_GR + (size_t)NT * 512 * 2, R3_AQ = R3_LR + (size_t)NT * 32 * 4, R3_AK = R3_AQ + (size_t)NT * 512 * 2, R3_AV = R3_AK + (size_t)NT * 128 * 2,
                 R3_END = R3_AV + (size_t)NT * 128 * 2;
static_assert(WS_R3 + R3_END <= 256 * MiB, "ws map end");
constexpr size_t R3_OQ = 0, R3_OK = R3_OQ + (size_t)NL * 1024 * 2, R3_OV = R3_OK + (size_t)NT * 128 * 2;

__device__ __forceinline__ void ph_prologue(const Ptrs& P, LAS unsigned char* smem, int bid, int nblk) {
    const int lane = threadIdx.x & 63, wave = threadIdx.x >> 6;
    LAS float* scr = (LAS float*)smem + wave * 64 * 33;
    const int gw = bid * 4 + wave, NGW = nblk * 4;
    unsigned char* ws = P.ws;
    constexpr int I_WINE = 16 * 73, I_SQ = 16 * 32, I_WINO = 16 * 40, I_EXP_GU = 16 * 8, I_EXP_D = 4 * 32;
    constexpr int T_WINE = I_WINE, T_WOUTE = T_WINE + I_SQ, T_WINO = T_WOUTE + I_WINO, T_WOUTO = T_WINO + I_SQ,
                  T_G = T_WOUTO + 32 * I_EXP_GU, T_U = T_G + 32 * I_EXP_GU, T_D = T_U + 32 * I_EXP_D;
    for (int it = gw; it < T_D; it += NGW) {
        if (it < T_WINE) {
            int kb = it / 73, nb = it % 73, n0 = nb * 32;
            int dst = n0 < 1536 ? n0 : (n0 < 1568 ? n0 + 768 : n0 - 32);
            transpose_item(P.in[8], 1024, EVEN_IN, (bf16*)(ws + WS_WINE), dst, kb * 64, n0, scr, lane);
        } else if (it < T_WOUTE) { int r = it - T_WINE; transpose_item(P.in[9], 1024, 1024, (bf16*)(ws + WS_WOUTE), (r % 32) * 32, (r / 32) * 64, (r % 32) * 32, scr, lane); }
        else if (it < T_WINO) { int r = it - T_WOUTE; transpose_item(P.in[15], 1024, 1280, (bf16*)(ws + WS_WINO), (r % 40) * 32, (r / 40) * 64, (r % 40) * 32, scr, lane); }
        else if (it < T_WOUTO) { int r = it - T_WINO; transpose_item(P.in[16], 1024, 1024, (bf16*)(ws + WS_WOUTO), (r % 32) * 32, (r / 32) * 64, (r % 32) * 32, scr, lane); }
        else if (it < T_U) {
            bool up = it >= T_G; int r = it - (up ? T_G : T_WOUTO); int le = r / I_EXP_GU; r %= I_EXP_GU; int kb = r / 8, hb = r % 8;
            const float* W = (up ? P.in[25] : P.in[24]) + (size_t)le * 1024 * 256;
            transpose_item(W, 1024, 256, (bf16*)(ws + WS_WGU) + (size_t)le * 512 * 1024, 64 * hb + (up ? 32 : 0), kb * 64, hb * 32, scr, lane);
        } else {
            int r = it - T_U; int le = r / I_EXP_D; r %= I_EXP_D; int kb = r / 32, nb = r % 32;
            transpose_item(P.in[26] + (size_t)le * 256 * 1024, 256, 1024, (bf16*)(ws + WS_WD) + (size_t)le * 1024 * 256, nb * 32, kb * 64, nb * 32, scr, lane);
        }
    }
    { u32x4 z = {0, 0, 0, 0}; u32x4* p = (u32x4*)((bf16*)(ws + WS_WINE) + (size_t)EVEN_IN * 1024);
      for (int i = bid * 256 + threadIdx.x; i < 96 * 1024 * 2 / 16; i += nblk * 256) p[i] = z; }
    for (int i = bid * 256 + threadIdx.x; i < 1024; i += nblk * 256) {
        int pos = i >> 4, f = i & 15; float inv = powf(10000.f, -(float)(2 * f) / 32.f); float ang = (float)pos * inv;
        ((float2*)(ws + WS_ROPE))[i] = make_float2(cosf(ang), sinf(ang));
    }
    __syncthreads();
    {
        LAS float* sc = (LAS float*)smem;
        LAS float* red = (LAS float*)smem + 5 * 1024;
        for (int i = threadIdx.x; i < 5 * 1024; i += 256) { const float cv = i < 4096 ? P.in[1][i] : P.in[3][i - 4096]; sc[i] = cv / (1.f + expf(-cv)); }
        __syncthreads();
        for (int it = bid; it < 2 * 96; it += nblk) {
            const int layer = it / 96, col = (it % 96) * 64 + lane;
            const float* w = P.in[4] + (size_t)layer * D * 6144 + col;
            float a0 = 0.f, a1 = 0.f, a2 = 0.f, a3 = 0.f, a4 = 0.f;
#pragma unroll 32
            for (int k = 256 * wave; k < 256 * wave + 256; ++k) { const float wv = w[(size_t)k * 6144]; a0 += sc[k] * wv; a1 += sc[1024 + k] * wv; a2 += sc[2048 + k] * wv; a3 += sc[3072 + k] * wv; a4 += sc[4096 + k] * wv; }
            red[(wave * 5 + 0) * 64 + lane] = a0; red[(wave * 5 + 1) * 64 + lane] = a1; red[(wave * 5 + 2) * 64 + lane] = a2; red[(wave * 5 + 3) * 64 + lane] = a3; red[(wave * 5 + 4) * 64 + lane] = a4;
            __syncthreads();
            for (int i = threadIdx.x; i < 320; i += 256) { const int row = i >> 6, cl = i & 63;
                ((float*)(ws + WS_MODV))[((size_t)layer * 5 + row) * 6144 + (it % 96) * 64 + cl] = red[row * 64 + cl] + red[(5 + row) * 64 + cl] + red[(10 + row) * 64 + cl] + red[(15 + row) * 64 + cl] + P.in[5][layer * 6144 + (it % 96) * 64 + cl]; }
            __syncthreads();
        }
    }
}

__device__ __forceinline__ void modulate_rows(const float* xlat, const float* xctx, const float* modv_layer, const float* gain, int which, bf16* H, int nrows, int gw, int NGW, int lane) {
    for (int row = gw; row < nrows; row += NGW) {
        const float* xr = row < NL ? xlat + (size_t)row * D : xctx + (size_t)(row - NL) * D;
        const float* mv = modv_layer + (size_t)(row < NL ? row / S : 4) * 6144;
        f32x4 v[4]; float ss = 0.f;
#pragma unroll
        for (int j = 0; j < 4; ++j) { v[j] = *(const f32x4*)(xr + 4 * lane + 256 * j); ss += v[j].x * v[j].x + v[j].y * v[j].y + v[j].z * v[j].z + v[j].w * v[j].w; }
        float rstd = rsqrtf(wave_sum(ss) / D + EPS);
#pragma unroll
        for (int j = 0; j < 4; ++j) {
            int k = 4 * lane + 256 * j;
            f32x4 g = *(const f32x4*)(gain + k), sc = *(const f32x4*)(mv + (which + 1) * 1024 + k), sh = *(const f32x4*)(mv + which * 1024 + k);
            float h0 = v[j].x * rstd * g.x * (1.f + sc.x) + sh.x, h1 = v[j].y * rstd * g.y * (1.f + sc.y) + sh.y;
            float h2 = v[j].z * rstd * g.z * (1.f + sc.z) + sh.z, h3 = v[j].w * rstd * g.w * (1.f + sc.w) + sh.w;
            u32x2 o = {pk2(h0, h1), pk2(h2, h3)};
            *(u32x2*)(H + (size_t)row * D + k) = o;
        }
    }
}
__device__ __forceinline__ void route_tables(const Ptrs& P, int layer, int bid, int nblk);
__device__ __forceinline__ void ph_modulate(const Ptrs& P, int layer, int bid, int nblk) {
    route_tables(P, layer, bid, nblk);
    modulate_rows(layer ? P.out : P.in[0], layer ? (const float*)(P.ws + WS_CTXS) : P.in[2], (const float*)(P.ws + WS_MODV) + (size_t)layer * 5 * 6144, P.in[6] + layer * D, 0,
                  (bf16*)(P.ws + WS_R1), NT, bid * 4 + (threadIdx.x >> 6), nblk * 4, threadIdx.x & 63);
}

struct AffineRows {
    const bf16* base; size_t ld; const bf16* p0;
    __device__ __forceinline__ AffineRows(const bf16* b, size_t ld_) : base(b), ld(ld_), p0(b) {}
    __device__ __forceinline__ void init(int r0) { p0 = base + (size_t)r0 * ld; }
    __device__ __forceinline__ const bf16* ptr(int i, int kt) const { return p0 + (size_t)i * 8 * ld + kt * 64; }
};
template <bool SWP, class AF, class BF, class Epi>
__device__ __forceinline__ void gemm_tile(AF af, BF bf, int nk, LAS unsigned char* smem, const Epi& epi) {
    const int tid = threadIdx.x, lane = tid & 63, wave = tid >> 6, wn = wave & 1, wm = wave >> 1, l31 = lane & 31, hh = lane >> 5;
    const int r0 = wave * 32 + (lane >> 3);
    af.init(r0); bf.init(r0);
    __syncthreads();
    int coff[4];
#pragma unroll
    for (int i = 0; i < 4; ++i) coff[i] = ((lane & 7) ^ (((r0 >> 1) + 4 * i) & 7)) * 8;
#define GT_STAGE(st, kt) do { _Pragma("unroll") for (int i = 0; i < 4; ++i) { \
        __builtin_amdgcn_global_load_lds((const unsigned*)(af.ptr(i, (kt)) + coff[i]), (LAS unsigned*)(smem + (st) * 2 * TILE_LDS + (wave * 4 + i) * 1024), 16, 0, 0); \
        __builtin_amdgcn_global_load_lds((const unsigned*)(bf.ptr(i, (kt)) + coff[i]), (LAS unsigned*)(smem + (st) * 2 * TILE_LDS + TILE_LDS + (wave * 4 + i) * 1024), 16, 0, 0); } } while (0)
    GT_STAGE(0, 0);
    f32x16 acc[2][2];
#pragma unroll
    for (int i = 0; i < 2; ++i)
#pragma unroll
        for (int j = 0; j < 2; ++j)
#pragma unroll
            for (int r = 0; r < 16; ++r) acc[i][j][r] = 0.f;
    const int sw = (l31 >> 1) & 7;
    int xo[4], wo[4];
#pragma unroll
    for (int s = 0; s < 4; ++s) { const int cs = ((2 * s + hh) ^ sw) * 16; xo[s] = (wm * 64 + l31) * 128 + cs; wo[s] = TILE_LDS + (wn * 64 + l31) * 128 + cs; }
    asm volatile("s_waitcnt vmcnt(0)" ::: "memory");
    __syncthreads();
    for (int kt = 0; kt < nk; ++kt) {
        const int st = kt & 1;
        if (kt + 1 < nk) GT_STAGE(st ^ 1, kt + 1);
        LAS unsigned char* sb = smem + st * 2 * TILE_LDS;
#pragma unroll
        for (int s = 0; s < 4; ++s) {
            bf16x8 wf[2], xf[2];
#pragma unroll
            for (int i = 0; i < 2; ++i) wf[i] = *(LAS bf16x8*)(sb + wo[s] + i * 4096);
#pragma unroll
            for (int j = 0; j < 2; ++j) xf[j] = *(LAS bf16x8*)(sb + xo[s] + j * 4096);
#pragma unroll
            for (int i = 0; i < 2; ++i)
#pragma unroll
                for (int j = 0; j < 2; ++j) acc[i][j] = SWP ? __builtin_amdgcn_mfma_f32_32x32x16_bf16(xf[j], wf[i], acc[i][j], 0, 0, 0)
                                                            : __builtin_amdgcn_mfma_f32_32x32x16_bf16(wf[i], xf[j], acc[i][j], 0, 0, 0);
        }
        asm volatile("s_waitcnt vmcnt(0)" ::: "memory");
        __syncthreads();
    }
#undef GT_STAGE
    { int l31e = l31, hhe = hh, we = wave; asm volatile("" : "+v"(l31e), "+v"(hhe), "+v"(we));
      epi(acc, (we & 1) * 64, (we >> 1) * 64, l31e, hhe, smem + we * 16384); }
}

constexpr int SG_P = 144;
__device__ __forceinline__ void store_bf16_T(const f32x16 (&acc)[2][2], bf16* out, size_t ld, size_t trow0, int col0, int l31, int hh, LAS unsigned char* wl) {
#pragma unroll
    for (int j = 0; j < 2; ++j)
#pragma unroll
        for (int i = 0; i < 2; ++i)
#pragma unroll
            for (int g = 0; g < 4; ++g) { u32x2 v = {pk2(acc[i][j][4 * g], acc[i][j][4 * g + 1]), pk2(acc[i][j][4 * g + 2], acc[i][j][4 * g + 3])}; *(LAS u32x2*)(wl + (32 * j + l31) * SG_P + (32 * i + 8 * g + 4 * hh) * 2) = v; }
    const int lane = l31 + 32 * hh, rr = lane >> 3, ch = lane & 7;
#pragma unroll
    for (int q = 0; q < 8; ++q) { const int R = 8 * q + rr; const u32x4 v = *(LAS u32x4*)(wl + R * SG_P + ch * 16); *(u32x4*)(out + (trow0 + R) * ld + col0 + ch * 8) = v; }
}
__device__ __forceinline__ void qknorm_rope_T(f32x16 (&acc)[2][2], const float* gain, const float2* ropeT, bool latent, int tok0  , int l31, int hh) {
#pragma unroll
    for (int j = 0; j < 2; ++j) {
        float ss = 0.f;
#pragma unroll
        for (int i = 0; i < 2; ++i)
#pragma unroll
            for (int r = 0; r < 16; ++r) ss += acc[i][j][r] * acc[i][j][r];
        ss = xhalf_sum(ss);
        const float rstd = rsqrtf(ss * (1.f / 64.f) + EPS);
#pragma unroll
        for (int i = 0; i < 2; ++i)
#pragma unroll
            for (int r = 0; r < 16; ++r) acc[i][j][r] *= rstd * gain[i * 32 + (r & 3) + 8 * (r >> 2) + 4 * hh];
        if (latent) {
            const int t = tok0 + j * 32 + l31;
#pragma unroll
            for (int i = 0; i < 2; ++i) {
                const int pos = i == 0 ? (t >> 6) : (t & 63);
#pragma unroll
                for (int r = 0; r < 8; ++r) {
                    const int f = (r & 3) + 8 * (r >> 2) + 4 * hh;
                    const float2 cs = ropeT[pos * 16 + f];
                    const float x1 = acc[i][j][r], x2 = acc[i][j][r + 8];
                    acc[i][j][r] = x1 * cs.x - x2 * cs.y; acc[i][j][r + 8] = x2 * cs.x + x1 * cs.y;
                }
            }
        }
    }
}

constexpr int VT_LD = S + CL;
__device__ __forceinline__ void store_vt_swapped(const f32x16 (&acc)[2][2], bf16* vt_head  , int key0, int l31, int hh, LAS unsigned char* wl) {
#pragma unroll
    for (int i = 0; i < 2; ++i)
#pragma unroll
        for (int j = 0; j < 2; ++j)
#pragma unroll
            for (int g = 0; g < 4; ++g) { u32x2 v = {pk2(acc[i][j][4 * g], acc[i][j][4 * g + 1]), pk2(acc[i][j][4 * g + 2], acc[i][j][4 * g + 3])}; *(LAS u32x2*)(wl + (32 * i + l31) * SG_P + (32 * j + 8 * g + 4 * hh) * 2) = v; }
    const int lane = l31 + 32 * hh, rr = lane >> 3, ch = lane & 7;
#pragma unroll
    for (int q = 0; q < 8; ++q) { const int R = 8 * q + rr; const u32x4 v = *(LAS u32x4*)(wl + R * SG_P + ch * 16); *(u32x4*)(vt_head + (size_t)R * VT_LD + key0 + ch * 8) = v; }
}
template <class RowF>
__device__ __forceinline__ void rmw_f32_T(const f32x16 (&acc)[2][2], const RowF& rowf  , int l31, int hh, LAS unsigned char* wl) {
    const int lane = l31 + 32 * hh, rr = lane >> 4, ch = lane & 15;
#pragma unroll
    for (int j = 0; j < 2; ++j)
#pragma unroll
        for (int i = 0; i < 2; ++i)
#pragma unroll
            for (int g = 0; g < 4; ++g) { f32x4 v = {acc[i][j][4 * g], acc[i][j][4 * g + 1], acc[i][j][4 * g + 2], acc[i][j][4 * g + 3]};
                const int R = 32 * j + l31; *(LAS f32x4*)(wl + R * 256 + (((8 * i + 2 * g + hh) ^ (R & 15)) * 16)) = v; }
    f32x4 xi[16]; float* dp[16]; const float* gp[16]; bool ok[16];
#pragma unroll
    for (int q = 0; q < 16; ++q) { const float* sp; ok[q] = rowf(4 * q + rr, sp, dp[q], gp[q]); if (ok[q]) xi[q] = *(const f32x4*)(sp + ch * 4); }
#pragma unroll
    for (int q = 0; q < 16; ++q) {
        if (ok[q]) {
            const int R = 4 * q + rr; const f32x4 a = *(LAS f32x4*)(wl + R * 256 + ((ch ^ (R & 15)) * 16)); const f32x4 gt = *(const f32x4*)(gp[q] + ch * 4);
            f32x4 v = {xi[q].x + gt.x * a.x, xi[q].y + gt.y * a.y, xi[q].z + gt.z * a.z, xi[q].w + gt.w * a.w};
            *(f32x4*)(dp[q] + ch * 4) = v;
        }
    }
}
struct EpiEvenIn {
    unsigned char* r3; const float* qn; const float* kn; const float2* ropeT; int mt, nt;
    __device__ __forceinline__ bool swapped() const { return nt == 17 || (nt >= 4 && nt < 8); }
    __device__ __forceinline__ void operator()(f32x16 (&acc)[2][2], int fb, int tb, int l31, int hh, LAS unsigned char* wl) const {
        const size_t trow0 = (size_t)mt * 128 + tb; const bool latent = mt < NL / 128; const int tok0 = (int)(trow0 & (S - 1));
        if (swapped()) {
            const int b = latent ? (int)(trow0 / S) : (int)((trow0 - NL) / CL); const int key0 = latent ? tok0 : S + (int)((trow0 - NL) % CL);
            const size_t off = nt == 17 ? R3_AV + (size_t)(b * 2 + fb / 64) * 64 * VT_LD * 2 : R3_GV + ((size_t)(b * 4 + nt - 4) * 128 + fb) * VT_LD * 2;
            store_vt_swapped(acc, (bf16*)(r3 + off), key0, l31, hh, wl);
        } else if (nt == 18) {
            if (fb == 0) {
                float* LR = (float*)(r3 + R3_LR);
#pragma unroll
                for (int j = 0; j < 2; ++j)
#pragma unroll
                    for (int g = 0; g < 4; ++g) { f32x4 v = {acc[0][j][4 * g], acc[0][j][4 * g + 1], acc[0][j][4 * g + 2], acc[0][j][4 * g + 3]}; *(f32x4*)(LR + (trow0 + j * 32 + l31) * 32 + 8 * g + 4 * hh) = v; }
            }
        } else {
            size_t off; int ld, col;
            if (nt < 2) { off = R3_GQ; ld = 256; col = nt * 128; }
            else if (nt < 4) { off = R3_GK; ld = 256; col = (nt - 2) * 128; }
            else if (nt < 12) { off = R3_GR; ld = 512; col = (nt - 8) * 128; }
            else if (nt < 16) { off = R3_AQ; ld = 512; col = (nt - 12) * 128; }
            else { off = R3_AK; ld = 128; col = 0; }
            if (nt >= 12) qknorm_rope_T(acc, nt < 16 ? qn : kn, ropeT, latent, tok0, l31, hh);
            store_bf16_T(acc, (bf16*)(r3 + off), ld, trow0, col + fb, l31, hh, wl);
        }
    }
};
__device__ __forceinline__ int xcd_vid(int bid, int nb) { return (nb % 8 == 0) ? (bid % 8) * (nb / 8) + bid / 8 : bid; }

__device__ __forceinline__ void ph_even_inproj(const Ptrs& P, LAS unsigned char* smem, int bid, int nblk) {
    unsigned char* ws = P.ws;
    const int lrow = threadIdx.x >> 3, kc = threadIdx.x & 7;
    const int vid = xcd_vid(bid, nblk);
    for (int tile = vid; tile < (NT / 128) * 19; tile += nblk) {
        const int mt = tile / 19, nt = tile % 19;
        AffineRows af((const bf16*)(ws + WS_R1) + (size_t)mt * 128 * D, D);
        AffineRows bf_((const bf16*)(ws + WS_WINE) + (size_t)nt * 128 * D, D);
        EpiEvenIn epi{ws + WS_R3, P.in[13], P.in[14], (const float2*)(ws + WS_ROPE), mt, nt};
        if (epi.swapped()) gemm_tile<true>(af, bf_, D / 64, smem, epi); else gemm_tile<false>(af, bf_, D / 64, smem, epi);
    }
}

struct EpiOutProj {
    const float* modv_layer; const float* xin_lat; const float* xin_ctx; float* xout_lat; float* xout_ctx; int mt, nt;
    __device__ __forceinline__ bool swapped() const { return false; }
    __device__ __forceinline__ void operator()(f32x16 (&acc)[2][2], int fb, int tb, int l31, int hh, LAS unsigned char* wl) const {
        const size_t trow0 = (size_t)mt * 128 + tb; const bool latent = mt < NL / 128;
        const int c0 = nt * 128 + fb;
        const float* gate = modv_layer + (size_t)(latent ? trow0 / S : 4) * 6144 + 2 * 1024 + c0;
        const float* xin = (latent ? xin_lat + trow0 * D : xin_ctx + (trow0 - NL) * D) + c0;
        float* xout = (latent ? xout_lat + trow0 * D : xout_ctx + (trow0 - NL) * D) + c0;
        rmw_f32_T(acc, [&](int R, const float*& sp, float*& dp, const float*& gp) { sp = xin + (size_t)R * D; dp = xout + (size_t)R * D; gp = gate; return true; }, l31, hh, wl);
    }
};
__device__ __forceinline__ void ph_outproj(const Ptrs& P, LAS unsigned char* smem, int bid, int nblk, int layer, int nrows) {
    unsigned char* ws = P.ws;
    const int lrow = threadIdx.x >> 3, kc = threadIdx.x & 7;
    const int vid = xcd_vid(bid, nblk);
    const float* modv_layer = (const float*)(ws + WS_MODV) + (size_t)layer * 5 * 6144;
    for (int tile = vid; tile < (nrows / 128) * 8; tile += nblk) {
        const int mt = tile / 8, nt = tile % 8;
        AffineRows af((const bf16*)(ws + WS_R2) + (size_t)mt * 128 * D, D);
        AffineRows bf_((const bf16*)(ws + (layer ? WS_WOUTO : WS_WOUTE)) + (size_t)nt * 128 * D, D);
        EpiOutProj epi{modv_layer, layer ? P.out : P.in[0], layer ? (const float*)(ws + WS_CTXS) : P.in[2], P.out, (float*)(ws + WS_CTXS), mt, nt};
        gemm_tile<false>(af, bf_, D / 64, smem, epi);
    }
}

struct EpiOddIn {
    unsigned char* r3; const float* qn; const float* kn; const float2* ropeT; int mt, nt;
    __device__ __forceinline__ bool swapped() const { return nt == 9; }
    __device__ __forceinline__ void operator()(f32x16 (&acc)[2][2], int fb, int tb, int l31, int hh, LAS unsigned char* wl) const {
        const size_t trow0 = (size_t)mt * 128 + tb; const bool latent = mt < NL / 128; const int tok0 = (int)(trow0 & (S - 1));
        if (nt < 8) { if (latent) { qknorm_rope_T(acc, qn, ropeT, true, tok0, l31, hh); store_bf16_T(acc, (bf16*)(r3 + R3_OQ), 1024, trow0, nt * 128 + fb, l31, hh, wl); } }
        else if (nt == 8) { qknorm_rope_T(acc, kn, ropeT, latent, tok0, l31, hh); store_bf16_T(acc, (bf16*)(r3 + R3_OK), 128, trow0, fb, l31, hh, wl); }
        else {
            const int b = latent ? (int)(trow0 / S) : (int)((trow0 - NL) / CL); const int key0 = latent ? tok0 : S + (int)((trow0 - NL) % CL);
            store_vt_swapped(acc, (bf16*)(r3 + R3_OV) + (size_t)(b * 2 + fb / 64) * 64 * VT_LD, key0, l31, hh, wl);
        }
    }
};
__device__ __forceinline__ void ph_odd_inproj(const Ptrs& P, LAS unsigned char* smem, int bid, int nblk) {
    unsigned char* ws = P.ws;
    const int lrow = threadIdx.x >> 3, kc = threadIdx.x & 7;
    const int vid = xcd_vid(bid, nblk);
    constexpr int T_LAT = (NL / 128) * 10, T_ALL = T_LAT + (NC / 128) * 2;
    for (int tile = vid; tile < T_ALL; tile += nblk) {
        int mt, nt;
        if (tile < T_LAT) { mt = tile / 10; nt = tile % 10; } else { mt = NL / 128 + (tile - T_LAT) / 2; nt = 8 + (tile - T_LAT) % 2; }
        AffineRows af((const bf16*)(ws + WS_R1) + (size_t)mt * 128 * D, D);
        AffineRows bf_((const bf16*)(ws + WS_WINO) + (size_t)nt * 128 * D, D);
        EpiOddIn epi{ws + WS_R3, P.in[18], P.in[19], (const float2*)(ws + WS_ROPE), mt, nt};
        if (epi.swapped()) gemm_tile<true>(af, bf_, D / 64, smem, epi); else gemm_tile<false>(af, bf_, D / 64, smem, epi);
    }
}

constexpr int AT_KP = 144, AT_VP = 136;
constexpr int AT_STAGE = 64 * AT_KP + 64 * AT_VP;
constexpr int ATTN_LDS = 2 * AT_STAGE;
struct AttnArgs {
    const bf16* Q; int ldq; size_t qrow0; int qcol;
    const bf16* K; size_t klat0, kctx0;
    const bf16* Vt;
    int nctx, tlo, nlat;
    int banded, tq0;
    float sink_l2;
    bf16* out;
};
__device__ __forceinline__ float xhalf_max(float x) {
    auto t = __builtin_amdgcn_permlane32_swap(__float_as_uint(x), __float_as_uint(x), false, false);
    return fmaxf(__uint_as_float(t[0]), __uint_as_float(t[1]));
}
__device__ __forceinline__ void attn_block(const AttnArgs& a, LAS unsigned char* smem) {
    const int tid = threadIdx.x, lane = tid & 63, wave = tid >> 6, l31 = lane & 31, hh = lane >> 5;
    constexpr float C = 0.125f * 1.4426950408889634f;
    bf16x8 qf[4];
    { const bf16* qp = a.Q + (a.qrow0 + wave * 32 + l31) * a.ldq + a.qcol + hh * 8;
#pragma unroll
      for (int s = 0; s < 4; ++s) qf[s] = *(const bf16x8*)(qp + 16 * s); }
    f32x16 o[2];
#pragma unroll
    for (int dt = 0; dt < 2; ++dt)
#pragma unroll
        for (int r = 0; r < 16; ++r) o[dt][r] = 0.f;
    float m = -1e30f, lsum = 0.f;
    const int ntile = a.nctx + a.nlat;
    const int lr0 = tid >> 3, kc = tid & 7;
    u32x4 rk[2], rv[2];
#define AT_ISSUE(n) do { const int t_ = (n) < a.nctx ? 64 + (n) : a.tlo + (n) - a.nctx; \
        const bf16* kb_ = a.K + (t_ < 64 ? a.klat0 + 64 * t_ : a.kctx0 + 64 * (t_ - 64)) * 128 + kc * 8; const bf16* vb_ = a.Vt + 64 * t_ + kc * 8; \
        _Pragma("unroll") for (int i = 0; i < 2; ++i) { rk[i] = *(const u32x4*)(kb_ + (size_t)(lr0 + 32 * i) * 128); rv[i] = *(const u32x4*)(vb_ + (size_t)(lr0 + 32 * i) * VT_LD); } } while (0)
#define AT_COMMIT(st) do { LAS unsigned char* sb_ = smem + (st) * AT_STAGE; \
        _Pragma("unroll") for (int i = 0; i < 2; ++i) { *(LAS u32x4*)(sb_ + (lr0 + 32 * i) * AT_KP + kc * 16) = rk[i]; \
            LAS unsigned char* vp_ = sb_ + 64 * AT_KP + (lr0 + 32 * i) * AT_VP + kc * 16; u32x2 lo_ = {rv[i].x, rv[i].y}, hi_ = {rv[i].z, rv[i].w}; *(LAS u32x2*)vp_ = lo_; *(LAS u32x2*)(vp_ + 8) = hi_; } } while (0)
    AT_ISSUE(0); AT_COMMIT(0);
    __syncthreads();
    const int tq = a.tq0 + wave * 32 + l31;
    for (int n = 0; n < ntile; ++n) {
        const int st = n & 1;
        if (n + 1 < ntile) AT_ISSUE(n + 1);
        __builtin_amdgcn_sched_barrier(0);
        LAS unsigned char* sb = smem + st * AT_STAGE;
        f32x16 sc[2];
#pragma unroll
        for (int kt = 0; kt < 2; ++kt) {
#pragma unroll
            for (int r = 0; r < 16; ++r) sc[kt][r] = 0.f;
#pragma unroll
            for (int s = 0; s < 4; ++s) {
                const bf16x8 kf = *(LAS bf16x8*)(sb + (32 * kt + l31) * AT_KP + s * 32 + hh * 16);
                sc[kt] = __builtin_amdgcn_mfma_f32_32x32x16_bf16(kf, qf[s], sc[kt], 0, 0, 0);
            }
        }
        if (a.banded && n >= a.nctx) {
            const int t_ = a.tlo + n - a.nctx; const int dbase = 64 * t_ + 4 * hh - tq;
#pragma unroll
            for (int kt = 0; kt < 2; ++kt)
#pragma unroll
                for (int r = 0; r < 16; ++r) { const int df = dbase + 32 * kt + (r & 3) + 8 * (r >> 2); if (df > 128 || df < -128) sc[kt][r] = -1e30f; }
        }
        float mx = sc[0][0];
#pragma unroll
        for (int kt = 0; kt < 2; ++kt)
#pragma unroll
            for (int r = 0; r < 16; ++r) mx = fmaxf(mx, sc[kt][r]);
        mx = xhalf_max(mx);
        const float mnew = fmaxf(m, mx * C);
        const float alpha = __builtin_amdgcn_exp2f(m - mnew);
        m = mnew;
        float ps = 0.f;
#pragma unroll
        for (int kt = 0; kt < 2; ++kt)
#pragma unroll
            for (int r = 0; r < 16; ++r) { sc[kt][r] = __builtin_amdgcn_exp2f(fmaf(sc[kt][r], C, -mnew)); ps += sc[kt][r]; }
        lsum = lsum * alpha + ps;
#pragma unroll
        for (int dt = 0; dt < 2; ++dt)
#pragma unroll
            for (int r = 0; r < 16; ++r) o[dt][r] *= alpha;
#pragma unroll
        for (int kt = 0; kt < 2; ++kt)
#pragma unroll
            for (int s2 = 0; s2 < 2; ++s2) {
                u32x4 pw = {pk2(sc[kt][8 * s2], sc[kt][8 * s2 + 1]), pk2(sc[kt][8 * s2 + 2], sc[kt][8 * s2 + 3]), pk2(sc[kt][8 * s2 + 4], sc[kt][8 * s2 + 5]), pk2(sc[kt][8 * s2 + 6], sc[kt][8 * s2 + 7])};
                const bf16x8 pf = __builtin_bit_cast(bf16x8, pw);
#pragma unroll
                for (int dt = 0; dt < 2; ++dt) {
                    LAS unsigned char* vp = sb + 64 * AT_KP + (32 * dt + l31) * AT_VP + (32 * kt + 16 * s2 + 4 * hh) * 2;
                    const u32x2 v0 = *(LAS u32x2*)vp, v1 = *(LAS u32x2*)(vp + 16);
                    u32x4 vw = {v0.x, v0.y, v1.x, v1.y};
                    o[dt] = __builtin_amdgcn_mfma_f32_32x32x16_bf16(__builtin_bit_cast(bf16x8, vw), pf, o[dt], 0, 0, 0);
                }
            }
        __builtin_amdgcn_sched_barrier(0);
        if (n + 1 < ntile) AT_COMMIT(st ^ 1);
        __syncthreads();
    }
#undef AT_ISSUE
#undef AT_COMMIT
    float l = xhalf_sum(lsum) + __builtin_amdgcn_exp2f(a.sink_l2 - m);
    const float inv = 1.f / l;
    bf16* op = a.out + (a.qrow0 + wave * 32 + l31) * 1024 + 4 * hh;
#pragma unroll
    for (int dt = 0; dt < 2; ++dt)
#pragma unroll
        for (int g = 0; g < 4; ++g) { u32x2 v = {pk2(o[dt][4 * g] * inv, o[dt][4 * g + 1] * inv), pk2(o[dt][4 * g + 2] * inv, o[dt][4 * g + 3] * inv)}; *(u32x2*)(op + dt * 32 + 8 * g) = v; }
}

__device__ __forceinline__ void ph_dense_attn(const Ptrs& P, LAS unsigned char* smem, int bid, int nblk) {
    unsigned char* r3 = P.ws + WS_R3;
    const int vid = xcd_vid(bid, nblk);
    for (int item = vid; item < 1024 + 64; item += nblk) {
        AttnArgs a;
        int bh, qb; bool isctx = item >= 1024;
        if (!isctx) { bh = item >> 5; qb = item & 31; } else { bh = (item - 1024) >> 1; qb = (item - 1024) & 1; }
        const int hq = bh & 7, b = bh >> 3, kv = hq >> 2;
        a.Q = (const bf16*)(r3 + R3_AQ); a.ldq = 512; a.qcol = hq * 64;
        a.qrow0 = isctx ? (size_t)NL + b * CL + qb * 128 : (size_t)b * S + qb * 128;
        a.K = (const bf16*)(r3 + R3_AK) + kv * 64; a.klat0 = (size_t)b * S; a.kctx0 = (size_t)NL + b * CL;
        a.Vt = (const bf16*)(r3 + R3_AV) + (size_t)(b * 2 + kv) * 64 * VT_LD;
        a.nctx = 4; a.tlo = 0; a.nlat = isctx ? 0 : 64; a.banded = 0; a.tq0 = 0; a.sink_l2 = -INFINITY;
        a.out = (bf16*)(P.ws + WS_R2) + 512 + hq * 64;
        attn_block(a, smem);
    }
}
__device__ __forceinline__ void ph_swa_attn(const Ptrs& P, LAS unsigned char* smem, int bid, int nblk) {
    unsigned char* r3 = P.ws + WS_R3;
    const int vid = xcd_vid(bid, nblk);
    for (int item = vid; item < 2048; item += nblk) {
        AttnArgs a;
        const int bh = item >> 5, qb = item & 31, hq = bh & 15, b = bh >> 4, kv = hq >> 3;
        a.Q = (const bf16*)(r3 + R3_OQ); a.ldq = 1024; a.qcol = hq * 64; a.qrow0 = (size_t)b * S + qb * 128;
        a.K = (const bf16*)(r3 + R3_OK) + kv * 64; a.klat0 = (size_t)b * S; a.kctx0 = (size_t)NL + b * CL;
        a.Vt = (const bf16*)(r3 + R3_OV) + (size_t)(b * 2 + kv) * 64 * VT_LD;
        const int tlo = qb * 2 - 2 < 0 ? 0 : qb * 2 - 2, thi = qb * 2 + 3 > 63 ? 63 : qb * 2 + 3;
        a.nctx = 4; a.tlo = tlo; a.nlat = thi - tlo + 1; a.banded = 1; a.tq0 = qb * 128; a.sink_l2 = P.in[17][hq] * 1.4426950408889634f;
        a.out = (bf16*)(P.ws + WS_R2) + hq * 64;
        attn_block(a, smem);
    }
}

constexpr size_t WS_LIST = 247 * MiB;
constexpr size_t WS_WTS = WS_LIST + (size_t)24 * NT * 4;
constexpr size_t WS_END_ALL = WS_WTS + (size_t)NT * 2 * 4;
static_assert(WS_R3 + R3_END <= WS_LIST && WS_END_ALL <= 256 * MiB, "ws map tail");
constexpr int CTL_CNT = 8192;
constexpr int MOE_MAXT = NT / 128 + 24;

constexpr size_t WS_WRT = 250 * MiB, WS_SL = 251 * MiB;
typedef float f32x4v __attribute__((ext_vector_type(4)));
__device__ __forceinline__ void route_tables(const Ptrs& P, int layer, int bid, int nblk) {
    unsigned char* ws = P.ws;
    const float* mvl = (const float*)(ws + WS_MODV) + (size_t)layer * 5 * 6144;
    const float* gain = P.in[7] + layer * D;
    const float* wg = P.in[20] + (size_t)layer * D * 4; const float* bg = P.in[21] + layer * 4;
    const float* we = P.in[22] + (size_t)layer * D * 16; const float* be = P.in[23] + layer * 16;
    bf16* wrt = (bf16*)(ws + WS_WRT);
    for (int e = bid * 256 + threadIdx.x; e < 5 * 32 * 1024; e += nblk * 256) {
        const int k = e & 1023, r = (e >> 10) & 31, br = e >> 15;
        const float a = gain[k] * (1.f + mvl[(size_t)br * 6144 + 4 * 1024 + k]);
        const float w = (r < 16 ? wg[k * 4 + (r & 3)] : we[k * 16 + r - 16]) * a;
        const bf16 hi = f2bf(w); const bf16 lo = f2bf(w - bf2f(hi));
        wrt[((size_t)(br * 2 + 0) * 32 + r) * 1024 + k] = hi; wrt[((size_t)(br * 2 + 1) * 32 + r) * 1024 + k] = lo;
    }
    const int gw = bid * 4 + (threadIdx.x >> 6), lane = threadIdx.x & 63;
    if (gw < 160) {
        const int r = gw & 31, br = gw >> 5; float s = 0.f;
        for (int k = lane; k < 1024; k += 64) s += mvl[(size_t)br * 6144 + 3 * 1024 + k] * (r < 16 ? wg[k * 4 + (r & 3)] : we[k * 16 + r - 16]);
        s = wave_sum(s);
        if (lane == 0) ((float*)(ws + WS_SL))[br * 32 + r] = s + (r < 16 ? bg[r & 3] : be[r - 16]);
    }
}
typedef float f32x4a __attribute__((ext_vector_type(4)));
__device__ __forceinline__ float xq_sum(float x) {
    x += __shfl_xor(x, 16); x += __shfl_xor(x, 32); return x;
}
__device__ __forceinline__ void ph_moe_route(const Ptrs& P, LAS unsigned char* smem, int bid, int nblk, int layer, int nrows) {
    unsigned char* ws = P.ws;
    const int tid = threadIdx.x, lane = tid & 63, wave = tid >> 6, tk = lane & 15, kq = lane >> 4;
    const float* modv_layer = (const float*)(ws + WS_MODV) + (size_t)layer * 5 * 6144;
    const float* gain = P.in[7] + layer * D;
    const float* xlat = P.out; const float* xctx = (const float*)(ws + WS_CTXS);
    bf16* H = (bf16*)(ws + WS_R1);
    int* cnt = (int*)(ws + WS_CTL) + CTL_CNT + layer * 2048; int* list = (int*)(ws + WS_LIST); float* wts = (float*)(ws + WS_WTS);
    LAS float* part = (LAS float*)smem;
    for (int task = xcd_vid(bid, nblk); task < nrows / 16; task += nblk) {
        const int row0 = task * 16; const int row = row0 + tk;
        const int br = row0 < NL ? row0 / S : 4;
        const float* xr = row < NL ? xlat + (size_t)row * D : xctx + (size_t)(row - NL) * D;
        const bf16* wt = (const bf16*)(ws + WS_WRT) + (size_t)br * 2 * 32 * 1024;
        f32x4a acc0 = {0.f, 0.f, 0.f, 0.f}, acc1 = {0.f, 0.f, 0.f, 0.f};
        float ss = 0.f;
#pragma unroll 4
        for (int s = 8 * wave; s < 8 * wave + 8; ++s) {
            const int k = 32 * s + 8 * kq;
            const f32x4 x0 = *(const f32x4*)(xr + k), x1 = *(const f32x4*)(xr + k + 4);
            ss += x0.x * x0.x + x0.y * x0.y + x0.z * x0.z + x0.w * x0.w + x1.x * x1.x + x1.y * x1.y + x1.z * x1.z + x1.w * x1.w;
            const unsigned h0 = pk2(x0.x, x0.y), h1 = pk2(x0.z, x0.w), h2 = pk2(x1.x, x1.y), h3 = pk2(x1.z, x1.w);
            const unsigned l0 = pk2(x0.x - __uint_as_float(h0 << 16), x0.y - __uint_as_float(h0 & 0xffff0000u)), l1 = pk2(x0.z - __uint_as_float(h1 << 16), x0.w - __uint_as_float(h1 & 0xffff0000u));
            const unsigned l2 = pk2(x1.x - __uint_as_float(h2 << 16), x1.y - __uint_as_float(h2 & 0xffff0000u)), l3 = pk2(x1.z - __uint_as_float(h3 << 16), x1.w - __uint_as_float(h3 & 0xffff0000u));
            u32x4 xh = {h0, h1, h2, h3}, xl = {l0, l1, l2, l3};
            const bf16x8 bh = __builtin_bit_cast(bf16x8, xh), bl = __builtin_bit_cast(bf16x8, xl);
            const bf16x8 a0h = *(const bf16x8*)(wt + (size_t)tk * 1024 + k), a1h = *(const bf16x8*)(wt + (size_t)(16 + tk) * 1024 + k);
            const bf16x8 a0l = *(const bf16x8*)(wt + (size_t)(32 + tk) * 1024 + k), a1l = *(const bf16x8*)(wt + (size_t)(48 + tk) * 1024 + k);
            acc0 = __builtin_amdgcn_mfma_f32_16x16x32_bf16(a0h, bh, acc0, 0, 0, 0); acc1 = __builtin_amdgcn_mfma_f32_16x16x32_bf16(a1h, bh, acc1, 0, 0, 0);
            acc0 = __builtin_amdgcn_mfma_f32_16x16x32_bf16(a0h, bl, acc0, 0, 0, 0); acc1 = __builtin_amdgcn_mfma_f32_16x16x32_bf16(a1h, bl, acc1, 0, 0, 0);
            acc0 = __builtin_amdgcn_mfma_f32_16x16x32_bf16(a0l, bh, acc0, 0, 0, 0); acc1 = __builtin_amdgcn_mfma_f32_16x16x32_bf16(a1l, bh, acc1, 0, 0, 0);
        }
#pragma unroll
        for (int j = 0; j < 4; ++j) { part[(wave * 9 + j) * 64 + lane] = acc0[j]; part[(wave * 9 + 4 + j) * 64 + lane] = acc1[j]; }
        part[(wave * 9 + 8) * 64 + lane] = ss;
        __syncthreads();
        float tot[9];
#pragma unroll
        for (int j = 0; j < 9; ++j) tot[j] = (part[j * 64 + lane] + part[(9 + j) * 64 + lane]) + (part[(18 + j) * 64 + lane] + part[(27 + j) * 64 + lane]);
        const float rstd = rsqrtf(xq_sum(tot[8]) * (1.f / D) + EPS);
        if (wave == 0) {
            const float* sl = (const float*)(ws + WS_SL) + br * 32;
            float gl[4], el[4];
#pragma unroll
            for (int j = 0; j < 4; ++j) { gl[j] = tot[j] * rstd + sl[j]; el[j] = tot[4 + j] * rstd + sl[16 + 4 * kq + j]; }
            int gi = 0; float gm = gl[0];
#pragma unroll
            for (int j = 1; j < 4; ++j) if (gl[j] > gm) { gm = gl[j]; gi = j; }
            if (gi == kq) {
                float gs = 0.f;
#pragma unroll
                for (int j = 0; j < 4; ++j) gs += expf(gl[j] - gm);
                const float gwt = 1.f / gs;
                int i0 = 0; float e0 = el[0];
#pragma unroll
                for (int j = 1; j < 4; ++j) if (el[j] > e0) { e0 = el[j]; i0 = j; }
                int i1 = -1; float e1 = -INFINITY;
#pragma unroll
                for (int j = 0; j < 4; ++j) if (j != i0 && el[j] > e1) { e1 = el[j]; i1 = j; }
                const float p1 = expf(e1 - e0); const float w0 = gwt / (1.f + p1), w1 = gwt * p1 / (1.f + p1);
                const int ea = i0 < i1 ? i0 : i1, eb = i0 < i1 ? i1 : i0;
                const int pidx = ea == 0 ? eb - 1 : (ea == 1 ? eb + 1 : 5);
                const int cls = gi * 6 + pidx;
                wts[(size_t)row * 2] = i0 < i1 ? w0 : w1; wts[(size_t)row * 2 + 1] = i0 < i1 ? w1 : w0;
                const int pos = atomicAdd(&cnt[cls * 64], 1);
                list[(size_t)cls * NT + pos] = row;
            }
        }
        const float* mv = modv_layer + (size_t)br * 6144;
        float rs[4];
#pragma unroll
        for (int r = 0; r < 4; ++r) rs[r] = __shfl(rstd, 4 * wave + r);
        f32x4 xv[4][4];
#pragma unroll
        for (int r = 0; r < 4; ++r) {
            const int rr = row0 + 4 * wave + r;
            const float* xp = (rr < NL ? xlat + (size_t)rr * D : xctx + (size_t)(rr - NL) * D) + 4 * lane;
#pragma unroll
            for (int jq = 0; jq < 4; ++jq) xv[r][jq] = *(const f32x4*)(xp + 256 * jq);
        }
#pragma unroll
        for (int jq = 0; jq < 4; ++jq) {
            const int k = 4 * lane + 256 * jq;
            const f32x4 g = *(const f32x4*)(gain + k), sc = *(const f32x4*)(mv + 4 * 1024 + k), sh = *(const f32x4*)(mv + 3 * 1024 + k);
            const f32x4 a = {g.x * (1.f + sc.x), g.y * (1.f + sc.y), g.z * (1.f + sc.z), g.w * (1.f + sc.w)};
#pragma unroll
            for (int r = 0; r < 4; ++r) {
                const f32x4 x = xv[r][jq];
                u32x2 o = {pk2(x.x * rs[r] * a.x + sh.x, x.y * rs[r] * a.y + sh.y), pk2(x.z * rs[r] * a.z + sh.z, x.w * rs[r] * a.w + sh.w)};
                *(u32x2*)(H + (size_t)(row0 + 4 * wave + r) * D + k) = o;
            }
        }
        __syncthreads();
    }
}

__device__ __forceinline__ void moe_tiles_init(const int* cnt, LAS int* tile0) {
    if (threadIdx.x == 0) { int a = 0; for (int c = 0; c < 24; ++c) { tile0[c] = a; a += (cnt[c * 64] + 127) >> 7; } tile0[24] = a; }
    __syncthreads();
}
struct GatherRows {
    const bf16* H; const int* lst; int n; const bf16* p[4];
    __device__ __forceinline__ void init(int r0) {
#pragma unroll
        for (int i = 0; i < 4; ++i) { const int r = r0 + 8 * i; p[i] = H + (size_t)lst[r < n ? r : 0] * D; }
    }
    __device__ __forceinline__ const bf16* ptr(int i, int kt) const { return p[i] + kt * 64; }
};
struct SplitKRows {
    const bf16* b0; const bf16* b1; size_t ld; int ksplit; const bf16* p0; const bf16* p1;
    __device__ __forceinline__ SplitKRows(const bf16* b0_, const bf16* b1_, size_t ld_, int ksplit_) : b0(b0_), b1(b1_), ld(ld_), ksplit(ksplit_), p0(b0_), p1(b1_) {}
    __device__ __forceinline__ void init(int r0) { p0 = b0 + (size_t)r0 * ld; p1 = b1 + (size_t)r0 * ld; }
    __device__ __forceinline__ const bf16* ptr(int i, int kt) const { return (kt < ksplit ? p0 + kt * 64 : p1 + (kt - ksplit) * 64) + (size_t)i * 8 * ld; }
};
struct EpiMoe1 {
    bf16* hid; const int* lst; int n; const float* wts; int nt;
    __device__ __forceinline__ bool swapped() const { return false; }
    __device__ __forceinline__ void operator()(f32x16 (&acc)[2][2], int fb, int tb, int l31, int hh, LAS unsigned char* wl) const {
        const int col = (nt >> 2) * 256 + 32 * (2 * (nt & 3) + (fb >> 6));
#pragma unroll 1
        for (int j = 0; j < 2; ++j) {
            const int r = tb + j * 32 + l31;
            const int tok = lst[r < n ? r : 0];
            const float w = wts[(size_t)tok * 2 + (nt >> 2)];
#pragma unroll
            for (int g = 0; g < 4; ++g) {
                float hv[4];
#pragma unroll
                for (int e = 0; e < 4; ++e) { const float a_ = j ? acc[0][1][4 * g + e] : acc[0][0][4 * g + e], u_ = j ? acc[1][1][4 * g + e] : acc[1][0][4 * g + e]; hv[e] = a_ / (1.f + __expf(-a_)) * u_ * w; }
                u32x2 v = {pk2(hv[0], hv[1]), pk2(hv[2], hv[3])}; *(LAS u32x2*)(wl + (32 * j + l31) * 80 + (8 * g + 4 * hh) * 2) = v;
            }
        }
        const int lane = l31 + 32 * hh, rr = lane >> 2, ch = lane & 3;
#pragma unroll
        for (int q = 0; q < 4; ++q) { const int R = 16 * q + rr; const u32x4 v = *(LAS u32x4*)(wl + R * 80 + ch * 16); *(u32x4*)(hid + (size_t)(tb + R) * 512 + col + ch * 8) = v; }
    }
};
__device__ __forceinline__ void ph_moe_stage1(const Ptrs& P, LAS unsigned char* smem, int bid, int nblk, int layer) {
    unsigned char* ws = P.ws;
    const int* cnt = (const int*)(ws + WS_CTL) + CTL_CNT + layer * 2048; const int* list = (const int*)(ws + WS_LIST);
    LAS int* tile0 = (LAS int*)(smem + GEMM_LDS);
    moe_tiles_init(cnt, tile0);
    const int lrow = threadIdx.x >> 3, kc = threadIdx.x & 7;
    const bf16* H = (const bf16*)(ws + WS_R1);
    const int nitems = tile0[24] * 8;
    for (int item = xcd_vid(bid, nblk); item < nitems; item += nblk) {
        const int tt = item >> 3, nt = item & 7;
        int c = 0; while (tile0[c + 1] <= tt) ++c;
        const int lt = tt - tile0[c], n = min(128, cnt[c * 64] - lt * 128);
        const int* lst = list + (size_t)c * NT + lt * 128;
        const int g = c / 6, pidx = c % 6; const int ea = pidx < 3 ? 0 : (pidx < 5 ? 1 : 2), eb = pidx < 3 ? pidx + 1 : (pidx < 5 ? pidx - 1 : 3);
        const int expert = g * 4 + (nt < 4 ? ea : eb);
        GatherRows af{H, lst, n, {nullptr, nullptr, nullptr, nullptr}};
        AffineRows bf_((const bf16*)(ws + WS_WGU) + ((size_t)(layer * 16 + expert) * 512 + (nt & 3) * 128) * D, D);
        EpiMoe1 epi{(bf16*)(ws + WS_R3) + (size_t)tt * 128 * 512, lst, n, (const float*)(ws + WS_WTS), nt};
        gemm_tile<false>(af, bf_, D / 64, smem, epi);
    }
}
struct EpiMoe2 {
    float* xlat; float* xctx; const float* modv_layer; LAS const int* lst; int n; int nt;
    __device__ __forceinline__ bool swapped() const { return false; }
    __device__ __forceinline__ void operator()(f32x16 (&acc)[2][2], int fb, int tb, int l31, int hh, LAS unsigned char* wl) const {
        const int c0 = nt * 128 + fb;
        rmw_f32_T(acc, [&](int R, const float*& sp, float*& dp, const float*& gp) {
            const int r = tb + R; if (r >= n) return false;
            const int tok = lst[r];
            float* xr = (tok < NL ? xlat + (size_t)tok * D : xctx + (size_t)(tok - NL) * D) + c0;
            sp = xr; dp = xr; gp = modv_layer + (size_t)(tok < NL ? tok / S : 4) * 6144 + 5 * 1024 + c0; return true; }, l31, hh, wl);
    }
};
__device__ __forceinline__ void ph_moe_stage2(const Ptrs& P, LAS unsigned char* smem, int bid, int nblk, int layer) {
    unsigned char* ws = P.ws;
    const int* cnt = (const int*)(ws + WS_CTL) + CTL_CNT + layer * 2048; const int* list = (const int*)(ws + WS_LIST);
    LAS int* tile0 = (LAS int*)(smem + GEMM_LDS);
    moe_tiles_init(cnt, tile0);
    const int lrow = threadIdx.x >> 3, kc = threadIdx.x & 7;
    const int nitems = tile0[24] * 8;
    for (int item = xcd_vid(bid, nblk); item < nitems; item += nblk) {
        const int tt = item >> 3, nt = item & 7;
        int c = 0; while (tile0[c + 1] <= tt) ++c;
        const int lt = tt - tile0[c], n = min(128, cnt[c * 64] - lt * 128);
        const int* lst = list + (size_t)c * NT + lt * 128;
        const int g = c / 6, pidx = c % 6; const int ea = pidx < 3 ? 0 : (pidx < 5 ? 1 : 2), eb = pidx < 3 ? pidx + 1 : (pidx < 5 ? pidx - 1 : 3);
        AffineRows af((const bf16*)(ws + WS_R3) + (size_t)tt * 128 * 512, 512);
        const bf16* wd = (const bf16*)(ws + WS_WD);
        SplitKRows bf_(wd + ((size_t)(layer * 16 + g * 4 + ea) * 1024 + nt * 128) * 256, wd + ((size_t)(layer * 16 + g * 4 + eb) * 1024 + nt * 128) * 256, 256, 4);
        LAS int* toks = (LAS int*)(smem + GEMM_LDS + 256);
        __syncthreads();
        if (threadIdx.x < 128) toks[threadIdx.x] = lst[threadIdx.x < n ? threadIdx.x : 0];
        EpiMoe2 epi{P.out, (float*)(ws + WS_CTXS), (const float*)(ws + WS_MODV) + (size_t)layer * 5 * 6144, toks, n, nt};
        gemm_tile<false>(af, bf_, 8, smem, epi);
    }
}

constexpr size_t GLA_ST = 8192;
constexpr size_t WS_DEC = WS_WTS + (size_t)NT * 2 * 4;
static_assert(WS_DEC + (size_t)32 * 68 * 64 * 4 <= 256 * MiB, "ws dec");
__device__ __forceinline__ void gla_chunk_geom(int b, int M, size_t& row0, int& vcol0, int& c0, int& c1) {
    if (M < 4) { row0 = (size_t)NL + b * CL + 64 * M; vcol0 = S + 64 * M; c0 = M; c1 = 3 - M; }
    else { const int Ml = M - 4; row0 = (size_t)b * S + 64 * Ml; vcol0 = 64 * Ml; c0 = 4 + Ml; c1 = 4 + 63 - Ml; }
}
template <bool PASS_C>
__device__ __forceinline__ float gla_prep(const float (&gw)[16], float gb, int dir, LAS unsigned char* out, LAS const unsigned char* qraw, LAS const unsigned char* kraw, LAS const float* lrs, LAS float* tot) {
    const int tid = threadIdx.x, k = tid & 63, grp = tid >> 6;
    float gl[16];
#pragma unroll
    for (int j = 0; j < 16; ++j) {
        const int p = 16 * grp + j; float z = gb;
#pragma unroll
        for (int r4 = 0; r4 < 4; ++r4) { const f32x4 l4 = *(LAS const f32x4*)(lrs + p * 16 + r4 * 4); z += l4.x * gw[4 * r4] + l4.y * gw[4 * r4 + 1] + l4.z * gw[4 * r4 + 2] + l4.w * gw[4 * r4 + 3]; }
        gl[j] = (fminf(z, 0.f) - __logf(1.f + __expf(-fabsf(z)))) * (1.f / 16.f);
    }
    if (dir == 0) {
#pragma unroll
        for (int j = 1; j < 16; ++j) gl[j] += gl[j - 1];
        tot[grp * 64 + k] = gl[15];
    } else {
#pragma unroll
        for (int j = 14; j >= 0; --j) gl[j] += gl[j + 1];
        tot[grp * 64 + k] = gl[0];
    }
    __syncthreads();
    const float t0 = tot[k], t1 = tot[64 + k], t2 = tot[128 + k], t3 = tot[192 + k];
    const float bend = t0 + t1 + t2 + t3;
    float offs;
    if (dir == 0) offs = grp == 0 ? 0.f : grp == 1 ? t0 : grp == 2 ? t0 + t1 : t0 + t1 + t2;
    else offs = grp == 3 ? 0.f : grp == 2 ? t3 : grp == 1 ? t3 + t2 : t3 + t2 + t1;
    if (PASS_C) {
#pragma unroll
        for (int j = 0; j < 16; ++j) {
            const int p = 16 * grp + j; const float bp = gl[j] + offs;
            const float q = bf2f(*(LAS const bf16*)(qraw + p * 128 + k * 2)) * 0.125f, kk = bf2f(*(LAS const bf16*)(kraw + p * 128 + k * 2));
            *(LAS bf16*)(out + p * 144 + k * 2) = f2bf(q * __expf(bp));
            *(LAS bf16*)(out + 9216 + p * 144 + k * 2) = f2bf(q * __expf(bp - bend));
            *(LAS bf16*)(out + 18432 + p * 144 + k * 2) = f2bf(kk * __expf(bend - bp));
        }
    } else {
        float kt[16];
#pragma unroll
        for (int j = 0; j < 16; ++j) { const int p = 16 * grp + j; const float bp = gl[j] + offs; kt[j] = bf2f(*(LAS const bf16*)(kraw + p * 128 + k * 2)) * __expf(bend - bp); }
        u32x4 w0 = {pk2(kt[0], kt[1]), pk2(kt[2], kt[3]), pk2(kt[4], kt[5]), pk2(kt[6], kt[7])}, w1 = {pk2(kt[8], kt[9]), pk2(kt[10], kt[11]), pk2(kt[12], kt[13]), pk2(kt[14], kt[15])};
        *(LAS u32x4*)(out + k * 144 + grp * 32) = w0; *(LAS u32x4*)(out + k * 144 + grp * 32 + 16) = w1;
    }
    return __expf(bend);
}
#define GLA_LOAD_GW(gw, gb, dir, h) do { _Pragma("unroll") for (int r_ = 0; r_ < 16; ++r_) gw[r_] = P.in[10][((dir) * 16 + r_) * 256 + (h) * 64 + (threadIdx.x & 63)]; gb = P.in[11][(dir) * 256 + (h) * 64 + (threadIdx.x & 63)]; } while (0)

constexpr int GA_KTT = 0, GA_VT = 9216, GA_KRAW = GA_VT + 128 * 144, GA_LRS = GA_KRAW + 8192, GA_TOT = GA_LRS + 4096, GLA_A_LDS = GA_TOT + 1024;
__device__ __forceinline__ void gla_pass_a_item(const Ptrs& P, int item, LAS unsigned char* lds) {
    const int tid = threadIdx.x, lane = tid & 63, wave = tid >> 6, l31 = lane & 31, hh = lane >> 5;
    const int M = item % 68, dir = (item / 68) & 1, h = (item / 136) & 3, b = item / 544;
    size_t row0; int vcol0, c0, c1; gla_chunk_geom(b, M, row0, vcol0, c0, c1);
    const int sidx = ((b * 4 + h) * 2 + dir) * 68 + (dir ? c1 : c0);
    const unsigned char* r3 = P.ws + WS_R3;
    u32x4 vt[4], kr[2]; f32x4 lr; float gw[16], gb;
    { const bf16* gvt = (const bf16*)(r3 + R3_GV) + (size_t)(b * 4 + h) * 128 * VT_LD + vcol0;
#pragma unroll
      for (int i = 0; i < 4; ++i) { const int c = tid + 256 * i; vt[i] = *(const u32x4*)(gvt + (size_t)(c >> 3) * VT_LD + (c & 7) * 8); }
      const bf16* gk = (const bf16*)(r3 + R3_GK) + row0 * 256 + h * 64;
#pragma unroll
      for (int i = 0; i < 2; ++i) { const int c = tid + 256 * i; kr[i] = *(const u32x4*)(gk + (size_t)(c >> 3) * 256 + (c & 7) * 8); }
      lr = *(const f32x4*)((const float*)(r3 + R3_LR) + (row0 + (tid >> 2)) * 32 + dir * 16 + (tid & 3) * 4);
      GLA_LOAD_GW(gw, gb, dir, h); }
#pragma unroll
    for (int i = 0; i < 4; ++i) { const int c = tid + 256 * i; *(LAS u32x4*)(lds + GA_VT + (c >> 3) * 144 + (c & 7) * 16) = vt[i]; }
#pragma unroll
    for (int i = 0; i < 2; ++i) { const int c = tid + 256 * i; *(LAS u32x4*)(lds + GA_KRAW + (c >> 3) * 128 + (c & 7) * 16) = kr[i]; }
    *(LAS f32x4*)(lds + GA_LRS + tid * 16) = lr;
    __syncthreads();
    const float dec = gla_prep<false>(gw, gb, dir, lds + GA_KTT, lds + GA_KRAW, lds + GA_KRAW, (LAS const float*)(lds + GA_LRS), (LAS float*)(lds + GA_TOT));
    if (tid < 64) ((float*)(P.ws + WS_DEC))[(size_t)sidx * 64 + tid] = dec;
    __syncthreads();
    f32x16 acc[2];
#pragma unroll
    for (int kt = 0; kt < 2; ++kt)
#pragma unroll
        for (int r = 0; r < 16; ++r) acc[kt][r] = 0.f;
#pragma unroll
    for (int ps = 0; ps < 4; ++ps) {
        const bf16x8 vf = *(LAS bf16x8*)(lds + GA_VT + (32 * wave + l31) * 144 + ps * 32 + hh * 16);
#pragma unroll
        for (int kt = 0; kt < 2; ++kt) { const bf16x8 kf = *(LAS bf16x8*)(lds + GA_KTT + (32 * kt + l31) * 144 + ps * 32 + hh * 16); acc[kt] = __builtin_amdgcn_mfma_f32_32x32x16_bf16(kf, vf, acc[kt], 0, 0, 0); }
    }
    bf16* ds = (bf16*)(P.ws + WS_R1) + (size_t)sidx * GLA_ST + (size_t)(32 * wave + l31) * 64 + 4 * hh;
#pragma unroll
    for (int kt = 0; kt < 2; ++kt)
#pragma unroll
        for (int g = 0; g < 4; ++g) { u32x2 v = {pk2(acc[kt][4 * g], acc[kt][4 * g + 1]), pk2(acc[kt][4 * g + 2], acc[kt][4 * g + 3])}; *(u32x2*)(ds + kt * 32 + 8 * g) = v; }
    __syncthreads();
}
__device__ __forceinline__ void ph_gla_a(const Ptrs& P, LAS unsigned char* smem, int bid, int nblk) {
    for (int item = bid; item < 4 * 4 * 2 * 68; item += nblk) gla_pass_a_item(P, item, smem);
}
__device__ __forceinline__ void gla_pass_b(const Ptrs& P, int gtid, int nthreads) {
    const bf16* DS = (const bf16*)(P.ws + WS_R1); bf16* SIN = (bf16*)(P.ws + WS_R4); const float* DEC = (const float*)(P.ws + WS_DEC);
    for (int idx = gtid; idx < 32 * 2048; idx += nthreads) {
        const int bhd = idx >> 11, e4 = idx & 2047, k4 = (e4 & 15) * 4;
        float s0 = 0.f, s1 = 0.f, s2 = 0.f, s3 = 0.f;
#pragma unroll 17
        for (int c = 0; c < 68; ++c) {
            const size_t sidx = (size_t)bhd * 68 + c;
            u32x2 o = {pk2(s0, s1), pk2(s2, s3)};
            *(u32x2*)(SIN + sidx * GLA_ST + e4 * 4) = o;
            const f32x4 d = *(const f32x4*)(DEC + sidx * 64 + k4);
            const u32x2 w = *(const u32x2*)(DS + sidx * GLA_ST + e4 * 4);
            s0 = s0 * d.x + __uint_as_float(w.x << 16); s1 = s1 * d.y + __uint_as_float(w.x & 0xffff0000u);
            s2 = s2 * d.z + __uint_as_float(w.y << 16); s3 = s3 * d.w + __uint_as_float(w.y & 0xffff0000u);
        }
    }
}

constexpr int GC_QT = 0, GC_QA = 9216, GC_KT = 18432, GC_VT = 27648, GC_QRAW = GC_VT + 128 * 136, GC_KRAW = GC_QRAW + 8192, GC_LRS = GC_KRAW + 8192, GC_TOT = GEMM_LDS + 256, GC_XCH = GC_TOT + 1024;
static_assert(GC_LRS + 4096 <= GEMM_LDS, "gla c lds");
__device__ __forceinline__ void gla_pass_c_item(const Ptrs& P, int item, LAS unsigned char* lds) {
    const int tid = threadIdx.x, lane = tid & 63, wave = tid >> 6, l31 = lane & 31, hh = lane >> 5, pt = wave & 1, vh = wave >> 1;
    const int M = item % 68, h = (item / 68) & 3, b = item / 272;
    size_t row0; int vcol0, c0, c1; gla_chunk_geom(b, M, row0, vcol0, c0, c1);
    const unsigned char* r3 = P.ws + WS_R3;
    u32x4 vt[4], qr[2], kr[2]; f32x4 lr0, lr1; float gw[16], gb;
    { const bf16* gvt = (const bf16*)(r3 + R3_GV) + (size_t)(b * 4 + h) * 128 * VT_LD + vcol0;
#pragma unroll
      for (int i = 0; i < 4; ++i) { const int c = tid + 256 * i; vt[i] = *(const u32x4*)(gvt + (size_t)(c >> 3) * VT_LD + (c & 7) * 8); }
      const bf16* gq = (const bf16*)(r3 + R3_GQ) + row0 * 256 + h * 64; const bf16* gk = (const bf16*)(r3 + R3_GK) + row0 * 256 + h * 64;
#pragma unroll
      for (int i = 0; i < 2; ++i) { const int c = tid + 256 * i; qr[i] = *(const u32x4*)(gq + (size_t)(c >> 3) * 256 + (c & 7) * 8); kr[i] = *(const u32x4*)(gk + (size_t)(c >> 3) * 256 + (c & 7) * 8); }
      const float* lrp = (const float*)(r3 + R3_LR) + (row0 + (tid >> 2)) * 32 + (tid & 3) * 4;
      lr0 = *(const f32x4*)lrp; lr1 = *(const f32x4*)(lrp + 16);
      GLA_LOAD_GW(gw, gb, 0, h); }
#pragma unroll
    for (int i = 0; i < 4; ++i) { const int c = tid + 256 * i; LAS unsigned char* vp = lds + GC_VT + (c >> 3) * 136 + (c & 7) * 16; u32x2 lo = {vt[i].x, vt[i].y}, hi = {vt[i].z, vt[i].w}; *(LAS u32x2*)vp = lo; *(LAS u32x2*)(vp + 8) = hi; }
#pragma unroll
    for (int i = 0; i < 2; ++i) { const int c = tid + 256 * i; *(LAS u32x4*)(lds + GC_QRAW + (c >> 3) * 128 + (c & 7) * 16) = qr[i]; *(LAS u32x4*)(lds + GC_KRAW + (c >> 3) * 128 + (c & 7) * 16) = kr[i]; }
    *(LAS f32x4*)(lds + GC_LRS + tid * 16) = lr0;
    f32x16 o[2];
#pragma unroll
    for (int i = 0; i < 2; ++i)
#pragma unroll
        for (int r = 0; r < 16; ++r) o[i][r] = 0.f;
    const bf16* SIN = (const bf16*)(P.ws + WS_R4);
    __syncthreads();
#pragma unroll 1
    for (int dir = 0; dir < 2; ++dir) {
        const int sidx = ((b * 4 + h) * 2 + dir) * 68 + (dir ? c1 : c0);
        (void)gla_prep<true>(gw, gb, dir, lds + GC_QT, lds + GC_QRAW, lds + GC_KRAW, (LAS const float*)(lds + GC_LRS), (LAS float*)(lds + GC_TOT));
        bf16x8 sf[2][4];
#pragma unroll
        for (int i = 0; i < 2; ++i)
#pragma unroll
            for (int ks = 0; ks < 4; ++ks) sf[i][ks] = *(const bf16x8*)(SIN + (size_t)sidx * GLA_ST + (size_t)(64 * vh + 32 * i + l31) * 64 + 16 * ks + 8 * hh);
        if (dir == 0) { *(LAS f32x4*)(lds + GC_LRS + tid * 16) = lr1; GLA_LOAD_GW(gw, gb, 1, h); }
        __syncthreads();
        f32x16 at[2];
#pragma unroll
        for (int st = 0; st < 2; ++st) {
#pragma unroll
            for (int r = 0; r < 16; ++r) at[st][r] = 0.f;
#pragma unroll
            for (int ks = 0; ks < 4; ++ks) {
                const bf16x8 ka = *(LAS bf16x8*)(lds + GC_KT + (32 * st + l31) * 144 + ks * 32 + hh * 16);
                const bf16x8 qa = *(LAS bf16x8*)(lds + GC_QA + (32 * pt + l31) * 144 + ks * 32 + hh * 16);
                at[st] = __builtin_amdgcn_mfma_f32_32x32x16_bf16(ka, qa, at[st], 0, 0, 0);
            }
            const int pq = 32 * pt + l31;
#pragma unroll
            for (int r = 0; r < 16; ++r) { const int s_ = 32 * st + (r & 3) + 8 * (r >> 2) + 4 * hh; const bool ok = dir ? (s_ >= pq) : (s_ <= pq); if (!ok) at[st][r] = 0.f; }
        }
#pragma unroll
        for (int ks = 0; ks < 4; ++ks) {
            const bf16x8 qt = *(LAS bf16x8*)(lds + GC_QT + (32 * pt + l31) * 144 + ks * 32 + hh * 16);
#pragma unroll
            for (int i = 0; i < 2; ++i) o[i] = __builtin_amdgcn_mfma_f32_32x32x16_bf16(sf[i][ks], qt, o[i], 0, 0, 0);
        }
#pragma unroll
        for (int st = 0; st < 2; ++st)
#pragma unroll
            for (int s2 = 0; s2 < 2; ++s2) {
                u32x4 pw = {pk2(at[st][8 * s2], at[st][8 * s2 + 1]), pk2(at[st][8 * s2 + 2], at[st][8 * s2 + 3]), pk2(at[st][8 * s2 + 4], at[st][8 * s2 + 5]), pk2(at[st][8 * s2 + 6], at[st][8 * s2 + 7])};
                const bf16x8 pf = __builtin_bit_cast(bf16x8, pw);
#pragma unroll
                for (int i = 0; i < 2; ++i) {
                    LAS unsigned char* vp = lds + GC_VT + (64 * vh + 32 * i + l31) * 136 + (32 * st + 16 * s2 + 4 * hh) * 2;
                    const u32x2 v0 = *(LAS u32x2*)vp, v1 = *(LAS u32x2*)(vp + 16);
                    u32x4 vw = {v0.x, v0.y, v1.x, v1.y};
                    o[i] = __builtin_amdgcn_mfma_f32_32x32x16_bf16(__builtin_bit_cast(bf16x8, vw), pf, o[i], 0, 0, 0);
                }
            }
        __syncthreads();
    }
    float ss = 0.f;
#pragma unroll
    for (int i = 0; i < 2; ++i)
#pragma unroll
        for (int r = 0; r < 16; ++r) ss += o[i][r] * o[i][r];
    ss = xhalf_sum(ss);
    LAS float* xch = (LAS float*)(lds + GC_XCH);
    if (hh == 0) xch[(pt * 2 + vh) * 32 + l31] = ss;
    __syncthreads();
    ss += xch[(pt * 2 + (1 - vh)) * 32 + l31];
    const float rstd = rsqrtf(ss * (1.f / 128.f) + EPS);
    const size_t trow = row0 + 32 * pt + l31;
    const bf16* gr = (const bf16*)(P.ws + WS_R3 + R3_GR) + trow * 512 + h * 128 + 64 * vh + 4 * hh;
    bf16* mx = (bf16*)(P.ws + WS_R2) + trow * 1024 + h * 128 + 64 * vh + 4 * hh;
    const float* gn = P.in[12] + 64 * vh + 4 * hh;
#pragma unroll
    for (int i = 0; i < 2; ++i)
#pragma unroll
        for (int g = 0; g < 4; ++g) {
            const u32x2 rw = *(const u32x2*)(gr + i * 32 + 8 * g); const f32x4 gg = *(const f32x4*)(gn + i * 32 + 8 * g);
            const float r0 = __uint_as_float(rw.x << 16), r1 = __uint_as_float(rw.x & 0xffff0000u), r2 = __uint_as_float(rw.y << 16), r3_ = __uint_as_float(rw.y & 0xffff0000u);
            const float y0 = o[i][4 * g] * rstd * gg.x * (r0 / (1.f + __expf(-r0))), y1 = o[i][4 * g + 1] * rstd * gg.y * (r1 / (1.f + __expf(-r1)));
            const float y2 = o[i][4 * g + 2] * rstd * gg.z * (r2 / (1.f + __expf(-r2))), y3 = o[i][4 * g + 3] * rstd * gg.w * (r3_ / (1.f + __expf(-r3_)));
            u32x2 v = {pk2(y0, y1), pk2(y2, y3)}; *(u32x2*)(mx + i * 32 + 8 * g) = v;
        }
    __syncthreads();
}
__device__ __forceinline__ void ph_gla_c(const Ptrs& P, LAS unsigned char* smem, int bid, int nblk) {
    for (int item = bid; item < 4 * 4 * 68; item += nblk) gla_pass_c_item(P, item, smem);
}

#define XB_TMO      128
#define XB_XCNT(j)  (256  + 64 * (j))
#define XB_XSUB(j)  (1280 + 64 * (j))
#define XB_XGEN(j)  (2304 + 64 * (j))
#define XB_TOP      3328
#define XB_TOPGEN   3392
#define XB_SPIN_CAP (1u << 20)
constexpr int CTL_BAR = 4096;
__device__ __forceinline__ unsigned xb_ld(unsigned* p) { return __hip_atomic_load(p, __ATOMIC_RELAXED, __HIP_MEMORY_SCOPE_AGENT); }
__device__ __forceinline__ unsigned xb_add(unsigned* p, unsigned v) { return __hip_atomic_fetch_add(p, v, __ATOMIC_RELAXED, __HIP_MEMORY_SCOPE_AGENT); }
__device__ __forceinline__ unsigned xb_xcc_id() { return (unsigned)__builtin_amdgcn_s_getreg((3 << 11) | 20) & 0xFu; }
#define XB_SPIN(cond, bar) do { unsigned _sp = 0; while (cond) { __builtin_amdgcn_s_sleep(1); \
    if ((++_sp & 255u) == 0u) { if (xb_ld(&(bar)[XB_TMO])) break; if (_sp > XB_SPIN_CAP) { atomicAdd(&(bar)[XB_TMO], 1u); break; } } } } while (0)
struct XcdBarrier { unsigned* bar; unsigned x; volatile LAS unsigned* st; };
__device__ __forceinline__ XcdBarrier xcd_barrier_post(unsigned* bar, volatile LAS unsigned* st) {
    XcdBarrier b; b.bar = bar; b.x = xb_xcc_id(); b.st = st;
    if (threadIdx.x == 0) (void)xb_add(&bar[XB_XCNT(b.x)], 1u);
    return b;
}
__device__ __forceinline__ void xcd_barrier_complete(unsigned* bar, unsigned x, unsigned& nloc, unsigned& nx) {
    const unsigned G = gridDim.x * gridDim.y * gridDim.z;
    unsigned sum, cnt, mine, sp = 0u;
    for (;;) {
        sum = 0u; cnt = 0u; mine = 0u;
#pragma unroll
        for (unsigned j = 0; j < 16; ++j) { const unsigned c = xb_ld(&bar[XB_XCNT(j)]); sum += c; cnt += (c > 0u) ? 1u : 0u; mine = (j == x) ? c : mine; }
        if (sum == G) break;
        __builtin_amdgcn_s_sleep(1);
        if ((++sp & 255u) == 0u) { if (xb_ld(&bar[XB_TMO])) break; if (sp > XB_SPIN_CAP) { atomicAdd(&bar[XB_TMO], 1u); break; } }
    }
    nloc = mine > 0u ? mine : 1u; nx = cnt > 0u ? cnt : 1u;
}
__device__ __forceinline__ void xcd_barrier(const XcdBarrier& b) {
    asm volatile("s_waitcnt vmcnt(0)" ::: "memory");
    __syncthreads();
    if (threadIdx.x == 0) {
        unsigned* bar = b.bar;
        __builtin_amdgcn_s_waitcnt(0);
        unsigned nloc = b.st[0], nx = b.st[1];
        if (nloc == 0u) { xcd_barrier_complete(bar, b.x, nloc, nx); b.st[0] = nloc; b.st[1] = nx; }
        const unsigned old = xb_add(&bar[XB_XSUB(b.x)], 1u);
        const unsigned gen = old / nloc;
        if (old + 1u == (gen + 1u) * nloc) {
            __builtin_amdgcn_fence(__ATOMIC_RELEASE, "agent");
            asm volatile("s_waitcnt vmcnt(0)" ::: "memory");
            const unsigned og = xb_add(&bar[XB_TOP], 1u);
            const unsigned tg = og / nx;
            if (og + 1u == (tg + 1u) * nx) xb_add(&bar[XB_TOPGEN], 1u);
            else XB_SPIN(xb_ld(&bar[XB_TOPGEN]) == tg, bar);
            __builtin_amdgcn_fence(__ATOMIC_ACQUIRE, "agent");
            xb_add(&bar[XB_XGEN(b.x)], 1u);
            asm volatile("s_waitcnt vmcnt(0)" ::: "memory");
        } else {
            XB_SPIN(xb_ld(&bar[XB_XGEN(b.x)]) == gen, bar);
            __builtin_amdgcn_fence(__ATOMIC_ACQUIRE, "agent");
            asm volatile("s_waitcnt vmcnt(0)" ::: "memory");
        }
    }
    __syncthreads();
}

constexpr int N_PHASES = 18;
constexpr int SMEM_BYTES = GEMM_LDS + 2048;
struct Args { Ptrs P; int ph_lo, ph_hi; };
__global__ void __launch_bounds__(256, 2) fwd_megakernel(Args args) {
    __shared__ __attribute__((aligned(16))) unsigned char smem_raw[SMEM_BYTES];
    LAS unsigned char* smem = (LAS unsigned char*)smem_raw;
    const Ptrs& P = args.P;
    const int bid = blockIdx.x, nblk = gridDim.x;
    volatile LAS unsigned* bst = (volatile LAS unsigned*)(smem + GEMM_LDS + 128);
    if (threadIdx.x < 2) bst[threadIdx.x] = 0u;
    __syncthreads();
    XcdBarrier bar; bar.bar = (unsigned*)(P.ws + WS_CTL) + CTL_BAR; bar.x = 0; bar.st = bst;
    const bool multi = args.ph_hi - args.ph_lo > 1;
    if (multi) bar = xcd_barrier_post((unsigned*)(P.ws + WS_CTL) + CTL_BAR, bst);
    const int lo = args.ph_lo, hi = args.ph_hi;
#define PHASE(k, call) if (lo <= (k) && (k) < hi) { if ((k) > lo) xcd_barrier(bar); call; }
    PHASE(0, ph_prologue(P, smem, bid, nblk))
    PHASE(1, ph_modulate(P, 0, bid, nblk))
    PHASE(2, ph_even_inproj(P, smem, bid, nblk))
    PHASE(3, ph_gla_a(P, smem, bid, nblk))
    PHASE(4, gla_pass_b(P, bid * 256 + threadIdx.x, nblk * 256))
    PHASE(5, (ph_dense_attn(P, smem, bid, nblk), __syncthreads(), ph_gla_c(P, smem, (bid + nblk - 128) % nblk, nblk)))
    PHASE(7, ph_outproj(P, smem, bid, nblk, 0, NT))
    PHASE(8, ph_moe_route(P, smem, bid, nblk, 0, NT))
    PHASE(9, ph_moe_stage1(P, smem, bid, nblk, 0))
    PHASE(10, ph_moe_stage2(P, smem, bid, nblk, 0))
    PHASE(11, ph_modulate(P, 1, bid, nblk))
    PHASE(12, ph_odd_inproj(P, smem, bid, nblk))
    PHASE(13, ph_swa_attn(P, smem, bid, nblk))
    PHASE(14, ph_outproj(P, smem, bid, nblk, 1, NL))
    PHASE(15, ph_moe_route(P, smem, bid, nblk, 1, NL))
    PHASE(16, ph_moe_stage1(P, smem, bid, nblk, 1))
    PHASE(17, ph_moe_stage2(P, smem, bid, nblk, 1))
#undef PHASE
}

#ifndef MK_LAUNCHES
#define MK_LAUNCHES 1
#endif
extern "C" void kernel_launch(void* const* d_in, const int* in_sizes, int n_in, void* d_out, int out_size, void* d_ws, size_t ws_size, hipStream_t stream) {
    static int grid = 0;
    if (grid == 0) {
        int dev = 0, cus = 0, per_cu = 0;
        hipGetDevice(&dev);
        hipDeviceGetAttribute(&cus, hipDeviceAttributeMultiprocessorCount, dev);
        hipOccupancyMaxActiveBlocksPerMultiprocessor(&per_cu, (const void*)fwd_megakernel, 256, 0);
        if (per_cu > 2) per_cu = 2;
        if (per_cu < 1) per_cu = 1;
        grid = cus * per_cu;
    }
    hipMemsetAsync((unsigned char*)d_ws + WS_CTL, 0, 65536, stream);
    Args a{};
    for (int i = 0; i < 27; ++i) a.P.in[i] = (const float*)d_in[i];
    a.P.out = (float*)d_out; a.P.ws = (unsigned char*)d_ws;
#if MK_LAUNCHES == 1
    a.ph_lo = 0; a.ph_hi = N_PHASES;
    void* kargs[] = {&a};
    hipLaunchCooperativeKernel((const void*)fwd_megakernel, dim3(grid), dim3(256), kargs, 0, stream);
#else
    for (int ph = 0; ph < N_PHASES; ++ph) { a.ph_lo = ph; a.ph_hi = ph + 1; hipLaunchKernelGGL(fwd_megakernel, dim3(grid), dim3(256), 0, stream, a); }
#endif
}
```

```cpp
#include <hip/hip_runtime.h>
#include <stdint.h>

typedef unsigned short bf16;
__device__ __forceinline__ float bf2f(bf16 v) { return __uint_as_float(((unsigned)v) << 16); }
__device__ __forceinline__ bf16 f2bf(float f) { unsigned u = __float_as_uint(f); return (bf16)((u + 0x7fffu + ((u >> 16) & 1u)) >> 16); }

constexpr int D = 1024, NB = 4, S = 4096, CL = 256, NL = NB * S, NC = NB * CL, NT = NL + NC;
constexpr int EVEN_IN = 2336, ODD_IN = 1280;
constexpr float EPS = 1e-6f;

__device__ __forceinline__ float silu(float x) { return x / (1.f + expf(-x)); }
__device__ __forceinline__ float wave_sum(float v) {
#pragma unroll
    for (int o = 1; o < 64; o <<= 1) v += __shfl_xor(v, o);
    return v;
}

#define LAS __attribute__((address_space(3)))
typedef short bf16x8 __attribute__((ext_vector_type(8)));
typedef float f32x16 __attribute__((ext_vector_type(16)));
typedef float f32x4 __attribute__((ext_vector_type(4)));
typedef unsigned u32x4 __attribute__((ext_vector_type(4)));
typedef unsigned u32x2 __attribute__((ext_vector_type(2)));
typedef __bf16 bf16x2_t __attribute__((ext_vector_type(2)));
typedef float f32x2_t __attribute__((ext_vector_type(2)));
__device__ __forceinline__ unsigned pk2(float lo, float hi) { f32x2_t v = {lo, hi}; bf16x2_t b = __builtin_convertvector(v, bf16x2_t); return __builtin_bit_cast(unsigned, b); }
__device__ __forceinline__ float xhalf_sum(float x) {
    auto t = __builtin_amdgcn_permlane32_swap(__float_as_uint(x), __float_as_uint(x), false, false);
    return __uint_as_float(t[0]) + __uint_as_float(t[1]);
}

constexpr int NPAD_E = 2432;
constexpr int TILE_LDS = 128 * 128;
constexpr int GEMM_LDS = 4 * TILE_LDS;

__device__ __forceinline__ void transpose_item(const float* W, int K, int N, bf16* WT, int dst_row0, int k0, int n0, LAS float* scr, int lane) {
    float tv[32];
#pragma unroll
    for (int i = 0; i < 32; ++i) tv[i] = W[(size_t)(k0 + 2 * i + (lane >> 5)) * N + n0 + (lane & 31)];
#pragma unroll
    for (int i = 0; i < 32; ++i) scr[(2 * i + (lane >> 5)) * 33 + (lane & 31)] = tv[i];
    asm volatile("s_waitcnt lgkmcnt(0)" ::: "memory");
    const int c = lane & 7;
#pragma unroll
    for (int j = 0; j < 4; ++j) {
        const int n = (lane >> 3) + 8 * j; const LAS float* s = scr + (8 * c) * 33 + n;
        u32x4 o; o.x = pk2(s[0 * 33], s[1 * 33]); o.y = pk2(s[2 * 33], s[3 * 33]); o.z = pk2(s[4 * 33], s[5 * 33]); o.w = pk2(s[6 * 33], s[7 * 33]);
        *(u32x4*)(WT + (size_t)(dst_row0 + n) * K + k0 + 8 * c) = o;
    }
    asm volatile("s_waitcnt lgkmcnt(0)" ::: "memory");
}

struct Ptrs {
    const float* in[27];
    float* out;
    unsigned char* ws;
};

constexpr size_t MiB = 1u << 20;
constexpr size_t WS_CTL = 0;
constexpr size_t WS_MODV = 1 * MiB;
constexpr size_t WS_ROPE = WS_MODV + 256 * 1024;
constexpr size_t WS_WINE = 2 * MiB;
constexpr size_t WS_WOUTE = WS_WINE + (size_t)NPAD_E * 1024 * 2;
constexpr size_t WS_WINO = WS_WOUTE + 2 * MiB;
constexpr size_t WS_WOUTO = WS_WINO + (size_t)1280 * 1024 * 2;
constexpr size_t WS_WGU = WS_WOUTO + 2 * MiB;
constexpr size_t WS_WD = WS_WGU + 32 * MiB;
constexpr size_t WS_CTXS = WS_WD + 16 * MiB;
constexpr size_t WS_R1 = 66 * MiB;
constexpr size_t WS_R4 = WS_R1 + 34 * MiB;
constexpr size_t WS_R2 = WS_R4 + 34 * MiB;
constexpr size_t WS_R3 = WS_R2 + 34 * MiB;
static_assert(WS_CTXS + 4 * MiB <= WS_R1, "ws map");
constexpr size_t R3_GQ = 0, R3_GK = R3_GQ + (size_t)NT * 256 * 2, R3_GV = R3_GK + (size_t)NT * 256 * 2, R3_GR = R3_GV + (size_t)NT * 512 * 2,
                 R3_LR = R3_GR + (size_t)NT * 512 * 2, R3_AQ = R3_LR + (size_t)NT * 32 * 4, R3_AK = R3_AQ + (size_t)NT * 512 * 2, R3_AV = R3_AK + (size_t)NT * 128 * 2,
                 R3_END = R3_AV + (size_t)NT * 128 * 2;
static_assert(WS_R3 + R3_END <= 256 * MiB, "ws map end");
constexpr size_t R3_OQ = 0, R3_OK = R3_OQ + (size_t)NL * 1024 * 2, R3_OV = R3_OK + (size_t)NT * 128 * 2;

__device__ __forceinline__ void ph_prologue(const Ptrs& P, LAS unsigned char* smem, int bid, int nblk) {
    const int lane = threadIdx.x & 63, wave = threadIdx.x >> 6;
    LAS float* scr = (LAS float*)smem + wave * 64 * 33;
    const int gw = bid * 4 + wave, NGW = nblk * 4;
    unsigned char* ws = P.ws;
    constexpr int I_WINE = 16 * 73, I_SQ = 16 * 32, I_WINO = 16 * 40, I_EXP_GU = 16 * 8, I_EXP_D = 4 * 32;
    constexpr int T_WINE = I_WINE, T_WOUTE = T_WINE + I_SQ, T_WINO = T_WOUTE + I_WINO, T_WOUTO = T_WINO + I_SQ,
                  T_G = T_WOUTO + 32 * I_EXP_GU, T_U = T_G + 32 * I_EXP_GU, T_D = T_U + 32 * I_EXP_D;
    for (int it = gw; it < T_D; it += NGW) {
        if (it < T_WINE) {
            int kb = it / 73, nb = it % 73, n0 = nb * 32;
            int dst = n0 < 1536 ? n0 : (n0 < 1568 ? n0 + 768 : n0 - 32);
            transpose_item(P.in[8], 1024, EVEN_IN, (bf16*)(ws + WS_WINE), dst, kb * 64, n0, scr, lane);
        } else if (it < T_WOUTE) { int r = it - T_WINE; transpose_item(P.in[9], 1024, 1024, (bf16*)(ws + WS_WOUTE), (r % 32) * 32, (r / 32) * 64, (r % 32) * 32, scr, lane); }
        else if (it < T_WINO) { int r = it - T_WOUTE; transpose_item(P.in[15], 1024, 1280, (bf16*)(ws + WS_WINO), (r % 40) * 32, (r / 40) * 64, (r % 40) * 32, scr, lane); }
        else if (it < T_WOUTO) { int r = it - T_WINO; transpose_item(P.in[16], 1024, 1024, (bf16*)(ws + WS_WOUTO), (r % 32) * 32, (r / 32) * 64, (r % 32) * 32, scr, lane); }
        else if (it < T_U) {
            bool up = it >= T_G; int r = it - (up ? T_G : T_WOUTO); int le = r / I_EXP_GU; r %= I_EXP_GU; int kb = r / 8, hb = r % 8;
            const float* W = (up ? P.in[25] : P.in[24]) + (size_t)le * 1024 * 256;
            transpose_item(W, 1024, 256, (bf16*)(ws + WS_WGU) + (size_t)le * 512 * 1024, 64 * hb + (up ? 32 : 0), kb * 64, hb * 32, scr, lane);
        } else {
            int r = it - T_U; int le = r / I_EXP_D; r %= I_EXP_D; int kb = r / 32, nb = r % 32;
            transpose_item(P.in[26] + (size_t)le * 256 * 1024, 256, 1024, (bf16*)(ws + WS_WD) + (size_t)le * 1024 * 256, nb * 32, kb * 64, nb * 32, scr, lane);
        }
    }
    { u32x4 z = {0, 0, 0, 0}; u32x4* p = (u32x4*)((bf16*)(ws + WS_WINE) + (size_t)EVEN_IN * 1024);
      for (int i = bid * 256 + threadIdx.x; i < 96 * 1024 * 2 / 16; i += nblk * 256) p[i] = z; }
    for (int i = bid * 256 + threadIdx.x; i < 1024; i += nblk * 256) {
        int pos = i >> 4, f = i & 15; float inv = powf(10000.f, -(float)(2 * f) / 32.f); float ang = (float)pos * inv;
        ((float2*)(ws + WS_ROPE))[i] = make_float2(cosf(ang), sinf(ang));
    }
    __syncthreads();
    {
        LAS float* sc = (LAS float*)smem;
        LAS float* red = (LAS float*)smem + 5 * 1024;
        for (int i = threadIdx.x; i < 5 * 1024; i += 256) { const float cv = i < 4096 ? P.in[1][i] : P.in[3][i - 4096]; sc[i] = cv / (1.f + expf(-cv)); }
        __syncthreads();
        for (int it = bid; it < 2 * 96; it += nblk) {
            const int layer = it / 96, col = (it % 96) * 64 + lane;
            const float* w = P.in[4] + (size_t)layer * D * 6144 + col;
            float a0 = 0.f, a1 = 0.f, a2 = 0.f, a3 = 0.f, a4 = 0.f;
#pragma unroll 32
            for (int k = 256 * wave; k < 256 * wave + 256; ++k) { const float wv = w[(size_t)k * 6144]; a0 += sc[k] * wv; a1 += sc[1024 + k] * wv; a2 += sc[2048 + k] * wv; a3 += sc[3072 + k] * wv; a4 += sc[4096 + k] * wv; }
            red[(wave * 5 + 0) * 64 + lane] = a0; red[(wave * 5 + 1) * 64 + lane] = a1; red[(wave * 5 + 2) * 64 + lane] = a2; red[(wave * 5 + 3) * 64 + lane] = a3; red[(wave * 5 + 4) * 64 + lane] = a4;
            __syncthreads();
            for (int i = threadIdx.x; i < 320; i += 256) { const int row = i >> 6, cl = i & 63;
                ((float*)(ws + WS_MODV))[((size_t)layer * 5 + row) * 6144 + (it % 96) * 64 + cl] = red[row * 64 + cl] + red[(5 + row) * 64 + cl] + red[(10 + row) * 64 + cl] + red[(15 + row) * 64 + cl] + P.in[5][layer * 6144 + (it % 96) * 64 + cl]; }
            __syncthreads();
        }
    }
}

template <bool SRC_BF>
__device__ __forceinline__ void modulate_rows(const float* xlat, const float* xctx, const bf16* xs, const float* modv_layer, const float* gain, int which, bf16* H, int nrows, int gw, int NGW, int lane) {
    for (int row = gw; row < nrows; row += NGW) {
        const float* mv = modv_layer + (size_t)(row < NL ? row / S : 4) * 6144;
        f32x4 v[4]; float ss = 0.f;
#pragma unroll
        for (int j = 0; j < 4; ++j) {
            if (SRC_BF) { const u32x2 w = *(const u32x2*)(xs + (size_t)row * D + 4 * lane + 256 * j); f32x4 t = {__uint_as_float(w.x << 16), __uint_as_float(w.x & 0xffff0000u), __uint_as_float(w.y << 16), __uint_as_float(w.y & 0xffff0000u)}; v[j] = t; }
            else { const float* xr = row < NL ? xlat + (size_t)row * D : xctx + (size_t)(row - NL) * D; v[j] = *(const f32x4*)(xr + 4 * lane + 256 * j); }
            ss += v[j].x * v[j].x + v[j].y * v[j].y + v[j].z * v[j].z + v[j].w * v[j].w;
        }
        float rstd = rsqrtf(wave_sum(ss) / D + EPS);
#pragma unroll
        for (int j = 0; j < 4; ++j) {
            int k = 4 * lane + 256 * j;
            f32x4 g = *(const f32x4*)(gain + k), sc = *(const f32x4*)(mv + (which + 1) * 1024 + k), sh = *(const f32x4*)(mv + which * 1024 + k);
            float h0 = v[j].x * rstd * g.x * (1.f + sc.x) + sh.x, h1 = v[j].y * rstd * g.y * (1.f + sc.y) + sh.y;
            float h2 = v[j].z * rstd * g.z * (1.f + sc.z) + sh.z, h3 = v[j].w * rstd * g.w * (1.f + sc.w) + sh.w;
            u32x2 o = {pk2(h0, h1), pk2(h2, h3)};
            *(u32x2*)(H + (size_t)row * D + k) = o;
        }
    }
}
__device__ __forceinline__ void route_tables(const Ptrs& P, int layer, int bid, int nblk);
__device__ __forceinline__ void ph_modulate(const Ptrs& P, int layer, int bid, int nblk) {
    route_tables(P, layer, bid, nblk);
    if (layer == 0) modulate_rows<false>(P.in[0], P.in[2], nullptr, (const float*)(P.ws + WS_MODV), P.in[6], 0, (bf16*)(P.ws + WS_R1), NT, bid * 4 + (threadIdx.x >> 6), nblk * 4, threadIdx.x & 63);
    else modulate_rows<true>(nullptr, nullptr, (const bf16*)(P.ws + WS_R4), (const float*)(P.ws + WS_MODV) + (size_t)5 * 6144, P.in[6] + D, 0, (bf16*)(P.ws + WS_R1), NT, bid * 4 + (threadIdx.x >> 6), nblk * 4, threadIdx.x & 63);
}

struct AffineRows {
    const bf16* base; size_t ld; const bf16* p0;
    __device__ __forceinline__ AffineRows(const bf16* b, size_t ld_) : base(b), ld(ld_), p0(b) {}
    __device__ __forceinline__ void init(int r0) { p0 = base + (size_t)r0 * ld; }
    __device__ __forceinline__ const bf16* ptr(int i, int kt) const { return p0 + (size_t)i * 8 * ld + kt * 64; }
};
template <bool SWP, class AF, class BF, class Epi>
__device__ __forceinline__ void gemm_tile(AF af, BF bf, int nk, LAS unsigned char* smem, const Epi& epi) {
    const int tid = threadIdx.x, lane = tid & 63, wave = tid >> 6, wn = wave & 1, wm = wave >> 1, l31 = lane & 31, hh = lane >> 5;
    const int r0 = wave * 32 + (lane >> 3);
    af.init(r0); bf.init(r0);
    __syncthreads();
    typename Epi::Pre pre; epi.prefetch(pre, wn * 64, wm * 64, l31, hh);
    __builtin_amdgcn_sched_barrier(0);
    int coff[4];
#pragma unroll
    for (int i = 0; i < 4; ++i) coff[i] = ((lane & 7) ^ (((r0 >> 1) + 4 * i) & 7)) * 8;
#define GT_STAGE(st, kt) do { _Pragma("unroll") for (int i = 0; i < 4; ++i) { \
        __builtin_amdgcn_global_load_lds((const unsigned*)(af.ptr(i, (kt)) + coff[i]), (LAS unsigned*)(smem + (st) * 2 * TILE_LDS + (wave * 4 + i) * 1024), 16, 0, 0); \
        __builtin_amdgcn_global_load_lds((const unsigned*)(bf.ptr(i, (kt)) + coff[i]), (LAS unsigned*)(smem + (st) * 2 * TILE_LDS + TILE_LDS + (wave * 4 + i) * 1024), 16, 0, 0); } } while (0)
    GT_STAGE(0, 0);
    f32x16 acc[2][2];
#pragma unroll
    for (int i = 0; i < 2; ++i)
#pragma unroll
        for (int j = 0; j < 2; ++j)
#pragma unroll
            for (int r = 0; r < 16; ++r) acc[i][j][r] = 0.f;
    const int sw = (l31 >> 1) & 7;
    int xo[4], wo[4];
#pragma unroll
    for (int s = 0; s < 4; ++s) { const int cs = ((2 * s + hh) ^ sw) * 16; xo[s] = (wm * 64 + l31) * 128 + cs; wo[s] = TILE_LDS + (wn * 64 + l31) * 128 + cs; }
    asm volatile("s_waitcnt vmcnt(0)" ::: "memory");
    __syncthreads();
    for (int kt = 0; kt < nk; ++kt) {
        const int st = kt & 1;
        if (kt + 1 < nk) GT_STAGE(st ^ 1, kt + 1);
        LAS unsigned char* sb = smem + st * 2 * TILE_LDS;
#pragma unroll
        for (int s = 0; s < 4; ++s) {
            bf16x8 wf[2], xf[2];
#pragma unroll
            for (int i = 0; i < 2; ++i) wf[i] = *(LAS bf16x8*)(sb + wo[s] + i * 4096);
#pragma unroll
            for (int j = 0; j < 2; ++j) xf[j] = *(LAS bf16x8*)(sb + xo[s] + j * 4096);
#pragma unroll
            for (int i = 0; i < 2; ++i)
#pragma unroll
                for (int j = 0; j < 2; ++j) acc[i][j] = SWP ? __builtin_amdgcn_mfma_f32_32x32x16_bf16(xf[j], wf[i], acc[i][j], 0, 0, 0)
                                                            : __builtin_amdgcn_mfma_f32_32x32x16_bf16(wf[i], xf[j], acc[i][j], 0, 0, 0);
        }
        asm volatile("s_waitcnt vmcnt(0)" ::: "memory");
        __syncthreads();
    }
#undef GT_STAGE
    { int l31e = l31, hhe = hh, we = wave; asm volatile("" : "+v"(l31e), "+v"(hhe), "+v"(we));
      epi(acc, (we & 1) * 64, (we >> 1) * 64, l31e, hhe, smem + we * 16384, pre); }
}

constexpr int SG_P = 144;
__device__ __forceinline__ void store_bf16_T(const f32x16 (&acc)[2][2], bf16* out, size_t ld, size_t trow0, int col0, int l31, int hh, LAS unsigned char* wl) {
#pragma unroll
    for (int j = 0; j < 2; ++j)
#pragma unroll
        for (int i = 0; i < 2; ++i)
#pragma unroll
            for (int g = 0; g < 4; ++g) { u32x2 v = {pk2(acc[i][j][4 * g], acc[i][j][4 * g + 1]), pk2(acc[i][j][4 * g + 2], acc[i][j][4 * g + 3])}; *(LAS u32x2*)(wl + (32 * j + l31) * SG_P + (32 * i + 8 * g + 4 * hh) * 2) = v; }
    const int lane = l31 + 32 * hh, rr = lane >> 3, ch = lane & 7;
#pragma unroll
    for (int q = 0; q < 8; ++q) { const int R = 8 * q + rr; const u32x4 v = *(LAS u32x4*)(wl + R * SG_P + ch * 16); *(u32x4*)(out + (trow0 + R) * ld + col0 + ch * 8) = v; }
}
__device__ __forceinline__ void qknorm_rope_T(f32x16 (&acc)[2][2], const float* gain, const float2* ropeT, bool latent, int tok0  , int l31, int hh) {
#pragma unroll
    for (int j = 0; j < 2; ++j) {
        float ss = 0.f;
#pragma unroll
        for (int i = 0; i < 2; ++i)
#pragma unroll
            for (int r = 0; r < 16; ++r) ss += acc[i][j][r] * acc[i][j][r];
        ss = xhalf_sum(ss);
        const float rstd = rsqrtf(ss * (1.f / 64.f) + EPS);
#pragma unroll
        for (int i = 0; i < 2; ++i)
#pragma unroll
            for (int r = 0; r < 16; ++r) acc[i][j][r] *= rstd * gain[i * 32 + (r & 3) + 8 * (r >> 2) + 4 * hh];
        if (latent) {
            const int t = tok0 + j * 32 + l31;
#pragma unroll
            for (int i = 0; i < 2; ++i) {
                const int pos = i == 0 ? (t >> 6) : (t & 63);
#pragma unroll
                for (int r = 0; r < 8; ++r) {
                    const int f = (r & 3) + 8 * (r >> 2) + 4 * hh;
                    const float2 cs = ropeT[pos * 16 + f];
                    const float x1 = acc[i][j][r], x2 = acc[i][j][r + 8];
                    acc[i][j][r] = x1 * cs.x - x2 * cs.y; acc[i][j][r + 8] = x2 * cs.x + x1 * cs.y;
                }
            }
        }
    }
}

constexpr int VT_LD = S + CL;
__device__ __forceinline__ void store_vt_swapped(const f32x16 (&acc)[2][2], bf16* vt_head  , int key0, int l31, int hh, LAS unsigned char* wl) {
#pragma unroll
    for (int i = 0; i < 2; ++i)
#pragma unroll
        for (int j = 0; j < 2; ++j)
#pragma unroll
            for (int g = 0; g < 4; ++g) { u32x2 v = {pk2(acc[i][j][4 * g], acc[i][j][4 * g + 1]), pk2(acc[i][j][4 * g + 2], acc[i][j][4 * g + 3])}; *(LAS u32x2*)(wl + (32 * i + l31) * SG_P + (32 * j + 8 * g + 4 * hh) * 2) = v; }
    const int lane = l31 + 32 * hh, rr = lane >> 3, ch = lane & 7;
#pragma unroll
    for (int q = 0; q < 8; ++q) { const int R = 8 * q + rr; const u32x4 v = *(LAS u32x4*)(wl + R * SG_P + ch * 16); *(u32x4*)(vt_head + (size_t)R * VT_LD + key0 + ch * 8) = v; }
}
struct NoPre {};
template <bool SRC_BF> struct RmwPre { f32x4 xi[16]; };
template <> struct RmwPre<true> { u32x2 xi[16]; };
template <bool SRC_BF, class RowF>
__device__ __forceinline__ void rmw_prefetch(RmwPre<SRC_BF>& pre, const RowF& rowf, int l31, int hh) {
    const int lane = l31 + 32 * hh, rr = lane >> 4, ch = lane & 15;
#pragma unroll
    for (int q = 0; q < 16; ++q) {
        const void* sp; void* dp; const float* gp;
        if (rowf(4 * q + rr, sp, dp, gp)) {
            if constexpr (SRC_BF) pre.xi[q] = *(const u32x2*)((const bf16*)sp + ch * 4); else pre.xi[q] = *(const f32x4*)((const float*)sp + ch * 4);
        }
    }
}
template <bool SRC_BF, bool DST_BF, class RowF>
__device__ __forceinline__ void rmw_finish(const f32x16 (&acc)[2][2], const RmwPre<SRC_BF>& pre, const RowF& rowf, int l31, int hh, LAS unsigned char* wl) {
    const int lane = l31 + 32 * hh, rr = lane >> 4, ch = lane & 15;
#pragma unroll
    for (int j = 0; j < 2; ++j)
#pragma unroll
        for (int i = 0; i < 2; ++i)
#pragma unroll
            for (int g = 0; g < 4; ++g) { f32x4 v = {acc[i][j][4 * g], acc[i][j][4 * g + 1], acc[i][j][4 * g + 2], acc[i][j][4 * g + 3]};
                const int R = 32 * j + l31; *(LAS f32x4*)(wl + R * 256 + (((8 * i + 2 * g + hh) ^ (R & 15)) * 16)) = v; }
#pragma unroll
    for (int q = 0; q < 16; ++q) {
        const void* sp; void* dp; const float* gp;
        if (rowf(4 * q + rr, sp, dp, gp)) {
            f32x4 x;
            if constexpr (SRC_BF) { const u32x2 w = pre.xi[q]; f32x4 t = {__uint_as_float(w.x << 16), __uint_as_float(w.x & 0xffff0000u), __uint_as_float(w.y << 16), __uint_as_float(w.y & 0xffff0000u)}; x = t; } else x = pre.xi[q];
            const int R = 4 * q + rr; const f32x4 a = *(LAS f32x4*)(wl + R * 256 + ((ch ^ (R & 15)) * 16)); const f32x4 gt = *(const f32x4*)(gp + ch * 4);
            const f32x4 v = {x.x + gt.x * a.x, x.y + gt.y * a.y, x.z + gt.z * a.z, x.w + gt.w * a.w};
            if (DST_BF) { u32x2 o = {pk2(v.x, v.y), pk2(v.z, v.w)}; *(u32x2*)((bf16*)dp + ch * 4) = o; }
            else *(f32x4*)((float*)dp + ch * 4) = v;
        }
    }
}
struct EpiEvenIn {
    typedef NoPre Pre;
    __device__ __forceinline__ void prefetch(Pre&, int, int, int, int) const {}
    unsigned char* r3; const float* qn; const float* kn; const float2* ropeT; int mt, nt;
    __device__ __forceinline__ bool swapped() const { return nt == 17 || (nt >= 4 && nt < 8); }
    __device__ __forceinline__ void operator()(f32x16 (&acc)[2][2], int fb, int tb, int l31, int hh, LAS unsigned char* wl, const Pre& pre) const {
        const size_t trow0 = (size_t)mt * 128 + tb; const bool latent = mt < NL / 128; const int tok0 = (int)(trow0 & (S - 1));
        if (swapped()) {
            const int b = latent ? (int)(trow0 / S) : (int)((trow0 - NL) / CL); const int key0 = latent ? tok0 : S + (int)((trow0 - NL) % CL);
            const size_t off = nt == 17 ? R3_AV + (size_t)(b * 2 + fb / 64) * 64 * VT_LD * 2 : R3_GV + ((size_t)(b * 4 + nt - 4) * 128 + fb) * VT_LD * 2;
            store_vt_swapped(acc, (bf16*)(r3 + off), key0, l31, hh, wl);
        } else if (nt == 18) {
            if (fb == 0) {
                float* LR = (float*)(r3 + R3_LR);
#pragma unroll
                for (int j = 0; j < 2; ++j)
#pragma unroll
                    for (int g = 0; g < 4; ++g) { f32x4 v = {acc[0][j][4 * g], acc[0][j][4 * g + 1], acc[0][j][4 * g + 2], acc[0][j][4 * g + 3]}; *(f32x4*)(LR + (trow0 + j * 32 + l31) * 32 + 8 * g + 4 * hh) = v; }
            }
        } else {
            size_t off; int ld, col;
            if (nt < 2) { off = R3_GQ; ld = 256; col = nt * 128; }
            else if (nt < 4) { off = R3_GK; ld = 256; col = (nt - 2) * 128; }
            else if (nt < 12) { off = R3_GR; ld = 512; col = (nt - 8) * 128; }
            else if (nt < 16) { off = R3_AQ; ld = 512; col = (nt - 12) * 128; }
            else { off = R3_AK; ld = 128; col = 0; }
            if (nt >= 12) qknorm_rope_T(acc, nt < 16 ? qn : kn, ropeT, latent, tok0, l31, hh);
            store_bf16_T(acc, (bf16*)(r3 + off), ld, trow0, col + fb, l31, hh, wl);
        }
    }
};
__device__ __forceinline__ int xcd_vid(int bid, int nb) { return (nb % 8 == 0) ? (bid % 8) * (nb / 8) + bid / 8 : bid; }

__device__ __forceinline__ void ph_even_inproj(const Ptrs& P, LAS unsigned char* smem, int bid, int nblk) {
    unsigned char* ws = P.ws;
    const int lrow = threadIdx.x >> 3, kc = threadIdx.x & 7;
    const int vid = xcd_vid(bid, nblk);
    for (int tile = vid; tile < (NT / 128) * 19; tile += nblk) {
        const int mt = tile / 19, nt = tile % 19;
        AffineRows af((const bf16*)(ws + WS_R1) + (size_t)mt * 128 * D, D);
        AffineRows bf_((const bf16*)(ws + WS_WINE) + (size_t)nt * 128 * D, D);
        EpiEvenIn epi{ws + WS_R3, P.in[13], P.in[14], (const float2*)(ws + WS_ROPE), mt, nt};
        if (epi.swapped()) gemm_tile<true>(af, bf_, D / 64, smem, epi); else gemm_tile<false>(af, bf_, D / 64, smem, epi);
    }
}

template <int LAYER>
struct EpiOutProj {
    typedef RmwPre<LAYER != 0> Pre;
    const float* modv_layer; const float* xin_lat; const float* xin_ctx; bf16* xs; int mt, nt;
    __device__ __forceinline__ bool swapped() const { return false; }
    __device__ __forceinline__ auto rowfn(int fb, int tb) const {
        const size_t trow0 = (size_t)mt * 128 + tb; const bool latent = mt < NL / 128;
        const int c0 = nt * 128 + fb;
        const float* gate = modv_layer + (size_t)(latent ? trow0 / S : 4) * 6144 + 2 * 1024 + c0;
        bf16* xo = xs + trow0 * D + c0;
        const float* xin = LAYER == 0 ? (latent ? xin_lat + trow0 * D : xin_ctx + (trow0 - NL) * D) + c0 : nullptr;
        return [=](int R, const void*& sp, void*& dp, const float*& gp) { if (LAYER == 0) sp = xin + (size_t)R * D; else sp = xo + (size_t)R * D; dp = xo + (size_t)R * D; gp = gate; return true; };
    }
    __device__ __forceinline__ void prefetch(Pre& pre, int fb, int tb, int l31, int hh) const { rmw_prefetch<LAYER != 0>(pre, rowfn(fb, tb), l31, hh); }
    __device__ __forceinline__ void operator()(f32x16 (&acc)[2][2], int fb, int tb, int l31, int hh, LAS unsigned char* wl, const Pre& pre) const {
        rmw_finish<LAYER != 0, true>(acc, pre, rowfn(fb, tb), l31, hh, wl);
    }
};
__device__ __forceinline__ void ph_outproj(const Ptrs& P, LAS unsigned char* smem, int bid, int nblk, int layer, int nrows) {
    unsigned char* ws = P.ws;
    const int lrow = threadIdx.x >> 3, kc = threadIdx.x & 7;
    const int vid = xcd_vid(bid, nblk);
    const float* modv_layer = (const float*)(ws + WS_MODV) + (size_t)layer * 5 * 6144;
    for (int tile = vid; tile < (nrows / 128) * 8; tile += nblk) {
        const int mt = tile / 8, nt = tile % 8;
        AffineRows af((const bf16*)(ws + WS_R2) + (size_t)mt * 128 * D, D);
        AffineRows bf_((const bf16*)(ws + (layer ? WS_WOUTO : WS_WOUTE)) + (size_t)nt * 128 * D, D);
        if (layer == 0) { EpiOutProj<0> epi{modv_layer, P.in[0], P.in[2], (bf16*)(ws + WS_R4), mt, nt}; gemm_tile<false>(af, bf_, D / 64, smem, epi); }
        else { EpiOutProj<1> epi{modv_layer, nullptr, nullptr, (bf16*)(ws + WS_R4), mt, nt}; gemm_tile<false>(af, bf_, D / 64, smem, epi); }
    }
}

struct EpiOddIn {
    typedef NoPre Pre;
    __device__ __forceinline__ void prefetch(Pre&, int, int, int, int) const {}
    unsigned char* r3; const float* qn; const float* kn; const float2* ropeT; int mt, nt;
    __device__ __forceinline__ bool swapped() const { return nt == 9; }
    __device__ __forceinline__ void operator()(f32x16 (&acc)[2][2], int fb, int tb, int l31, int hh, LAS unsigned char* wl, const Pre& pre) const {
        const size_t trow0 = (size_t)mt * 128 + tb; const bool latent = mt < NL / 128; const int tok0 = (int)(trow0 & (S - 1));
        if (nt < 8) { if (latent) { qknorm_rope_T(acc, qn, ropeT, true, tok0, l31, hh); store_bf16_T(acc, (bf16*)(r3 + R3_OQ), 1024, trow0, nt * 128 + fb, l31, hh, wl); } }
        else if (nt == 8) { qknorm_rope_T(acc, kn, ropeT, latent, tok0, l31, hh); store_bf16_T(acc, (bf16*)(r3 + R3_OK), 128, trow0, fb, l31, hh, wl); }
        else {
            const int b = latent ? (int)(trow0 / S) : (int)((trow0 - NL) / CL); const int key0 = latent ? tok0 : S + (int)((trow0 - NL) % CL);
            store_vt_swapped(acc, (bf16*)(r3 + R3_OV) + (size_t)(b * 2 + fb / 64) * 64 * VT_LD, key0, l31, hh, wl);
        }
    }
};
__device__ __forceinline__ void ph_odd_inproj(const Ptrs& P, LAS unsigned char* smem, int bid, int nblk) {
    unsigned char* ws = P.ws;
    const int lrow = threadIdx.x >> 3, kc = threadIdx.x & 7;
    const int vid = xcd_vid(bid, nblk);
    constexpr int T_LAT = (NL / 128) * 10, T_ALL = T_LAT + (NC / 128) * 2;
    for (int tile = vid; tile < T_ALL; tile += nblk) {
        int mt, nt;
        if (tile < T_LAT) { mt = tile / 10; nt = tile % 10; } else { mt = NL / 128 + (tile - T_LAT) / 2; nt = 8 + (tile - T_LAT) % 2; }
        AffineRows af((const bf16*)(ws + WS_R1) + (size_t)mt * 128 * D, D);
        AffineRows bf_((const bf16*)(ws + WS_WINO) + (size_t)nt * 128 * D, D);
        EpiOddIn epi{ws + WS_R3, P.in[18], P.in[19], (const float2*)(ws + WS_ROPE), mt, nt};
        if (epi.swapped()) gemm_tile<true>(af, bf_, D / 64, smem, epi); else gemm_tile<false>(af, bf_, D / 64, smem, epi);
    }
}

constexpr int AT_KP = 144, AT_VP = 136;
constexpr int AT_STAGE = 64 * AT_KP + 64 * AT_VP;
constexpr int ATTN_LDS = 2 * AT_STAGE;
struct AttnArgs {
    const bf16* Q; int ldq; size_t qrow0; int qcol;
    const bf16* K; size_t klat0, kctx0;
    const bf16* Vt;
    int nctx, tlo, nlat;
    int banded, tq0;
    float sink_l2;
    bf16* out;
};
__device__ __forceinline__ float xhalf_max(float x) {
    auto t = __builtin_amdgcn_permlane32_swap(__float_as_uint(x), __float_as_uint(x), false, false);
    return fmaxf(__uint_as_float(t[0]), __uint_as_float(t[1]));
}
__device__ __forceinline__ void attn_block(const AttnArgs& a, LAS unsigned char* smem) {
    const int tid = threadIdx.x, lane = tid & 63, wave = tid >> 6, l31 = lane & 31, hh = lane >> 5;
    constexpr float C = 0.125f * 1.4426950408889634f;
    bf16x8 qf[4];
    { const bf16* qp = a.Q + (a.qrow0 + wave * 32 + l31) * a.ldq + a.qcol + hh * 8;
#pragma unroll
      for (int s = 0; s < 4; ++s) qf[s] = *(const bf16x8*)(qp + 16 * s); }
    f32x16 o[2];
#pragma unroll
    for (int dt = 0; dt < 2; ++dt)
#pragma unroll
        for (int r = 0; r < 16; ++r) o[dt][r] = 0.f;
    float m = -1e30f, lsum = 0.f;
    const int ntile = a.nctx + a.nlat;
    const int lr0 = tid >> 3, kc = tid & 7;
    u32x4 rk[2], rv[2];
#define AT_ISSUE(n) do { const int t_ = (n) < a.nctx ? 64 + (n) : a.tlo + (n) - a.nctx; \
        const bf16* kb_ = a.K + (t_ < 64 ? a.klat0 + 64 * t_ : a.kctx0 + 64 * (t_ - 64)) * 128 + kc * 8; const bf16* vb_ = a.Vt + 64 * t_ + kc * 8; \
        _Pragma("unroll") for (int i = 0; i < 2; ++i) { rk[i] = *(const u32x4*)(kb_ + (size_t)(lr0 + 32 * i) * 128); rv[i] = *(const u32x4*)(vb_ + (size_t)(lr0 + 32 * i) * VT_LD); } } while (0)
#define AT_COMMIT(st) do { LAS unsigned char* sb_ = smem + (st) * AT_STAGE; \
        _Pragma("unroll") for (int i = 0; i < 2; ++i) { *(LAS u32x4*)(sb_ + (lr0 + 32 * i) * AT_KP + kc * 16) = rk[i]; \
            LAS unsigned char* vp_ = sb_ + 64 * AT_KP + (lr0 + 32 * i) * AT_VP + kc * 16; u32x2 lo_ = {rv[i].x, rv[i].y}, hi_ = {rv[i].z, rv[i].w}; *(LAS u32x2*)vp_ = lo_; *(LAS u32x2*)(vp_ + 8) = hi_; } } while (0)
    AT_ISSUE(0); AT_COMMIT(0);
    __syncthreads();
    const int tq = a.tq0 + wave * 32 + l31;
    for (int n = 0; n < ntile; ++n) {
        const int st = n & 1;
        if (n + 1 < ntile) AT_ISSUE(n + 1);
        __builtin_amdgcn_sched_barrier(0);
        LAS unsigned char* sb = smem + st * AT_STAGE;
        f32x16 sc[2];
#pragma unroll
        for (int kt = 0; kt < 2; ++kt) {
#pragma unroll
            for (int r = 0; r < 16; ++r) sc[kt][r] = 0.f;
#pragma unroll
            for (int s = 0; s < 4; ++s) {
                const bf16x8 kf = *(LAS bf16x8*)(sb + (32 * kt + l31) * AT_KP + s * 32 + hh * 16);
                sc[kt] = __builtin_amdgcn_mfma_f32_32x32x16_bf16(kf, qf[s], sc[kt], 0, 0, 0);
            }
        }
        if (a.banded && n >= a.nctx) {
            const int t_ = a.tlo + n - a.nctx; const int dbase = 64 * t_ + 4 * hh - tq;
#pragma unroll
            for (int kt = 0; kt < 2; ++kt)
#pragma unroll
                for (int r = 0; r < 16; ++r) { const int df = dbase + 32 * kt + (r & 3) + 8 * (r >> 2); if (df > 128 || df < -128) sc[kt][r] = -1e30f; }
        }
        bf16x8 vfr[2][2][2];
#pragma unroll
        for (int kt = 0; kt < 2; ++kt)
#pragma unroll
            for (int s2 = 0; s2 < 2; ++s2)
#pragma unroll
                for (int dt = 0; dt < 2; ++dt) {
                    LAS unsigned char* vp = sb + 64 * AT_KP + (32 * dt + l31) * AT_VP + (32 * kt + 16 * s2 + 4 * hh) * 2;
                    const u32x2 v0 = *(LAS u32x2*)vp, v1 = *(LAS u32x2*)(vp + 16);
                    u32x4 vw = {v0.x, v0.y, v1.x, v1.y};
                    vfr[kt][s2][dt] = __builtin_bit_cast(bf16x8, vw);
                }
        __builtin_amdgcn_sched_barrier(0);
        float mx = sc[0][0];
#pragma unroll
        for (int kt = 0; kt < 2; ++kt)
#pragma unroll
            for (int r = 0; r < 16; ++r) mx = fmaxf(mx, sc[kt][r]);
        mx = xhalf_max(mx);
        const float mnew = fmaxf(m, mx * C);
        const float alpha = __builtin_amdgcn_exp2f(m - mnew);
        m = mnew;
        float ps = 0.f;
#pragma unroll
        for (int kt = 0; kt < 2; ++kt)
#pragma unroll
            for (int r = 0; r < 16; ++r) { sc[kt][r] = __builtin_amdgcn_exp2f(fmaf(sc[kt][r], C, -mnew)); ps += sc[kt][r]; }
        lsum = lsum * alpha + ps;
#pragma unroll
        for (int dt = 0; dt < 2; ++dt)
#pragma unroll
            for (int r = 0; r < 16; ++r) o[dt][r] *= alpha;
#pragma unroll
        for (int kt = 0; kt < 2; ++kt)
#pragma unroll
            for (int s2 = 0; s2 < 2; ++s2) {
                u32x4 pw = {pk2(sc[kt][8 * s2], sc[kt][8 * s2 + 1]), pk2(sc[kt][8 * s2 + 2], sc[kt][8 * s2 + 3]), pk2(sc[kt][8 * s2 + 4], sc[kt][8 * s2 + 5]), pk2(sc[kt][8 * s2 + 6], sc[kt][8 * s2 + 7])};
                const bf16x8 pf = __builtin_bit_cast(bf16x8, pw);
#pragma unroll
                for (int dt = 0; dt < 2; ++dt) o[dt] = __builtin_amdgcn_mfma_f32_32x32x16_bf16(vfr[kt][s2][dt], pf, o[dt], 0, 0, 0);
            }
        __builtin_amdgcn_sched_barrier(0);
        if (n + 1 < ntile) AT_COMMIT(st ^ 1);
        __syncthreads();
    }
#undef AT_ISSUE
#undef AT_COMMIT
    float l = xhalf_sum(lsum) + __builtin_amdgcn_exp2f(a.sink_l2 - m);
    const float inv = 1.f / l;
    bf16* op = a.out + (a.qrow0 + wave * 32 + l31) * 1024 + 4 * hh;
#pragma unroll
    for (int dt = 0; dt < 2; ++dt)
#pragma unroll
        for (int g = 0; g < 4; ++g) { u32x2 v = {pk2(o[dt][4 * g] * inv, o[dt][4 * g + 1] * inv), pk2(o[dt][4 * g + 2] * inv, o[dt][4 * g + 3] * inv)}; *(u32x2*)(op + dt * 32 + 8 * g) = v; }
}

__device__ __forceinline__ void ph_dense_attn(const Ptrs& P, LAS unsigned char* smem, int bid, int nblk) {
    unsigned char* r3 = P.ws + WS_R3;
    const int vid = xcd_vid(bid, nblk);
    for (int item = vid; item < 1024 + 64; item += nblk) {
        AttnArgs a;
        int bh, qb; bool isctx = item >= 1024;
        if (!isctx) { bh = item >> 5; qb = item & 31; } else { bh = (item - 1024) >> 1; qb = (item - 1024) & 1; }
        const int hq = bh & 7, b = bh >> 3, kv = hq >> 2;
        a.Q = (const bf16*)(r3 + R3_AQ); a.ldq = 512; a.qcol = hq * 64;
        a.qrow0 = isctx ? (size_t)NL + b * CL + qb * 128 : (size_t)b * S + qb * 128;
        a.K = (const bf16*)(r3 + R3_AK) + kv * 64; a.klat0 = (size_t)b * S; a.kctx0 = (size_t)NL + b * CL;
        a.Vt = (const bf16*)(r3 + R3_AV) + (size_t)(b * 2 + kv) * 64 * VT_LD;
        a.nctx = 4; a.tlo = 0; a.nlat = isctx ? 0 : 64; a.banded = 0; a.tq0 = 0; a.sink_l2 = -INFINITY;
        a.out = (bf16*)(P.ws + WS_R2) + 512 + hq * 64;
        attn_block(a, smem);
    }
}
__device__ __forceinline__ void ph_swa_attn(const Ptrs& P, LAS unsigned char* smem, int bid, int nblk) {
    unsigned char* r3 = P.ws + WS_R3;
    const int vid = xcd_vid(bid, nblk);
    for (int item = vid; item < 2048; item += nblk) {
        AttnArgs a;
        const int bh = item >> 5, qb = item & 31, hq = bh & 15, b = bh >> 4, kv = hq >> 3;
        a.Q = (const bf16*)(r3 + R3_OQ); a.ldq = 1024; a.qcol = hq * 64; a.qrow0 = (size_t)b * S + qb * 128;
        a.K = (const bf16*)(r3 + R3_OK) + kv * 64; a.klat0 = (size_t)b * S; a.kctx0 = (size_t)NL + b * CL;
        a.Vt = (const bf16*)(r3 + R3_OV) + (size_t)(b * 2 + kv) * 64 * VT_LD;
        const int tlo = qb * 2 - 2 < 0 ? 0 : qb * 2 - 2, thi = qb * 2 + 3 > 63 ? 63 : qb * 2 + 3;
        a.nctx = 4; a.tlo = tlo; a.nlat = thi - tlo + 1; a.banded = 1; a.tq0 = qb * 128; a.sink_l2 = P.in[17][hq] * 1.4426950408889634f;
        a.out = (bf16*)(P.ws + WS_R2) + hq * 64;
        attn_block(a, smem);
    }
}

constexpr size_t WS_LIST = 247 * MiB;
constexpr size_t WS_WTS = WS_LIST + (size_t)24 * NT * 4;
constexpr size_t WS_END_ALL = WS_WTS + (size_t)NT * 2 * 4;
static_assert(WS_R3 + R3_END <= WS_LIST && WS_END_ALL <= 256 * MiB, "ws map tail");
constexpr int CTL_CNT = 8192;
constexpr int MOE_MAXT = NT / 128 + 24;

constexpr size_t WS_WRT = 250 * MiB, WS_SL = 251 * MiB;
typedef float f32x4v __attribute__((ext_vector_type(4)));
__device__ __forceinline__ void route_tables(const Ptrs& P, int layer, int bid, int nblk) {
    unsigned char* ws = P.ws;
    const float* mvl = (const float*)(ws + WS_MODV) + (size_t)layer * 5 * 6144;
    const float* gain = P.in[7] + layer * D;
    const float* wg = P.in[20] + (size_t)layer * D * 4; const float* bg = P.in[21] + layer * 4;
    const float* we = P.in[22] + (size_t)layer * D * 16; const float* be = P.in[23] + layer * 16;
    bf16* wrt = (bf16*)(ws + WS_WRT);
    for (int e = bid * 256 + threadIdx.x; e < 5 * 32 * 1024; e += nblk * 256) {
        const int k = e & 1023, r = (e >> 10) & 31, br = e >> 15;
        const float a = gain[k] * (1.f + mvl[(size_t)br * 6144 + 4 * 1024 + k]);
        const float w = (r < 16 ? wg[k * 4 + (r & 3)] : we[k * 16 + r - 16]) * a;
        const bf16 hi = f2bf(w); const bf16 lo = f2bf(w - bf2f(hi));
        wrt[((size_t)(br * 2 + 0) * 32 + r) * 1024 + k] = hi; wrt[((size_t)(br * 2 + 1) * 32 + r) * 1024 + k] = lo;
    }
    const int gw = bid * 4 + (threadIdx.x >> 6), lane = threadIdx.x & 63;
    if (gw < 160) {
        const int r = gw & 31, br = gw >> 5; float s = 0.f;
        for (int k = lane; k < 1024; k += 64) s += mvl[(size_t)br * 6144 + 3 * 1024 + k] * (r < 16 ? wg[k * 4 + (r & 3)] : we[k * 16 + r - 16]);
        s = wave_sum(s);
        if (lane == 0) ((float*)(ws + WS_SL))[br * 32 + r] = s + (r < 16 ? bg[r & 3] : be[r - 16]);
    }
}
typedef float f32x4a __attribute__((ext_vector_type(4)));
__device__ __forceinline__ float xq_sum(float x) {
    x += __shfl_xor(x, 16); x += __shfl_xor(x, 32); return x;
}
__device__ __forceinline__ void ph_moe_route(const Ptrs& P, LAS unsigned char* smem, int bid, int nblk, int layer, int nrows) {
    unsigned char* ws = P.ws;
    const int tid = threadIdx.x, lane = tid & 63, wave = tid >> 6, tk = lane & 15, kq = lane >> 4;
    const float* modv_layer = (const float*)(ws + WS_MODV) + (size_t)layer * 5 * 6144;
    const float* gain = P.in[7] + layer * D;
    const bf16* xs = (const bf16*)(ws + WS_R4);
    bf16* H = (bf16*)(ws + WS_R1);
    int* cnt = (int*)(ws + WS_CTL) + CTL_CNT + layer * 2048; int* list = (int*)(ws + WS_LIST); float* wts = (float*)(ws + WS_WTS);
    LAS float* part = (LAS float*)smem;
    for (int task = xcd_vid(bid, nblk); task < nrows / 16; task += nblk) {
        const int row0 = task * 16; const int row = row0 + tk;
        const int br = row0 < NL ? row0 / S : 4;
        const bf16* xr = xs + (size_t)row * D;
        const bf16* wt = (const bf16*)(ws + WS_WRT) + (size_t)br * 2 * 32 * 1024;
        f32x4a acc0 = {0.f, 0.f, 0.f, 0.f}, acc1 = {0.f, 0.f, 0.f, 0.f};
        float ss = 0.f;
#pragma unroll 4
        for (int s = 8 * wave; s < 8 * wave + 8; ++s) {
            const int k = 32 * s + 8 * kq;
            const u32x4 xh = *(const u32x4*)(xr + k);
            { const float f0 = __uint_as_float(xh.x << 16), f1 = __uint_as_float(xh.x & 0xffff0000u), f2 = __uint_as_float(xh.y << 16), f3 = __uint_as_float(xh.y & 0xffff0000u);
              const float f4 = __uint_as_float(xh.z << 16), f5 = __uint_as_float(xh.z & 0xffff0000u), f6 = __uint_as_float(xh.w << 16), f7 = __uint_as_float(xh.w & 0xffff0000u);
              ss += (f0 * f0 + f1 * f1) + (f2 * f2 + f3 * f3) + (f4 * f4 + f5 * f5) + (f6 * f6 + f7 * f7); }
            const bf16x8 bh = __builtin_bit_cast(bf16x8, xh);
            const bf16x8 a0h = *(const bf16x8*)(wt + (size_t)tk * 1024 + k), a1h = *(const bf16x8*)(wt + (size_t)(16 + tk) * 1024 + k);
            const bf16x8 a0l = *(const bf16x8*)(wt + (size_t)(32 + tk) * 1024 + k), a1l = *(const bf16x8*)(wt + (size_t)(48 + tk) * 1024 + k);
            acc0 = __builtin_amdgcn_mfma_f32_16x16x32_bf16(a0h, bh, acc0, 0, 0, 0); acc1 = __builtin_amdgcn_mfma_f32_16x16x32_bf16(a1h, bh, acc1, 0, 0, 0);
            acc0 = __builtin_amdgcn_mfma_f32_16x16x32_bf16(a0l, bh, acc0, 0, 0, 0); acc1 = __builtin_amdgcn_mfma_f32_16x16x32_bf16(a1l, bh, acc1, 0, 0, 0);
        }
#pragma unroll
        for (int j = 0; j < 4; ++j) { part[(wave * 9 + j) * 64 + lane] = acc0[j]; part[(wave * 9 + 4 + j) * 64 + lane] = acc1[j]; }
        part[(wave * 9 + 8) * 64 + lane] = ss;
        __syncthreads();
        float tot[9];
#pragma unroll
        for (int j = 0; j < 9; ++j) tot[j] = (part[j * 64 + lane] + part[(9 + j) * 64 + lane]) + (part[(18 + j) * 64 + lane] + part[(27 + j) * 64 + lane]);
        const float rstd = rsqrtf(xq_sum(tot[8]) * (1.f / D) + EPS);
        if (wave == 0) {
            const float* sl = (const float*)(ws + WS_SL) + br * 32;
            float gl[4], el[4];
#pragma unroll
            for (int j = 0; j < 4; ++j) { gl[j] = tot[j] * rstd + sl[j]; el[j] = tot[4 + j] * rstd + sl[16 + 4 * kq + j]; }
            int gi = 0; float gm = gl[0];
#pragma unroll
            for (int j = 1; j < 4; ++j) if (gl[j] > gm) { gm = gl[j]; gi = j; }
            if (gi == kq) {
                float gs = 0.f;
#pragma unroll
                for (int j = 0; j < 4; ++j) gs += expf(gl[j] - gm);
                const float gwt = 1.f / gs;
                int i0 = 0; float e0 = el[0];
#pragma unroll
                for (int j = 1; j < 4; ++j) if (el[j] > e0) { e0 = el[j]; i0 = j; }
                int i1 = -1; float e1 = -INFINITY;
#pragma unroll
                for (int j = 0; j < 4; ++j) if (j != i0 && el[j] > e1) { e1 = el[j]; i1 = j; }
                const float p1 = expf(e1 - e0); const float w0 = gwt / (1.f + p1), w1 = gwt * p1 / (1.f + p1);
                const int ea = i0 < i1 ? i0 : i1, eb = i0 < i1 ? i1 : i0;
                const int pidx = ea == 0 ? eb - 1 : (ea == 1 ? eb + 1 : 5);
                const int cls = gi * 6 + pidx;
                wts[(size_t)row * 2] = i0 < i1 ? w0 : w1; wts[(size_t)row * 2 + 1] = i0 < i1 ? w1 : w0;
                const int pos = atomicAdd(&cnt[cls * 64], 1);
                list[(size_t)cls * NT + pos] = row;
            }
        }
        const float* mv = modv_layer + (size_t)br * 6144;
        float rs[4];
#pragma unroll
        for (int r = 0; r < 4; ++r) rs[r] = __shfl(rstd, 4 * wave + r);
        u32x2 xv[4][4];
#pragma unroll
        for (int r = 0; r < 4; ++r) {
            const bf16* xp = xs + (size_t)(row0 + 4 * wave + r) * D + 4 * lane;
#pragma unroll
            for (int jq = 0; jq < 4; ++jq) xv[r][jq] = *(const u32x2*)(xp + 256 * jq);
        }
#pragma unroll
        for (int jq = 0; jq < 4; ++jq) {
            const int k = 4 * lane + 256 * jq;
            const f32x4 g = *(const f32x4*)(gain + k), sc = *(const f32x4*)(mv + 4 * 1024 + k), sh = *(const f32x4*)(mv + 3 * 1024 + k);
            const f32x4 a = {g.x * (1.f + sc.x), g.y * (1.f + sc.y), g.z * (1.f + sc.z), g.w * (1.f + sc.w)};
#pragma unroll
            for (int r = 0; r < 4; ++r) {
                const u32x2 xw = xv[r][jq]; const f32x4 x = {__uint_as_float(xw.x << 16), __uint_as_float(xw.x & 0xffff0000u), __uint_as_float(xw.y << 16), __uint_as_float(xw.y & 0xffff0000u)};
                u32x2 o = {pk2(x.x * rs[r] * a.x + sh.x, x.y * rs[r] * a.y + sh.y), pk2(x.z * rs[r] * a.z + sh.z, x.w * rs[r] * a.w + sh.w)};
                *(u32x2*)(H + (size_t)(row0 + 4 * wave + r) * D + k) = o;
            }
        }
        __syncthreads();
    }
}

__device__ __forceinline__ void moe_tiles_init(const int* cnt, LAS int* tile0) {
    __syncthreads();
    if (threadIdx.x < 24) tile0[192 + threadIdx.x] = cnt[threadIdx.x * 64];
    __syncthreads();
    if (threadIdx.x == 0) { int a = 0; for (int c = 0; c < 24; ++c) { tile0[c] = a; a += (tile0[192 + c] + 127) >> 7; } tile0[24] = a; }
    __syncthreads();
}
struct GatherRows {
    const bf16* H; const int* lst; int n; const bf16* p[4];
    __device__ __forceinline__ void init(int r0) {
#pragma unroll
        for (int i = 0; i < 4; ++i) { const int r = r0 + 8 * i; p[i] = H + (size_t)lst[r < n ? r : 0] * D; }
    }
    __device__ __forceinline__ const bf16* ptr(int i, int kt) const { return p[i] + kt * 64; }
};
struct SplitKRows {
    const bf16* b0; const bf16* b1; size_t ld; int ksplit; const bf16* p0; const bf16* p1;
    __device__ __forceinline__ SplitKRows(const bf16* b0_, const bf16* b1_, size_t ld_, int ksplit_) : b0(b0_), b1(b1_), ld(ld_), ksplit(ksplit_), p0(b0_), p1(b1_) {}
    __device__ __forceinline__ void init(int r0) { p0 = b0 + (size_t)r0 * ld; p1 = b1 + (size_t)r0 * ld; }
    __device__ __forceinline__ const bf16* ptr(int i, int kt) const { return (kt < ksplit ? p0 + kt * 64 : p1 + (kt - ksplit) * 64) + (size_t)i * 8 * ld; }
};
struct EpiMoe1 {
    typedef NoPre Pre;
    __device__ __forceinline__ void prefetch(Pre&, int, int, int, int) const {}
    bf16* hid; const int* lst; int n; const float* wts; int nt;
    __device__ __forceinline__ bool swapped() const { return false; }
    __device__ __forceinline__ void operator()(f32x16 (&acc)[2][2], int fb, int tb, int l31, int hh, LAS unsigned char* wl, const Pre& pre) const {
        const int col = (nt >> 2) * 256 + 32 * (2 * (nt & 3) + (fb >> 6));
#pragma unroll 1
        for (int j = 0; j < 2; ++j) {
            const int r = tb + j * 32 + l31;
            const int tok = lst[r < n ? r : 0];
            const float w = wts[(size_t)tok * 2 + (nt >> 2)];
#pragma unroll
            for (int g = 0; g < 4; ++g) {
                float hv[4];
#pragma unroll
                for (int e = 0; e < 4; ++e) { const float a_ = j ? acc[0][1][4 * g + e] : acc[0][0][4 * g + e], u_ = j ? acc[1][1][4 * g + e] : acc[1][0][4 * g + e]; hv[e] = a_ / (1.f + __expf(-a_)) * u_ * w; }
                u32x2 v = {pk2(hv[0], hv[1]), pk2(hv[2], hv[3])}; *(LAS u32x2*)(wl + (32 * j + l31) * 80 + (8 * g + 4 * hh) * 2) = v;
            }
        }
        const int lane = l31 + 32 * hh, rr = lane >> 2, ch = lane & 3;
#pragma unroll
        for (int q = 0; q < 4; ++q) { const int R = 16 * q + rr; const u32x4 v = *(LAS u32x4*)(wl + R * 80 + ch * 16); *(u32x4*)(hid + (size_t)(tb + R) * 512 + col + ch * 8) = v; }
    }
};
__device__ __forceinline__ void ph_moe_stage1(const Ptrs& P, LAS unsigned char* smem, int bid, int nblk, int layer) {
    unsigned char* ws = P.ws;
    const int* cnt = (const int*)(ws + WS_CTL) + CTL_CNT + layer * 2048; const int* list = (const int*)(ws + WS_LIST);
    LAS int* tile0 = (LAS int*)(smem + GEMM_LDS);
    moe_tiles_init(cnt, tile0);
    const int lrow = threadIdx.x >> 3, kc = threadIdx.x & 7;
    const bf16* H = (const bf16*)(ws + WS_R1);
    const int nitems = tile0[24] * 8;
    for (int item = xcd_vid(bid, nblk); item < nitems; item += nblk) {
        const int tt = item >> 3, nt = item & 7;
        int c = 0; while (tile0[c + 1] <= tt) ++c;
        const int lt = tt - tile0[c], n = min(128, tile0[192 + c] - lt * 128);
        const int* lst = list + (size_t)c * NT + lt * 128;
        const int g = c / 6, pidx = c % 6; const int ea = pidx < 3 ? 0 : (pidx < 5 ? 1 : 2), eb = pidx < 3 ? pidx + 1 : (pidx < 5 ? pidx - 1 : 3);
        const int expert = g * 4 + (nt < 4 ? ea : eb);
        GatherRows af{H, lst, n, {nullptr, nullptr, nullptr, nullptr}};
        AffineRows bf_((const bf16*)(ws + WS_WGU) + ((size_t)(layer * 16 + expert) * 512 + (nt & 3) * 128) * D, D);
        EpiMoe1 epi{(bf16*)(ws + WS_R3) + (size_t)tt * 128 * 512, lst, n, (const float*)(ws + WS_WTS), nt};
        gemm_tile<false>(af, bf_, D / 64, smem, epi);
    }
}
template <int LAYER>
struct EpiMoe2 {
    typedef RmwPre<true> Pre;
    bf16* xs; float* out; const float* modv_layer; LAS const int* lst; int n; int nt;
    __device__ __forceinline__ bool swapped() const { return false; }
    __device__ __forceinline__ auto rowfn(int fb, int tb) const {
        const int c0 = nt * 128 + fb; const EpiMoe2 e = *this;
        return [=](int R, const void*& sp, void*& dp, const float*& gp) {
            const int r = tb + R; if (r >= e.n) return false;
            const int tok = e.lst[r];
            sp = e.xs + (size_t)tok * D + c0;
            if (LAYER == 0) dp = e.xs + (size_t)tok * D + c0; else dp = e.out + (size_t)tok * D + c0;
            gp = e.modv_layer + (size_t)(tok < NL ? tok / S : 4) * 6144 + 5 * 1024 + c0; return true; };
    }
    __device__ __forceinline__ void prefetch(Pre& pre, int fb, int tb, int l31, int hh) const { rmw_prefetch<true>(pre, rowfn(fb, tb), l31, hh); }
    __device__ __forceinline__ void operator()(f32x16 (&acc)[2][2], int fb, int tb, int l31, int hh, LAS unsigned char* wl, const Pre& pre) const {
        rmw_finish<true, LAYER == 0>(acc, pre, rowfn(fb, tb), l31, hh, wl);
    }
};
__device__ __forceinline__ void ph_moe_stage2(const Ptrs& P, LAS unsigned char* smem, int bid, int nblk, int layer) {
    unsigned char* ws = P.ws;
    const int* cnt = (const int*)(ws + WS_CTL) + CTL_CNT + layer * 2048; const int* list = (const int*)(ws + WS_LIST);
    LAS int* tile0 = (LAS int*)(smem + GEMM_LDS);
    moe_tiles_init(cnt, tile0);
    const int lrow = threadIdx.x >> 3, kc = threadIdx.x & 7;
    const int nitems = tile0[24] * 8;
    for (int item = xcd_vid(bid, nblk); item < nitems; item += nblk) {
        const int tt = item >> 3, nt = item & 7;
        int c = 0; while (tile0[c + 1] <= tt) ++c;
        const int lt = tt - tile0[c], n = min(128, tile0[192 + c] - lt * 128);
        const int* lst = list + (size_t)c * NT + lt * 128;
        const int g = c / 6, pidx = c % 6; const int ea = pidx < 3 ? 0 : (pidx < 5 ? 1 : 2), eb = pidx < 3 ? pidx + 1 : (pidx < 5 ? pidx - 1 : 3);
        AffineRows af((const bf16*)(ws + WS_R3) + (size_t)tt * 128 * 512, 512);
        const bf16* wd = (const bf16*)(ws + WS_WD);
        SplitKRows bf_(wd + ((size_t)(layer * 16 + g * 4 + ea) * 1024 + nt * 128) * 256, wd + ((size_t)(layer * 16 + g * 4 + eb) * 1024 + nt * 128) * 256, 256, 4);
        LAS int* toks = (LAS int*)(smem + GEMM_LDS + 256);
        __syncthreads();
        if (threadIdx.x < 128) toks[threadIdx.x] = lst[threadIdx.x < n ? threadIdx.x : 0];
        if (layer == 0) { EpiMoe2<0> epi{(bf16*)(ws + WS_R4), P.out, (const float*)(ws + WS_MODV), toks, n, nt}; gemm_tile<false>(af, bf_, 8, smem, epi); }
        else { EpiMoe2<1> epi{(bf16*)(ws + WS_R4), P.out, (const float*)(ws + WS_MODV) + (size_t)5 * 6144, toks, n, nt}; gemm_tile<false>(af, bf_, 8, smem, epi); }
    }
}

constexpr size_t GLA_ST = 8192;
constexpr size_t WS_DEC = WS_WTS + (size_t)NT * 2 * 4;
static_assert(WS_DEC + (size_t)32 * 68 * 64 * 4 <= 256 * MiB, "ws dec");
__device__ __forceinline__ void gla_chunk_geom(int b, int M, size_t& row0, int& vcol0, int& c0, int& c1) {
    if (M < 4) { row0 = (size_t)NL + b * CL + 64 * M; vcol0 = S + 64 * M; c0 = M; c1 = 3 - M; }
    else { const int Ml = M - 4; row0 = (size_t)b * S + 64 * Ml; vcol0 = 64 * Ml; c0 = 4 + Ml; c1 = 4 + 63 - Ml; }
}
template <bool PASS_C>
__device__ __forceinline__ float gla_prep(const float (&gw)[16], float gb, int dir, LAS unsigned char* out, LAS const unsigned char* qraw, LAS const unsigned char* kraw, LAS const float* lrs, LAS float* tot) {
    const int tid = threadIdx.x, k = tid & 63, grp = tid >> 6;
    float gl[16];
#pragma unroll
    for (int j = 0; j < 16; ++j) {
        const int p = 16 * grp + j; float z = gb;
#pragma unroll
        for (int r4 = 0; r4 < 4; ++r4) { const f32x4 l4 = *(LAS const f32x4*)(lrs + p * 16 + r4 * 4); z += l4.x * gw[4 * r4] + l4.y * gw[4 * r4 + 1] + l4.z * gw[4 * r4 + 2] + l4.w * gw[4 * r4 + 3]; }
        gl[j] = (fminf(z, 0.f) - __logf(1.f + __expf(-fabsf(z)))) * (1.f / 16.f);
    }
    if (dir == 0) {
#pragma unroll
        for (int j = 1; j < 16; ++j) gl[j] += gl[j - 1];
        tot[grp * 64 + k] = gl[15];
    } else {
#pragma unroll
        for (int j = 14; j >= 0; --j) gl[j] += gl[j + 1];
        tot[grp * 64 + k] = gl[0];
    }
    __syncthreads();
    const float t0 = tot[k], t1 = tot[64 + k], t2 = tot[128 + k], t3 = tot[192 + k];
    const float bend = t0 + t1 + t2 + t3;
    float offs;
    if (dir == 0) offs = grp == 0 ? 0.f : grp == 1 ? t0 : grp == 2 ? t0 + t1 : t0 + t1 + t2;
    else offs = grp == 3 ? 0.f : grp == 2 ? t3 : grp == 1 ? t3 + t2 : t3 + t2 + t1;
    if (PASS_C) {
#pragma unroll
        for (int j = 0; j < 16; ++j) {
            const int p = 16 * grp + j; const float bp = gl[j] + offs;
            const float q = bf2f(*(LAS const bf16*)(qraw + p * 128 + k * 2)) * 0.125f, kk = bf2f(*(LAS const bf16*)(kraw + p * 128 + k * 2));
            *(LAS bf16*)(out + p * 144 + k * 2) = f2bf(q * __expf(bp));
            *(LAS bf16*)(out + 9216 + p * 144 + k * 2) = f2bf(q * __expf(bp - bend));
            *(LAS bf16*)(out + 18432 + p * 144 + k * 2) = f2bf(kk * __expf(bend - bp));
        }
    } else {
        float kt[16];
#pragma unroll
        for (int j = 0; j < 16; ++j) { const int p = 16 * grp + j; const float bp = gl[j] + offs; kt[j] = bf2f(*(LAS const bf16*)(kraw + p * 128 + k * 2)) * __expf(bend - bp); }
        u32x4 w0 = {pk2(kt[0], kt[1]), pk2(kt[2], kt[3]), pk2(kt[4], kt[5]), pk2(kt[6], kt[7])}, w1 = {pk2(kt[8], kt[9]), pk2(kt[10], kt[11]), pk2(kt[12], kt[13]), pk2(kt[14], kt[15])};
        *(LAS u32x4*)(out + k * 144 + grp * 32) = w0; *(LAS u32x4*)(out + k * 144 + grp * 32 + 16) = w1;
    }
    return __expf(bend);
}
#define GLA_LOAD_GW(gw, gb, dir, h) do { _Pragma("unroll") for (int r_ = 0; r_ < 16; ++r_) gw[r_] = P.in[10][((dir) * 16 + r_) * 256 + (h) * 64 + (threadIdx.x & 63)]; gb = P.in[11][(dir) * 256 + (h) * 64 + (threadIdx.x & 63)]; } while (0)

constexpr int GA_KTT = 0, GA_VT = 9216, GA_KRAW = GA_VT + 128 * 144, GA_LRS = GA_KRAW + 8192, GA_TOT = GA_LRS + 4096, GLA_A_LDS = GA_TOT + 1024;
__device__ __forceinline__ void gla_pass_a_item(const Ptrs& P, int item, LAS unsigned char* lds) {
    const int tid = threadIdx.x, lane = tid & 63, wave = tid >> 6, l31 = lane & 31, hh = lane >> 5;
    const int M = item % 68, dir = (item / 68) & 1, h = (item / 136) & 3, b = item / 544;
    size_t row0; int vcol0, c0, c1; gla_chunk_geom(b, M, row0, vcol0, c0, c1);
    const int sidx = ((b * 4 + h) * 2 + dir) * 68 + (dir ? c1 : c0);
    const unsigned char* r3 = P.ws + WS_R3;
    u32x4 vt[4], kr[2]; f32x4 lr; float gw[16], gb;
    { const bf16* gvt = (const bf16*)(r3 + R3_GV) + (size_t)(b * 4 + h) * 128 * VT_LD + vcol0;
#pragma unroll
      for (int i = 0; i < 4; ++i) { const int c = tid + 256 * i; vt[i] = *(const u32x4*)(gvt + (size_t)(c >> 3) * VT_LD + (c & 7) * 8); }
      const bf16* gk = (const bf16*)(r3 + R3_GK) + row0 * 256 + h * 64;
#pragma unroll
      for (int i = 0; i < 2; ++i) { const int c = tid + 256 * i; kr[i] = *(const u32x4*)(gk + (size_t)(c >> 3) * 256 + (c & 7) * 8); }
      lr = *(const f32x4*)((const float*)(r3 + R3_LR) + (row0 + (tid >> 2)) * 32 + dir * 16 + (tid & 3) * 4);
      GLA_LOAD_GW(gw, gb, dir, h); }
#pragma unroll
    for (int i = 0; i < 4; ++i) { const int c = tid + 256 * i; *(LAS u32x4*)(lds + GA_VT + (c >> 3) * 144 + (c & 7) * 16) = vt[i]; }
#pragma unroll
    for (int i = 0; i < 2; ++i) { const int c = tid + 256 * i; *(LAS u32x4*)(lds + GA_KRAW + (c >> 3) * 128 + (c & 7) * 16) = kr[i]; }
    *(LAS f32x4*)(lds + GA_LRS + tid * 16) = lr;
    __syncthreads();
    const float dec = gla_prep<false>(gw, gb, dir, lds + GA_KTT, lds + GA_KRAW, lds + GA_KRAW, (LAS const float*)(lds + GA_LRS), (LAS float*)(lds + GA_TOT));
    if (tid < 64) ((float*)(P.ws + WS_DEC))[(size_t)sidx * 64 + tid] = dec;
    __syncthreads();
    f32x16 acc[2];
#pragma unroll
    for (int kt = 0; kt < 2; ++kt)
#pragma unroll
        for (int r = 0; r < 16; ++r) acc[kt][r] = 0.f;
#pragma unroll
    for (int ps = 0; ps < 4; ++ps) {
        const bf16x8 vf = *(LAS bf16x8*)(lds + GA_VT + (32 * wave + l31) * 144 + ps * 32 + hh * 16);
#pragma unroll
        for (int kt = 0; kt < 2; ++kt) { const bf16x8 kf = *(LAS bf16x8*)(lds + GA_KTT + (32 * kt + l31) * 144 + ps * 32 + hh * 16); acc[kt] = __builtin_amdgcn_mfma_f32_32x32x16_bf16(kf, vf, acc[kt], 0, 0, 0); }
    }
    bf16* ds = (bf16*)(P.ws + WS_R1) + (size_t)sidx * GLA_ST + (size_t)(32 * wave + l31) * 64 + 4 * hh;
#pragma unroll
    for (int kt = 0; kt < 2; ++kt)
#pragma unroll
        for (int g = 0; g < 4; ++g) { u32x2 v = {pk2(acc[kt][4 * g], acc[kt][4 * g + 1]), pk2(acc[kt][4 * g + 2], acc[kt][4 * g + 3])}; *(u32x2*)(ds + kt * 32 + 8 * g) = v; }
    __syncthreads();
}
__device__ __forceinline__ void ph_gla_a(const Ptrs& P, LAS unsigned char* smem, int bid, int nblk) {
    for (int item = bid; item < 4 * 4 * 2 * 68; item += nblk) gla_pass_a_item(P, item, smem);
}
__device__ __forceinline__ void gla_pass_b(const Ptrs& P, int gtid, int nthreads) {
    const bf16* DS = (const bf16*)(P.ws + WS_R1); bf16* SIN = (bf16*)(P.ws + WS_R4); const float* DEC = (const float*)(P.ws + WS_DEC);
    for (int idx = gtid; idx < 32 * 2048; idx += nthreads) {
        const int bhd = idx >> 11, e4 = idx & 2047, k4 = (e4 & 15) * 4;
        float s0 = 0.f, s1 = 0.f, s2 = 0.f, s3 = 0.f;
#pragma unroll 17
        for (int c = 0; c < 68; ++c) {
            const size_t sidx = (size_t)bhd * 68 + c;
            u32x2 o = {pk2(s0, s1), pk2(s2, s3)};
            *(u32x2*)(SIN + sidx * GLA_ST + e4 * 4) = o;
            const f32x4 d = *(const f32x4*)(DEC + sidx * 64 + k4);
            const u32x2 w = *(const u32x2*)(DS + sidx * GLA_ST + e4 * 4);
            s0 = s0 * d.x + __uint_as_float(w.x << 16); s1 = s1 * d.y + __uint_as_float(w.x & 0xffff0000u);
            s2 = s2 * d.z + __uint_as_float(w.y << 16); s3 = s3 * d.w + __uint_as_float(w.y & 0xffff0000u);
        }
    }
}

constexpr int GC_QT = 0, GC_QA = 9216, GC_KT = 18432, GC_VT = 27648, GC_QRAW = GC_VT + 128 * 136, GC_KRAW = GC_QRAW + 8192, GC_LRS = GC_KRAW + 8192, GC_TOT = GEMM_LDS + 256, GC_XCH = GC_TOT + 1024;
static_assert(GC_LRS + 4096 <= GEMM_LDS, "gla c lds");
__device__ __forceinline__ void gla_pass_c_item(const Ptrs& P, int item, LAS unsigned char* lds) {
    const int tid = threadIdx.x, lane = tid & 63, wave = tid >> 6, l31 = lane & 31, hh = lane >> 5, pt = wave & 1, vh = wave >> 1;
    const int M = item % 68, h = (item / 68) & 3, b = item / 272;
    size_t row0; int vcol0, c0, c1; gla_chunk_geom(b, M, row0, vcol0, c0, c1);
    const unsigned char* r3 = P.ws + WS_R3;
    u32x4 vt[4], qr[2], kr[2]; f32x4 lr0, lr1; float gw[16], gb;
    { const bf16* gvt = (const bf16*)(r3 + R3_GV) + (size_t)(b * 4 + h) * 128 * VT_LD + vcol0;
#pragma unroll
      for (int i = 0; i < 4; ++i) { const int c = tid + 256 * i; vt[i] = *(const u32x4*)(gvt + (size_t)(c >> 3) * VT_LD + (c & 7) * 8); }
      const bf16* gq = (const bf16*)(r3 + R3_GQ) + row0 * 256 + h * 64; const bf16* gk = (const bf16*)(r3 + R3_GK) + row0 * 256 + h * 64;
#pragma unroll
      for (int i = 0; i < 2; ++i) { const int c = tid + 256 * i; qr[i] = *(const u32x4*)(gq + (size_t)(c >> 3) * 256 + (c & 7) * 8); kr[i] = *(const u32x4*)(gk + (size_t)(c >> 3) * 256 + (c & 7) * 8); }
      const float* lrp = (const float*)(r3 + R3_LR) + (row0 + (tid >> 2)) * 32 + (tid & 3) * 4;
      lr0 = *(const f32x4*)lrp; lr1 = *(const f32x4*)(lrp + 16);
      GLA_LOAD_GW(gw, gb, 0, h); }
#pragma unroll
    for (int i = 0; i < 4; ++i) { const int c = tid + 256 * i; LAS unsigned char* vp = lds + GC_VT + (c >> 3) * 136 + (c & 7) * 16; u32x2 lo = {vt[i].x, vt[i].y}, hi = {vt[i].z, vt[i].w}; *(LAS u32x2*)vp = lo; *(LAS u32x2*)(vp + 8) = hi; }
#pragma unroll
    for (int i = 0; i < 2; ++i) { const int c = tid + 256 * i; *(LAS u32x4*)(lds + GC_QRAW + (c >> 3) * 128 + (c & 7) * 16) = qr[i]; *(LAS u32x4*)(lds + GC_KRAW + (c >> 3) * 128 + (c & 7) * 16) = kr[i]; }
    *(LAS f32x4*)(lds + GC_LRS + tid * 16) = lr0;
    f32x16 o[2];
#pragma unroll
    for (int i = 0; i < 2; ++i)
#pragma unroll
        for (int r = 0; r < 16; ++r) o[i][r] = 0.f;
    const bf16* SIN = (const bf16*)(P.ws + WS_R4);
    __syncthreads();
#pragma unroll 1
    for (int dir = 0; dir < 2; ++dir) {
        const int sidx = ((b * 4 + h) * 2 + dir) * 68 + (dir ? c1 : c0);
        (void)gla_prep<true>(gw, gb, dir, lds + GC_QT, lds + GC_QRAW, lds + GC_KRAW, (LAS const float*)(lds + GC_LRS), (LAS float*)(lds + GC_TOT));
        bf16x8 sf[2][4];
#pragma unroll
        for (int i = 0; i < 2; ++i)
#pragma unroll
            for (int ks = 0; ks < 4; ++ks) sf[i][ks] = *(const bf16x8*)(SIN + (size_t)sidx * GLA_ST + (size_t)(64 * vh + 32 * i + l31) * 64 + 16 * ks + 8 * hh);
        if (dir == 0) { *(LAS f32x4*)(lds + GC_LRS + tid * 16) = lr1; GLA_LOAD_GW(gw, gb, 1, h); }
        __syncthreads();
        f32x16 at[2];
#pragma unroll
        for (int st = 0; st < 2; ++st) {
#pragma unroll
            for (int r = 0; r < 16; ++r) at[st][r] = 0.f;
#pragma unroll
            for (int ks = 0; ks < 4; ++ks) {
                const bf16x8 ka = *(LAS bf16x8*)(lds + GC_KT + (32 * st + l31) * 144 + ks * 32 + hh * 16);
                const bf16x8 qa = *(LAS bf16x8*)(lds + GC_QA + (32 * pt + l31) * 144 + ks * 32 + hh * 16);
                at[st] = __builtin_amdgcn_mfma_f32_32x32x16_bf16(ka, qa, at[st], 0, 0, 0);
            }
            const int pq = 32 * pt + l31;
#pragma unroll
            for (int r = 0; r < 16; ++r) { const int s_ = 32 * st + (r & 3) + 8 * (r >> 2) + 4 * hh; const bool ok = dir ? (s_ >= pq) : (s_ <= pq); if (!ok) at[st][r] = 0.f; }
        }
#pragma unroll
        for (int ks = 0; ks < 4; ++ks) {
            const bf16x8 qt = *(LAS bf16x8*)(lds + GC_QT + (32 * pt + l31) * 144 + ks * 32 + hh * 16);
#pragma unroll
            for (int i = 0; i < 2; ++i) o[i] = __builtin_amdgcn_mfma_f32_32x32x16_bf16(sf[i][ks], qt, o[i], 0, 0, 0);
        }
#pragma unroll
        for (int st = 0; st < 2; ++st)
#pragma unroll
            for (int s2 = 0; s2 < 2; ++s2) {
                u32x4 pw = {pk2(at[st][8 * s2], at[st][8 * s2 + 1]), pk2(at[st][8 * s2 + 2], at[st][8 * s2 + 3]), pk2(at[st][8 * s2 + 4], at[st][8 * s2 + 5]), pk2(at[st][8 * s2 + 6], at[st][8 * s2 + 7])};
                const bf16x8 pf = __builtin_bit_cast(bf16x8, pw);
#pragma unroll
                for (int i = 0; i < 2; ++i) {
                    LAS unsigned char* vp = lds + GC_VT + (64 * vh + 32 * i + l31) * 136 + (32 * st + 16 * s2 + 4 * hh) * 2;
                    const u32x2 v0 = *(LAS u32x2*)vp, v1 = *(LAS u32x2*)(vp + 16);
                    u32x4 vw = {v0.x, v0.y, v1.x, v1.y};
                    o[i] = __builtin_amdgcn_mfma_f32_32x32x16_bf16(__builtin_bit_cast(bf16x8, vw), pf, o[i], 0, 0, 0);
                }
            }
        __syncthreads();
    }
    float ss = 0.f;
#pragma unroll
    for (int i = 0; i < 2; ++i)
#pragma unroll
        for (int r = 0; r < 16; ++r) ss += o[i][r] * o[i][r];
    ss = xhalf_sum(ss);
    LAS float* xch = (LAS float*)(lds + GC_XCH);
    if (hh == 0) xch[(pt * 2 + vh) * 32 + l31] = ss;
    __syncthreads();
    ss += xch[(pt * 2 + (1 - vh)) * 32 + l31];
    const float rstd = rsqrtf(ss * (1.f / 128.f) + EPS);
    const size_t trow = row0 + 32 * pt + l31;
    const bf16* gr = (const bf16*)(P.ws + WS_R3 + R3_GR) + trow * 512 + h * 128 + 64 * vh + 4 * hh;
    bf16* mx = (bf16*)(P.ws + WS_R2) + trow * 1024 + h * 128 + 64 * vh + 4 * hh;
    const float* gn = P.in[12] + 64 * vh + 4 * hh;
#pragma unroll
    for (int i = 0; i < 2; ++i)
#pragma unroll
        for (int g = 0; g < 4; ++g) {
            const u32x2 rw = *(const u32x2*)(gr + i * 32 + 8 * g); const f32x4 gg = *(const f32x4*)(gn + i * 32 + 8 * g);
            const float r0 = __uint_as_float(rw.x << 16), r1 = __uint_as_float(rw.x & 0xffff0000u), r2 = __uint_as_float(rw.y << 16), r3_ = __uint_as_float(rw.y & 0xffff0000u);
            const float y0 = o[i][4 * g] * rstd * gg.x * (r0 / (1.f + __expf(-r0))), y1 = o[i][4 * g + 1] * rstd * gg.y * (r1 / (1.f + __expf(-r1)));
            const float y2 = o[i][4 * g + 2] * rstd * gg.z * (r2 / (1.f + __expf(-r2))), y3 = o[i][4 * g + 3] * rstd * gg.w * (r3_ / (1.f + __expf(-r3_)));
            u32x2 v = {pk2(y0, y1), pk2(y2, y3)}; *(u32x2*)(mx + i * 32 + 8 * g) = v;
        }
    __syncthreads();
}
__device__ __forceinline__ void ph_gla_c(const Ptrs& P, LAS unsigned char* smem, int bid, int nblk) {
    for (int item = bid; item < 4 * 4 * 68; item += nblk) gla_pass_c_item(P, item, smem);
}

#define XB_TMO      128
#define XB_XCNT(j)  (256  + 64 * (j))
#define XB_XSUB(j)  (1280 + 64 * (j))
#define XB_XGEN(j)  (2304 + 64 * (j))
#define XB_TOP      3328
#define XB_TOPGEN   3392
#define XB_SPIN_CAP (1u << 20)
constexpr int CTL_BAR = 4096;
__device__ __forceinline__ unsigned xb_ld(unsigned* p) { return __hip_atomic_load(p, __ATOMIC_RELAXED, __HIP_MEMORY_SCOPE_AGENT); }
__device__ __forceinline__ unsigned xb_add(unsigned* p, unsigned v) { return __hip_atomic_fetch_add(p, v, __ATOMIC_RELAXED, __HIP_MEMORY_SCOPE_AGENT); }
__device__ __forceinline__ unsigned xb_xcc_id() { return (unsigned)__builtin_amdgcn_s_getreg((3 << 11) | 20) & 0xFu; }
#define XB_SPIN(cond, bar) do { unsigned _sp = 0; while (cond) { __builtin_amdgcn_s_sleep(1); \
    if ((++_sp & 255u) == 0u) { if (xb_ld(&(bar)[XB_TMO])) break; if (_sp > XB_SPIN_CAP) { atomicAdd(&(bar)[XB_TMO], 1u); break; } } } } while (0)
struct XcdBarrier { unsigned* bar; unsigned x; volatile LAS unsigned* st; };
__device__ __forceinline__ XcdBarrier xcd_barrier_post(unsigned* bar, volatile LAS unsigned* st) {
    XcdBarrier b; b.bar = bar; b.x = xb_xcc_id(); b.st = st;
    if (threadIdx.x == 0) (void)xb_add(&bar[XB_XCNT(b.x)], 1u);
    return b;
}
__device__ __forceinline__ void xcd_barrier_complete(unsigned* bar, unsigned x, unsigned& nloc, unsigned& nx) {
    const unsigned G = gridDim.x * gridDim.y * gridDim.z;
    unsigned sum, cnt, mine, sp = 0u;
    for (;;) {
        sum = 0u; cnt = 0u; mine = 0u;
#pragma unroll
        for (unsigned j = 0; j < 16; ++j) { const unsigned c = xb_ld(&bar[XB_XCNT(j)]); sum += c; cnt += (c > 0u) ? 1u : 0u; mine = (j == x) ? c : mine; }
        if (sum == G) break;
        __builtin_amdgcn_s_sleep(1);
        if ((++sp & 255u) == 0u) { if (xb_ld(&bar[XB_TMO])) break; if (sp > XB_SPIN_CAP) { atomicAdd(&bar[XB_TMO], 1u); break; } }
    }
    nloc = mine > 0u ? mine : 1u; nx = cnt > 0u ? cnt : 1u;
}
__device__ __forceinline__ void xcd_barrier(const XcdBarrier& b) {
    asm volatile("s_waitcnt vmcnt(0)" ::: "memory");
    __syncthreads();
    if (threadIdx.x == 0) {
        unsigned* bar = b.bar;
        __builtin_amdgcn_s_waitcnt(0);
        unsigned nloc = b.st[0], nx = b.st[1];
        if (nloc == 0u) { xcd_barrier_complete(bar, b.x, nloc, nx); b.st[0] = nloc; b.st[1] = nx; }
        const unsigned old = xb_add(&bar[XB_XSUB(b.x)], 1u);
        const unsigned gen = old / nloc;
        if (old + 1u == (gen + 1u) * nloc) {
            __builtin_amdgcn_fence(__ATOMIC_RELEASE, "agent");
            asm volatile("s_waitcnt vmcnt(0)" ::: "memory");
            const unsigned og = xb_add(&bar[XB_TOP], 1u);
            const unsigned tg = og / nx;
            if (og + 1u == (tg + 1u) * nx) xb_add(&bar[XB_TOPGEN], 1u);
            else XB_SPIN(xb_ld(&bar[XB_TOPGEN]) == tg, bar);
            __builtin_amdgcn_fence(__ATOMIC_ACQUIRE, "agent");
            xb_add(&bar[XB_XGEN(b.x)], 1u);
            asm volatile("s_waitcnt vmcnt(0)" ::: "memory");
        } else {
            XB_SPIN(xb_ld(&bar[XB_XGEN(b.x)]) == gen, bar);
            __builtin_amdgcn_fence(__ATOMIC_ACQUIRE, "agent");
            asm volatile("s_waitcnt vmcnt(0)" ::: "memory");
        }
    }
    __syncthreads();
}

constexpr int N_PHASES = 18;
constexpr int SMEM_BYTES = GEMM_LDS + 2048;
struct Args { Ptrs P; int ph_lo, ph_hi; };
__global__ void __launch_bounds__(256, 2) fwd_megakernel(Args args) {
    __shared__ __attribute__((aligned(16))) unsigned char smem_raw[SMEM_BYTES];
    LAS unsigned char* smem = (LAS unsigned char*)smem_raw;
    const Ptrs& P = args.P;
    const int bid = blockIdx.x, nblk = gridDim.x;
    volatile LAS unsigned* bst = (volatile LAS unsigned*)(smem + GEMM_LDS + 128);
    if (threadIdx.x < 2) bst[threadIdx.x] = 0u;
    __syncthreads();
    XcdBarrier bar; bar.bar = (unsigned*)(P.ws + WS_CTL) + CTL_BAR; bar.x = 0; bar.st = bst;
    const bool multi = args.ph_hi - args.ph_lo > 1;
    if (multi) bar = xcd_barrier_post((unsigned*)(P.ws + WS_CTL) + CTL_BAR, bst);
    const int lo = args.ph_lo, hi = args.ph_hi;
#define PHASE(k, call) if (lo <= (k) && (k) < hi) { if ((k) > lo) xcd_barrier(bar); call; }
    PHASE(0, ph_prologue(P, smem, bid, nblk))
    PHASE(1, ph_modulate(P, 0, bid, nblk))
    PHASE(2, ph_even_inproj(P, smem, bid, nblk))
    PHASE(3, ph_gla_a(P, smem, bid, nblk))
    PHASE(4, gla_pass_b(P, bid * 256 + threadIdx.x, nblk * 256))
    PHASE(5, (ph_dense_attn(P, smem, bid, nblk), __syncthreads(), ph_gla_c(P, smem, (bid + nblk - 128) % nblk, nblk)))
    PHASE(7, ph_outproj(P, smem, bid, nblk, 0, NT))
    PHASE(8, ph_moe_route(P, smem, bid, nblk, 0, NT))
    PHASE(9, ph_moe_stage1(P, smem, bid, nblk, 0))
    PHASE(10, ph_moe_stage2(P, smem, bid, nblk, 0))
    PHASE(11, ph_modulate(P, 1, bid, nblk))
    PHASE(12, ph_odd_inproj(P, smem, bid, nblk))
    PHASE(13, ph_swa_attn(P, smem, bid, nblk))
    PHASE(14, ph_outproj(P, smem, bid, nblk, 1, NL))
    PHASE(15, ph_moe_route(P, smem, bid, nblk, 1, NL))
    PHASE(16, ph_moe_stage1(P, smem, bid, nblk, 1))
    PHASE(17, ph_moe_stage2(P, smem, bid, nblk, 1))
#undef PHASE
}

#ifndef MK_LAUNCHES
#define MK_LAUNCHES 1
#endif
extern "C" void kernel_launch(void* const* d_in, const int* in_sizes, int n_in, void* d_out, int out_size, void* d_ws, size_t ws_size, hipStream_t stream) {
    static int grid = 0;
    if (grid == 0) {
        int dev = 0, cus = 0, per_cu = 0;
        hipGetDevice(&dev);
        hipDeviceGetAttribute(&cus, hipDeviceAttributeMultiprocessorCount, dev);
        hipOccupancyMaxActiveBlocksPerMultiprocessor(&per_cu, (const void*)fwd_megakernel, 256, 0);
        if (per_cu > 2) per_cu = 2;
        if (per_cu < 1) per_cu = 1;
        grid = cus * per_cu;
    }
    hipMemsetAsync((unsigned char*)d_ws + WS_CTL, 0, 65536, stream);
    Args a{};
    for (int i = 0; i < 27; ++i) a.P.in[i] = (const float*)d_in[i];
    a.P.out = (float*)d_out; a.P.ws = (unsigned char*)d_ws;
#if MK_LAUNCHES == 1
    a.ph_lo = 0; a.ph_hi = N_PHASES;
    void* kargs[] = {&a};
    hipLaunchCooperativeKernel((const void*)fwd_megakernel, dim3(grid), dim3(256), kargs, 0, stream);
#else
    for (int ph = 0; ph < N_PHASES; ++ph) { a.ph_lo = ph; a.ph_hi = ph + 1; hipLaunchKernelGGL(fwd_megakernel, dim3(grid), dim3(256), 0, stream, a); }
#endif
}
```

```cpp
#include <hip/hip_runtime.h>
#include <stdint.h>

typedef unsigned short bf16;
__device__ __forceinline__ float bf2f(bf16 v) { return __uint_as_float(((unsigned)v) << 16); }
__device__ __forceinline__ bf16 f2bf(float f) { unsigned u = __float_as_uint(f); return (bf16)((u + 0x7fffu + ((u >> 16) & 1u)) >> 16); }

constexpr int D = 1024, NB = 4, S = 4096, CL = 256, NL = NB * S, NC = NB * CL, NT = NL + NC;
constexpr int EVEN_IN = 2336, ODD_IN = 1280;
constexpr float EPS = 1e-6f;

__device__ __forceinline__ float silu(float x) { return x / (1.f + expf(-x)); }
__device__ __forceinline__ float wave_sum(float v) {
#pragma unroll
    for (int o = 1; o < 64; o <<= 1) v += __shfl_xor(v, o);
    return v;
}

#define LAS __attribute__((address_space(3)))
typedef short bf16x8 __attribute__((ext_vector_type(8)));
typedef float f32x16 __attribute__((ext_vector_type(16)));
typedef float f32x4 __attribute__((ext_vector_type(4)));
typedef unsigned u32x4 __attribute__((ext_vector_type(4)));
typedef unsigned u32x2 __attribute__((ext_vector_type(2)));
typedef __bf16 bf16x2_t __attribute__((ext_vector_type(2)));
typedef float f32x2_t __attribute__((ext_vector_type(2)));
__device__ __forceinline__ unsigned pk2(float lo, float hi) { f32x2_t v = {lo, hi}; bf16x2_t b = __builtin_convertvector(v, bf16x2_t); return __builtin_bit_cast(unsigned, b); }
__device__ __forceinline__ float xhalf_sum(float x) {
    auto t = __builtin_amdgcn_permlane32_swap(__float_as_uint(x), __float_as_uint(x), false, false);
    return __uint_as_float(t[0]) + __uint_as_float(t[1]);
}

constexpr int NPAD_E = 2432;
constexpr int TILE_LDS = 128 * 128;
constexpr int GEMM_LDS = 4 * TILE_LDS;

__device__ __forceinline__ void transpose_item(const float* W, int K, int N, bf16* WT, int dst_row0, int k0, int n0, LAS float* scr, int lane) {
    float tv[32];
#pragma unroll
    for (int i = 0; i < 32; ++i) tv[i] = W[(size_t)(k0 + 2 * i + (lane >> 5)) * N + n0 + (lane & 31)];
#pragma unroll
    for (int i = 0; i < 32; ++i) scr[(2 * i + (lane >> 5)) * 33 + (lane & 31)] = tv[i];
    asm volatile("s_waitcnt lgkmcnt(0)" ::: "memory");
    const int c = lane & 7;
#pragma unroll
    for (int j = 0; j < 4; ++j) {
        const int n = (lane >> 3) + 8 * j; const LAS float* s = scr + (8 * c) * 33 + n;
        u32x4 o; o.x = pk2(s[0 * 33], s[1 * 33]); o.y = pk2(s[2 * 33], s[3 * 33]); o.z = pk2(s[4 * 33], s[5 * 33]); o.w = pk2(s[6 * 33], s[7 * 33]);
        *(u32x4*)(WT + (size_t)(dst_row0 + n) * K + k0 + 8 * c) = o;
    }
    asm volatile("s_waitcnt lgkmcnt(0)" ::: "memory");
}

struct Ptrs {
    const float* in[27];
    float* out;
    unsigned char* ws;
};

constexpr size_t MiB = 1u << 20;
constexpr size_t WS_CTL = 0;
constexpr size_t WS_MODV = 1 * MiB;
constexpr size_t WS_ROPE = WS_MODV + 256 * 1024;
constexpr size_t WS_WINE = 2 * MiB;
constexpr size_t WS_WOUTE = WS_WINE + (size_t)NPAD_E * 1024 * 2;
constexpr size_t WS_WINO = WS_WOUTE + 2 * MiB;
constexpr size_t WS_WOUTO = WS_WINO + (size_t)1280 * 1024 * 2;
constexpr size_t WS_WGU = WS_WOUTO + 2 * MiB;
constexpr size_t WS_WD = WS_WGU + 32 * MiB;
constexpr size_t WS_CTXS = WS_WD + 16 * MiB;
constexpr size_t WS_R1 = 66 * MiB;
constexpr size_t WS_R4 = WS_R1 + 34 * MiB;
constexpr size_t WS_R2 = WS_R4 + 34 * MiB;
constexpr size_t WS_R3 = WS_R2 + 34 * MiB;
static_assert(WS_CTXS + 4 * MiB <= WS_R1, "ws map");
constexpr size_t R3_GQ = 0, R3_GK = R3_GQ + (size_t)NT * 256 * 2, R3_GV = R3_GK + (size_t)NT * 256 * 2, R3_GR = R3_GV + (size_t)NT * 512 * 2,
                 R3_LR = R3_GR + (size_t)NT * 512 * 2, R3_AQ = R3_LR + (size_t)NT * 32 * 4, R3_AK = R3_AQ + (size_t)NT * 512 * 2, R3_AV = R3_AK + (size_t)NT * 128 * 2,
                 R3_END = R3_AV + (size_t)NT * 128 * 2;
static_assert(WS_R3 + R3_END <= 256 * MiB, "ws map end");
constexpr size_t R3_OQ = 0, R3_OK = R3_OQ + (size_t)NL * 1024 * 2, R3_OV = R3_OK + (size_t)NT * 128 * 2;

__device__ __forceinline__ void ph_prologue(const Ptrs& P, LAS unsigned char* smem, int bid, int nblk) {
    const int lane = threadIdx.x & 63, wave = threadIdx.x >> 6;
    LAS float* scr = (LAS float*)smem + wave * 64 * 33;
    const int gw = bid * 4 + wave, NGW = nblk * 4;
    unsigned char* ws = P.ws;
    constexpr int I_WINE = 16 * 73, I_SQ = 16 * 32, I_WINO = 16 * 40, I_EXP_GU = 16 * 8, I_EXP_D = 4 * 32;
    constexpr int T_WINE = I_WINE, T_WOUTE = T_WINE + I_SQ, T_WINO = T_WOUTE + I_WINO, T_WOUTO = T_WINO + I_SQ,
                  T_G = T_WOUTO + 32 * I_EXP_GU, T_U = T_G + 32 * I_EXP_GU, T_D = T_U + 32 * I_EXP_D;
    for (int it = gw; it < T_D; it += NGW) {
        if (it < T_WINE) {
            int kb = it / 73, nb = it % 73, n0 = nb * 32;
            int dst = n0 < 1536 ? n0 : (n0 < 1568 ? n0 + 768 : n0 - 32);
            transpose_item(P.in[8], 1024, EVEN_IN, (bf16*)(ws + WS_WINE), dst, kb * 64, n0, scr, lane);
        } else if (it < T_WOUTE) { int r = it - T_WINE; transpose_item(P.in[9], 1024, 1024, (bf16*)(ws + WS_WOUTE), (r % 32) * 32, (r / 32) * 64, (r % 32) * 32, scr, lane); }
        else if (it < T_WINO) { int r = it - T_WOUTE; transpose_item(P.in[15], 1024, 1280, (bf16*)(ws + WS_WINO), (r % 40) * 32, (r / 40) * 64, (r % 40) * 32, scr, lane); }
        else if (it < T_WOUTO) { int r = it - T_WINO; transpose_item(P.in[16], 1024, 1024, (bf16*)(ws + WS_WOUTO), (r % 32) * 32, (r / 32) * 64, (r % 32) * 32, scr, lane); }
        else if (it < T_U) {
            bool up = it >= T_G; int r = it - (up ? T_G : T_WOUTO); int le = r / I_EXP_GU; r %= I_EXP_GU; int kb = r / 8, hb = r % 8;
            const float* W = (up ? P.in[25] : P.in[24]) + (size_t)le * 1024 * 256;
            transpose_item(W, 1024, 256, (bf16*)(ws + WS_WGU) + (size_t)le * 512 * 1024, 64 * hb + (up ? 32 : 0), kb * 64, hb * 32, scr, lane);
        } else {
            int r = it - T_U; int le = r / I_EXP_D; r %= I_EXP_D; int kb = r / 32, nb = r % 32;
            transpose_item(P.in[26] + (size_t)le * 256 * 1024, 256, 1024, (bf16*)(ws + WS_WD) + (size_t)le * 1024 * 256, nb * 32, kb * 64, nb * 32, scr, lane);
        }
    }
    { u32x4 z = {0, 0, 0, 0}; u32x4* p = (u32x4*)((bf16*)(ws + WS_WINE) + (size_t)EVEN_IN * 1024);
      for (int i = bid * 256 + threadIdx.x; i < 96 * 1024 * 2 / 16; i += nblk * 256) p[i] = z; }
    for (int i = bid * 256 + threadIdx.x; i < 1024; i += nblk * 256) {
        int pos = i >> 4, f = i & 15; float inv = powf(10000.f, -(float)(2 * f) / 32.f); float ang = (float)pos * inv;
        ((float2*)(ws + WS_ROPE))[i] = make_float2(cosf(ang), sinf(ang));
    }
    __syncthreads();
    {
        LAS float* sc = (LAS float*)smem;
        LAS float* red = (LAS float*)smem + 5 * 1024;
        for (int i = threadIdx.x; i < 5 * 1024; i += 256) { const float cv = i < 4096 ? P.in[1][i] : P.in[3][i - 4096]; sc[i] = cv / (1.f + expf(-cv)); }
        __syncthreads();
        for (int it = bid; it < 2 * 96; it += nblk) {
            const int layer = it / 96, col = (it % 96) * 64 + lane;
            const float* w = P.in[4] + (size_t)layer * D * 6144 + col;
            float a0 = 0.f, a1 = 0.f, a2 = 0.f, a3 = 0.f, a4 = 0.f;
#pragma unroll 32
            for (int k = 256 * wave; k < 256 * wave + 256; ++k) { const float wv = w[(size_t)k * 6144]; a0 += sc[k] * wv; a1 += sc[1024 + k] * wv; a2 += sc[2048 + k] * wv; a3 += sc[3072 + k] * wv; a4 += sc[4096 + k] * wv; }
            red[(wave * 5 + 0) * 64 + lane] = a0; red[(wave * 5 + 1) * 64 + lane] = a1; red[(wave * 5 + 2) * 64 + lane] = a2; red[(wave * 5 + 3) * 64 + lane] = a3; red[(wave * 5 + 4) * 64 + lane] = a4;
            __syncthreads();
            for (int i = threadIdx.x; i < 320; i += 256) { const int row = i >> 6, cl = i & 63;
                ((float*)(ws + WS_MODV))[((size_t)layer * 5 + row) * 6144 + (it % 96) * 64 + cl] = red[row * 64 + cl] + red[(5 + row) * 64 + cl] + red[(10 + row) * 64 + cl] + red[(15 + row) * 64 + cl] + P.in[5][layer * 6144 + (it % 96) * 64 + cl]; }
            __syncthreads();
        }
    }
}

template <bool SRC_BF>
__device__ __forceinline__ void modulate_rows(const float* xlat, const float* xctx, const bf16* xs, const float* modv_layer, const float* gain, int which, bf16* H, int nrows, int gw, int NGW, int lane) {
    for (int row = gw; row < nrows; row += NGW) {
        const float* mv = modv_layer + (size_t)(row < NL ? row / S : 4) * 6144;
        f32x4 v[4]; float ss = 0.f;
#pragma unroll
        for (int j = 0; j < 4; ++j) {
            if (SRC_BF) { const u32x2 w = *(const u32x2*)(xs + (size_t)row * D + 4 * lane + 256 * j); f32x4 t = {__uint_as_float(w.x << 16), __uint_as_float(w.x & 0xffff0000u), __uint_as_float(w.y << 16), __uint_as_float(w.y & 0xffff0000u)}; v[j] = t; }
            else { const float* xr = row < NL ? xlat + (size_t)row * D : xctx + (size_t)(row - NL) * D; v[j] = *(const f32x4*)(xr + 4 * lane + 256 * j); }
            ss += v[j].x * v[j].x + v[j].y * v[j].y + v[j].z * v[j].z + v[j].w * v[j].w;
        }
        float rstd = rsqrtf(wave_sum(ss) / D + EPS);
#pragma unroll
        for (int j = 0; j < 4; ++j) {
            int k = 4 * lane + 256 * j;
            f32x4 g = *(const f32x4*)(gain + k), sc = *(const f32x4*)(mv + (which + 1) * 1024 + k), sh = *(const f32x4*)(mv + which * 1024 + k);
            float h0 = v[j].x * rstd * g.x * (1.f + sc.x) + sh.x, h1 = v[j].y * rstd * g.y * (1.f + sc.y) + sh.y;
            float h2 = v[j].z * rstd * g.z * (1.f + sc.z) + sh.z, h3 = v[j].w * rstd * g.w * (1.f + sc.w) + sh.w;
            u32x2 o = {pk2(h0, h1), pk2(h2, h3)};
            *(u32x2*)(H + (size_t)row * D + k) = o;
        }
    }
}
__device__ __forceinline__ void route_tables(const Ptrs& P, int layer, int bid, int nblk);
__device__ __forceinline__ void ph_modulate(const Ptrs& P, int layer, int bid, int nblk) {
    route_tables(P, layer, bid, nblk);
    if (layer == 0) modulate_rows<false>(P.in[0], P.in[2], nullptr, (const float*)(P.ws + WS_MODV), P.in[6], 0, (bf16*)(P.ws + WS_R1), NT, bid * 4 + (threadIdx.x >> 6), nblk * 4, threadIdx.x & 63);
    else modulate_rows<true>(nullptr, nullptr, (const bf16*)(P.ws + WS_R4), (const float*)(P.ws + WS_MODV) + (size_t)5 * 6144, P.in[6] + D, 0, (bf16*)(P.ws + WS_R1), NT, bid * 4 + (threadIdx.x >> 6), nblk * 4, threadIdx.x & 63);
}

struct AffineRows {
    const bf16* base; size_t ld; const bf16* p0;
    __device__ __forceinline__ AffineRows(const bf16* b, size_t ld_) : base(b), ld(ld_), p0(b) {}
    __device__ __forceinline__ void init(int r0) { p0 = base + (size_t)r0 * ld; }
    __device__ __forceinline__ const bf16* ptr(int i, int kt) const { return p0 + (size_t)i * 8 * ld + kt * 64; }
};
template <bool SWP, class AF, class BF, class Epi>
__device__ __forceinline__ void gemm_tile(AF af, BF bf, int nk, LAS unsigned char* smem, const Epi& epi) {
    const int tid = threadIdx.x, lane = tid & 63, wave = tid >> 6, wn = wave & 1, wm = wave >> 1, l31 = lane & 31, hh = lane >> 5;
    const int r0 = wave * 32 + (lane >> 3);
    af.init(r0); bf.init(r0);
    __syncthreads();
    typename Epi::Pre pre; epi.prefetch(pre, wn * 64, wm * 64, l31, hh);
    __builtin_amdgcn_sched_barrier(0);
    int coff[4];
#pragma unroll
    for (int i = 0; i < 4; ++i) coff[i] = ((lane & 7) ^ (((r0 >> 1) + 4 * i) & 7)) * 8;
#define GT_STAGE(st, kt) do { _Pragma("unroll") for (int i = 0; i < 4; ++i) { \
        __builtin_amdgcn_global_load_lds((const unsigned*)(af.ptr(i, (kt)) + coff[i]), (LAS unsigned*)(smem + (st) * 2 * TILE_LDS + (wave * 4 + i) * 1024), 16, 0, 0); \
        __builtin_amdgcn_global_load_lds((const unsigned*)(bf.ptr(i, (kt)) + coff[i]), (LAS unsigned*)(smem + (st) * 2 * TILE_LDS + TILE_LDS + (wave * 4 + i) * 1024), 16, 0, 0); } } while (0)
    GT_STAGE(0, 0);
    f32x16 acc[2][2];
#pragma unroll
    for (int i = 0; i < 2; ++i)
#pragma unroll
        for (int j = 0; j < 2; ++j)
#pragma unroll
            for (int r = 0; r < 16; ++r) acc[i][j][r] = 0.f;
    const int sw = (l31 >> 1) & 7;
    int xo[4], wo[4];
#pragma unroll
    for (int s = 0; s < 4; ++s) { const int cs = ((2 * s + hh) ^ sw) * 16; xo[s] = (wm * 64 + l31) * 128 + cs; wo[s] = TILE_LDS + (wn * 64 + l31) * 128 + cs; }
    asm volatile("s_waitcnt vmcnt(0)" ::: "memory");
    __syncthreads();
    for (int kt = 0; kt < nk; ++kt) {
        const int st = kt & 1;
        if (kt + 1 < nk) GT_STAGE(st ^ 1, kt + 1);
        LAS unsigned char* sb = smem + st * 2 * TILE_LDS;
#pragma unroll
        for (int s = 0; s < 4; ++s) {
            bf16x8 wf[2], xf[2];
#pragma unroll
            for (int i = 0; i < 2; ++i) wf[i] = *(LAS bf16x8*)(sb + wo[s] + i * 4096);
#pragma unroll
            for (int j = 0; j < 2; ++j) xf[j] = *(LAS bf16x8*)(sb + xo[s] + j * 4096);
#pragma unroll
            for (int i = 0; i < 2; ++i)
#pragma unroll
                for (int j = 0; j < 2; ++j) acc[i][j] = SWP ? __builtin_amdgcn_mfma_f32_32x32x16_bf16(xf[j], wf[i], acc[i][j], 0, 0, 0)
                                                            : __builtin_amdgcn_mfma_f32_32x32x16_bf16(wf[i], xf[j], acc[i][j], 0, 0, 0);
        }
        asm volatile("s_waitcnt vmcnt(0)" ::: "memory");
        __syncthreads();
    }
#undef GT_STAGE
    { int l31e = l31, hhe = hh, we = wave; asm volatile("" : "+v"(l31e), "+v"(hhe), "+v"(we));
      epi(acc, (we & 1) * 64, (we >> 1) * 64, l31e, hhe, smem + we * 16384, pre); }
}

constexpr int SG_P = 144;
__device__ __forceinline__ void store_bf16_T(const f32x16 (&acc)[2][2], bf16* out, size_t ld, size_t trow0, int col0, int l31, int hh, LAS unsigned char* wl) {
#pragma unroll
    for (int j = 0; j < 2; ++j)
#pragma unroll
        for (int i = 0; i < 2; ++i)
#pragma unroll
            for (int g = 0; g < 4; ++g) { u32x2 v = {pk2(acc[i][j][4 * g], acc[i][j][4 * g + 1]), pk2(acc[i][j][4 * g + 2], acc[i][j][4 * g + 3])}; *(LAS u32x2*)(wl + (32 * j + l31) * SG_P + (32 * i + 8 * g + 4 * hh) * 2) = v; }
    const int lane = l31 + 32 * hh, rr = lane >> 3, ch = lane & 7;
#pragma unroll
    for (int q = 0; q < 8; ++q) { const int R = 8 * q + rr; const u32x4 v = *(LAS u32x4*)(wl + R * SG_P + ch * 16); *(u32x4*)(out + (trow0 + R) * ld + col0 + ch * 8) = v; }
}
__device__ __forceinline__ void qknorm_rope_T(f32x16 (&acc)[2][2], const float* gain, const float2* ropeT, bool latent, int tok0  , int l31, int hh) {
#pragma unroll
    for (int j = 0; j < 2; ++j) {
        float ss = 0.f;
#pragma unroll
        for (int i = 0; i < 2; ++i)
#pragma unroll
            for (int r = 0; r < 16; ++r) ss += acc[i][j][r] * acc[i][j][r];
        ss = xhalf_sum(ss);
        const float rstd = rsqrtf(ss * (1.f / 64.f) + EPS);
#pragma unroll
        for (int i = 0; i < 2; ++i)
#pragma unroll
            for (int r = 0; r < 16; ++r) acc[i][j][r] *= rstd * gain[i * 32 + (r & 3) + 8 * (r >> 2) + 4 * hh];
        if (latent) {
            const int t = tok0 + j * 32 + l31;
#pragma unroll
            for (int i = 0; i < 2; ++i) {
                const int pos = i == 0 ? (t >> 6) : (t & 63);
#pragma unroll
                for (int r = 0; r < 8; ++r) {
                    const int f = (r & 3) + 8 * (r >> 2) + 4 * hh;
                    const float2 cs = ropeT[pos * 16 + f];
                    const float x1 = acc[i][j][r], x2 = acc[i][j][r + 8];
                    acc[i][j][r] = x1 * cs.x - x2 * cs.y; acc[i][j][r + 8] = x2 * cs.x + x1 * cs.y;
                }
            }
        }
    }
}

constexpr int VT_LD = S + CL;
__device__ __forceinline__ void store_vt_swapped(const f32x16 (&acc)[2][2], bf16* vt_head  , int key0, int l31, int hh, LAS unsigned char* wl) {
#pragma unroll
    for (int i = 0; i < 2; ++i)
#pragma unroll
        for (int j = 0; j < 2; ++j)
#pragma unroll
            for (int g = 0; g < 4; ++g) { u32x2 v = {pk2(acc[i][j][4 * g], acc[i][j][4 * g + 1]), pk2(acc[i][j][4 * g + 2], acc[i][j][4 * g + 3])}; *(LAS u32x2*)(wl + (32 * i + l31) * SG_P + (32 * j + 8 * g + 4 * hh) * 2) = v; }
    const int lane = l31 + 32 * hh, rr = lane >> 3, ch = lane & 7;
#pragma unroll
    for (int q = 0; q < 8; ++q) { const int R = 8 * q + rr; const u32x4 v = *(LAS u32x4*)(wl + R * SG_P + ch * 16); *(u32x4*)(vt_head + (size_t)R * VT_LD + key0 + ch * 8) = v; }
}
struct NoPre {};
template <bool SRC_BF> struct RmwPre { f32x4 xi[16]; };
template <> struct RmwPre<true> { u32x2 xi[16]; };
template <bool SRC_BF, class RowF>
__device__ __forceinline__ void rmw_prefetch(RmwPre<SRC_BF>& pre, const RowF& rowf, int l31, int hh) {
    const int lane = l31 + 32 * hh, rr = lane >> 4, ch = lane & 15;
#pragma unroll
    for (int q = 0; q < 16; ++q) {
        const void* sp; void* dp; const float* gp;
        if (rowf(4 * q + rr, sp, dp, gp)) {
            if constexpr (SRC_BF) pre.xi[q] = *(const u32x2*)((const bf16*)sp + ch * 4); else pre.xi[q] = *(const f32x4*)((const float*)sp + ch * 4);
        }
    }
}
template <bool SRC_BF, bool DST_BF, class RowF>
__device__ __forceinline__ void rmw_finish(const f32x16 (&acc)[2][2], const RmwPre<SRC_BF>& pre, const RowF& rowf, int l31, int hh, LAS unsigned char* wl) {
    const int lane = l31 + 32 * hh, rr = lane >> 4, ch = lane & 15;
#pragma unroll
    for (int j = 0; j < 2; ++j)
#pragma unroll
        for (int i = 0; i < 2; ++i)
#pragma unroll
            for (int g = 0; g < 4; ++g) { f32x4 v = {acc[i][j][4 * g], acc[i][j][4 * g + 1], acc[i][j][4 * g + 2], acc[i][j][4 * g + 3]};
                const int R = 32 * j + l31; *(LAS f32x4*)(wl + R * 256 + (((8 * i + 2 * g + hh) ^ (R & 15)) * 16)) = v; }
#pragma unroll
    for (int q = 0; q < 16; ++q) {
        const void* sp; void* dp; const float* gp;
        if (rowf(4 * q + rr, sp, dp, gp)) {
            f32x4 x;
            if constexpr (SRC_BF) { const u32x2 w = pre.xi[q]; f32x4 t = {__uint_as_float(w.x << 16), __uint_as_float(w.x & 0xffff0000u), __uint_as_float(w.y << 16), __uint_as_float(w.y & 0xffff0000u)}; x = t; } else x = pre.xi[q];
            const int R = 4 * q + rr; const f32x4 a = *(LAS f32x4*)(wl + R * 256 + ((ch ^ (R & 15)) * 16)); const f32x4 gt = *(const f32x4*)(gp + ch * 4);
            const f32x4 v = {x.x + gt.x * a.x, x.y + gt.y * a.y, x.z + gt.z * a.z, x.w + gt.w * a.w};
            if (DST_BF) { u32x2 o = {pk2(v.x, v.y), pk2(v.z, v.w)}; *(u32x2*)((bf16*)dp + ch * 4) = o; }
            else *(f32x4*)((float*)dp + ch * 4) = v;
        }
    }
}
struct EpiEvenIn {
    typedef NoPre Pre;
    __device__ __forceinline__ void prefetch(Pre&, int, int, int, int) const {}
    unsigned char* r3; const float* qn; const float* kn; const float2* ropeT; int mt, nt;
    __device__ __forceinline__ bool swapped() const { return nt == 17 || (nt >= 4 && nt < 8); }
    __device__ __forceinline__ void operator()(f32x16 (&acc)[2][2], int fb, int tb, int l31, int hh, LAS unsigned char* wl, const Pre& pre) const {
        const size_t trow0 = (size_t)mt * 128 + tb; const bool latent = mt < NL / 128; const int tok0 = (int)(trow0 & (S - 1));
        if (swapped()) {
            const int b = latent ? (int)(trow0 / S) : (int)((trow0 - NL) / CL); const int key0 = latent ? tok0 : S + (int)((trow0 - NL) % CL);
            const size_t off = nt == 17 ? R3_AV + (size_t)(b * 2 + fb / 64) * 64 * VT_LD * 2 : R3_GV + ((size_t)(b * 4 + nt - 4) * 128 + fb) * VT_LD * 2;
            store_vt_swapped(acc, (bf16*)(r3 + off), key0, l31, hh, wl);
        } else if (nt == 18) {
            if (fb == 0) {
                float* LR = (float*)(r3 + R3_LR);
#pragma unroll
                for (int j = 0; j < 2; ++j)
#pragma unroll
                    for (int g = 0; g < 4; ++g) { f32x4 v = {acc[0][j][4 * g], acc[0][j][4 * g + 1], acc[0][j][4 * g + 2], acc[0][j][4 * g + 3]}; *(f32x4*)(LR + (trow0 + j * 32 + l31) * 32 + 8 * g + 4 * hh) = v; }
            }
        } else {
            size_t off; int ld, col;
            if (nt < 2) { off = R3_GQ; ld = 256; col = nt * 128; }
            else if (nt < 4) { off = R3_GK; ld = 256; col = (nt - 2) * 128; }
            else if (nt < 12) { off = R3_GR; ld = 512; col = (nt - 8) * 128; }
            else if (nt < 16) { off = R3_AQ; ld = 512; col = (nt - 12) * 128; }
            else { off = R3_AK; ld = 128; col = 0; }
            if (nt >= 12) qknorm_rope_T(acc, nt < 16 ? qn : kn, ropeT, latent, tok0, l31, hh);
            store_bf16_T(acc, (bf16*)(r3 + off), ld, trow0, col + fb, l31, hh, wl);
        }
    }
};
__device__ __forceinline__ int xcd_vid(int bid, int nb) { return (nb % 8 == 0) ? (bid % 8) * (nb / 8) + bid / 8 : bid; }

__device__ __forceinline__ void ph_even_inproj(const Ptrs& P, LAS unsigned char* smem, int bid, int nblk) {
    unsigned char* ws = P.ws;
    const int lrow = threadIdx.x >> 3, kc = threadIdx.x & 7;
    const int vid = xcd_vid(bid, nblk);
    for (int tile = vid; tile < (NT / 128) * 19; tile += nblk) {
        const int mt = tile / 19, nt = tile % 19;
        AffineRows af((const bf16*)(ws + WS_R1) + (size_t)mt * 128 * D, D);
        AffineRows bf_((const bf16*)(ws + WS_WINE) + (size_t)nt * 128 * D, D);
        EpiEvenIn epi{ws + WS_R3, P.in[13], P.in[14], (const float2*)(ws + WS_ROPE), mt, nt};
        if (epi.swapped()) gemm_tile<true>(af, bf_, D / 64, smem, epi); else gemm_tile<false>(af, bf_, D / 64, smem, epi);
    }
}

template <int LAYER>
struct EpiOutProj {
    typedef RmwPre<LAYER != 0> Pre;
    const float* modv_layer; const float* xin_lat; const float* xin_ctx; bf16* xs; int mt, nt;
    __device__ __forceinline__ bool swapped() const { return false; }
    __device__ __forceinline__ auto rowfn(int fb, int tb) const {
        const size_t trow0 = (size_t)mt * 128 + tb; const bool latent = mt < NL / 128;
        const int c0 = nt * 128 + fb;
        const float* gate = modv_layer + (size_t)(latent ? trow0 / S : 4) * 6144 + 2 * 1024 + c0;
        bf16* xo = xs + trow0 * D + c0;
        const float* xin = LAYER == 0 ? (latent ? xin_lat + trow0 * D : xin_ctx + (trow0 - NL) * D) + c0 : nullptr;
        return [=](int R, const void*& sp, void*& dp, const float*& gp) { if (LAYER == 0) sp = xin + (size_t)R * D; else sp = xo + (size_t)R * D; dp = xo + (size_t)R * D; gp = gate; return true; };
    }
    __device__ __forceinline__ void prefetch(Pre& pre, int fb, int tb, int l31, int hh) const { rmw_prefetch<LAYER != 0>(pre, rowfn(fb, tb), l31, hh); }
    __device__ __forceinline__ void operator()(f32x16 (&acc)[2][2], int fb, int tb, int l31, int hh, LAS unsigned char* wl, const Pre& pre) const {
        rmw_finish<LAYER != 0, true>(acc, pre, rowfn(fb, tb), l31, hh, wl);
    }
};
__device__ __forceinline__ void ph_outproj(const Ptrs& P, LAS unsigned char* smem, int bid, int nblk, int layer, int nrows) {
    unsigned char* ws = P.ws;
    const int lrow = threadIdx.x >> 3, kc = threadIdx.x & 7;
    const int vid = xcd_vid(bid, nblk);
    const float* modv_layer = (const float*)(ws + WS_MODV) + (size_t)layer * 5 * 6144;
    for (int tile = vid; tile < (nrows / 128) * 8; tile += nblk) {
        const int mt = tile / 8, nt = tile % 8;
        AffineRows af((const bf16*)(ws + WS_R2) + (size_t)mt * 128 * D, D);
        AffineRows bf_((const bf16*)(ws + (layer ? WS_WOUTO : WS_WOUTE)) + (size_t)nt * 128 * D, D);
        if (layer == 0) { EpiOutProj<0> epi{modv_layer, P.in[0], P.in[2], (bf16*)(ws + WS_R4), mt, nt}; gemm_tile<false>(af, bf_, D / 64, smem, epi); }
        else { EpiOutProj<1> epi{modv_layer, nullptr, nullptr, (bf16*)(ws + WS_R4), mt, nt}; gemm_tile<false>(af, bf_, D / 64, smem, epi); }
    }
}

struct EpiOddIn {
    typedef NoPre Pre;
    __device__ __forceinline__ void prefetch(Pre&, int, int, int, int) const {}
    unsigned char* r3; const float* qn; const float* kn; const float2* ropeT; int mt, nt;
    __device__ __forceinline__ bool swapped() const { return nt == 9; }
    __device__ __forceinline__ void operator()(f32x16 (&acc)[2][2], int fb, int tb, int l31, int hh, LAS unsigned char* wl, const Pre& pre) const {
        const size_t trow0 = (size_t)mt * 128 + tb; const bool latent = mt < NL / 128; const int tok0 = (int)(trow0 & (S - 1));
        if (nt < 8) { if (latent) { qknorm_rope_T(acc, qn, ropeT, true, tok0, l31, hh); store_bf16_T(acc, (bf16*)(r3 + R3_OQ), 1024, trow0, nt * 128 + fb, l31, hh, wl); } }
        else if (nt == 8) { qknorm_rope_T(acc, kn, ropeT, latent, tok0, l31, hh); store_bf16_T(acc, (bf16*)(r3 + R3_OK), 128, trow0, fb, l31, hh, wl); }
        else {
            const int b = latent ? (int)(trow0 / S) : (int)((trow0 - NL) / CL); const int key0 = latent ? tok0 : S + (int)((trow0 - NL) % CL);
            store_vt_swapped(acc, (bf16*)(r3 + R3_OV) + (size_t)(b * 2 + fb / 64) * 64 * VT_LD, key0, l31, hh, wl);
        }
    }
};
__device__ __forceinline__ void ph_odd_inproj(const Ptrs& P, LAS unsigned char* smem, int bid, int nblk) {
    unsigned char* ws = P.ws;
    const int lrow = threadIdx.x >> 3, kc = threadIdx.x & 7;
    const int vid = xcd_vid(bid, nblk);
    constexpr int T_LAT = (NL / 128) * 10, T_ALL = T_LAT + (NC / 128) * 2;
    for (int tile = vid; tile < T_ALL; tile += nblk) {
        int mt, nt;
        if (tile < T_LAT) { mt = tile / 10; nt = tile % 10; } else { mt = NL / 128 + (tile - T_LAT) / 2; nt = 8 + (tile - T_LAT) % 2; }
        AffineRows af((const bf16*)(ws + WS_R1) + (size_t)mt * 128 * D, D);
        AffineRows bf_((const bf16*)(ws + WS_WINO) + (size_t)nt * 128 * D, D);
        EpiOddIn epi{ws + WS_R3, P.in[18], P.in[19], (const float2*)(ws + WS_ROPE), mt, nt};
        if (epi.swapped()) gemm_tile<true>(af, bf_, D / 64, smem, epi); else gemm_tile<false>(af, bf_, D / 64, smem, epi);
    }
}

constexpr int AT_KP = 144, AT_VP = 136;
constexpr int AT_STAGE = 64 * AT_KP + 64 * AT_VP;
constexpr int ATTN_LDS = 2 * AT_STAGE;
struct AttnArgs {
    const bf16* Q; int ldq; size_t qrow0; int qcol;
    const bf16* K; size_t klat0, kctx0;
    const bf16* Vt;
    int nctx, tlo, nlat;
    int banded, tq0;
    float sink_l2;
    bf16* out;
};
__device__ __forceinline__ float xhalf_max(float x) {
    auto t = __builtin_amdgcn_permlane32_swap(__float_as_uint(x), __float_as_uint(x), false, false);
    return fmaxf(__uint_as_float(t[0]), __uint_as_float(t[1]));
}
__device__ __forceinline__ void attn_block(const AttnArgs& a, LAS unsigned char* smem) {
    const int tid = threadIdx.x, lane = tid & 63, wave = tid >> 6, l31 = lane & 31, hh = lane >> 5;
    constexpr float C = 0.125f * 1.4426950408889634f;
    bf16x8 qf[4];
    { const bf16* qp = a.Q + (a.qrow0 + wave * 32 + l31) * a.ldq + a.qcol + hh * 8;
#pragma unroll
      for (int s = 0; s < 4; ++s) qf[s] = *(const bf16x8*)(qp + 16 * s); }
    f32x16 o[2];
#pragma unroll
    for (int dt = 0; dt < 2; ++dt)
#pragma unroll
        for (int r = 0; r < 16; ++r) o[dt][r] = 0.f;
    float m = -1e30f, lsum = 0.f;
    const int ntile = a.nctx + a.nlat;
    const int lr0 = tid >> 3, kc = tid & 7;
    u32x4 rk[2], rv[2];
#define AT_ISSUE(n) do { const int t_ = (n) < a.nctx ? 64 + (n) : a.tlo + (n) - a.nctx; \
        const bf16* kb_ = a.K + (t_ < 64 ? a.klat0 + 64 * t_ : a.kctx0 + 64 * (t_ - 64)) * 128 + kc * 8; const bf16* vb_ = a.Vt + 64 * t_ + kc * 8; \
        _Pragma("unroll") for (int i = 0; i < 2; ++i) { rk[i] = *(const u32x4*)(kb_ + (size_t)(lr0 + 32 * i) * 128); rv[i] = *(const u32x4*)(vb_ + (size_t)(lr0 + 32 * i) * VT_LD); } } while (0)
#define AT_COMMIT(st) do { LAS unsigned char* sb_ = smem + (st) * AT_STAGE; \
        _Pragma("unroll") for (int i = 0; i < 2; ++i) { *(LAS u32x4*)(sb_ + (lr0 + 32 * i) * AT_KP + kc * 16) = rk[i]; \
            LAS unsigned char* vp_ = sb_ + 64 * AT_KP + (lr0 + 32 * i) * AT_VP + kc * 16; u32x2 lo_ = {rv[i].x, rv[i].y}, hi_ = {rv[i].z, rv[i].w}; *(LAS u32x2*)vp_ = lo_; *(LAS u32x2*)(vp_ + 8) = hi_; } } while (0)
    AT_ISSUE(0); AT_COMMIT(0);
    __syncthreads();
    const int tq = a.tq0 + wave * 32 + l31;
    for (int n = 0; n < ntile; ++n) {
        const int st = n & 1;
        if (n + 1 < ntile) AT_ISSUE(n + 1);
        __builtin_amdgcn_sched_barrier(0);
        LAS unsigned char* sb = smem + st * AT_STAGE;
        bool skip = false;
        if (a.banded && n >= a.nctx) { const int k0 = 64 * (a.tlo + n - a.nctx), q0w = a.tq0 + wave * 32; skip = (k0 + 63 < q0w - 128) || (k0 > q0w + 31 + 128); }
        if (!skip) {
        f32x16 sc[2];
#pragma unroll
        for (int kt = 0; kt < 2; ++kt) {
#pragma unroll
            for (int r = 0; r < 16; ++r) sc[kt][r] = 0.f;
#pragma unroll
            for (int s = 0; s < 4; ++s) {
                const bf16x8 kf = *(LAS bf16x8*)(sb + (32 * kt + l31) * AT_KP + s * 32 + hh * 16);
                sc[kt] = __builtin_amdgcn_mfma_f32_32x32x16_bf16(kf, qf[s], sc[kt], 0, 0, 0);
            }
        }
        if (a.banded && n >= a.nctx) {
            const int t_ = a.tlo + n - a.nctx; const int dbase = 64 * t_ + 4 * hh - tq;
#pragma unroll
            for (int kt = 0; kt < 2; ++kt)
#pragma unroll
                for (int r = 0; r < 16; ++r) { const int df = dbase + 32 * kt + (r & 3) + 8 * (r >> 2); if (df > 128 || df < -128) sc[kt][r] = -1e30f; }
        }
        bf16x8 vfr[2][2][2];
#pragma unroll
        for (int kt = 0; kt < 2; ++kt)
#pragma unroll
            for (int s2 = 0; s2 < 2; ++s2)
#pragma unroll
                for (int dt = 0; dt < 2; ++dt) {
                    LAS unsigned char* vp = sb + 64 * AT_KP + (32 * dt + l31) * AT_VP + (32 * kt + 16 * s2 + 4 * hh) * 2;
                    const u32x2 v0 = *(LAS u32x2*)vp, v1 = *(LAS u32x2*)(vp + 16);
                    u32x4 vw = {v0.x, v0.y, v1.x, v1.y};
                    vfr[kt][s2][dt] = __builtin_bit_cast(bf16x8, vw);
                }
        __builtin_amdgcn_sched_barrier(0);
        float mx = sc[0][0];
#pragma unroll
        for (int kt = 0; kt < 2; ++kt)
#pragma unroll
            for (int r = 0; r < 16; ++r) mx = fmaxf(mx, sc[kt][r]);
        mx = xhalf_max(mx);
        const float mcand = fmaxf(m, mx * C);
        if (__builtin_amdgcn_ballot_w64(mcand > m + 6.f) != 0ull) {
            const float alpha = __builtin_amdgcn_exp2f(m - mcand);
            m = mcand; lsum *= alpha;
#pragma unroll
            for (int dt = 0; dt < 2; ++dt)
#pragma unroll
                for (int r = 0; r < 16; ++r) o[dt][r] *= alpha;
        }
        float ps0 = 0.f, ps1 = 0.f, ps2 = 0.f, ps3 = 0.f;
#pragma unroll
        for (int kt = 0; kt < 2; ++kt)
#pragma unroll
            for (int r = 0; r < 16; r += 4) {
                sc[kt][r] = __builtin_amdgcn_exp2f(fmaf(sc[kt][r], C, -m)); ps0 += sc[kt][r];
                sc[kt][r + 1] = __builtin_amdgcn_exp2f(fmaf(sc[kt][r + 1], C, -m)); ps1 += sc[kt][r + 1];
                sc[kt][r + 2] = __builtin_amdgcn_exp2f(fmaf(sc[kt][r + 2], C, -m)); ps2 += sc[kt][r + 2];
                sc[kt][r + 3] = __builtin_amdgcn_exp2f(fmaf(sc[kt][r + 3], C, -m)); ps3 += sc[kt][r + 3];
            }
        lsum += (ps0 + ps1) + (ps2 + ps3);
#pragma unroll
        for (int kt = 0; kt < 2; ++kt)
#pragma unroll
            for (int s2 = 0; s2 < 2; ++s2) {
                u32x4 pw = {pk2(sc[kt][8 * s2], sc[kt][8 * s2 + 1]), pk2(sc[kt][8 * s2 + 2], sc[kt][8 * s2 + 3]), pk2(sc[kt][8 * s2 + 4], sc[kt][8 * s2 + 5]), pk2(sc[kt][8 * s2 + 6], sc[kt][8 * s2 + 7])};
                const bf16x8 pf = __builtin_bit_cast(bf16x8, pw);
#pragma unroll
                for (int dt = 0; dt < 2; ++dt) o[dt] = __builtin_amdgcn_mfma_f32_32x32x16_bf16(vfr[kt][s2][dt], pf, o[dt], 0, 0, 0);
            }
        }
        __builtin_amdgcn_sched_barrier(0);
        if (n + 1 < ntile) AT_COMMIT(st ^ 1);
        __syncthreads();
    }
#undef AT_ISSUE
#undef AT_COMMIT
    float l = xhalf_sum(lsum) + __builtin_amdgcn_exp2f(a.sink_l2 - m);
    const float inv = 1.f / l;
    bf16* op = a.out + (a.qrow0 + wave * 32 + l31) * 1024 + 4 * hh;
#pragma unroll
    for (int dt = 0; dt < 2; ++dt)
#pragma unroll
        for (int g = 0; g < 4; ++g) { u32x2 v = {pk2(o[dt][4 * g] * inv, o[dt][4 * g + 1] * inv), pk2(o[dt][4 * g + 2] * inv, o[dt][4 * g + 3] * inv)}; *(u32x2*)(op + dt * 32 + 8 * g) = v; }
}

__device__ __forceinline__ void ph_dense_attn(const Ptrs& P, LAS unsigned char* smem, int bid, int nblk) {
    unsigned char* r3 = P.ws + WS_R3;
    const int vid = xcd_vid(bid, nblk);
    for (int item = vid; item < 1024 + 64; item += nblk) {
        AttnArgs a;
        int bh, qb; bool isctx = item >= 1024;
        if (!isctx) { bh = item >> 5; qb = item & 31; } else { bh = (item - 1024) >> 1; qb = (item - 1024) & 1; }
        const int hq = bh & 7, b = bh >> 3, kv = hq >> 2;
        a.Q = (const bf16*)(r3 + R3_AQ); a.ldq = 512; a.qcol = hq * 64;
        a.qrow0 = isctx ? (size_t)NL + b * CL + qb * 128 : (size_t)b * S + qb * 128;
        a.K = (const bf16*)(r3 + R3_AK) + kv * 64; a.klat0 = (size_t)b * S; a.kctx0 = (size_t)NL + b * CL;
        a.Vt = (const bf16*)(r3 + R3_AV) + (size_t)(b * 2 + kv) * 64 * VT_LD;
        a.nctx = 4; a.tlo = 0; a.nlat = isctx ? 0 : 64; a.banded = 0; a.tq0 = 0; a.sink_l2 = -INFINITY;
        a.out = (bf16*)(P.ws + WS_R2) + 512 + hq * 64;
        attn_block(a, smem);
    }
}
__device__ __forceinline__ void ph_swa_attn(const Ptrs& P, LAS unsigned char* smem, int bid, int nblk) {
    unsigned char* r3 = P.ws + WS_R3;
    const int vid = xcd_vid(bid, nblk);
    for (int item = vid; item < 2048; item += nblk) {
        AttnArgs a;
        const int bh = item >> 5, qb = item & 31, hq = bh & 15, b = bh >> 4, kv = hq >> 3;
        a.Q = (const bf16*)(r3 + R3_OQ); a.ldq = 1024; a.qcol = hq * 64; a.qrow0 = (size_t)b * S + qb * 128;
        a.K = (const bf16*)(r3 + R3_OK) + kv * 64; a.klat0 = (size_t)b * S; a.kctx0 = (size_t)NL + b * CL;
        a.Vt = (const bf16*)(r3 + R3_OV) + (size_t)(b * 2 + kv) * 64 * VT_LD;
        const int tlo = qb * 2 - 2 < 0 ? 0 : qb * 2 - 2, thi = qb * 2 + 3 > 63 ? 63 : qb * 2 + 3;
        a.nctx = 4; a.tlo = tlo; a.nlat = thi - tlo + 1; a.banded = 1; a.tq0 = qb * 128; a.sink_l2 = P.in[17][hq] * 1.4426950408889634f;
        a.out = (bf16*)(P.ws + WS_R2) + hq * 64;
        attn_block(a, smem);
    }
}

constexpr size_t WS_LIST = 247 * MiB;
constexpr size_t WS_WTS = WS_LIST + (size_t)24 * NT * 4;
constexpr size_t WS_END_ALL = WS_WTS + (size_t)NT * 2 * 4;
static_assert(WS_R3 + R3_END <= WS_LIST && WS_END_ALL <= 256 * MiB, "ws map tail");
constexpr int CTL_CNT = 8192;
constexpr int MOE_MAXT = NT / 128 + 24;

constexpr size_t WS_WRT = 250 * MiB, WS_SL = 251 * MiB;
typedef float f32x4v __attribute__((ext_vector_type(4)));
__device__ __forceinline__ void route_tables(const Ptrs& P, int layer, int bid, int nblk) {
    unsigned char* ws = P.ws;
    const float* mvl = (const float*)(ws + WS_MODV) + (size_t)layer * 5 * 6144;
    const float* gain = P.in[7] + layer * D;
    const float* wg = P.in[20] + (size_t)layer * D * 4; const float* bg = P.in[21] + layer * 4;
    const float* we = P.in[22] + (size_t)layer * D * 16; const float* be = P.in[23] + layer * 16;
    bf16* wrt = (bf16*)(ws + WS_WRT);
    for (int e = bid * 256 + threadIdx.x; e < 5 * 32 * 1024; e += nblk * 256) {
        const int k = e & 1023, r = (e >> 10) & 31, br = e >> 15;
        const float a = gain[k] * (1.f + mvl[(size_t)br * 6144 + 4 * 1024 + k]);
        const float w = (r < 16 ? wg[k * 4 + (r & 3)] : we[k * 16 + r - 16]) * a;
        const bf16 hi = f2bf(w); const bf16 lo = f2bf(w - bf2f(hi));
        wrt[((size_t)(br * 2 + 0) * 32 + r) * 1024 + k] = hi; wrt[((size_t)(br * 2 + 1) * 32 + r) * 1024 + k] = lo;
    }
    const int gw = bid * 4 + (threadIdx.x >> 6), lane = threadIdx.x & 63;
    if (gw < 160) {
        const int r = gw & 31, br = gw >> 5; float s = 0.f;
        for (int k = lane; k < 1024; k += 64) s += mvl[(size_t)br * 6144 + 3 * 1024 + k] * (r < 16 ? wg[k * 4 + (r & 3)] : we[k * 16 + r - 16]);
        s = wave_sum(s);
        if (lane == 0) ((float*)(ws + WS_SL))[br * 32 + r] = s + (r < 16 ? bg[r & 3] : be[r - 16]);
    }
}
typedef float f32x4a __attribute__((ext_vector_type(4)));
__device__ __forceinline__ float xq_sum(float x) {
    x += __shfl_xor(x, 16); x += __shfl_xor(x, 32); return x;
}
__device__ __forceinline__ void ph_moe_route(const Ptrs& P, LAS unsigned char* smem, int bid, int nblk, int layer, int nrows) {
    unsigned char* ws = P.ws;
    const int tid = threadIdx.x, lane = tid & 63, wave = tid >> 6, tk = lane & 15, kq = lane >> 4;
    const float* modv_layer = (const float*)(ws + WS_MODV) + (size_t)layer * 5 * 6144;
    const float* gain = P.in[7] + layer * D;
    const bf16* xs = (const bf16*)(ws + WS_R4);
    bf16* H = (bf16*)(ws + WS_R1);
    int* cnt = (int*)(ws + WS_CTL) + CTL_CNT + layer * 2048; int* list = (int*)(ws + WS_LIST); float* wts = (float*)(ws + WS_WTS);
    LAS float* part = (LAS float*)smem;
    for (int task = xcd_vid(bid, nblk); task < nrows / 16; task += nblk) {
        const int row0 = task * 16; const int row = row0 + tk;
        const int br = row0 < NL ? row0 / S : 4;
        const bf16* xr = xs + (size_t)row * D;
        const bf16* wt = (const bf16*)(ws + WS_WRT) + (size_t)br * 2 * 32 * 1024;
        f32x4a acc0 = {0.f, 0.f, 0.f, 0.f}, acc1 = {0.f, 0.f, 0.f, 0.f};
        float ss = 0.f;
#pragma unroll 4
        for (int s = 8 * wave; s < 8 * wave + 8; ++s) {
            const int k = 32 * s + 8 * kq;
            const u32x4 xh = *(const u32x4*)(xr + k);
            { const float f0 = __uint_as_float(xh.x << 16), f1 = __uint_as_float(xh.x & 0xffff0000u), f2 = __uint_as_float(xh.y << 16), f3 = __uint_as_float(xh.y & 0xffff0000u);
              const float f4 = __uint_as_float(xh.z << 16), f5 = __uint_as_float(xh.z & 0xffff0000u), f6 = __uint_as_float(xh.w << 16), f7 = __uint_as_float(xh.w & 0xffff0000u);
              ss += (f0 * f0 + f1 * f1) + (f2 * f2 + f3 * f3) + (f4 * f4 + f5 * f5) + (f6 * f6 + f7 * f7); }
            const bf16x8 bh = __builtin_bit_cast(bf16x8, xh);
            const bf16x8 a0h = *(const bf16x8*)(wt + (size_t)tk * 1024 + k), a1h = *(const bf16x8*)(wt + (size_t)(16 + tk) * 1024 + k);
            const bf16x8 a0l = *(const bf16x8*)(wt + (size_t)(32 + tk) * 1024 + k), a1l = *(const bf16x8*)(wt + (size_t)(48 + tk) * 1024 + k);
            acc0 = __builtin_amdgcn_mfma_f32_16x16x32_bf16(a0h, bh, acc0, 0, 0, 0); acc1 = __builtin_amdgcn_mfma_f32_16x16x32_bf16(a1h, bh, acc1, 0, 0, 0);
            acc0 = __builtin_amdgcn_mfma_f32_16x16x32_bf16(a0l, bh, acc0, 0, 0, 0); acc1 = __builtin_amdgcn_mfma_f32_16x16x32_bf16(a1l, bh, acc1, 0, 0, 0);
        }
#pragma unroll
        for (int j = 0; j < 4; ++j) { part[(wave * 9 + j) * 64 + lane] = acc0[j]; part[(wave * 9 + 4 + j) * 64 + lane] = acc1[j]; }
        part[(wave * 9 + 8) * 64 + lane] = ss;
        __syncthreads();
        float tot[9];
#pragma unroll
        for (int j = 0; j < 9; ++j) tot[j] = (part[j * 64 + lane] + part[(9 + j) * 64 + lane]) + (part[(18 + j) * 64 + lane] + part[(27 + j) * 64 + lane]);
        const float rstd = rsqrtf(xq_sum(tot[8]) * (1.f / D) + EPS);
        if (wave == 0) {
            const float* sl = (const float*)(ws + WS_SL) + br * 32;
            float gl[4], el[4];
#pragma unroll
            for (int j = 0; j < 4; ++j) { gl[j] = tot[j] * rstd + sl[j]; el[j] = tot[4 + j] * rstd + sl[16 + 4 * kq + j]; }
            int gi = 0; float gm = gl[0];
#pragma unroll
            for (int j = 1; j < 4; ++j) if (gl[j] > gm) { gm = gl[j]; gi = j; }
            if (gi == kq) {
                float gs = 0.f;
#pragma unroll
                for (int j = 0; j < 4; ++j) gs += expf(gl[j] - gm);
                const float gwt = 1.f / gs;
                int i0 = 0; float e0 = el[0];
#pragma unroll
                for (int j = 1; j < 4; ++j) if (el[j] > e0) { e0 = el[j]; i0 = j; }
                int i1 = -1; float e1 = -INFINITY;
#pragma unroll
                for (int j = 0; j < 4; ++j) if (j != i0 && el[j] > e1) { e1 = el[j]; i1 = j; }
                const float p1 = expf(e1 - e0); const float w0 = gwt / (1.f + p1), w1 = gwt * p1 / (1.f + p1);
                const int ea = i0 < i1 ? i0 : i1, eb = i0 < i1 ? i1 : i0;
                const int pidx = ea == 0 ? eb - 1 : (ea == 1 ? eb + 1 : 5);
                const int cls = gi * 6 + pidx;
                wts[(size_t)row * 2] = i0 < i1 ? w0 : w1; wts[(size_t)row * 2 + 1] = i0 < i1 ? w1 : w0;
                const int pos = atomicAdd(&cnt[cls * 64], 1);
                list[(size_t)cls * NT + pos] = row;
            }
        }
        const float* mv = modv_layer + (size_t)br * 6144;
        float rs[4];
#pragma unroll
        for (int r = 0; r < 4; ++r) rs[r] = __shfl(rstd, 4 * wave + r);
        u32x2 xv[4][4];
#pragma unroll
        for (int r = 0; r < 4; ++r) {
            const bf16* xp = xs + (size_t)(row0 + 4 * wave + r) * D + 4 * lane;
#pragma unroll
            for (int jq = 0; jq < 4; ++jq) xv[r][jq] = *(const u32x2*)(xp + 256 * jq);
        }
#pragma unroll
        for (int jq = 0; jq < 4; ++jq) {
            const int k = 4 * lane + 256 * jq;
            const f32x4 g = *(const f32x4*)(gain + k), sc = *(const f32x4*)(mv + 4 * 1024 + k), sh = *(const f32x4*)(mv + 3 * 1024 + k);
            const f32x4 a = {g.x * (1.f + sc.x), g.y * (1.f + sc.y), g.z * (1.f + sc.z), g.w * (1.f + sc.w)};
#pragma unroll
            for (int r = 0; r < 4; ++r) {
                const u32x2 xw = xv[r][jq]; const f32x4 x = {__uint_as_float(xw.x << 16), __uint_as_float(xw.x & 0xffff0000u), __uint_as_float(xw.y << 16), __uint_as_float(xw.y & 0xffff0000u)};
                u32x2 o = {pk2(x.x * rs[r] * a.x + sh.x, x.y * rs[r] * a.y + sh.y), pk2(x.z * rs[r] * a.z + sh.z, x.w * rs[r] * a.w + sh.w)};
                *(u32x2*)(H + (size_t)(row0 + 4 * wave + r) * D + k) = o;
            }
        }
        __syncthreads();
    }
}

__device__ __forceinline__ void moe_tiles_init(const int* cnt, LAS int* tile0) {
    __syncthreads();
    if (threadIdx.x < 24) tile0[192 + threadIdx.x] = cnt[threadIdx.x * 64];
    __syncthreads();
    if (threadIdx.x == 0) { int a = 0; for (int c = 0; c < 24; ++c) { tile0[c] = a; a += (tile0[192 + c] + 127) >> 7; } tile0[24] = a; }
    __syncthreads();
}
struct GatherRows {
    const bf16* H; const int* lst; int n; const bf16* p[4];
    __device__ __forceinline__ void init(int r0) {
#pragma unroll
        for (int i = 0; i < 4; ++i) { const int r = r0 + 8 * i; p[i] = H + (size_t)lst[r < n ? r : 0] * D; }
    }
    __device__ __forceinline__ const bf16* ptr(int i, int kt) const { return p[i] + kt * 64; }
};
struct SplitKRows {
    const bf16* b0; const bf16* b1; size_t ld; int ksplit; const bf16* p0; const bf16* p1;
    __device__ __forceinline__ SplitKRows(const bf16* b0_, const bf16* b1_, size_t ld_, int ksplit_) : b0(b0_), b1(b1_), ld(ld_), ksplit(ksplit_), p0(b0_), p1(b1_) {}
    __device__ __forceinline__ void init(int r0) { p0 = b0 + (size_t)r0 * ld; p1 = b1 + (size_t)r0 * ld; }
    __device__ __forceinline__ const bf16* ptr(int i, int kt) const { return (kt < ksplit ? p0 + kt * 64 : p1 + (kt - ksplit) * 64) + (size_t)i * 8 * ld; }
};
struct EpiMoe1 {
    typedef NoPre Pre;
    __device__ __forceinline__ void prefetch(Pre&, int, int, int, int) const {}
    bf16* hid; const int* lst; int n; const float* wts; int nt;
    __device__ __forceinline__ bool swapped() const { return false; }
    __device__ __forceinline__ void operator()(f32x16 (&acc)[2][2], int fb, int tb, int l31, int hh, LAS unsigned char* wl, const Pre& pre) const {
        const int col = (nt >> 2) * 256 + 32 * (2 * (nt & 3) + (fb >> 6));
#pragma unroll 1
        for (int j = 0; j < 2; ++j) {
            const int r = tb + j * 32 + l31;
            const int tok = lst[r < n ? r : 0];
            const float w = wts[(size_t)tok * 2 + (nt >> 2)];
#pragma unroll
            for (int g = 0; g < 4; ++g) {
                float hv[4];
#pragma unroll
                for (int e = 0; e < 4; ++e) { const float a_ = j ? acc[0][1][4 * g + e] : acc[0][0][4 * g + e], u_ = j ? acc[1][1][4 * g + e] : acc[1][0][4 * g + e]; hv[e] = a_ / (1.f + __expf(-a_)) * u_ * w; }
                u32x2 v = {pk2(hv[0], hv[1]), pk2(hv[2], hv[3])}; *(LAS u32x2*)(wl + (32 * j + l31) * 80 + (8 * g + 4 * hh) * 2) = v;
            }
        }
        const int lane = l31 + 32 * hh, rr = lane >> 2, ch = lane & 3;
#pragma unroll
        for (int q = 0; q < 4; ++q) { const int R = 16 * q + rr; const u32x4 v = *(LAS u32x4*)(wl + R * 80 + ch * 16); *(u32x4*)(hid + (size_t)(tb + R) * 512 + col + ch * 8) = v; }
    }
};
__device__ __forceinline__ void ph_moe_stage1(const Ptrs& P, LAS unsigned char* smem, int bid, int nblk, int layer) {
    unsigned char* ws = P.ws;
    const int* cnt = (const int*)(ws + WS_CTL) + CTL_CNT + layer * 2048; const int* list = (const int*)(ws + WS_LIST);
    LAS int* tile0 = (LAS int*)(smem + GEMM_LDS);
    moe_tiles_init(cnt, tile0);
    const int lrow = threadIdx.x >> 3, kc = threadIdx.x & 7;
    const bf16* H = (const bf16*)(ws + WS_R1);
    const int nitems = tile0[24] * 8;
    for (int item = xcd_vid(bid, nblk); item < nitems; item += nblk) {
        const int tt = item >> 3, nt = item & 7;
        int c = 0; while (tile0[c + 1] <= tt) ++c;
        const int lt = tt - tile0[c], n = min(128, tile0[192 + c] - lt * 128);
        const int* lst = list + (size_t)c * NT + lt * 128;
        const int g = c / 6, pidx = c % 6; const int ea = pidx < 3 ? 0 : (pidx < 5 ? 1 : 2), eb = pidx < 3 ? pidx + 1 : (pidx < 5 ? pidx - 1 : 3);
        const int expert = g * 4 + (nt < 4 ? ea : eb);
        GatherRows af{H, lst, n, {nullptr, nullptr, nullptr, nullptr}};
        AffineRows bf_((const bf16*)(ws + WS_WGU) + ((size_t)(layer * 16 + expert) * 512 + (nt & 3) * 128) * D, D);
        EpiMoe1 epi{(bf16*)(ws + WS_R3) + (size_t)tt * 128 * 512, lst, n, (const float*)(ws + WS_WTS), nt};
        gemm_tile<false>(af, bf_, D / 64, smem, epi);
    }
}
template <int LAYER>
struct EpiMoe2 {
    typedef RmwPre<true> Pre;
    bf16* xs; float* out; const float* modv_layer; LAS const int* lst; int n; int nt;
    __device__ __forceinline__ bool swapped() const { return false; }
    __device__ __forceinline__ auto rowfn(int fb, int tb) const {
        const int c0 = nt * 128 + fb; const EpiMoe2 e = *this;
        return [=](int R, const void*& sp, void*& dp, const float*& gp) {
            const int r = tb + R; if (r >= e.n) return false;
            const int tok = e.lst[r];
            sp = e.xs + (size_t)tok * D + c0;
            if (LAYER == 0) dp = e.xs + (size_t)tok * D + c0; else dp = e.out + (size_t)tok * D + c0;
            gp = e.modv_layer + (size_t)(tok < NL ? tok / S : 4) * 6144 + 5 * 1024 + c0; return true; };
    }
    __device__ __forceinline__ void prefetch(Pre& pre, int fb, int tb, int l31, int hh) const { rmw_prefetch<true>(pre, rowfn(fb, tb), l31, hh); }
    __device__ __forceinline__ void operator()(f32x16 (&acc)[2][2], int fb, int tb, int l31, int hh, LAS unsigned char* wl, const Pre& pre) const {
        rmw_finish<true, LAYER == 0>(acc, pre, rowfn(fb, tb), l31, hh, wl);
    }
};
__device__ __forceinline__ void ph_moe_stage2(const Ptrs& P, LAS unsigned char* smem, int bid, int nblk, int layer) {
    unsigned char* ws = P.ws;
    const int* cnt = (const int*)(ws + WS_CTL) + CTL_CNT + layer * 2048; const int* list = (const int*)(ws + WS_LIST);
    LAS int* tile0 = (LAS int*)(smem + GEMM_LDS);
    moe_tiles_init(cnt, tile0);
    const int lrow = threadIdx.x >> 3, kc = threadIdx.x & 7;
    const int nitems = tile0[24] * 8;
    for (int item = xcd_vid(bid, nblk); item < nitems; item += nblk) {
        const int tt = item >> 3, nt = item & 7;
        int c = 0; while (tile0[c + 1] <= tt) ++c;
        const int lt = tt - tile0[c], n = min(128, tile0[192 + c] - lt * 128);
        const int* lst = list + (size_t)c * NT + lt * 128;
        const int g = c / 6, pidx = c % 6; const int ea = pidx < 3 ? 0 : (pidx < 5 ? 1 : 2), eb = pidx < 3 ? pidx + 1 : (pidx < 5 ? pidx - 1 : 3);
        AffineRows af((const bf16*)(ws + WS_R3) + (size_t)tt * 128 * 512, 512);
        const bf16* wd = (const bf16*)(ws + WS_WD);
        SplitKRows bf_(wd + ((size_t)(layer * 16 + g * 4 + ea) * 1024 + nt * 128) * 256, wd + ((size_t)(layer * 16 + g * 4 + eb) * 1024 + nt * 128) * 256, 256, 4);
        LAS int* toks = (LAS int*)(smem + GEMM_LDS + 256);
        __syncthreads();
        if (threadIdx.x < 128) toks[threadIdx.x] = lst[threadIdx.x < n ? threadIdx.x : 0];
        if (layer == 0) { EpiMoe2<0> epi{(bf16*)(ws + WS_R4), P.out, (const float*)(ws + WS_MODV), toks, n, nt}; gemm_tile<false>(af, bf_, 8, smem, epi); }
        else { EpiMoe2<1> epi{(bf16*)(ws + WS_R4), P.out, (const float*)(ws + WS_MODV) + (size_t)5 * 6144, toks, n, nt}; gemm_tile<false>(af, bf_, 8, smem, epi); }
    }
}

constexpr size_t GLA_ST = 8192;
constexpr size_t WS_DEC = WS_WTS + (size_t)NT * 2 * 4;
static_assert(WS_DEC + (size_t)32 * 68 * 64 * 4 <= 256 * MiB, "ws dec");
__device__ __forceinline__ void gla_chunk_geom(int b, int M, size_t& row0, int& vcol0, int& c0, int& c1) {
    if (M < 4) { row0 = (size_t)NL + b * CL + 64 * M; vcol0 = S + 64 * M; c0 = M; c1 = 3 - M; }
    else { const int Ml = M - 4; row0 = (size_t)b * S + 64 * Ml; vcol0 = 64 * Ml; c0 = 4 + Ml; c1 = 4 + 63 - Ml; }
}
template <bool PASS_C>
__device__ __forceinline__ float gla_prep(const float (&gw)[16], float gb, int dir, LAS unsigned char* out, LAS const unsigned char* qraw, LAS const unsigned char* kraw, LAS const float* lrs, LAS float* tot) {
    const int tid = threadIdx.x, k = tid & 63, grp = tid >> 6;
    float gl[16];
#pragma unroll
    for (int j = 0; j < 16; ++j) {
        const int p = 16 * grp + j; float z = gb;
#pragma unroll
        for (int r4 = 0; r4 < 4; ++r4) { const f32x4 l4 = *(LAS const f32x4*)(lrs + p * 16 + r4 * 4); z += l4.x * gw[4 * r4] + l4.y * gw[4 * r4 + 1] + l4.z * gw[4 * r4 + 2] + l4.w * gw[4 * r4 + 3]; }
        gl[j] = (fminf(z, 0.f) - __logf(1.f + __expf(-fabsf(z)))) * (1.f / 16.f);
    }
    if (dir == 0) {
#pragma unroll
        for (int j = 1; j < 16; ++j) gl[j] += gl[j - 1];
        tot[grp * 64 + k] = gl[15];
    } else {
#pragma unroll
        for (int j = 14; j >= 0; --j) gl[j] += gl[j + 1];
        tot[grp * 64 + k] = gl[0];
    }
    __syncthreads();
    const float t0 = tot[k], t1 = tot[64 + k], t2 = tot[128 + k], t3 = tot[192 + k];
    const float bend = t0 + t1 + t2 + t3;
    float offs;
    if (dir == 0) offs = grp == 0 ? 0.f : grp == 1 ? t0 : grp == 2 ? t0 + t1 : t0 + t1 + t2;
    else offs = grp == 3 ? 0.f : grp == 2 ? t3 : grp == 1 ? t3 + t2 : t3 + t2 + t1;
    if (PASS_C) {
#pragma unroll
        for (int j = 0; j < 16; ++j) {
            const int p = 16 * grp + j; const float bp = gl[j] + offs;
            const float q = bf2f(*(LAS const bf16*)(qraw + p * 128 + k * 2)) * 0.125f, kk = bf2f(*(LAS const bf16*)(kraw + p * 128 + k * 2));
            *(LAS bf16*)(out + p * 144 + k * 2) = f2bf(q * __expf(bp));
            *(LAS bf16*)(out + 9216 + p * 144 + k * 2) = f2bf(q * __expf(bp - bend));
            *(LAS bf16*)(out + 18432 + p * 144 + k * 2) = f2bf(kk * __expf(bend - bp));
        }
    } else {
        float kt[16];
#pragma unroll
        for (int j = 0; j < 16; ++j) { const int p = 16 * grp + j; const float bp = gl[j] + offs; kt[j] = bf2f(*(LAS const bf16*)(kraw + p * 128 + k * 2)) * __expf(bend - bp); }
        u32x4 w0 = {pk2(kt[0], kt[1]), pk2(kt[2], kt[3]), pk2(kt[4], kt[5]), pk2(kt[6], kt[7])}, w1 = {pk2(kt[8], kt[9]), pk2(kt[10], kt[11]), pk2(kt[12], kt[13]), pk2(kt[14], kt[15])};
        *(LAS u32x4*)(out + k * 144 + grp * 32) = w0; *(LAS u32x4*)(out + k * 144 + grp * 32 + 16) = w1;
    }
    return __expf(bend);
}
#define GLA_LOAD_GW(gw, gb, dir, h) do { _Pragma("unroll") for (int r_ = 0; r_ < 16; ++r_) gw[r_] = P.in[10][((dir) * 16 + r_) * 256 + (h) * 64 + (threadIdx.x & 63)]; gb = P.in[11][(dir) * 256 + (h) * 64 + (threadIdx.x & 63)]; } while (0)

constexpr int GA_KTT = 0, GA_VT = 9216, GA_KRAW = GA_VT + 128 * 144, GA_LRS = GA_KRAW + 8192, GA_TOT = GA_LRS + 4096, GLA_A_LDS = GA_TOT + 1024;
__device__ __forceinline__ void gla_pass_a_item(const Ptrs& P, int item, LAS unsigned char* lds) {
    const int tid = threadIdx.x, lane = tid & 63, wave = tid >> 6, l31 = lane & 31, hh = lane >> 5;
    const int M = item % 68, dir = (item / 68) & 1, h = (item / 136) & 3, b = item / 544;
    size_t row0; int vcol0, c0, c1; gla_chunk_geom(b, M, row0, vcol0, c0, c1);
    const int sidx = ((b * 4 + h) * 2 + dir) * 68 + (dir ? c1 : c0);
    const unsigned char* r3 = P.ws + WS_R3;
    u32x4 vt[4], kr[2]; f32x4 lr; float gw[16], gb;
    { const bf16* gvt = (const bf16*)(r3 + R3_GV) + (size_t)(b * 4 + h) * 128 * VT_LD + vcol0;
#pragma unroll
      for (int i = 0; i < 4; ++i) { const int c = tid + 256 * i; vt[i] = *(const u32x4*)(gvt + (size_t)(c >> 3) * VT_LD + (c & 7) * 8); }
      const bf16* gk = (const bf16*)(r3 + R3_GK) + row0 * 256 + h * 64;
#pragma unroll
      for (int i = 0; i < 2; ++i) { const int c = tid + 256 * i; kr[i] = *(const u32x4*)(gk + (size_t)(c >> 3) * 256 + (c & 7) * 8); }
      lr = *(const f32x4*)((const float*)(r3 + R3_LR) + (row0 + (tid >> 2)) * 32 + dir * 16 + (tid & 3) * 4);
      GLA_LOAD_GW(gw, gb, dir, h); }
#pragma unroll
    for (int i = 0; i < 4; ++i) { const int c = tid + 256 * i; *(LAS u32x4*)(lds + GA_VT + (c >> 3) * 144 + (c & 7) * 16) = vt[i]; }
#pragma unroll
    for (int i = 0; i < 2; ++i) { const int c = tid + 256 * i; *(LAS u32x4*)(lds + GA_KRAW + (c >> 3) * 128 + (c & 7) * 16) = kr[i]; }
    *(LAS f32x4*)(lds + GA_LRS + tid * 16) = lr;
    __syncthreads();
    const float dec = gla_prep<false>(gw, gb, dir, lds + GA_KTT, lds + GA_KRAW, lds + GA_KRAW, (LAS const float*)(lds + GA_LRS), (LAS float*)(lds + GA_TOT));
    if (tid < 64) ((float*)(P.ws + WS_DEC))[(size_t)sidx * 64 + tid] = dec;
    __syncthreads();
    f32x16 acc[2];
#pragma unroll
    for (int kt = 0; kt < 2; ++kt)
#pragma unroll
        for (int r = 0; r < 16; ++r) acc[kt][r] = 0.f;
#pragma unroll
    for (int ps = 0; ps < 4; ++ps) {
        const bf16x8 vf = *(LAS bf16x8*)(lds + GA_VT + (32 * wave + l31) * 144 + ps * 32 + hh * 16);
#pragma unroll
        for (int kt = 0; kt < 2; ++kt) { const bf16x8 kf = *(LAS bf16x8*)(lds + GA_KTT + (32 * kt + l31) * 144 + ps * 32 + hh * 16); acc[kt] = __builtin_amdgcn_mfma_f32_32x32x16_bf16(kf, vf, acc[kt], 0, 0, 0); }
    }
    bf16* ds = (bf16*)(P.ws + WS_R1) + (size_t)sidx * GLA_ST + (size_t)(32 * wave + l31) * 64 + 4 * hh;
#pragma unroll
    for (int kt = 0; kt < 2; ++kt)
#pragma unroll
        for (int g = 0; g < 4; ++g) { u32x2 v = {pk2(acc[kt][4 * g], acc[kt][4 * g + 1]), pk2(acc[kt][4 * g + 2], acc[kt][4 * g + 3])}; *(u32x2*)(ds + kt * 32 + 8 * g) = v; }
    __syncthreads();
}
__device__ __forceinline__ void ph_gla_a(const Ptrs& P, LAS unsigned char* smem, int bid, int nblk) {
    for (int item = bid; item < 4 * 4 * 2 * 68; item += nblk) gla_pass_a_item(P, item, smem);
}
__device__ __forceinline__ void gla_pass_b(const Ptrs& P, int gtid, int nthreads) {
    const bf16* DS = (const bf16*)(P.ws + WS_R1); bf16* SIN = (bf16*)(P.ws + WS_R4); const float* DEC = (const float*)(P.ws + WS_DEC);
    for (int idx = gtid; idx < 32 * 2048; idx += nthreads) {
        const int bhd = idx >> 11, e4 = idx & 2047, k4 = (e4 & 15) * 4;
        float s0 = 0.f, s1 = 0.f, s2 = 0.f, s3 = 0.f;
#pragma unroll 17
        for (int c = 0; c < 68; ++c) {
            const size_t sidx = (size_t)bhd * 68 + c;
            u32x2 o = {pk2(s0, s1), pk2(s2, s3)};
            *(u32x2*)(SIN + sidx * GLA_ST + e4 * 4) = o;
            const f32x4 d = *(const f32x4*)(DEC + sidx * 64 + k4);
            const u32x2 w = *(const u32x2*)(DS + sidx * GLA_ST + e4 * 4);
            s0 = s0 * d.x + __uint_as_float(w.x << 16); s1 = s1 * d.y + __uint_as_float(w.x & 0xffff0000u);
            s2 = s2 * d.z + __uint_as_float(w.y << 16); s3 = s3 * d.w + __uint_as_float(w.y & 0xffff0000u);
        }
    }
}

constexpr int GC_QT = 0, GC_QA = 9216, GC_KT = 18432, GC_VT = 27648, GC_QRAW = GC_VT + 128 * 136, GC_KRAW = GC_QRAW + 8192, GC_LRS = GC_KRAW + 8192, GC_TOT = GEMM_LDS + 256, GC_XCH = GC_TOT + 1024;
static_assert(GC_LRS + 4096 <= GEMM_LDS, "gla c lds");
__device__ __forceinline__ void gla_pass_c_item(const Ptrs& P, int item, LAS unsigned char* lds) {
    const int tid = threadIdx.x, lane = tid & 63, wave = tid >> 6, l31 = lane & 31, hh = lane >> 5, pt = wave & 1, vh = wave >> 1;
    const int M = item % 68, h = (item / 68) & 3, b = item / 272;
    size_t row0; int vcol0, c0, c1; gla_chunk_geom(b, M, row0, vcol0, c0, c1);
    const unsigned char* r3 = P.ws + WS_R3;
    u32x4 vt[4], qr[2], kr[2]; f32x4 lr0, lr1; float gw[16], gb;
    { const bf16* gvt = (const bf16*)(r3 + R3_GV) + (size_t)(b * 4 + h) * 128 * VT_LD + vcol0;
#pragma unroll
      for (int i = 0; i < 4; ++i) { const int c = tid + 256 * i; vt[i] = *(const u32x4*)(gvt + (size_t)(c >> 3) * VT_LD + (c & 7) * 8); }
      const bf16* gq = (const bf16*)(r3 + R3_GQ) + row0 * 256 + h * 64; const bf16* gk = (const bf16*)(r3 + R3_GK) + row0 * 256 + h * 64;
#pragma unroll
      for (int i = 0; i < 2; ++i) { const int c = tid + 256 * i; qr[i] = *(const u32x4*)(gq + (size_t)(c >> 3) * 256 + (c & 7) * 8); kr[i] = *(const u32x4*)(gk + (size_t)(c >> 3) * 256 + (c & 7) * 8); }
      const float* lrp = (const float*)(r3 + R3_LR) + (row0 + (tid >> 2)) * 32 + (tid & 3) * 4;
      lr0 = *(const f32x4*)lrp; lr1 = *(const f32x4*)(lrp + 16);
      GLA_LOAD_GW(gw, gb, 0, h); }
#pragma unroll
    for (int i = 0; i < 4; ++i) { const int c = tid + 256 * i; LAS unsigned char* vp = lds + GC_VT + (c >> 3) * 136 + (c & 7) * 16; u32x2 lo = {vt[i].x, vt[i].y}, hi = {vt[i].z, vt[i].w}; *(LAS u32x2*)vp = lo; *(LAS u32x2*)(vp + 8) = hi; }
#pragma unroll
    for (int i = 0; i < 2; ++i) { const int c = tid + 256 * i; *(LAS u32x4*)(lds + GC_QRAW + (c >> 3) * 128 + (c & 7) * 16) = qr[i]; *(LAS u32x4*)(lds + GC_KRAW + (c >> 3) * 128 + (c & 7) * 16) = kr[i]; }
    *(LAS f32x4*)(lds + GC_LRS + tid * 16) = lr0;
    f32x16 o[2];
#pragma unroll
    for (int i = 0; i < 2; ++i)
#pragma unroll
        for (int r = 0; r < 16; ++r) o[i][r] = 0.f;
    const bf16* SIN = (const bf16*)(P.ws + WS_R4);
    __syncthreads();
#pragma unroll 1
    for (int dir = 0; dir < 2; ++dir) {
        const int sidx = ((b * 4 + h) * 2 + dir) * 68 + (dir ? c1 : c0);
        (void)gla_prep<true>(gw, gb, dir, lds + GC_QT, lds + GC_QRAW, lds + GC_KRAW, (LAS const float*)(lds + GC_LRS), (LAS float*)(lds + GC_TOT));
        bf16x8 sf[2][4];
#pragma unroll
        for (int i = 0; i < 2; ++i)
#pragma unroll
            for (int ks = 0; ks < 4; ++ks) sf[i][ks] = *(const bf16x8*)(SIN + (size_t)sidx * GLA_ST + (size_t)(64 * vh + 32 * i + l31) * 64 + 16 * ks + 8 * hh);
        if (dir == 0) { *(LAS f32x4*)(lds + GC_LRS + tid * 16) = lr1; GLA_LOAD_GW(gw, gb, 1, h); }
        __syncthreads();
        f32x16 at[2];
#pragma unroll
        for (int st = 0; st < 2; ++st) {
#pragma unroll
            for (int r = 0; r < 16; ++r) at[st][r] = 0.f;
#pragma unroll
            for (int ks = 0; ks < 4; ++ks) {
                const bf16x8 ka = *(LAS bf16x8*)(lds + GC_KT + (32 * st + l31) * 144 + ks * 32 + hh * 16);
                const bf16x8 qa = *(LAS bf16x8*)(lds + GC_QA + (32 * pt + l31) * 144 + ks * 32 + hh * 16);
                at[st] = __builtin_amdgcn_mfma_f32_32x32x16_bf16(ka, qa, at[st], 0, 0, 0);
            }
            const int pq = 32 * pt + l31;
#pragma unroll
            for (int r = 0; r < 16; ++r) { const int s_ = 32 * st + (r & 3) + 8 * (r >> 2) + 4 * hh; const bool ok = dir ? (s_ >= pq) : (s_ <= pq); if (!ok) at[st][r] = 0.f; }
        }
#pragma unroll
        for (int ks = 0; ks < 4; ++ks) {
            const bf16x8 qt = *(LAS bf16x8*)(lds + GC_QT + (32 * pt + l31) * 144 + ks * 32 + hh * 16);
#pragma unroll
            for (int i = 0; i < 2; ++i) o[i] = __builtin_amdgcn_mfma_f32_32x32x16_bf16(sf[i][ks], qt, o[i], 0, 0, 0);
        }
#pragma unroll
        for (int st = 0; st < 2; ++st)
#pragma unroll
            for (int s2 = 0; s2 < 2; ++s2) {
                u32x4 pw = {pk2(at[st][8 * s2], at[st][8 * s2 + 1]), pk2(at[st][8 * s2 + 2], at[st][8 * s2 + 3]), pk2(at[st][8 * s2 + 4], at[st][8 * s2 + 5]), pk2(at[st][8 * s2 + 6], at[st][8 * s2 + 7])};
                const bf16x8 pf = __builtin_bit_cast(bf16x8, pw);
#pragma unroll
                for (int i = 0; i < 2; ++i) {
                    LAS unsigned char* vp = lds + GC_VT + (64 * vh + 32 * i + l31) * 136 + (32 * st + 16 * s2 + 4 * hh) * 2;
                    const u32x2 v0 = *(LAS u32x2*)vp, v1 = *(LAS u32x2*)(vp + 16);
                    u32x4 vw = {v0.x, v0.y, v1.x, v1.y};
                    o[i] = __builtin_amdgcn_mfma_f32_32x32x16_bf16(__builtin_bit_cast(bf16x8, vw), pf, o[i], 0, 0, 0);
                }
            }
        __syncthreads();
    }
    float ss = 0.f;
#pragma unroll
    for (int i = 0; i < 2; ++i)
#pragma unroll
        for (int r = 0; r < 16; ++r) ss += o[i][r] * o[i][r];
    ss = xhalf_sum(ss);
    LAS float* xch = (LAS float*)(lds + GC_XCH);
    if (hh == 0) xch[(pt * 2 + vh) * 32 + l31] = ss;
    __syncthreads();
    ss += xch[(pt * 2 + (1 - vh)) * 32 + l31];
    const float rstd = rsqrtf(ss * (1.f / 128.f) + EPS);
    const size_t trow = row0 + 32 * pt + l31;
    const bf16* gr = (const bf16*)(P.ws + WS_R3 + R3_GR) + trow * 512 + h * 128 + 64 * vh + 4 * hh;
    bf16* mx = (bf16*)(P.ws + WS_R2) + trow * 1024 + h * 128 + 64 * vh + 4 * hh;
    const float* gn = P.in[12] + 64 * vh + 4 * hh;
#pragma unroll
    for (int i = 0; i < 2; ++i)
#pragma unroll
        for (int g = 0; g < 4; ++g) {
            const u32x2 rw = *(const u32x2*)(gr + i * 32 + 8 * g); const f32x4 gg = *(const f32x4*)(gn + i * 32 + 8 * g);
            const float r0 = __uint_as_float(rw.x << 16), r1 = __uint_as_float(rw.x & 0xffff0000u), r2 = __uint_as_float(rw.y << 16), r3_ = __uint_as_float(rw.y & 0xffff0000u);
            const float y0 = o[i][4 * g] * rstd * gg.x * (r0 / (1.f + __expf(-r0))), y1 = o[i][4 * g + 1] * rstd * gg.y * (r1 / (1.f + __expf(-r1)));
            const float y2 = o[i][4 * g + 2] * rstd * gg.z * (r2 / (1.f + __expf(-r2))), y3 = o[i][4 * g + 3] * rstd * gg.w * (r3_ / (1.f + __expf(-r3_)));
            u32x2 v = {pk2(y0, y1), pk2(y2, y3)}; *(u32x2*)(mx + i * 32 + 8 * g) = v;
        }
    __syncthreads();
}
__device__ __forceinline__ void ph_gla_c(const Ptrs& P, LAS unsigned char* smem, int bid, int nblk) {
    for (int item = bid; item < 4 * 4 * 68; item += nblk) gla_pass_c_item(P, item, smem);
}

#define XB_TMO      128
#define XB_XCNT(j)  (256  + 64 * (j))
#define XB_XSUB(j)  (1280 + 64 * (j))
#define XB_XGEN(j)  (2304 + 64 * (j))
#define XB_TOP      3328
#define XB_TOPGEN   3392
#define XB_SPIN_CAP (1u << 20)
constexpr int CTL_BAR = 4096;
__device__ __forceinline__ unsigned xb_ld(unsigned* p) { return __hip_atomic_load(p, __ATOMIC_RELAXED, __HIP_MEMORY_SCOPE_AGENT); }
__device__ __forceinline__ unsigned xb_add(unsigned* p, unsigned v) { return __hip_atomic_fetch_add(p, v, __ATOMIC_RELAXED, __HIP_MEMORY_SCOPE_AGENT); }
__device__ __forceinline__ unsigned xb_xcc_id() { return (unsigned)__builtin_amdgcn_s_getreg((3 << 11) | 20) & 0xFu; }
#define XB_SPIN(cond, bar) do { unsigned _sp = 0; while (cond) { __builtin_amdgcn_s_sleep(1); \
    if ((++_sp & 255u) == 0u) { if (xb_ld(&(bar)[XB_TMO])) break; if (_sp > XB_SPIN_CAP) { atomicAdd(&(bar)[XB_TMO], 1u); break; } } } } while (0)
struct XcdBarrier { unsigned* bar; unsigned x; volatile LAS unsigned* st; };
__device__ __forceinline__ XcdBarrier xcd_barrier_post(unsigned* bar, volatile LAS unsigned* st) {
    XcdBarrier b; b.bar = bar; b.x = xb_xcc_id(); b.st = st;
    if (threadIdx.x == 0) (void)xb_add(&bar[XB_XCNT(b.x)], 1u);
    return b;
}
__device__ __forceinline__ void xcd_barrier_complete(unsigned* bar, unsigned x, unsigned& nloc, unsigned& nx) {
    const unsigned G = gridDim.x * gridDim.y * gridDim.z;
    unsigned sum, cnt, mine, sp = 0u;
    for (;;) {
        sum = 0u; cnt = 0u; mine = 0u;
#pragma unroll
        for (unsigned j = 0; j < 16; ++j) { const unsigned c = xb_ld(&bar[XB_XCNT(j)]); sum += c; cnt += (c > 0u) ? 1u : 0u; mine = (j == x) ? c : mine; }
        if (sum == G) break;
        __builtin_amdgcn_s_sleep(1);
        if ((++sp & 255u) == 0u) { if (xb_ld(&bar[XB_TMO])) break; if (sp > XB_SPIN_CAP) { atomicAdd(&bar[XB_TMO], 1u); break; } }
    }
    nloc = mine > 0u ? mine : 1u; nx = cnt > 0u ? cnt : 1u;
}
__device__ __forceinline__ void xcd_barrier(const XcdBarrier& b) {
    asm volatile("s_waitcnt vmcnt(0)" ::: "memory");
    __syncthreads();
    if (threadIdx.x == 0) {
        unsigned* bar = b.bar;
        __builtin_amdgcn_s_waitcnt(0);
        unsigned nloc = b.st[0], nx = b.st[1];
        if (nloc == 0u) { xcd_barrier_complete(bar, b.x, nloc, nx); b.st[0] = nloc; b.st[1] = nx; }
        const unsigned old = xb_add(&bar[XB_XSUB(b.x)], 1u);
        const unsigned gen = old / nloc;
        if (old + 1u == (gen + 1u) * nloc) {
            __builtin_amdgcn_fence(__ATOMIC_RELEASE, "agent");
            asm volatile("s_waitcnt vmcnt(0)" ::: "memory");
            const unsigned og = xb_add(&bar[XB_TOP], 1u);
            const unsigned tg = og / nx;
            if (og + 1u == (tg + 1u) * nx) xb_add(&bar[XB_TOPGEN], 1u);
            else XB_SPIN(xb_ld(&bar[XB_TOPGEN]) == tg, bar);
            __builtin_amdgcn_fence(__ATOMIC_ACQUIRE, "agent");
            xb_add(&bar[XB_XGEN(b.x)], 1u);
            asm volatile("s_waitcnt vmcnt(0)" ::: "memory");
        } else {
            XB_SPIN(xb_ld(&bar[XB_XGEN(b.x)]) == gen, bar);
            __builtin_amdgcn_fence(__ATOMIC_ACQUIRE, "agent");
            asm volatile("s_waitcnt vmcnt(0)" ::: "memory");
        }
    }
    __syncthreads();
}

constexpr int N_PHASES = 18;
constexpr int SMEM_BYTES = GEMM_LDS + 2048;
struct Args { Ptrs P; int ph_lo, ph_hi; };
__global__ void __launch_bounds__(256, 2) fwd_megakernel(Args args) {
    __shared__ __attribute__((aligned(16))) unsigned char smem_raw[SMEM_BYTES];
    LAS unsigned char* smem = (LAS unsigned char*)smem_raw;
    const Ptrs& P = args.P;
    const int bid = blockIdx.x, nblk = gridDim.x;
    volatile LAS unsigned* bst = (volatile LAS unsigned*)(smem + GEMM_LDS + 128);
    if (threadIdx.x < 2) bst[threadIdx.x] = 0u;
    __syncthreads();
    XcdBarrier bar; bar.bar = (unsigned*)(P.ws + WS_CTL) + CTL_BAR; bar.x = 0; bar.st = bst;
    const bool multi = args.ph_hi - args.ph_lo > 1;
    if (multi) bar = xcd_barrier_post((unsigned*)(P.ws + WS_CTL) + CTL_BAR, bst);
    const int lo = args.ph_lo, hi = args.ph_hi;
#define PHASE(k, call) if (lo <= (k) && (k) < hi) { if ((k) > lo) xcd_barrier(bar); call; }
    PHASE(0, ph_prologue(P, smem, bid, nblk))
    PHASE(1, ph_modulate(P, 0, bid, nblk))
    PHASE(2, ph_even_inproj(P, smem, bid, nblk))
    PHASE(3, ph_gla_a(P, smem, bid, nblk))
    PHASE(4, gla_pass_b(P, bid * 256 + threadIdx.x, nblk * 256))
    PHASE(5, (ph_dense_attn(P, smem, bid, nblk), __syncthreads(), ph_gla_c(P, smem, (bid + nblk - 128) % nblk, nblk)))
    PHASE(7, ph_outproj(P, smem, bid, nblk, 0, NT))
    PHASE(8, ph_moe_route(P, smem, bid, nblk, 0, NT))
    PHASE(9, ph_moe_stage1(P, smem, bid, nblk, 0))
    PHASE(10, ph_moe_stage2(P, smem, bid, nblk, 0))
    PHASE(11, ph_modulate(P, 1, bid, nblk))
    PHASE(12, ph_odd_inproj(P, smem, bid, nblk))
    PHASE(13, ph_swa_attn(P, smem, bid, nblk))
    PHASE(14, ph_outproj(P, smem, bid, nblk, 1, NL))
    PHASE(15, ph_moe_route(P, smem, bid, nblk, 1, NL))
    PHASE(16, ph_moe_stage1(P, smem, bid, nblk, 1))
    PHASE(17, ph_moe_stage2(P, smem, bid, nblk, 1))
#undef PHASE
}

#ifndef MK_LAUNCHES
#define MK_LAUNCHES 1
#endif
extern "C" void kernel_launch(void* const* d_in, const int* in_sizes, int n_in, void* d_out, int out_size, void* d_ws, size_t ws_size, hipStream_t stream) {
    static int grid = 0;
    if (grid == 0) {
        int dev = 0, cus = 0, per_cu = 0;
        hipGetDevice(&dev);
        hipDeviceGetAttribute(&cus, hipDeviceAttributeMultiprocessorCount, dev);
        hipOccupancyMaxActiveBlocksPerMultiprocessor(&per_cu, (const void*)fwd_megakernel, 256, 0);
        if (per_cu > 2) per_cu = 2;
        if (per_cu < 1) per_cu = 1;
        grid = cus * per_cu;
    }
    hipMemsetAsync((unsigned char*)d_ws + WS_CTL, 0, 65536, stream);
    Args a{};
    for (int i = 0; i < 27; ++i) a.P.in[i] = (const float*)d_in[i];
    a.P.out = (float*)d_out; a.P.ws = (unsigned char*)d_ws;
#if MK_LAUNCHES == 1
    a.ph_lo = 0; a.ph_hi = N_PHASES;
    void* kargs[] = {&a};
    hipLaunchCooperativeKernel((const void*)fwd_megakernel, dim3(grid), dim3(256), kargs, 0, stream);
#else
    for (int ph = 0; ph < N_PHASES; ++ph) { a.ph_lo = ph; a.ph_hi = ph + 1; hipLaunchKernelGGL(fwd_megakernel, dim3(grid), dim3(256), 0, stream, a); }
#endif
}
```

```cpp
#include <hip/hip_runtime.h>
#include <stdint.h>

typedef unsigned short bf16;
__device__ __forceinline__ float bf2f(bf16 v) { return __uint_as_float(((unsigned)v) << 16); }
__device__ __forceinline__ bf16 f2bf(float f) { unsigned u = __float_as_uint(f); return (bf16)((u + 0x7fffu + ((u >> 16) & 1u)) >> 16); }

constexpr int D = 1024, NB = 4, S = 4096, CL = 256, NL = NB * S, NC = NB * CL, NT = NL + NC;
constexpr int EVEN_IN = 2336, ODD_IN = 1280;
constexpr float EPS = 1e-6f;

__device__ __forceinline__ float silu(float x) { return x / (1.f + expf(-x)); }
__device__ __forceinline__ float wave_sum(float v) {
#pragma unroll
    for (int o = 1; o < 64; o <<= 1) v += __shfl_xor(v, o);
    return v;
}

#define LAS __attribute__((address_space(3)))
typedef short bf16x8 __attribute__((ext_vector_type(8)));
typedef float f32x16 __attribute__((ext_vector_type(16)));
typedef float f32x4 __attribute__((ext_vector_type(4)));
typedef unsigned u32x4 __attribute__((ext_vector_type(4)));
typedef unsigned u32x2 __attribute__((ext_vector_type(2)));
typedef __bf16 bf16x2_t __attribute__((ext_vector_type(2)));
typedef float f32x2_t __attribute__((ext_vector_type(2)));
__device__ __forceinline__ unsigned pk2(float lo, float hi) { f32x2_t v = {lo, hi}; bf16x2_t b = __builtin_convertvector(v, bf16x2_t); return __builtin_bit_cast(unsigned, b); }
__device__ __forceinline__ float xhalf_sum(float x) {
    auto t = __builtin_amdgcn_permlane32_swap(__float_as_uint(x), __float_as_uint(x), false, false);
    return __uint_as_float(t[0]) + __uint_as_float(t[1]);
}

constexpr float QSCALE = 0.125f * 1.4426950408889634f;
constexpr int NPAD_E = 2432;
constexpr int TILE_LDS = 128 * 128;
constexpr int GEMM_LDS = 4 * TILE_LDS;

__device__ __forceinline__ void transpose_item(const float* W, int K, int N, bf16* WT, int dst_row0, int k0, int n0, LAS float* scr, int lane) {
    float tv[32];
#pragma unroll
    for (int i = 0; i < 32; ++i) tv[i] = W[(size_t)(k0 + 2 * i + (lane >> 5)) * N + n0 + (lane & 31)];
#pragma unroll
    for (int i = 0; i < 32; ++i) scr[(2 * i + (lane >> 5)) * 33 + (lane & 31)] = tv[i];
    asm volatile("s_waitcnt lgkmcnt(0)" ::: "memory");
    const int c = lane & 7;
#pragma unroll
    for (int j = 0; j < 4; ++j) {
        const int n = (lane >> 3) + 8 * j; const LAS float* s = scr + (8 * c) * 33 + n;
        u32x4 o; o.x = pk2(s[0 * 33], s[1 * 33]); o.y = pk2(s[2 * 33], s[3 * 33]); o.z = pk2(s[4 * 33], s[5 * 33]); o.w = pk2(s[6 * 33], s[7 * 33]);
        *(u32x4*)(WT + (size_t)(dst_row0 + n) * K + k0 + 8 * c) = o;
    }
    asm volatile("s_waitcnt lgkmcnt(0)" ::: "memory");
}

struct Ptrs {
    const float* in[27];
    float* out;
    unsigned char* ws;
};

constexpr size_t MiB = 1u << 20;
constexpr size_t WS_CTL = 0;
constexpr size_t WS_MODV = 1 * MiB;
constexpr size_t WS_ROPE = WS_MODV + 256 * 1024;
constexpr size_t WS_WINE = 2 * MiB;
constexpr size_t WS_WOUTE = WS_WINE + (size_t)NPAD_E * 1024 * 2;
constexpr size_t WS_WINO = WS_WOUTE + 2 * MiB;
constexpr size_t WS_WOUTO = WS_WINO + (size_t)1280 * 1024 * 2;
constexpr size_t WS_WGU = WS_WOUTO + 2 * MiB;
constexpr size_t WS_WD = WS_WGU + 32 * MiB;
constexpr size_t WS_CTXS = WS_WD + 16 * MiB;
constexpr size_t WS_R1 = 66 * MiB;
constexpr size_t WS_R4 = WS_R1 + 34 * MiB;
constexpr size_t WS_R2 = WS_R4 + 34 * MiB;
constexpr size_t WS_R3 = WS_R2 + 34 * MiB;
static_assert(WS_CTXS + 4 * MiB <= WS_R1, "ws map");
constexpr size_t R3_GQ = 0, R3_GK = R3_GQ + (size_t)NT * 256 * 2, R3_GV = R3_GK + (size_t)NT * 256 * 2, R3_GR = R3_GV + (size_t)NT * 512 * 2,
                 R3_LR = R3_GR + (size_t)NT * 512 * 2, R3_AQ = R3_LR + (size_t)NT * 32 * 4, R3_AK = R3_AQ + (size_t)NT * 512 * 2, R3_AV = R3_AK + (size_t)NT * 128 * 2,
                 R3_END = R3_AV + (size_t)NT * 128 * 2;
static_assert(WS_R3 + R3_END <= 256 * MiB, "ws map end");
constexpr size_t R3_OQ = 0, R3_OK = R3_OQ + (size_t)NL * 1024 * 2, R3_OV = R3_OK + (size_t)NT * 128 * 2;

__device__ __forceinline__ void ph_prologue(const Ptrs& P, LAS unsigned char* smem, int bid, int nblk) {
    const int lane = threadIdx.x & 63, wave = threadIdx.x >> 6;
    LAS float* scr = (LAS float*)smem + wave * 64 * 33;
    const int gw = bid * 4 + wave, NGW = nblk * 4;
    unsigned char* ws = P.ws;
    constexpr int I_WINE = 16 * 73, I_SQ = 16 * 32, I_WINO = 16 * 40, I_EXP_GU = 16 * 8, I_EXP_D = 4 * 32;
    constexpr int T_WINE = I_WINE, T_WOUTE = T_WINE + I_SQ, T_WINO = T_WOUTE + I_WINO, T_WOUTO = T_WINO + I_SQ,
                  T_G = T_WOUTO + 32 * I_EXP_GU, T_U = T_G + 32 * I_EXP_GU, T_D = T_U + 32 * I_EXP_D;
    for (int it = gw; it < T_D; it += NGW) {
        if (it < T_WINE) {
            int kb = it / 73, nb = it % 73, n0 = nb * 32;
            int dst = n0 < 1536 ? n0 : (n0 < 1568 ? n0 + 768 : n0 - 32);
            transpose_item(P.in[8], 1024, EVEN_IN, (bf16*)(ws + WS_WINE), dst, kb * 64, n0, scr, lane);
        } else if (it < T_WOUTE) { int r = it - T_WINE; transpose_item(P.in[9], 1024, 1024, (bf16*)(ws + WS_WOUTE), (r % 32) * 32, (r / 32) * 64, (r % 32) * 32, scr, lane); }
        else if (it < T_WINO) { int r = it - T_WOUTE; transpose_item(P.in[15], 1024, 1280, (bf16*)(ws + WS_WINO), (r % 40) * 32, (r / 40) * 64, (r % 40) * 32, scr, lane); }
        else if (it < T_WOUTO) { int r = it - T_WINO; transpose_item(P.in[16], 1024, 1024, (bf16*)(ws + WS_WOUTO), (r % 32) * 32, (r / 32) * 64, (r % 32) * 32, scr, lane); }
        else if (it < T_U) {
            bool up = it >= T_G; int r = it - (up ? T_G : T_WOUTO); int le = r / I_EXP_GU; r %= I_EXP_GU; int kb = r / 8, hb = r % 8;
            const float* W = (up ? P.in[25] : P.in[24]) + (size_t)le * 1024 * 256;
            transpose_item(W, 1024, 256, (bf16*)(ws + WS_WGU) + (size_t)le * 512 * 1024, 64 * hb + (up ? 32 : 0), kb * 64, hb * 32, scr, lane);
        } else {
            int r = it - T_U; int le = r / I_EXP_D; r %= I_EXP_D; int kb = r / 32, nb = r % 32;
            transpose_item(P.in[26] + (size_t)le * 256 * 1024, 256, 1024, (bf16*)(ws + WS_WD) + (size_t)le * 1024 * 256, nb * 32, kb * 64, nb * 32, scr, lane);
        }
    }
    { u32x4 z = {0, 0, 0, 0}; u32x4* p = (u32x4*)((bf16*)(ws + WS_WINE) + (size_t)EVEN_IN * 1024);
      for (int i = bid * 256 + threadIdx.x; i < 96 * 1024 * 2 / 16; i += nblk * 256) p[i] = z; }
    for (int i = bid * 256 + threadIdx.x; i < 1024; i += nblk * 256) {
        int pos = i >> 4, f = i & 15; float inv = powf(10000.f, -(float)(2 * f) / 32.f); float ang = (float)pos * inv;
        ((float2*)(ws + WS_ROPE))[i] = make_float2(cosf(ang), sinf(ang));
    }
    if (bid == 0 && threadIdx.x < 2) {
        const float* gq = threadIdx.x ? P.in[18] : P.in[13]; const float* gk = threadIdx.x ? P.in[19] : P.in[14];
        float mq = 0.f, mk = 0.f; for (int d = 0; d < 64; ++d) { mq = fmaxf(mq, fabsf(gq[d])); mk = fmaxf(mk, fabsf(gk[d])); }
        ((float*)(ws + WS_ROPE + 8192))[threadIdx.x] = 8.f * mq * mk * 1.4426950408889634f;
    }
    __syncthreads();
    {
        LAS float* sc = (LAS float*)smem;
        LAS float* red = (LAS float*)smem + 5 * 1024;
        for (int i = threadIdx.x; i < 5 * 1024; i += 256) { const float cv = i < 4096 ? P.in[1][i] : P.in[3][i - 4096]; sc[i] = cv / (1.f + expf(-cv)); }
        __syncthreads();
        for (int it = bid; it < 2 * 96; it += nblk) {
            const int layer = it / 96, col = (it % 96) * 64 + lane;
            const float* w = P.in[4] + (size_t)layer * D * 6144 + col;
            float a0 = 0.f, a1 = 0.f, a2 = 0.f, a3 = 0.f, a4 = 0.f;
#pragma unroll 32
            for (int k = 256 * wave; k < 256 * wave + 256; ++k) { const float wv = w[(size_t)k * 6144]; a0 += sc[k] * wv; a1 += sc[1024 + k] * wv; a2 += sc[2048 + k] * wv; a3 += sc[3072 + k] * wv; a4 += sc[4096 + k] * wv; }
            red[(wave * 5 + 0) * 64 + lane] = a0; red[(wave * 5 + 1) * 64 + lane] = a1; red[(wave * 5 + 2) * 64 + lane] = a2; red[(wave * 5 + 3) * 64 + lane] = a3; red[(wave * 5 + 4) * 64 + lane] = a4;
            __syncthreads();
            for (int i = threadIdx.x; i < 320; i += 256) { const int row = i >> 6, cl = i & 63;
                ((float*)(ws + WS_MODV))[((size_t)layer * 5 + row) * 6144 + (it % 96) * 64 + cl] = red[row * 64 + cl] + red[(5 + row) * 64 + cl] + red[(10 + row) * 64 + cl] + red[(15 + row) * 64 + cl] + P.in[5][layer * 6144 + (it % 96) * 64 + cl]; }
            __syncthreads();
        }
    }
}

template <bool SRC_BF>
__device__ __forceinline__ void modulate_rows(const float* xlat, const float* xctx, const bf16* xs, const float* modv_layer, const float* gain, int which, bf16* H, int nrows, int gw, int NGW, int lane) {
    for (int row = gw; row < nrows; row += NGW) {
        const float* mv = modv_layer + (size_t)(row < NL ? row / S : 4) * 6144;
        f32x4 v[4]; float ss = 0.f;
#pragma unroll
        for (int j = 0; j < 4; ++j) {
            if (SRC_BF) { const u32x2 w = *(const u32x2*)(xs + (size_t)row * D + 4 * lane + 256 * j); f32x4 t = {__uint_as_float(w.x << 16), __uint_as_float(w.x & 0xffff0000u), __uint_as_float(w.y << 16), __uint_as_float(w.y & 0xffff0000u)}; v[j] = t; }
            else { const float* xr = row < NL ? xlat + (size_t)row * D : xctx + (size_t)(row - NL) * D; v[j] = *(const f32x4*)(xr + 4 * lane + 256 * j); }
            ss += v[j].x * v[j].x + v[j].y * v[j].y + v[j].z * v[j].z + v[j].w * v[j].w;
        }
        float rstd = rsqrtf(wave_sum(ss) / D + EPS);
#pragma unroll
        for (int j = 0; j < 4; ++j) {
            int k = 4 * lane + 256 * j;
            f32x4 g = *(const f32x4*)(gain + k), sc = *(const f32x4*)(mv + (which + 1) * 1024 + k), sh = *(const f32x4*)(mv + which * 1024 + k);
            float h0 = v[j].x * rstd * g.x * (1.f + sc.x) + sh.x, h1 = v[j].y * rstd * g.y * (1.f + sc.y) + sh.y;
            float h2 = v[j].z * rstd * g.z * (1.f + sc.z) + sh.z, h3 = v[j].w * rstd * g.w * (1.f + sc.w) + sh.w;
            u32x2 o = {pk2(h0, h1), pk2(h2, h3)};
            *(u32x2*)(H + (size_t)row * D + k) = o;
        }
    }
}
__device__ __forceinline__ void route_tables(const Ptrs& P, int layer, int bid, int nblk);
__device__ __forceinline__ void ph_modulate(const Ptrs& P, int layer, int bid, int nblk) {
    route_tables(P, layer, bid, nblk);
    if (layer == 0) modulate_rows<false>(P.in[0], P.in[2], nullptr, (const float*)(P.ws + WS_MODV), P.in[6], 0, (bf16*)(P.ws + WS_R1), NT, bid * 4 + (threadIdx.x >> 6), nblk * 4, threadIdx.x & 63);
    else modulate_rows<true>(nullptr, nullptr, (const bf16*)(P.ws + WS_R4), (const float*)(P.ws + WS_MODV) + (size_t)5 * 6144, P.in[6] + D, 0, (bf16*)(P.ws + WS_R1), NT, bid * 4 + (threadIdx.x >> 6), nblk * 4, threadIdx.x & 63);
}

struct AffineRows {
    const bf16* base; size_t ld; int w; unsigned vo[4];
    __device__ __forceinline__ AffineRows(const bf16* b, size_t ld_) : base(b), ld(ld_), w(0) {}
    __device__ __forceinline__ void init(int w_, int rl, const int (&co)[4]) { w = w_;
#pragma unroll
        for (int i = 0; i < 4; ++i) vo[i] = (unsigned)((rl * ld + co[i]) * 2); }
    __device__ __forceinline__ const bf16* sb(int i, int kt) const { return base + (size_t)(32 * w + 8 * i) * ld + kt * 64; }
};
template <bool SWP, class AF, class BF, class Epi>
__device__ __forceinline__ void gemm_tile(AF af, BF bf, int nk, LAS unsigned char* smem, const Epi& epi) {
    const int tid = threadIdx.x, lane = tid & 63, wave = __builtin_amdgcn_readfirstlane(tid >> 6), wn = wave & 1, wm = wave >> 1, l31 = lane & 31, hh = lane >> 5;
    const int r0 = wave * 32 + (lane >> 3);
    __syncthreads();
    typename Epi::Pre pre; epi.prefetch(pre, wn * 64, wm * 64, l31, hh);
    __builtin_amdgcn_sched_barrier(0);
    int coff[4];
#pragma unroll
    for (int i = 0; i < 4; ++i) coff[i] = ((lane & 7) ^ (((r0 >> 1) + 4 * i) & 7)) * 8;
    af.init(wave, lane >> 3, coff); bf.init(wave, lane >> 3, coff);
#define GT_STAGE(st, kt) do { _Pragma("unroll") for (int i = 0; i < 4; ++i) { \
        __builtin_amdgcn_global_load_lds((const unsigned*)((const char*)af.sb(i, (kt)) + af.vo[i]), (LAS unsigned*)(smem + (st) * 2 * TILE_LDS + (wave * 4 + i) * 1024), 16, 0, 0); \
        __builtin_amdgcn_global_load_lds((const unsigned*)((const char*)bf.sb(i, (kt)) + bf.vo[i]), (LAS unsigned*)(smem + (st) * 2 * TILE_LDS + TILE_LDS + (wave * 4 + i) * 1024), 16, 0, 0); } } while (0)
    GT_STAGE(0, 0);
    f32x16 acc[2][2];
#pragma unroll
    for (int i = 0; i < 2; ++i)
#pragma unroll
        for (int j = 0; j < 2; ++j)
#pragma unroll
            for (int r = 0; r < 16; ++r) acc[i][j][r] = 0.f;
    const int sw = (l31 >> 1) & 7;
    int xo[4], wo[4];
#pragma unroll
    for (int s = 0; s < 4; ++s) { const int cs = ((2 * s + hh) ^ sw) * 16; xo[s] = (wm * 64 + l31) * 128 + cs; wo[s] = TILE_LDS + (wn * 64 + l31) * 128 + cs; }
    asm volatile("s_waitcnt vmcnt(0)" ::: "memory");
    __syncthreads();
    for (int kt = 0; kt < nk; ++kt) {
        const int st = kt & 1;
        if (kt + 1 < nk) GT_STAGE(st ^ 1, kt + 1);
        LAS unsigned char* sb = smem + st * 2 * TILE_LDS;
#pragma unroll
        for (int s = 0; s < 4; ++s) {
            bf16x8 wf[2], xf[2];
#pragma unroll
            for (int i = 0; i < 2; ++i) wf[i] = *(LAS bf16x8*)(sb + wo[s] + i * 4096);
#pragma unroll
            for (int j = 0; j < 2; ++j) xf[j] = *(LAS bf16x8*)(sb + xo[s] + j * 4096);
#pragma unroll
            for (int i = 0; i < 2; ++i)
#pragma unroll
                for (int j = 0; j < 2; ++j) acc[i][j] = SWP ? __builtin_amdgcn_mfma_f32_32x32x16_bf16(xf[j], wf[i], acc[i][j], 0, 0, 0)
                                                            : __builtin_amdgcn_mfma_f32_32x32x16_bf16(wf[i], xf[j], acc[i][j], 0, 0, 0);
        }
        asm volatile("s_waitcnt vmcnt(0)" ::: "memory");
        __syncthreads();
    }
#undef GT_STAGE
    { int l31e = l31, hhe = hh, we = wave; asm volatile("" : "+v"(l31e), "+v"(hhe), "+v"(we));
      epi(acc, (we & 1) * 64, (we >> 1) * 64, l31e, hhe, smem + we * 16384, pre); }
}

constexpr int SG_P = 144;
__device__ __forceinline__ void store_bf16_T(const f32x16 (&acc)[2][2], bf16* out, size_t ld, size_t trow0, int col0, int l31, int hh, LAS unsigned char* wl) {
#pragma unroll
    for (int j = 0; j < 2; ++j)
#pragma unroll
        for (int i = 0; i < 2; ++i)
#pragma unroll
            for (int g = 0; g < 4; ++g) { u32x2 v = {pk2(acc[i][j][4 * g], acc[i][j][4 * g + 1]), pk2(acc[i][j][4 * g + 2], acc[i][j][4 * g + 3])}; *(LAS u32x2*)(wl + (32 * j + l31) * SG_P + (32 * i + 8 * g + 4 * hh) * 2) = v; }
    const int lane = l31 + 32 * hh, rr = lane >> 3, ch = lane & 7;
#pragma unroll
    for (int q = 0; q < 8; ++q) { const int R = 8 * q + rr; const u32x4 v = *(LAS u32x4*)(wl + R * SG_P + ch * 16); *(u32x4*)(out + (trow0 + R) * ld + col0 + ch * 8) = v; }
}
__device__ __forceinline__ void qknorm_rope_T(f32x16 (&acc)[2][2], const float* gain, const float2* ropeT, bool latent, int tok0  , int l31, int hh, float oscale = 1.f) {
#pragma unroll
    for (int j = 0; j < 2; ++j) {
        float ss = 0.f;
#pragma unroll
        for (int i = 0; i < 2; ++i)
#pragma unroll
            for (int r = 0; r < 16; ++r) ss += acc[i][j][r] * acc[i][j][r];
        ss = xhalf_sum(ss);
        const float rstd = rsqrtf(ss * (1.f / 64.f) + EPS) * oscale;
#pragma unroll
        for (int i = 0; i < 2; ++i)
#pragma unroll
            for (int r = 0; r < 16; ++r) acc[i][j][r] *= rstd * gain[i * 32 + (r & 3) + 8 * (r >> 2) + 4 * hh];
        if (latent) {
            const int t = tok0 + j * 32 + l31;
#pragma unroll
            for (int i = 0; i < 2; ++i) {
                const int pos = i == 0 ? (t >> 6) : (t & 63);
#pragma unroll
                for (int r = 0; r < 8; ++r) {
                    const int f = (r & 3) + 8 * (r >> 2) + 4 * hh;
                    const float2 cs = ropeT[pos * 16 + f];
                    const float x1 = acc[i][j][r], x2 = acc[i][j][r + 8];
                    acc[i][j][r] = x1 * cs.x - x2 * cs.y; acc[i][j][r + 8] = x2 * cs.x + x1 * cs.y;
                }
            }
        }
    }
}

constexpr int VT_LD = S + CL;
__device__ __forceinline__ void store_vt_swapped(const f32x16 (&acc)[2][2], bf16* vt_head  , int key0, int l31, int hh, LAS unsigned char* wl) {
#pragma unroll
    for (int i = 0; i < 2; ++i)
#pragma unroll
        for (int j = 0; j < 2; ++j)
#pragma unroll
            for (int g = 0; g < 4; ++g) { u32x2 v = {pk2(acc[i][j][4 * g], acc[i][j][4 * g + 1]), pk2(acc[i][j][4 * g + 2], acc[i][j][4 * g + 3])}; *(LAS u32x2*)(wl + (32 * i + l31) * SG_P + (32 * j + 8 * g + 4 * hh) * 2) = v; }
    const int lane = l31 + 32 * hh, rr = lane >> 3, ch = lane & 7;
#pragma unroll
    for (int q = 0; q < 8; ++q) { const int R = 8 * q + rr; const u32x4 v = *(LAS u32x4*)(wl + R * SG_P + ch * 16); *(u32x4*)(vt_head + (size_t)R * VT_LD + key0 + ch * 8) = v; }
}
struct NoPre {};
template <bool SRC_BF> struct RmwPre { f32x4 xi[16]; };
template <> struct RmwPre<true> { u32x2 xi[16]; };
template <bool SRC_BF, class RowF>
__device__ __forceinline__ void rmw_prefetch(RmwPre<SRC_BF>& pre, const RowF& rowf, int l31, int hh) {
    const int lane = l31 + 32 * hh, rr = lane >> 4, ch = lane & 15;
#pragma unroll
    for (int q = 0; q < 16; ++q) {
        const void* sp; void* dp; const float* gp;
        if (rowf(4 * q + rr, sp, dp, gp)) {
            if constexpr (SRC_BF) pre.xi[q] = *(const u32x2*)((const bf16*)sp + ch * 4); else pre.xi[q] = *(const f32x4*)((const float*)sp + ch * 4);
        }
    }
}
template <bool SRC_BF, bool DST_BF, class RowF>
__device__ __forceinline__ void rmw_finish(const f32x16 (&acc)[2][2], const RmwPre<SRC_BF>& pre, const RowF& rowf, int l31, int hh, LAS unsigned char* wl) {
    const int lane = l31 + 32 * hh, rr = lane >> 4, ch = lane & 15;
#pragma unroll
    for (int j = 0; j < 2; ++j)
#pragma unroll
        for (int i = 0; i < 2; ++i)
#pragma unroll
            for (int g = 0; g < 4; ++g) { f32x4 v = {acc[i][j][4 * g], acc[i][j][4 * g + 1], acc[i][j][4 * g + 2], acc[i][j][4 * g + 3]};
                const int R = 32 * j + l31; *(LAS f32x4*)(wl + R * 256 + (((8 * i + 2 * g + hh) ^ (R & 15)) * 16)) = v; }
#pragma unroll
    for (int q = 0; q < 16; ++q) {
        const void* sp; void* dp; const float* gp;
        if (rowf(4 * q + rr, sp, dp, gp)) {
            f32x4 x;
            if constexpr (SRC_BF) { const u32x2 w = pre.xi[q]; f32x4 t = {__uint_as_float(w.x << 16), __uint_as_float(w.x & 0xffff0000u), __uint_as_float(w.y << 16), __uint_as_float(w.y & 0xffff0000u)}; x = t; } else x = pre.xi[q];
            const int R = 4 * q + rr; const f32x4 a = *(LAS f32x4*)(wl + R * 256 + ((ch ^ (R & 15)) * 16)); const f32x4 gt = *(const f32x4*)(gp + ch * 4);
            const f32x4 v = {x.x + gt.x * a.x, x.y + gt.y * a.y, x.z + gt.z * a.z, x.w + gt.w * a.w};
            if (DST_BF) { u32x2 o = {pk2(v.x, v.y), pk2(v.z, v.w)}; *(u32x2*)((bf16*)dp + ch * 4) = o; }
            else *(f32x4*)((float*)dp + ch * 4) = v;
        }
    }
}
struct EpiEvenIn {
    typedef NoPre Pre;
    __device__ __forceinline__ void prefetch(Pre&, int, int, int, int) const {}
    unsigned char* r3; const float* qn; const float* kn; const float2* ropeT; int mt, nt;
    __device__ __forceinline__ bool swapped() const { return nt == 17 || (nt >= 4 && nt < 8); }
    __device__ __forceinline__ void operator()(f32x16 (&acc)[2][2], int fb, int tb, int l31, int hh, LAS unsigned char* wl, const Pre& pre) const {
        const size_t trow0 = (size_t)mt * 128 + tb; const bool latent = mt < NL / 128; const int tok0 = (int)(trow0 & (S - 1));
        if (swapped()) {
            const int b = latent ? (int)(trow0 / S) : (int)((trow0 - NL) / CL); const int key0 = latent ? tok0 : S + (int)((trow0 - NL) % CL);
            const size_t off = nt == 17 ? R3_AV + (size_t)(b * 2 + fb / 64) * 64 * VT_LD * 2 : R3_GV + ((size_t)(b * 4 + nt - 4) * 128 + fb) * VT_LD * 2;
            store_vt_swapped(acc, (bf16*)(r3 + off), key0, l31, hh, wl);
        } else if (nt == 18) {
            if (fb == 0) {
                float* LR = (float*)(r3 + R3_LR);
#pragma unroll
                for (int j = 0; j < 2; ++j)
#pragma unroll
                    for (int g = 0; g < 4; ++g) { f32x4 v = {acc[0][j][4 * g], acc[0][j][4 * g + 1], acc[0][j][4 * g + 2], acc[0][j][4 * g + 3]}; *(f32x4*)(LR + (trow0 + j * 32 + l31) * 32 + 8 * g + 4 * hh) = v; }
            }
        } else {
            size_t off; int ld, col;
            if (nt < 2) { off = R3_GQ; ld = 256; col = nt * 128; }
            else if (nt < 4) { off = R3_GK; ld = 256; col = (nt - 2) * 128; }
            else if (nt < 12) { off = R3_GR; ld = 512; col = (nt - 8) * 128; }
            else if (nt < 16) { off = R3_AQ; ld = 512; col = (nt - 12) * 128; }
            else { off = R3_AK; ld = 128; col = 0; }
            if (nt >= 12) qknorm_rope_T(acc, nt < 16 ? qn : kn, ropeT, latent, tok0, l31, hh, nt < 16 ? QSCALE : 1.f);
            store_bf16_T(acc, (bf16*)(r3 + off), ld, trow0, col + fb, l31, hh, wl);
        }
    }
};
__device__ __forceinline__ int xcd_vid(int bid, int nb) { return (nb % 8 == 0) ? (bid % 8) * (nb / 8) + bid / 8 : bid; }

__device__ __forceinline__ void ph_even_inproj(const Ptrs& P, LAS unsigned char* smem, int bid, int nblk) {
    unsigned char* ws = P.ws;
    const int lrow = threadIdx.x >> 3, kc = threadIdx.x & 7;
    const int vid = xcd_vid(bid, nblk);
    for (int tile = vid; tile < (NT / 128) * 19; tile += nblk) {
        const int mt = tile / 19, nt = tile % 19;
        AffineRows af((const bf16*)(ws + WS_R1) + (size_t)mt * 128 * D, D);
        AffineRows bf_((const bf16*)(ws + WS_WINE) + (size_t)nt * 128 * D, D);
        EpiEvenIn epi{ws + WS_R3, P.in[13], P.in[14], (const float2*)(ws + WS_ROPE), mt, nt};
        if (epi.swapped()) gemm_tile<true>(af, bf_, D / 64, smem, epi); else gemm_tile<false>(af, bf_, D / 64, smem, epi);
    }
}

template <int LAYER>
struct EpiOutProj {
    typedef RmwPre<LAYER != 0> Pre;
    const float* modv_layer; const float* xin_lat; const float* xin_ctx; bf16* xs; int mt, nt;
    __device__ __forceinline__ bool swapped() const { return false; }
    __device__ __forceinline__ auto rowfn(int fb, int tb) const {
        const size_t trow0 = (size_t)mt * 128 + tb; const bool latent = mt < NL / 128;
        const int c0 = nt * 128 + fb;
        const float* gate = modv_layer + (size_t)(latent ? trow0 / S : 4) * 6144 + 2 * 1024 + c0;
        bf16* xo = xs + trow0 * D + c0;
        const float* xin = LAYER == 0 ? (latent ? xin_lat + trow0 * D : xin_ctx + (trow0 - NL) * D) + c0 : nullptr;
        return [=](int R, const void*& sp, void*& dp, const float*& gp) { if (LAYER == 0) sp = xin + (size_t)R * D; else sp = xo + (size_t)R * D; dp = xo + (size_t)R * D; gp = gate; return true; };
    }
    __device__ __forceinline__ void prefetch(Pre& pre, int fb, int tb, int l31, int hh) const { rmw_prefetch<LAYER != 0>(pre, rowfn(fb, tb), l31, hh); }
    __device__ __forceinline__ void operator()(f32x16 (&acc)[2][2], int fb, int tb, int l31, int hh, LAS unsigned char* wl, const Pre& pre) const {
        rmw_finish<LAYER != 0, true>(acc, pre, rowfn(fb, tb), l31, hh, wl);
    }
};
__device__ __forceinline__ void ph_outproj(const Ptrs& P, LAS unsigned char* smem, int bid, int nblk, int layer, int nrows) {
    unsigned char* ws = P.ws;
    const int lrow = threadIdx.x >> 3, kc = threadIdx.x & 7;
    const int vid = xcd_vid(bid, nblk);
    const float* modv_layer = (const float*)(ws + WS_MODV) + (size_t)layer * 5 * 6144;
    for (int tile = vid; tile < (nrows / 128) * 8; tile += nblk) {
        const int mt = tile / 8, nt = tile % 8;
        AffineRows af((const bf16*)(ws + WS_R2) + (size_t)mt * 128 * D, D);
        AffineRows bf_((const bf16*)(ws + (layer ? WS_WOUTO : WS_WOUTE)) + (size_t)nt * 128 * D, D);
        if (layer == 0) { EpiOutProj<0> epi{modv_layer, P.in[0], P.in[2], (bf16*)(ws + WS_R4), mt, nt}; gemm_tile<false>(af, bf_, D / 64, smem, epi); }
        else { EpiOutProj<1> epi{modv_layer, nullptr, nullptr, (bf16*)(ws + WS_R4), mt, nt}; gemm_tile<false>(af, bf_, D / 64, smem, epi); }
    }
}

struct EpiOddIn {
    typedef NoPre Pre;
    __device__ __forceinline__ void prefetch(Pre&, int, int, int, int) const {}
    unsigned char* r3; const float* qn; const float* kn; const float2* ropeT; int mt, nt;
    __device__ __forceinline__ bool swapped() const { return nt == 9; }
    __device__ __forceinline__ void operator()(f32x16 (&acc)[2][2], int fb, int tb, int l31, int hh, LAS unsigned char* wl, const Pre& pre) const {
        const size_t trow0 = (size_t)mt * 128 + tb; const bool latent = mt < NL / 128; const int tok0 = (int)(trow0 & (S - 1));
        if (nt < 8) { if (latent) { qknorm_rope_T(acc, qn, ropeT, true, tok0, l31, hh, QSCALE); store_bf16_T(acc, (bf16*)(r3 + R3_OQ), 1024, trow0, nt * 128 + fb, l31, hh, wl); } }
        else if (nt == 8) { qknorm_rope_T(acc, kn, ropeT, latent, tok0, l31, hh); store_bf16_T(acc, (bf16*)(r3 + R3_OK), 128, trow0, fb, l31, hh, wl); }
        else {
            const int b = latent ? (int)(trow0 / S) : (int)((trow0 - NL) / CL); const int key0 = latent ? tok0 : S + (int)((trow0 - NL) % CL);
            store_vt_swapped(acc, (bf16*)(r3 + R3_OV) + (size_t)(b * 2 + fb / 64) * 64 * VT_LD, key0, l31, hh, wl);
        }
    }
};
__device__ __forceinline__ void ph_odd_inproj(const Ptrs& P, LAS unsigned char* smem, int bid, int nblk) {
    unsigned char* ws = P.ws;
    const int lrow = threadIdx.x >> 3, kc = threadIdx.x & 7;
    const int vid = xcd_vid(bid, nblk);
    constexpr int T_LAT = (NL / 128) * 10, T_ALL = T_LAT + (NC / 128) * 2;
    for (int tile = vid; tile < T_ALL; tile += nblk) {
        int mt, nt;
        if (tile < T_LAT) { mt = tile / 10; nt = tile % 10; } else { mt = NL / 128 + (tile - T_LAT) / 2; nt = 8 + (tile - T_LAT) % 2; }
        AffineRows af((const bf16*)(ws + WS_R1) + (size_t)mt * 128 * D, D);
        AffineRows bf_((const bf16*)(ws + WS_WINO) + (size_t)nt * 128 * D, D);
        EpiOddIn epi{ws + WS_R3, P.in[18], P.in[19], (const float2*)(ws + WS_ROPE), mt, nt};
        if (epi.swapped()) gemm_tile<true>(af, bf_, D / 64, smem, epi); else gemm_tile<false>(af, bf_, D / 64, smem, epi);
    }
}

constexpr int AT_KP = 144, AT_VP = 136;
constexpr int AT_STAGE = 64 * AT_KP + 64 * AT_VP;
constexpr int ATTN_LDS = 2 * AT_STAGE;
struct AttnArgs {
    const bf16* Q; int ldq; size_t qrow0; int qcol;
    const bf16* K; size_t klat0, kctx0;
    const bf16* Vt;
    int nctx, tlo, nlat;
    int banded, tq0;
    float sink_l2;
    float m0;
    bf16* out;
};
__device__ __forceinline__ float xhalf_max(float x) {
    auto t = __builtin_amdgcn_permlane32_swap(__float_as_uint(x), __float_as_uint(x), false, false);
    return fmaxf(__uint_as_float(t[0]), __uint_as_float(t[1]));
}
__device__ __forceinline__ void attn_block(const AttnArgs& a, LAS unsigned char* smem) {
    int tid_ = threadIdx.x; asm volatile("" : "+v"(tid_));
    const int tid = tid_, lane = tid & 63, wave = tid >> 6, l31 = lane & 31, hh = lane >> 5;
    bf16x8 qf[4];
    { const bf16* qp = a.Q + (a.qrow0 + wave * 32 + l31) * a.ldq + a.qcol + hh * 8;
#pragma unroll
      for (int s = 0; s < 4; ++s) qf[s] = *(const bf16x8*)(qp + 16 * s); }
    f32x16 o[2], minit;
#pragma unroll
    for (int r = 0; r < 16; ++r) { o[0][r] = 0.f; o[1][r] = 0.f; minit[r] = -a.m0; }
    float ls0 = 0.f, ls1 = 0.f, ls2 = 0.f, ls3 = 0.f;
    const int ntile = a.nctx + a.nlat;
    const int lr0 = tid >> 3, kc = tid & 7;
    const bf16* kbase = a.K + (size_t)lr0 * 128 + kc * 8;
    const bf16* vbase = a.Vt + (size_t)lr0 * VT_LD + kc * 8;
    const int kwoff = lr0 * AT_KP + kc * 16, vwoff = 64 * AT_KP + lr0 * AT_VP + kc * 16;
    const int kroff = l31 * AT_KP + hh * 16, vroff = 64 * AT_KP + l31 * AT_VP + hh * 8;
    u32x4 rk[2], rv[2];
#define AT_ISSUE(n) do { const int t_ = (n) < a.nctx ? 64 + (n) : a.tlo + (n) - a.nctx; \
        const size_t kr_ = (t_ < 64 ? a.klat0 + 64 * t_ : a.kctx0 + 64 * (t_ - 64)); \
        _Pragma("unroll") for (int i = 0; i < 2; ++i) { rk[i] = *(const u32x4*)(kbase + (kr_ + 32 * i) * 128); rv[i] = *(const u32x4*)(vbase + (size_t)(32 * i) * VT_LD + 64 * t_); } } while (0)
#define AT_COMMIT(ST) do { LAS unsigned char* sb_ = smem + (ST) * AT_STAGE; \
        _Pragma("unroll") for (int i = 0; i < 2; ++i) { *(LAS u32x4*)(sb_ + kwoff + i * 32 * AT_KP) = rk[i]; \
            u32x2 lo_ = {rv[i].x, rv[i].y}, hi_ = {rv[i].z, rv[i].w}; *(LAS u32x2*)(sb_ + vwoff + i * 32 * AT_VP) = lo_; *(LAS u32x2*)(sb_ + vwoff + i * 32 * AT_VP + 8) = hi_; } } while (0)
#define AT_BODY(ST, n) do { \
        if ((n) + 1 < ntile) AT_ISSUE((n) + 1); \
        __builtin_amdgcn_sched_barrier(0); \
        LAS unsigned char* sb = smem + (ST) * AT_STAGE; \
        bool skip = false; \
        if (a.banded && (n) >= a.nctx) { const int k0 = 64 * (a.tlo + (n) - a.nctx), q0w = a.tq0 + wave * 32; skip = (k0 + 63 < q0w - 128) || (k0 > q0w + 31 + 128); } \
        if (!skip) { \
            f32x16 sc[2]; \
            _Pragma("unroll") for (int kt = 0; kt < 2; ++kt) { \
                _Pragma("unroll") for (int s = 0; s < 4; ++s) { \
                    const bf16x8 kf = *(LAS bf16x8*)(sb + kroff + kt * 32 * AT_KP + s * 32); \
                    sc[kt] = __builtin_amdgcn_mfma_f32_32x32x16_bf16(kf, qf[s], s == 0 ? minit : sc[kt], 0, 0, 0); } } \
            bf16x8 vfr[2][2][2]; \
            _Pragma("unroll") for (int kt = 0; kt < 2; ++kt) _Pragma("unroll") for (int s2 = 0; s2 < 2; ++s2) _Pragma("unroll") for (int dt = 0; dt < 2; ++dt) { \
                LAS unsigned char* vp = sb + vroff + dt * 32 * AT_VP + (32 * kt + 16 * s2) * 2; \
                const u32x2 v0 = *(LAS u32x2*)vp, v1 = *(LAS u32x2*)(vp + 16); u32x4 vw = {v0.x, v0.y, v1.x, v1.y}; vfr[kt][s2][dt] = __builtin_bit_cast(bf16x8, vw); } \
            if (a.banded && (n) >= a.nctx) { \
                const int dbase = 64 * (a.tlo + (n) - a.nctx) + 4 * hh - (a.tq0 + wave * 32 + l31); \
                _Pragma("unroll") for (int kt = 0; kt < 2; ++kt) _Pragma("unroll") for (int r = 0; r < 16; ++r) { const int df = dbase + 32 * kt + (r & 3) + 8 * (r >> 2); if (df > 128 || df < -128) sc[kt][r] = -1e30f; } } \
            _Pragma("unroll") for (int kt = 0; kt < 2; ++kt) _Pragma("unroll") for (int r = 0; r < 16; r += 4) { \
                sc[kt][r] = __builtin_amdgcn_exp2f(sc[kt][r]); ls0 += sc[kt][r]; sc[kt][r + 1] = __builtin_amdgcn_exp2f(sc[kt][r + 1]); ls1 += sc[kt][r + 1]; \
                sc[kt][r + 2] = __builtin_amdgcn_exp2f(sc[kt][r + 2]); ls2 += sc[kt][r + 2]; sc[kt][r + 3] = __builtin_amdgcn_exp2f(sc[kt][r + 3]); ls3 += sc[kt][r + 3]; } \
            _Pragma("unroll") for (int kt = 0; kt < 2; ++kt) _Pragma("unroll") for (int s2 = 0; s2 < 2; ++s2) { \
                u32x4 pw = {pk2(sc[kt][8 * s2], sc[kt][8 * s2 + 1]), pk2(sc[kt][8 * s2 + 2], sc[kt][8 * s2 + 3]), pk2(sc[kt][8 * s2 + 4], sc[kt][8 * s2 + 5]), pk2(sc[kt][8 * s2 + 6], sc[kt][8 * s2 + 7])}; \
                const bf16x8 pf = __builtin_bit_cast(bf16x8, pw); \
                _Pragma("unroll") for (int dt = 0; dt < 2; ++dt) o[dt] = __builtin_amdgcn_mfma_f32_32x32x16_bf16(vfr[kt][s2][dt], pf, o[dt], 0, 0, 0); } \
        } \
        __builtin_amdgcn_sched_barrier(0); \
        if ((n) + 1 < ntile) AT_COMMIT((ST) ^ 1); \
        __syncthreads(); } while (0)
    AT_ISSUE(0); AT_COMMIT(0);
    __syncthreads();
    for (int n = 0; n < ntile; n += 2) {
        AT_BODY(0, n);
        if (n + 1 < ntile) AT_BODY(1, n + 1);
    }
#undef AT_ISSUE
#undef AT_COMMIT
#undef AT_BODY
    const float l = xhalf_sum((ls0 + ls1) + (ls2 + ls3)) + __builtin_amdgcn_exp2f(a.sink_l2 - a.m0);
    const float inv = 1.f / l;
    bf16* op = a.out + (a.qrow0 + wave * 32 + l31) * 1024 + 4 * hh;
#pragma unroll
    for (int dt = 0; dt < 2; ++dt)
#pragma unroll
        for (int g = 0; g < 4; ++g) { u32x2 v = {pk2(o[dt][4 * g] * inv, o[dt][4 * g + 1] * inv), pk2(o[dt][4 * g + 2] * inv, o[dt][4 * g + 3] * inv)}; *(u32x2*)(op + dt * 32 + 8 * g) = v; }
}

__device__ __forceinline__ void ph_dense_attn(const Ptrs& P, LAS unsigned char* smem, int bid, int nblk) {
    unsigned char* r3 = P.ws + WS_R3;
    const int vid = xcd_vid(bid, nblk);
    for (int item = vid; item < 1024 + 64; item += nblk) {
        AttnArgs a;
        int bh, qb; bool isctx = item >= 1024;
        if (!isctx) { bh = item >> 5; qb = item & 31; } else { bh = (item - 1024) >> 1; qb = (item - 1024) & 1; }
        const int hq = bh & 7, b = bh >> 3, kv = hq >> 2;
        a.Q = (const bf16*)(r3 + R3_AQ); a.ldq = 512; a.qcol = hq * 64;
        a.qrow0 = isctx ? (size_t)NL + b * CL + qb * 128 : (size_t)b * S + qb * 128;
        a.K = (const bf16*)(r3 + R3_AK) + kv * 64; a.klat0 = (size_t)b * S; a.kctx0 = (size_t)NL + b * CL;
        a.Vt = (const bf16*)(r3 + R3_AV) + (size_t)(b * 2 + kv) * 64 * VT_LD;
        a.nctx = 4; a.tlo = 0; a.nlat = isctx ? 0 : 64; a.banded = 0; a.tq0 = 0; a.sink_l2 = -INFINITY; a.m0 = ((const float*)(P.ws + WS_ROPE + 8192))[0];
        a.out = (bf16*)(P.ws + WS_R2) + 512 + hq * 64;
        attn_block(a, smem);
    }
}
__device__ __forceinline__ void ph_swa_attn(const Ptrs& P, LAS unsigned char* smem, int bid, int nblk) {
    unsigned char* r3 = P.ws + WS_R3;
    const int vid = xcd_vid(bid, nblk);
    for (int item = vid; item < 2048; item += nblk) {
        AttnArgs a;
        const int bh = item >> 5, qb = item & 31, hq = bh & 15, b = bh >> 4, kv = hq >> 3;
        a.Q = (const bf16*)(r3 + R3_OQ); a.ldq = 1024; a.qcol = hq * 64; a.qrow0 = (size_t)b * S + qb * 128;
        a.K = (const bf16*)(r3 + R3_OK) + kv * 64; a.klat0 = (size_t)b * S; a.kctx0 = (size_t)NL + b * CL;
        a.Vt = (const bf16*)(r3 + R3_OV) + (size_t)(b * 2 + kv) * 64 * VT_LD;
        const int tlo = qb * 2 - 2 < 0 ? 0 : qb * 2 - 2, thi = qb * 2 + 3 > 63 ? 63 : qb * 2 + 3;
        a.nctx = 4; a.tlo = tlo; a.nlat = thi - tlo + 1; a.banded = 1; a.tq0 = qb * 128; a.sink_l2 = P.in[17][hq] * 1.4426950408889634f; a.m0 = ((const float*)(P.ws + WS_ROPE + 8192))[1];
        a.out = (bf16*)(P.ws + WS_R2) + hq * 64;
        attn_block(a, smem);
    }
}

constexpr size_t WS_LIST = 247 * MiB;
constexpr size_t WS_WTS = WS_LIST + (size_t)24 * NT * 4;
constexpr size_t WS_END_ALL = WS_WTS + (size_t)NT * 2 * 4;
static_assert(WS_R3 + R3_END <= WS_LIST && WS_END_ALL <= 256 * MiB, "ws map tail");
constexpr int CTL_CNT = 8192;
constexpr int MOE_MAXT = NT / 128 + 24;

constexpr size_t WS_WRT = 250 * MiB, WS_SL = 251 * MiB;
typedef float f32x4v __attribute__((ext_vector_type(4)));
__device__ __forceinline__ void route_tables(const Ptrs& P, int layer, int bid, int nblk) {
    unsigned char* ws = P.ws;
    const float* mvl = (const float*)(ws + WS_MODV) + (size_t)layer * 5 * 6144;
    const float* gain = P.in[7] + layer * D;
    const float* wg = P.in[20] + (size_t)layer * D * 4; const float* bg = P.in[21] + layer * 4;
    const float* we = P.in[22] + (size_t)layer * D * 16; const float* be = P.in[23] + layer * 16;
    bf16* wrt = (bf16*)(ws + WS_WRT);
    for (int e = bid * 256 + threadIdx.x; e < 5 * 32 * 1024; e += nblk * 256) {
        const int k = e & 1023, r = (e >> 10) & 31, br = e >> 15;
        const float a = gain[k] * (1.f + mvl[(size_t)br * 6144 + 4 * 1024 + k]);
        const float w = (r < 16 ? wg[k * 4 + (r & 3)] : we[k * 16 + r - 16]) * a;
        const bf16 hi = f2bf(w); const bf16 lo = f2bf(w - bf2f(hi));
        wrt[((size_t)(br * 2 + 0) * 32 + r) * 1024 + k] = hi; wrt[((size_t)(br * 2 + 1) * 32 + r) * 1024 + k] = lo;
    }
    const int gw = bid * 4 + (threadIdx.x >> 6), lane = threadIdx.x & 63;
    if (gw < 160) {
        const int r = gw & 31, br = gw >> 5; float s = 0.f;
        for (int k = lane; k < 1024; k += 64) s += mvl[(size_t)br * 6144 + 3 * 1024 + k] * (r < 16 ? wg[k * 4 + (r & 3)] : we[k * 16 + r - 16]);
        s = wave_sum(s);
        if (lane == 0) ((float*)(ws + WS_SL))[br * 32 + r] = s + (r < 16 ? bg[r & 3] : be[r - 16]);
    }
}
typedef float f32x4a __attribute__((ext_vector_type(4)));
__device__ __forceinline__ float xq_sum(float x) {
    x += __shfl_xor(x, 16); x += __shfl_xor(x, 32); return x;
}
__device__ __forceinline__ void ph_moe_route(const Ptrs& P, LAS unsigned char* smem, int bid, int nblk, int layer, int nrows) {
    unsigned char* ws = P.ws;
    const int tid = threadIdx.x, lane = tid & 63, wave = tid >> 6, tk = lane & 15, kq = lane >> 4;
    const float* modv_layer = (const float*)(ws + WS_MODV) + (size_t)layer * 5 * 6144;
    const float* gain = P.in[7] + layer * D;
    const bf16* xs = (const bf16*)(ws + WS_R4);
    bf16* H = (bf16*)(ws + WS_R1);
    int* cnt = (int*)(ws + WS_CTL) + CTL_CNT + layer * 2048; int* list = (int*)(ws + WS_LIST); float* wts = (float*)(ws + WS_WTS);
    LAS float* part = (LAS float*)smem;
    for (int task = xcd_vid(bid, nblk); task < nrows / 16; task += nblk) {
        const int row0 = task * 16; const int row = row0 + tk;
        const int br = row0 < NL ? row0 / S : 4;
        const bf16* xr = xs + (size_t)row * D;
        const bf16* wt = (const bf16*)(ws + WS_WRT) + (size_t)br * 2 * 32 * 1024;
        f32x4a acc0 = {0.f, 0.f, 0.f, 0.f}, acc1 = {0.f, 0.f, 0.f, 0.f};
        float ss = 0.f;
#pragma unroll 4
        for (int s = 8 * wave; s < 8 * wave + 8; ++s) {
            const int k = 32 * s + 8 * kq;
            const u32x4 xh = *(const u32x4*)(xr + k);
            { const float f0 = __uint_as_float(xh.x << 16), f1 = __uint_as_float(xh.x & 0xffff0000u), f2 = __uint_as_float(xh.y << 16), f3 = __uint_as_float(xh.y & 0xffff0000u);
              const float f4 = __uint_as_float(xh.z << 16), f5 = __uint_as_float(xh.z & 0xffff0000u), f6 = __uint_as_float(xh.w << 16), f7 = __uint_as_float(xh.w & 0xffff0000u);
              ss += (f0 * f0 + f1 * f1) + (f2 * f2 + f3 * f3) + (f4 * f4 + f5 * f5) + (f6 * f6 + f7 * f7); }
            const bf16x8 bh = __builtin_bit_cast(bf16x8, xh);
            const bf16x8 a0h = *(const bf16x8*)(wt + (size_t)tk * 1024 + k), a1h = *(const bf16x8*)(wt + (size_t)(16 + tk) * 1024 + k);
            const bf16x8 a0l = *(const bf16x8*)(wt + (size_t)(32 + tk) * 1024 + k), a1l = *(const bf16x8*)(wt + (size_t)(48 + tk) * 1024 + k);
            acc0 = __builtin_amdgcn_mfma_f32_16x16x32_bf16(a0h, bh, acc0, 0, 0, 0); acc1 = __builtin_amdgcn_mfma_f32_16x16x32_bf16(a1h, bh, acc1, 0, 0, 0);
            acc0 = __builtin_amdgcn_mfma_f32_16x16x32_bf16(a0l, bh, acc0, 0, 0, 0); acc1 = __builtin_amdgcn_mfma_f32_16x16x32_bf16(a1l, bh, acc1, 0, 0, 0);
        }
#pragma unroll
        for (int j = 0; j < 4; ++j) { part[(wave * 9 + j) * 64 + lane] = acc0[j]; part[(wave * 9 + 4 + j) * 64 + lane] = acc1[j]; }
        part[(wave * 9 + 8) * 64 + lane] = ss;
        __syncthreads();
        float tot[9];
#pragma unroll
        for (int j = 0; j < 9; ++j) tot[j] = (part[j * 64 + lane] + part[(9 + j) * 64 + lane]) + (part[(18 + j) * 64 + lane] + part[(27 + j) * 64 + lane]);
        const float rstd = rsqrtf(xq_sum(tot[8]) * (1.f / D) + EPS);
        if (wave == 0) {
            const float* sl = (const float*)(ws + WS_SL) + br * 32;
            float gl[4], el[4];
#pragma unroll
            for (int j = 0; j < 4; ++j) { gl[j] = tot[j] * rstd + sl[j]; el[j] = tot[4 + j] * rstd + sl[16 + 4 * kq + j]; }
            int gi = 0; float gm = gl[0];
#pragma unroll
            for (int j = 1; j < 4; ++j) if (gl[j] > gm) { gm = gl[j]; gi = j; }
            if (gi == kq) {
                float gs = 0.f;
#pragma unroll
                for (int j = 0; j < 4; ++j) gs += expf(gl[j] - gm);
                const float gwt = 1.f / gs;
                int i0 = 0; float e0 = el[0];
#pragma unroll
                for (int j = 1; j < 4; ++j) if (el[j] > e0) { e0 = el[j]; i0 = j; }
                int i1 = -1; float e1 = -INFINITY;
#pragma unroll
                for (int j = 0; j < 4; ++j) if (j != i0 && el[j] > e1) { e1 = el[j]; i1 = j; }
                const float p1 = expf(e1 - e0); const float w0 = gwt / (1.f + p1), w1 = gwt * p1 / (1.f + p1);
                const int ea = i0 < i1 ? i0 : i1, eb = i0 < i1 ? i1 : i0;
                const int pidx = ea == 0 ? eb - 1 : (ea == 1 ? eb + 1 : 5);
                const int cls = gi * 6 + pidx;
                wts[(size_t)row * 2] = i0 < i1 ? w0 : w1; wts[(size_t)row * 2 + 1] = i0 < i1 ? w1 : w0;
                const int pos = atomicAdd(&cnt[cls * 64], 1);
                list[(size_t)cls * NT + pos] = row;
            }
        }
        const float* mv = modv_layer + (size_t)br * 6144;
        float rs[4];
#pragma unroll
        for (int r = 0; r < 4; ++r) rs[r] = __shfl(rstd, 4 * wave + r);
        u32x2 xv[4][4];
#pragma unroll
        for (int r = 0; r < 4; ++r) {
            const bf16* xp = xs + (size_t)(row0 + 4 * wave + r) * D + 4 * lane;
#pragma unroll
            for (int jq = 0; jq < 4; ++jq) xv[r][jq] = *(const u32x2*)(xp + 256 * jq);
        }
#pragma unroll
        for (int jq = 0; jq < 4; ++jq) {
            const int k = 4 * lane + 256 * jq;
            const f32x4 g = *(const f32x4*)(gain + k), sc = *(const f32x4*)(mv + 4 * 1024 + k), sh = *(const f32x4*)(mv + 3 * 1024 + k);
            const f32x4 a = {g.x * (1.f + sc.x), g.y * (1.f + sc.y), g.z * (1.f + sc.z), g.w * (1.f + sc.w)};
#pragma unroll
            for (int r = 0; r < 4; ++r) {
                const u32x2 xw = xv[r][jq]; const f32x4 x = {__uint_as_float(xw.x << 16), __uint_as_float(xw.x & 0xffff0000u), __uint_as_float(xw.y << 16), __uint_as_float(xw.y & 0xffff0000u)};
                u32x2 o = {pk2(x.x * rs[r] * a.x + sh.x, x.y * rs[r] * a.y + sh.y), pk2(x.z * rs[r] * a.z + sh.z, x.w * rs[r] * a.w + sh.w)};
                *(u32x2*)(H + (size_t)(row0 + 4 * wave + r) * D + k) = o;
            }
        }
        __syncthreads();
    }
}

__device__ __forceinline__ void moe_tiles_init(const int* cnt, LAS int* tile0) {
    __syncthreads();
    if (threadIdx.x < 24) tile0[192 + threadIdx.x] = cnt[threadIdx.x * 64];
    __syncthreads();
    if (threadIdx.x == 0) { int a = 0; for (int c = 0; c < 24; ++c) { tile0[c] = a; a += (tile0[192 + c] + 127) >> 7; } tile0[24] = a; }
    __syncthreads();
}
struct GatherRows {
    const bf16* H; const int* lst; int n; unsigned vo[4];
    __device__ __forceinline__ void init(int w, int rl, const int (&co)[4]) {
#pragma unroll
        for (int i = 0; i < 4; ++i) { const int r = 32 * w + 8 * i + rl; vo[i] = (unsigned)(((size_t)lst[r < n ? r : 0] * D + co[i]) * 2); }
    }
    __device__ __forceinline__ const bf16* sb(int i, int kt) const { return H + kt * 64; }
};
struct SplitKRows {
    const bf16* b0; const bf16* b1; size_t ld; int ksplit; int w; unsigned vo[4];
    __device__ __forceinline__ SplitKRows(const bf16* b0_, const bf16* b1_, size_t ld_, int ksplit_) : b0(b0_), b1(b1_), ld(ld_), ksplit(ksplit_), w(0) {}
    __device__ __forceinline__ void init(int w_, int rl, const int (&co)[4]) { w = w_;
#pragma unroll
        for (int i = 0; i < 4; ++i) vo[i] = (unsigned)((rl * ld + co[i]) * 2); }
    __device__ __forceinline__ const bf16* sb(int i, int kt) const { return (kt < ksplit ? b0 + kt * 64 : b1 + (kt - ksplit) * 64) + (size_t)(32 * w + 8 * i) * ld; }
};
struct EpiMoe1 {
    typedef NoPre Pre;
    __device__ __forceinline__ void prefetch(Pre&, int, int, int, int) const {}
    bf16* hid; const int* lst; int n; const float* wts; int nt;
    __device__ __forceinline__ bool swapped() const { return false; }
    __device__ __forceinline__ void operator()(f32x16 (&acc)[2][2], int fb, int tb, int l31, int hh, LAS unsigned char* wl, const Pre& pre) const {
        const int col = (nt >> 2) * 256 + 32 * (2 * (nt & 3) + (fb >> 6));
#pragma unroll 1
        for (int j = 0; j < 2; ++j) {
            const int r = tb + j * 32 + l31;
            const int tok = lst[r < n ? r : 0];
            const float w = wts[(size_t)tok * 2 + (nt >> 2)];
#pragma unroll
            for (int g = 0; g < 4; ++g) {
                float hv[4];
#pragma unroll
                for (int e = 0; e < 4; ++e) { const float a_ = j ? acc[0][1][4 * g + e] : acc[0][0][4 * g + e], u_ = j ? acc[1][1][4 * g + e] : acc[1][0][4 * g + e]; hv[e] = a_ / (1.f + __expf(-a_)) * u_ * w; }
                u32x2 v = {pk2(hv[0], hv[1]), pk2(hv[2], hv[3])}; *(LAS u32x2*)(wl + (32 * j + l31) * 80 + (8 * g + 4 * hh) * 2) = v;
            }
        }
        const int lane = l31 + 32 * hh, rr = lane >> 2, ch = lane & 3;
#pragma unroll
        for (int q = 0; q < 4; ++q) { const int R = 16 * q + rr; const u32x4 v = *(LAS u32x4*)(wl + R * 80 + ch * 16); *(u32x4*)(hid + (size_t)(tb + R) * 512 + col + ch * 8) = v; }
    }
};
__device__ __forceinline__ void ph_moe_stage1(const Ptrs& P, LAS unsigned char* smem, int bid, int nblk, int layer) {
    unsigned char* ws = P.ws;
    const int* cnt = (const int*)(ws + WS_CTL) + CTL_CNT + layer * 2048; const int* list = (const int*)(ws + WS_LIST);
    LAS int* tile0 = (LAS int*)(smem + GEMM_LDS);
    moe_tiles_init(cnt, tile0);
    const int lrow = threadIdx.x >> 3, kc = threadIdx.x & 7;
    const bf16* H = (const bf16*)(ws + WS_R1);
    const int nitems = tile0[24] * 8;
    for (int item = xcd_vid(bid, nblk); item < nitems; item += nblk) {
        const int tt = item >> 3, nt = item & 7;
        int c = 0; while (tile0[c + 1] <= tt) ++c;
        const int lt = tt - tile0[c], n = min(128, tile0[192 + c] - lt * 128);
        const int* lst = list + (size_t)c * NT + lt * 128;
        const int g = c / 6, pidx = c % 6; const int ea = pidx < 3 ? 0 : (pidx < 5 ? 1 : 2), eb = pidx < 3 ? pidx + 1 : (pidx < 5 ? pidx - 1 : 3);
        const int expert = g * 4 + (nt < 4 ? ea : eb);
        GatherRows af{H, lst, n, {0u, 0u, 0u, 0u}};
        AffineRows bf_((const bf16*)(ws + WS_WGU) + ((size_t)(layer * 16 + expert) * 512 + (nt & 3) * 128) * D, D);
        EpiMoe1 epi{(bf16*)(ws + WS_R3) + (size_t)tt * 128 * 512, lst, n, (const float*)(ws + WS_WTS), nt};
        gemm_tile<false>(af, bf_, D / 64, smem, epi);
    }
}
template <int LAYER>
struct EpiMoe2 {
    typedef RmwPre<true> Pre;
    bf16* xs; float* out; const float* modv_layer; LAS const int* lst; int n; int nt;
    __device__ __forceinline__ bool swapped() const { return false; }
    __device__ __forceinline__ auto rowfn(int fb, int tb) const {
        const int c0 = nt * 128 + fb; const EpiMoe2 e = *this;
        return [=](int R, const void*& sp, void*& dp, const float*& gp) {
            const int r = tb + R; if (r >= e.n) return false;
            const int tok = e.lst[r];
            sp = e.xs + (size_t)tok * D + c0;
            if (LAYER == 0) dp = e.xs + (size_t)tok * D + c0; else dp = e.out + (size_t)tok * D + c0;
            gp = e.modv_layer + (size_t)(tok < NL ? tok / S : 4) * 6144 + 5 * 1024 + c0; return true; };
    }
    __device__ __forceinline__ void prefetch(Pre& pre, int fb, int tb, int l31, int hh) const { rmw_prefetch<true>(pre, rowfn(fb, tb), l31, hh); }
    __device__ __forceinline__ void operator()(f32x16 (&acc)[2][2], int fb, int tb, int l31, int hh, LAS unsigned char* wl, const Pre& pre) const {
        rmw_finish<true, LAYER == 0>(acc, pre, rowfn(fb, tb), l31, hh, wl);
    }
};
__device__ __forceinline__ void ph_moe_stage2(const Ptrs& P, LAS unsigned char* smem, int bid, int nblk, int layer) {
    unsigned char* ws = P.ws;
    const int* cnt = (const int*)(ws + WS_CTL) + CTL_CNT + layer * 2048; const int* list = (const int*)(ws + WS_LIST);
    LAS int* tile0 = (LAS int*)(smem + GEMM_LDS);
    moe_tiles_init(cnt, tile0);
    const int lrow = threadIdx.x >> 3, kc = threadIdx.x & 7;
    const int nitems = tile0[24] * 8;
    for (int item = xcd_vid(bid, nblk); item < nitems; item += nblk) {
        const int tt = item >> 3, nt = item & 7;
        int c = 0; while (tile0[c + 1] <= tt) ++c;
        const int lt = tt - tile0[c], n = min(128, tile0[192 + c] - lt * 128);
        const int* lst = list + (size_t)c * NT + lt * 128;
        const int g = c / 6, pidx = c % 6; const int ea = pidx < 3 ? 0 : (pidx < 5 ? 1 : 2), eb = pidx < 3 ? pidx + 1 : (pidx < 5 ? pidx - 1 : 3);
        AffineRows af((const bf16*)(ws + WS_R3) + (size_t)tt * 128 * 512, 512);
        const bf16* wd = (const bf16*)(ws + WS_WD);
        SplitKRows bf_(wd + ((size_t)(layer * 16 + g * 4 + ea) * 1024 + nt * 128) * 256, wd + ((size_t)(layer * 16 + g * 4 + eb) * 1024 + nt * 128) * 256, 256, 4);
        LAS int* toks = (LAS int*)(smem + GEMM_LDS + 256);
        __syncthreads();
        if (threadIdx.x < 128) toks[threadIdx.x] = lst[threadIdx.x < n ? threadIdx.x : 0];
        if (layer == 0) { EpiMoe2<0> epi{(bf16*)(ws + WS_R4), P.out, (const float*)(ws + WS_MODV), toks, n, nt}; gemm_tile<false>(af, bf_, 8, smem, epi); }
        else { EpiMoe2<1> epi{(bf16*)(ws + WS_R4), P.out, (const float*)(ws + WS_MODV) + (size_t)5 * 6144, toks, n, nt}; gemm_tile<false>(af, bf_, 8, smem, epi); }
    }
}

constexpr size_t GLA_ST = 8192;
constexpr size_t WS_DEC = WS_WTS + (size_t)NT * 2 * 4;
static_assert(WS_DEC + (size_t)32 * 68 * 64 * 4 <= 256 * MiB, "ws dec");
__device__ __forceinline__ void gla_chunk_geom(int b, int M, size_t& row0, int& vcol0, int& c0, int& c1) {
    if (M < 4) { row0 = (size_t)NL + b * CL + 64 * M; vcol0 = S + 64 * M; c0 = M; c1 = 3 - M; }
    else { const int Ml = M - 4; row0 = (size_t)b * S + 64 * Ml; vcol0 = 64 * Ml; c0 = 4 + Ml; c1 = 4 + 63 - Ml; }
}
template <bool PASS_C>
__device__ __forceinline__ float gla_prep(const float (&gw)[16], float gb, int dir, LAS unsigned char* out, LAS const unsigned char* qraw, LAS const unsigned char* kraw, LAS const float* lrs, LAS float* tot) {
    const int tid = threadIdx.x, k = tid & 63, grp = tid >> 6;
    float gl[16];
#pragma unroll
    for (int j = 0; j < 16; ++j) {
        const int p = 16 * grp + j; float z = gb;
#pragma unroll
        for (int r4 = 0; r4 < 4; ++r4) { const f32x4 l4 = *(LAS const f32x4*)(lrs + p * 16 + r4 * 4); z += l4.x * gw[4 * r4] + l4.y * gw[4 * r4 + 1] + l4.z * gw[4 * r4 + 2] + l4.w * gw[4 * r4 + 3]; }
        gl[j] = (fminf(z, 0.f) - __logf(1.f + __expf(-fabsf(z)))) * (1.f / 16.f);
    }
    if (dir == 0) {
#pragma unroll
        for (int j = 1; j < 16; ++j) gl[j] += gl[j - 1];
        tot[grp * 64 + k] = gl[15];
    } else {
#pragma unroll
        for (int j = 14; j >= 0; --j) gl[j] += gl[j + 1];
        tot[grp * 64 + k] = gl[0];
    }
    __syncthreads();
    const float t0 = tot[k], t1 = tot[64 + k], t2 = tot[128 + k], t3 = tot[192 + k];
    const float bend = t0 + t1 + t2 + t3;
    float offs;
    if (dir == 0) offs = grp == 0 ? 0.f : grp == 1 ? t0 : grp == 2 ? t0 + t1 : t0 + t1 + t2;
    else offs = grp == 3 ? 0.f : grp == 2 ? t3 : grp == 1 ? t3 + t2 : t3 + t2 + t1;
    if (PASS_C) {
#pragma unroll
        for (int j = 0; j < 16; ++j) {
            const int p = 16 * grp + j; const float bp = gl[j] + offs;
            const float q = bf2f(*(LAS const bf16*)(qraw + p * 128 + k * 2)) * 0.125f, kk = bf2f(*(LAS const bf16*)(kraw + p * 128 + k * 2));
            *(LAS bf16*)(out + p * 144 + k * 2) = f2bf(q * __expf(bp));
            *(LAS bf16*)(out + 9216 + p * 144 + k * 2) = f2bf(q * __expf(bp - bend));
            *(LAS bf16*)(out + 18432 + p * 144 + k * 2) = f2bf(kk * __expf(bend - bp));
        }
    } else {
        float kt[16];
#pragma unroll
        for (int j = 0; j < 16; ++j) { const int p = 16 * grp + j; const float bp = gl[j] + offs; kt[j] = bf2f(*(LAS const bf16*)(kraw + p * 128 + k * 2)) * __expf(bend - bp); }
        u32x4 w0 = {pk2(kt[0], kt[1]), pk2(kt[2], kt[3]), pk2(kt[4], kt[5]), pk2(kt[6], kt[7])}, w1 = {pk2(kt[8], kt[9]), pk2(kt[10], kt[11]), pk2(kt[12], kt[13]), pk2(kt[14], kt[15])};
        *(LAS u32x4*)(out + k * 144 + grp * 32) = w0; *(LAS u32x4*)(out + k * 144 + grp * 32 + 16) = w1;
    }
    return __expf(bend);
}
#define GLA_LOAD_GW(gw, gb, dir, h) do { _Pragma("unroll") for (int r_ = 0; r_ < 16; ++r_) gw[r_] = P.in[10][((dir) * 16 + r_) * 256 + (h) * 64 + (threadIdx.x & 63)]; gb = P.in[11][(dir) * 256 + (h) * 64 + (threadIdx.x & 63)]; } while (0)

constexpr int GA_KTT = 0, GA_VT = 9216, GA_KRAW = GA_VT + 128 * 144, GA_LRS = GA_KRAW + 8192, GA_TOT = GA_LRS + 4096, GLA_A_LDS = GA_TOT + 1024;
__device__ __forceinline__ void gla_pass_a_item(const Ptrs& P, int item, LAS unsigned char* lds) {
    const int tid = threadIdx.x, lane = tid & 63, wave = tid >> 6, l31 = lane & 31, hh = lane >> 5;
    const int M = item % 68, dir = (item / 68) & 1, h = (item / 136) & 3, b = item / 544;
    size_t row0; int vcol0, c0, c1; gla_chunk_geom(b, M, row0, vcol0, c0, c1);
    const int sidx = ((b * 4 + h) * 2 + dir) * 68 + (dir ? c1 : c0);
    const unsigned char* r3 = P.ws + WS_R3;
    u32x4 vt[4], kr[2]; f32x4 lr; float gw[16], gb;
    { const bf16* gvt = (const bf16*)(r3 + R3_GV) + (size_t)(b * 4 + h) * 128 * VT_LD + vcol0;
#pragma unroll
      for (int i = 0; i < 4; ++i) { const int c = tid + 256 * i; vt[i] = *(const u32x4*)(gvt + (size_t)(c >> 3) * VT_LD + (c & 7) * 8); }
      const bf16* gk = (const bf16*)(r3 + R3_GK) + row0 * 256 + h * 64;
#pragma unroll
      for (int i = 0; i < 2; ++i) { const int c = tid + 256 * i; kr[i] = *(const u32x4*)(gk + (size_t)(c >> 3) * 256 + (c & 7) * 8); }
      lr = *(const f32x4*)((const float*)(r3 + R3_LR) + (row0 + (tid >> 2)) * 32 + dir * 16 + (tid & 3) * 4);
      GLA_LOAD_GW(gw, gb, dir, h); }
#pragma unroll
    for (int i = 0; i < 4; ++i) { const int c = tid + 256 * i; *(LAS u32x4*)(lds + GA_VT + (c >> 3) * 144 + (c & 7) * 16) = vt[i]; }
#pragma unroll
    for (int i = 0; i < 2; ++i) { const int c = tid + 256 * i; *(LAS u32x4*)(lds + GA_KRAW + (c >> 3) * 128 + (c & 7) * 16) = kr[i]; }
    *(LAS f32x4*)(lds + GA_LRS + tid * 16) = lr;
    __syncthreads();
    const float dec = gla_prep<false>(gw, gb, dir, lds + GA_KTT, lds + GA_KRAW, lds + GA_KRAW, (LAS const float*)(lds + GA_LRS), (LAS float*)(lds + GA_TOT));
    if (tid < 64) ((float*)(P.ws + WS_DEC))[(size_t)sidx * 64 + tid] = dec;
    __syncthreads();
    f32x16 acc[2];
#pragma unroll
    for (int kt = 0; kt < 2; ++kt)
#pragma unroll
        for (int r = 0; r < 16; ++r) acc[kt][r] = 0.f;
#pragma unroll
    for (int ps = 0; ps < 4; ++ps) {
        const bf16x8 vf = *(LAS bf16x8*)(lds + GA_VT + (32 * wave + l31) * 144 + ps * 32 + hh * 16);
#pragma unroll
        for (int kt = 0; kt < 2; ++kt) { const bf16x8 kf = *(LAS bf16x8*)(lds + GA_KTT + (32 * kt + l31) * 144 + ps * 32 + hh * 16); acc[kt] = __builtin_amdgcn_mfma_f32_32x32x16_bf16(kf, vf, acc[kt], 0, 0, 0); }
    }
    bf16* ds = (bf16*)(P.ws + WS_R1) + (size_t)sidx * GLA_ST + (size_t)(32 * wave + l31) * 64 + 4 * hh;
#pragma unroll
    for (int kt = 0; kt < 2; ++kt)
#pragma unroll
        for (int g = 0; g < 4; ++g) { u32x2 v = {pk2(acc[kt][4 * g], acc[kt][4 * g + 1]), pk2(acc[kt][4 * g + 2], acc[kt][4 * g + 3])}; *(u32x2*)(ds + kt * 32 + 8 * g) = v; }
    __syncthreads();
}
__device__ __forceinline__ void ph_gla_a(const Ptrs& P, LAS unsigned char* smem, int bid, int nblk) {
    for (int item = bid; item < 4 * 4 * 2 * 68; item += nblk) gla_pass_a_item(P, item, smem);
}
__device__ __forceinline__ void gla_pass_b(const Ptrs& P, int gtid, int nthreads) {
    const bf16* DS = (const bf16*)(P.ws + WS_R1); bf16* SIN = (bf16*)(P.ws + WS_R4); const float* DEC = (const float*)(P.ws + WS_DEC);
    for (int idx = gtid; idx < 32 * 2048; idx += nthreads) {
        const int bhd = idx >> 11, e4 = idx & 2047, k4 = (e4 & 15) * 4;
        float s0 = 0.f, s1 = 0.f, s2 = 0.f, s3 = 0.f;
#pragma unroll 17
        for (int c = 0; c < 68; ++c) {
            const size_t sidx = (size_t)bhd * 68 + c;
            u32x2 o = {pk2(s0, s1), pk2(s2, s3)};
            *(u32x2*)(SIN + sidx * GLA_ST + e4 * 4) = o;
            const f32x4 d = *(const f32x4*)(DEC + sidx * 64 + k4);
            const u32x2 w = *(const u32x2*)(DS + sidx * GLA_ST + e4 * 4);
            s0 = s0 * d.x + __uint_as_float(w.x << 16); s1 = s1 * d.y + __uint_as_float(w.x & 0xffff0000u);
            s2 = s2 * d.z + __uint_as_float(w.y << 16); s3 = s3 * d.w + __uint_as_float(w.y & 0xffff0000u);
        }
    }
}

constexpr int GC_QT = 0, GC_QA = 9216, GC_KT = 18432, GC_VT = 27648, GC_QRAW = GC_VT + 128 * 136, GC_KRAW = GC_QRAW + 8192, GC_LRS = GC_KRAW + 8192, GC_TOT = GEMM_LDS + 256, GC_XCH = GC_TOT + 1024;
static_assert(GC_LRS + 4096 <= GEMM_LDS, "gla c lds");
__device__ __forceinline__ void gla_pass_c_item(const Ptrs& P, int item, LAS unsigned char* lds) {
    const int tid = threadIdx.x, lane = tid & 63, wave = tid >> 6, l31 = lane & 31, hh = lane >> 5, pt = wave & 1, vh = wave >> 1;
    const int M = item % 68, h = (item / 68) & 3, b = item / 272;
    size_t row0; int vcol0, c0, c1; gla_chunk_geom(b, M, row0, vcol0, c0, c1);
    const unsigned char* r3 = P.ws + WS_R3;
    u32x4 vt[4], qr[2], kr[2]; f32x4 lr0, lr1; float gw[16], gb;
    { const bf16* gvt = (const bf16*)(r3 + R3_GV) + (size_t)(b * 4 + h) * 128 * VT_LD + vcol0;
#pragma unroll
      for (int i = 0; i < 4; ++i) { const int c = tid + 256 * i; vt[i] = *(const u32x4*)(gvt + (size_t)(c >> 3) * VT_LD + (c & 7) * 8); }
      const bf16* gq = (const bf16*)(r3 + R3_GQ) + row0 * 256 + h * 64; const bf16* gk = (const bf16*)(r3 + R3_GK) + row0 * 256 + h * 64;
#pragma unroll
      for (int i = 0; i < 2; ++i) { const int c = tid + 256 * i; qr[i] = *(const u32x4*)(gq + (size_t)(c >> 3) * 256 + (c & 7) * 8); kr[i] = *(const u32x4*)(gk + (size_t)(c >> 3) * 256 + (c & 7) * 8); }
      const float* lrp = (const float*)(r3 + R3_LR) + (row0 + (tid >> 2)) * 32 + (tid & 3) * 4;
      lr0 = *(const f32x4*)lrp; lr1 = *(const f32x4*)(lrp + 16);
      GLA_LOAD_GW(gw, gb, 0, h); }
#pragma unroll
    for (int i = 0; i < 4; ++i) { const int c = tid + 256 * i; LAS unsigned char* vp = lds + GC_VT + (c >> 3) * 136 + (c & 7) * 16; u32x2 lo = {vt[i].x, vt[i].y}, hi = {vt[i].z, vt[i].w}; *(LAS u32x2*)vp = lo; *(LAS u32x2*)(vp + 8) = hi; }
#pragma unroll
    for (int i = 0; i < 2; ++i) { const int c = tid + 256 * i; *(LAS u32x4*)(lds + GC_QRAW + (c >> 3) * 128 + (c & 7) * 16) = qr[i]; *(LAS u32x4*)(lds + GC_KRAW + (c >> 3) * 128 + (c & 7) * 16) = kr[i]; }
    *(LAS f32x4*)(lds + GC_LRS + tid * 16) = lr0;
    f32x16 o[2];
#pragma unroll
    for (int i = 0; i < 2; ++i)
#pragma unroll
        for (int r = 0; r < 16; ++r) o[i][r] = 0.f;
    const bf16* SIN = (const bf16*)(P.ws + WS_R4);
    __syncthreads();
#pragma unroll 1
    for (int dir = 0; dir < 2; ++dir) {
        const int sidx = ((b * 4 + h) * 2 + dir) * 68 + (dir ? c1 : c0);
        (void)gla_prep<true>(gw, gb, dir, lds + GC_QT, lds + GC_QRAW, lds + GC_KRAW, (LAS const float*)(lds + GC_LRS), (LAS float*)(lds + GC_TOT));
        bf16x8 sf[2][4];
#pragma unroll
        for (int i = 0; i < 2; ++i)
#pragma unroll
            for (int ks = 0; ks < 4; ++ks) sf[i][ks] = *(const bf16x8*)(SIN + (size_t)sidx * GLA_ST + (size_t)(64 * vh + 32 * i + l31) * 64 + 16 * ks + 8 * hh);
        if (dir == 0) { *(LAS f32x4*)(lds + GC_LRS + tid * 16) = lr1; GLA_LOAD_GW(gw, gb, 1, h); }
        __syncthreads();
        f32x16 at[2];
#pragma unroll
        for (int st = 0; st < 2; ++st) {
#pragma unroll
            for (int r = 0; r < 16; ++r) at[st][r] = 0.f;
#pragma unroll
            for (int ks = 0; ks < 4; ++ks) {
                const bf16x8 ka = *(LAS bf16x8*)(lds + GC_KT + (32 * st + l31) * 144 + ks * 32 + hh * 16);
                const bf16x8 qa = *(LAS bf16x8*)(lds + GC_QA + (32 * pt + l31) * 144 + ks * 32 + hh * 16);
                at[st] = __builtin_amdgcn_mfma_f32_32x32x16_bf16(ka, qa, at[st], 0, 0, 0);
            }
            const int pq = 32 * pt + l31;
#pragma unroll
            for (int r = 0; r < 16; ++r) { const int s_ = 32 * st + (r & 3) + 8 * (r >> 2) + 4 * hh; const bool ok = dir ? (s_ >= pq) : (s_ <= pq); if (!ok) at[st][r] = 0.f; }
        }
#pragma unroll
        for (int ks = 0; ks < 4; ++ks) {
            const bf16x8 qt = *(LAS bf16x8*)(lds + GC_QT + (32 * pt + l31) * 144 + ks * 32 + hh * 16);
#pragma unroll
            for (int i = 0; i < 2; ++i) o[i] = __builtin_amdgcn_mfma_f32_32x32x16_bf16(sf[i][ks], qt, o[i], 0, 0, 0);
        }
#pragma unroll
        for (int st = 0; st < 2; ++st)
#pragma unroll
            for (int s2 = 0; s2 < 2; ++s2) {
                u32x4 pw = {pk2(at[st][8 * s2], at[st][8 * s2 + 1]), pk2(at[st][8 * s2 + 2], at[st][8 * s2 + 3]), pk2(at[st][8 * s2 + 4], at[st][8 * s2 + 5]), pk2(at[st][8 * s2 + 6], at[st][8 * s2 + 7])};
                const bf16x8 pf = __builtin_bit_cast(bf16x8, pw);
#pragma unroll
                for (int i = 0; i < 2; ++i) {
                    LAS unsigned char* vp = lds + GC_VT + (64 * vh + 32 * i + l31) * 136 + (32 * st + 16 * s2 + 4 * hh) * 2;
                    const u32x2 v0 = *(LAS u32x2*)vp, v1 = *(LAS u32x2*)(vp + 16);
                    u32x4 vw = {v0.x, v0.y, v1.x, v1.y};
                    o[i] = __builtin_amdgcn_mfma_f32_32x32x16_bf16(__builtin_bit_cast(bf16x8, vw), pf, o[i], 0, 0, 0);
                }
            }
        __syncthreads();
    }
    float ss = 0.f;
#pragma unroll
    for (int i = 0; i < 2; ++i)
#pragma unroll
        for (int r = 0; r < 16; ++r) ss += o[i][r] * o[i][r];
    ss = xhalf_sum(ss);
    LAS float* xch = (LAS float*)(lds + GC_XCH);
    if (hh == 0) xch[(pt * 2 + vh) * 32 + l31] = ss;
    __syncthreads();
    ss += xch[(pt * 2 + (1 - vh)) * 32 + l31];
    const float rstd = rsqrtf(ss * (1.f / 128.f) + EPS);
    const size_t trow = row0 + 32 * pt + l31;
    const bf16* gr = (const bf16*)(P.ws + WS_R3 + R3_GR) + trow * 512 + h * 128 + 64 * vh + 4 * hh;
    bf16* mx = (bf16*)(P.ws + WS_R2) + trow * 1024 + h * 128 + 64 * vh + 4 * hh;
    const float* gn = P.in[12] + 64 * vh + 4 * hh;
#pragma unroll
    for (int i = 0; i < 2; ++i)
#pragma unroll
        for (int g = 0; g < 4; ++g) {
            const u32x2 rw = *(const u32x2*)(gr + i * 32 + 8 * g); const f32x4 gg = *(const f32x4*)(gn + i * 32 + 8 * g);
            const float r0 = __uint_as_float(rw.x << 16), r1 = __uint_as_float(rw.x & 0xffff0000u), r2 = __uint_as_float(rw.y << 16), r3_ = __uint_as_float(rw.y & 0xffff0000u);
            const float y0 = o[i][4 * g] * rstd * gg.x * (r0 / (1.f + __expf(-r0))), y1 = o[i][4 * g + 1] * rstd * gg.y * (r1 / (1.f + __expf(-r1)));
            const float y2 = o[i][4 * g + 2] * rstd * gg.z * (r2 / (1.f + __expf(-r2))), y3 = o[i][4 * g + 3] * rstd * gg.w * (r3_ / (1.f + __expf(-r3_)));
            u32x2 v = {pk2(y0, y1), pk2(y2, y3)}; *(u32x2*)(mx + i * 32 + 8 * g) = v;
        }
    __syncthreads();
}
__device__ __forceinline__ void ph_gla_c(const Ptrs& P, LAS unsigned char* smem, int bid, int nblk) {
    for (int item = bid; item < 4 * 4 * 68; item += nblk) gla_pass_c_item(P, item, smem);
}

#define XB_TMO      128
#define XB_XCNT(j)  (256  + 64 * (j))
#define XB_XSUB(j)  (1280 + 64 * (j))
#define XB_XGEN(j)  (2304 + 64 * (j))
#define XB_TOP      3328
#define XB_TOPGEN   3392
#define XB_SPIN_CAP (1u << 20)
constexpr int CTL_BAR = 4096;
__device__ __forceinline__ unsigned xb_ld(unsigned* p) { return __hip_atomic_load(p, __ATOMIC_RELAXED, __HIP_MEMORY_SCOPE_AGENT); }
__device__ __forceinline__ unsigned xb_add(unsigned* p, unsigned v) { return __hip_atomic_fetch_add(p, v, __ATOMIC_RELAXED, __HIP_MEMORY_SCOPE_AGENT); }
__device__ __forceinline__ unsigned xb_xcc_id() { return (unsigned)__builtin_amdgcn_s_getreg((3 << 11) | 20) & 0xFu; }
#define XB_SPIN(cond, bar) do { unsigned _sp = 0; while (cond) { __builtin_amdgcn_s_sleep(1); \
    if ((++_sp & 255u) == 0u) { if (xb_ld(&(bar)[XB_TMO])) break; if (_sp > XB_SPIN_CAP) { atomicAdd(&(bar)[XB_TMO], 1u); break; } } } } while (0)
struct XcdBarrier { unsigned* bar; unsigned x; volatile LAS unsigned* st; };
__device__ __forceinline__ XcdBarrier xcd_barrier_post(unsigned* bar, volatile LAS unsigned* st) {
    XcdBarrier b; b.bar = bar; b.x = xb_xcc_id(); b.st = st;
    if (threadIdx.x == 0) (void)xb_add(&bar[XB_XCNT(b.x)], 1u);
    return b;
}
__device__ __forceinline__ void xcd_barrier_complete(unsigned* bar, unsigned x, unsigned& nloc, unsigned& nx) {
    const unsigned G = gridDim.x * gridDim.y * gridDim.z;
    unsigned sum, cnt, mine, sp = 0u;
    for (;;) {
        sum = 0u; cnt = 0u; mine = 0u;
#pragma unroll
        for (unsigned j = 0; j < 16; ++j) { const unsigned c = xb_ld(&bar[XB_XCNT(j)]); sum += c; cnt += (c > 0u) ? 1u : 0u; mine = (j == x) ? c : mine; }
        if (sum == G) break;
        __builtin_amdgcn_s_sleep(1);
        if ((++sp & 255u) == 0u) { if (xb_ld(&bar[XB_TMO])) break; if (sp > XB_SPIN_CAP) { atomicAdd(&bar[XB_TMO], 1u); break; } }
    }
    nloc = mine > 0u ? mine : 1u; nx = cnt > 0u ? cnt : 1u;
}
__device__ __forceinline__ void xcd_barrier(const XcdBarrier& b) {
    asm volatile("s_waitcnt vmcnt(0)" ::: "memory");
    __syncthreads();
    if (threadIdx.x == 0) {
        unsigned* bar = b.bar;
        __builtin_amdgcn_s_waitcnt(0);
        unsigned nloc = b.st[0], nx = b.st[1];
        if (nloc == 0u) { xcd_barrier_complete(bar, b.x, nloc, nx); b.st[0] = nloc; b.st[1] = nx; }
        const unsigned old = xb_add(&bar[XB_XSUB(b.x)], 1u);
        const unsigned gen = old / nloc;
        if (old + 1u == (gen + 1u) * nloc) {
            __builtin_amdgcn_fence(__ATOMIC_RELEASE, "agent");
            asm volatile("s_waitcnt vmcnt(0)" ::: "memory");
            const unsigned og = xb_add(&bar[XB_TOP], 1u);
            const unsigned tg = og / nx;
            if (og + 1u == (tg + 1u) * nx) xb_add(&bar[XB_TOPGEN], 1u);
            else XB_SPIN(xb_ld(&bar[XB_TOPGEN]) == tg, bar);
            __builtin_amdgcn_fence(__ATOMIC_ACQUIRE, "agent");
            xb_add(&bar[XB_XGEN(b.x)], 1u);
            asm volatile("s_waitcnt vmcnt(0)" ::: "memory");
        } else {
            XB_SPIN(xb_ld(&bar[XB_XGEN(b.x)]) == gen, bar);
            __builtin_amdgcn_fence(__ATOMIC_ACQUIRE, "agent");
            asm volatile("s_waitcnt vmcnt(0)" ::: "memory");
        }
    }
    __syncthreads();
}

constexpr int N_PHASES = 18;
constexpr int SMEM_BYTES = GEMM_LDS + 2048;
struct Args { Ptrs P; int ph_lo, ph_hi; };
__global__ void __launch_bounds__(256, 2) fwd_megakernel(Args args) {
    __shared__ __attribute__((aligned(16))) unsigned char smem_raw[SMEM_BYTES];
    LAS unsigned char* smem = (LAS unsigned char*)smem_raw;
    const Ptrs& P = args.P;
    const int bid = blockIdx.x, nblk = gridDim.x;
    volatile LAS unsigned* bst = (volatile LAS unsigned*)(smem + GEMM_LDS + 128);
    if (threadIdx.x < 2) bst[threadIdx.x] = 0u;
    __syncthreads();
    XcdBarrier bar; bar.bar = (unsigned*)(P.ws + WS_CTL) + CTL_BAR; bar.x = 0; bar.st = bst;
    const bool multi = args.ph_hi - args.ph_lo > 1;
    if (multi) bar = xcd_barrier_post((unsigned*)(P.ws + WS_CTL) + CTL_BAR, bst);
    const int lo = args.ph_lo, hi = args.ph_hi;
#define PHASE(k, call) if (lo <= (k) && (k) < hi) { if ((k) > lo) xcd_barrier(bar); call; }
    PHASE(0, ph_prologue(P, smem, bid, nblk))
    PHASE(1, ph_modulate(P, 0, bid, nblk))
    PHASE(2, ph_even_inproj(P, smem, bid, nblk))
    PHASE(3, ph_gla_a(P, smem, bid, nblk))
    PHASE(4, gla_pass_b(P, bid * 256 + threadIdx.x, nblk * 256))
    PHASE(5, (ph_dense_attn(P, smem, bid, nblk), __syncthreads(), ph_gla_c(P, smem, (bid + nblk - 128) % nblk, nblk)))
    PHASE(7, ph_outproj(P, smem, bid, nblk, 0, NT))
    PHASE(8, ph_moe_route(P, smem, bid, nblk, 0, NT))
    PHASE(9, ph_moe_stage1(P, smem, bid, nblk, 0))
    PHASE(10, ph_moe_stage2(P, smem, bid, nblk, 0))
    PHASE(11, ph_modulate(P, 1, bid, nblk))
    PHASE(12, ph_odd_inproj(P, smem, bid, nblk))
    PHASE(13, ph_swa_attn(P, smem, bid, nblk))
    PHASE(14, ph_outproj(P, smem, bid, nblk, 1, NL))
    PHASE(15, ph_moe_route(P, smem, bid, nblk, 1, NL))
    PHASE(16, ph_moe_stage1(P, smem, bid, nblk, 1))
    PHASE(17, ph_moe_stage2(P, smem, bid, nblk, 1))
#undef PHASE
}

#ifndef MK_LAUNCHES
#define MK_LAUNCHES 1
#endif
extern "C" void kernel_launch(void* const* d_in, const int* in_sizes, int n_in, void* d_out, int out_size, void* d_ws, size_t ws_size, hipStream_t stream) {
    static int grid = 0;
    if (grid == 0) {
        int dev = 0, cus = 0, per_cu = 0;
        hipGetDevice(&dev);
        hipDeviceGetAttribute(&cus, hipDeviceAttributeMultiprocessorCount, dev);
        hipOccupancyMaxActiveBlocksPerMultiprocessor(&per_cu, (const void*)fwd_megakernel, 256, 0);
        if (per_cu > 2) per_cu = 2;
        if (per_cu < 1) per_cu = 1;
        grid = cus * per_cu;
    }
    hipMemsetAsync((unsigned char*)d_ws + WS_CTL, 0, 65536, stream);
    Args a{};
    for (int i = 0; i < 27; ++i) a.P.in[i] = (const float*)d_in[i];
    a.P.out = (float*)d_out; a.P.ws = (unsigned char*)d_ws;
#if MK_LAUNCHES == 1
    a.ph_lo = 0; a.ph_hi = N_PHASES;
    void* kargs[] = {&a};
    hipLaunchCooperativeKernel((const void*)fwd_megakernel, dim3(grid), dim3(256), kargs, 0, stream);
#else
    for (int ph = 0; ph < N_PHASES; ++ph) { a.ph_lo = ph; a.ph_hi = ph + 1; hipLaunchKernelGGL(fwd_megakernel, dim3(grid), dim3(256), 0, stream, a); }
#endif
}
```

```cpp
#include <hip/hip_runtime.h>
#include <stdint.h>

typedef unsigned short bf16;
__device__ __forceinline__ float bf2f(bf16 v) { return __uint_as_float(((unsigned)v) << 16); }
__device__ __forceinline__ bf16 f2bf(float f) { unsigned u = __float_as_uint(f); return (bf16)((u + 0x7fffu + ((u >> 16) & 1u)) >> 16); }

constexpr int D = 1024, NB = 4, S = 4096, CL = 256, NL = NB * S, NC = NB * CL, NT = NL + NC;
constexpr int EVEN_IN = 2336, ODD_IN = 1280;
constexpr float EPS = 1e-6f;

__device__ __forceinline__ float silu(float x) { return x / (1.f + expf(-x)); }
__device__ __forceinline__ float wave_sum(float v) {
#pragma unroll
    for (int o = 1; o < 64; o <<= 1) v += __shfl_xor(v, o);
    return v;
}

#define LAS __attribute__((address_space(3)))
typedef short bf16x8 __attribute__((ext_vector_type(8)));
typedef float f32x16 __attribute__((ext_vector_type(16)));
typedef float f32x4 __attribute__((ext_vector_type(4)));
typedef unsigned u32x4 __attribute__((ext_vector_type(4)));
typedef unsigned u32x2 __attribute__((ext_vector_type(2)));
typedef __bf16 bf16x2_t __attribute__((ext_vector_type(2)));
typedef float f32x2_t __attribute__((ext_vector_type(2)));
__device__ __forceinline__ unsigned pk2(float lo, float hi) { f32x2_t v = {lo, hi}; bf16x2_t b = __builtin_convertvector(v, bf16x2_t); return __builtin_bit_cast(unsigned, b); }
__device__ __forceinline__ float xhalf_sum(float x) {
    auto t = __builtin_amdgcn_permlane32_swap(__float_as_uint(x), __float_as_uint(x), false, false);
    return __uint_as_float(t[0]) + __uint_as_float(t[1]);
}

constexpr float QSCALE = 0.125f * 1.4426950408889634f;
constexpr int NPAD_E = 2432;
constexpr int TILE_LDS = 128 * 128;
constexpr int GEMM_LDS = 4 * TILE_LDS;

__device__ __forceinline__ void transpose_item(const float* W, int K, int N, bf16* WT, int dst_row0, int k0, int n0, LAS float* scr, int lane) {
    float tv[32];
#pragma unroll
    for (int i = 0; i < 32; ++i) tv[i] = W[(size_t)(k0 + 2 * i + (lane >> 5)) * N + n0 + (lane & 31)];
#pragma unroll
    for (int i = 0; i < 32; ++i) scr[(2 * i + (lane >> 5)) * 33 + (lane & 31)] = tv[i];
    asm volatile("s_waitcnt lgkmcnt(0)" ::: "memory");
    const int c = lane & 7;
#pragma unroll
    for (int j = 0; j < 4; ++j) {
        const int n = (lane >> 3) + 8 * j; const LAS float* s = scr + (8 * c) * 33 + n;
        u32x4 o; o.x = pk2(s[0 * 33], s[1 * 33]); o.y = pk2(s[2 * 33], s[3 * 33]); o.z = pk2(s[4 * 33], s[5 * 33]); o.w = pk2(s[6 * 33], s[7 * 33]);
        *(u32x4*)(WT + (size_t)(dst_row0 + n) * K + k0 + 8 * c) = o;
    }
    asm volatile("s_waitcnt lgkmcnt(0)" ::: "memory");
}

struct Ptrs {
    const float* in[27];
    float* out;
    unsigned char* ws;
};

constexpr size_t MiB = 1u << 20;
constexpr size_t WS_CTL = 0;
constexpr size_t WS_MODV = 1 * MiB;
constexpr size_t WS_ROPE = WS_MODV + 256 * 1024;
constexpr size_t WS_WINE = 2 * MiB;
constexpr size_t WS_WOUTE = WS_WINE + (size_t)NPAD_E * 1024 * 2;
constexpr size_t WS_WINO = WS_WOUTE + 2 * MiB;
constexpr size_t WS_WOUTO = WS_WINO + (size_t)1280 * 1024 * 2;
constexpr size_t WS_WGU = WS_WOUTO + 2 * MiB;
constexpr size_t WS_WD = WS_WGU + 32 * MiB;
constexpr size_t WS_CTXS = WS_WD + 16 * MiB;
constexpr size_t WS_R1 = 66 * MiB;
constexpr size_t WS_R4 = WS_R1 + 34 * MiB;
constexpr size_t WS_R2 = WS_R4 + 34 * MiB;
constexpr size_t WS_R3 = WS_R2 + 34 * MiB;
static_assert(WS_CTXS + 4 * MiB <= WS_R1, "ws map");
constexpr size_t R3_GQ = 0, R3_GK = R3_GQ + (size_t)NT * 256 * 2, R3_GV = R3_GK + (size_t)NT * 256 * 2, R3_GR = R3_GV + (size_t)NT * 512 * 2,
                 R3_LR = R3_GR + (size_t)NT * 512 * 2, R3_AQ = R3_LR + (size_t)NT * 32 * 4, R3_AK = R3_AQ + (size_t)NT * 512 * 2, R3_AV = R3_AK + (size_t)NT * 128 * 2,
                 R3_END = R3_AV + (size_t)NT * 128 * 2;
static_assert(WS_R3 + R3_END <= 256 * MiB, "ws map end");
constexpr size_t R3_OQ = 0, R3_OK = R3_OQ + (size_t)NL * 1024 * 2, R3_OV = R3_OK + (size_t)NT * 128 * 2;
constexpr size_t WS_WRT = 250 * MiB, WS_SL = 252 * MiB;
constexpr size_t WRT_STRIDE = 768 * 1024;
constexpr size_t WS_RSS = 253 * MiB;
constexpr size_t WS_BI = WS_RSS + 128 * 1024;
constexpr size_t WS_WINOF = WS_R3 + 48 * MiB;
static_assert(WS_WINOF + (size_t)5 * 1280 * 1024 * 2 <= WS_R3 + R3_END && WS_BI + 5 * 1280 * 4 <= 254 * MiB && WS_WRT + 2 * WRT_STRIDE <= WS_SL, "fold buffers");

__device__ __forceinline__ void ph_prologue(const Ptrs& P, LAS unsigned char* smem, int bid, int nblk) {
    const int lane = threadIdx.x & 63, wave = threadIdx.x >> 6;
    LAS float* scr = (LAS float*)smem + wave * 64 * 33;
    const int gw = bid * 4 + wave, NGW = nblk * 4;
    unsigned char* ws = P.ws;
    constexpr int I_WINE = 16 * 73, I_SQ = 16 * 32, I_WINO = 16 * 40, I_EXP_GU = 16 * 8, I_EXP_D = 4 * 32;
    constexpr int T_WINE = I_WINE, T_WOUTE = T_WINE + I_SQ, T_WINO = T_WOUTE + I_WINO, T_WOUTO = T_WINO + I_SQ,
                  T_G = T_WOUTO + 32 * I_EXP_GU, T_U = T_G + 32 * I_EXP_GU, T_D = T_U + 32 * I_EXP_D;
    for (int it = gw; it < T_D; it += NGW) {
        if (it < T_WINE) {
            int kb = it / 73, nb = it % 73, n0 = nb * 32;
            int dst = n0 < 1536 ? n0 : (n0 < 1568 ? n0 + 768 : n0 - 32);
            transpose_item(P.in[8], 1024, EVEN_IN, (bf16*)(ws + WS_WINE), dst, kb * 64, n0, scr, lane);
        } else if (it < T_WOUTE) { int r = it - T_WINE; transpose_item(P.in[9], 1024, 1024, (bf16*)(ws + WS_WOUTE), (r % 32) * 32, (r / 32) * 64, (r % 32) * 32, scr, lane); }
        else if (it < T_WINO) { int r = it - T_WOUTE; transpose_item(P.in[15], 1024, 1280, (bf16*)(ws + WS_WINO), (r % 40) * 32, (r / 40) * 64, (r % 40) * 32, scr, lane); }
        else if (it < T_WOUTO) { int r = it - T_WINO; transpose_item(P.in[16], 1024, 1024, (bf16*)(ws + WS_WOUTO), (r % 32) * 32, (r / 32) * 64, (r % 32) * 32, scr, lane); }
        else if (it < T_U) {
            bool up = it >= T_G; int r = it - (up ? T_G : T_WOUTO); int le = r / I_EXP_GU; r %= I_EXP_GU; int kb = r / 8, hb = r % 8;
            const float* W = (up ? P.in[25] : P.in[24]) + (size_t)le * 1024 * 256;
            transpose_item(W, 1024, 256, (bf16*)(ws + WS_WGU) + (size_t)le * 512 * 1024, 64 * hb + (up ? 32 : 0), kb * 64, hb * 32, scr, lane);
        } else {
            int r = it - T_U; int le = r / I_EXP_D; r %= I_EXP_D; int kb = r / 32, nb = r % 32;
            transpose_item(P.in[26] + (size_t)le * 256 * 1024, 256, 1024, (bf16*)(ws + WS_WD) + (size_t)le * 1024 * 256, nb * 32, kb * 64, nb * 32, scr, lane);
        }
    }
    { u32x4 z = {0, 0, 0, 0}; u32x4* p = (u32x4*)((bf16*)(ws + WS_WINE) + (size_t)EVEN_IN * 1024);
      for (int i = bid * 256 + threadIdx.x; i < 96 * 1024 * 2 / 16; i += nblk * 256) p[i] = z; }
    for (int i = bid * 256 + threadIdx.x; i < 1024; i += nblk * 256) {
        int pos = i >> 4, f = i & 15; float inv = powf(10000.f, -(float)(2 * f) / 32.f); float ang = (float)pos * inv;
        ((float2*)(ws + WS_ROPE))[i] = make_float2(cosf(ang), sinf(ang));
    }
    for (int i = bid * 256 + threadIdx.x; i < NT; i += nblk * 256) ((float*)(ws + WS_RSS))[i] = 0.f;
    if (bid == 0 && threadIdx.x < 2) {
        const float* gq = threadIdx.x ? P.in[18] : P.in[13]; const float* gk = threadIdx.x ? P.in[19] : P.in[14];
        float mq = 0.f, mk = 0.f; for (int d = 0; d < 64; ++d) { mq = fmaxf(mq, fabsf(gq[d])); mk = fmaxf(mk, fabsf(gk[d])); }
        ((float*)(ws + WS_ROPE + 8192))[threadIdx.x] = 8.f * mq * mk * 1.4426950408889634f;
    }
    __syncthreads();
    {
        LAS float* sc = (LAS float*)smem;
        LAS float* red = (LAS float*)smem + 5 * 1024;
        for (int i = threadIdx.x; i < 5 * 1024; i += 256) { const float cv = i < 4096 ? P.in[1][i] : P.in[3][i - 4096]; sc[i] = cv / (1.f + expf(-cv)); }
        __syncthreads();
        for (int it = bid; it < 2 * 96; it += nblk) {
            const int layer = it / 96, col = (it % 96) * 64 + lane;
            const float* w = P.in[4] + (size_t)layer * D * 6144 + col;
            float a0 = 0.f, a1 = 0.f, a2 = 0.f, a3 = 0.f, a4 = 0.f;
#pragma unroll 32
            for (int k = 256 * wave; k < 256 * wave + 256; ++k) { const float wv = w[(size_t)k * 6144]; a0 += sc[k] * wv; a1 += sc[1024 + k] * wv; a2 += sc[2048 + k] * wv; a3 += sc[3072 + k] * wv; a4 += sc[4096 + k] * wv; }
            red[(wave * 5 + 0) * 64 + lane] = a0; red[(wave * 5 + 1) * 64 + lane] = a1; red[(wave * 5 + 2) * 64 + lane] = a2; red[(wave * 5 + 3) * 64 + lane] = a3; red[(wave * 5 + 4) * 64 + lane] = a4;
            __syncthreads();
            for (int i = threadIdx.x; i < 320; i += 256) { const int row = i >> 6, cl = i & 63;
                ((float*)(ws + WS_MODV))[((size_t)layer * 5 + row) * 6144 + (it % 96) * 64 + cl] = red[row * 64 + cl] + red[(5 + row) * 64 + cl] + red[(10 + row) * 64 + cl] + red[(15 + row) * 64 + cl] + P.in[5][layer * 6144 + (it % 96) * 64 + cl]; }
            __syncthreads();
        }
    }
}

template <bool SRC_BF>
__device__ __forceinline__ void modulate_rows(const float* xlat, const float* xctx, const bf16* xs, const float* modv_layer, const float* gain, int which, bf16* H, int nrows, int gw, int NGW, int lane) {
    for (int row = gw; row < nrows; row += NGW) {
        const float* mv = modv_layer + (size_t)(row < NL ? row / S : 4) * 6144;
        f32x4 v[4]; float ss = 0.f;
#pragma unroll
        for (int j = 0; j < 4; ++j) {
            if (SRC_BF) { const u32x2 w = *(const u32x2*)(xs + (size_t)row * D + 4 * lane + 256 * j); f32x4 t = {__uint_as_float(w.x << 16), __uint_as_float(w.x & 0xffff0000u), __uint_as_float(w.y << 16), __uint_as_float(w.y & 0xffff0000u)}; v[j] = t; }
            else { const float* xr = row < NL ? xlat + (size_t)row * D : xctx + (size_t)(row - NL) * D; v[j] = *(const f32x4*)(xr + 4 * lane + 256 * j); }
            ss += v[j].x * v[j].x + v[j].y * v[j].y + v[j].z * v[j].z + v[j].w * v[j].w;
        }
        float rstd = rsqrtf(wave_sum(ss) / D + EPS);
#pragma unroll
        for (int j = 0; j < 4; ++j) {
            int k = 4 * lane + 256 * j;
            f32x4 g = *(const f32x4*)(gain + k), sc = *(const f32x4*)(mv + (which + 1) * 1024 + k), sh = *(const f32x4*)(mv + which * 1024 + k);
            float h0 = v[j].x * rstd * g.x * (1.f + sc.x) + sh.x, h1 = v[j].y * rstd * g.y * (1.f + sc.y) + sh.y;
            float h2 = v[j].z * rstd * g.z * (1.f + sc.z) + sh.z, h3 = v[j].w * rstd * g.w * (1.f + sc.w) + sh.w;
            u32x2 o = {pk2(h0, h1), pk2(h2, h3)};
            *(u32x2*)(H + (size_t)row * D + k) = o;
        }
    }
}
__device__ __forceinline__ void route_tables(const Ptrs& P, int layer, int bid, int nblk);
__device__ __forceinline__ void ph_modulate(const Ptrs& P, int layer, int bid, int nblk) {
    route_tables(P, layer, bid, nblk);
    if (layer == 0) modulate_rows<false>(P.in[0], P.in[2], nullptr, (const float*)(P.ws + WS_MODV), P.in[6], 0, (bf16*)(P.ws + WS_R1), NT, bid * 4 + (threadIdx.x >> 6), nblk * 4, threadIdx.x & 63);
    else modulate_rows<true>(nullptr, nullptr, (const bf16*)(P.ws + WS_R4), (const float*)(P.ws + WS_MODV) + (size_t)5 * 6144, P.in[6] + D, 0, (bf16*)(P.ws + WS_R1), NT, bid * 4 + (threadIdx.x >> 6), nblk * 4, threadIdx.x & 63);
}

struct AffineRows {
    const bf16* base; size_t ld; int w; unsigned vo[4];
    __device__ __forceinline__ AffineRows(const bf16* b, size_t ld_) : base(b), ld(ld_), w(0) {}
    __device__ __forceinline__ void init(int w_, int rl, const int (&co)[4]) { w = w_;
#pragma unroll
        for (int i = 0; i < 4; ++i) vo[i] = (unsigned)((rl * ld + co[i]) * 2); }
    __device__ __forceinline__ const bf16* sb(int i, int kt) const { return base + (size_t)(32 * w + 8 * i) * ld + kt * 64; }
};
template <bool SWP, class AF, class BF, class Epi>
__device__ __forceinline__ void gemm_tile(AF af, BF bf, int nk, LAS unsigned char* smem, const Epi& epi) {
    const int tid = threadIdx.x, lane = tid & 63, wave = __builtin_amdgcn_readfirstlane(tid >> 6), wn = wave & 1, wm = wave >> 1, l31 = lane & 31, hh = lane >> 5;
    const int r0 = wave * 32 + (lane >> 3);
    __syncthreads();
    typename Epi::Pre pre; epi.prefetch(pre, wn * 64, wm * 64, l31, hh);
    __builtin_amdgcn_sched_barrier(0);
    int coff[4];
#pragma unroll
    for (int i = 0; i < 4; ++i) coff[i] = ((lane & 7) ^ (((r0 >> 1) + 4 * i) & 7)) * 8;
    af.init(wave, lane >> 3, coff); bf.init(wave, lane >> 3, coff);
#define GT_STAGE(st, kt) do { _Pragma("unroll") for (int i = 0; i < 4; ++i) { \
        __builtin_amdgcn_global_load_lds((const unsigned*)((const char*)af.sb(i, (kt)) + af.vo[i]), (LAS unsigned*)(smem + (st) * 2 * TILE_LDS + (wave * 4 + i) * 1024), 16, 0, 0); \
        __builtin_amdgcn_global_load_lds((const unsigned*)((const char*)bf.sb(i, (kt)) + bf.vo[i]), (LAS unsigned*)(smem + (st) * 2 * TILE_LDS + TILE_LDS + (wave * 4 + i) * 1024), 16, 0, 0); } } while (0)
    GT_STAGE(0, 0);
    f32x16 acc[2][2];
#pragma unroll
    for (int i = 0; i < 2; ++i)
#pragma unroll
        for (int j = 0; j < 2; ++j)
#pragma unroll
            for (int r = 0; r < 16; ++r) acc[i][j][r] = 0.f;
    const int sw = (l31 >> 1) & 7;
    int xo[4], wo[4];
#pragma unroll
    for (int s = 0; s < 4; ++s) { const int cs = ((2 * s + hh) ^ sw) * 16; xo[s] = (wm * 64 + l31) * 128 + cs; wo[s] = TILE_LDS + (wn * 64 + l31) * 128 + cs; }
    asm volatile("s_waitcnt vmcnt(0)" ::: "memory");
    __syncthreads();
    for (int kt = 0; kt < nk; ++kt) {
        const int st = kt & 1;
        if (kt + 1 < nk) GT_STAGE(st ^ 1, kt + 1);
        LAS unsigned char* sb = smem + st * 2 * TILE_LDS;
#pragma unroll
        for (int s = 0; s < 4; ++s) {
            bf16x8 wf[2], xf[2];
#pragma unroll
            for (int i = 0; i < 2; ++i) wf[i] = *(LAS bf16x8*)(sb + wo[s] + i * 4096);
#pragma unroll
            for (int j = 0; j < 2; ++j) xf[j] = *(LAS bf16x8*)(sb + xo[s] + j * 4096);
#pragma unroll
            for (int i = 0; i < 2; ++i)
#pragma unroll
                for (int j = 0; j < 2; ++j) acc[i][j] = SWP ? __builtin_amdgcn_mfma_f32_32x32x16_bf16(xf[j], wf[i], acc[i][j], 0, 0, 0)
                                                            : __builtin_amdgcn_mfma_f32_32x32x16_bf16(wf[i], xf[j], acc[i][j], 0, 0, 0);
        }
        asm volatile("s_waitcnt vmcnt(0)" ::: "memory");
        __syncthreads();
    }
#undef GT_STAGE
    { int l31e = l31, hhe = hh, we = wave; asm volatile("" : "+v"(l31e), "+v"(hhe), "+v"(we));
      epi(acc, (we & 1) * 64, (we >> 1) * 64, l31e, hhe, smem + we * 16384, pre); }
}

constexpr int SG_P = 144;
__device__ __forceinline__ void store_bf16_T(const f32x16 (&acc)[2][2], bf16* out, size_t ld, size_t trow0, int col0, int l31, int hh, LAS unsigned char* wl) {
#pragma unroll
    for (int j = 0; j < 2; ++j)
#pragma unroll
        for (int i = 0; i < 2; ++i)
#pragma unroll
            for (int g = 0; g < 4; ++g) { u32x2 v = {pk2(acc[i][j][4 * g], acc[i][j][4 * g + 1]), pk2(acc[i][j][4 * g + 2], acc[i][j][4 * g + 3])}; *(LAS u32x2*)(wl + (32 * j + l31) * SG_P + (32 * i + 8 * g + 4 * hh) * 2) = v; }
    const int lane = l31 + 32 * hh, rr = lane >> 3, ch = lane & 7;
#pragma unroll
    for (int q = 0; q < 8; ++q) { const int R = 8 * q + rr; const u32x4 v = *(LAS u32x4*)(wl + R * SG_P + ch * 16); *(u32x4*)(out + (trow0 + R) * ld + col0 + ch * 8) = v; }
}
__device__ __forceinline__ void qknorm_rope_T(f32x16 (&acc)[2][2], const float* gain, const float2* ropeT, bool latent, int tok0  , int l31, int hh, float oscale = 1.f) {
#pragma unroll
    for (int j = 0; j < 2; ++j) {
        float ss = 0.f;
#pragma unroll
        for (int i = 0; i < 2; ++i)
#pragma unroll
            for (int r = 0; r < 16; ++r) ss += acc[i][j][r] * acc[i][j][r];
        ss = xhalf_sum(ss);
        const float rstd = rsqrtf(ss * (1.f / 64.f) + EPS) * oscale;
#pragma unroll
        for (int i = 0; i < 2; ++i)
#pragma unroll
            for (int r = 0; r < 16; ++r) acc[i][j][r] *= rstd * gain[i * 32 + (r & 3) + 8 * (r >> 2) + 4 * hh];
        if (latent) {
            const int t = tok0 + j * 32 + l31;
#pragma unroll
            for (int i = 0; i < 2; ++i) {
                const int pos = i == 0 ? (t >> 6) : (t & 63);
#pragma unroll
                for (int r = 0; r < 8; ++r) {
                    const int f = (r & 3) + 8 * (r >> 2) + 4 * hh;
                    const float2 cs = ropeT[pos * 16 + f];
                    const float x1 = acc[i][j][r], x2 = acc[i][j][r + 8];
                    acc[i][j][r] = x1 * cs.x - x2 * cs.y; acc[i][j][r + 8] = x2 * cs.x + x1 * cs.y;
                }
            }
        }
    }
}

constexpr int VT_LD = S + CL;
__device__ __forceinline__ void store_vt_swapped(const f32x16 (&acc)[2][2], bf16* vt_head  , int key0, int l31, int hh, LAS unsigned char* wl) {
#pragma unroll
    for (int i = 0; i < 2; ++i)
#pragma unroll
        for (int j = 0; j < 2; ++j)
#pragma unroll
            for (int g = 0; g < 4; ++g) { u32x2 v = {pk2(acc[i][j][4 * g], acc[i][j][4 * g + 1]), pk2(acc[i][j][4 * g + 2], acc[i][j][4 * g + 3])}; *(LAS u32x2*)(wl + (32 * i + l31) * SG_P + (32 * j + 8 * g + 4 * hh) * 2) = v; }
    const int lane = l31 + 32 * hh, rr = lane >> 3, ch = lane & 7;
#pragma unroll
    for (int q = 0; q < 8; ++q) { const int R = 8 * q + rr; const u32x4 v = *(LAS u32x4*)(wl + R * SG_P + ch * 16); *(u32x4*)(vt_head + (size_t)R * VT_LD + key0 + ch * 8) = v; }
}
struct NoPre {};
template <bool SRC_BF> struct RmwPre { f32x4 xi[16]; };
template <> struct RmwPre<true> { u32x2 xi[16]; };
template <bool SRC_BF, class RowF>
__device__ __forceinline__ void rmw_prefetch(RmwPre<SRC_BF>& pre, const RowF& rowf, int l31, int hh) {
    const int lane = l31 + 32 * hh, rr = lane >> 4, ch = lane & 15;
#pragma unroll
    for (int q = 0; q < 16; ++q) {
        const void* sp; void* dp; const float* gp; int tk;
        if (rowf(4 * q + rr, sp, dp, gp, tk)) {
            if constexpr (SRC_BF) pre.xi[q] = *(const u32x2*)((const bf16*)sp + ch * 4); else pre.xi[q] = *(const f32x4*)((const float*)sp + ch * 4);
        }
    }
}
template <bool SRC_BF, bool DST_BF, bool SS, class RowF>
__device__ __forceinline__ void rmw_finish(const f32x16 (&acc)[2][2], const RmwPre<SRC_BF>& pre, const RowF& rowf, int l31, int hh, LAS unsigned char* wl, float* rss = nullptr) {
    const int lane = l31 + 32 * hh, rr = lane >> 4, ch = lane & 15;
#pragma unroll
    for (int j = 0; j < 2; ++j)
#pragma unroll
        for (int i = 0; i < 2; ++i)
#pragma unroll
            for (int g = 0; g < 4; ++g) { f32x4 v = {acc[i][j][4 * g], acc[i][j][4 * g + 1], acc[i][j][4 * g + 2], acc[i][j][4 * g + 3]};
                const int R = 32 * j + l31; *(LAS f32x4*)(wl + R * 256 + (((8 * i + 2 * g + hh) ^ (R & 15)) * 16)) = v; }
    float ssr[16];
#pragma unroll
    for (int q = 0; q < 16; ++q) {
        const void* sp; void* dp; const float* gp; int tk = 0;
        const bool ok = rowf(4 * q + rr, sp, dp, gp, tk);
        float ssq = 0.f;
        if (ok) {
            f32x4 x;
            if constexpr (SRC_BF) { const u32x2 w = pre.xi[q]; f32x4 t = {__uint_as_float(w.x << 16), __uint_as_float(w.x & 0xffff0000u), __uint_as_float(w.y << 16), __uint_as_float(w.y & 0xffff0000u)}; x = t; } else x = pre.xi[q];
            const int R = 4 * q + rr; const f32x4 a = *(LAS f32x4*)(wl + R * 256 + ((ch ^ (R & 15)) * 16)); const f32x4 gt = *(const f32x4*)(gp + ch * 4);
            const f32x4 v = {x.x + gt.x * a.x, x.y + gt.y * a.y, x.z + gt.z * a.z, x.w + gt.w * a.w};
            if (DST_BF) { u32x2 o = {pk2(v.x, v.y), pk2(v.z, v.w)}; *(u32x2*)((bf16*)dp + ch * 4) = o;
                if (SS) { const float r0 = __uint_as_float(o.x << 16), r1 = __uint_as_float(o.x & 0xffff0000u), r2 = __uint_as_float(o.y << 16), r3 = __uint_as_float(o.y & 0xffff0000u); ssq = (r0 * r0 + r1 * r1) + (r2 * r2 + r3 * r3); } }
            else *(f32x4*)((float*)dp + ch * 4) = v;
        }
        if (SS) { ssq += __shfl_xor(ssq, 1); ssq += __shfl_xor(ssq, 2); ssq += __shfl_xor(ssq, 4); ssq += __shfl_xor(ssq, 8); ssr[q] = ssq; }
    }
    if (SS) {
        if (ch == 0) {
#pragma unroll
            for (int q = 0; q < 16; ++q) *(LAS float*)(wl + (4 * q + rr) * 4) = ssr[q];
        }
        const float sv = *(LAS float*)(wl + lane * 4);
        const void* sp; void* dp; const float* gp; int tk = 0;
        if (rowf(lane, sp, dp, gp, tk)) atomicAdd(rss + tk, sv);
    }
}
struct EpiEvenIn {
    typedef NoPre Pre;
    __device__ __forceinline__ void prefetch(Pre&, int, int, int, int) const {}
    unsigned char* r3; const float* qn; const float* kn; const float2* ropeT; int mt, nt;
    __device__ __forceinline__ bool swapped() const { return nt == 17 || (nt >= 4 && nt < 8); }
    __device__ __forceinline__ void operator()(f32x16 (&acc)[2][2], int fb, int tb, int l31, int hh, LAS unsigned char* wl, const Pre& pre) const {
        const size_t trow0 = (size_t)mt * 128 + tb; const bool latent = mt < NL / 128; const int tok0 = (int)(trow0 & (S - 1));
        if (swapped()) {
            const int b = latent ? (int)(trow0 / S) : (int)((trow0 - NL) / CL); const int key0 = latent ? tok0 : S + (int)((trow0 - NL) % CL);
            const size_t off = nt == 17 ? R3_AV + (size_t)(b * 2 + fb / 64) * 64 * VT_LD * 2 : R3_GV + ((size_t)(b * 4 + nt - 4) * 128 + fb) * VT_LD * 2;
            store_vt_swapped(acc, (bf16*)(r3 + off), key0, l31, hh, wl);
        } else if (nt == 18) {
            if (fb == 0) {
                float* LR = (float*)(r3 + R3_LR);
#pragma unroll
                for (int j = 0; j < 2; ++j)
#pragma unroll
                    for (int g = 0; g < 4; ++g) { f32x4 v = {acc[0][j][4 * g], acc[0][j][4 * g + 1], acc[0][j][4 * g + 2], acc[0][j][4 * g + 3]}; *(f32x4*)(LR + (trow0 + j * 32 + l31) * 32 + 8 * g + 4 * hh) = v; }
            }
        } else {
            size_t off; int ld, col;
            if (nt < 2) { off = R3_GQ; ld = 256; col = nt * 128; }
            else if (nt < 4) { off = R3_GK; ld = 256; col = (nt - 2) * 128; }
            else if (nt < 12) { off = R3_GR; ld = 512; col = (nt - 8) * 128; }
            else if (nt < 16) { off = R3_AQ; ld = 512; col = (nt - 12) * 128; }
            else { off = R3_AK; ld = 128; col = 0; }
            if (nt >= 12) qknorm_rope_T(acc, nt < 16 ? qn : kn, ropeT, latent, tok0, l31, hh, nt < 16 ? QSCALE : 1.f);
            store_bf16_T(acc, (bf16*)(r3 + off), ld, trow0, col + fb, l31, hh, wl);
        }
    }
};
__device__ __forceinline__ int xcd_vid(int bid, int nb) { return (nb % 8 == 0) ? (bid % 8) * (nb / 8) + bid / 8 : bid; }

__device__ __forceinline__ void ph_even_inproj(const Ptrs& P, LAS unsigned char* smem, int bid, int nblk) {
    unsigned char* ws = P.ws;
    const int lrow = threadIdx.x >> 3, kc = threadIdx.x & 7;
    const int vid = xcd_vid(bid, nblk);
    for (int tile = vid; tile < (NT / 128) * 19; tile += nblk) {
        const int mt = tile / 19, nt = tile % 19;
        AffineRows af((const bf16*)(ws + WS_R1) + (size_t)mt * 128 * D, D);
        AffineRows bf_((const bf16*)(ws + WS_WINE) + (size_t)nt * 128 * D, D);
        EpiEvenIn epi{ws + WS_R3, P.in[13], P.in[14], (const float2*)(ws + WS_ROPE), mt, nt};
        if (epi.swapped()) gemm_tile<true>(af, bf_, D / 64, smem, epi); else gemm_tile<false>(af, bf_, D / 64, smem, epi);
    }
}

template <int LAYER>
struct EpiOutProj {
    typedef RmwPre<LAYER != 0> Pre;
    const float* modv_layer; const float* xin_lat; const float* xin_ctx; bf16* xs; int mt, nt;
    __device__ __forceinline__ bool swapped() const { return false; }
    __device__ __forceinline__ auto rowfn(int fb, int tb) const {
        const size_t trow0 = (size_t)mt * 128 + tb; const bool latent = mt < NL / 128;
        const int c0 = nt * 128 + fb;
        const float* gate = modv_layer + (size_t)(latent ? trow0 / S : 4) * 6144 + 2 * 1024 + c0;
        bf16* xo = xs + trow0 * D + c0;
        const float* xin = LAYER == 0 ? (latent ? xin_lat + trow0 * D : xin_ctx + (trow0 - NL) * D) + c0 : nullptr;
        return [=](int R, const void*& sp, void*& dp, const float*& gp, int& tk) { if (LAYER == 0) sp = xin + (size_t)R * D; else sp = xo + (size_t)R * D; dp = xo + (size_t)R * D; gp = gate; tk = (int)trow0 + R; return true; };
    }
    __device__ __forceinline__ void prefetch(Pre& pre, int fb, int tb, int l31, int hh) const { rmw_prefetch<LAYER != 0>(pre, rowfn(fb, tb), l31, hh); }
    __device__ __forceinline__ void operator()(f32x16 (&acc)[2][2], int fb, int tb, int l31, int hh, LAS unsigned char* wl, const Pre& pre) const {
        rmw_finish<LAYER != 0, true, false>(acc, pre, rowfn(fb, tb), l31, hh, wl);
    }
};
__device__ __forceinline__ void ph_outproj(const Ptrs& P, LAS unsigned char* smem, int bid, int nblk, int layer, int nrows) {
    unsigned char* ws = P.ws;
    const int lrow = threadIdx.x >> 3, kc = threadIdx.x & 7;
    const int vid = xcd_vid(bid, nblk);
    const float* modv_layer = (const float*)(ws + WS_MODV) + (size_t)layer * 5 * 6144;
    for (int tile = vid; tile < (nrows / 128) * 8; tile += nblk) {
        const int mt = tile / 8, nt = tile % 8;
        AffineRows af((const bf16*)(ws + WS_R2) + (size_t)mt * 128 * D, D);
        AffineRows bf_((const bf16*)(ws + (layer ? WS_WOUTO : WS_WOUTE)) + (size_t)nt * 128 * D, D);
        if (layer == 0) { EpiOutProj<0> epi{modv_layer, P.in[0], P.in[2], (bf16*)(ws + WS_R4), mt, nt}; gemm_tile<false>(af, bf_, D / 64, smem, epi); }
        else { EpiOutProj<1> epi{modv_layer, nullptr, nullptr, (bf16*)(ws + WS_R4), mt, nt}; gemm_tile<false>(af, bf_, D / 64, smem, epi); }
    }
}

struct EpiOddIn {
    typedef NoPre Pre;
    __device__ __forceinline__ void prefetch(Pre&, int, int, int, int) const {}
    unsigned char* r3; const float* qn; const float* kn; const float2* ropeT; const float* rss; const float* bi; int mt, nt;
    __device__ __forceinline__ bool swapped() const { return nt == 9; }
    __device__ __forceinline__ void operator()(f32x16 (&acc)[2][2], int fb, int tb, int l31, int hh, LAS unsigned char* wl, const Pre& pre) const {
        const size_t trow0 = (size_t)mt * 128 + tb; const bool latent = mt < NL / 128; const int tok0 = (int)(trow0 & (S - 1));
        if (!swapped()) {
#pragma unroll
            for (int j = 0; j < 2; ++j) {
                const float rs = rsqrtf(rss[trow0 + 32 * j + l31] * (1.f / D) + EPS);
#pragma unroll
                for (int i = 0; i < 2; ++i)
#pragma unroll
                    for (int g = 0; g < 4; ++g) { const f32x4 b4 = *(const f32x4*)(bi + nt * 128 + fb + 32 * i + 8 * g + 4 * hh);
                        acc[i][j][4 * g] = acc[i][j][4 * g] * rs + b4.x; acc[i][j][4 * g + 1] = acc[i][j][4 * g + 1] * rs + b4.y; acc[i][j][4 * g + 2] = acc[i][j][4 * g + 2] * rs + b4.z; acc[i][j][4 * g + 3] = acc[i][j][4 * g + 3] * rs + b4.w; }
            }
        } else {
#pragma unroll
            for (int j = 0; j < 2; ++j)
#pragma unroll
                for (int g = 0; g < 4; ++g) { const f32x4 q4 = *(const f32x4*)(rss + trow0 + 32 * j + 8 * g + 4 * hh);
                    const float r0 = rsqrtf(q4.x * (1.f / D) + EPS), r1 = rsqrtf(q4.y * (1.f / D) + EPS), r2 = rsqrtf(q4.z * (1.f / D) + EPS), r3_ = rsqrtf(q4.w * (1.f / D) + EPS);
#pragma unroll
                    for (int i = 0; i < 2; ++i) { const float bb = bi[nt * 128 + fb + 32 * i + l31];
                        acc[i][j][4 * g] = acc[i][j][4 * g] * r0 + bb; acc[i][j][4 * g + 1] = acc[i][j][4 * g + 1] * r1 + bb; acc[i][j][4 * g + 2] = acc[i][j][4 * g + 2] * r2 + bb; acc[i][j][4 * g + 3] = acc[i][j][4 * g + 3] * r3_ + bb; } }
        }
        if (nt < 8) { if (latent) { qknorm_rope_T(acc, qn, ropeT, true, tok0, l31, hh, QSCALE); store_bf16_T(acc, (bf16*)(r3 + R3_OQ), 1024, trow0, nt * 128 + fb, l31, hh, wl); } }
        else if (nt == 8) { qknorm_rope_T(acc, kn, ropeT, latent, tok0, l31, hh); store_bf16_T(acc, (bf16*)(r3 + R3_OK), 128, trow0, fb, l31, hh, wl); }
        else {
            const int b = latent ? (int)(trow0 / S) : (int)((trow0 - NL) / CL); const int key0 = latent ? tok0 : S + (int)((trow0 - NL) % CL);
            store_vt_swapped(acc, (bf16*)(r3 + R3_OV) + (size_t)(b * 2 + fb / 64) * 64 * VT_LD, key0, l31, hh, wl);
        }
    }
};
__device__ __forceinline__ void ph_odd_inproj(const Ptrs& P, LAS unsigned char* smem, int bid, int nblk) {
    unsigned char* ws = P.ws;
    const int lrow = threadIdx.x >> 3, kc = threadIdx.x & 7;
    const int vid = xcd_vid(bid, nblk);
    constexpr int T_LAT = (NL / 128) * 10, T_ALL = T_LAT + (NC / 128) * 2;
    for (int tile = vid; tile < T_ALL; tile += nblk) {
        int mt, nt;
        if (tile < T_LAT) { mt = tile / 10; nt = tile % 10; } else { mt = NL / 128 + (tile - T_LAT) / 2; nt = 8 + (tile - T_LAT) % 2; }
        const int brow = mt < NL / 128 ? mt / (S / 128) : 4;
        AffineRows af((const bf16*)(ws + WS_R4) + (size_t)mt * 128 * D, D);
        AffineRows bf_((const bf16*)(ws + WS_WINOF) + ((size_t)brow * 1280 + nt * 128) * D, D);
        EpiOddIn epi{ws + WS_R3, P.in[18], P.in[19], (const float2*)(ws + WS_ROPE), (const float*)(ws + WS_RSS), (const float*)(ws + WS_BI) + brow * 1280, mt, nt};
        if (epi.swapped()) gemm_tile<true>(af, bf_, D / 64, smem, epi); else gemm_tile<false>(af, bf_, D / 64, smem, epi);
    }
}

constexpr int AT_KP = 144, AT_VP = 136;
constexpr int AT_STAGE = 64 * AT_KP + 64 * AT_VP;
constexpr int ATTN_LDS = 2 * AT_STAGE;
struct AttnArgs {
    const bf16* Q; int ldq; size_t qrow0; int qcol;
    const bf16* K; size_t klat0, kctx0;
    const bf16* Vt;
    int nctx, tlo, nlat;
    int banded, tq0;
    float sink_l2;
    float m0;
    bf16* out;
};
__device__ __forceinline__ float xhalf_max(float x) {
    auto t = __builtin_amdgcn_permlane32_swap(__float_as_uint(x), __float_as_uint(x), false, false);
    return fmaxf(__uint_as_float(t[0]), __uint_as_float(t[1]));
}
__device__ __forceinline__ void attn_block(const AttnArgs& a, LAS unsigned char* smem) {
    int tid_ = threadIdx.x; asm volatile("" : "+v"(tid_));
    const int tid = tid_, lane = tid & 63, wave = tid >> 6, l31 = lane & 31, hh = lane >> 5;
    bf16x8 qf[4];
    { const bf16* qp = a.Q + (a.qrow0 + wave * 32 + l31) * a.ldq + a.qcol + hh * 8;
#pragma unroll
      for (int s = 0; s < 4; ++s) qf[s] = *(const bf16x8*)(qp + 16 * s); }
    f32x16 o[2], minit;
#pragma unroll
    for (int r = 0; r < 16; ++r) { o[0][r] = 0.f; o[1][r] = 0.f; minit[r] = -a.m0; }
    float ls0 = 0.f, ls1 = 0.f, ls2 = 0.f, ls3 = 0.f;
    const int ntile = a.nctx + a.nlat;
    const int lr0 = tid >> 3, kc = tid & 7;
    const bf16* kbase = a.K + (size_t)lr0 * 128 + kc * 8;
    const bf16* vbase = a.Vt + (size_t)lr0 * VT_LD + kc * 8;
    const int kwoff = lr0 * AT_KP + kc * 16, vwoff = 64 * AT_KP + lr0 * AT_VP + kc * 16;
    const int kroff = l31 * AT_KP + hh * 16, vroff = 64 * AT_KP + l31 * AT_VP + hh * 8;
    u32x4 rk[2], rv[2];
#define AT_ISSUE(n) do { const int t_ = (n) < a.nctx ? 64 + (n) : a.tlo + (n) - a.nctx; \
        const size_t kr_ = (t_ < 64 ? a.klat0 + 64 * t_ : a.kctx0 + 64 * (t_ - 64)); \
        _Pragma("unroll") for (int i = 0; i < 2; ++i) { rk[i] = *(const u32x4*)(kbase + (kr_ + 32 * i) * 128); rv[i] = *(const u32x4*)(vbase + (size_t)(32 * i) * VT_LD + 64 * t_); } } while (0)
#define AT_COMMIT(ST) do { LAS unsigned char* sb_ = smem + (ST) * AT_STAGE; \
        _Pragma("unroll") for (int i = 0; i < 2; ++i) { *(LAS u32x4*)(sb_ + kwoff + i * 32 * AT_KP) = rk[i]; \
            u32x2 lo_ = {rv[i].x, rv[i].y}, hi_ = {rv[i].z, rv[i].w}; *(LAS u32x2*)(sb_ + vwoff + i * 32 * AT_VP) = lo_; *(LAS u32x2*)(sb_ + vwoff + i * 32 * AT_VP + 8) = hi_; } } while (0)
#define AT_BODY(ST, n) do { \
        if ((n) + 1 < ntile) AT_ISSUE((n) + 1); \
        __builtin_amdgcn_sched_barrier(0); \
        LAS unsigned char* sb = smem + (ST) * AT_STAGE; \
        bool skip = false; \
        if (a.banded && (n) >= a.nctx) { const int k0 = 64 * (a.tlo + (n) - a.nctx), q0w = a.tq0 + wave * 32; skip = (k0 + 63 < q0w - 128) || (k0 > q0w + 31 + 128); } \
        if (!skip) { \
            f32x16 sc[2]; \
            _Pragma("unroll") for (int kt = 0; kt < 2; ++kt) { \
                _Pragma("unroll") for (int s = 0; s < 4; ++s) { \
                    const bf16x8 kf = *(LAS bf16x8*)(sb + kroff + kt * 32 * AT_KP + s * 32); \
                    sc[kt] = __builtin_amdgcn_mfma_f32_32x32x16_bf16(kf, qf[s], s == 0 ? minit : sc[kt], 0, 0, 0); } } \
            bf16x8 vfr[2][2][2]; \
            _Pragma("unroll") for (int kt = 0; kt < 2; ++kt) _Pragma("unroll") for (int s2 = 0; s2 < 2; ++s2) _Pragma("unroll") for (int dt = 0; dt < 2; ++dt) { \
                LAS unsigned char* vp = sb + vroff + dt * 32 * AT_VP + (32 * kt + 16 * s2) * 2; \
                const u32x2 v0 = *(LAS u32x2*)vp, v1 = *(LAS u32x2*)(vp + 16); u32x4 vw = {v0.x, v0.y, v1.x, v1.y}; vfr[kt][s2][dt] = __builtin_bit_cast(bf16x8, vw); } \
            if (a.banded && (n) >= a.nctx) { \
                const int dbase = 64 * (a.tlo + (n) - a.nctx) + 4 * hh - (a.tq0 + wave * 32 + l31); \
                _Pragma("unroll") for (int kt = 0; kt < 2; ++kt) _Pragma("unroll") for (int r = 0; r < 16; ++r) { const int df = dbase + 32 * kt + (r & 3) + 8 * (r >> 2); if (df > 128 || df < -128) sc[kt][r] = -1e30f; } } \
            _Pragma("unroll") for (int kt = 0; kt < 2; ++kt) _Pragma("unroll") for (int r = 0; r < 16; r += 4) { \
                sc[kt][r] = __builtin_amdgcn_exp2f(sc[kt][r]); ls0 += sc[kt][r]; sc[kt][r + 1] = __builtin_amdgcn_exp2f(sc[kt][r + 1]); ls1 += sc[kt][r + 1]; \
                sc[kt][r + 2] = __builtin_amdgcn_exp2f(sc[kt][r + 2]); ls2 += sc[kt][r + 2]; sc[kt][r + 3] = __builtin_amdgcn_exp2f(sc[kt][r + 3]); ls3 += sc[kt][r + 3]; } \
            _Pragma("unroll") for (int kt = 0; kt < 2; ++kt) _Pragma("unroll") for (int s2 = 0; s2 < 2; ++s2) { \
                u32x4 pw = {pk2(sc[kt][8 * s2], sc[kt][8 * s2 + 1]), pk2(sc[kt][8 * s2 + 2], sc[kt][8 * s2 + 3]), pk2(sc[kt][8 * s2 + 4], sc[kt][8 * s2 + 5]), pk2(sc[kt][8 * s2 + 6], sc[kt][8 * s2 + 7])}; \
                const bf16x8 pf = __builtin_bit_cast(bf16x8, pw); \
                _Pragma("unroll") for (int dt = 0; dt < 2; ++dt) o[dt] = __builtin_amdgcn_mfma_f32_32x32x16_bf16(vfr[kt][s2][dt], pf, o[dt], 0, 0, 0); } \
        } \
        __builtin_amdgcn_sched_barrier(0); \
        if ((n) + 1 < ntile) AT_COMMIT((ST) ^ 1); \
        __syncthreads(); } while (0)
    AT_ISSUE(0); AT_COMMIT(0);
    __syncthreads();
    for (int n = 0; n < ntile; n += 2) {
        AT_BODY(0, n);
        if (n + 1 < ntile) AT_BODY(1, n + 1);
    }
#undef AT_ISSUE
#undef AT_COMMIT
#undef AT_BODY
    const float l = xhalf_sum((ls0 + ls1) + (ls2 + ls3)) + __builtin_amdgcn_exp2f(a.sink_l2 - a.m0);
    const float inv = 1.f / l;
    bf16* op = a.out + (a.qrow0 + wave * 32 + l31) * 1024 + 4 * hh;
#pragma unroll
    for (int dt = 0; dt < 2; ++dt)
#pragma unroll
        for (int g = 0; g < 4; ++g) { u32x2 v = {pk2(o[dt][4 * g] * inv, o[dt][4 * g + 1] * inv), pk2(o[dt][4 * g + 2] * inv, o[dt][4 * g + 3] * inv)}; *(u32x2*)(op + dt * 32 + 8 * g) = v; }
}

__device__ __forceinline__ void ph_dense_attn(const Ptrs& P, LAS unsigned char* smem, int bid, int nblk) {
    unsigned char* r3 = P.ws + WS_R3;
    const int vid = xcd_vid(bid, nblk);
    for (int item = vid; item < 1024 + 64; item += nblk) {
        AttnArgs a;
        int bh, qb; bool isctx = item >= 1024;
        if (!isctx) { bh = item >> 5; qb = item & 31; } else { bh = (item - 1024) >> 1; qb = (item - 1024) & 1; }
        const int hq = bh & 7, b = bh >> 3, kv = hq >> 2;
        a.Q = (const bf16*)(r3 + R3_AQ); a.ldq = 512; a.qcol = hq * 64;
        a.qrow0 = isctx ? (size_t)NL + b * CL + qb * 128 : (size_t)b * S + qb * 128;
        a.K = (const bf16*)(r3 + R3_AK) + kv * 64; a.klat0 = (size_t)b * S; a.kctx0 = (size_t)NL + b * CL;
        a.Vt = (const bf16*)(r3 + R3_AV) + (size_t)(b * 2 + kv) * 64 * VT_LD;
        a.nctx = 4; a.tlo = 0; a.nlat = isctx ? 0 : 64; a.banded = 0; a.tq0 = 0; a.sink_l2 = -INFINITY; a.m0 = ((const float*)(P.ws + WS_ROPE + 8192))[0];
        a.out = (bf16*)(P.ws + WS_R2) + 512 + hq * 64;
        attn_block(a, smem);
    }
}
__device__ __forceinline__ void ph_swa_attn(const Ptrs& P, LAS unsigned char* smem, int bid, int nblk) {
    unsigned char* r3 = P.ws + WS_R3;
    const int vid = xcd_vid(bid, nblk);
    for (int item = vid; item < 2048; item += nblk) {
        AttnArgs a;
        const int bh = item >> 5, qb = item & 31, hq = bh & 15, b = bh >> 4, kv = hq >> 3;
        a.Q = (const bf16*)(r3 + R3_OQ); a.ldq = 1024; a.qcol = hq * 64; a.qrow0 = (size_t)b * S + qb * 128;
        a.K = (const bf16*)(r3 + R3_OK) + kv * 64; a.klat0 = (size_t)b * S; a.kctx0 = (size_t)NL + b * CL;
        a.Vt = (const bf16*)(r3 + R3_OV) + (size_t)(b * 2 + kv) * 64 * VT_LD;
        const int tlo = qb * 2 - 2 < 0 ? 0 : qb * 2 - 2, thi = qb * 2 + 3 > 63 ? 63 : qb * 2 + 3;
        a.nctx = 4; a.tlo = tlo; a.nlat = thi - tlo + 1; a.banded = 1; a.tq0 = qb * 128; a.sink_l2 = P.in[17][hq] * 1.4426950408889634f; a.m0 = ((const float*)(P.ws + WS_ROPE + 8192))[1];
        a.out = (bf16*)(P.ws + WS_R2) + hq * 64;
        attn_block(a, smem);
    }
}

constexpr size_t WS_LIST = 247 * MiB;
constexpr size_t WS_WTS = WS_LIST + (size_t)24 * NT * 4;
constexpr size_t WS_END_ALL = WS_WTS + (size_t)NT * 2 * 4;
static_assert(WS_R3 + R3_END <= WS_LIST && WS_END_ALL <= 256 * MiB, "ws map tail");
constexpr int CTL_CNT = 8192;
constexpr int MOE_MAXT = NT / 128 + 24;


typedef float f32x4v __attribute__((ext_vector_type(4)));
__device__ __forceinline__ void route_tables(const Ptrs& P, int layer, int bid, int nblk) {
    unsigned char* ws = P.ws;
    const float* mvl = (const float*)(ws + WS_MODV) + (size_t)layer * 5 * 6144;
    const float* gain = P.in[7] + layer * D;
    const float* wg = P.in[20] + (size_t)layer * D * 4; const float* bg = P.in[21] + layer * 4;
    const float* we = P.in[22] + (size_t)layer * D * 16; const float* be = P.in[23] + layer * 16;
    bf16* wrt = (bf16*)(ws + WS_WRT + layer * WRT_STRIDE);
    for (int e = bid * 256 + threadIdx.x; e < 5 * 32 * 1024; e += nblk * 256) {
        const int k = e & 1023, r = (e >> 10) & 31, br = e >> 15;
        const float a = gain[k] * (1.f + mvl[(size_t)br * 6144 + 4 * 1024 + k]);
        const float w = (r < 16 ? wg[k * 4 + (r & 3)] : we[k * 16 + r - 16]) * a;
        const bf16 hi = f2bf(w); const bf16 lo = f2bf(w - bf2f(hi));
        wrt[((size_t)(br * 2 + 0) * 32 + r) * 1024 + k] = hi; wrt[((size_t)(br * 2 + 1) * 32 + r) * 1024 + k] = lo;
    }
    const int gw = bid * 4 + (threadIdx.x >> 6), lane = threadIdx.x & 63;
    if (gw < 160) {
        const int r = gw & 31, br = gw >> 5; float s = 0.f;
        for (int k = lane; k < 1024; k += 64) s += mvl[(size_t)br * 6144 + 3 * 1024 + k] * (r < 16 ? wg[k * 4 + (r & 3)] : we[k * 16 + r - 16]);
        s = wave_sum(s);
        if (lane == 0) ((float*)(ws + WS_SL))[layer * 256 + br * 32 + r] = s + (r < 16 ? bg[r & 3] : be[r - 16]);
    }
}
__device__ __forceinline__ void fold_odd_inproj(const Ptrs& P, int bid, int nblk) {
    unsigned char* ws = P.ws;
    const float* mv1 = (const float*)(ws + WS_MODV) + (size_t)5 * 6144; const float* gain = P.in[6] + D;
    const bf16* wt = (const bf16*)(ws + WS_WINO); bf16* wf = (bf16*)(ws + WS_WINOF);
    for (int e = bid * 256 + threadIdx.x; e < 5 * 80 * 128; e += nblk * 256) {
        const int k8 = (e & 127) * 8, n0 = ((e >> 7) % 80) * 16, b = e / (80 * 128);
        const f32x4 g0 = *(const f32x4*)(gain + k8), g1 = *(const f32x4*)(gain + k8 + 4), s0 = *(const f32x4*)(mv1 + (size_t)b * 6144 + 1024 + k8), s1 = *(const f32x4*)(mv1 + (size_t)b * 6144 + 1024 + k8 + 4);
        const float a0 = g0.x * (1.f + s0.x), a1 = g0.y * (1.f + s0.y), a2 = g0.z * (1.f + s0.z), a3 = g0.w * (1.f + s0.w), a4 = g1.x * (1.f + s1.x), a5 = g1.y * (1.f + s1.y), a6 = g1.z * (1.f + s1.z), a7 = g1.w * (1.f + s1.w);
        u32x4 w[16];
#pragma unroll
        for (int i = 0; i < 16; ++i) w[i] = *(const u32x4*)(wt + (size_t)(n0 + i) * 1024 + k8);
#pragma unroll
        for (int i = 0; i < 16; ++i) {
            u32x4 o;
            o.x = pk2(__uint_as_float(w[i].x << 16) * a0, __uint_as_float(w[i].x & 0xffff0000u) * a1); o.y = pk2(__uint_as_float(w[i].y << 16) * a2, __uint_as_float(w[i].y & 0xffff0000u) * a3);
            o.z = pk2(__uint_as_float(w[i].z << 16) * a4, __uint_as_float(w[i].z & 0xffff0000u) * a5); o.w = pk2(__uint_as_float(w[i].w << 16) * a6, __uint_as_float(w[i].w & 0xffff0000u) * a7);
            *(u32x4*)(wf + ((size_t)b * 1280 + n0 + i) * 1024 + k8) = o;
        }
    }
    const int gw = bid * 4 + (threadIdx.x >> 6), NGW = nblk * 4, lane = threadIdx.x & 63;
    for (int t = gw; t < 5 * 1280; t += NGW) {
        const int n = t % 1280, b = t / 1280;
        const u32x4 w0 = *(const u32x4*)(wt + (size_t)n * 1024 + 8 * lane), w1 = *(const u32x4*)(wt + (size_t)n * 1024 + 512 + 8 * lane);
        const float* sh = mv1 + (size_t)b * 6144;
        const f32x4 p0 = *(const f32x4*)(sh + 8 * lane), p1 = *(const f32x4*)(sh + 8 * lane + 4), p2 = *(const f32x4*)(sh + 512 + 8 * lane), p3 = *(const f32x4*)(sh + 512 + 8 * lane + 4);
        float s = p0.x * __uint_as_float(w0.x << 16) + p0.y * __uint_as_float(w0.x & 0xffff0000u) + p0.z * __uint_as_float(w0.y << 16) + p0.w * __uint_as_float(w0.y & 0xffff0000u)
                + p1.x * __uint_as_float(w0.z << 16) + p1.y * __uint_as_float(w0.z & 0xffff0000u) + p1.z * __uint_as_float(w0.w << 16) + p1.w * __uint_as_float(w0.w & 0xffff0000u)
                + p2.x * __uint_as_float(w1.x << 16) + p2.y * __uint_as_float(w1.x & 0xffff0000u) + p2.z * __uint_as_float(w1.y << 16) + p2.w * __uint_as_float(w1.y & 0xffff0000u)
                + p3.x * __uint_as_float(w1.z << 16) + p3.y * __uint_as_float(w1.z & 0xffff0000u) + p3.z * __uint_as_float(w1.w << 16) + p3.w * __uint_as_float(w1.w & 0xffff0000u);
        s = wave_sum(s);
        if (lane == 0) ((float*)(ws + WS_BI))[t] = s;
    }
}
typedef float f32x4a __attribute__((ext_vector_type(4)));
__device__ __forceinline__ float xq_sum(float x) {
    x += __shfl_xor(x, 16); x += __shfl_xor(x, 32); return x;
}
__device__ __forceinline__ void ph_moe_route(const Ptrs& P, LAS unsigned char* smem, int bid, int nblk, int layer, int nrows) {
    unsigned char* ws = P.ws;
    const int tid = threadIdx.x, lane = tid & 63, wave = tid >> 6, tk = lane & 15, kq = lane >> 4;
    const float* modv_layer = (const float*)(ws + WS_MODV) + (size_t)layer * 5 * 6144;
    const float* gain = P.in[7] + layer * D;
    const bf16* xs = (const bf16*)(ws + WS_R4);
    bf16* H = (bf16*)(ws + WS_R1);
    int* cnt = (int*)(ws + WS_CTL) + CTL_CNT + layer * 2048; int* list = (int*)(ws + WS_LIST); float* wts = (float*)(ws + WS_WTS);
    LAS float* part = (LAS float*)smem;
    for (int task = xcd_vid(bid, nblk); task < nrows / 16; task += nblk) {
        const int row0 = task * 16; const int row = row0 + tk;
        const int br = row0 < NL ? row0 / S : 4;
        const bf16* xr = xs + (size_t)row * D;
        const bf16* wt = (const bf16*)(ws + WS_WRT + layer * WRT_STRIDE) + (size_t)br * 2 * 32 * 1024;
        f32x4a acc0 = {0.f, 0.f, 0.f, 0.f}, acc1 = {0.f, 0.f, 0.f, 0.f};
        float ss = 0.f;
#pragma unroll 4
        for (int s = 8 * wave; s < 8 * wave + 8; ++s) {
            const int k = 32 * s + 8 * kq;
            const u32x4 xh = *(const u32x4*)(xr + k);
            { const float f0 = __uint_as_float(xh.x << 16), f1 = __uint_as_float(xh.x & 0xffff0000u), f2 = __uint_as_float(xh.y << 16), f3 = __uint_as_float(xh.y & 0xffff0000u);
              const float f4 = __uint_as_float(xh.z << 16), f5 = __uint_as_float(xh.z & 0xffff0000u), f6 = __uint_as_float(xh.w << 16), f7 = __uint_as_float(xh.w & 0xffff0000u);
              ss += (f0 * f0 + f1 * f1) + (f2 * f2 + f3 * f3) + (f4 * f4 + f5 * f5) + (f6 * f6 + f7 * f7); }
            const bf16x8 bh = __builtin_bit_cast(bf16x8, xh);
            const bf16x8 a0h = *(const bf16x8*)(wt + (size_t)tk * 1024 + k), a1h = *(const bf16x8*)(wt + (size_t)(16 + tk) * 1024 + k);
            const bf16x8 a0l = *(const bf16x8*)(wt + (size_t)(32 + tk) * 1024 + k), a1l = *(const bf16x8*)(wt + (size_t)(48 + tk) * 1024 + k);
            acc0 = __builtin_amdgcn_mfma_f32_16x16x32_bf16(a0h, bh, acc0, 0, 0, 0); acc1 = __builtin_amdgcn_mfma_f32_16x16x32_bf16(a1h, bh, acc1, 0, 0, 0);
            acc0 = __builtin_amdgcn_mfma_f32_16x16x32_bf16(a0l, bh, acc0, 0, 0, 0); acc1 = __builtin_amdgcn_mfma_f32_16x16x32_bf16(a1l, bh, acc1, 0, 0, 0);
        }
#pragma unroll
        for (int j = 0; j < 4; ++j) { part[(wave * 9 + j) * 64 + lane] = acc0[j]; part[(wave * 9 + 4 + j) * 64 + lane] = acc1[j]; }
        part[(wave * 9 + 8) * 64 + lane] = ss;
        __syncthreads();
        float tot[9];
#pragma unroll
        for (int j = 0; j < 9; ++j) tot[j] = (part[j * 64 + lane] + part[(9 + j) * 64 + lane]) + (part[(18 + j) * 64 + lane] + part[(27 + j) * 64 + lane]);
        const float rstd = rsqrtf(xq_sum(tot[8]) * (1.f / D) + EPS);
        if (wave == 0) {
            const float* sl = (const float*)(ws + WS_SL) + layer * 256 + br * 32;
            float gl[4], el[4];
#pragma unroll
            for (int j = 0; j < 4; ++j) { gl[j] = tot[j] * rstd + sl[j]; el[j] = tot[4 + j] * rstd + sl[16 + 4 * kq + j]; }
            int gi = 0; float gm = gl[0];
#pragma unroll
            for (int j = 1; j < 4; ++j) if (gl[j] > gm) { gm = gl[j]; gi = j; }
            if (gi == kq) {
                float gs = 0.f;
#pragma unroll
                for (int j = 0; j < 4; ++j) gs += expf(gl[j] - gm);
                const float gwt = 1.f / gs;
                int i0 = 0; float e0 = el[0];
#pragma unroll
                for (int j = 1; j < 4; ++j) if (el[j] > e0) { e0 = el[j]; i0 = j; }
                int i1 = -1; float e1 = -INFINITY;
#pragma unroll
                for (int j = 0; j < 4; ++j) if (j != i0 && el[j] > e1) { e1 = el[j]; i1 = j; }
                const float p1 = expf(e1 - e0); const float w0 = gwt / (1.f + p1), w1 = gwt * p1 / (1.f + p1);
                const int ea = i0 < i1 ? i0 : i1, eb = i0 < i1 ? i1 : i0;
                const int pidx = ea == 0 ? eb - 1 : (ea == 1 ? eb + 1 : 5);
                const int cls = gi * 6 + pidx;
                wts[(size_t)row * 2] = i0 < i1 ? w0 : w1; wts[(size_t)row * 2 + 1] = i0 < i1 ? w1 : w0;
                const int pos = atomicAdd(&cnt[cls * 64], 1);
                list[(size_t)cls * NT + pos] = row;
            }
        }
        const float* mv = modv_layer + (size_t)br * 6144;
        float rs[4];
#pragma unroll
        for (int r = 0; r < 4; ++r) rs[r] = __shfl(rstd, 4 * wave + r);
        u32x2 xv[4][4];
#pragma unroll
        for (int r = 0; r < 4; ++r) {
            const bf16* xp = xs + (size_t)(row0 + 4 * wave + r) * D + 4 * lane;
#pragma unroll
            for (int jq = 0; jq < 4; ++jq) xv[r][jq] = *(const u32x2*)(xp + 256 * jq);
        }
#pragma unroll
        for (int jq = 0; jq < 4; ++jq) {
            const int k = 4 * lane + 256 * jq;
            const f32x4 g = *(const f32x4*)(gain + k), sc = *(const f32x4*)(mv + 4 * 1024 + k), sh = *(const f32x4*)(mv + 3 * 1024 + k);
            const f32x4 a = {g.x * (1.f + sc.x), g.y * (1.f + sc.y), g.z * (1.f + sc.z), g.w * (1.f + sc.w)};
#pragma unroll
            for (int r = 0; r < 4; ++r) {
                const u32x2 xw = xv[r][jq]; const f32x4 x = {__uint_as_float(xw.x << 16), __uint_as_float(xw.x & 0xffff0000u), __uint_as_float(xw.y << 16), __uint_as_float(xw.y & 0xffff0000u)};
                u32x2 o = {pk2(x.x * rs[r] * a.x + sh.x, x.y * rs[r] * a.y + sh.y), pk2(x.z * rs[r] * a.z + sh.z, x.w * rs[r] * a.w + sh.w)};
                *(u32x2*)(H + (size_t)(row0 + 4 * wave + r) * D + k) = o;
            }
        }
        __syncthreads();
    }
}

__device__ __forceinline__ void moe_tiles_init(const int* cnt, LAS int* tile0) {
    __syncthreads();
    if (threadIdx.x < 24) tile0[192 + threadIdx.x] = cnt[threadIdx.x * 64];
    __syncthreads();
    if (threadIdx.x == 0) { int a = 0; for (int c = 0; c < 24; ++c) { tile0[c] = a; a += (tile0[192 + c] + 127) >> 7; } tile0[24] = a; }
    __syncthreads();
}
struct GatherRows {
    const bf16* H; const int* lst; int n; unsigned vo[4];
    __device__ __forceinline__ void init(int w, int rl, const int (&co)[4]) {
#pragma unroll
        for (int i = 0; i < 4; ++i) { const int r = 32 * w + 8 * i + rl; vo[i] = (unsigned)(((size_t)lst[r < n ? r : 0] * D + co[i]) * 2); }
    }
    __device__ __forceinline__ const bf16* sb(int i, int kt) const { return H + kt * 64; }
};
struct SplitKRows {
    const bf16* b0; const bf16* b1; size_t ld; int ksplit; int w; unsigned vo[4];
    __device__ __forceinline__ SplitKRows(const bf16* b0_, const bf16* b1_, size_t ld_, int ksplit_) : b0(b0_), b1(b1_), ld(ld_), ksplit(ksplit_), w(0) {}
    __device__ __forceinline__ void init(int w_, int rl, const int (&co)[4]) { w = w_;
#pragma unroll
        for (int i = 0; i < 4; ++i) vo[i] = (unsigned)((rl * ld + co[i]) * 2); }
    __device__ __forceinline__ const bf16* sb(int i, int kt) const { return (kt < ksplit ? b0 + kt * 64 : b1 + (kt - ksplit) * 64) + (size_t)(32 * w + 8 * i) * ld; }
};
struct EpiMoe1 {
    typedef NoPre Pre;
    __device__ __forceinline__ void prefetch(Pre&, int, int, int, int) const {}
    bf16* hid; const int* lst; int n; const float* wts; int nt;
    __device__ __forceinline__ bool swapped() const { return false; }
    __device__ __forceinline__ void operator()(f32x16 (&acc)[2][2], int fb, int tb, int l31, int hh, LAS unsigned char* wl, const Pre& pre) const {
        const int col = (nt >> 2) * 256 + 32 * (2 * (nt & 3) + (fb >> 6));
#pragma unroll 1
        for (int j = 0; j < 2; ++j) {
            const int r = tb + j * 32 + l31;
            const int tok = lst[r < n ? r : 0];
            const float w = wts[(size_t)tok * 2 + (nt >> 2)];
#pragma unroll
            for (int g = 0; g < 4; ++g) {
                float hv[4];
#pragma unroll
                for (int e = 0; e < 4; ++e) { const float a_ = j ? acc[0][1][4 * g + e] : acc[0][0][4 * g + e], u_ = j ? acc[1][1][4 * g + e] : acc[1][0][4 * g + e]; hv[e] = a_ / (1.f + __expf(-a_)) * u_ * w; }
                u32x2 v = {pk2(hv[0], hv[1]), pk2(hv[2], hv[3])}; *(LAS u32x2*)(wl + (32 * j + l31) * 80 + (8 * g + 4 * hh) * 2) = v;
            }
        }
        const int lane = l31 + 32 * hh, rr = lane >> 2, ch = lane & 3;
#pragma unroll
        for (int q = 0; q < 4; ++q) { const int R = 16 * q + rr; const u32x4 v = *(LAS u32x4*)(wl + R * 80 + ch * 16); *(u32x4*)(hid + (size_t)(tb + R) * 512 + col + ch * 8) = v; }
    }
};
__device__ __forceinline__ void ph_moe_stage1(const Ptrs& P, LAS unsigned char* smem, int bid, int nblk, int layer) {
    unsigned char* ws = P.ws;
    const int* cnt = (const int*)(ws + WS_CTL) + CTL_CNT + layer * 2048; const int* list = (const int*)(ws + WS_LIST);
    LAS int* tile0 = (LAS int*)(smem + GEMM_LDS);
    moe_tiles_init(cnt, tile0);
    const int lrow = threadIdx.x >> 3, kc = threadIdx.x & 7;
    const bf16* H = (const bf16*)(ws + WS_R1);
    const int nitems = tile0[24] * 8;
    for (int item = xcd_vid(bid, nblk); item < nitems; item += nblk) {
        const int tt = item >> 3, nt = item & 7;
        int c = 0; while (tile0[c + 1] <= tt) ++c;
        const int lt = tt - tile0[c], n = min(128, tile0[192 + c] - lt * 128);
        const int* lst = list + (size_t)c * NT + lt * 128;
        const int g = c / 6, pidx = c % 6; const int ea = pidx < 3 ? 0 : (pidx < 5 ? 1 : 2), eb = pidx < 3 ? pidx + 1 : (pidx < 5 ? pidx - 1 : 3);
        const int expert = g * 4 + (nt < 4 ? ea : eb);
        GatherRows af{H, lst, n, {0u, 0u, 0u, 0u}};
        AffineRows bf_((const bf16*)(ws + WS_WGU) + ((size_t)(layer * 16 + expert) * 512 + (nt & 3) * 128) * D, D);
        EpiMoe1 epi{(bf16*)(ws + WS_R3) + (size_t)tt * 128 * 512, lst, n, (const float*)(ws + WS_WTS), nt};
        gemm_tile<false>(af, bf_, D / 64, smem, epi);
    }
}
template <int LAYER>
struct EpiMoe2 {
    typedef RmwPre<true> Pre;
    bf16* xs; float* out; float* rss; const float* modv_layer; LAS const int* lst; int n; int nt;
    __device__ __forceinline__ bool swapped() const { return false; }
    __device__ __forceinline__ auto rowfn(int fb, int tb) const {
        const int c0 = nt * 128 + fb; const EpiMoe2 e = *this;
        return [=](int R, const void*& sp, void*& dp, const float*& gp, int& tk) {
            const int r = tb + R; if (r >= e.n) return false;
            const int tok = e.lst[r]; tk = tok;
            sp = e.xs + (size_t)tok * D + c0;
            if (LAYER == 0) dp = e.xs + (size_t)tok * D + c0; else dp = e.out + (size_t)tok * D + c0;
            gp = e.modv_layer + (size_t)(tok < NL ? tok / S : 4) * 6144 + 5 * 1024 + c0; return true; };
    }
    __device__ __forceinline__ void prefetch(Pre& pre, int fb, int tb, int l31, int hh) const { rmw_prefetch<true>(pre, rowfn(fb, tb), l31, hh); }
    __device__ __forceinline__ void operator()(f32x16 (&acc)[2][2], int fb, int tb, int l31, int hh, LAS unsigned char* wl, const Pre& pre) const {
        rmw_finish<true, LAYER == 0, LAYER == 0>(acc, pre, rowfn(fb, tb), l31, hh, wl, rss);
    }
};
__device__ __forceinline__ void ph_moe_stage2(const Ptrs& P, LAS unsigned char* smem, int bid, int nblk, int layer) {
    unsigned char* ws = P.ws;
    const int* cnt = (const int*)(ws + WS_CTL) + CTL_CNT + layer * 2048; const int* list = (const int*)(ws + WS_LIST);
    LAS int* tile0 = (LAS int*)(smem + GEMM_LDS);
    moe_tiles_init(cnt, tile0);
    const int lrow = threadIdx.x >> 3, kc = threadIdx.x & 7;
    const int nitems = tile0[24] * 8;
    for (int item = xcd_vid(bid, nblk); item < nitems; item += nblk) {
        const int tt = item >> 3, nt = item & 7;
        int c = 0; while (tile0[c + 1] <= tt) ++c;
        const int lt = tt - tile0[c], n = min(128, tile0[192 + c] - lt * 128);
        const int* lst = list + (size_t)c * NT + lt * 128;
        const int g = c / 6, pidx = c % 6; const int ea = pidx < 3 ? 0 : (pidx < 5 ? 1 : 2), eb = pidx < 3 ? pidx + 1 : (pidx < 5 ? pidx - 1 : 3);
        AffineRows af((const bf16*)(ws + WS_R3) + (size_t)tt * 128 * 512, 512);
        const bf16* wd = (const bf16*)(ws + WS_WD);
        SplitKRows bf_(wd + ((size_t)(layer * 16 + g * 4 + ea) * 1024 + nt * 128) * 256, wd + ((size_t)(layer * 16 + g * 4 + eb) * 1024 + nt * 128) * 256, 256, 4);
        LAS int* toks = (LAS int*)(smem + GEMM_LDS + 256);
        __syncthreads();
        if (threadIdx.x < 128) toks[threadIdx.x] = lst[threadIdx.x < n ? threadIdx.x : 0];
        if (layer == 0) { EpiMoe2<0> epi{(bf16*)(ws + WS_R4), P.out, (float*)(ws + WS_RSS), (const float*)(ws + WS_MODV), toks, n, nt}; gemm_tile<false>(af, bf_, 8, smem, epi); }
        else { EpiMoe2<1> epi{(bf16*)(ws + WS_R4), P.out, nullptr, (const float*)(ws + WS_MODV) + (size_t)5 * 6144, toks, n, nt}; gemm_tile<false>(af, bf_, 8, smem, epi); }
    }
}

constexpr size_t GLA_ST = 8192;
constexpr size_t WS_DEC = WS_WTS + (size_t)NT * 2 * 4;
static_assert(WS_DEC + (size_t)32 * 68 * 64 * 4 <= 256 * MiB, "ws dec");
__device__ __forceinline__ void gla_chunk_geom(int b, int M, size_t& row0, int& vcol0, int& c0, int& c1) {
    if (M < 4) { row0 = (size_t)NL + b * CL + 64 * M; vcol0 = S + 64 * M; c0 = M; c1 = 3 - M; }
    else { const int Ml = M - 4; row0 = (size_t)b * S + 64 * Ml; vcol0 = 64 * Ml; c0 = 4 + Ml; c1 = 4 + 63 - Ml; }
}
template <bool PASS_C>
__device__ __forceinline__ float gla_prep(const float (&gw)[16], float gb, int dir, LAS unsigned char* out, LAS const unsigned char* qraw, LAS const unsigned char* kraw, LAS const float* lrs, LAS float* tot) {
    const int tid = threadIdx.x, k = tid & 63, grp = tid >> 6;
    float gl[16];
#pragma unroll
    for (int j = 0; j < 16; ++j) {
        const int p = 16 * grp + j; float z = gb;
#pragma unroll
        for (int r4 = 0; r4 < 4; ++r4) { const f32x4 l4 = *(LAS const f32x4*)(lrs + p * 16 + r4 * 4); z += l4.x * gw[4 * r4] + l4.y * gw[4 * r4 + 1] + l4.z * gw[4 * r4 + 2] + l4.w * gw[4 * r4 + 3]; }
        gl[j] = (fminf(z, 0.f) - __logf(1.f + __expf(-fabsf(z)))) * (1.f / 16.f);
    }
    if (dir == 0) {
#pragma unroll
        for (int j = 1; j < 16; ++j) gl[j] += gl[j - 1];
        tot[grp * 64 + k] = gl[15];
    } else {
#pragma unroll
        for (int j = 14; j >= 0; --j) gl[j] += gl[j + 1];
        tot[grp * 64 + k] = gl[0];
    }
    __syncthreads();
    const float t0 = tot[k], t1 = tot[64 + k], t2 = tot[128 + k], t3 = tot[192 + k];
    const float bend = t0 + t1 + t2 + t3;
    float offs;
    if (dir == 0) offs = grp == 0 ? 0.f : grp == 1 ? t0 : grp == 2 ? t0 + t1 : t0 + t1 + t2;
    else offs = grp == 3 ? 0.f : grp == 2 ? t3 : grp == 1 ? t3 + t2 : t3 + t2 + t1;
    if (PASS_C) {
#pragma unroll
        for (int j = 0; j < 16; ++j) {
            const int p = 16 * grp + j; const float bp = gl[j] + offs;
            const float q = bf2f(*(LAS const bf16*)(qraw + p * 128 + k * 2)) * 0.125f, kk = bf2f(*(LAS const bf16*)(kraw + p * 128 + k * 2));
            *(LAS bf16*)(out + p * 144 + k * 2) = f2bf(q * __expf(bp));
            *(LAS bf16*)(out + 9216 + p * 144 + k * 2) = f2bf(q * __expf(bp - bend));
            *(LAS bf16*)(out + 18432 + p * 144 + k * 2) = f2bf(kk * __expf(bend - bp));
        }
    } else {
        float kt[16];
#pragma unroll
        for (int j = 0; j < 16; ++j) { const int p = 16 * grp + j; const float bp = gl[j] + offs; kt[j] = bf2f(*(LAS const bf16*)(kraw + p * 128 + k * 2)) * __expf(bend - bp); }
        u32x4 w0 = {pk2(kt[0], kt[1]), pk2(kt[2], kt[3]), pk2(kt[4], kt[5]), pk2(kt[6], kt[7])}, w1 = {pk2(kt[8], kt[9]), pk2(kt[10], kt[11]), pk2(kt[12], kt[13]), pk2(kt[14], kt[15])};
        *(LAS u32x4*)(out + k * 144 + grp * 32) = w0; *(LAS u32x4*)(out + k * 144 + grp * 32 + 16) = w1;
    }
    return __expf(bend);
}
#define GLA_LOAD_GW(gw, gb, dir, h) do { _Pragma("unroll") for (int r_ = 0; r_ < 16; ++r_) gw[r_] = P.in[10][((dir) * 16 + r_) * 256 + (h) * 64 + (threadIdx.x & 63)]; gb = P.in[11][(dir) * 256 + (h) * 64 + (threadIdx.x & 63)]; } while (0)

constexpr int GA_KTT = 0, GA_VT = 9216, GA_KRAW = GA_VT + 128 * 144, GA_LRS = GA_KRAW + 8192, GA_TOT = GA_LRS + 4096, GLA_A_LDS = GA_TOT + 1024;
__device__ __forceinline__ void gla_pass_a_item(const Ptrs& P, int item, LAS unsigned char* lds) {
    const int tid = threadIdx.x, lane = tid & 63, wave = tid >> 6, l31 = lane & 31, hh = lane >> 5;
    const int M = item % 68, dir = (item / 68) & 1, h = (item / 136) & 3, b = item / 544;
    size_t row0; int vcol0, c0, c1; gla_chunk_geom(b, M, row0, vcol0, c0, c1);
    const int sidx = ((b * 4 + h) * 2 + dir) * 68 + (dir ? c1 : c0);
    const unsigned char* r3 = P.ws + WS_R3;
    u32x4 vt[4], kr[2]; f32x4 lr; float gw[16], gb;
    { const bf16* gvt = (const bf16*)(r3 + R3_GV) + (size_t)(b * 4 + h) * 128 * VT_LD + vcol0;
#pragma unroll
      for (int i = 0; i < 4; ++i) { const int c = tid + 256 * i; vt[i] = *(const u32x4*)(gvt + (size_t)(c >> 3) * VT_LD + (c & 7) * 8); }
      const bf16* gk = (const bf16*)(r3 + R3_GK) + row0 * 256 + h * 64;
#pragma unroll
      for (int i = 0; i < 2; ++i) { const int c = tid + 256 * i; kr[i] = *(const u32x4*)(gk + (size_t)(c >> 3) * 256 + (c & 7) * 8); }
      lr = *(const f32x4*)((const float*)(r3 + R3_LR) + (row0 + (tid >> 2)) * 32 + dir * 16 + (tid & 3) * 4);
      GLA_LOAD_GW(gw, gb, dir, h); }
#pragma unroll
    for (int i = 0; i < 4; ++i) { const int c = tid + 256 * i; *(LAS u32x4*)(lds + GA_VT + (c >> 3) * 144 + (c & 7) * 16) = vt[i]; }
#pragma unroll
    for (int i = 0; i < 2; ++i) { const int c = tid + 256 * i; *(LAS u32x4*)(lds + GA_KRAW + (c >> 3) * 128 + (c & 7) * 16) = kr[i]; }
    *(LAS f32x4*)(lds + GA_LRS + tid * 16) = lr;
    __syncthreads();
    const float dec = gla_prep<false>(gw, gb, dir, lds + GA_KTT, lds + GA_KRAW, lds + GA_KRAW, (LAS const float*)(lds + GA_LRS), (LAS float*)(lds + GA_TOT));
    if (tid < 64) ((float*)(P.ws + WS_DEC))[(size_t)sidx * 64 + tid] = dec;
    __syncthreads();
    f32x16 acc[2];
#pragma unroll
    for (int kt = 0; kt < 2; ++kt)
#pragma unroll
        for (int r = 0; r < 16; ++r) acc[kt][r] = 0.f;
#pragma unroll
    for (int ps = 0; ps < 4; ++ps) {
        const bf16x8 vf = *(LAS bf16x8*)(lds + GA_VT + (32 * wave + l31) * 144 + ps * 32 + hh * 16);
#pragma unroll
        for (int kt = 0; kt < 2; ++kt) { const bf16x8 kf = *(LAS bf16x8*)(lds + GA_KTT + (32 * kt + l31) * 144 + ps * 32 + hh * 16); acc[kt] = __builtin_amdgcn_mfma_f32_32x32x16_bf16(kf, vf, acc[kt], 0, 0, 0); }
    }
    bf16* ds = (bf16*)(P.ws + WS_R1) + (size_t)sidx * GLA_ST + (size_t)(32 * wave + l31) * 64 + 4 * hh;
#pragma unroll
    for (int kt = 0; kt < 2; ++kt)
#pragma unroll
        for (int g = 0; g < 4; ++g) { u32x2 v = {pk2(acc[kt][4 * g], acc[kt][4 * g + 1]), pk2(acc[kt][4 * g + 2], acc[kt][4 * g + 3])}; *(u32x2*)(ds + kt * 32 + 8 * g) = v; }
    __syncthreads();
}
__device__ __forceinline__ void ph_gla_a(const Ptrs& P, LAS unsigned char* smem, int bid, int nblk) {
    for (int item = bid; item < 4 * 4 * 2 * 68; item += nblk) gla_pass_a_item(P, item, smem);
}
__device__ __forceinline__ void gla_pass_b(const Ptrs& P, int gtid, int nthreads) {
    const bf16* DS = (const bf16*)(P.ws + WS_R1); bf16* SIN = (bf16*)(P.ws + WS_R4); const float* DEC = (const float*)(P.ws + WS_DEC);
    for (int idx = gtid; idx < 32 * 2048; idx += nthreads) {
        const int bhd = idx >> 11, e4 = idx & 2047, k4 = (e4 & 15) * 4;
        float s0 = 0.f, s1 = 0.f, s2 = 0.f, s3 = 0.f;
#pragma unroll 17
        for (int c = 0; c < 68; ++c) {
            const size_t sidx = (size_t)bhd * 68 + c;
            u32x2 o = {pk2(s0, s1), pk2(s2, s3)};
            *(u32x2*)(SIN + sidx * GLA_ST + e4 * 4) = o;
            const f32x4 d = *(const f32x4*)(DEC + sidx * 64 + k4);
            const u32x2 w = *(const u32x2*)(DS + sidx * GLA_ST + e4 * 4);
            s0 = s0 * d.x + __uint_as_float(w.x << 16); s1 = s1 * d.y + __uint_as_float(w.x & 0xffff0000u);
            s2 = s2 * d.z + __uint_as_float(w.y << 16); s3 = s3 * d.w + __uint_as_float(w.y & 0xffff0000u);
        }
    }
}

constexpr int GC_QT = 0, GC_QA = 9216, GC_KT = 18432, GC_VT = 27648, GC_QRAW = GC_VT + 128 * 136, GC_KRAW = GC_QRAW + 8192, GC_LRS = GC_KRAW + 8192, GC_TOT = GEMM_LDS + 256, GC_XCH = GC_TOT + 1024;
static_assert(GC_LRS + 4096 <= GEMM_LDS, "gla c lds");
__device__ __forceinline__ void gla_pass_c_item(const Ptrs& P, int item, LAS unsigned char* lds) {
    const int tid = threadIdx.x, lane = tid & 63, wave = tid >> 6, l31 = lane & 31, hh = lane >> 5, pt = wave & 1, vh = wave >> 1;
    const int M = item % 68, h = (item / 68) & 3, b = item / 272;
    size_t row0; int vcol0, c0, c1; gla_chunk_geom(b, M, row0, vcol0, c0, c1);
    const unsigned char* r3 = P.ws + WS_R3;
    u32x4 vt[4], qr[2], kr[2]; f32x4 lr0, lr1; float gw[16], gb;
    { const bf16* gvt = (const bf16*)(r3 + R3_GV) + (size_t)(b * 4 + h) * 128 * VT_LD + vcol0;
#pragma unroll
      for (int i = 0; i < 4; ++i) { const int c = tid + 256 * i; vt[i] = *(const u32x4*)(gvt + (size_t)(c >> 3) * VT_LD + (c & 7) * 8); }
      const bf16* gq = (const bf16*)(r3 + R3_GQ) + row0 * 256 + h * 64; const bf16* gk = (const bf16*)(r3 + R3_GK) + row0 * 256 + h * 64;
#pragma unroll
      for (int i = 0; i < 2; ++i) { const int c = tid + 256 * i; qr[i] = *(const u32x4*)(gq + (size_t)(c >> 3) * 256 + (c & 7) * 8); kr[i] = *(const u32x4*)(gk + (size_t)(c >> 3) * 256 + (c & 7) * 8); }
      const float* lrp = (const float*)(r3 + R3_LR) + (row0 + (tid >> 2)) * 32 + (tid & 3) * 4;
      lr0 = *(const f32x4*)lrp; lr1 = *(const f32x4*)(lrp + 16);
      GLA_LOAD_GW(gw, gb, 0, h); }
#pragma unroll
    for (int i = 0; i < 4; ++i) { const int c = tid + 256 * i; LAS unsigned char* vp = lds + GC_VT + (c >> 3) * 136 + (c & 7) * 16; u32x2 lo = {vt[i].x, vt[i].y}, hi = {vt[i].z, vt[i].w}; *(LAS u32x2*)vp = lo; *(LAS u32x2*)(vp + 8) = hi; }
#pragma unroll
    for (int i = 0; i < 2; ++i) { const int c = tid + 256 * i; *(LAS u32x4*)(lds + GC_QRAW + (c >> 3) * 128 + (c & 7) * 16) = qr[i]; *(LAS u32x4*)(lds + GC_KRAW + (c >> 3) * 128 + (c & 7) * 16) = kr[i]; }
    *(LAS f32x4*)(lds + GC_LRS + tid * 16) = lr0;
    f32x16 o[2];
#pragma unroll
    for (int i = 0; i < 2; ++i)
#pragma unroll
        for (int r = 0; r < 16; ++r) o[i][r] = 0.f;
    const bf16* SIN = (const bf16*)(P.ws + WS_R4);
    __syncthreads();
#pragma unroll 1
    for (int dir = 0; dir < 2; ++dir) {
        const int sidx = ((b * 4 + h) * 2 + dir) * 68 + (dir ? c1 : c0);
        (void)gla_prep<true>(gw, gb, dir, lds + GC_QT, lds + GC_QRAW, lds + GC_KRAW, (LAS const float*)(lds + GC_LRS), (LAS float*)(lds + GC_TOT));
        bf16x8 sf[2][4];
#pragma unroll
        for (int i = 0; i < 2; ++i)
#pragma unroll
            for (int ks = 0; ks < 4; ++ks) sf[i][ks] = *(const bf16x8*)(SIN + (size_t)sidx * GLA_ST + (size_t)(64 * vh + 32 * i + l31) * 64 + 16 * ks + 8 * hh);
        if (dir == 0) { *(LAS f32x4*)(lds + GC_LRS + tid * 16) = lr1; GLA_LOAD_GW(gw, gb, 1, h); }
        __syncthreads();
        f32x16 at[2];
#pragma unroll
        for (int st = 0; st < 2; ++st) {
#pragma unroll
            for (int r = 0; r < 16; ++r) at[st][r] = 0.f;
#pragma unroll
            for (int ks = 0; ks < 4; ++ks) {
                const bf16x8 ka = *(LAS bf16x8*)(lds + GC_KT + (32 * st + l31) * 144 + ks * 32 + hh * 16);
                const bf16x8 qa = *(LAS bf16x8*)(lds + GC_QA + (32 * pt + l31) * 144 + ks * 32 + hh * 16);
                at[st] = __builtin_amdgcn_mfma_f32_32x32x16_bf16(ka, qa, at[st], 0, 0, 0);
            }
            const int pq = 32 * pt + l31;
#pragma unroll
            for (int r = 0; r < 16; ++r) { const int s_ = 32 * st + (r & 3) + 8 * (r >> 2) + 4 * hh; const bool ok = dir ? (s_ >= pq) : (s_ <= pq); if (!ok) at[st][r] = 0.f; }
        }
#pragma unroll
        for (int ks = 0; ks < 4; ++ks) {
            const bf16x8 qt = *(LAS bf16x8*)(lds + GC_QT + (32 * pt + l31) * 144 + ks * 32 + hh * 16);
#pragma unroll
            for (int i = 0; i < 2; ++i) o[i] = __builtin_amdgcn_mfma_f32_32x32x16_bf16(sf[i][ks], qt, o[i], 0, 0, 0);
        }
#pragma unroll
        for (int st = 0; st < 2; ++st)
#pragma unroll
            for (int s2 = 0; s2 < 2; ++s2) {
                u32x4 pw = {pk2(at[st][8 * s2], at[st][8 * s2 + 1]), pk2(at[st][8 * s2 + 2], at[st][8 * s2 + 3]), pk2(at[st][8 * s2 + 4], at[st][8 * s2 + 5]), pk2(at[st][8 * s2 + 6], at[st][8 * s2 + 7])};
                const bf16x8 pf = __builtin_bit_cast(bf16x8, pw);
#pragma unroll
                for (int i = 0; i < 2; ++i) {
                    LAS unsigned char* vp = lds + GC_VT + (64 * vh + 32 * i + l31) * 136 + (32 * st + 16 * s2 + 4 * hh) * 2;
                    const u32x2 v0 = *(LAS u32x2*)vp, v1 = *(LAS u32x2*)(vp + 16);
                    u32x4 vw = {v0.x, v0.y, v1.x, v1.y};
                    o[i] = __builtin_amdgcn_mfma_f32_32x32x16_bf16(__builtin_bit_cast(bf16x8, vw), pf, o[i], 0, 0, 0);
                }
            }
        __syncthreads();
    }
    float ss = 0.f;
#pragma unroll
    for (int i = 0; i < 2; ++i)
#pragma unroll
        for (int r = 0; r < 16; ++r) ss += o[i][r] * o[i][r];
    ss = xhalf_sum(ss);
    LAS float* xch = (LAS float*)(lds + GC_XCH);
    if (hh == 0) xch[(pt * 2 + vh) * 32 + l31] = ss;
    __syncthreads();
    ss += xch[(pt * 2 + (1 - vh)) * 32 + l31];
    const float rstd = rsqrtf(ss * (1.f / 128.f) + EPS);
    const size_t trow = row0 + 32 * pt + l31;
    const bf16* gr = (const bf16*)(P.ws + WS_R3 + R3_GR) + trow * 512 + h * 128 + 64 * vh + 4 * hh;
    bf16* mx = (bf16*)(P.ws + WS_R2) + trow * 1024 + h * 128 + 64 * vh + 4 * hh;
    const float* gn = P.in[12] + 64 * vh + 4 * hh;
#pragma unroll
    for (int i = 0; i < 2; ++i)
#pragma unroll
        for (int g = 0; g < 4; ++g) {
            const u32x2 rw = *(const u32x2*)(gr + i * 32 + 8 * g); const f32x4 gg = *(const f32x4*)(gn + i * 32 + 8 * g);
            const float r0 = __uint_as_float(rw.x << 16), r1 = __uint_as_float(rw.x & 0xffff0000u), r2 = __uint_as_float(rw.y << 16), r3_ = __uint_as_float(rw.y & 0xffff0000u);
            const float y0 = o[i][4 * g] * rstd * gg.x * (r0 / (1.f + __expf(-r0))), y1 = o[i][4 * g + 1] * rstd * gg.y * (r1 / (1.f + __expf(-r1)));
            const float y2 = o[i][4 * g + 2] * rstd * gg.z * (r2 / (1.f + __expf(-r2))), y3 = o[i][4 * g + 3] * rstd * gg.w * (r3_ / (1.f + __expf(-r3_)));
            u32x2 v = {pk2(y0, y1), pk2(y2, y3)}; *(u32x2*)(mx + i * 32 + 8 * g) = v;
        }
    __syncthreads();
}
__device__ __forceinline__ void ph_gla_c(const Ptrs& P, LAS unsigned char* smem, int bid, int nblk) {
    for (int item = bid; item < 4 * 4 * 68; item += nblk) gla_pass_c_item(P, item, smem);
}

#define XB_TMO      128
#define XB_XCNT(j)  (256  + 64 * (j))
#define XB_XSUB(j)  (1280 + 64 * (j))
#define XB_XGEN(j)  (2304 + 64 * (j))
#define XB_TOP      3328
#define XB_TOPGEN   3392
#define XB_SPIN_CAP (1u << 20)
constexpr int CTL_BAR = 4096;
__device__ __forceinline__ unsigned xb_ld(unsigned* p) { return __hip_atomic_load(p, __ATOMIC_RELAXED, __HIP_MEMORY_SCOPE_AGENT); }
__device__ __forceinline__ unsigned xb_add(unsigned* p, unsigned v) { return __hip_atomic_fetch_add(p, v, __ATOMIC_RELAXED, __HIP_MEMORY_SCOPE_AGENT); }
__device__ __forceinline__ unsigned xb_xcc_id() { return (unsigned)__builtin_amdgcn_s_getreg((3 << 11) | 20) & 0xFu; }
#define XB_SPIN(cond, bar) do { unsigned _sp = 0; while (cond) { __builtin_amdgcn_s_sleep(1); \
    if ((++_sp & 255u) == 0u) { if (xb_ld(&(bar)[XB_TMO])) break; if (_sp > XB_SPIN_CAP) { atomicAdd(&(bar)[XB_TMO], 1u); break; } } } } while (0)
struct XcdBarrier { unsigned* bar; unsigned x; volatile LAS unsigned* st; };
__device__ __forceinline__ XcdBarrier xcd_barrier_post(unsigned* bar, volatile LAS unsigned* st) {
    XcdBarrier b; b.bar = bar; b.x = xb_xcc_id(); b.st = st;
    if (threadIdx.x == 0) (void)xb_add(&bar[XB_XCNT(b.x)], 1u);
    return b;
}
__device__ __forceinline__ void xcd_barrier_complete(unsigned* bar, unsigned x, unsigned& nloc, unsigned& nx) {
    const unsigned G = gridDim.x * gridDim.y * gridDim.z;
    unsigned sum, cnt, mine, sp = 0u;
    for (;;) {
        sum = 0u; cnt = 0u; mine = 0u;
#pragma unroll
        for (unsigned j = 0; j < 16; ++j) { const unsigned c = xb_ld(&bar[XB_XCNT(j)]); sum += c; cnt += (c > 0u) ? 1u : 0u; mine = (j == x) ? c : mine; }
        if (sum == G) break;
        __builtin_amdgcn_s_sleep(1);
        if ((++sp & 255u) == 0u) { if (xb_ld(&bar[XB_TMO])) break; if (sp > XB_SPIN_CAP) { atomicAdd(&bar[XB_TMO], 1u); break; } }
    }
    nloc = mine > 0u ? mine : 1u; nx = cnt > 0u ? cnt : 1u;
}
__device__ __forceinline__ void xcd_barrier(const XcdBarrier& b) {
    asm volatile("s_waitcnt vmcnt(0)" ::: "memory");
    __syncthreads();
    if (threadIdx.x == 0) {
        unsigned* bar = b.bar;
        __builtin_amdgcn_s_waitcnt(0);
        unsigned nloc = b.st[0], nx = b.st[1];
        if (nloc == 0u) { xcd_barrier_complete(bar, b.x, nloc, nx); b.st[0] = nloc; b.st[1] = nx; }
        const unsigned old = xb_add(&bar[XB_XSUB(b.x)], 1u);
        const unsigned gen = old / nloc;
        if (old + 1u == (gen + 1u) * nloc) {
            __builtin_amdgcn_fence(__ATOMIC_RELEASE, "agent");
            asm volatile("s_waitcnt vmcnt(0)" ::: "memory");
            const unsigned og = xb_add(&bar[XB_TOP], 1u);
            const unsigned tg = og / nx;
            if (og + 1u == (tg + 1u) * nx) xb_add(&bar[XB_TOPGEN], 1u);
            else XB_SPIN(xb_ld(&bar[XB_TOPGEN]) == tg, bar);
            __builtin_amdgcn_fence(__ATOMIC_ACQUIRE, "agent");
            xb_add(&bar[XB_XGEN(b.x)], 1u);
            asm volatile("s_waitcnt vmcnt(0)" ::: "memory");
        } else {
            XB_SPIN(xb_ld(&bar[XB_XGEN(b.x)]) == gen, bar);
            __builtin_amdgcn_fence(__ATOMIC_ACQUIRE, "agent");
            asm volatile("s_waitcnt vmcnt(0)" ::: "memory");
        }
    }
    __syncthreads();
}

constexpr int N_PHASES = 18;
constexpr int SMEM_BYTES = GEMM_LDS + 2048;
struct Args { Ptrs P; int ph_lo, ph_hi; };
__global__ void __launch_bounds__(256, 2) fwd_megakernel(Args args) {
    __shared__ __attribute__((aligned(16))) unsigned char smem_raw[SMEM_BYTES];
    LAS unsigned char* smem = (LAS unsigned char*)smem_raw;
    const Ptrs& P = args.P;
    const int bid = blockIdx.x, nblk = gridDim.x;
    volatile LAS unsigned* bst = (volatile LAS unsigned*)(smem + GEMM_LDS + 128);
    if (threadIdx.x < 2) bst[threadIdx.x] = 0u;
    __syncthreads();
    XcdBarrier bar; bar.bar = (unsigned*)(P.ws + WS_CTL) + CTL_BAR; bar.x = 0; bar.st = bst;
    const bool multi = args.ph_hi - args.ph_lo > 1;
    if (multi) bar = xcd_barrier_post((unsigned*)(P.ws + WS_CTL) + CTL_BAR, bst);
    const int lo = args.ph_lo, hi = args.ph_hi;
#define PHASE(k, call) if (lo <= (k) && (k) < hi) { if ((k) > lo) xcd_barrier(bar); call; }
    PHASE(0, ph_prologue(P, smem, bid, nblk))
    PHASE(1, ph_modulate(P, 0, bid, nblk))
    PHASE(2, ph_even_inproj(P, smem, bid, nblk))
    PHASE(3, ph_gla_a(P, smem, bid, nblk))
    PHASE(4, gla_pass_b(P, bid * 256 + threadIdx.x, nblk * 256))
    PHASE(5, (ph_dense_attn(P, smem, bid, nblk), __syncthreads(), ph_gla_c(P, smem, (bid + nblk - 128) % nblk, nblk)))
    PHASE(7, ph_outproj(P, smem, bid, nblk, 0, NT))
    PHASE(8, (ph_moe_route(P, smem, bid, nblk, 0, NT), fold_odd_inproj(P, bid, nblk), route_tables(P, 1, bid, nblk)))
    PHASE(9, ph_moe_stage1(P, smem, bid, nblk, 0))
    PHASE(10, ph_moe_stage2(P, smem, bid, nblk, 0))
    PHASE(12, ph_odd_inproj(P, smem, bid, nblk))
    PHASE(13, ph_swa_attn(P, smem, bid, nblk))
    PHASE(14, ph_outproj(P, smem, bid, nblk, 1, NL))
    PHASE(15, ph_moe_route(P, smem, bid, nblk, 1, NL))
    PHASE(16, ph_moe_stage1(P, smem, bid, nblk, 1))
    PHASE(17, ph_moe_stage2(P, smem, bid, nblk, 1))
#undef PHASE
}

#ifndef MK_LAUNCHES
#define MK_LAUNCHES 1
#endif
extern "C" void kernel_launch(void* const* d_in, const int* in_sizes, int n_in, void* d_out, int out_size, void* d_ws, size_t ws_size, hipStream_t stream) {
    static int grid = 0;
    if (grid == 0) {
        int dev = 0, cus = 0, per_cu = 0;
        hipGetDevice(&dev);
        hipDeviceGetAttribute(&cus, hipDeviceAttributeMultiprocessorCount, dev);
        hipOccupancyMaxActiveBlocksPerMultiprocessor(&per_cu, (const void*)fwd_megakernel, 256, 0);
        if (per_cu > 2) per_cu = 2;
        if (per_cu < 1) per_cu = 1;
        grid = cus * per_cu;
    }
    hipMemsetAsync((unsigned char*)d_ws + WS_CTL, 0, 65536, stream);
    Args a{};
    for (int i = 0; i < 27; ++i) a.P.in[i] = (const float*)d_in[i];
    a.P.out = (float*)d_out; a.P.ws = (unsigned char*)d_ws;
#if MK_LAUNCHES == 1
    a.ph_lo = 0; a.ph_hi = N_PHASES;
    void* kargs[] = {&a};
    hipLaunchCooperativeKernel((const void*)fwd_megakernel, dim3(grid), dim3(256), kargs, 0, stream);
#else
    for (int ph = 0; ph < N_PHASES; ++ph) { a.ph_lo = ph; a.ph_hi = ph + 1; hipLaunchKernelGGL(fwd_megakernel, dim3(grid), dim3(256), 0, stream, a); }
#endif
}
```

```cpp
#include <hip/hip_runtime.h>
#include <stdint.h>

typedef unsigned short bf16;
__device__ __forceinline__ float bf2f(bf16 v) { return __uint_as_float(((unsigned)v) << 16); }
__device__ __forceinline__ bf16 f2bf(float f) { unsigned u = __float_as_uint(f); return (bf16)((u + 0x7fffu + ((u >> 16) & 1u)) >> 16); }

constexpr int D = 1024, NB = 4, S = 4096, CL = 256, NL = NB * S, NC = NB * CL, NT = NL + NC;
constexpr int EVEN_IN = 2336, ODD_IN = 1280;
constexpr float EPS = 1e-6f;

__device__ __forceinline__ float silu(float x) { return x / (1.f + expf(-x)); }
__device__ __forceinline__ float wave_sum(float v) {
#pragma unroll
    for (int o = 1; o < 64; o <<= 1) v += __shfl_xor(v, o);
    return v;
}

#define LAS __attribute__((address_space(3)))
typedef short bf16x8 __attribute__((ext_vector_type(8)));
typedef float f32x16 __attribute__((ext_vector_type(16)));
typedef float f32x4 __attribute__((ext_vector_type(4)));
typedef unsigned u32x4 __attribute__((ext_vector_type(4)));
typedef unsigned u32x2 __attribute__((ext_vector_type(2)));
typedef __bf16 bf16x2_t __attribute__((ext_vector_type(2)));
typedef float f32x2_t __attribute__((ext_vector_type(2)));
__device__ __forceinline__ unsigned pk2(float lo, float hi) { f32x2_t v = {lo, hi}; bf16x2_t b = __builtin_convertvector(v, bf16x2_t); return __builtin_bit_cast(unsigned, b); }
__device__ __forceinline__ float xhalf_sum(float x) {
    auto t = __builtin_amdgcn_permlane32_swap(__float_as_uint(x), __float_as_uint(x), false, false);
    return __uint_as_float(t[0]) + __uint_as_float(t[1]);
}

constexpr float QSCALE = 0.125f * 1.4426950408889634f;
constexpr int NPAD_E = 2432;
constexpr int TILE_LDS = 128 * 128;
constexpr int GEMM_LDS = 4 * TILE_LDS;

__device__ __forceinline__ void transpose_item(const float* W, int K, int N, bf16* WT, int dst_row0, int k0, int n0, LAS float* scr, int lane) {
    float tv[32];
#pragma unroll
    for (int i = 0; i < 32; ++i) tv[i] = W[(size_t)(k0 + 2 * i + (lane >> 5)) * N + n0 + (lane & 31)];
#pragma unroll
    for (int i = 0; i < 32; ++i) scr[(2 * i + (lane >> 5)) * 33 + (lane & 31)] = tv[i];
    asm volatile("s_waitcnt lgkmcnt(0)" ::: "memory");
    const int c = lane & 7;
#pragma unroll
    for (int j = 0; j < 4; ++j) {
        const int n = (lane >> 3) + 8 * j; const LAS float* s = scr + (8 * c) * 33 + n;
        u32x4 o; o.x = pk2(s[0 * 33], s[1 * 33]); o.y = pk2(s[2 * 33], s[3 * 33]); o.z = pk2(s[4 * 33], s[5 * 33]); o.w = pk2(s[6 * 33], s[7 * 33]);
        *(u32x4*)(WT + (size_t)(dst_row0 + n) * K + k0 + 8 * c) = o;
    }
    asm volatile("s_waitcnt lgkmcnt(0)" ::: "memory");
}

struct Ptrs {
    const float* in[27];
    float* out;
    unsigned char* ws;
};

constexpr size_t MiB = 1u << 20;
constexpr size_t WS_CTL = 0;
constexpr size_t WS_MODV = 1 * MiB;
constexpr size_t WS_ROPE = WS_MODV + 256 * 1024;
constexpr size_t WS_WINE = 2 * MiB;
constexpr size_t WS_WOUTE = WS_WINE + (size_t)NPAD_E * 1024 * 2;
constexpr size_t WS_WINO = WS_WOUTE + 2 * MiB;
constexpr size_t WS_WOUTO = WS_WINO + (size_t)1280 * 1024 * 2;
constexpr size_t WS_WGU = WS_WOUTO + 2 * MiB;
constexpr size_t WS_WD = WS_WGU + 32 * MiB;
constexpr size_t WS_CTXS = WS_WD + 16 * MiB;
constexpr size_t WS_R1 = 66 * MiB;
constexpr size_t WS_R4 = WS_R1 + 34 * MiB;
constexpr size_t WS_R2 = WS_R4 + 34 * MiB;
constexpr size_t WS_R3 = WS_R2 + 34 * MiB;
static_assert(WS_CTXS + 4 * MiB <= WS_R1, "ws map");
constexpr size_t R3_GQ = 0, R3_GK = R3_GQ + (size_t)NT * 256 * 2, R3_GV = R3_GK + (size_t)NT * 256 * 2, R3_GR = R3_GV + (size_t)NT * 512 * 2,
                 R3_LR = R3_GR + (size_t)NT * 512 * 2, R3_AQ = R3_LR + (size_t)NT * 32 * 4, R3_AK = R3_AQ + (size_t)NT * 512 * 2, R3_AV = R3_AK + (size_t)NT * 128 * 2,
                 R3_END = R3_AV + (size_t)NT * 128 * 2;
static_assert(WS_R3 + R3_END <= 256 * MiB, "ws map end");
constexpr size_t R3_OQ = 0, R3_OK = R3_OQ + (size_t)NL * 1024 * 2, R3_OV = R3_OK + (size_t)NT * 128 * 2;
constexpr size_t WS_WRT = 250 * MiB, WS_SL = 252 * MiB;
constexpr size_t WRT_STRIDE = 768 * 1024;
constexpr size_t WS_RSS = 253 * MiB;
constexpr size_t WS_BI = WS_RSS + 128 * 1024;
constexpr size_t WS_WINOF = WS_R3 + 48 * MiB;
static_assert(WS_WINOF + (size_t)5 * 1280 * 1024 * 2 <= WS_R3 + R3_END && WS_BI + 5 * 1280 * 4 <= 254 * MiB && WS_WRT + 2 * WRT_STRIDE <= WS_SL, "fold buffers");

__device__ __forceinline__ void ph_prologue(const Ptrs& P, LAS unsigned char* smem, int bid, int nblk) {
    const int lane = threadIdx.x & 63, wave = threadIdx.x >> 6;
    LAS float* scr = (LAS float*)smem + wave * 64 * 33;
    const int gw = bid * 4 + wave, NGW = nblk * 4;
    unsigned char* ws = P.ws;
    constexpr int I_WINE = 16 * 73, I_SQ = 16 * 32, I_WINO = 16 * 40, I_EXP_GU = 16 * 8, I_EXP_D = 4 * 32;
    constexpr int T_WINE = I_WINE, T_WOUTE = T_WINE + I_SQ, T_WINO = T_WOUTE + I_WINO, T_WOUTO = T_WINO + I_SQ,
                  T_G = T_WOUTO + 32 * I_EXP_GU, T_U = T_G + 32 * I_EXP_GU, T_D = T_U + 32 * I_EXP_D;
    for (int it = gw; it < T_D; it += NGW) {
        if (it < T_WINE) {
            int kb = it / 73, nb = it % 73, n0 = nb * 32;
            int dst = n0 < 1536 ? n0 : (n0 < 1568 ? n0 + 768 : n0 - 32);
            transpose_item(P.in[8], 1024, EVEN_IN, (bf16*)(ws + WS_WINE), dst, kb * 64, n0, scr, lane);
        } else if (it < T_WOUTE) { int r = it - T_WINE; transpose_item(P.in[9], 1024, 1024, (bf16*)(ws + WS_WOUTE), (r % 32) * 32, (r / 32) * 64, (r % 32) * 32, scr, lane); }
        else if (it < T_WINO) { int r = it - T_WOUTE; transpose_item(P.in[15], 1024, 1280, (bf16*)(ws + WS_WINO), (r % 40) * 32, (r / 40) * 64, (r % 40) * 32, scr, lane); }
        else if (it < T_WOUTO) { int r = it - T_WINO; transpose_item(P.in[16], 1024, 1024, (bf16*)(ws + WS_WOUTO), (r % 32) * 32, (r / 32) * 64, (r % 32) * 32, scr, lane); }
        else if (it < T_U) {
            bool up = it >= T_G; int r = it - (up ? T_G : T_WOUTO); int le = r / I_EXP_GU; r %= I_EXP_GU; int kb = r / 8, hb = r % 8;
            const float* W = (up ? P.in[25] : P.in[24]) + (size_t)le * 1024 * 256;
            transpose_item(W, 1024, 256, (bf16*)(ws + WS_WGU) + (size_t)le * 512 * 1024, 64 * hb + (up ? 32 : 0), kb * 64, hb * 32, scr, lane);
        } else {
            int r = it - T_U; int le = r / I_EXP_D; r %= I_EXP_D; int kb = r / 32, nb = r % 32;
            transpose_item(P.in[26] + (size_t)le * 256 * 1024, 256, 1024, (bf16*)(ws + WS_WD) + (size_t)le * 1024 * 256, nb * 32, kb * 64, nb * 32, scr, lane);
        }
    }
    { u32x4 z = {0, 0, 0, 0}; u32x4* p = (u32x4*)((bf16*)(ws + WS_WINE) + (size_t)EVEN_IN * 1024);
      for (int i = bid * 256 + threadIdx.x; i < 96 * 1024 * 2 / 16; i += nblk * 256) p[i] = z; }
    for (int i = bid * 256 + threadIdx.x; i < 1024; i += nblk * 256) {
        int pos = i >> 4, f = i & 15; float inv = powf(10000.f, -(float)(2 * f) / 32.f); float ang = (float)pos * inv;
        ((float2*)(ws + WS_ROPE))[i] = make_float2(cosf(ang), sinf(ang));
    }
    for (int i = bid * 256 + threadIdx.x; i < NT; i += nblk * 256) ((float*)(ws + WS_RSS))[i] = 0.f;
    if (bid == 0 && threadIdx.x < 2) {
        const float* gq = threadIdx.x ? P.in[18] : P.in[13]; const float* gk = threadIdx.x ? P.in[19] : P.in[14];
        float mq = 0.f, mk = 0.f; for (int d = 0; d < 64; ++d) { mq = fmaxf(mq, fabsf(gq[d])); mk = fmaxf(mk, fabsf(gk[d])); }
        ((float*)(ws + WS_ROPE + 8192))[threadIdx.x] = 8.f * mq * mk * 1.4426950408889634f;
    }
    __syncthreads();
    {
        LAS float* sc = (LAS float*)smem;
        LAS float* red = (LAS float*)smem + 5 * 1024;
        for (int i = threadIdx.x; i < 5 * 1024; i += 256) { const float cv = i < 4096 ? P.in[1][i] : P.in[3][i - 4096]; sc[i] = cv / (1.f + expf(-cv)); }
        __syncthreads();
        for (int it = bid; it < 2 * 96; it += nblk) {
            const int layer = it / 96, col = (it % 96) * 64 + lane;
            const float* w = P.in[4] + (size_t)layer * D * 6144 + col;
            float a0 = 0.f, a1 = 0.f, a2 = 0.f, a3 = 0.f, a4 = 0.f;
#pragma unroll 32
            for (int k = 256 * wave; k < 256 * wave + 256; ++k) { const float wv = w[(size_t)k * 6144]; a0 += sc[k] * wv; a1 += sc[1024 + k] * wv; a2 += sc[2048 + k] * wv; a3 += sc[3072 + k] * wv; a4 += sc[4096 + k] * wv; }
            red[(wave * 5 + 0) * 64 + lane] = a0; red[(wave * 5 + 1) * 64 + lane] = a1; red[(wave * 5 + 2) * 64 + lane] = a2; red[(wave * 5 + 3) * 64 + lane] = a3; red[(wave * 5 + 4) * 64 + lane] = a4;
            __syncthreads();
            for (int i = threadIdx.x; i < 320; i += 256) { const int row = i >> 6, cl = i & 63;
                ((float*)(ws + WS_MODV))[((size_t)layer * 5 + row) * 6144 + (it % 96) * 64 + cl] = red[row * 64 + cl] + red[(5 + row) * 64 + cl] + red[(10 + row) * 64 + cl] + red[(15 + row) * 64 + cl] + P.in[5][layer * 6144 + (it % 96) * 64 + cl]; }
            __syncthreads();
        }
    }
}

template <bool SRC_BF>
__device__ __forceinline__ void modulate_rows(const float* xlat, const float* xctx, const bf16* xs, const float* modv_layer, const float* gain, int which, bf16* H, int nrows, int gw, int NGW, int lane) {
    for (int row = gw; row < nrows; row += NGW) {
        const float* mv = modv_layer + (size_t)(row < NL ? row / S : 4) * 6144;
        f32x4 v[4]; float ss = 0.f;
#pragma unroll
        for (int j = 0; j < 4; ++j) {
            if (SRC_BF) { const u32x2 w = *(const u32x2*)(xs + (size_t)row * D + 4 * lane + 256 * j); f32x4 t = {__uint_as_float(w.x << 16), __uint_as_float(w.x & 0xffff0000u), __uint_as_float(w.y << 16), __uint_as_float(w.y & 0xffff0000u)}; v[j] = t; }
            else { const float* xr = row < NL ? xlat + (size_t)row * D : xctx + (size_t)(row - NL) * D; v[j] = *(const f32x4*)(xr + 4 * lane + 256 * j); }
            ss += v[j].x * v[j].x + v[j].y * v[j].y + v[j].z * v[j].z + v[j].w * v[j].w;
        }
        float rstd = rsqrtf(wave_sum(ss) / D + EPS);
#pragma unroll
        for (int j = 0; j < 4; ++j) {
            int k = 4 * lane + 256 * j;
            f32x4 g = *(const f32x4*)(gain + k), sc = *(const f32x4*)(mv + (which + 1) * 1024 + k), sh = *(const f32x4*)(mv + which * 1024 + k);
            float h0 = v[j].x * rstd * g.x * (1.f + sc.x) + sh.x, h1 = v[j].y * rstd * g.y * (1.f + sc.y) + sh.y;
            float h2 = v[j].z * rstd * g.z * (1.f + sc.z) + sh.z, h3 = v[j].w * rstd * g.w * (1.f + sc.w) + sh.w;
            u32x2 o = {pk2(h0, h1), pk2(h2, h3)};
            *(u32x2*)(H + (size_t)row * D + k) = o;
        }
    }
}
__device__ __forceinline__ void route_tables(const Ptrs& P, int layer, int bid, int nblk);
__device__ __forceinline__ void ph_modulate(const Ptrs& P, int layer, int bid, int nblk) {
    route_tables(P, layer, bid, nblk);
    if (layer == 0) modulate_rows<false>(P.in[0], P.in[2], nullptr, (const float*)(P.ws + WS_MODV), P.in[6], 0, (bf16*)(P.ws + WS_R1), NT, bid * 4 + (threadIdx.x >> 6), nblk * 4, threadIdx.x & 63);
    else modulate_rows<true>(nullptr, nullptr, (const bf16*)(P.ws + WS_R4), (const float*)(P.ws + WS_MODV) + (size_t)5 * 6144, P.in[6] + D, 0, (bf16*)(P.ws + WS_R1), NT, bid * 4 + (threadIdx.x >> 6), nblk * 4, threadIdx.x & 63);
}

struct AffineRows {
    const bf16* base; size_t ld; int w; unsigned vo[4];
    __device__ __forceinline__ AffineRows(const bf16* b, size_t ld_) : base(b), ld(ld_), w(0) {}
    __device__ __forceinline__ void init(int w_, int rl, const int (&co)[4]) { w = w_;
#pragma unroll
        for (int i = 0; i < 4; ++i) vo[i] = (unsigned)((rl * ld + co[i]) * 2); }
    __device__ __forceinline__ const bf16* sb(int i, int kt) const { return base + (size_t)(32 * w + 8 * i) * ld + kt * 64; }
};
template <bool SWP, class AF, class BF, class Epi>
__device__ __forceinline__ void gemm_tile(AF af, BF bf, int nk, LAS unsigned char* smem, const Epi& epi) {
    const int tid = threadIdx.x, lane = tid & 63, wave = __builtin_amdgcn_readfirstlane(tid >> 6), wn = wave & 1, wm = wave >> 1, l31 = lane & 31, hh = lane >> 5;
    const int r0 = wave * 32 + (lane >> 3);
    __syncthreads();
    typename Epi::Pre pre; epi.prefetch(pre, wn * 64, wm * 64, l31, hh);
    __builtin_amdgcn_sched_barrier(0);
    int coff[4];
#pragma unroll
    for (int i = 0; i < 4; ++i) coff[i] = ((lane & 7) ^ (((r0 >> 1) + 4 * i) & 7)) * 8;
    af.init(wave, lane >> 3, coff); bf.init(wave, lane >> 3, coff);
#define GT_STAGE(st, kt) do { _Pragma("unroll") for (int i = 0; i < 4; ++i) { \
        __builtin_amdgcn_global_load_lds((const unsigned*)((const char*)af.sb(i, (kt)) + af.vo[i]), (LAS unsigned*)(smem + (st) * 2 * TILE_LDS + (wave * 4 + i) * 1024), 16, 0, 0); \
        __builtin_amdgcn_global_load_lds((const unsigned*)((const char*)bf.sb(i, (kt)) + bf.vo[i]), (LAS unsigned*)(smem + (st) * 2 * TILE_LDS + TILE_LDS + (wave * 4 + i) * 1024), 16, 0, 0); } } while (0)
    GT_STAGE(0, 0);
    f32x16 acc[2][2];
#pragma unroll
    for (int i = 0; i < 2; ++i)
#pragma unroll
        for (int j = 0; j < 2; ++j)
#pragma unroll
            for (int r = 0; r < 16; ++r) acc[i][j][r] = 0.f;
    const int sw = (l31 >> 1) & 7;
    int xo[4], wo[4];
#pragma unroll
    for (int s = 0; s < 4; ++s) { const int cs = ((2 * s + hh) ^ sw) * 16; xo[s] = (wm * 64 + l31) * 128 + cs; wo[s] = TILE_LDS + (wn * 64 + l31) * 128 + cs; }
    asm volatile("s_waitcnt vmcnt(0)" ::: "memory");
    __syncthreads();
    for (int kt = 0; kt < nk; ++kt) {
        const int st = kt & 1;
        if (kt + 1 < nk) GT_STAGE(st ^ 1, kt + 1);
        LAS unsigned char* sb = smem + st * 2 * TILE_LDS;
#pragma unroll
        for (int s = 0; s < 4; ++s) {
            bf16x8 wf[2], xf[2];
#pragma unroll
            for (int i = 0; i < 2; ++i) wf[i] = *(LAS bf16x8*)(sb + wo[s] + i * 4096);
#pragma unroll
            for (int j = 0; j < 2; ++j) xf[j] = *(LAS bf16x8*)(sb + xo[s] + j * 4096);
#pragma unroll
            for (int i = 0; i < 2; ++i)
#pragma unroll
                for (int j = 0; j < 2; ++j) acc[i][j] = SWP ? __builtin_amdgcn_mfma_f32_32x32x16_bf16(xf[j], wf[i], acc[i][j], 0, 0, 0)
                                                            : __builtin_amdgcn_mfma_f32_32x32x16_bf16(wf[i], xf[j], acc[i][j], 0, 0, 0);
        }
        asm volatile("s_waitcnt vmcnt(0)" ::: "memory");
        __syncthreads();
    }
#undef GT_STAGE
    { int l31e = l31, hhe = hh, we = wave; asm volatile("" : "+v"(l31e), "+v"(hhe), "+v"(we));
      epi(acc, (we & 1) * 64, (we >> 1) * 64, l31e, hhe, smem + we * 16384, pre); }
}

constexpr int SG_P = 144;
__device__ __forceinline__ void store_bf16_T(const f32x16 (&acc)[2][2], bf16* out, size_t ld, size_t trow0, int col0, int l31, int hh, LAS unsigned char* wl) {
#pragma unroll
    for (int j = 0; j < 2; ++j)
#pragma unroll
        for (int i = 0; i < 2; ++i)
#pragma unroll
            for (int g = 0; g < 4; ++g) { u32x2 v = {pk2(acc[i][j][4 * g], acc[i][j][4 * g + 1]), pk2(acc[i][j][4 * g + 2], acc[i][j][4 * g + 3])}; *(LAS u32x2*)(wl + (32 * j + l31) * SG_P + (32 * i + 8 * g + 4 * hh) * 2) = v; }
    const int lane = l31 + 32 * hh, rr = lane >> 3, ch = lane & 7;
#pragma unroll
    for (int q = 0; q < 8; ++q) { const int R = 8 * q + rr; const u32x4 v = *(LAS u32x4*)(wl + R * SG_P + ch * 16); *(u32x4*)(out + (trow0 + R) * ld + col0 + ch * 8) = v; }
}
__device__ __forceinline__ void qknorm_rope_T(f32x16 (&acc)[2][2], const float* gain, const float2* ropeT, bool latent, int tok0  , int l31, int hh, float oscale = 1.f) {
#pragma unroll
    for (int j = 0; j < 2; ++j) {
        float ss = 0.f;
#pragma unroll
        for (int i = 0; i < 2; ++i)
#pragma unroll
            for (int r = 0; r < 16; ++r) ss += acc[i][j][r] * acc[i][j][r];
        ss = xhalf_sum(ss);
        const float rstd = rsqrtf(ss * (1.f / 64.f) + EPS) * oscale;
#pragma unroll
        for (int i = 0; i < 2; ++i)
#pragma unroll
            for (int r = 0; r < 16; ++r) acc[i][j][r] *= rstd * gain[i * 32 + (r & 3) + 8 * (r >> 2) + 4 * hh];
        if (latent) {
            const int t = tok0 + j * 32 + l31;
#pragma unroll
            for (int i = 0; i < 2; ++i) {
                const int pos = i == 0 ? (t >> 6) : (t & 63);
#pragma unroll
                for (int r = 0; r < 8; ++r) {
                    const int f = (r & 3) + 8 * (r >> 2) + 4 * hh;
                    const float2 cs = ropeT[pos * 16 + f];
                    const float x1 = acc[i][j][r], x2 = acc[i][j][r + 8];
                    acc[i][j][r] = x1 * cs.x - x2 * cs.y; acc[i][j][r + 8] = x2 * cs.x + x1 * cs.y;
                }
            }
        }
    }
}

constexpr int VT_LD = S + CL;
__device__ __forceinline__ void store_vt_swapped(const f32x16 (&acc)[2][2], bf16* vt_head  , int key0, int l31, int hh, LAS unsigned char* wl) {
#pragma unroll
    for (int i = 0; i < 2; ++i)
#pragma unroll
        for (int j = 0; j < 2; ++j)
#pragma unroll
            for (int g = 0; g < 4; ++g) { u32x2 v = {pk2(acc[i][j][4 * g], acc[i][j][4 * g + 1]), pk2(acc[i][j][4 * g + 2], acc[i][j][4 * g + 3])}; *(LAS u32x2*)(wl + (32 * i + l31) * SG_P + (32 * j + 8 * g + 4 * hh) * 2) = v; }
    const int lane = l31 + 32 * hh, rr = lane >> 3, ch = lane & 7;
#pragma unroll
    for (int q = 0; q < 8; ++q) { const int R = 8 * q + rr; const u32x4 v = *(LAS u32x4*)(wl + R * SG_P + ch * 16); *(u32x4*)(vt_head + (size_t)R * VT_LD + key0 + ch * 8) = v; }
}
struct NoPre {};
template <bool SRC_BF> struct RmwPre { f32x4 xi[16]; };
template <> struct RmwPre<true> { u32x2 xi[16]; };
template <bool SRC_BF, class RowF>
__device__ __forceinline__ void rmw_prefetch(RmwPre<SRC_BF>& pre, const RowF& rowf, int l31, int hh) {
    const int lane = l31 + 32 * hh, rr = lane >> 4, ch = lane & 15;
#pragma unroll
    for (int q = 0; q < 16; ++q) {
        const void* sp; void* dp; const float* gp; int tk;
        if (rowf(4 * q + rr, sp, dp, gp, tk)) {
            if constexpr (SRC_BF) pre.xi[q] = *(const u32x2*)((const bf16*)sp + ch * 4); else pre.xi[q] = *(const f32x4*)((const float*)sp + ch * 4);
        }
    }
}
template <bool SRC_BF, bool DST_BF, bool SS, class RowF>
__device__ __forceinline__ void rmw_finish(const f32x16 (&acc)[2][2], const RmwPre<SRC_BF>& pre, const RowF& rowf, int l31, int hh, LAS unsigned char* wl, float* rss = nullptr) {
    const int lane = l31 + 32 * hh, rr = lane >> 4, ch = lane & 15;
#pragma unroll
    for (int j = 0; j < 2; ++j)
#pragma unroll
        for (int i = 0; i < 2; ++i)
#pragma unroll
            for (int g = 0; g < 4; ++g) { f32x4 v = {acc[i][j][4 * g], acc[i][j][4 * g + 1], acc[i][j][4 * g + 2], acc[i][j][4 * g + 3]};
                const int R = 32 * j + l31; *(LAS f32x4*)(wl + R * 256 + (((8 * i + 2 * g + hh) ^ (R & 15)) * 16)) = v; }
    float ssr[16];
#pragma unroll
    for (int q = 0; q < 16; ++q) {
        const void* sp; void* dp; const float* gp; int tk = 0;
        const bool ok = rowf(4 * q + rr, sp, dp, gp, tk);
        float ssq = 0.f;
        if (ok) {
            f32x4 x;
            if constexpr (SRC_BF) { const u32x2 w = pre.xi[q]; f32x4 t = {__uint_as_float(w.x << 16), __uint_as_float(w.x & 0xffff0000u), __uint_as_float(w.y << 16), __uint_as_float(w.y & 0xffff0000u)}; x = t; } else x = pre.xi[q];
            const int R = 4 * q + rr; const f32x4 a = *(LAS f32x4*)(wl + R * 256 + ((ch ^ (R & 15)) * 16)); const f32x4 gt = *(const f32x4*)(gp + ch * 4);
            const f32x4 v = {x.x + gt.x * a.x, x.y + gt.y * a.y, x.z + gt.z * a.z, x.w + gt.w * a.w};
            if (DST_BF) { u32x2 o = {pk2(v.x, v.y), pk2(v.z, v.w)}; *(u32x2*)((bf16*)dp + ch * 4) = o;
                if (SS) { const float r0 = __uint_as_float(o.x << 16), r1 = __uint_as_float(o.x & 0xffff0000u), r2 = __uint_as_float(o.y << 16), r3 = __uint_as_float(o.y & 0xffff0000u); ssq = (r0 * r0 + r1 * r1) + (r2 * r2 + r3 * r3); } }
            else *(f32x4*)((float*)dp + ch * 4) = v;
        }
        if (SS) { ssq += __shfl_xor(ssq, 1); ssq += __shfl_xor(ssq, 2); ssq += __shfl_xor(ssq, 4); ssq += __shfl_xor(ssq, 8); ssr[q] = ssq; }
    }
    if (SS) {
        if (ch == 0) {
#pragma unroll
            for (int q = 0; q < 16; ++q) *(LAS float*)(wl + (4 * q + rr) * 4) = ssr[q];
        }
        const float sv = *(LAS float*)(wl + lane * 4);
        const void* sp; void* dp; const float* gp; int tk = 0;
        if (rowf(lane, sp, dp, gp, tk)) atomicAdd(rss + tk, sv);
    }
}
struct EpiEvenIn {
    typedef NoPre Pre;
    __device__ __forceinline__ void prefetch(Pre&, int, int, int, int) const {}
    unsigned char* r3; const float* qn; const float* kn; const float2* ropeT; int mt, nt;
    __device__ __forceinline__ bool swapped() const { return nt == 17 || (nt >= 4 && nt < 8); }
    __device__ __forceinline__ void operator()(f32x16 (&acc)[2][2], int fb, int tb, int l31, int hh, LAS unsigned char* wl, const Pre& pre) const {
        const size_t trow0 = (size_t)mt * 128 + tb; const bool latent = mt < NL / 128; const int tok0 = (int)(trow0 & (S - 1));
        if (swapped()) {
            const int b = latent ? (int)(trow0 / S) : (int)((trow0 - NL) / CL); const int key0 = latent ? tok0 : S + (int)((trow0 - NL) % CL);
            const size_t off = nt == 17 ? R3_AV + (size_t)(b * 2 + fb / 64) * 64 * VT_LD * 2 : R3_GV + ((size_t)(b * 4 + nt - 4) * 128 + fb) * VT_LD * 2;
            store_vt_swapped(acc, (bf16*)(r3 + off), key0, l31, hh, wl);
        } else if (nt == 18) {
            if (fb == 0) {
                float* LR = (float*)(r3 + R3_LR);
#pragma unroll
                for (int j = 0; j < 2; ++j)
#pragma unroll
                    for (int g = 0; g < 4; ++g) { f32x4 v = {acc[0][j][4 * g], acc[0][j][4 * g + 1], acc[0][j][4 * g + 2], acc[0][j][4 * g + 3]}; *(f32x4*)(LR + (trow0 + j * 32 + l31) * 32 + 8 * g + 4 * hh) = v; }
            }
        } else {
            size_t off; int ld, col;
            if (nt < 2) { off = R3_GQ; ld = 256; col = nt * 128; }
            else if (nt < 4) { off = R3_GK; ld = 256; col = (nt - 2) * 128; }
            else if (nt < 12) { off = R3_GR; ld = 512; col = (nt - 8) * 128; }
            else if (nt < 16) { off = R3_AQ; ld = 512; col = (nt - 12) * 128; }
            else { off = R3_AK; ld = 128; col = 0; }
            if (nt >= 12) qknorm_rope_T(acc, nt < 16 ? qn : kn, ropeT, latent, tok0, l31, hh, nt < 16 ? QSCALE : 1.f);
            store_bf16_T(acc, (bf16*)(r3 + off), ld, trow0, col + fb, l31, hh, wl);
        }
    }
};
__device__ __forceinline__ int xcd_vid(int bid, int nb) { return (nb % 8 == 0) ? (bid % 8) * (nb / 8) + bid / 8 : bid; }

__device__ __forceinline__ void ph_even_inproj(const Ptrs& P, LAS unsigned char* smem, int bid, int nblk) {
    unsigned char* ws = P.ws;
    const int lrow = threadIdx.x >> 3, kc = threadIdx.x & 7;
    const int vid = xcd_vid(bid, nblk);
    for (int tile = vid; tile < (NT / 128) * 19; tile += nblk) {
        const int mt = tile / 19, nt = tile % 19;
        AffineRows af((const bf16*)(ws + WS_R1) + (size_t)mt * 128 * D, D);
        AffineRows bf_((const bf16*)(ws + WS_WINE) + (size_t)nt * 128 * D, D);
        EpiEvenIn epi{ws + WS_R3, P.in[13], P.in[14], (const float2*)(ws + WS_ROPE), mt, nt};
        if (epi.swapped()) gemm_tile<true>(af, bf_, D / 64, smem, epi); else gemm_tile<false>(af, bf_, D / 64, smem, epi);
    }
}

template <int LAYER>
struct EpiOutProj {
    typedef RmwPre<LAYER != 0> Pre;
    const float* modv_layer; const float* xin_lat; const float* xin_ctx; bf16* xs; int mt, nt;
    __device__ __forceinline__ bool swapped() const { return false; }
    __device__ __forceinline__ auto rowfn(int fb, int tb) const {
        const size_t trow0 = (size_t)mt * 128 + tb; const bool latent = mt < NL / 128;
        const int c0 = nt * 128 + fb;
        const float* gate = modv_layer + (size_t)(latent ? trow0 / S : 4) * 6144 + 2 * 1024 + c0;
        bf16* xo = xs + trow0 * D + c0;
        const float* xin = LAYER == 0 ? (latent ? xin_lat + trow0 * D : xin_ctx + (trow0 - NL) * D) + c0 : nullptr;
        return [=](int R, const void*& sp, void*& dp, const float*& gp, int& tk) { if (LAYER == 0) sp = xin + (size_t)R * D; else sp = xo + (size_t)R * D; dp = xo + (size_t)R * D; gp = gate; tk = (int)trow0 + R; return true; };
    }
    __device__ __forceinline__ void prefetch(Pre& pre, int fb, int tb, int l31, int hh) const { rmw_prefetch<LAYER != 0>(pre, rowfn(fb, tb), l31, hh); }
    __device__ __forceinline__ void operator()(f32x16 (&acc)[2][2], int fb, int tb, int l31, int hh, LAS unsigned char* wl, const Pre& pre) const {
        rmw_finish<LAYER != 0, true, false>(acc, pre, rowfn(fb, tb), l31, hh, wl);
    }
};
__device__ __forceinline__ void ph_outproj(const Ptrs& P, LAS unsigned char* smem, int bid, int nblk, int layer, int nrows) {
    unsigned char* ws = P.ws;
    const int lrow = threadIdx.x >> 3, kc = threadIdx.x & 7;
    const int vid = xcd_vid(bid, nblk);
    const float* modv_layer = (const float*)(ws + WS_MODV) + (size_t)layer * 5 * 6144;
    for (int tile = vid; tile < (nrows / 128) * 8; tile += nblk) {
        const int mt = tile / 8, nt = tile % 8;
        AffineRows af((const bf16*)(ws + WS_R2) + (size_t)mt * 128 * D, D);
        AffineRows bf_((const bf16*)(ws + (layer ? WS_WOUTO : WS_WOUTE)) + (size_t)nt * 128 * D, D);
        if (layer == 0) { EpiOutProj<0> epi{modv_layer, P.in[0], P.in[2], (bf16*)(ws + WS_R4), mt, nt}; gemm_tile<false>(af, bf_, D / 64, smem, epi); }
        else { EpiOutProj<1> epi{modv_layer, nullptr, nullptr, (bf16*)(ws + WS_R4), mt, nt}; gemm_tile<false>(af, bf_, D / 64, smem, epi); }
    }
}

struct EpiOddIn {
    typedef NoPre Pre;
    __device__ __forceinline__ void prefetch(Pre&, int, int, int, int) const {}
    unsigned char* r3; const float* qn; const float* kn; const float2* ropeT; const float* rss; const float* bi; int mt, nt;
    __device__ __forceinline__ bool swapped() const { return nt == 9; }
    __device__ __forceinline__ void operator()(f32x16 (&acc)[2][2], int fb, int tb, int l31, int hh, LAS unsigned char* wl, const Pre& pre) const {
        const size_t trow0 = (size_t)mt * 128 + tb; const bool latent = mt < NL / 128; const int tok0 = (int)(trow0 & (S - 1));
        if (!swapped()) {
#pragma unroll
            for (int j = 0; j < 2; ++j) {
                const float rs = rsqrtf(rss[trow0 + 32 * j + l31] * (1.f / D) + EPS);
#pragma unroll
                for (int i = 0; i < 2; ++i)
#pragma unroll
                    for (int g = 0; g < 4; ++g) { const f32x4 b4 = *(const f32x4*)(bi + nt * 128 + fb + 32 * i + 8 * g + 4 * hh);
                        acc[i][j][4 * g] = acc[i][j][4 * g] * rs + b4.x; acc[i][j][4 * g + 1] = acc[i][j][4 * g + 1] * rs + b4.y; acc[i][j][4 * g + 2] = acc[i][j][4 * g + 2] * rs + b4.z; acc[i][j][4 * g + 3] = acc[i][j][4 * g + 3] * rs + b4.w; }
            }
        } else {
#pragma unroll
            for (int j = 0; j < 2; ++j)
#pragma unroll
                for (int g = 0; g < 4; ++g) { const f32x4 q4 = *(const f32x4*)(rss + trow0 + 32 * j + 8 * g + 4 * hh);
                    const float r0 = rsqrtf(q4.x * (1.f / D) + EPS), r1 = rsqrtf(q4.y * (1.f / D) + EPS), r2 = rsqrtf(q4.z * (1.f / D) + EPS), r3_ = rsqrtf(q4.w * (1.f / D) + EPS);
#pragma unroll
                    for (int i = 0; i < 2; ++i) { const float bb = bi[nt * 128 + fb + 32 * i + l31];
                        acc[i][j][4 * g] = acc[i][j][4 * g] * r0 + bb; acc[i][j][4 * g + 1] = acc[i][j][4 * g + 1] * r1 + bb; acc[i][j][4 * g + 2] = acc[i][j][4 * g + 2] * r2 + bb; acc[i][j][4 * g + 3] = acc[i][j][4 * g + 3] * r3_ + bb; } }
        }
        if (nt < 8) { if (latent) { qknorm_rope_T(acc, qn, ropeT, true, tok0, l31, hh, QSCALE); store_bf16_T(acc, (bf16*)(r3 + R3_OQ), 1024, trow0, nt * 128 + fb, l31, hh, wl); } }
        else if (nt == 8) { qknorm_rope_T(acc, kn, ropeT, latent, tok0, l31, hh); store_bf16_T(acc, (bf16*)(r3 + R3_OK), 128, trow0, fb, l31, hh, wl); }
        else {
            const int b = latent ? (int)(trow0 / S) : (int)((trow0 - NL) / CL); const int key0 = latent ? tok0 : S + (int)((trow0 - NL) % CL);
            store_vt_swapped(acc, (bf16*)(r3 + R3_OV) + (size_t)(b * 2 + fb / 64) * 64 * VT_LD, key0, l31, hh, wl);
        }
    }
};
__device__ __forceinline__ void ph_odd_inproj(const Ptrs& P, LAS unsigned char* smem, int bid, int nblk) {
    unsigned char* ws = P.ws;
    const int lrow = threadIdx.x >> 3, kc = threadIdx.x & 7;
    const int vid = xcd_vid(bid, nblk);
    constexpr int T_LAT = (NL / 128) * 10, T_ALL = T_LAT + (NC / 128) * 2;
    for (int tile = vid; tile < T_ALL; tile += nblk) {
        int mt, nt;
        if (tile < T_LAT) { mt = tile / 10; nt = tile % 10; } else { mt = NL / 128 + (tile - T_LAT) / 2; nt = 8 + (tile - T_LAT) % 2; }
        const int brow = mt < NL / 128 ? mt / (S / 128) : 4;
        AffineRows af((const bf16*)(ws + WS_R4) + (size_t)mt * 128 * D, D);
        AffineRows bf_((const bf16*)(ws + WS_WINOF) + ((size_t)brow * 1280 + nt * 128) * D, D);
        EpiOddIn epi{ws + WS_R3, P.in[18], P.in[19], (const float2*)(ws + WS_ROPE), (const float*)(ws + WS_RSS), (const float*)(ws + WS_BI) + brow * 1280, mt, nt};
        if (epi.swapped()) gemm_tile<true>(af, bf_, D / 64, smem, epi); else gemm_tile<false>(af, bf_, D / 64, smem, epi);
    }
}

constexpr int AT_KP = 144, AT_VP = 136;
constexpr int AT_STAGE = 64 * AT_KP + 64 * AT_VP;
constexpr int ATTN_LDS = 2 * AT_STAGE;
struct AttnArgs {
    const bf16* Q; int ldq; size_t qrow0; int qcol;
    const bf16* K; size_t klat0, kctx0;
    const bf16* Vt;
    int nctx, tlo, nlat;
    int banded, tq0;
    float sink_l2;
    float m0;
    bf16* out;
};
__device__ __forceinline__ float xhalf_max(float x) {
    auto t = __builtin_amdgcn_permlane32_swap(__float_as_uint(x), __float_as_uint(x), false, false);
    return fmaxf(__uint_as_float(t[0]), __uint_as_float(t[1]));
}
__device__ __forceinline__ void attn_block(const AttnArgs& a, LAS unsigned char* smem) {
    int tid_ = threadIdx.x; asm volatile("" : "+v"(tid_));
    const int tid = tid_, lane = tid & 63, wave = tid >> 6, l31 = lane & 31, hh = lane >> 5;
    bf16x8 qf[2][4];
#pragma unroll
    for (int u = 0; u < 2; ++u) { const bf16* qp = a.Q + (a.qrow0 + wave * 64 + u * 32 + l31) * a.ldq + a.qcol + hh * 8;
#pragma unroll
      for (int s = 0; s < 4; ++s) qf[u][s] = *(const bf16x8*)(qp + 16 * s); }
    f32x16 o[2][2], minit;
#pragma unroll
    for (int r = 0; r < 16; ++r) { o[0][0][r] = 0.f; o[0][1][r] = 0.f; o[1][0][r] = 0.f; o[1][1][r] = 0.f; minit[r] = -a.m0; }
    float ls[2][2] = {{0.f, 0.f}, {0.f, 0.f}};
    const int ntile = a.nctx + a.nlat;
    const int lr0 = tid >> 3, kc = tid & 7;
    const bf16* kbase = a.K + (size_t)lr0 * 128 + kc * 8;
    const bf16* vbase = a.Vt + (size_t)lr0 * VT_LD + kc * 8;
    const int kwoff = lr0 * AT_KP + kc * 16, vwoff = 64 * AT_KP + lr0 * AT_VP + kc * 16;
    const int kroff = l31 * AT_KP + hh * 16, vroff = 64 * AT_KP + l31 * AT_VP + hh * 8;
    u32x4 rk[2], rv[2];
#define AT_ISSUE(n) do { const int t_ = __builtin_amdgcn_readfirstlane((n) < a.nctx ? 64 + (n) : a.tlo + (n) - a.nctx); \
        const size_t kr_ = (t_ < 64 ? a.klat0 + 64 * t_ : a.kctx0 + 64 * (t_ - 64)); \
        const bf16* kq_ = kbase + kr_ * 128; const bf16* vq_ = vbase + 64 * t_; \
        rk[0] = *(const u32x4*)kq_; rk[1] = *(const u32x4*)(kq_ + 32 * 128); rv[0] = *(const u32x4*)vq_; rv[1] = *(const u32x4*)(vq_ + (size_t)32 * VT_LD); } while (0)
#define AT_COMMIT(ST) do { LAS unsigned char* sb_ = smem + (ST) * AT_STAGE; \
        _Pragma("unroll") for (int i = 0; i < 2; ++i) { *(LAS u32x4*)(sb_ + kwoff + i * 32 * AT_KP) = rk[i]; \
            u32x2 lo_ = {rv[i].x, rv[i].y}, hi_ = {rv[i].z, rv[i].w}; *(LAS u32x2*)(sb_ + vwoff + i * 32 * AT_VP) = lo_; *(LAS u32x2*)(sb_ + vwoff + i * 32 * AT_VP + 8) = hi_; } } while (0)
#define AT_BODY(ST, n) do { \
        if ((n) + 1 < ntile) AT_ISSUE((n) + 1); \
        __builtin_amdgcn_sched_barrier(0); \
        LAS unsigned char* sb = smem + (ST) * AT_STAGE; \
        bool skip = false; \
        if (a.banded && (n) >= a.nctx) { const int k0 = 64 * (a.tlo + (n) - a.nctx), q0w = a.tq0 + wave * 64; skip = (k0 + 63 < q0w - 128) || (k0 > q0w + 63 + 128); } \
        if (!skip) { \
            _Pragma("unroll") for (int kt = 0; kt < 2; ++kt) { \
                f32x16 sc[2]; \
                _Pragma("unroll") for (int s = 0; s < 4; ++s) { \
                    const bf16x8 kf = *(LAS bf16x8*)(sb + kroff + kt * 32 * AT_KP + s * 32); \
                    sc[0] = __builtin_amdgcn_mfma_f32_32x32x16_bf16(kf, qf[0][s], s == 0 ? minit : sc[0], 0, 0, 0); \
                    sc[1] = __builtin_amdgcn_mfma_f32_32x32x16_bf16(kf, qf[1][s], s == 0 ? minit : sc[1], 0, 0, 0); } \
                if (a.banded && (n) >= a.nctx) { \
                    _Pragma("unroll") for (int u = 0; u < 2; ++u) { \
                        const int dbase = 64 * (a.tlo + (n) - a.nctx) + 32 * kt + 4 * hh - (a.tq0 + wave * 64 + u * 32 + l31); \
                        _Pragma("unroll") for (int r = 0; r < 16; ++r) { const int df = dbase + (r & 3) + 8 * (r >> 2); if (df > 128 || df < -128) sc[u][r] = -1e30f; } } } \
                _Pragma("unroll") for (int u = 0; u < 2; ++u) _Pragma("unroll") for (int r = 0; r < 16; r += 4) { \
                    sc[u][r] = __builtin_amdgcn_exp2f(sc[u][r]); ls[u][0] += sc[u][r]; sc[u][r + 1] = __builtin_amdgcn_exp2f(sc[u][r + 1]); ls[u][1] += sc[u][r + 1]; \
                    sc[u][r + 2] = __builtin_amdgcn_exp2f(sc[u][r + 2]); ls[u][0] += sc[u][r + 2]; sc[u][r + 3] = __builtin_amdgcn_exp2f(sc[u][r + 3]); ls[u][1] += sc[u][r + 3]; } \
                _Pragma("unroll") for (int s2 = 0; s2 < 2; ++s2) { \
                    bf16x8 pf[2]; \
                    _Pragma("unroll") for (int u = 0; u < 2; ++u) { \
                        u32x4 pw = {pk2(sc[u][8 * s2], sc[u][8 * s2 + 1]), pk2(sc[u][8 * s2 + 2], sc[u][8 * s2 + 3]), pk2(sc[u][8 * s2 + 4], sc[u][8 * s2 + 5]), pk2(sc[u][8 * s2 + 6], sc[u][8 * s2 + 7])}; \
                        pf[u] = __builtin_bit_cast(bf16x8, pw); } \
                    _Pragma("unroll") for (int dt = 0; dt < 2; ++dt) { \
                        LAS unsigned char* vp = sb + vroff + dt * 32 * AT_VP + (32 * kt + 16 * s2) * 2; \
                        const u32x2 v0 = *(LAS u32x2*)vp, v1 = *(LAS u32x2*)(vp + 16); u32x4 vw = {v0.x, v0.y, v1.x, v1.y}; const bf16x8 vf = __builtin_bit_cast(bf16x8, vw); \
                        _Pragma("unroll") for (int u = 0; u < 2; ++u) o[u][dt] = __builtin_amdgcn_mfma_f32_32x32x16_bf16(vf, pf[u], o[u][dt], 0, 0, 0); } } \
                __builtin_amdgcn_sched_barrier(0); \
            } \
        } \
        __builtin_amdgcn_sched_barrier(0); \
        if ((n) + 1 < ntile) AT_COMMIT((ST) ^ 1); \
        __syncthreads(); } while (0)
    AT_ISSUE(0); AT_COMMIT(0);
    __syncthreads();
#pragma unroll 1
    for (int n = 0; n < ntile; n += 2) {
        AT_BODY(0, n);
        if (n + 1 < ntile) AT_BODY(1, n + 1);
    }
#undef AT_ISSUE
#undef AT_COMMIT
#undef AT_BODY
#pragma unroll
    for (int u = 0; u < 2; ++u) {
        const float l = xhalf_sum(ls[u][0] + ls[u][1]) + __builtin_amdgcn_exp2f(a.sink_l2 - a.m0);
        const float inv = 1.f / l;
        bf16* op = a.out + (a.qrow0 + wave * 64 + u * 32 + l31) * 1024 + 4 * hh;
#pragma unroll
        for (int dt = 0; dt < 2; ++dt)
#pragma unroll
            for (int g = 0; g < 4; ++g) { u32x2 v = {pk2(o[u][dt][4 * g] * inv, o[u][dt][4 * g + 1] * inv), pk2(o[u][dt][4 * g + 2] * inv, o[u][dt][4 * g + 3] * inv)}; *(u32x2*)(op + dt * 32 + 8 * g) = v; }
    }
}

__device__ __forceinline__ void ph_dense_attn(const Ptrs& P, LAS unsigned char* smem, int bid, int nblk) {
    unsigned char* r3 = P.ws + WS_R3;
    const int vid = xcd_vid(bid, nblk);
    for (int item = vid; item < 512 + 32; item += nblk) {
        AttnArgs a;
        int bh, qb; bool isctx = item >= 512;
        if (!isctx) { bh = item >> 4; qb = item & 15; } else { bh = item - 512; qb = 0; }
        const int hq = bh & 7, b = bh >> 3, kv = hq >> 2;
        a.Q = (const bf16*)(r3 + R3_AQ); a.ldq = 512; a.qcol = hq * 64;
        a.qrow0 = isctx ? (size_t)NL + b * CL : (size_t)b * S + qb * 256;
        a.K = (const bf16*)(r3 + R3_AK) + kv * 64; a.klat0 = (size_t)b * S; a.kctx0 = (size_t)NL + b * CL;
        a.Vt = (const bf16*)(r3 + R3_AV) + (size_t)(b * 2 + kv) * 64 * VT_LD;
        a.nctx = 4; a.tlo = 0; a.nlat = isctx ? 0 : 64; a.banded = 0; a.tq0 = 0; a.sink_l2 = -INFINITY; a.m0 = ((const float*)(P.ws + WS_ROPE + 8192))[0];
        a.out = (bf16*)(P.ws + WS_R2) + 512 + hq * 64;
        attn_block(a, smem);
    }
}
__device__ __forceinline__ void ph_swa_attn(const Ptrs& P, LAS unsigned char* smem, int bid, int nblk) {
    unsigned char* r3 = P.ws + WS_R3;
    const int vid = xcd_vid(bid, nblk);
    for (int item = vid; item < 1024; item += nblk) {
        AttnArgs a;
        const int bh = item >> 4, qb = item & 15, hq = bh & 15, b = bh >> 4, kv = hq >> 3;
        a.Q = (const bf16*)(r3 + R3_OQ); a.ldq = 1024; a.qcol = hq * 64; a.qrow0 = (size_t)b * S + qb * 256;
        a.K = (const bf16*)(r3 + R3_OK) + kv * 64; a.klat0 = (size_t)b * S; a.kctx0 = (size_t)NL + b * CL;
        a.Vt = (const bf16*)(r3 + R3_OV) + (size_t)(b * 2 + kv) * 64 * VT_LD;
        const int tlo = qb * 4 - 2 < 0 ? 0 : qb * 4 - 2, thi = qb * 4 + 5 > 63 ? 63 : qb * 4 + 5;
        a.nctx = 4; a.tlo = tlo; a.nlat = thi - tlo + 1; a.banded = 1; a.tq0 = qb * 256; a.sink_l2 = P.in[17][hq] * 1.4426950408889634f; a.m0 = ((const float*)(P.ws + WS_ROPE + 8192))[1];
        a.out = (bf16*)(P.ws + WS_R2) + hq * 64;
        attn_block(a, smem);
    }
}

constexpr size_t WS_LIST = 247 * MiB;
constexpr size_t WS_WTS = WS_LIST + (size_t)24 * NT * 4;
constexpr size_t WS_END_ALL = WS_WTS + (size_t)NT * 2 * 4;
static_assert(WS_R3 + R3_END <= WS_LIST && WS_END_ALL <= 256 * MiB, "ws map tail");
constexpr int CTL_CNT = 8192;
constexpr int MOE_MAXT = NT / 128 + 24;


typedef float f32x4v __attribute__((ext_vector_type(4)));
__device__ __forceinline__ void route_tables(const Ptrs& P, int layer, int bid, int nblk) {
    unsigned char* ws = P.ws;
    const float* mvl = (const float*)(ws + WS_MODV) + (size_t)layer * 5 * 6144;
    const float* gain = P.in[7] + layer * D;
    const float* wg = P.in[20] + (size_t)layer * D * 4; const float* bg = P.in[21] + layer * 4;
    const float* we = P.in[22] + (size_t)layer * D * 16; const float* be = P.in[23] + layer * 16;
    bf16* wrt = (bf16*)(ws + WS_WRT + layer * WRT_STRIDE);
    for (int e = bid * 256 + threadIdx.x; e < 5 * 32 * 1024; e += nblk * 256) {
        const int k = e & 1023, r = (e >> 10) & 31, br = e >> 15;
        const float a = gain[k] * (1.f + mvl[(size_t)br * 6144 + 4 * 1024 + k]);
        const float w = (r < 16 ? wg[k * 4 + (r & 3)] : we[k * 16 + r - 16]) * a;
        const bf16 hi = f2bf(w); const bf16 lo = f2bf(w - bf2f(hi));
        wrt[((size_t)(br * 2 + 0) * 32 + r) * 1024 + k] = hi; wrt[((size_t)(br * 2 + 1) * 32 + r) * 1024 + k] = lo;
    }
    const int gw = bid * 4 + (threadIdx.x >> 6), lane = threadIdx.x & 63;
    if (gw < 160) {
        const int r = gw & 31, br = gw >> 5; float s = 0.f;
        for (int k = lane; k < 1024; k += 64) s += mvl[(size_t)br * 6144 + 3 * 1024 + k] * (r < 16 ? wg[k * 4 + (r & 3)] : we[k * 16 + r - 16]);
        s = wave_sum(s);
        if (lane == 0) ((float*)(ws + WS_SL))[layer * 256 + br * 32 + r] = s + (r < 16 ? bg[r & 3] : be[r - 16]);
    }
}
__device__ __forceinline__ void fold_odd_inproj(const Ptrs& P, int bid, int nblk) {
    unsigned char* ws = P.ws;
    const float* mv1 = (const float*)(ws + WS_MODV) + (size_t)5 * 6144; const float* gain = P.in[6] + D;
    const bf16* wt = (const bf16*)(ws + WS_WINO); bf16* wf = (bf16*)(ws + WS_WINOF);
    for (int e = bid * 256 + threadIdx.x; e < 5 * 80 * 128; e += nblk * 256) {
        const int k8 = (e & 127) * 8, n0 = ((e >> 7) % 80) * 16, b = e / (80 * 128);
        const f32x4 g0 = *(const f32x4*)(gain + k8), g1 = *(const f32x4*)(gain + k8 + 4), s0 = *(const f32x4*)(mv1 + (size_t)b * 6144 + 1024 + k8), s1 = *(const f32x4*)(mv1 + (size_t)b * 6144 + 1024 + k8 + 4);
        const float a0 = g0.x * (1.f + s0.x), a1 = g0.y * (1.f + s0.y), a2 = g0.z * (1.f + s0.z), a3 = g0.w * (1.f + s0.w), a4 = g1.x * (1.f + s1.x), a5 = g1.y * (1.f + s1.y), a6 = g1.z * (1.f + s1.z), a7 = g1.w * (1.f + s1.w);
        u32x4 w[16];
#pragma unroll
        for (int i = 0; i < 16; ++i) w[i] = *(const u32x4*)(wt + (size_t)(n0 + i) * 1024 + k8);
#pragma unroll
        for (int i = 0; i < 16; ++i) {
            u32x4 o;
            o.x = pk2(__uint_as_float(w[i].x << 16) * a0, __uint_as_float(w[i].x & 0xffff0000u) * a1); o.y = pk2(__uint_as_float(w[i].y << 16) * a2, __uint_as_float(w[i].y & 0xffff0000u) * a3);
            o.z = pk2(__uint_as_float(w[i].z << 16) * a4, __uint_as_float(w[i].z & 0xffff0000u) * a5); o.w = pk2(__uint_as_float(w[i].w << 16) * a6, __uint_as_float(w[i].w & 0xffff0000u) * a7);
            *(u32x4*)(wf + ((size_t)b * 1280 + n0 + i) * 1024 + k8) = o;
        }
    }
    const int gw = bid * 4 + (threadIdx.x >> 6), NGW = nblk * 4, lane = threadIdx.x & 63;
    for (int t = gw; t < 5 * 1280; t += NGW) {
        const int n = t % 1280, b = t / 1280;
        const u32x4 w0 = *(const u32x4*)(wt + (size_t)n * 1024 + 8 * lane), w1 = *(const u32x4*)(wt + (size_t)n * 1024 + 512 + 8 * lane);
        const float* sh = mv1 + (size_t)b * 6144;
        const f32x4 p0 = *(const f32x4*)(sh + 8 * lane), p1 = *(const f32x4*)(sh + 8 * lane + 4), p2 = *(const f32x4*)(sh + 512 + 8 * lane), p3 = *(const f32x4*)(sh + 512 + 8 * lane + 4);
        float s = p0.x * __uint_as_float(w0.x << 16) + p0.y * __uint_as_float(w0.x & 0xffff0000u) + p0.z * __uint_as_float(w0.y << 16) + p0.w * __uint_as_float(w0.y & 0xffff0000u)
                + p1.x * __uint_as_float(w0.z << 16) + p1.y * __uint_as_float(w0.z & 0xffff0000u) + p1.z * __uint_as_float(w0.w << 16) + p1.w * __uint_as_float(w0.w & 0xffff0000u)
                + p2.x * __uint_as_float(w1.x << 16) + p2.y * __uint_as_float(w1.x & 0xffff0000u) + p2.z * __uint_as_float(w1.y << 16) + p2.w * __uint_as_float(w1.y & 0xffff0000u)
                + p3.x * __uint_as_float(w1.z << 16) + p3.y * __uint_as_float(w1.z & 0xffff0000u) + p3.z * __uint_as_float(w1.w << 16) + p3.w * __uint_as_float(w1.w & 0xffff0000u);
        s = wave_sum(s);
        if (lane == 0) ((float*)(ws + WS_BI))[t] = s;
    }
}
typedef float f32x4a __attribute__((ext_vector_type(4)));
__device__ __forceinline__ float xq_sum(float x) {
    x += __shfl_xor(x, 16); x += __shfl_xor(x, 32); return x;
}
__device__ __forceinline__ void ph_moe_route(const Ptrs& P, LAS unsigned char* smem, int bid, int nblk, int layer, int nrows) {
    unsigned char* ws = P.ws;
    const int tid = threadIdx.x, lane = tid & 63, wave = tid >> 6, tk = lane & 15, kq = lane >> 4;
    const float* modv_layer = (const float*)(ws + WS_MODV) + (size_t)layer * 5 * 6144;
    const float* gain = P.in[7] + layer * D;
    const bf16* xs = (const bf16*)(ws + WS_R4);
    bf16* H = (bf16*)(ws + WS_R1);
    int* cnt = (int*)(ws + WS_CTL) + CTL_CNT + layer * 2048; int* list = (int*)(ws + WS_LIST); float* wts = (float*)(ws + WS_WTS);
    LAS float* part = (LAS float*)smem;
    for (int task = xcd_vid(bid, nblk); task < nrows / 16; task += nblk) {
        const int row0 = task * 16; const int row = row0 + tk;
        const int br = row0 < NL ? row0 / S : 4;
        const bf16* xr = xs + (size_t)row * D;
        const bf16* wt = (const bf16*)(ws + WS_WRT + layer * WRT_STRIDE) + (size_t)br * 2 * 32 * 1024;
        f32x4a acc0 = {0.f, 0.f, 0.f, 0.f}, acc1 = {0.f, 0.f, 0.f, 0.f};
        float ss = 0.f;
#pragma unroll 4
        for (int s = 8 * wave; s < 8 * wave + 8; ++s) {
            const int k = 32 * s + 8 * kq;
            const u32x4 xh = *(const u32x4*)(xr + k);
            { const float f0 = __uint_as_float(xh.x << 16), f1 = __uint_as_float(xh.x & 0xffff0000u), f2 = __uint_as_float(xh.y << 16), f3 = __uint_as_float(xh.y & 0xffff0000u);
              const float f4 = __uint_as_float(xh.z << 16), f5 = __uint_as_float(xh.z & 0xffff0000u), f6 = __uint_as_float(xh.w << 16), f7 = __uint_as_float(xh.w & 0xffff0000u);
              ss += (f0 * f0 + f1 * f1) + (f2 * f2 + f3 * f3) + (f4 * f4 + f5 * f5) + (f6 * f6 + f7 * f7); }
            const bf16x8 bh = __builtin_bit_cast(bf16x8, xh);
            const bf16x8 a0h = *(const bf16x8*)(wt + (size_t)tk * 1024 + k), a1h = *(const bf16x8*)(wt + (size_t)(16 + tk) * 1024 + k);
            const bf16x8 a0l = *(const bf16x8*)(wt + (size_t)(32 + tk) * 1024 + k), a1l = *(const bf16x8*)(wt + (size_t)(48 + tk) * 1024 + k);
            acc0 = __builtin_amdgcn_mfma_f32_16x16x32_bf16(a0h, bh, acc0, 0, 0, 0); acc1 = __builtin_amdgcn_mfma_f32_16x16x32_bf16(a1h, bh, acc1, 0, 0, 0);
            acc0 = __builtin_amdgcn_mfma_f32_16x16x32_bf16(a0l, bh, acc0, 0, 0, 0); acc1 = __builtin_amdgcn_mfma_f32_16x16x32_bf16(a1l, bh, acc1, 0, 0, 0);
        }
#pragma unroll
        for (int j = 0; j < 4; ++j) { part[(wave * 9 + j) * 64 + lane] = acc0[j]; part[(wave * 9 + 4 + j) * 64 + lane] = acc1[j]; }
        part[(wave * 9 + 8) * 64 + lane] = ss;
        __syncthreads();
        float tot[9];
#pragma unroll
        for (int j = 0; j < 9; ++j) tot[j] = (part[j * 64 + lane] + part[(9 + j) * 64 + lane]) + (part[(18 + j) * 64 + lane] + part[(27 + j) * 64 + lane]);
        const float rstd = rsqrtf(xq_sum(tot[8]) * (1.f / D) + EPS);
        if (wave == 0) {
            const float* sl = (const float*)(ws + WS_SL) + layer * 256 + br * 32;
            float gl[4], el[4];
#pragma unroll
            for (int j = 0; j < 4; ++j) { gl[j] = tot[j] * rstd + sl[j]; el[j] = tot[4 + j] * rstd + sl[16 + 4 * kq + j]; }
            int gi = 0; float gm = gl[0];
#pragma unroll
            for (int j = 1; j < 4; ++j) if (gl[j] > gm) { gm = gl[j]; gi = j; }
            if (gi == kq) {
                float gs = 0.f;
#pragma unroll
                for (int j = 0; j < 4; ++j) gs += expf(gl[j] - gm);
                const float gwt = 1.f / gs;
                int i0 = 0; float e0 = el[0];
#pragma unroll
                for (int j = 1; j < 4; ++j) if (el[j] > e0) { e0 = el[j]; i0 = j; }
                int i1 = -1; float e1 = -INFINITY;
#pragma unroll
                for (int j = 0; j < 4; ++j) if (j != i0 && el[j] > e1) { e1 = el[j]; i1 = j; }
                const float p1 = expf(e1 - e0); const float w0 = gwt / (1.f + p1), w1 = gwt * p1 / (1.f + p1);
                const int ea = i0 < i1 ? i0 : i1, eb = i0 < i1 ? i1 : i0;
                const int pidx = ea == 0 ? eb - 1 : (ea == 1 ? eb + 1 : 5);
                const int cls = gi * 6 + pidx;
                wts[(size_t)row * 2] = i0 < i1 ? w0 : w1; wts[(size_t)row * 2 + 1] = i0 < i1 ? w1 : w0;
                const int pos = atomicAdd(&cnt[cls * 64], 1);
                list[(size_t)cls * NT + pos] = row;
            }
        }
        const float* mv = modv_layer + (size_t)br * 6144;
        float rs[4];
#pragma unroll
        for (int r = 0; r < 4; ++r) rs[r] = __shfl(rstd, 4 * wave + r);
        u32x2 xv[4][4];
#pragma unroll
        for (int r = 0; r < 4; ++r) {
            const bf16* xp = xs + (size_t)(row0 + 4 * wave + r) * D + 4 * lane;
#pragma unroll
            for (int jq = 0; jq < 4; ++jq) xv[r][jq] = *(const u32x2*)(xp + 256 * jq);
        }
#pragma unroll
        for (int jq = 0; jq < 4; ++jq) {
            const int k = 4 * lane + 256 * jq;
            const f32x4 g = *(const f32x4*)(gain + k), sc = *(const f32x4*)(mv + 4 * 1024 + k), sh = *(const f32x4*)(mv + 3 * 1024 + k);
            const f32x4 a = {g.x * (1.f + sc.x), g.y * (1.f + sc.y), g.z * (1.f + sc.z), g.w * (1.f + sc.w)};
#pragma unroll
            for (int r = 0; r < 4; ++r) {
                const u32x2 xw = xv[r][jq]; const f32x4 x = {__uint_as_float(xw.x << 16), __uint_as_float(xw.x & 0xffff0000u), __uint_as_float(xw.y << 16), __uint_as_float(xw.y & 0xffff0000u)};
                u32x2 o = {pk2(x.x * rs[r] * a.x + sh.x, x.y * rs[r] * a.y + sh.y), pk2(x.z * rs[r] * a.z + sh.z, x.w * rs[r] * a.w + sh.w)};
                *(u32x2*)(H + (size_t)(row0 + 4 * wave + r) * D + k) = o;
            }
        }
        __syncthreads();
    }
}

__device__ __forceinline__ void moe_tiles_init(const int* cnt, LAS int* tile0) {
    __syncthreads();
    if (threadIdx.x < 24) tile0[192 + threadIdx.x] = cnt[threadIdx.x * 64];
    __syncthreads();
    if (threadIdx.x == 0) { int a = 0; for (int c = 0; c < 24; ++c) { tile0[c] = a; a += (tile0[192 + c] + 127) >> 7; } tile0[24] = a; }
    __syncthreads();
}
struct GatherRows {
    const bf16* H; const int* lst; int n; unsigned vo[4];
    __device__ __forceinline__ void init(int w, int rl, const int (&co)[4]) {
#pragma unroll
        for (int i = 0; i < 4; ++i) { const int r = 32 * w + 8 * i + rl; vo[i] = (unsigned)(((size_t)lst[r < n ? r : 0] * D + co[i]) * 2); }
    }
    __device__ __forceinline__ const bf16* sb(int i, int kt) const { return H + kt * 64; }
};
struct SplitKRows {
    const bf16* b0; const bf16* b1; size_t ld; int ksplit; int w; unsigned vo[4];
    __device__ __forceinline__ SplitKRows(const bf16* b0_, const bf16* b1_, size_t ld_, int ksplit_) : b0(b0_), b1(b1_), ld(ld_), ksplit(ksplit_), w(0) {}
    __device__ __forceinline__ void init(int w_, int rl, const int (&co)[4]) { w = w_;
#pragma unroll
        for (int i = 0; i < 4; ++i) vo[i] = (unsigned)((rl * ld + co[i]) * 2); }
    __device__ __forceinline__ const bf16* sb(int i, int kt) const { return (kt < ksplit ? b0 + kt * 64 : b1 + (kt - ksplit) * 64) + (size_t)(32 * w + 8 * i) * ld; }
};
struct EpiMoe1 {
    typedef NoPre Pre;
    __device__ __forceinline__ void prefetch(Pre&, int, int, int, int) const {}
    bf16* hid; const int* lst; int n; const float* wts; int nt;
    __device__ __forceinline__ bool swapped() const { return false; }
    __device__ __forceinline__ void operator()(f32x16 (&acc)[2][2], int fb, int tb, int l31, int hh, LAS unsigned char* wl, const Pre& pre) const {
        const int col = (nt >> 2) * 256 + 32 * (2 * (nt & 3) + (fb >> 6));
#pragma unroll 1
        for (int j = 0; j < 2; ++j) {
            const int r = tb + j * 32 + l31;
            const int tok = lst[r < n ? r : 0];
            const float w = wts[(size_t)tok * 2 + (nt >> 2)];
#pragma unroll
            for (int g = 0; g < 4; ++g) {
                float hv[4];
#pragma unroll
                for (int e = 0; e < 4; ++e) { const float a_ = j ? acc[0][1][4 * g + e] : acc[0][0][4 * g + e], u_ = j ? acc[1][1][4 * g + e] : acc[1][0][4 * g + e]; hv[e] = a_ / (1.f + __expf(-a_)) * u_ * w; }
                u32x2 v = {pk2(hv[0], hv[1]), pk2(hv[2], hv[3])}; *(LAS u32x2*)(wl + (32 * j + l31) * 80 + (8 * g + 4 * hh) * 2) = v;
            }
        }
        const int lane = l31 + 32 * hh, rr = lane >> 2, ch = lane & 3;
#pragma unroll
        for (int q = 0; q < 4; ++q) { const int R = 16 * q + rr; const u32x4 v = *(LAS u32x4*)(wl + R * 80 + ch * 16); *(u32x4*)(hid + (size_t)(tb + R) * 512 + col + ch * 8) = v; }
    }
};
__device__ __forceinline__ void ph_moe_stage1(const Ptrs& P, LAS unsigned char* smem, int bid, int nblk, int layer) {
    unsigned char* ws = P.ws;
    const int* cnt = (const int*)(ws + WS_CTL) + CTL_CNT + layer * 2048; const int* list = (const int*)(ws + WS_LIST);
    LAS int* tile0 = (LAS int*)(smem + GEMM_LDS);
    moe_tiles_init(cnt, tile0);
    const int lrow = threadIdx.x >> 3, kc = threadIdx.x & 7;
    const bf16* H = (const bf16*)(ws + WS_R1);
    const int nitems = tile0[24] * 8;
    for (int item = xcd_vid(bid, nblk); item < nitems; item += nblk) {
        const int tt = item >> 3, nt = item & 7;
        int c = 0; while (tile0[c + 1] <= tt) ++c;
        const int lt = tt - tile0[c], n = min(128, tile0[192 + c] - lt * 128);
        const int* lst = list + (size_t)c * NT + lt * 128;
        const int g = c / 6, pidx = c % 6; const int ea = pidx < 3 ? 0 : (pidx < 5 ? 1 : 2), eb = pidx < 3 ? pidx + 1 : (pidx < 5 ? pidx - 1 : 3);
        const int expert = g * 4 + (nt < 4 ? ea : eb);
        GatherRows af{H, lst, n, {0u, 0u, 0u, 0u}};
        AffineRows bf_((const bf16*)(ws + WS_WGU) + ((size_t)(layer * 16 + expert) * 512 + (nt & 3) * 128) * D, D);
        EpiMoe1 epi{(bf16*)(ws + WS_R3) + (size_t)tt * 128 * 512, lst, n, (const float*)(ws + WS_WTS), nt};
        gemm_tile<false>(af, bf_, D / 64, smem, epi);
    }
}
template <int LAYER>
struct EpiMoe2 {
    typedef RmwPre<true> Pre;
    bf16* xs; float* out; float* rss; const float* modv_layer; LAS const int* lst; int n; int nt;
    __device__ __forceinline__ bool swapped() const { return false; }
    __device__ __forceinline__ auto rowfn(int fb, int tb) const {
        const int c0 = nt * 128 + fb; const EpiMoe2 e = *this;
        return [=](int R, const void*& sp, void*& dp, const float*& gp, int& tk) {
            const int r = tb + R; if (r >= e.n) return false;
            const int tok = e.lst[r]; tk = tok;
            sp = e.xs + (size_t)tok * D + c0;
            if (LAYER == 0) dp = e.xs + (size_t)tok * D + c0; else dp = e.out + (size_t)tok * D + c0;
            gp = e.modv_layer + (size_t)(tok < NL ? tok / S : 4) * 6144 + 5 * 1024 + c0; return true; };
    }
    __device__ __forceinline__ void prefetch(Pre& pre, int fb, int tb, int l31, int hh) const { rmw_prefetch<true>(pre, rowfn(fb, tb), l31, hh); }
    __device__ __forceinline__ void operator()(f32x16 (&acc)[2][2], int fb, int tb, int l31, int hh, LAS unsigned char* wl, const Pre& pre) const {
        rmw_finish<true, LAYER == 0, LAYER == 0>(acc, pre, rowfn(fb, tb), l31, hh, wl, rss);
    }
};
__device__ __forceinline__ void ph_moe_stage2(const Ptrs& P, LAS unsigned char* smem, int bid, int nblk, int layer) {
    unsigned char* ws = P.ws;
    const int* cnt = (const int*)(ws + WS_CTL) + CTL_CNT + layer * 2048; const int* list = (const int*)(ws + WS_LIST);
    LAS int* tile0 = (LAS int*)(smem + GEMM_LDS);
    moe_tiles_init(cnt, tile0);
    const int lrow = threadIdx.x >> 3, kc = threadIdx.x & 7;
    const int nitems = tile0[24] * 8;
    for (int item = xcd_vid(bid, nblk); item < nitems; item += nblk) {
        const int tt = item >> 3, nt = item & 7;
        int c = 0; while (tile0[c + 1] <= tt) ++c;
        const int lt = tt - tile0[c], n = min(128, tile0[192 + c] - lt * 128);
        const int* lst = list + (size_t)c * NT + lt * 128;
        const int g = c / 6, pidx = c % 6; const int ea = pidx < 3 ? 0 : (pidx < 5 ? 1 : 2), eb = pidx < 3 ? pidx + 1 : (pidx < 5 ? pidx - 1 : 3);
        AffineRows af((const bf16*)(ws + WS_R3) + (size_t)tt * 128 * 512, 512);
        const bf16* wd = (const bf16*)(ws + WS_WD);
        SplitKRows bf_(wd + ((size_t)(layer * 16 + g * 4 + ea) * 1024 + nt * 128) * 256, wd + ((size_t)(layer * 16 + g * 4 + eb) * 1024 + nt * 128) * 256, 256, 4);
        LAS int* toks = (LAS int*)(smem + GEMM_LDS + 256);
        __syncthreads();
        if (threadIdx.x < 128) toks[threadIdx.x] = lst[threadIdx.x < n ? threadIdx.x : 0];
        if (layer == 0) { EpiMoe2<0> epi{(bf16*)(ws + WS_R4), P.out, (float*)(ws + WS_RSS), (const float*)(ws + WS_MODV), toks, n, nt}; gemm_tile<false>(af, bf_, 8, smem, epi); }
        else { EpiMoe2<1> epi{(bf16*)(ws + WS_R4), P.out, nullptr, (const float*)(ws + WS_MODV) + (size_t)5 * 6144, toks, n, nt}; gemm_tile<false>(af, bf_, 8, smem, epi); }
    }
}

constexpr size_t GLA_ST = 8192;
constexpr size_t WS_DEC = WS_WTS + (size_t)NT * 2 * 4;
static_assert(WS_DEC + (size_t)32 * 68 * 64 * 4 <= 256 * MiB, "ws dec");
__device__ __forceinline__ void gla_chunk_geom(int b, int M, size_t& row0, int& vcol0, int& c0, int& c1) {
    if (M < 4) { row0 = (size_t)NL + b * CL + 64 * M; vcol0 = S + 64 * M; c0 = M; c1 = 3 - M; }
    else { const int Ml = M - 4; row0 = (size_t)b * S + 64 * Ml; vcol0 = 64 * Ml; c0 = 4 + Ml; c1 = 4 + 63 - Ml; }
}
template <bool PASS_C>
__device__ __forceinline__ float gla_prep(const float (&gw)[16], float gb, int dir, LAS unsigned char* out, LAS const unsigned char* qraw, LAS const unsigned char* kraw, LAS const float* lrs, LAS float* tot) {
    const int tid = threadIdx.x, k = tid & 63, grp = tid >> 6;
    float gl[16];
#pragma unroll
    for (int j = 0; j < 16; ++j) {
        const int p = 16 * grp + j; float z = gb;
#pragma unroll
        for (int r4 = 0; r4 < 4; ++r4) { const f32x4 l4 = *(LAS const f32x4*)(lrs + p * 16 + r4 * 4); z += l4.x * gw[4 * r4] + l4.y * gw[4 * r4 + 1] + l4.z * gw[4 * r4 + 2] + l4.w * gw[4 * r4 + 3]; }
        gl[j] = (fminf(z, 0.f) - __logf(1.f + __expf(-fabsf(z)))) * (1.f / 16.f);
    }
    if (dir == 0) {
#pragma unroll
        for (int j = 1; j < 16; ++j) gl[j] += gl[j - 1];
        tot[grp * 64 + k] = gl[15];
    } else {
#pragma unroll
        for (int j = 14; j >= 0; --j) gl[j] += gl[j + 1];
        tot[grp * 64 + k] = gl[0];
    }
    __syncthreads();
    const float t0 = tot[k], t1 = tot[64 + k], t2 = tot[128 + k], t3 = tot[192 + k];
    const float bend = t0 + t1 + t2 + t3;
    float offs;
    if (dir == 0) offs = grp == 0 ? 0.f : grp == 1 ? t0 : grp == 2 ? t0 + t1 : t0 + t1 + t2;
    else offs = grp == 3 ? 0.f : grp == 2 ? t3 : grp == 1 ? t3 + t2 : t3 + t2 + t1;
    if (PASS_C) {
#pragma unroll
        for (int j = 0; j < 16; ++j) {
            const int p = 16 * grp + j; const float bp = gl[j] + offs;
            const float q = bf2f(*(LAS const bf16*)(qraw + p * 128 + k * 2)) * 0.125f, kk = bf2f(*(LAS const bf16*)(kraw + p * 128 + k * 2));
            *(LAS bf16*)(out + p * 144 + k * 2) = f2bf(q * __expf(bp));
            *(LAS bf16*)(out + 9216 + p * 144 + k * 2) = f2bf(q * __expf(bp - bend));
            *(LAS bf16*)(out + 18432 + p * 144 + k * 2) = f2bf(kk * __expf(bend - bp));
        }
    } else {
        float kt[16];
#pragma unroll
        for (int j = 0; j < 16; ++j) { const int p = 16 * grp + j; const float bp = gl[j] + offs; kt[j] = bf2f(*(LAS const bf16*)(kraw + p * 128 + k * 2)) * __expf(bend - bp); }
        u32x4 w0 = {pk2(kt[0], kt[1]), pk2(kt[2], kt[3]), pk2(kt[4], kt[5]), pk2(kt[6], kt[7])}, w1 = {pk2(kt[8], kt[9]), pk2(kt[10], kt[11]), pk2(kt[12], kt[13]), pk2(kt[14], kt[15])};
        *(LAS u32x4*)(out + k * 144 + grp * 32) = w0; *(LAS u32x4*)(out + k * 144 + grp * 32 + 16) = w1;
    }
    return __expf(bend);
}
#define GLA_LOAD_GW(gw, gb, dir, h) do { _Pragma("unroll") for (int r_ = 0; r_ < 16; ++r_) gw[r_] = P.in[10][((dir) * 16 + r_) * 256 + (h) * 64 + (threadIdx.x & 63)]; gb = P.in[11][(dir) * 256 + (h) * 64 + (threadIdx.x & 63)]; } while (0)

constexpr int GA_KTT = 0, GA_VT = 9216, GA_KRAW = GA_VT + 128 * 144, GA_LRS = GA_KRAW + 8192, GA_TOT = GA_LRS + 4096, GLA_A_LDS = GA_TOT + 1024;
__device__ __forceinline__ void gla_pass_a_item(const Ptrs& P, int item, LAS unsigned char* lds) {
    const int tid = threadIdx.x, lane = tid & 63, wave = tid >> 6, l31 = lane & 31, hh = lane >> 5;
    const int M = item % 68, dir = (item / 68) & 1, h = (item / 136) & 3, b = item / 544;
    size_t row0; int vcol0, c0, c1; gla_chunk_geom(b, M, row0, vcol0, c0, c1);
    const int sidx = ((b * 4 + h) * 2 + dir) * 68 + (dir ? c1 : c0);
    const unsigned char* r3 = P.ws + WS_R3;
    u32x4 vt[4], kr[2]; f32x4 lr; float gw[16], gb;
    { const bf16* gvt = (const bf16*)(r3 + R3_GV) + (size_t)(b * 4 + h) * 128 * VT_LD + vcol0;
#pragma unroll
      for (int i = 0; i < 4; ++i) { const int c = tid + 256 * i; vt[i] = *(const u32x4*)(gvt + (size_t)(c >> 3) * VT_LD + (c & 7) * 8); }
      const bf16* gk = (const bf16*)(r3 + R3_GK) + row0 * 256 + h * 64;
#pragma unroll
      for (int i = 0; i < 2; ++i) { const int c = tid + 256 * i; kr[i] = *(const u32x4*)(gk + (size_t)(c >> 3) * 256 + (c & 7) * 8); }
      lr = *(const f32x4*)((const float*)(r3 + R3_LR) + (row0 + (tid >> 2)) * 32 + dir * 16 + (tid & 3) * 4);
      GLA_LOAD_GW(gw, gb, dir, h); }
#pragma unroll
    for (int i = 0; i < 4; ++i) { const int c = tid + 256 * i; *(LAS u32x4*)(lds + GA_VT + (c >> 3) * 144 + (c & 7) * 16) = vt[i]; }
#pragma unroll
    for (int i = 0; i < 2; ++i) { const int c = tid + 256 * i; *(LAS u32x4*)(lds + GA_KRAW + (c >> 3) * 128 + (c & 7) * 16) = kr[i]; }
    *(LAS f32x4*)(lds + GA_LRS + tid * 16) = lr;
    __syncthreads();
    const float dec = gla_prep<false>(gw, gb, dir, lds + GA_KTT, lds + GA_KRAW, lds + GA_KRAW, (LAS const float*)(lds + GA_LRS), (LAS float*)(lds + GA_TOT));
    if (tid < 64) ((float*)(P.ws + WS_DEC))[(size_t)sidx * 64 + tid] = dec;
    __syncthreads();
    f32x16 acc[2];
#pragma unroll
    for (int kt = 0; kt < 2; ++kt)
#pragma unroll
        for (int r = 0; r < 16; ++r) acc[kt][r] = 0.f;
#pragma unroll
    for (int ps = 0; ps < 4; ++ps) {
        const bf16x8 vf = *(LAS bf16x8*)(lds + GA_VT + (32 * wave + l31) * 144 + ps * 32 + hh * 16);
#pragma unroll
        for (int kt = 0; kt < 2; ++kt) { const bf16x8 kf = *(LAS bf16x8*)(lds + GA_KTT + (32 * kt + l31) * 144 + ps * 32 + hh * 16); acc[kt] = __builtin_amdgcn_mfma_f32_32x32x16_bf16(kf, vf, acc[kt], 0, 0, 0); }
    }
    bf16* ds = (bf16*)(P.ws + WS_R1) + (size_t)sidx * GLA_ST + (size_t)(32 * wave + l31) * 64 + 4 * hh;
#pragma unroll
    for (int kt = 0; kt < 2; ++kt)
#pragma unroll
        for (int g = 0; g < 4; ++g) { u32x2 v = {pk2(acc[kt][4 * g], acc[kt][4 * g + 1]), pk2(acc[kt][4 * g + 2], acc[kt][4 * g + 3])}; *(u32x2*)(ds + kt * 32 + 8 * g) = v; }
    __syncthreads();
}
__device__ __forceinline__ void ph_gla_a(const Ptrs& P, LAS unsigned char* smem, int bid, int nblk) {
    for (int item = bid; item < 4 * 4 * 2 * 68; item += nblk) gla_pass_a_item(P, item, smem);
}
__device__ __forceinline__ void gla_pass_b(const Ptrs& P, int gtid, int nthreads) {
    const bf16* DS = (const bf16*)(P.ws + WS_R1); bf16* SIN = (bf16*)(P.ws + WS_R4); const float* DEC = (const float*)(P.ws + WS_DEC);
    for (int idx = gtid; idx < 32 * 2048; idx += nthreads) {
        const int bhd = idx >> 11, e4 = idx & 2047, k4 = (e4 & 15) * 4;
        float s0 = 0.f, s1 = 0.f, s2 = 0.f, s3 = 0.f;
#pragma unroll 17
        for (int c = 0; c < 68; ++c) {
            const size_t sidx = (size_t)bhd * 68 + c;
            u32x2 o = {pk2(s0, s1), pk2(s2, s3)};
            *(u32x2*)(SIN + sidx * GLA_ST + e4 * 4) = o;
            const f32x4 d = *(const f32x4*)(DEC + sidx * 64 + k4);
            const u32x2 w = *(const u32x2*)(DS + sidx * GLA_ST + e4 * 4);
            s0 = s0 * d.x + __uint_as_float(w.x << 16); s1 = s1 * d.y + __uint_as_float(w.x & 0xffff0000u);
            s2 = s2 * d.z + __uint_as_float(w.y << 16); s3 = s3 * d.w + __uint_as_float(w.y & 0xffff0000u);
        }
    }
}

constexpr int GC_QT = 0, GC_QA = 9216, GC_KT = 18432, GC_VT = 27648, GC_QRAW = GC_VT + 128 * 136, GC_KRAW = GC_QRAW + 8192, GC_LRS = GC_KRAW + 8192, GC_TOT = GEMM_LDS + 256, GC_XCH = GC_TOT + 1024;
static_assert(GC_LRS + 4096 <= GEMM_LDS, "gla c lds");
__device__ __forceinline__ void gla_pass_c_item(const Ptrs& P, int item, LAS unsigned char* lds) {
    const int tid = threadIdx.x, lane = tid & 63, wave = tid >> 6, l31 = lane & 31, hh = lane >> 5, pt = wave & 1, vh = wave >> 1;
    const int M = item % 68, h = (item / 68) & 3, b = item / 272;
    size_t row0; int vcol0, c0, c1; gla_chunk_geom(b, M, row0, vcol0, c0, c1);
    const unsigned char* r3 = P.ws + WS_R3;
    u32x4 vt[4], qr[2], kr[2]; f32x4 lr0, lr1; float gw[16], gb;
    { const bf16* gvt = (const bf16*)(r3 + R3_GV) + (size_t)(b * 4 + h) * 128 * VT_LD + vcol0;
#pragma unroll
      for (int i = 0; i < 4; ++i) { const int c = tid + 256 * i; vt[i] = *(const u32x4*)(gvt + (size_t)(c >> 3) * VT_LD + (c & 7) * 8); }
      const bf16* gq = (const bf16*)(r3 + R3_GQ) + row0 * 256 + h * 64; const bf16* gk = (const bf16*)(r3 + R3_GK) + row0 * 256 + h * 64;
#pragma unroll
      for (int i = 0; i < 2; ++i) { const int c = tid + 256 * i; qr[i] = *(const u32x4*)(gq + (size_t)(c >> 3) * 256 + (c & 7) * 8); kr[i] = *(const u32x4*)(gk + (size_t)(c >> 3) * 256 + (c & 7) * 8); }
      const float* lrp = (const float*)(r3 + R3_LR) + (row0 + (tid >> 2)) * 32 + (tid & 3) * 4;
      lr0 = *(const f32x4*)lrp; lr1 = *(const f32x4*)(lrp + 16);
      GLA_LOAD_GW(gw, gb, 0, h); }
#pragma unroll
    for (int i = 0; i < 4; ++i) { const int c = tid + 256 * i; LAS unsigned char* vp = lds + GC_VT + (c >> 3) * 136 + (c & 7) * 16; u32x2 lo = {vt[i].x, vt[i].y}, hi = {vt[i].z, vt[i].w}; *(LAS u32x2*)vp = lo; *(LAS u32x2*)(vp + 8) = hi; }
#pragma unroll
    for (int i = 0; i < 2; ++i) { const int c = tid + 256 * i; *(LAS u32x4*)(lds + GC_QRAW + (c >> 3) * 128 + (c & 7) * 16) = qr[i]; *(LAS u32x4*)(lds + GC_KRAW + (c >> 3) * 128 + (c & 7) * 16) = kr[i]; }
    *(LAS f32x4*)(lds + GC_LRS + tid * 16) = lr0;
    f32x16 o[2];
#pragma unroll
    for (int i = 0; i < 2; ++i)
#pragma unroll
        for (int r = 0; r < 16; ++r) o[i][r] = 0.f;
    const bf16* SIN = (const bf16*)(P.ws + WS_R4);
    __syncthreads();
#pragma unroll 1
    for (int dir = 0; dir < 2; ++dir) {
        const int sidx = ((b * 4 + h) * 2 + dir) * 68 + (dir ? c1 : c0);
        (void)gla_prep<true>(gw, gb, dir, lds + GC_QT, lds + GC_QRAW, lds + GC_KRAW, (LAS const float*)(lds + GC_LRS), (LAS float*)(lds + GC_TOT));
        bf16x8 sf[2][4];
#pragma unroll
        for (int i = 0; i < 2; ++i)
#pragma unroll
            for (int ks = 0; ks < 4; ++ks) sf[i][ks] = *(const bf16x8*)(SIN + (size_t)sidx * GLA_ST + (size_t)(64 * vh + 32 * i + l31) * 64 + 16 * ks + 8 * hh);
        if (dir == 0) { *(LAS f32x4*)(lds + GC_LRS + tid * 16) = lr1; GLA_LOAD_GW(gw, gb, 1, h); }
        __syncthreads();
        f32x16 at[2];
#pragma unroll
        for (int st = 0; st < 2; ++st) {
#pragma unroll
            for (int r = 0; r < 16; ++r) at[st][r] = 0.f;
#pragma unroll
            for (int ks = 0; ks < 4; ++ks) {
                const bf16x8 ka = *(LAS bf16x8*)(lds + GC_KT + (32 * st + l31) * 144 + ks * 32 + hh * 16);
                const bf16x8 qa = *(LAS bf16x8*)(lds + GC_QA + (32 * pt + l31) * 144 + ks * 32 + hh * 16);
                at[st] = __builtin_amdgcn_mfma_f32_32x32x16_bf16(ka, qa, at[st], 0, 0, 0);
            }
            const int pq = 32 * pt + l31;
#pragma unroll
            for (int r = 0; r < 16; ++r) { const int s_ = 32 * st + (r & 3) + 8 * (r >> 2) + 4 * hh; const bool ok = dir ? (s_ >= pq) : (s_ <= pq); if (!ok) at[st][r] = 0.f; }
        }
#pragma unroll
        for (int ks = 0; ks < 4; ++ks) {
            const bf16x8 qt = *(LAS bf16x8*)(lds + GC_QT + (32 * pt + l31) * 144 + ks * 32 + hh * 16);
#pragma unroll
            for (int i = 0; i < 2; ++i) o[i] = __builtin_amdgcn_mfma_f32_32x32x16_bf16(sf[i][ks], qt, o[i], 0, 0, 0);
        }
#pragma unroll
        for (int st = 0; st < 2; ++st)
#pragma unroll
            for (int s2 = 0; s2 < 2; ++s2) {
                u32x4 pw = {pk2(at[st][8 * s2], at[st][8 * s2 + 1]), pk2(at[st][8 * s2 + 2], at[st][8 * s2 + 3]), pk2(at[st][8 * s2 + 4], at[st][8 * s2 + 5]), pk2(at[st][8 * s2 + 6], at[st][8 * s2 + 7])};
                const bf16x8 pf = __builtin_bit_cast(bf16x8, pw);
#pragma unroll
                for (int i = 0; i < 2; ++i) {
                    LAS unsigned char* vp = lds + GC_VT + (64 * vh + 32 * i + l31) * 136 + (32 * st + 16 * s2 + 4 * hh) * 2;
                    const u32x2 v0 = *(LAS u32x2*)vp, v1 = *(LAS u32x2*)(vp + 16);
                    u32x4 vw = {v0.x, v0.y, v1.x, v1.y};
                    o[i] = __builtin_amdgcn_mfma_f32_32x32x16_bf16(__builtin_bit_cast(bf16x8, vw), pf, o[i], 0, 0, 0);
                }
            }
        __syncthreads();
    }
    float ss = 0.f;
#pragma unroll
    for (int i = 0; i < 2; ++i)
#pragma unroll
        for (int r = 0; r < 16; ++r) ss += o[i][r] * o[i][r];
    ss = xhalf_sum(ss);
    LAS float* xch = (LAS float*)(lds + GC_XCH);
    if (hh == 0) xch[(pt * 2 + vh) * 32 + l31] = ss;
    __syncthreads();
    ss += xch[(pt * 2 + (1 - vh)) * 32 + l31];
    const float rstd = rsqrtf(ss * (1.f / 128.f) + EPS);
    const size_t trow = row0 + 32 * pt + l31;
    const bf16* gr = (const bf16*)(P.ws + WS_R3 + R3_GR) + trow * 512 + h * 128 + 64 * vh + 4 * hh;
    bf16* mx = (bf16*)(P.ws + WS_R2) + trow * 1024 + h * 128 + 64 * vh + 4 * hh;
    const float* gn = P.in[12] + 64 * vh + 4 * hh;
#pragma unroll
    for (int i = 0; i < 2; ++i)
#pragma unroll
        for (int g = 0; g < 4; ++g) {
            const u32x2 rw = *(const u32x2*)(gr + i * 32 + 8 * g); const f32x4 gg = *(const f32x4*)(gn + i * 32 + 8 * g);
            const float r0 = __uint_as_float(rw.x << 16), r1 = __uint_as_float(rw.x & 0xffff0000u), r2 = __uint_as_float(rw.y << 16), r3_ = __uint_as_float(rw.y & 0xffff0000u);
            const float y0 = o[i][4 * g] * rstd * gg.x * (r0 / (1.f + __expf(-r0))), y1 = o[i][4 * g + 1] * rstd * gg.y * (r1 / (1.f + __expf(-r1)));
            const float y2 = o[i][4 * g + 2] * rstd * gg.z * (r2 / (1.f + __expf(-r2))), y3 = o[i][4 * g + 3] * rstd * gg.w * (r3_ / (1.f + __expf(-r3_)));
            u32x2 v = {pk2(y0, y1), pk2(y2, y3)}; *(u32x2*)(mx + i * 32 + 8 * g) = v;
        }
    __syncthreads();
}
__device__ __forceinline__ void ph_gla_c(const Ptrs& P, LAS unsigned char* smem, int bid, int nblk) {
    for (int item = bid; item < 4 * 4 * 68; item += nblk) gla_pass_c_item(P, item, smem);
}

#define XB_TMO      128
#define XB_XCNT(j)  (256  + 64 * (j))
#define XB_XSUB(j)  (1280 + 64 * (j))
#define XB_XGEN(j)  (2304 + 64 * (j))
#define XB_TOP      3328
#define XB_TOPGEN   3392
#define XB_SPIN_CAP (1u << 20)
constexpr int CTL_BAR = 4096;
__device__ __forceinline__ unsigned xb_ld(unsigned* p) { return __hip_atomic_load(p, __ATOMIC_RELAXED, __HIP_MEMORY_SCOPE_AGENT); }
__device__ __forceinline__ unsigned xb_add(unsigned* p, unsigned v) { return __hip_atomic_fetch_add(p, v, __ATOMIC_RELAXED, __HIP_MEMORY_SCOPE_AGENT); }
__device__ __forceinline__ unsigned xb_xcc_id() { return (unsigned)__builtin_amdgcn_s_getreg((3 << 11) | 20) & 0xFu; }
#define XB_SPIN(cond, bar) do { unsigned _sp = 0; while (cond) { __builtin_amdgcn_s_sleep(1); \
    if ((++_sp & 255u) == 0u) { if (xb_ld(&(bar)[XB_TMO])) break; if (_sp > XB_SPIN_CAP) { atomicAdd(&(bar)[XB_TMO], 1u); break; } } } } while (0)
struct XcdBarrier { unsigned* bar; unsigned x; volatile LAS unsigned* st; };
__device__ __forceinline__ XcdBarrier xcd_barrier_post(unsigned* bar, volatile LAS unsigned* st) {
    XcdBarrier b; b.bar = bar; b.x = xb_xcc_id(); b.st = st;
    if (threadIdx.x == 0) (void)xb_add(&bar[XB_XCNT(b.x)], 1u);
    return b;
}
__device__ __forceinline__ void xcd_barrier_complete(unsigned* bar, unsigned x, unsigned& nloc, unsigned& nx) {
    const unsigned G = gridDim.x * gridDim.y * gridDim.z;
    unsigned sum, cnt, mine, sp = 0u;
    for (;;) {
        sum = 0u; cnt = 0u; mine = 0u;
#pragma unroll
        for (unsigned j = 0; j < 16; ++j) { const unsigned c = xb_ld(&bar[XB_XCNT(j)]); sum += c; cnt += (c > 0u) ? 1u : 0u; mine = (j == x) ? c : mine; }
        if (sum == G) break;
        __builtin_amdgcn_s_sleep(1);
        if ((++sp & 255u) == 0u) { if (xb_ld(&bar[XB_TMO])) break; if (sp > XB_SPIN_CAP) { atomicAdd(&bar[XB_TMO], 1u); break; } }
    }
    nloc = mine > 0u ? mine : 1u; nx = cnt > 0u ? cnt : 1u;
}
__device__ __forceinline__ void xcd_barrier(const XcdBarrier& b) {
    asm volatile("s_waitcnt vmcnt(0)" ::: "memory");
    __syncthreads();
    if (threadIdx.x == 0) {
        unsigned* bar = b.bar;
        __builtin_amdgcn_s_waitcnt(0);
        unsigned nloc = b.st[0], nx = b.st[1];
        if (nloc == 0u) { xcd_barrier_complete(bar, b.x, nloc, nx); b.st[0] = nloc; b.st[1] = nx; }
        const unsigned old = xb_add(&bar[XB_XSUB(b.x)], 1u);
        const unsigned gen = old / nloc;
        if (old + 1u == (gen + 1u) * nloc) {
            __builtin_amdgcn_fence(__ATOMIC_RELEASE, "agent");
            asm volatile("s_waitcnt vmcnt(0)" ::: "memory");
            const unsigned og = xb_add(&bar[XB_TOP], 1u);
            const unsigned tg = og / nx;
            if (og + 1u == (tg + 1u) * nx) xb_add(&bar[XB_TOPGEN], 1u);
            else XB_SPIN(xb_ld(&bar[XB_TOPGEN]) == tg, bar);
            __builtin_amdgcn_fence(__ATOMIC_ACQUIRE, "agent");
            xb_add(&bar[XB_XGEN(b.x)], 1u);
            asm volatile("s_waitcnt vmcnt(0)" ::: "memory");
        } else {
            XB_SPIN(xb_ld(&bar[XB_XGEN(b.x)]) == gen, bar);
            __builtin_amdgcn_fence(__ATOMIC_ACQUIRE, "agent");
            asm volatile("s_waitcnt vmcnt(0)" ::: "memory");
        }
    }
    __syncthreads();
}

constexpr int N_PHASES = 18;
constexpr int SMEM_BYTES = GEMM_LDS + 2048;
struct Args { Ptrs P; int ph_lo, ph_hi; };
__global__ void __launch_bounds__(256, 2) fwd_megakernel(Args args) {
    __shared__ __attribute__((aligned(16))) unsigned char smem_raw[SMEM_BYTES];
    LAS unsigned char* smem = (LAS unsigned char*)smem_raw;
    const Ptrs& P = args.P;
    const int bid = blockIdx.x, nblk = gridDim.x;
    volatile LAS unsigned* bst = (volatile LAS unsigned*)(smem + GEMM_LDS + 128);
    if (threadIdx.x < 2) bst[threadIdx.x] = 0u;
    __syncthreads();
    XcdBarrier bar; bar.bar = (unsigned*)(P.ws + WS_CTL) + CTL_BAR; bar.x = 0; bar.st = bst;
    const bool multi = args.ph_hi - args.ph_lo > 1;
    if (multi) bar = xcd_barrier_post((unsigned*)(P.ws + WS_CTL) + CTL_BAR, bst);
    const int lo = args.ph_lo, hi = args.ph_hi;
#define PHASE(k, call) if (lo <= (k) && (k) < hi) { if ((k) > lo) xcd_barrier(bar); call; }
    PHASE(0, ph_prologue(P, smem, bid, nblk))
    PHASE(1, ph_modulate(P, 0, bid, nblk))
    PHASE(2, ph_even_inproj(P, smem, bid, nblk))
    PHASE(3, ph_gla_a(P, smem, bid, nblk))
    PHASE(4, gla_pass_b(P, bid * 256 + threadIdx.x, nblk * 256))
    PHASE(5, (ph_dense_attn(P, smem, bid, nblk), __syncthreads(), ph_gla_c(P, smem, (bid + nblk - 128) % nblk, nblk)))
    PHASE(7, ph_outproj(P, smem, bid, nblk, 0, NT))
    PHASE(8, (ph_moe_route(P, smem, bid, nblk, 0, NT), fold_odd_inproj(P, bid, nblk), route_tables(P, 1, bid, nblk)))
    PHASE(9, ph_moe_stage1(P, smem, bid, nblk, 0))
    PHASE(10, ph_moe_stage2(P, smem, bid, nblk, 0))
    PHASE(12, ph_odd_inproj(P, smem, bid, nblk))
    PHASE(13, ph_swa_attn(P, smem, bid, nblk))
    PHASE(14, ph_outproj(P, smem, bid, nblk, 1, NL))
    PHASE(15, ph_moe_route(P, smem, bid, nblk, 1, NL))
    PHASE(16, ph_moe_stage1(P, smem, bid, nblk, 1))
    PHASE(17, ph_moe_stage2(P, smem, bid, nblk, 1))
#undef PHASE
}

#ifndef MK_LAUNCHES
#define MK_LAUNCHES 1
#endif
extern "C" void kernel_launch(void* const* d_in, const int* in_sizes, int n_in, void* d_out, int out_size, void* d_ws, size_t ws_size, hipStream_t stream) {
    static int grid = 0;
    if (grid == 0) {
        int dev = 0, cus = 0, per_cu = 0;
        hipGetDevice(&dev);
        hipDeviceGetAttribute(&cus, hipDeviceAttributeMultiprocessorCount, dev);
        hipOccupancyMaxActiveBlocksPerMultiprocessor(&per_cu, (const void*)fwd_megakernel, 256, 0);
        if (per_cu > 2) per_cu = 2;
        if (per_cu < 1) per_cu = 1;
        grid = cus * per_cu;
    }
    hipMemsetAsync((unsigned char*)d_ws + WS_CTL, 0, 65536, stream);
    Args a{};
    for (int i = 0; i < 27; ++i) a.P.in[i] = (const float*)d_in[i];
    a.P.out = (float*)d_out; a.P.ws = (unsigned char*)d_ws;
#if MK_LAUNCHES == 1
    a.ph_lo = 0; a.ph_hi = N_PHASES;
    void* kargs[] = {&a};
    hipLaunchCooperativeKernel((const void*)fwd_megakernel, dim3(grid), dim3(256), kargs, 0, stream);
#else
    for (int ph = 0; ph < N_PHASES; ++ph) { a.ph_lo = ph; a.ph_hi = ph + 1; hipLaunchKernelGGL(fwd_megakernel, dim3(grid), dim3(256), 0, stream, a); }
#endif
}
```

```cpp
#include <hip/hip_runtime.h>
#include <stdint.h>

typedef unsigned short bf16;
__device__ __forceinline__ float bf2f(bf16 v) { return __uint_as_float(((unsigned)v) << 16); }
__device__ __forceinline__ bf16 f2bf(float f) { unsigned u = __float_as_uint(f); return (bf16)((u + 0x7fffu + ((u >> 16) & 1u)) >> 16); }

constexpr int D = 1024, NB = 4, S = 4096, CL = 256, NL = NB * S, NC = NB * CL, NT = NL + NC;
constexpr int EVEN_IN = 2336, ODD_IN = 1280;
constexpr float EPS = 1e-6f;

__device__ __forceinline__ float silu(float x) { return x / (1.f + expf(-x)); }
__device__ __forceinline__ float wave_sum(float v) {
#pragma unroll
    for (int o = 1; o < 64; o <<= 1) v += __shfl_xor(v, o);
    return v;
}

#define LAS __attribute__((address_space(3)))
typedef short bf16x8 __attribute__((ext_vector_type(8)));
typedef float f32x16 __attribute__((ext_vector_type(16)));
typedef float f32x4 __attribute__((ext_vector_type(4)));
typedef unsigned u32x4 __attribute__((ext_vector_type(4)));
typedef unsigned u32x2 __attribute__((ext_vector_type(2)));
typedef __bf16 bf16x2_t __attribute__((ext_vector_type(2)));
typedef float f32x2_t __attribute__((ext_vector_type(2)));
__device__ __forceinline__ unsigned pk2(float lo, float hi) { f32x2_t v = {lo, hi}; bf16x2_t b = __builtin_convertvector(v, bf16x2_t); return __builtin_bit_cast(unsigned, b); }
__device__ __forceinline__ float xhalf_sum(float x) {
    auto t = __builtin_amdgcn_permlane32_swap(__float_as_uint(x), __float_as_uint(x), false, false);
    return __uint_as_float(t[0]) + __uint_as_float(t[1]);
}

constexpr float QSCALE = 0.125f * 1.4426950408889634f;
constexpr int NPAD_E = 2432;
constexpr int TILE_LDS = 128 * 128;
constexpr int GEMM_LDS = 4 * TILE_LDS;

__device__ __forceinline__ void transpose_item(const float* W, int K, int N, bf16* WT, int dst_row0, int k0, int n0, LAS float* scr, int lane) {
    float tv[32];
#pragma unroll
    for (int i = 0; i < 32; ++i) tv[i] = W[(size_t)(k0 + 2 * i + (lane >> 5)) * N + n0 + (lane & 31)];
#pragma unroll
    for (int i = 0; i < 32; ++i) scr[(2 * i + (lane >> 5)) * 33 + (lane & 31)] = tv[i];
    asm volatile("s_waitcnt lgkmcnt(0)" ::: "memory");
    const int c = lane & 7;
#pragma unroll
    for (int j = 0; j < 4; ++j) {
        const int n = (lane >> 3) + 8 * j; const LAS float* s = scr + (8 * c) * 33 + n;
        u32x4 o; o.x = pk2(s[0 * 33], s[1 * 33]); o.y = pk2(s[2 * 33], s[3 * 33]); o.z = pk2(s[4 * 33], s[5 * 33]); o.w = pk2(s[6 * 33], s[7 * 33]);
        *(u32x4*)(WT + (size_t)(dst_row0 + n) * K + k0 + 8 * c) = o;
    }
    asm volatile("s_waitcnt lgkmcnt(0)" ::: "memory");
}

struct Ptrs {
    const float* in[27];
    float* out;
    unsigned char* ws;
};

constexpr size_t MiB = 1u << 20;
constexpr size_t WS_CTL = 0;
constexpr size_t WS_MODV = 1 * MiB;
constexpr size_t WS_ROPE = WS_MODV + 256 * 1024;
constexpr size_t WS_WINE = 2 * MiB;
constexpr size_t WS_WOUTE = WS_WINE + (size_t)NPAD_E * 1024 * 2;
constexpr size_t WS_WINO = WS_WOUTE + 2 * MiB;
constexpr size_t WS_WOUTO = WS_WINO + (size_t)1280 * 1024 * 2;
constexpr size_t WS_WGU = WS_WOUTO + 2 * MiB;
constexpr size_t WS_WD = WS_WGU + 32 * MiB;
constexpr size_t WS_CTXS = WS_WD + 16 * MiB;
constexpr size_t WS_R1 = 66 * MiB;
constexpr size_t WS_R4 = WS_R1 + 34 * MiB;
constexpr size_t WS_R2 = WS_R4 + 34 * MiB;
constexpr size_t WS_R3 = WS_R2 + 34 * MiB;
static_assert(WS_CTXS + 4 * MiB <= WS_R1, "ws map");
constexpr size_t R3_GQ = 0, R3_GK = R3_GQ + (size_t)NT * 256 * 2, R3_GV = R3_GK + (size_t)NT * 256 * 2, R3_GR = R3_GV + (size_t)NT * 512 * 2,
                 R3_LR = R3_GR + (size_t)NT * 512 * 2, R3_AQ = R3_LR + (size_t)NT * 32 * 4, R3_AK = R3_AQ + (size_t)NT * 512 * 2, R3_AV = R3_AK + (size_t)NT * 128 * 2,
                 R3_END = R3_AV + (size_t)NT * 128 * 2;
static_assert(WS_R3 + R3_END <= 256 * MiB, "ws map end");
constexpr size_t R3_OQ = 0, R3_OK = R3_OQ + (size_t)NL * 1024 * 2, R3_OV = R3_OK + (size_t)NT * 128 * 2;
constexpr size_t WS_WRT = 250 * MiB, WS_SL = 252 * MiB;
constexpr size_t WRT_STRIDE = 768 * 1024;
constexpr size_t WS_RSS = 253 * MiB;
constexpr size_t WS_BI = WS_RSS + 128 * 1024;
constexpr size_t WS_WINOF = WS_R3 + 48 * MiB;
static_assert(WS_WINOF + (size_t)5 * 1280 * 1024 * 2 <= WS_R3 + R3_END && WS_BI + 5 * 1280 * 4 <= 254 * MiB && WS_WRT + 2 * WRT_STRIDE <= WS_SL, "fold buffers");

__device__ __forceinline__ void ph_prologue(const Ptrs& P, LAS unsigned char* smem, int bid, int nblk) {
    const int lane = threadIdx.x & 63, wave = threadIdx.x >> 6;
    LAS float* scr = (LAS float*)smem + wave * 64 * 33;
    const int gw = bid * 4 + wave, NGW = nblk * 4;
    unsigned char* ws = P.ws;
    constexpr int I_WINE = 16 * 73, I_SQ = 16 * 32, I_WINO = 16 * 40, I_EXP_GU = 16 * 8, I_EXP_D = 4 * 32;
    constexpr int T_WINE = I_WINE, T_WOUTE = T_WINE + I_SQ, T_WINO = T_WOUTE + I_WINO, T_WOUTO = T_WINO + I_SQ,
                  T_G = T_WOUTO + 32 * I_EXP_GU, T_U = T_G + 32 * I_EXP_GU, T_D = T_U + 32 * I_EXP_D;
    for (int it = gw; it < T_D; it += NGW) {
        if (it < T_WINE) {
            int kb = it / 73, nb = it % 73, n0 = nb * 32;
            int dst = n0 < 1536 ? n0 : (n0 < 1568 ? n0 + 768 : n0 - 32);
            transpose_item(P.in[8], 1024, EVEN_IN, (bf16*)(ws + WS_WINE), dst, kb * 64, n0, scr, lane);
        } else if (it < T_WOUTE) { int r = it - T_WINE; transpose_item(P.in[9], 1024, 1024, (bf16*)(ws + WS_WOUTE), (r % 32) * 32, (r / 32) * 64, (r % 32) * 32, scr, lane); }
        else if (it < T_WINO) { int r = it - T_WOUTE; transpose_item(P.in[15], 1024, 1280, (bf16*)(ws + WS_WINO), (r % 40) * 32, (r / 40) * 64, (r % 40) * 32, scr, lane); }
        else if (it < T_WOUTO) { int r = it - T_WINO; transpose_item(P.in[16], 1024, 1024, (bf16*)(ws + WS_WOUTO), (r % 32) * 32, (r / 32) * 64, (r % 32) * 32, scr, lane); }
        else if (it < T_U) {
            bool up = it >= T_G; int r = it - (up ? T_G : T_WOUTO); int le = r / I_EXP_GU; r %= I_EXP_GU; int kb = r / 8, hb = r % 8;
            const float* W = (up ? P.in[25] : P.in[24]) + (size_t)le * 1024 * 256;
            transpose_item(W, 1024, 256, (bf16*)(ws + WS_WGU) + (size_t)le * 512 * 1024, 64 * hb + (up ? 32 : 0), kb * 64, hb * 32, scr, lane);
        } else {
            int r = it - T_U; int le = r / I_EXP_D; r %= I_EXP_D; int kb = r / 32, nb = r % 32;
            transpose_item(P.in[26] + (size_t)le * 256 * 1024, 256, 1024, (bf16*)(ws + WS_WD) + (size_t)le * 1024 * 256, nb * 32, kb * 64, nb * 32, scr, lane);
        }
    }
    { u32x4 z = {0, 0, 0, 0}; u32x4* p = (u32x4*)((bf16*)(ws + WS_WINE) + (size_t)EVEN_IN * 1024);
      for (int i = bid * 256 + threadIdx.x; i < 96 * 1024 * 2 / 16; i += nblk * 256) p[i] = z; }
    for (int i = bid * 256 + threadIdx.x; i < 1024; i += nblk * 256) {
        int pos = i >> 4, f = i & 15; float inv = powf(10000.f, -(float)(2 * f) / 32.f); float ang = (float)pos * inv;
        ((float2*)(ws + WS_ROPE))[i] = make_float2(cosf(ang), sinf(ang));
    }
    for (int i = bid * 256 + threadIdx.x; i < NT; i += nblk * 256) ((float*)(ws + WS_RSS))[i] = 0.f;
    if (bid == 0 && threadIdx.x < 2) {
        const float* gq = threadIdx.x ? P.in[18] : P.in[13]; const float* gk = threadIdx.x ? P.in[19] : P.in[14];
        float mq = 0.f, mk = 0.f; for (int d = 0; d < 64; ++d) { mq = fmaxf(mq, fabsf(gq[d])); mk = fmaxf(mk, fabsf(gk[d])); }
        ((float*)(ws + WS_ROPE + 8192))[threadIdx.x] = 8.f * mq * mk * 1.4426950408889634f;
    }
    __syncthreads();
    {
        LAS float* sc = (LAS float*)smem;
        LAS float* red = (LAS float*)smem + 5 * 1024;
        for (int i = threadIdx.x; i < 5 * 1024; i += 256) { const float cv = i < 4096 ? P.in[1][i] : P.in[3][i - 4096]; sc[i] = cv / (1.f + expf(-cv)); }
        __syncthreads();
        for (int it = bid; it < 2 * 96; it += nblk) {
            const int layer = it / 96, col = (it % 96) * 64 + lane;
            const float* w = P.in[4] + (size_t)layer * D * 6144 + col;
            float a0 = 0.f, a1 = 0.f, a2 = 0.f, a3 = 0.f, a4 = 0.f;
#pragma unroll 32
            for (int k = 256 * wave; k < 256 * wave + 256; ++k) { const float wv = w[(size_t)k * 6144]; a0 += sc[k] * wv; a1 += sc[1024 + k] * wv; a2 += sc[2048 + k] * wv; a3 += sc[3072 + k] * wv; a4 += sc[4096 + k] * wv; }
            red[(wave * 5 + 0) * 64 + lane] = a0; red[(wave * 5 + 1) * 64 + lane] = a1; red[(wave * 5 + 2) * 64 + lane] = a2; red[(wave * 5 + 3) * 64 + lane] = a3; red[(wave * 5 + 4) * 64 + lane] = a4;
            __syncthreads();
            for (int i = threadIdx.x; i < 320; i += 256) { const int row = i >> 6, cl = i & 63;
                ((float*)(ws + WS_MODV))[((size_t)layer * 5 + row) * 6144 + (it % 96) * 64 + cl] = red[row * 64 + cl] + red[(5 + row) * 64 + cl] + red[(10 + row) * 64 + cl] + red[(15 + row) * 64 + cl] + P.in[5][layer * 6144 + (it % 96) * 64 + cl]; }
            __syncthreads();
        }
    }
}

template <bool SRC_BF>
__device__ __forceinline__ void modulate_rows(const float* xlat, const float* xctx, const bf16* xs, const float* modv_layer, const float* gain, int which, bf16* H, int nrows, int gw, int NGW, int lane) {
    for (int row = gw; row < nrows; row += NGW) {
        const float* mv = modv_layer + (size_t)(row < NL ? row / S : 4) * 6144;
        f32x4 v[4]; float ss = 0.f;
#pragma unroll
        for (int j = 0; j < 4; ++j) {
            if (SRC_BF) { const u32x2 w = *(const u32x2*)(xs + (size_t)row * D + 4 * lane + 256 * j); f32x4 t = {__uint_as_float(w.x << 16), __uint_as_float(w.x & 0xffff0000u), __uint_as_float(w.y << 16), __uint_as_float(w.y & 0xffff0000u)}; v[j] = t; }
            else { const float* xr = row < NL ? xlat + (size_t)row * D : xctx + (size_t)(row - NL) * D; v[j] = *(const f32x4*)(xr + 4 * lane + 256 * j); }
            ss += v[j].x * v[j].x + v[j].y * v[j].y + v[j].z * v[j].z + v[j].w * v[j].w;
        }
        float rstd = rsqrtf(wave_sum(ss) / D + EPS);
#pragma unroll
        for (int j = 0; j < 4; ++j) {
            int k = 4 * lane + 256 * j;
            f32x4 g = *(const f32x4*)(gain + k), sc = *(const f32x4*)(mv + (which + 1) * 1024 + k), sh = *(const f32x4*)(mv + which * 1024 + k);
            float h0 = v[j].x * rstd * g.x * (1.f + sc.x) + sh.x, h1 = v[j].y * rstd * g.y * (1.f + sc.y) + sh.y;
            float h2 = v[j].z * rstd * g.z * (1.f + sc.z) + sh.z, h3 = v[j].w * rstd * g.w * (1.f + sc.w) + sh.w;
            u32x2 o = {pk2(h0, h1), pk2(h2, h3)};
            *(u32x2*)(H + (size_t)row * D + k) = o;
        }
    }
}
__device__ __forceinline__ void route_tables(const Ptrs& P, int layer, int bid, int nblk);
__device__ __forceinline__ void ph_modulate(const Ptrs& P, int layer, int bid, int nblk) {
    route_tables(P, layer, bid, nblk);
    if (layer == 0) modulate_rows<false>(P.in[0], P.in[2], nullptr, (const float*)(P.ws + WS_MODV), P.in[6], 0, (bf16*)(P.ws + WS_R1), NT, bid * 4 + (threadIdx.x >> 6), nblk * 4, threadIdx.x & 63);
    else modulate_rows<true>(nullptr, nullptr, (const bf16*)(P.ws + WS_R4), (const float*)(P.ws + WS_MODV) + (size_t)5 * 6144, P.in[6] + D, 0, (bf16*)(P.ws + WS_R1), NT, bid * 4 + (threadIdx.x >> 6), nblk * 4, threadIdx.x & 63);
}

struct AffineRows {
    const bf16* base; size_t ld; int w; unsigned vo[4];
    __device__ __forceinline__ AffineRows(const bf16* b, size_t ld_) : base(b), ld(ld_), w(0) {}
    __device__ __forceinline__ void init(int w_, int rl, const int (&co)[4]) { w = w_;
#pragma unroll
        for (int i = 0; i < 4; ++i) vo[i] = (unsigned)((rl * ld + co[i]) * 2); }
    __device__ __forceinline__ const bf16* sb(int i, int kt) const { return base + (size_t)(32 * w + 8 * i) * ld + kt * 64; }
};
template <bool SWP, class AF, class BF, class Epi>
__device__ __forceinline__ void gemm_tile(AF af, BF bf, int nk, LAS unsigned char* smem, const Epi& epi) {
    const int tid = threadIdx.x, lane = tid & 63, wave = __builtin_amdgcn_readfirstlane(tid >> 6), wn = wave & 1, wm = wave >> 1, l31 = lane & 31, hh = lane >> 5;
    const int r0 = wave * 32 + (lane >> 3);
    __syncthreads();
    typename Epi::Pre pre; epi.prefetch(pre, wn * 64, wm * 64, l31, hh);
    __builtin_amdgcn_sched_barrier(0);
    int coff[4];
#pragma unroll
    for (int i = 0; i < 4; ++i) coff[i] = ((lane & 7) ^ (((r0 >> 1) + 4 * i) & 7)) * 8;
    af.init(wave, lane >> 3, coff); bf.init(wave, lane >> 3, coff);
#define GT_STAGE(st, kt) do { _Pragma("unroll") for (int i = 0; i < 4; ++i) { \
        __builtin_amdgcn_global_load_lds((const unsigned*)((const char*)af.sb(i, (kt)) + af.vo[i]), (LAS unsigned*)(smem + (st) * 2 * TILE_LDS + (wave * 4 + i) * 1024), 16, 0, 0); \
        __builtin_amdgcn_global_load_lds((const unsigned*)((const char*)bf.sb(i, (kt)) + bf.vo[i]), (LAS unsigned*)(smem + (st) * 2 * TILE_LDS + TILE_LDS + (wave * 4 + i) * 1024), 16, 0, 0); } } while (0)
    GT_STAGE(0, 0);
    f32x16 acc[2][2];
#pragma unroll
    for (int i = 0; i < 2; ++i)
#pragma unroll
        for (int j = 0; j < 2; ++j)
#pragma unroll
            for (int r = 0; r < 16; ++r) acc[i][j][r] = 0.f;
    const int sw = (l31 >> 1) & 7;
    int xo[4], wo[4];
#pragma unroll
    for (int s = 0; s < 4; ++s) { const int cs = ((2 * s + hh) ^ sw) * 16; xo[s] = (wm * 64 + l31) * 128 + cs; wo[s] = TILE_LDS + (wn * 64 + l31) * 128 + cs; }
    asm volatile("s_waitcnt vmcnt(0)" ::: "memory");
    __syncthreads();
    for (int kt = 0; kt < nk; ++kt) {
        const int st = kt & 1;
        if (kt + 1 < nk) GT_STAGE(st ^ 1, kt + 1);
        LAS unsigned char* sb = smem + st * 2 * TILE_LDS;
#pragma unroll
        for (int s = 0; s < 4; ++s) {
            bf16x8 wf[2], xf[2];
#pragma unroll
            for (int i = 0; i < 2; ++i) wf[i] = *(LAS bf16x8*)(sb + wo[s] + i * 4096);
#pragma unroll
            for (int j = 0; j < 2; ++j) xf[j] = *(LAS bf16x8*)(sb + xo[s] + j * 4096);
#pragma unroll
            for (int i = 0; i < 2; ++i)
#pragma unroll
                for (int j = 0; j < 2; ++j) acc[i][j] = SWP ? __builtin_amdgcn_mfma_f32_32x32x16_bf16(xf[j], wf[i], acc[i][j], 0, 0, 0)
                                                            : __builtin_amdgcn_mfma_f32_32x32x16_bf16(wf[i], xf[j], acc[i][j], 0, 0, 0);
        }
        asm volatile("s_waitcnt vmcnt(0)" ::: "memory");
        __syncthreads();
    }
#undef GT_STAGE
    { int l31e = l31, hhe = hh, we = wave; asm volatile("" : "+v"(l31e), "+v"(hhe), "+v"(we));
      epi(acc, (we & 1) * 64, (we >> 1) * 64, l31e, hhe, smem + we * 16384, pre); }
}

constexpr int SG_P = 144;
__device__ __forceinline__ void store_bf16_T(const f32x16 (&acc)[2][2], bf16* out, size_t ld, size_t trow0, int col0, int l31, int hh, LAS unsigned char* wl) {
#pragma unroll
    for (int j = 0; j < 2; ++j)
#pragma unroll
        for (int i = 0; i < 2; ++i)
#pragma unroll
            for (int g = 0; g < 4; ++g) { u32x2 v = {pk2(acc[i][j][4 * g], acc[i][j][4 * g + 1]), pk2(acc[i][j][4 * g + 2], acc[i][j][4 * g + 3])}; *(LAS u32x2*)(wl + (32 * j + l31) * SG_P + (32 * i + 8 * g + 4 * hh) * 2) = v; }
    const int lane = l31 + 32 * hh, rr = lane >> 3, ch = lane & 7;
#pragma unroll
    for (int q = 0; q < 8; ++q) { const int R = 8 * q + rr; const u32x4 v = *(LAS u32x4*)(wl + R * SG_P + ch * 16); *(u32x4*)(out + (trow0 + R) * ld + col0 + ch * 8) = v; }
}
__device__ __forceinline__ void qknorm_rope_T(f32x16 (&acc)[2][2], const float* gain, const float2* ropeT, bool latent, int tok0  , int l31, int hh, float oscale = 1.f) {
#pragma unroll
    for (int j = 0; j < 2; ++j) {
        float ss = 0.f;
#pragma unroll
        for (int i = 0; i < 2; ++i)
#pragma unroll
            for (int r = 0; r < 16; ++r) ss += acc[i][j][r] * acc[i][j][r];
        ss = xhalf_sum(ss);
        const float rstd = rsqrtf(ss * (1.f / 64.f) + EPS) * oscale;
#pragma unroll
        for (int i = 0; i < 2; ++i)
#pragma unroll
            for (int r = 0; r < 16; ++r) acc[i][j][r] *= rstd * gain[i * 32 + (r & 3) + 8 * (r >> 2) + 4 * hh];
        if (latent) {
            const int t = tok0 + j * 32 + l31;
#pragma unroll
            for (int i = 0; i < 2; ++i) {
                const int pos = i == 0 ? (t >> 6) : (t & 63);
#pragma unroll
                for (int r = 0; r < 8; ++r) {
                    const int f = (r & 3) + 8 * (r >> 2) + 4 * hh;
                    const float2 cs = ropeT[pos * 16 + f];
                    const float x1 = acc[i][j][r], x2 = acc[i][j][r + 8];
                    acc[i][j][r] = x1 * cs.x - x2 * cs.y; acc[i][j][r + 8] = x2 * cs.x + x1 * cs.y;
                }
            }
        }
    }
}

constexpr int VT_LD = S + CL;
__device__ __forceinline__ void store_vt_swapped(const f32x16 (&acc)[2][2], bf16* vt_head  , int key0, int l31, int hh, LAS unsigned char* wl) {
#pragma unroll
    for (int i = 0; i < 2; ++i)
#pragma unroll
        for (int j = 0; j < 2; ++j)
#pragma unroll
            for (int g = 0; g < 4; ++g) { u32x2 v = {pk2(acc[i][j][4 * g], acc[i][j][4 * g + 1]), pk2(acc[i][j][4 * g + 2], acc[i][j][4 * g + 3])}; *(LAS u32x2*)(wl + (32 * i + l31) * SG_P + (32 * j + 8 * g + 4 * hh) * 2) = v; }
    const int lane = l31 + 32 * hh, rr = lane >> 3, ch = lane & 7;
#pragma unroll
    for (int q = 0; q < 8; ++q) { const int R = 8 * q + rr; const u32x4 v = *(LAS u32x4*)(wl + R * SG_P + ch * 16); *(u32x4*)(vt_head + (size_t)R * VT_LD + key0 + ch * 8) = v; }
}
struct NoPre {};
template <bool SRC_BF> struct RmwPre { f32x4 xi[16]; };
template <> struct RmwPre<true> { u32x2 xi[16]; };
template <bool SRC_BF, class RowF>
__device__ __forceinline__ void rmw_prefetch(RmwPre<SRC_BF>& pre, const RowF& rowf, int l31, int hh) {
    const int lane = l31 + 32 * hh, rr = lane >> 4, ch = lane & 15;
#pragma unroll
    for (int q = 0; q < 16; ++q) {
        const void* sp; void* dp; const float* gp; int tk;
        if (rowf(4 * q + rr, sp, dp, gp, tk)) {
            if constexpr (SRC_BF) pre.xi[q] = *(const u32x2*)((const bf16*)sp + ch * 4); else pre.xi[q] = *(const f32x4*)((const float*)sp + ch * 4);
        }
    }
}
template <bool SRC_BF, bool DST_BF, bool SS, class RowF>
__device__ __forceinline__ void rmw_finish(const f32x16 (&acc)[2][2], const RmwPre<SRC_BF>& pre, const RowF& rowf, int l31, int hh, LAS unsigned char* wl, float* rss = nullptr) {
    const int lane = l31 + 32 * hh, rr = lane >> 4, ch = lane & 15;
#pragma unroll
    for (int j = 0; j < 2; ++j)
#pragma unroll
        for (int i = 0; i < 2; ++i)
#pragma unroll
            for (int g = 0; g < 4; ++g) { f32x4 v = {acc[i][j][4 * g], acc[i][j][4 * g + 1], acc[i][j][4 * g + 2], acc[i][j][4 * g + 3]};
                const int R = 32 * j + l31; *(LAS f32x4*)(wl + R * 256 + (((8 * i + 2 * g + hh) ^ (R & 15)) * 16)) = v; }
    float ssr[16];
#pragma unroll
    for (int q = 0; q < 16; ++q) {
        const void* sp; void* dp; const float* gp; int tk = 0;
        const bool ok = rowf(4 * q + rr, sp, dp, gp, tk);
        float ssq = 0.f;
        if (ok) {
            f32x4 x;
            if constexpr (SRC_BF) { const u32x2 w = pre.xi[q]; f32x4 t = {__uint_as_float(w.x << 16), __uint_as_float(w.x & 0xffff0000u), __uint_as_float(w.y << 16), __uint_as_float(w.y & 0xffff0000u)}; x = t; } else x = pre.xi[q];
            const int R = 4 * q + rr; const f32x4 a = *(LAS f32x4*)(wl + R * 256 + ((ch ^ (R & 15)) * 16)); const f32x4 gt = *(const f32x4*)(gp + ch * 4);
            const f32x4 v = {x.x + gt.x * a.x, x.y + gt.y * a.y, x.z + gt.z * a.z, x.w + gt.w * a.w};
            if (DST_BF) { u32x2 o = {pk2(v.x, v.y), pk2(v.z, v.w)}; *(u32x2*)((bf16*)dp + ch * 4) = o;
                if (SS) { const float r0 = __uint_as_float(o.x << 16), r1 = __uint_as_float(o.x & 0xffff0000u), r2 = __uint_as_float(o.y << 16), r3 = __uint_as_float(o.y & 0xffff0000u); ssq = (r0 * r0 + r1 * r1) + (r2 * r2 + r3 * r3); } }
            else *(f32x4*)((float*)dp + ch * 4) = v;
        }
        if (SS) { ssq += __shfl_xor(ssq, 1); ssq += __shfl_xor(ssq, 2); ssq += __shfl_xor(ssq, 4); ssq += __shfl_xor(ssq, 8); ssr[q] = ssq; }
    }
    if (SS) {
        if (ch == 0) {
#pragma unroll
            for (int q = 0; q < 16; ++q) *(LAS float*)(wl + (4 * q + rr) * 4) = ssr[q];
        }
        const float sv = *(LAS float*)(wl + lane * 4);
        const void* sp; void* dp; const float* gp; int tk = 0;
        if (rowf(lane, sp, dp, gp, tk)) atomicAdd(rss + tk, sv);
    }
}
struct EpiEvenIn {
    typedef NoPre Pre;
    __device__ __forceinline__ void prefetch(Pre&, int, int, int, int) const {}
    unsigned char* r3; const float* qn; const float* kn; const float2* ropeT; int mt, nt;
    __device__ __forceinline__ bool swapped() const { return nt == 17 || (nt >= 4 && nt < 8); }
    __device__ __forceinline__ void operator()(f32x16 (&acc)[2][2], int fb, int tb, int l31, int hh, LAS unsigned char* wl, const Pre& pre) const {
        const size_t trow0 = (size_t)mt * 128 + tb; const bool latent = mt < NL / 128; const int tok0 = (int)(trow0 & (S - 1));
        if (swapped()) {
            const int b = latent ? (int)(trow0 / S) : (int)((trow0 - NL) / CL); const int key0 = latent ? tok0 : S + (int)((trow0 - NL) % CL);
            const size_t off = nt == 17 ? R3_AV + (size_t)(b * 2 + fb / 64) * 64 * VT_LD * 2 : R3_GV + ((size_t)(b * 4 + nt - 4) * 128 + fb) * VT_LD * 2;
            store_vt_swapped(acc, (bf16*)(r3 + off), key0, l31, hh, wl);
        } else if (nt == 18) {
            if (fb == 0) {
                float* LR = (float*)(r3 + R3_LR);
#pragma unroll
                for (int j = 0; j < 2; ++j)
#pragma unroll
                    for (int g = 0; g < 4; ++g) { f32x4 v = {acc[0][j][4 * g], acc[0][j][4 * g + 1], acc[0][j][4 * g + 2], acc[0][j][4 * g + 3]}; *(f32x4*)(LR + (trow0 + j * 32 + l31) * 32 + 8 * g + 4 * hh) = v; }
            }
        } else {
            size_t off; int ld, col;
            if (nt < 2) { off = R3_GQ; ld = 256; col = nt * 128; }
            else if (nt < 4) { off = R3_GK; ld = 256; col = (nt - 2) * 128; }
            else if (nt < 12) { off = R3_GR; ld = 512; col = (nt - 8) * 128; }
            else if (nt < 16) { off = R3_AQ; ld = 512; col = (nt - 12) * 128; }
            else { off = R3_AK; ld = 128; col = 0; }
            if (nt >= 12) qknorm_rope_T(acc, nt < 16 ? qn : kn, ropeT, latent, tok0, l31, hh, nt < 16 ? QSCALE : 1.f);
            store_bf16_T(acc, (bf16*)(r3 + off), ld, trow0, col + fb, l31, hh, wl);
        }
    }
};
__device__ __forceinline__ int xcd_vid(int bid, int nb) { return (nb % 8 == 0) ? (bid % 8) * (nb / 8) + bid / 8 : bid; }

__device__ __forceinline__ void ph_even_inproj(const Ptrs& P, LAS unsigned char* smem, int bid, int nblk) {
    unsigned char* ws = P.ws;
    const int lrow = threadIdx.x >> 3, kc = threadIdx.x & 7;
    const int vid = xcd_vid(bid, nblk);
    for (int tile = vid; tile < (NT / 128) * 19; tile += nblk) {
        const int mt = tile / 19, nt = tile % 19;
        AffineRows af((const bf16*)(ws + WS_R1) + (size_t)mt * 128 * D, D);
        AffineRows bf_((const bf16*)(ws + WS_WINE) + (size_t)nt * 128 * D, D);
        EpiEvenIn epi{ws + WS_R3, P.in[13], P.in[14], (const float2*)(ws + WS_ROPE), mt, nt};
        if (epi.swapped()) gemm_tile<true>(af, bf_, D / 64, smem, epi); else gemm_tile<false>(af, bf_, D / 64, smem, epi);
    }
}

template <int LAYER>
struct EpiOutProj {
    typedef RmwPre<LAYER != 0> Pre;
    const float* modv_layer; const float* xin_lat; const float* xin_ctx; bf16* xs; int mt, nt;
    __device__ __forceinline__ bool swapped() const { return false; }
    __device__ __forceinline__ auto rowfn(int fb, int tb) const {
        const size_t trow0 = (size_t)mt * 128 + tb; const bool latent = mt < NL / 128;
        const int c0 = nt * 128 + fb;
        const float* gate = modv_layer + (size_t)(latent ? trow0 / S : 4) * 6144 + 2 * 1024 + c0;
        bf16* xo = xs + trow0 * D + c0;
        const float* xin = LAYER == 0 ? (latent ? xin_lat + trow0 * D : xin_ctx + (trow0 - NL) * D) + c0 : nullptr;
        return [=](int R, const void*& sp, void*& dp, const float*& gp, int& tk) { if (LAYER == 0) sp = xin + (size_t)R * D; else sp = xo + (size_t)R * D; dp = xo + (size_t)R * D; gp = gate; tk = (int)trow0 + R; return true; };
    }
    __device__ __forceinline__ void prefetch(Pre& pre, int fb, int tb, int l31, int hh) const { rmw_prefetch<LAYER != 0>(pre, rowfn(fb, tb), l31, hh); }
    __device__ __forceinline__ void operator()(f32x16 (&acc)[2][2], int fb, int tb, int l31, int hh, LAS unsigned char* wl, const Pre& pre) const {
        rmw_finish<LAYER != 0, true, false>(acc, pre, rowfn(fb, tb), l31, hh, wl);
    }
};
__device__ __forceinline__ void ph_outproj(const Ptrs& P, LAS unsigned char* smem, int bid, int nblk, int layer, int nrows) {
    unsigned char* ws = P.ws;
    const int lrow = threadIdx.x >> 3, kc = threadIdx.x & 7;
    const int vid = xcd_vid(bid, nblk);
    const float* modv_layer = (const float*)(ws + WS_MODV) + (size_t)layer * 5 * 6144;
    for (int tile = vid; tile < (nrows / 128) * 8; tile += nblk) {
        const int mt = tile / 8, nt = tile % 8;
        AffineRows af((const bf16*)(ws + WS_R2) + (size_t)mt * 128 * D, D);
        AffineRows bf_((const bf16*)(ws + (layer ? WS_WOUTO : WS_WOUTE)) + (size_t)nt * 128 * D, D);
        if (layer == 0) { EpiOutProj<0> epi{modv_layer, P.in[0], P.in[2], (bf16*)(ws + WS_R4), mt, nt}; gemm_tile<false>(af, bf_, D / 64, smem, epi); }
        else { EpiOutProj<1> epi{modv_layer, nullptr, nullptr, (bf16*)(ws + WS_R4), mt, nt}; gemm_tile<false>(af, bf_, D / 64, smem, epi); }
    }
}

struct EpiOddIn {
    typedef NoPre Pre;
    __device__ __forceinline__ void prefetch(Pre&, int, int, int, int) const {}
    unsigned char* r3; const float* qn; const float* kn; const float2* ropeT; const float* rss; const float* bi; int mt, nt;
    __device__ __forceinline__ bool swapped() const { return nt == 9; }
    __device__ __forceinline__ void operator()(f32x16 (&acc)[2][2], int fb, int tb, int l31, int hh, LAS unsigned char* wl, const Pre& pre) const {
        const size_t trow0 = (size_t)mt * 128 + tb; const bool latent = mt < NL / 128; const int tok0 = (int)(trow0 & (S - 1));
        if (!swapped()) {
#pragma unroll
            for (int j = 0; j < 2; ++j) {
                const float rs = rsqrtf(rss[trow0 + 32 * j + l31] * (1.f / D) + EPS);
#pragma unroll
                for (int i = 0; i < 2; ++i)
#pragma unroll
                    for (int g = 0; g < 4; ++g) { const f32x4 b4 = *(const f32x4*)(bi + nt * 128 + fb + 32 * i + 8 * g + 4 * hh);
                        acc[i][j][4 * g] = acc[i][j][4 * g] * rs + b4.x; acc[i][j][4 * g + 1] = acc[i][j][4 * g + 1] * rs + b4.y; acc[i][j][4 * g + 2] = acc[i][j][4 * g + 2] * rs + b4.z; acc[i][j][4 * g + 3] = acc[i][j][4 * g + 3] * rs + b4.w; }
            }
        } else {
#pragma unroll
            for (int j = 0; j < 2; ++j)
#pragma unroll
                for (int g = 0; g < 4; ++g) { const f32x4 q4 = *(const f32x4*)(rss + trow0 + 32 * j + 8 * g + 4 * hh);
                    const float r0 = rsqrtf(q4.x * (1.f / D) + EPS), r1 = rsqrtf(q4.y * (1.f / D) + EPS), r2 = rsqrtf(q4.z * (1.f / D) + EPS), r3_ = rsqrtf(q4.w * (1.f / D) + EPS);
#pragma unroll
                    for (int i = 0; i < 2; ++i) { const float bb = bi[nt * 128 + fb + 32 * i + l31];
                        acc[i][j][4 * g] = acc[i][j][4 * g] * r0 + bb; acc[i][j][4 * g + 1] = acc[i][j][4 * g + 1] * r1 + bb; acc[i][j][4 * g + 2] = acc[i][j][4 * g + 2] * r2 + bb; acc[i][j][4 * g + 3] = acc[i][j][4 * g + 3] * r3_ + bb; } }
        }
        if (nt < 8) { if (latent) { qknorm_rope_T(acc, qn, ropeT, true, tok0, l31, hh, QSCALE); store_bf16_T(acc, (bf16*)(r3 + R3_OQ), 1024, trow0, nt * 128 + fb, l31, hh, wl); } }
        else if (nt == 8) { qknorm_rope_T(acc, kn, ropeT, latent, tok0, l31, hh); store_bf16_T(acc, (bf16*)(r3 + R3_OK), 128, trow0, fb, l31, hh, wl); }
        else {
            const int b = latent ? (int)(trow0 / S) : (int)((trow0 - NL) / CL); const int key0 = latent ? tok0 : S + (int)((trow0 - NL) % CL);
            store_vt_swapped(acc, (bf16*)(r3 + R3_OV) + (size_t)(b * 2 + fb / 64) * 64 * VT_LD, key0, l31, hh, wl);
        }
    }
};
__device__ __forceinline__ void ph_odd_inproj(const Ptrs& P, LAS unsigned char* smem, int bid, int nblk) {
    unsigned char* ws = P.ws;
    const int lrow = threadIdx.x >> 3, kc = threadIdx.x & 7;
    const int vid = xcd_vid(bid, nblk);
    constexpr int T_LAT = (NL / 128) * 10, T_ALL = T_LAT + (NC / 128) * 2;
    for (int tile = vid; tile < T_ALL; tile += nblk) {
        int mt, nt;
        if (tile < T_LAT) { mt = tile / 10; nt = tile % 10; } else { mt = NL / 128 + (tile - T_LAT) / 2; nt = 8 + (tile - T_LAT) % 2; }
        const int brow = mt < NL / 128 ? mt / (S / 128) : 4;
        AffineRows af((const bf16*)(ws + WS_R4) + (size_t)mt * 128 * D, D);
        AffineRows bf_((const bf16*)(ws + WS_WINOF) + ((size_t)brow * 1280 + nt * 128) * D, D);
        EpiOddIn epi{ws + WS_R3, P.in[18], P.in[19], (const float2*)(ws + WS_ROPE), (const float*)(ws + WS_RSS), (const float*)(ws + WS_BI) + brow * 1280, mt, nt};
        if (epi.swapped()) gemm_tile<true>(af, bf_, D / 64, smem, epi); else gemm_tile<false>(af, bf_, D / 64, smem, epi);
    }
}

constexpr int AT_KP = 144, AT_VP = 136;
constexpr int AT_STAGE = 64 * AT_KP + 64 * AT_VP;
constexpr int ATTN_LDS = 2 * AT_STAGE;
struct AttnArgs {
    const bf16* Q; int ldq; size_t qrow0; int qcol;
    const bf16* K; size_t klat0, kctx0;
    const bf16* Vt;
    int nctx, tlo, nlat;
    int banded, tq0;
    const float* sinkp;
    int sink0;
    int wrow, wcol;
    float m0;
    bf16* out;
};
__device__ __forceinline__ float xhalf_max(float x) {
    auto t = __builtin_amdgcn_permlane32_swap(__float_as_uint(x), __float_as_uint(x), false, false);
    return fmaxf(__uint_as_float(t[0]), __uint_as_float(t[1]));
}
__device__ __forceinline__ void attn_block(const AttnArgs& a, LAS unsigned char* smem) {
    int tid_ = threadIdx.x; asm volatile("" : "+v"(tid_));
    const int tid = tid_, lane = tid & 63, wave = tid >> 6, l31 = lane & 31, hh = lane >> 5;
    bf16x8 qf[2][4];
#pragma unroll
    for (int u = 0; u < 2; ++u) { const bf16* qp = a.Q + (a.qrow0 + wave * a.wrow + u * 32 + l31) * a.ldq + a.qcol + wave * a.wcol + hh * 8;
#pragma unroll
      for (int s = 0; s < 4; ++s) qf[u][s] = *(const bf16x8*)(qp + 16 * s); }
    f32x16 o[2][2], minit;
#pragma unroll
    for (int r = 0; r < 16; ++r) { o[0][0][r] = 0.f; o[0][1][r] = 0.f; o[1][0][r] = 0.f; o[1][1][r] = 0.f; minit[r] = -a.m0; }
    float ls[2][2] = {{0.f, 0.f}, {0.f, 0.f}};
    const int ntile = a.nctx + a.nlat;
    const int lr0 = tid >> 3, kc = tid & 7;
    const bf16* kbase = a.K + (size_t)lr0 * 128 + kc * 8;
    const bf16* vbase = a.Vt + (size_t)lr0 * VT_LD + kc * 8;
    const int kwoff = lr0 * AT_KP + kc * 16, vwoff = 64 * AT_KP + lr0 * AT_VP + kc * 16;
    const int kroff = l31 * AT_KP + hh * 16, vroff = 64 * AT_KP + l31 * AT_VP + hh * 8;
    u32x4 rk[2], rv[2];
#define AT_ISSUE(n) do { const int t_ = __builtin_amdgcn_readfirstlane((n) < a.nctx ? 64 + (n) : a.tlo + (n) - a.nctx); \
        const size_t kr_ = (t_ < 64 ? a.klat0 + 64 * t_ : a.kctx0 + 64 * (t_ - 64)); \
        const bf16* kq_ = kbase + kr_ * 128; const bf16* vq_ = vbase + 64 * t_; \
        rk[0] = *(const u32x4*)kq_; rk[1] = *(const u32x4*)(kq_ + 32 * 128); rv[0] = *(const u32x4*)vq_; rv[1] = *(const u32x4*)(vq_ + (size_t)32 * VT_LD); } while (0)
#define AT_COMMIT(ST) do { LAS unsigned char* sb_ = smem + (ST) * AT_STAGE; \
        _Pragma("unroll") for (int i = 0; i < 2; ++i) { *(LAS u32x4*)(sb_ + kwoff + i * 32 * AT_KP) = rk[i]; \
            u32x2 lo_ = {rv[i].x, rv[i].y}, hi_ = {rv[i].z, rv[i].w}; *(LAS u32x2*)(sb_ + vwoff + i * 32 * AT_VP) = lo_; *(LAS u32x2*)(sb_ + vwoff + i * 32 * AT_VP + 8) = hi_; } } while (0)
#define AT_BODY(ST, n) do { \
        if ((n) + 1 < ntile) AT_ISSUE((n) + 1); \
        __builtin_amdgcn_sched_barrier(0); \
        LAS unsigned char* sb = smem + (ST) * AT_STAGE; \
        bool skip = false, edge = false; \
        if (a.banded && (n) >= a.nctx) { const int k0 = 64 * (a.tlo + (n) - a.nctx), q0w = a.tq0 + wave * a.wrow; skip = (k0 + 63 < q0w - 128) || (k0 > q0w + 63 + 128); \
            edge = __builtin_amdgcn_readfirstlane((k0 + 63 > q0w + 128) || (k0 < q0w + 63 - 128)); }       \
        if (!skip) { \
            _Pragma("unroll") for (int kt = 0; kt < 2; ++kt) { \
                f32x16 sc[2]; \
                _Pragma("unroll") for (int s = 0; s < 4; ++s) { \
                    const bf16x8 kf = *(LAS bf16x8*)(sb + kroff + kt * 32 * AT_KP + s * 32); \
                    sc[0] = __builtin_amdgcn_mfma_f32_32x32x16_bf16(kf, qf[0][s], s == 0 ? minit : sc[0], 0, 0, 0); \
                    sc[1] = __builtin_amdgcn_mfma_f32_32x32x16_bf16(kf, qf[1][s], s == 0 ? minit : sc[1], 0, 0, 0); } \
                if (edge) { \
                    _Pragma("unroll") for (int u = 0; u < 2; ++u) { \
                        const int dbase = 64 * (a.tlo + (n) - a.nctx) + 32 * kt + 4 * hh - (a.tq0 + wave * a.wrow + u * 32 + l31); \
                        _Pragma("unroll") for (int r = 0; r < 16; ++r) { const int df = dbase + (r & 3) + 8 * (r >> 2); if (df > 128 || df < -128) sc[u][r] = -1e30f; } } } \
                _Pragma("unroll") for (int u = 0; u < 2; ++u) _Pragma("unroll") for (int r = 0; r < 16; r += 4) { \
                    sc[u][r] = __builtin_amdgcn_exp2f(sc[u][r]); ls[u][0] += sc[u][r]; sc[u][r + 1] = __builtin_amdgcn_exp2f(sc[u][r + 1]); ls[u][1] += sc[u][r + 1]; \
                    sc[u][r + 2] = __builtin_amdgcn_exp2f(sc[u][r + 2]); ls[u][0] += sc[u][r + 2]; sc[u][r + 3] = __builtin_amdgcn_exp2f(sc[u][r + 3]); ls[u][1] += sc[u][r + 3]; } \
                _Pragma("unroll") for (int s2 = 0; s2 < 2; ++s2) { \
                    bf16x8 pf[2]; \
                    _Pragma("unroll") for (int u = 0; u < 2; ++u) { \
                        u32x4 pw = {pk2(sc[u][8 * s2], sc[u][8 * s2 + 1]), pk2(sc[u][8 * s2 + 2], sc[u][8 * s2 + 3]), pk2(sc[u][8 * s2 + 4], sc[u][8 * s2 + 5]), pk2(sc[u][8 * s2 + 6], sc[u][8 * s2 + 7])}; \
                        pf[u] = __builtin_bit_cast(bf16x8, pw); } \
                    _Pragma("unroll") for (int dt = 0; dt < 2; ++dt) { \
                        LAS unsigned char* vp = sb + vroff + dt * 32 * AT_VP + (32 * kt + 16 * s2) * 2; \
                        const u32x2 v0 = *(LAS u32x2*)vp, v1 = *(LAS u32x2*)(vp + 16); u32x4 vw = {v0.x, v0.y, v1.x, v1.y}; const bf16x8 vf = __builtin_bit_cast(bf16x8, vw); \
                        _Pragma("unroll") for (int u = 0; u < 2; ++u) o[u][dt] = __builtin_amdgcn_mfma_f32_32x32x16_bf16(vf, pf[u], o[u][dt], 0, 0, 0); } } \
                __builtin_amdgcn_sched_barrier(0); \
            } \
        } \
        __builtin_amdgcn_sched_barrier(0); \
        if ((n) + 1 < ntile) AT_COMMIT((ST) ^ 1); \
        __syncthreads(); } while (0)
    AT_ISSUE(0); AT_COMMIT(0);
    __syncthreads();
#pragma unroll 1
    for (int n = 0; n < ntile; n += 2) {
        AT_BODY(0, n);
        if (n + 1 < ntile) AT_BODY(1, n + 1);
    }
#undef AT_ISSUE
#undef AT_COMMIT
#undef AT_BODY
#pragma unroll
    for (int u = 0; u < 2; ++u) {
        const float l = xhalf_sum(ls[u][0] + ls[u][1]) + (a.sinkp ? __builtin_amdgcn_exp2f(a.sinkp[a.sink0 + wave * (a.wcol >> 6)] * 1.4426950408889634f - a.m0) : 0.f);
        const float inv = 1.f / l;
        bf16* op = a.out + (a.qrow0 + wave * a.wrow + u * 32 + l31) * 1024 + wave * a.wcol + 4 * hh;
#pragma unroll
        for (int dt = 0; dt < 2; ++dt)
#pragma unroll
            for (int g = 0; g < 4; ++g) { u32x2 v = {pk2(o[u][dt][4 * g] * inv, o[u][dt][4 * g + 1] * inv), pk2(o[u][dt][4 * g + 2] * inv, o[u][dt][4 * g + 3] * inv)}; *(u32x2*)(op + dt * 32 + 8 * g) = v; }
    }
}

__device__ __forceinline__ void ph_dense_attn(const Ptrs& P, LAS unsigned char* smem, int bid, int nblk) {
    unsigned char* r3 = P.ws + WS_R3;
    const int vid = xcd_vid(bid, nblk);
    for (int item = vid; item < 512 + 32; item += nblk) {
        AttnArgs a;
        int bh, qb; bool isctx = item >= 512;
        if (!isctx) { bh = item >> 4; qb = item & 15; } else { bh = item - 512; qb = 0; }
        const int hq = bh & 7, b = bh >> 3, kv = hq >> 2;
        a.Q = (const bf16*)(r3 + R3_AQ); a.ldq = 512; a.qcol = hq * 64;
        a.qrow0 = isctx ? (size_t)NL + b * CL : (size_t)b * S + qb * 256;
        a.K = (const bf16*)(r3 + R3_AK) + kv * 64; a.klat0 = (size_t)b * S; a.kctx0 = (size_t)NL + b * CL;
        a.Vt = (const bf16*)(r3 + R3_AV) + (size_t)(b * 2 + kv) * 64 * VT_LD;
        a.nctx = 4; a.tlo = 0; a.nlat = isctx ? 0 : 64; a.banded = 0; a.tq0 = 0; a.sinkp = nullptr; a.sink0 = 0; a.wrow = 64; a.wcol = 0; a.m0 = ((const float*)(P.ws + WS_ROPE + 8192))[0];
        a.out = (bf16*)(P.ws + WS_R2) + 512 + hq * 64;
        attn_block(a, smem);
    }
}
__device__ __forceinline__ void ph_swa_attn(const Ptrs& P, LAS unsigned char* smem, int bid, int nblk) {
    unsigned char* r3 = P.ws + WS_R3;
    const int vid = xcd_vid(bid, nblk);
    for (int item = vid; item < 1024; item += nblk) {
        AttnArgs a;
        const int hg = item & 1, qb = (item >> 1) & 63, kv = (item >> 7) & 1, b = item >> 8, hq = kv * 8 + hg * 4;
        a.Q = (const bf16*)(r3 + R3_OQ); a.ldq = 1024; a.qcol = hq * 64; a.qrow0 = (size_t)b * S + qb * 64;
        a.K = (const bf16*)(r3 + R3_OK) + kv * 64; a.klat0 = (size_t)b * S; a.kctx0 = (size_t)NL + b * CL;
        a.Vt = (const bf16*)(r3 + R3_OV) + (size_t)(b * 2 + kv) * 64 * VT_LD;
        const int tlo = qb - 2 < 0 ? 0 : qb - 2, thi = qb + 2 > 63 ? 63 : qb + 2;
        a.nctx = 4; a.tlo = tlo; a.nlat = thi - tlo + 1; a.banded = 1; a.tq0 = qb * 64; a.sinkp = P.in[17]; a.sink0 = hq; a.wrow = 0; a.wcol = 64; a.m0 = ((const float*)(P.ws + WS_ROPE + 8192))[1];
        a.out = (bf16*)(P.ws + WS_R2) + hq * 64;
        attn_block(a, smem);
    }
}

constexpr size_t WS_LIST = 247 * MiB;
constexpr size_t WS_WTS = WS_LIST + (size_t)24 * NT * 4;
constexpr size_t WS_END_ALL = WS_WTS + (size_t)NT * 2 * 4;
static_assert(WS_R3 + R3_END <= WS_LIST && WS_END_ALL <= 256 * MiB, "ws map tail");
constexpr int CTL_CNT = 8192;
constexpr int MOE_MAXT = NT / 128 + 24;


typedef float f32x4v __attribute__((ext_vector_type(4)));
__device__ __forceinline__ void route_tables(const Ptrs& P, int layer, int bid, int nblk) {
    unsigned char* ws = P.ws;
    const float* mvl = (const float*)(ws + WS_MODV) + (size_t)layer * 5 * 6144;
    const float* gain = P.in[7] + layer * D;
    const float* wg = P.in[20] + (size_t)layer * D * 4; const float* bg = P.in[21] + layer * 4;
    const float* we = P.in[22] + (size_t)layer * D * 16; const float* be = P.in[23] + layer * 16;
    bf16* wrt = (bf16*)(ws + WS_WRT + layer * WRT_STRIDE);
    for (int e = bid * 256 + threadIdx.x; e < 5 * 32 * 1024; e += nblk * 256) {
        const int k = e & 1023, r = (e >> 10) & 31, br = e >> 15;
        const float a = gain[k] * (1.f + mvl[(size_t)br * 6144 + 4 * 1024 + k]);
        const float w = (r < 16 ? wg[k * 4 + (r & 3)] : we[k * 16 + r - 16]) * a;
        const bf16 hi = f2bf(w); const bf16 lo = f2bf(w - bf2f(hi));
        wrt[((size_t)(br * 2 + 0) * 32 + r) * 1024 + k] = hi; wrt[((size_t)(br * 2 + 1) * 32 + r) * 1024 + k] = lo;
    }
    const int gw = bid * 4 + (threadIdx.x >> 6), lane = threadIdx.x & 63;
    if (gw < 160) {
        const int r = gw & 31, br = gw >> 5; float s = 0.f;
        for (int k = lane; k < 1024; k += 64) s += mvl[(size_t)br * 6144 + 3 * 1024 + k] * (r < 16 ? wg[k * 4 + (r & 3)] : we[k * 16 + r - 16]);
        s = wave_sum(s);
        if (lane == 0) ((float*)(ws + WS_SL))[layer * 256 + br * 32 + r] = s + (r < 16 ? bg[r & 3] : be[r - 16]);
    }
}
__device__ __forceinline__ void fold_odd_inproj(const Ptrs& P, int bid, int nblk) {
    unsigned char* ws = P.ws;
    const float* mv1 = (const float*)(ws + WS_MODV) + (size_t)5 * 6144; const float* gain = P.in[6] + D;
    const bf16* wt = (const bf16*)(ws + WS_WINO); bf16* wf = (bf16*)(ws + WS_WINOF);
    for (int e = bid * 256 + threadIdx.x; e < 5 * 80 * 128; e += nblk * 256) {
        const int k8 = (e & 127) * 8, n0 = ((e >> 7) % 80) * 16, b = e / (80 * 128);
        const f32x4 g0 = *(const f32x4*)(gain + k8), g1 = *(const f32x4*)(gain + k8 + 4), s0 = *(const f32x4*)(mv1 + (size_t)b * 6144 + 1024 + k8), s1 = *(const f32x4*)(mv1 + (size_t)b * 6144 + 1024 + k8 + 4);
        const float a0 = g0.x * (1.f + s0.x), a1 = g0.y * (1.f + s0.y), a2 = g0.z * (1.f + s0.z), a3 = g0.w * (1.f + s0.w), a4 = g1.x * (1.f + s1.x), a5 = g1.y * (1.f + s1.y), a6 = g1.z * (1.f + s1.z), a7 = g1.w * (1.f + s1.w);
        u32x4 w[16];
#pragma unroll
        for (int i = 0; i < 16; ++i) w[i] = *(const u32x4*)(wt + (size_t)(n0 + i) * 1024 + k8);
#pragma unroll
        for (int i = 0; i < 16; ++i) {
            u32x4 o;
            o.x = pk2(__uint_as_float(w[i].x << 16) * a0, __uint_as_float(w[i].x & 0xffff0000u) * a1); o.y = pk2(__uint_as_float(w[i].y << 16) * a2, __uint_as_float(w[i].y & 0xffff0000u) * a3);
            o.z = pk2(__uint_as_float(w[i].z << 16) * a4, __uint_as_float(w[i].z & 0xffff0000u) * a5); o.w = pk2(__uint_as_float(w[i].w << 16) * a6, __uint_as_float(w[i].w & 0xffff0000u) * a7);
            *(u32x4*)(wf + ((size_t)b * 1280 + n0 + i) * 1024 + k8) = o;
        }
    }
    const int gw = bid * 4 + (threadIdx.x >> 6), NGW = nblk * 4, lane = threadIdx.x & 63;
    for (int t = gw; t < 5 * 1280; t += NGW) {
        const int n = t % 1280, b = t / 1280;
        const u32x4 w0 = *(const u32x4*)(wt + (size_t)n * 1024 + 8 * lane), w1 = *(const u32x4*)(wt + (size_t)n * 1024 + 512 + 8 * lane);
        const float* sh = mv1 + (size_t)b * 6144;
        const f32x4 p0 = *(const f32x4*)(sh + 8 * lane), p1 = *(const f32x4*)(sh + 8 * lane + 4), p2 = *(const f32x4*)(sh + 512 + 8 * lane), p3 = *(const f32x4*)(sh + 512 + 8 * lane + 4);
        float s = p0.x * __uint_as_float(w0.x << 16) + p0.y * __uint_as_float(w0.x & 0xffff0000u) + p0.z * __uint_as_float(w0.y << 16) + p0.w * __uint_as_float(w0.y & 0xffff0000u)
                + p1.x * __uint_as_float(w0.z << 16) + p1.y * __uint_as_float(w0.z & 0xffff0000u) + p1.z * __uint_as_float(w0.w << 16) + p1.w * __uint_as_float(w0.w & 0xffff0000u)
                + p2.x * __uint_as_float(w1.x << 16) + p2.y * __uint_as_float(w1.x & 0xffff0000u) + p2.z * __uint_as_float(w1.y << 16) + p2.w * __uint_as_float(w1.y & 0xffff0000u)
                + p3.x * __uint_as_float(w1.z << 16) + p3.y * __uint_as_float(w1.z & 0xffff0000u) + p3.z * __uint_as_float(w1.w << 16) + p3.w * __uint_as_float(w1.w & 0xffff0000u);
        s = wave_sum(s);
        if (lane == 0) ((float*)(ws + WS_BI))[t] = s;
    }
}
typedef float f32x4a __attribute__((ext_vector_type(4)));
__device__ __forceinline__ float xq_sum(float x) {
    x += __shfl_xor(x, 16); x += __shfl_xor(x, 32); return x;
}
__device__ __forceinline__ void ph_moe_route(const Ptrs& P, LAS unsigned char* smem, int bid, int nblk, int layer, int nrows) {
    unsigned char* ws = P.ws;
    const int tid = threadIdx.x, lane = tid & 63, wave = tid >> 6, tk = lane & 15, kq = lane >> 4;
    const float* modv_layer = (const float*)(ws + WS_MODV) + (size_t)layer * 5 * 6144;
    const float* gain = P.in[7] + layer * D;
    const bf16* xs = (const bf16*)(ws + WS_R4);
    bf16* H = (bf16*)(ws + WS_R1);
    int* cnt = (int*)(ws + WS_CTL) + CTL_CNT + layer * 2048; int* list = (int*)(ws + WS_LIST); float* wts = (float*)(ws + WS_WTS);
    LAS float* part = (LAS float*)smem;
    for (int task = xcd_vid(bid, nblk); task < nrows / 16; task += nblk) {
        const int row0 = task * 16; const int row = row0 + tk;
        const int br = row0 < NL ? row0 / S : 4;
        const bf16* xr = xs + (size_t)row * D;
        const bf16* wt = (const bf16*)(ws + WS_WRT + layer * WRT_STRIDE) + (size_t)br * 2 * 32 * 1024;
        f32x4a acc0 = {0.f, 0.f, 0.f, 0.f}, acc1 = {0.f, 0.f, 0.f, 0.f};
        float ss = 0.f;
#pragma unroll 4
        for (int s = 8 * wave; s < 8 * wave + 8; ++s) {
            const int k = 32 * s + 8 * kq;
            const u32x4 xh = *(const u32x4*)(xr + k);
            { const float f0 = __uint_as_float(xh.x << 16), f1 = __uint_as_float(xh.x & 0xffff0000u), f2 = __uint_as_float(xh.y << 16), f3 = __uint_as_float(xh.y & 0xffff0000u);
              const float f4 = __uint_as_float(xh.z << 16), f5 = __uint_as_float(xh.z & 0xffff0000u), f6 = __uint_as_float(xh.w << 16), f7 = __uint_as_float(xh.w & 0xffff0000u);
              ss += (f0 * f0 + f1 * f1) + (f2 * f2 + f3 * f3) + (f4 * f4 + f5 * f5) + (f6 * f6 + f7 * f7); }
            const bf16x8 bh = __builtin_bit_cast(bf16x8, xh);
            const bf16x8 a0h = *(const bf16x8*)(wt + (size_t)tk * 1024 + k), a1h = *(const bf16x8*)(wt + (size_t)(16 + tk) * 1024 + k);
            const bf16x8 a0l = *(const bf16x8*)(wt + (size_t)(32 + tk) * 1024 + k), a1l = *(const bf16x8*)(wt + (size_t)(48 + tk) * 1024 + k);
            acc0 = __builtin_amdgcn_mfma_f32_16x16x32_bf16(a0h, bh, acc0, 0, 0, 0); acc1 = __builtin_amdgcn_mfma_f32_16x16x32_bf16(a1h, bh, acc1, 0, 0, 0);
            acc0 = __builtin_amdgcn_mfma_f32_16x16x32_bf16(a0l, bh, acc0, 0, 0, 0); acc1 = __builtin_amdgcn_mfma_f32_16x16x32_bf16(a1l, bh, acc1, 0, 0, 0);
        }
#pragma unroll
        for (int j = 0; j < 4; ++j) { part[(wave * 9 + j) * 64 + lane] = acc0[j]; part[(wave * 9 + 4 + j) * 64 + lane] = acc1[j]; }
        part[(wave * 9 + 8) * 64 + lane] = ss;
        __syncthreads();
        float tot[9];
#pragma unroll
        for (int j = 0; j < 9; ++j) tot[j] = (part[j * 64 + lane] + part[(9 + j) * 64 + lane]) + (part[(18 + j) * 64 + lane] + part[(27 + j) * 64 + lane]);
        const float rstd = rsqrtf(xq_sum(tot[8]) * (1.f / D) + EPS);
        if (wave == 0) {
            const float* sl = (const float*)(ws + WS_SL) + layer * 256 + br * 32;
            float gl[4], el[4];
#pragma unroll
            for (int j = 0; j < 4; ++j) { gl[j] = tot[j] * rstd + sl[j]; el[j] = tot[4 + j] * rstd + sl[16 + 4 * kq + j]; }
            int gi = 0; float gm = gl[0];
#pragma unroll
            for (int j = 1; j < 4; ++j) if (gl[j] > gm) { gm = gl[j]; gi = j; }
            if (gi == kq) {
                float gs = 0.f;
#pragma unroll
                for (int j = 0; j < 4; ++j) gs += expf(gl[j] - gm);
                const float gwt = 1.f / gs;
                int i0 = 0; float e0 = el[0];
#pragma unroll
                for (int j = 1; j < 4; ++j) if (el[j] > e0) { e0 = el[j]; i0 = j; }
                int i1 = -1; float e1 = -INFINITY;
#pragma unroll
                for (int j = 0; j < 4; ++j) if (j != i0 && el[j] > e1) { e1 = el[j]; i1 = j; }
                const float p1 = expf(e1 - e0); const float w0 = gwt / (1.f + p1), w1 = gwt * p1 / (1.f + p1);
                const int ea = i0 < i1 ? i0 : i1, eb = i0 < i1 ? i1 : i0;
                const int pidx = ea == 0 ? eb - 1 : (ea == 1 ? eb + 1 : 5);
                const int cls = gi * 6 + pidx;
                wts[(size_t)row * 2] = i0 < i1 ? w0 : w1; wts[(size_t)row * 2 + 1] = i0 < i1 ? w1 : w0;
                const int pos = atomicAdd(&cnt[cls * 64], 1);
                list[(size_t)cls * NT + pos] = row;
            }
        }
        const float* mv = modv_layer + (size_t)br * 6144;
        float rs[4];
#pragma unroll
        for (int r = 0; r < 4; ++r) rs[r] = __shfl(rstd, 4 * wave + r);
        u32x2 xv[4][4];
#pragma unroll
        for (int r = 0; r < 4; ++r) {
            const bf16* xp = xs + (size_t)(row0 + 4 * wave + r) * D + 4 * lane;
#pragma unroll
            for (int jq = 0; jq < 4; ++jq) xv[r][jq] = *(const u32x2*)(xp + 256 * jq);
        }
#pragma unroll
        for (int jq = 0; jq < 4; ++jq) {
            const int k = 4 * lane + 256 * jq;
            const f32x4 g = *(const f32x4*)(gain + k), sc = *(const f32x4*)(mv + 4 * 1024 + k), sh = *(const f32x4*)(mv + 3 * 1024 + k);
            const f32x4 a = {g.x * (1.f + sc.x), g.y * (1.f + sc.y), g.z * (1.f + sc.z), g.w * (1.f + sc.w)};
#pragma unroll
            for (int r = 0; r < 4; ++r) {
                const u32x2 xw = xv[r][jq]; const f32x4 x = {__uint_as_float(xw.x << 16), __uint_as_float(xw.x & 0xffff0000u), __uint_as_float(xw.y << 16), __uint_as_float(xw.y & 0xffff0000u)};
                u32x2 o = {pk2(x.x * rs[r] * a.x + sh.x, x.y * rs[r] * a.y + sh.y), pk2(x.z * rs[r] * a.z + sh.z, x.w * rs[r] * a.w + sh.w)};
                *(u32x2*)(H + (size_t)(row0 + 4 * wave + r) * D + k) = o;
            }
        }
        __syncthreads();
    }
}

__device__ __forceinline__ void moe_tiles_init(const int* cnt, LAS int* tile0) {
    __syncthreads();
    if (threadIdx.x < 24) tile0[192 + threadIdx.x] = cnt[threadIdx.x * 64];
    __syncthreads();
    if (threadIdx.x == 0) { int a = 0; for (int c = 0; c < 24; ++c) { tile0[c] = a; a += (tile0[192 + c] + 127) >> 7; } tile0[24] = a; }
    __syncthreads();
}
struct GatherRows {
    const bf16* H; const int* lst; int n; unsigned vo[4];
    __device__ __forceinline__ void init(int w, int rl, const int (&co)[4]) {
#pragma unroll
        for (int i = 0; i < 4; ++i) { const int r = 32 * w + 8 * i + rl; vo[i] = (unsigned)(((size_t)lst[r < n ? r : 0] * D + co[i]) * 2); }
    }
    __device__ __forceinline__ const bf16* sb(int i, int kt) const { return H + kt * 64; }
};
struct SplitKRows {
    const bf16* b0; const bf16* b1; size_t ld; int ksplit; int w; unsigned vo[4];
    __device__ __forceinline__ SplitKRows(const bf16* b0_, const bf16* b1_, size_t ld_, int ksplit_) : b0(b0_), b1(b1_), ld(ld_), ksplit(ksplit_), w(0) {}
    __device__ __forceinline__ void init(int w_, int rl, const int (&co)[4]) { w = w_;
#pragma unroll
        for (int i = 0; i < 4; ++i) vo[i] = (unsigned)((rl * ld + co[i]) * 2); }
    __device__ __forceinline__ const bf16* sb(int i, int kt) const { return (kt < ksplit ? b0 + kt * 64 : b1 + (kt - ksplit) * 64) + (size_t)(32 * w + 8 * i) * ld; }
};
struct EpiMoe1 {
    typedef NoPre Pre;
    __device__ __forceinline__ void prefetch(Pre&, int, int, int, int) const {}
    bf16* hid; const int* lst; int n; const float* wts; int nt;
    __device__ __forceinline__ bool swapped() const { return false; }
    __device__ __forceinline__ void operator()(f32x16 (&acc)[2][2], int fb, int tb, int l31, int hh, LAS unsigned char* wl, const Pre& pre) const {
        const int col = (nt >> 2) * 256 + 32 * (2 * (nt & 3) + (fb >> 6));
#pragma unroll 1
        for (int j = 0; j < 2; ++j) {
            const int r = tb + j * 32 + l31;
            const int tok = lst[r < n ? r : 0];
            const float w = wts[(size_t)tok * 2 + (nt >> 2)];
#pragma unroll
            for (int g = 0; g < 4; ++g) {
                float hv[4];
#pragma unroll
                for (int e = 0; e < 4; ++e) { const float a_ = j ? acc[0][1][4 * g + e] : acc[0][0][4 * g + e], u_ = j ? acc[1][1][4 * g + e] : acc[1][0][4 * g + e]; hv[e] = a_ / (1.f + __expf(-a_)) * u_ * w; }
                u32x2 v = {pk2(hv[0], hv[1]), pk2(hv[2], hv[3])}; *(LAS u32x2*)(wl + (32 * j + l31) * 80 + (8 * g + 4 * hh) * 2) = v;
            }
        }
        const int lane = l31 + 32 * hh, rr = lane >> 2, ch = lane & 3;
#pragma unroll
        for (int q = 0; q < 4; ++q) { const int R = 16 * q + rr; const u32x4 v = *(LAS u32x4*)(wl + R * 80 + ch * 16); *(u32x4*)(hid + (size_t)(tb + R) * 512 + col + ch * 8) = v; }
    }
};
__device__ __forceinline__ void ph_moe_stage1(const Ptrs& P, LAS unsigned char* smem, int bid, int nblk, int layer) {
    unsigned char* ws = P.ws;
    const int* cnt = (const int*)(ws + WS_CTL) + CTL_CNT + layer * 2048; const int* list = (const int*)(ws + WS_LIST);
    LAS int* tile0 = (LAS int*)(smem + GEMM_LDS);
    moe_tiles_init(cnt, tile0);
    const int lrow = threadIdx.x >> 3, kc = threadIdx.x & 7;
    const bf16* H = (const bf16*)(ws + WS_R1);
    const int nitems = tile0[24] * 8;
    for (int item = xcd_vid(bid, nblk); item < nitems; item += nblk) {
        const int tt = item >> 3, nt = item & 7;
        int c = 0; while (tile0[c + 1] <= tt) ++c;
        const int lt = tt - tile0[c], n = min(128, tile0[192 + c] - lt * 128);
        const int* lst = list + (size_t)c * NT + lt * 128;
        const int g = c / 6, pidx = c % 6; const int ea = pidx < 3 ? 0 : (pidx < 5 ? 1 : 2), eb = pidx < 3 ? pidx + 1 : (pidx < 5 ? pidx - 1 : 3);
        const int expert = g * 4 + (nt < 4 ? ea : eb);
        GatherRows af{H, lst, n, {0u, 0u, 0u, 0u}};
        AffineRows bf_((const bf16*)(ws + WS_WGU) + ((size_t)(layer * 16 + expert) * 512 + (nt & 3) * 128) * D, D);
        EpiMoe1 epi{(bf16*)(ws + WS_R3) + (size_t)tt * 128 * 512, lst, n, (const float*)(ws + WS_WTS), nt};
        gemm_tile<false>(af, bf_, D / 64, smem, epi);
    }
}
template <int LAYER>
struct EpiMoe2 {
    typedef RmwPre<true> Pre;
    bf16* xs; float* out; float* rss; const float* modv_layer; LAS const int* lst; int n; int nt;
    __device__ __forceinline__ bool swapped() const { return false; }
    __device__ __forceinline__ auto rowfn(int fb, int tb) const {
        const int c0 = nt * 128 + fb; const EpiMoe2 e = *this;
        return [=](int R, const void*& sp, void*& dp, const float*& gp, int& tk) {
            const int r = tb + R; if (r >= e.n) return false;
            const int tok = e.lst[r]; tk = tok;
            sp = e.xs + (size_t)tok * D + c0;
            if (LAYER == 0) dp = e.xs + (size_t)tok * D + c0; else dp = e.out + (size_t)tok * D + c0;
            gp = e.modv_layer + (size_t)(tok < NL ? tok / S : 4) * 6144 + 5 * 1024 + c0; return true; };
    }
    __device__ __forceinline__ void prefetch(Pre& pre, int fb, int tb, int l31, int hh) const { rmw_prefetch<true>(pre, rowfn(fb, tb), l31, hh); }
    __device__ __forceinline__ void operator()(f32x16 (&acc)[2][2], int fb, int tb, int l31, int hh, LAS unsigned char* wl, const Pre& pre) const {
        rmw_finish<true, LAYER == 0, LAYER == 0>(acc, pre, rowfn(fb, tb), l31, hh, wl, rss);
    }
};
__device__ __forceinline__ void ph_moe_stage2(const Ptrs& P, LAS unsigned char* smem, int bid, int nblk, int layer) {
    unsigned char* ws = P.ws;
    const int* cnt = (const int*)(ws + WS_CTL) + CTL_CNT + layer * 2048; const int* list = (const int*)(ws + WS_LIST);
    LAS int* tile0 = (LAS int*)(smem + GEMM_LDS);
    moe_tiles_init(cnt, tile0);
    const int lrow = threadIdx.x >> 3, kc = threadIdx.x & 7;
    const int nitems = tile0[24] * 8;
    for (int item = xcd_vid(bid, nblk); item < nitems; item += nblk) {
        const int tt = item >> 3, nt = item & 7;
        int c = 0; while (tile0[c + 1] <= tt) ++c;
        const int lt = tt - tile0[c], n = min(128, tile0[192 + c] - lt * 128);
        const int* lst = list + (size_t)c * NT + lt * 128;
        const int g = c / 6, pidx = c % 6; const int ea = pidx < 3 ? 0 : (pidx < 5 ? 1 : 2), eb = pidx < 3 ? pidx + 1 : (pidx < 5 ? pidx - 1 : 3);
        AffineRows af((const bf16*)(ws + WS_R3) + (size_t)tt * 128 * 512, 512);
        const bf16* wd = (const bf16*)(ws + WS_WD);
        SplitKRows bf_(wd + ((size_t)(layer * 16 + g * 4 + ea) * 1024 + nt * 128) * 256, wd + ((size_t)(layer * 16 + g * 4 + eb) * 1024 + nt * 128) * 256, 256, 4);
        LAS int* toks = (LAS int*)(smem + GEMM_LDS + 256);
        __syncthreads();
        if (threadIdx.x < 128) toks[threadIdx.x] = lst[threadIdx.x < n ? threadIdx.x : 0];
        if (layer == 0) { EpiMoe2<0> epi{(bf16*)(ws + WS_R4), P.out, (float*)(ws + WS_RSS), (const float*)(ws + WS_MODV), toks, n, nt}; gemm_tile<false>(af, bf_, 8, smem, epi); }
        else { EpiMoe2<1> epi{(bf16*)(ws + WS_R4), P.out, nullptr, (const float*)(ws + WS_MODV) + (size_t)5 * 6144, toks, n, nt}; gemm_tile<false>(af, bf_, 8, smem, epi); }
    }
}

constexpr size_t GLA_ST = 8192;
constexpr size_t WS_DEC = WS_WTS + (size_t)NT * 2 * 4;
static_assert(WS_DEC + (size_t)32 * 68 * 64 * 4 <= 256 * MiB, "ws dec");
__device__ __forceinline__ void gla_chunk_geom(int b, int M, size_t& row0, int& vcol0, int& c0, int& c1) {
    if (M < 4) { row0 = (size_t)NL + b * CL + 64 * M; vcol0 = S + 64 * M; c0 = M; c1 = 3 - M; }
    else { const int Ml = M - 4; row0 = (size_t)b * S + 64 * Ml; vcol0 = 64 * Ml; c0 = 4 + Ml; c1 = 4 + 63 - Ml; }
}
template <bool PASS_C>
__device__ __forceinline__ float gla_prep(const float (&gw)[16], float gb, int dir, LAS unsigned char* out, LAS const unsigned char* qraw, LAS const unsigned char* kraw, LAS const float* lrs, LAS float* tot) {
    const int tid = threadIdx.x, k = tid & 63, grp = tid >> 6;
    float gl[16];
#pragma unroll
    for (int j = 0; j < 16; ++j) {
        const int p = 16 * grp + j; float z = gb;
#pragma unroll
        for (int r4 = 0; r4 < 4; ++r4) { const f32x4 l4 = *(LAS const f32x4*)(lrs + p * 16 + r4 * 4); z += l4.x * gw[4 * r4] + l4.y * gw[4 * r4 + 1] + l4.z * gw[4 * r4 + 2] + l4.w * gw[4 * r4 + 3]; }
        gl[j] = (fminf(z, 0.f) - __logf(1.f + __expf(-fabsf(z)))) * (1.f / 16.f);
    }
    if (dir == 0) {
#pragma unroll
        for (int j = 1; j < 16; ++j) gl[j] += gl[j - 1];
        tot[grp * 64 + k] = gl[15];
    } else {
#pragma unroll
        for (int j = 14; j >= 0; --j) gl[j] += gl[j + 1];
        tot[grp * 64 + k] = gl[0];
    }
    __syncthreads();
    const float t0 = tot[k], t1 = tot[64 + k], t2 = tot[128 + k], t3 = tot[192 + k];
    const float bend = t0 + t1 + t2 + t3;
    float offs;
    if (dir == 0) offs = grp == 0 ? 0.f : grp == 1 ? t0 : grp == 2 ? t0 + t1 : t0 + t1 + t2;
    else offs = grp == 3 ? 0.f : grp == 2 ? t3 : grp == 1 ? t3 + t2 : t3 + t2 + t1;
    if (PASS_C) {
#pragma unroll
        for (int j = 0; j < 16; ++j) {
            const int p = 16 * grp + j; const float bp = gl[j] + offs;
            const float q = bf2f(*(LAS const bf16*)(qraw + p * 128 + k * 2)) * 0.125f, kk = bf2f(*(LAS const bf16*)(kraw + p * 128 + k * 2));
            *(LAS bf16*)(out + p * 144 + k * 2) = f2bf(q * __expf(bp));
            *(LAS bf16*)(out + 9216 + p * 144 + k * 2) = f2bf(q * __expf(bp - bend));
            *(LAS bf16*)(out + 18432 + p * 144 + k * 2) = f2bf(kk * __expf(bend - bp));
        }
    } else {
        float kt[16];
#pragma unroll
        for (int j = 0; j < 16; ++j) { const int p = 16 * grp + j; const float bp = gl[j] + offs; kt[j] = bf2f(*(LAS const bf16*)(kraw + p * 128 + k * 2)) * __expf(bend - bp); }
        u32x4 w0 = {pk2(kt[0], kt[1]), pk2(kt[2], kt[3]), pk2(kt[4], kt[5]), pk2(kt[6], kt[7])}, w1 = {pk2(kt[8], kt[9]), pk2(kt[10], kt[11]), pk2(kt[12], kt[13]), pk2(kt[14], kt[15])};
        *(LAS u32x4*)(out + k * 144 + grp * 32) = w0; *(LAS u32x4*)(out + k * 144 + grp * 32 + 16) = w1;
    }
    return __expf(bend);
}
#define GLA_LOAD_GW(gw, gb, dir, h) do { _Pragma("unroll") for (int r_ = 0; r_ < 16; ++r_) gw[r_] = P.in[10][((dir) * 16 + r_) * 256 + (h) * 64 + (threadIdx.x & 63)]; gb = P.in[11][(dir) * 256 + (h) * 64 + (threadIdx.x & 63)]; } while (0)

constexpr int GA_KTT = 0, GA_VT = 9216, GA_KRAW = GA_VT + 128 * 144, GA_LRS = GA_KRAW + 8192, GA_TOT = GA_LRS + 4096, GLA_A_LDS = GA_TOT + 1024;
__device__ __forceinline__ void gla_pass_a_item(const Ptrs& P, int item, LAS unsigned char* lds) {
    const int tid = threadIdx.x, lane = tid & 63, wave = tid >> 6, l31 = lane & 31, hh = lane >> 5;
    const int M = item % 68, dir = (item / 68) & 1, h = (item / 136) & 3, b = item / 544;
    size_t row0; int vcol0, c0, c1; gla_chunk_geom(b, M, row0, vcol0, c0, c1);
    const int sidx = ((b * 4 + h) * 2 + dir) * 68 + (dir ? c1 : c0);
    const unsigned char* r3 = P.ws + WS_R3;
    u32x4 vt[4], kr[2]; f32x4 lr; float gw[16], gb;
    { const bf16* gvt = (const bf16*)(r3 + R3_GV) + (size_t)(b * 4 + h) * 128 * VT_LD + vcol0;
#pragma unroll
      for (int i = 0; i < 4; ++i) { const int c = tid + 256 * i; vt[i] = *(const u32x4*)(gvt + (size_t)(c >> 3) * VT_LD + (c & 7) * 8); }
      const bf16* gk = (const bf16*)(r3 + R3_GK) + row0 * 256 + h * 64;
#pragma unroll
      for (int i = 0; i < 2; ++i) { const int c = tid + 256 * i; kr[i] = *(const u32x4*)(gk + (size_t)(c >> 3) * 256 + (c & 7) * 8); }
      lr = *(const f32x4*)((const float*)(r3 + R3_LR) + (row0 + (tid >> 2)) * 32 + dir * 16 + (tid & 3) * 4);
      GLA_LOAD_GW(gw, gb, dir, h); }
#pragma unroll
    for (int i = 0; i < 4; ++i) { const int c = tid + 256 * i; *(LAS u32x4*)(lds + GA_VT + (c >> 3) * 144 + (c & 7) * 16) = vt[i]; }
#pragma unroll
    for (int i = 0; i < 2; ++i) { const int c = tid + 256 * i; *(LAS u32x4*)(lds + GA_KRAW + (c >> 3) * 128 + (c & 7) * 16) = kr[i]; }
    *(LAS f32x4*)(lds + GA_LRS + tid * 16) = lr;
    __syncthreads();
    const float dec = gla_prep<false>(gw, gb, dir, lds + GA_KTT, lds + GA_KRAW, lds + GA_KRAW, (LAS const float*)(lds + GA_LRS), (LAS float*)(lds + GA_TOT));
    if (tid < 64) ((float*)(P.ws + WS_DEC))[(size_t)sidx * 64 + tid] = dec;
    __syncthreads();
    f32x16 acc[2];
#pragma unroll
    for (int kt = 0; kt < 2; ++kt)
#pragma unroll
        for (int r = 0; r < 16; ++r) acc[kt][r] = 0.f;
#pragma unroll
    for (int ps = 0; ps < 4; ++ps) {
        const bf16x8 vf = *(LAS bf16x8*)(lds + GA_VT + (32 * wave + l31) * 144 + ps * 32 + hh * 16);
#pragma unroll
        for (int kt = 0; kt < 2; ++kt) { const bf16x8 kf = *(LAS bf16x8*)(lds + GA_KTT + (32 * kt + l31) * 144 + ps * 32 + hh * 16); acc[kt] = __builtin_amdgcn_mfma_f32_32x32x16_bf16(kf, vf, acc[kt], 0, 0, 0); }
    }
    bf16* ds = (bf16*)(P.ws + WS_R1) + (size_t)sidx * GLA_ST + (size_t)(32 * wave + l31) * 64 + 4 * hh;
#pragma unroll
    for (int kt = 0; kt < 2; ++kt)
#pragma unroll
        for (int g = 0; g < 4; ++g) { u32x2 v = {pk2(acc[kt][4 * g], acc[kt][4 * g + 1]), pk2(acc[kt][4 * g + 2], acc[kt][4 * g + 3])}; *(u32x2*)(ds + kt * 32 + 8 * g) = v; }
    __syncthreads();
}
__device__ __forceinline__ void ph_gla_a(const Ptrs& P, LAS unsigned char* smem, int bid, int nblk) {
    for (int item = bid; item < 4 * 4 * 2 * 68; item += nblk) gla_pass_a_item(P, item, smem);
}
__device__ __forceinline__ void gla_pass_b(const Ptrs& P, int gtid, int nthreads) {
    const bf16* DS = (const bf16*)(P.ws + WS_R1); bf16* SIN = (bf16*)(P.ws + WS_R4); const float* DEC = (const float*)(P.ws + WS_DEC);
    for (int idx = gtid; idx < 32 * 2048; idx += nthreads) {
        const int bhd = idx >> 11, e4 = idx & 2047, k4 = (e4 & 15) * 4;
        float s0 = 0.f, s1 = 0.f, s2 = 0.f, s3 = 0.f;
#pragma unroll 17
        for (int c = 0; c < 68; ++c) {
            const size_t sidx = (size_t)bhd * 68 + c;
            u32x2 o = {pk2(s0, s1), pk2(s2, s3)};
            *(u32x2*)(SIN + sidx * GLA_ST + e4 * 4) = o;
            const f32x4 d = *(const f32x4*)(DEC + sidx * 64 + k4);
            const u32x2 w = *(const u32x2*)(DS + sidx * GLA_ST + e4 * 4);
            s0 = s0 * d.x + __uint_as_float(w.x << 16); s1 = s1 * d.y + __uint_as_float(w.x & 0xffff0000u);
            s2 = s2 * d.z + __uint_as_float(w.y << 16); s3 = s3 * d.w + __uint_as_float(w.y & 0xffff0000u);
        }
    }
}

constexpr int GC_QT = 0, GC_QA = 9216, GC_KT = 18432, GC_VT = 27648, GC_QRAW = GC_VT + 128 * 136, GC_KRAW = GC_QRAW + 8192, GC_LRS = GC_KRAW + 8192, GC_TOT = GEMM_LDS + 256, GC_XCH = GC_TOT + 1024;
static_assert(GC_LRS + 4096 <= GEMM_LDS, "gla c lds");
__device__ __forceinline__ void gla_pass_c_item(const Ptrs& P, int item, LAS unsigned char* lds) {
    const int tid = threadIdx.x, lane = tid & 63, wave = tid >> 6, l31 = lane & 31, hh = lane >> 5, pt = wave & 1, vh = wave >> 1;
    const int M = item % 68, h = (item / 68) & 3, b = item / 272;
    size_t row0; int vcol0, c0, c1; gla_chunk_geom(b, M, row0, vcol0, c0, c1);
    const unsigned char* r3 = P.ws + WS_R3;
    u32x4 vt[4], qr[2], kr[2]; f32x4 lr0, lr1; float gw[16], gb;
    { const bf16* gvt = (const bf16*)(r3 + R3_GV) + (size_t)(b * 4 + h) * 128 * VT_LD + vcol0;
#pragma unroll
      for (int i = 0; i < 4; ++i) { const int c = tid + 256 * i; vt[i] = *(const u32x4*)(gvt + (size_t)(c >> 3) * VT_LD + (c & 7) * 8); }
      const bf16* gq = (const bf16*)(r3 + R3_GQ) + row0 * 256 + h * 64; const bf16* gk = (const bf16*)(r3 + R3_GK) + row0 * 256 + h * 64;
#pragma unroll
      for (int i = 0; i < 2; ++i) { const int c = tid + 256 * i; qr[i] = *(const u32x4*)(gq + (size_t)(c >> 3) * 256 + (c & 7) * 8); kr[i] = *(const u32x4*)(gk + (size_t)(c >> 3) * 256 + (c & 7) * 8); }
      const float* lrp = (const float*)(r3 + R3_LR) + (row0 + (tid >> 2)) * 32 + (tid & 3) * 4;
      lr0 = *(const f32x4*)lrp; lr1 = *(const f32x4*)(lrp + 16);
      GLA_LOAD_GW(gw, gb, 0, h); }
#pragma unroll
    for (int i = 0; i < 4; ++i) { const int c = tid + 256 * i; LAS unsigned char* vp = lds + GC_VT + (c >> 3) * 136 + (c & 7) * 16; u32x2 lo = {vt[i].x, vt[i].y}, hi = {vt[i].z, vt[i].w}; *(LAS u32x2*)vp = lo; *(LAS u32x2*)(vp + 8) = hi; }
#pragma unroll
    for (int i = 0; i < 2; ++i) { const int c = tid + 256 * i; *(LAS u32x4*)(lds + GC_QRAW + (c >> 3) * 128 + (c & 7) * 16) = qr[i]; *(LAS u32x4*)(lds + GC_KRAW + (c >> 3) * 128 + (c & 7) * 16) = kr[i]; }
    *(LAS f32x4*)(lds + GC_LRS + tid * 16) = lr0;
    f32x16 o[2];
#pragma unroll
    for (int i = 0; i < 2; ++i)
#pragma unroll
        for (int r = 0; r < 16; ++r) o[i][r] = 0.f;
    const bf16* SIN = (const bf16*)(P.ws + WS_R4);
    __syncthreads();
#pragma unroll 1
    for (int dir = 0; dir < 2; ++dir) {
        const int sidx = ((b * 4 + h) * 2 + dir) * 68 + (dir ? c1 : c0);
        (void)gla_prep<true>(gw, gb, dir, lds + GC_QT, lds + GC_QRAW, lds + GC_KRAW, (LAS const float*)(lds + GC_LRS), (LAS float*)(lds + GC_TOT));
        bf16x8 sf[2][4];
#pragma unroll
        for (int i = 0; i < 2; ++i)
#pragma unroll
            for (int ks = 0; ks < 4; ++ks) sf[i][ks] = *(const bf16x8*)(SIN + (size_t)sidx * GLA_ST + (size_t)(64 * vh + 32 * i + l31) * 64 + 16 * ks + 8 * hh);
        if (dir == 0) { *(LAS f32x4*)(lds + GC_LRS + tid * 16) = lr1; GLA_LOAD_GW(gw, gb, 1, h); }
        __syncthreads();
        f32x16 at[2];
#pragma unroll
        for (int st = 0; st < 2; ++st) {
#pragma unroll
            for (int r = 0; r < 16; ++r) at[st][r] = 0.f;
#pragma unroll
            for (int ks = 0; ks < 4; ++ks) {
                const bf16x8 ka = *(LAS bf16x8*)(lds + GC_KT + (32 * st + l31) * 144 + ks * 32 + hh * 16);
                const bf16x8 qa = *(LAS bf16x8*)(lds + GC_QA + (32 * pt + l31) * 144 + ks * 32 + hh * 16);
                at[st] = __builtin_amdgcn_mfma_f32_32x32x16_bf16(ka, qa, at[st], 0, 0, 0);
            }
            const int pq = 32 * pt + l31;
#pragma unroll
            for (int r = 0; r < 16; ++r) { const int s_ = 32 * st + (r & 3) + 8 * (r >> 2) + 4 * hh; const bool ok = dir ? (s_ >= pq) : (s_ <= pq); if (!ok) at[st][r] = 0.f; }
        }
#pragma unroll
        for (int ks = 0; ks < 4; ++ks) {
            const bf16x8 qt = *(LAS bf16x8*)(lds + GC_QT + (32 * pt + l31) * 144 + ks * 32 + hh * 16);
#pragma unroll
            for (int i = 0; i < 2; ++i) o[i] = __builtin_amdgcn_mfma_f32_32x32x16_bf16(sf[i][ks], qt, o[i], 0, 0, 0);
        }
#pragma unroll
        for (int st = 0; st < 2; ++st)
#pragma unroll
            for (int s2 = 0; s2 < 2; ++s2) {
                u32x4 pw = {pk2(at[st][8 * s2], at[st][8 * s2 + 1]), pk2(at[st][8 * s2 + 2], at[st][8 * s2 + 3]), pk2(at[st][8 * s2 + 4], at[st][8 * s2 + 5]), pk2(at[st][8 * s2 + 6], at[st][8 * s2 + 7])};
                const bf16x8 pf = __builtin_bit_cast(bf16x8, pw);
#pragma unroll
                for (int i = 0; i < 2; ++i) {
                    LAS unsigned char* vp = lds + GC_VT + (64 * vh + 32 * i + l31) * 136 + (32 * st + 16 * s2 + 4 * hh) * 2;
                    const u32x2 v0 = *(LAS u32x2*)vp, v1 = *(LAS u32x2*)(vp + 16);
                    u32x4 vw = {v0.x, v0.y, v1.x, v1.y};
                    o[i] = __builtin_amdgcn_mfma_f32_32x32x16_bf16(__builtin_bit_cast(bf16x8, vw), pf, o[i], 0, 0, 0);
                }
            }
        __syncthreads();
    }
    float ss = 0.f;
#pragma unroll
    for (int i = 0; i < 2; ++i)
#pragma unroll
        for (int r = 0; r < 16; ++r) ss += o[i][r] * o[i][r];
    ss = xhalf_sum(ss);
    LAS float* xch = (LAS float*)(lds + GC_XCH);
    if (hh == 0) xch[(pt * 2 + vh) * 32 + l31] = ss;
    __syncthreads();
    ss += xch[(pt * 2 + (1 - vh)) * 32 + l31];
    const float rstd = rsqrtf(ss * (1.f / 128.f) + EPS);
    const size_t trow = row0 + 32 * pt + l31;
    const bf16* gr = (const bf16*)(P.ws + WS_R3 + R3_GR) + trow * 512 + h * 128 + 64 * vh + 4 * hh;
    bf16* mx = (bf16*)(P.ws + WS_R2) + trow * 1024 + h * 128 + 64 * vh + 4 * hh;
    const float* gn = P.in[12] + 64 * vh + 4 * hh;
#pragma unroll
    for (int i = 0; i < 2; ++i)
#pragma unroll
        for (int g = 0; g < 4; ++g) {
            const u32x2 rw = *(const u32x2*)(gr + i * 32 + 8 * g); const f32x4 gg = *(const f32x4*)(gn + i * 32 + 8 * g);
            const float r0 = __uint_as_float(rw.x << 16), r1 = __uint_as_float(rw.x & 0xffff0000u), r2 = __uint_as_float(rw.y << 16), r3_ = __uint_as_float(rw.y & 0xffff0000u);
            const float y0 = o[i][4 * g] * rstd * gg.x * (r0 / (1.f + __expf(-r0))), y1 = o[i][4 * g + 1] * rstd * gg.y * (r1 / (1.f + __expf(-r1)));
            const float y2 = o[i][4 * g + 2] * rstd * gg.z * (r2 / (1.f + __expf(-r2))), y3 = o[i][4 * g + 3] * rstd * gg.w * (r3_ / (1.f + __expf(-r3_)));
            u32x2 v = {pk2(y0, y1), pk2(y2, y3)}; *(u32x2*)(mx + i * 32 + 8 * g) = v;
        }
    __syncthreads();
}
__device__ __forceinline__ void ph_gla_c(const Ptrs& P, LAS unsigned char* smem, int bid, int nblk) {
    for (int item = bid; item < 4 * 4 * 68; item += nblk) gla_pass_c_item(P, item, smem);
}

#define XB_TMO      128
#define XB_XCNT(j)  (256  + 64 * (j))
#define XB_XSUB(j)  (1280 + 64 * (j))
#define XB_XGEN(j)  (2304 + 64 * (j))
#define XB_TOP      3328
#define XB_TOPGEN   3392
#define XB_SPIN_CAP (1u << 20)
constexpr int CTL_BAR = 4096;
__device__ __forceinline__ unsigned xb_ld(unsigned* p) { return __hip_atomic_load(p, __ATOMIC_RELAXED, __HIP_MEMORY_SCOPE_AGENT); }
__device__ __forceinline__ unsigned xb_add(unsigned* p, unsigned v) { return __hip_atomic_fetch_add(p, v, __ATOMIC_RELAXED, __HIP_MEMORY_SCOPE_AGENT); }
__device__ __forceinline__ unsigned xb_xcc_id() { return (unsigned)__builtin_amdgcn_s_getreg((3 << 11) | 20) & 0xFu; }
#define XB_SPIN(cond, bar) do { unsigned _sp = 0; while (cond) { __builtin_amdgcn_s_sleep(1); \
    if ((++_sp & 255u) == 0u) { if (xb_ld(&(bar)[XB_TMO])) break; if (_sp > XB_SPIN_CAP) { atomicAdd(&(bar)[XB_TMO], 1u); break; } } } } while (0)
struct XcdBarrier { unsigned* bar; unsigned x; volatile LAS unsigned* st; };
__device__ __forceinline__ XcdBarrier xcd_barrier_post(unsigned* bar, volatile LAS unsigned* st) {
    XcdBarrier b; b.bar = bar; b.x = xb_xcc_id(); b.st = st;
    if (threadIdx.x == 0) (void)xb_add(&bar[XB_XCNT(b.x)], 1u);
    return b;
}
__device__ __forceinline__ void xcd_barrier_complete(unsigned* bar, unsigned x, unsigned& nloc, unsigned& nx) {
    const unsigned G = gridDim.x * gridDim.y * gridDim.z;
    unsigned sum, cnt, mine, sp = 0u;
    for (;;) {
        sum = 0u; cnt = 0u; mine = 0u;
#pragma unroll
        for (unsigned j = 0; j < 16; ++j) { const unsigned c = xb_ld(&bar[XB_XCNT(j)]); sum += c; cnt += (c > 0u) ? 1u : 0u; mine = (j == x) ? c : mine; }
        if (sum == G) break;
        __builtin_amdgcn_s_sleep(1);
        if ((++sp & 255u) == 0u) { if (xb_ld(&bar[XB_TMO])) break; if (sp > XB_SPIN_CAP) { atomicAdd(&bar[XB_TMO], 1u); break; } }
    }
    nloc = mine > 0u ? mine : 1u; nx = cnt > 0u ? cnt : 1u;
}
__device__ __forceinline__ void xcd_barrier(const XcdBarrier& b) {
    asm volatile("s_waitcnt vmcnt(0)" ::: "memory");
    __syncthreads();
    if (threadIdx.x == 0) {
        unsigned* bar = b.bar;
        __builtin_amdgcn_s_waitcnt(0);
        unsigned nloc = b.st[0], nx = b.st[1];
        if (nloc == 0u) { xcd_barrier_complete(bar, b.x, nloc, nx); b.st[0] = nloc; b.st[1] = nx; }
        const unsigned old = xb_add(&bar[XB_XSUB(b.x)], 1u);
        const unsigned gen = old / nloc;
        if (old + 1u == (gen + 1u) * nloc) {
            __builtin_amdgcn_fence(__ATOMIC_RELEASE, "agent");
            asm volatile("s_waitcnt vmcnt(0)" ::: "memory");
            const unsigned og = xb_add(&bar[XB_TOP], 1u);
            const unsigned tg = og / nx;
            if (og + 1u == (tg + 1u) * nx) xb_add(&bar[XB_TOPGEN], 1u);
            else XB_SPIN(xb_ld(&bar[XB_TOPGEN]) == tg, bar);
            __builtin_amdgcn_fence(__ATOMIC_ACQUIRE, "agent");
            xb_add(&bar[XB_XGEN(b.x)], 1u);
            asm volatile("s_waitcnt vmcnt(0)" ::: "memory");
        } else {
            XB_SPIN(xb_ld(&bar[XB_XGEN(b.x)]) == gen, bar);
            __builtin_amdgcn_fence(__ATOMIC_ACQUIRE, "agent");
            asm volatile("s_waitcnt vmcnt(0)" ::: "memory");
        }
    }
    __syncthreads();
}

constexpr int N_PHASES = 18;
constexpr int SMEM_BYTES = GEMM_LDS + 2048;
struct Args { Ptrs P; int ph_lo, ph_hi; };
__global__ void __launch_bounds__(256, 2) fwd_megakernel(Args args) {
    __shared__ __attribute__((aligned(16))) unsigned char smem_raw[SMEM_BYTES];
    LAS unsigned char* smem = (LAS unsigned char*)smem_raw;
    const Ptrs& P = args.P;
    const int bid = blockIdx.x, nblk = gridDim.x;
    volatile LAS unsigned* bst = (volatile LAS unsigned*)(smem + GEMM_LDS + 128);
    if (threadIdx.x < 2) bst[threadIdx.x] = 0u;
    __syncthreads();
    XcdBarrier bar; bar.bar = (unsigned*)(P.ws + WS_CTL) + CTL_BAR; bar.x = 0; bar.st = bst;
    const bool multi = args.ph_hi - args.ph_lo > 1;
    if (multi) bar = xcd_barrier_post((unsigned*)(P.ws + WS_CTL) + CTL_BAR, bst);
    const int lo = args.ph_lo, hi = args.ph_hi;
#define PHASE(k, call) if (lo <= (k) && (k) < hi) { if ((k) > lo) xcd_barrier(bar); call; }
    PHASE(0, ph_prologue(P, smem, bid, nblk))
    PHASE(1, ph_modulate(P, 0, bid, nblk))
    PHASE(2, ph_even_inproj(P, smem, bid, nblk))
    PHASE(3, ph_gla_a(P, smem, bid, nblk))
    PHASE(4, gla_pass_b(P, bid * 256 + threadIdx.x, nblk * 256))
    PHASE(5, (ph_dense_attn(P, smem, bid, nblk), __syncthreads(), ph_gla_c(P, smem, (bid + nblk - 128) % nblk, nblk)))
    PHASE(7, ph_outproj(P, smem, bid, nblk, 0, NT))
    PHASE(8, (ph_moe_route(P, smem, bid, nblk, 0, NT), fold_odd_inproj(P, bid, nblk), route_tables(P, 1, bid, nblk)))
    PHASE(9, ph_moe_stage1(P, smem, bid, nblk, 0))
    PHASE(10, ph_moe_stage2(P, smem, bid, nblk, 0))
    PHASE(12, ph_odd_inproj(P, smem, bid, nblk))
    PHASE(13, ph_swa_attn(P, smem, bid, nblk))
    PHASE(14, ph_outproj(P, smem, bid, nblk, 1, NL))
    PHASE(15, ph_moe_route(P, smem, bid, nblk, 1, NL))
    PHASE(16, ph_moe_stage1(P, smem, bid, nblk, 1))
    PHASE(17, ph_moe_stage2(P, smem, bid, nblk, 1))
#undef PHASE
}

#ifndef MK_LAUNCHES
#define MK_LAUNCHES 1
#endif
extern "C" void kernel_launch(void* const* d_in, const int* in_sizes, int n_in, void* d_out, int out_size, void* d_ws, size_t ws_size, hipStream_t stream) {
    static int grid = 0;
    if (grid == 0) {
        int dev = 0, cus = 0, per_cu = 0;
        hipGetDevice(&dev);
        hipDeviceGetAttribute(&cus, hipDeviceAttributeMultiprocessorCount, dev);
        hipOccupancyMaxActiveBlocksPerMultiprocessor(&per_cu, (const void*)fwd_megakernel, 256, 0);
        if (per_cu > 2) per_cu = 2;
        if (per_cu < 1) per_cu = 1;
        grid = cus * per_cu;
    }
    hipMemsetAsync((unsigned char*)d_ws + WS_CTL, 0, 65536, stream);
    Args a{};
    for (int i = 0; i < 27; ++i) a.P.in[i] = (const float*)d_in[i];
    a.P.out = (float*)d_out; a.P.ws = (unsigned char*)d_ws;
#if MK_LAUNCHES == 1
    a.ph_lo = 0; a.ph_hi = N_PHASES;
    void* kargs[] = {&a};
    hipLaunchCooperativeKernel((const void*)fwd_megakernel, dim3(grid), dim3(256), kargs, 0, stream);
#else
    for (int ph = 0; ph < N_PHASES; ++ph) { a.ph_lo = ph; a.ph_hi = ph + 1; hipLaunchKernelGGL(fwd_megakernel, dim3(grid), dim3(256), 0, stream, a); }
#endif
}
```

```cpp
#include <hip/hip_runtime.h>
#include <stdint.h>

typedef unsigned short bf16;
__device__ __forceinline__ float bf2f(bf16 v) { return __uint_as_float(((unsigned)v) << 16); }
__device__ __forceinline__ bf16 f2bf(float f) { unsigned u = __float_as_uint(f); return (bf16)((u + 0x7fffu + ((u >> 16) & 1u)) >> 16); }

constexpr int D = 1024, NB = 4, S = 4096, CL = 256, NL = NB * S, NC = NB * CL, NT = NL + NC;
constexpr int EVEN_IN = 2336, ODD_IN = 1280;
constexpr float EPS = 1e-6f;

__device__ __forceinline__ float silu(float x) { return x / (1.f + expf(-x)); }
__device__ __forceinline__ float wave_sum(float v) {
#pragma unroll
    for (int o = 1; o < 64; o <<= 1) v += __shfl_xor(v, o);
    return v;
}

#define LAS __attribute__((address_space(3)))
typedef short bf16x8 __attribute__((ext_vector_type(8)));
typedef float f32x16 __attribute__((ext_vector_type(16)));
typedef float f32x4 __attribute__((ext_vector_type(4)));
typedef unsigned u32x4 __attribute__((ext_vector_type(4)));
typedef unsigned u32x2 __attribute__((ext_vector_type(2)));
typedef __bf16 bf16x2_t __attribute__((ext_vector_type(2)));
typedef float f32x2_t __attribute__((ext_vector_type(2)));
__device__ __forceinline__ unsigned pk2(float lo, float hi) { f32x2_t v = {lo, hi}; bf16x2_t b = __builtin_convertvector(v, bf16x2_t); return __builtin_bit_cast(unsigned, b); }
__device__ __forceinline__ float xhalf_sum(float x) {
    auto t = __builtin_amdgcn_permlane32_swap(__float_as_uint(x), __float_as_uint(x), false, false);
    return __uint_as_float(t[0]) + __uint_as_float(t[1]);
}

constexpr float QSCALE = 0.125f * 1.4426950408889634f;
constexpr int NPAD_E = 2432;
constexpr int TILE_LDS = 128 * 128;
constexpr int GEMM_LDS = 4 * TILE_LDS;

__device__ __forceinline__ void transpose_item(const float* W, int K, int N, bf16* WT, int dst_row0, int k0, int n0, LAS float* scr, int lane) {
    float tv[32];
#pragma unroll
    for (int i = 0; i < 32; ++i) tv[i] = W[(size_t)(k0 + 2 * i + (lane >> 5)) * N + n0 + (lane & 31)];
#pragma unroll
    for (int i = 0; i < 32; ++i) scr[(2 * i + (lane >> 5)) * 33 + (lane & 31)] = tv[i];
    asm volatile("s_waitcnt lgkmcnt(0)" ::: "memory");
    const int c = lane & 7;
#pragma unroll
    for (int j = 0; j < 4; ++j) {
        const int n = (lane >> 3) + 8 * j; const LAS float* s = scr + (8 * c) * 33 + n;
        u32x4 o; o.x = pk2(s[0 * 33], s[1 * 33]); o.y = pk2(s[2 * 33], s[3 * 33]); o.z = pk2(s[4 * 33], s[5 * 33]); o.w = pk2(s[6 * 33], s[7 * 33]);
        *(u32x4*)(WT + (size_t)(dst_row0 + n) * K + k0 + 8 * c) = o;
    }
    asm volatile("s_waitcnt lgkmcnt(0)" ::: "memory");
}

struct Ptrs {
    const float* in[27];
    float* out;
    unsigned char* ws;
};

constexpr size_t MiB = 1u << 20;
constexpr size_t WS_CTL = 0;
constexpr size_t WS_MODV = 1 * MiB;
constexpr size_t WS_ROPE = WS_MODV + 256 * 1024;
constexpr size_t WS_WINE = 2 * MiB;
constexpr size_t WS_WOUTE = WS_WINE + (size_t)NPAD_E * 1024 * 2;
constexpr size_t WS_WINO = WS_WOUTE + 2 * MiB;
constexpr size_t WS_WOUTO = WS_WINO + (size_t)1280 * 1024 * 2;
constexpr size_t WS_WGU = WS_WOUTO + 2 * MiB;
constexpr size_t WS_WD = WS_WGU + 32 * MiB;
constexpr size_t WS_CTXS = WS_WD + 16 * MiB;
constexpr size_t WS_R1 = 66 * MiB;
constexpr size_t WS_R4 = WS_R1 + 34 * MiB;
constexpr size_t WS_R2 = WS_R4 + 34 * MiB;
constexpr size_t WS_R3 = WS_R2 + 34 * MiB;
static_assert(WS_CTXS + 4 * MiB <= WS_R1, "ws map");
constexpr size_t R3_GQ = 0, R3_GK = R3_GQ + (size_t)NT * 256 * 2, R3_GV = R3_GK + (size_t)NT * 256 * 2, R3_GR = R3_GV + (size_t)NT * 512 * 2,
                 R3_LR = R3_GR + (size_t)NT * 512 * 2, R3_AQ = R3_LR + (size_t)NT * 32 * 4, R3_AK = R3_AQ + (size_t)NT * 512 * 2, R3_AV = R3_AK + (size_t)NT * 128 * 2,
                 R3_END = R3_AV + (size_t)NT * 128 * 2;
static_assert(WS_R3 + R3_END <= 256 * MiB, "ws map end");
constexpr size_t R3_OQ = 0, R3_OK = R3_OQ + (size_t)NL * 1024 * 2, R3_OV = R3_OK + (size_t)NT * 128 * 2;
constexpr size_t WS_WRT = 250 * MiB, WS_SL = 252 * MiB;
constexpr size_t WRT_STRIDE = 768 * 1024;
constexpr size_t WS_RSS = 253 * MiB;
constexpr size_t WS_BI = WS_RSS + 128 * 1024;
constexpr size_t WS_WINOF = WS_R3 + 48 * MiB;
static_assert(WS_WINOF + (size_t)5 * 1280 * 1024 * 2 <= WS_R3 + R3_END && WS_BI + 5 * 1280 * 4 <= 254 * MiB && WS_WRT + 2 * WRT_STRIDE <= WS_SL, "fold buffers");

__device__ __forceinline__ void ph_prologue(const Ptrs& P, LAS unsigned char* smem, int bid, int nblk) {
    const int lane = threadIdx.x & 63, wave = threadIdx.x >> 6;
    LAS float* scr = (LAS float*)smem + wave * 64 * 33;
    const int gw = bid * 4 + wave, NGW = nblk * 4;
    unsigned char* ws = P.ws;
    constexpr int I_WINE = 16 * 73, I_SQ = 16 * 32, I_WINO = 16 * 40, I_EXP_GU = 16 * 8, I_EXP_D = 4 * 32;
    constexpr int T_WINE = I_WINE, T_WOUTE = T_WINE + I_SQ, T_WINO = T_WOUTE + I_WINO, T_WOUTO = T_WINO + I_SQ,
                  T_G = T_WOUTO + 32 * I_EXP_GU, T_U = T_G + 32 * I_EXP_GU, T_D = T_U + 32 * I_EXP_D;
    for (int it = gw; it < T_D; it += NGW) {
        if (it < T_WINE) {
            int kb = it / 73, nb = it % 73, n0 = nb * 32;
            int dst = n0 < 1536 ? n0 : (n0 < 1568 ? n0 + 768 : n0 - 32);
            transpose_item(P.in[8], 1024, EVEN_IN, (bf16*)(ws + WS_WINE), dst, kb * 64, n0, scr, lane);
        } else if (it < T_WOUTE) { int r = it - T_WINE; transpose_item(P.in[9], 1024, 1024, (bf16*)(ws + WS_WOUTE), (r % 32) * 32, (r / 32) * 64, (r % 32) * 32, scr, lane); }
        else if (it < T_WINO) { int r = it - T_WOUTE; transpose_item(P.in[15], 1024, 1280, (bf16*)(ws + WS_WINO), (r % 40) * 32, (r / 40) * 64, (r % 40) * 32, scr, lane); }
        else if (it < T_WOUTO) { int r = it - T_WINO; transpose_item(P.in[16], 1024, 1024, (bf16*)(ws + WS_WOUTO), (r % 32) * 32, (r / 32) * 64, (r % 32) * 32, scr, lane); }
        else if (it < T_U) {
            bool up = it >= T_G; int r = it - (up ? T_G : T_WOUTO); int le = r / I_EXP_GU; r %= I_EXP_GU; int kb = r / 8, hb = r % 8;
            const float* W = (up ? P.in[25] : P.in[24]) + (size_t)le * 1024 * 256;
            transpose_item(W, 1024, 256, (bf16*)(ws + WS_WGU) + (size_t)le * 512 * 1024, 64 * hb + (up ? 32 : 0), kb * 64, hb * 32, scr, lane);
        } else {
            int r = it - T_U; int le = r / I_EXP_D; r %= I_EXP_D; int kb = r / 32, nb = r % 32;
            transpose_item(P.in[26] + (size_t)le * 256 * 1024, 256, 1024, (bf16*)(ws + WS_WD) + (size_t)le * 1024 * 256, nb * 32, kb * 64, nb * 32, scr, lane);
        }
    }
    { u32x4 z = {0, 0, 0, 0}; u32x4* p = (u32x4*)((bf16*)(ws + WS_WINE) + (size_t)EVEN_IN * 1024);
      for (int i = bid * 256 + threadIdx.x; i < 96 * 1024 * 2 / 16; i += nblk * 256) p[i] = z; }
    for (int i = bid * 256 + threadIdx.x; i < 1024; i += nblk * 256) {
        int pos = i >> 4, f = i & 15; float inv = powf(10000.f, -(float)(2 * f) / 32.f); float ang = (float)pos * inv;
        ((float2*)(ws + WS_ROPE))[i] = make_float2(cosf(ang), sinf(ang));
    }
    for (int i = bid * 256 + threadIdx.x; i < NT; i += nblk * 256) ((float*)(ws + WS_RSS))[i] = 0.f;
    if (bid == 0 && threadIdx.x < 2) {
        const float* gq = threadIdx.x ? P.in[18] : P.in[13]; const float* gk = threadIdx.x ? P.in[19] : P.in[14];
        float mq = 0.f, mk = 0.f; for (int d = 0; d < 64; ++d) { mq = fmaxf(mq, fabsf(gq[d])); mk = fmaxf(mk, fabsf(gk[d])); }
        ((float*)(ws + WS_ROPE + 8192))[threadIdx.x] = 8.f * mq * mk * 1.4426950408889634f;
    }
    __syncthreads();
    {
        LAS float* sc = (LAS float*)smem;
        LAS float* red = (LAS float*)smem + 5 * 1024;
        for (int i = threadIdx.x; i < 5 * 1024; i += 256) { const float cv = i < 4096 ? P.in[1][i] : P.in[3][i - 4096]; sc[i] = cv / (1.f + expf(-cv)); }
        __syncthreads();
        for (int it = bid; it < 2 * 96; it += nblk) {
            const int layer = it / 96, col = (it % 96) * 64 + lane;
            const float* w = P.in[4] + (size_t)layer * D * 6144 + col;
            float a0 = 0.f, a1 = 0.f, a2 = 0.f, a3 = 0.f, a4 = 0.f;
#pragma unroll 32
            for (int k = 256 * wave; k < 256 * wave + 256; ++k) { const float wv = w[(size_t)k * 6144]; a0 += sc[k] * wv; a1 += sc[1024 + k] * wv; a2 += sc[2048 + k] * wv; a3 += sc[3072 + k] * wv; a4 += sc[4096 + k] * wv; }
            red[(wave * 5 + 0) * 64 + lane] = a0; red[(wave * 5 + 1) * 64 + lane] = a1; red[(wave * 5 + 2) * 64 + lane] = a2; red[(wave * 5 + 3) * 64 + lane] = a3; red[(wave * 5 + 4) * 64 + lane] = a4;
            __syncthreads();
            for (int i = threadIdx.x; i < 320; i += 256) { const int row = i >> 6, cl = i & 63;
                ((float*)(ws + WS_MODV))[((size_t)layer * 5 + row) * 6144 + (it % 96) * 64 + cl] = red[row * 64 + cl] + red[(5 + row) * 64 + cl] + red[(10 + row) * 64 + cl] + red[(15 + row) * 64 + cl] + P.in[5][layer * 6144 + (it % 96) * 64 + cl]; }
            __syncthreads();
        }
    }
}

template <bool SRC_BF>
__device__ __forceinline__ void modulate_rows(const float* xlat, const float* xctx, const bf16* xs, const float* modv_layer, const float* gain, int which, bf16* H, int nrows, int gw, int NGW, int lane) {
    for (int row = gw; row < nrows; row += NGW) {
        const float* mv = modv_layer + (size_t)(row < NL ? row / S : 4) * 6144;
        f32x4 v[4]; float ss = 0.f;
#pragma unroll
        for (int j = 0; j < 4; ++j) {
            if (SRC_BF) { const u32x2 w = *(const u32x2*)(xs + (size_t)row * D + 4 * lane + 256 * j); f32x4 t = {__uint_as_float(w.x << 16), __uint_as_float(w.x & 0xffff0000u), __uint_as_float(w.y << 16), __uint_as_float(w.y & 0xffff0000u)}; v[j] = t; }
            else { const float* xr = row < NL ? xlat + (size_t)row * D : xctx + (size_t)(row - NL) * D; v[j] = *(const f32x4*)(xr + 4 * lane + 256 * j); }
            ss += v[j].x * v[j].x + v[j].y * v[j].y + v[j].z * v[j].z + v[j].w * v[j].w;
        }
        float rstd = rsqrtf(wave_sum(ss) / D + EPS);
#pragma unroll
        for (int j = 0; j < 4; ++j) {
            int k = 4 * lane + 256 * j;
            f32x4 g = *(const f32x4*)(gain + k), sc = *(const f32x4*)(mv + (which + 1) * 1024 + k), sh = *(const f32x4*)(mv + which * 1024 + k);
            float h0 = v[j].x * rstd * g.x * (1.f + sc.x) + sh.x, h1 = v[j].y * rstd * g.y * (1.f + sc.y) + sh.y;
            float h2 = v[j].z * rstd * g.z * (1.f + sc.z) + sh.z, h3 = v[j].w * rstd * g.w * (1.f + sc.w) + sh.w;
            u32x2 o = {pk2(h0, h1), pk2(h2, h3)};
            *(u32x2*)(H + (size_t)row * D + k) = o;
        }
    }
}
__device__ __forceinline__ void route_tables(const Ptrs& P, int layer, int bid, int nblk);
__device__ __forceinline__ void ph_modulate(const Ptrs& P, int layer, int bid, int nblk) {
    route_tables(P, layer, bid, nblk);
    if (layer == 0) modulate_rows<false>(P.in[0], P.in[2], nullptr, (const float*)(P.ws + WS_MODV), P.in[6], 0, (bf16*)(P.ws + WS_R1), NT, bid * 4 + (threadIdx.x >> 6), nblk * 4, threadIdx.x & 63);
    else modulate_rows<true>(nullptr, nullptr, (const bf16*)(P.ws + WS_R4), (const float*)(P.ws + WS_MODV) + (size_t)5 * 6144, P.in[6] + D, 0, (bf16*)(P.ws + WS_R1), NT, bid * 4 + (threadIdx.x >> 6), nblk * 4, threadIdx.x & 63);
}

struct AffineRows {
    const bf16* base; size_t ld; int w; unsigned vo[4];
    __device__ __forceinline__ AffineRows(const bf16* b, size_t ld_) : base(b), ld(ld_), w(0) {}
    __device__ __forceinline__ void init(int w_, int rl, const int (&co)[4]) { w = w_;
#pragma unroll
        for (int i = 0; i < 4; ++i) vo[i] = (unsigned)((rl * ld + co[i]) * 2); }
    __device__ __forceinline__ const bf16* sb(int i, int kt) const { return base + (size_t)(32 * w + 8 * i) * ld + kt * 64; }
};
template <bool SWP, class AF, class BF, class Epi>
__device__ __forceinline__ void gemm_tile(AF af, BF bf, int nk, LAS unsigned char* smem, const Epi& epi) {
    const int tid = threadIdx.x, lane = tid & 63, wave = __builtin_amdgcn_readfirstlane(tid >> 6), wn = wave & 1, wm = wave >> 1, l31 = lane & 31, hh = lane >> 5;
    const int r0 = wave * 32 + (lane >> 3);
    __syncthreads();
    typename Epi::Pre pre; epi.prefetch(pre, wn * 64, wm * 64, l31, hh);
    __builtin_amdgcn_sched_barrier(0);
    int coff[4];
#pragma unroll
    for (int i = 0; i < 4; ++i) coff[i] = ((lane & 7) ^ (((r0 >> 1) + 4 * i) & 7)) * 8;
    af.init(wave, lane >> 3, coff); bf.init(wave, lane >> 3, coff);
#define GT_STAGE(st, kt) do { _Pragma("unroll") for (int i = 0; i < 4; ++i) { \
        __builtin_amdgcn_global_load_lds((const unsigned*)((const char*)af.sb(i, (kt)) + af.vo[i]), (LAS unsigned*)(smem + (st) * 2 * TILE_LDS + (wave * 4 + i) * 1024), 16, 0, 0); \
        __builtin_amdgcn_global_load_lds((const unsigned*)((const char*)bf.sb(i, (kt)) + bf.vo[i]), (LAS unsigned*)(smem + (st) * 2 * TILE_LDS + TILE_LDS + (wave * 4 + i) * 1024), 16, 0, 0); } } while (0)
    GT_STAGE(0, 0);
    f32x16 acc[2][2];
#pragma unroll
    for (int i = 0; i < 2; ++i)
#pragma unroll
        for (int j = 0; j < 2; ++j)
#pragma unroll
            for (int r = 0; r < 16; ++r) acc[i][j][r] = 0.f;
    const int sw = (l31 >> 1) & 7;
    int xo[4], wo[4];
#pragma unroll
    for (int s = 0; s < 4; ++s) { const int cs = ((2 * s + hh) ^ sw) * 16; xo[s] = (wm * 64 + l31) * 128 + cs; wo[s] = TILE_LDS + (wn * 64 + l31) * 128 + cs; }
    asm volatile("s_waitcnt vmcnt(0)" ::: "memory");
    __syncthreads();
    for (int kt = 0; kt < nk; ++kt) {
        const int st = kt & 1;
        if (kt + 1 < nk) GT_STAGE(st ^ 1, kt + 1);
        LAS unsigned char* sb = smem + st * 2 * TILE_LDS;
#pragma unroll
        for (int s = 0; s < 4; ++s) {
            bf16x8 wf[2], xf[2];
#pragma unroll
            for (int i = 0; i < 2; ++i) wf[i] = *(LAS bf16x8*)(sb + wo[s] + i * 4096);
#pragma unroll
            for (int j = 0; j < 2; ++j) xf[j] = *(LAS bf16x8*)(sb + xo[s] + j * 4096);
#pragma unroll
            for (int i = 0; i < 2; ++i)
#pragma unroll
                for (int j = 0; j < 2; ++j) acc[i][j] = SWP ? __builtin_amdgcn_mfma_f32_32x32x16_bf16(xf[j], wf[i], acc[i][j], 0, 0, 0)
                                                            : __builtin_amdgcn_mfma_f32_32x32x16_bf16(wf[i], xf[j], acc[i][j], 0, 0, 0);
        }
        asm volatile("s_waitcnt vmcnt(0)" ::: "memory");
        __syncthreads();
    }
#undef GT_STAGE
    { int l31e = l31, hhe = hh, we = wave; asm volatile("" : "+v"(l31e), "+v"(hhe), "+v"(we));
      epi(acc, (we & 1) * 64, (we >> 1) * 64, l31e, hhe, smem + we * 16384, pre); }
}

constexpr int SG_P = 144;
__device__ __forceinline__ void store_bf16_T(const f32x16 (&acc)[2][2], bf16* out, size_t ld, size_t trow0, int col0, int l31, int hh, LAS unsigned char* wl) {
#pragma unroll
    for (int j = 0; j < 2; ++j)
#pragma unroll
        for (int i = 0; i < 2; ++i)
#pragma unroll
            for (int g = 0; g < 4; ++g) { u32x2 v = {pk2(acc[i][j][4 * g], acc[i][j][4 * g + 1]), pk2(acc[i][j][4 * g + 2], acc[i][j][4 * g + 3])}; *(LAS u32x2*)(wl + (32 * j + l31) * SG_P + (32 * i + 8 * g + 4 * hh) * 2) = v; }
    const int lane = l31 + 32 * hh, rr = lane >> 3, ch = lane & 7;
#pragma unroll
    for (int q = 0; q < 8; ++q) { const int R = 8 * q + rr; const u32x4 v = *(LAS u32x4*)(wl + R * SG_P + ch * 16); *(u32x4*)(out + (trow0 + R) * ld + col0 + ch * 8) = v; }
}
__device__ __forceinline__ void qknorm_rope_T(f32x16 (&acc)[2][2], const float* gain, const float2* ropeT, bool latent, int tok0  , int l31, int hh, float oscale = 1.f) {
#pragma unroll
    for (int j = 0; j < 2; ++j) {
        float ss = 0.f;
#pragma unroll
        for (int i = 0; i < 2; ++i)
#pragma unroll
            for (int r = 0; r < 16; ++r) ss += acc[i][j][r] * acc[i][j][r];
        ss = xhalf_sum(ss);
        const float rstd = rsqrtf(ss * (1.f / 64.f) + EPS) * oscale;
#pragma unroll
        for (int i = 0; i < 2; ++i)
#pragma unroll
            for (int r = 0; r < 16; ++r) acc[i][j][r] *= rstd * gain[i * 32 + (r & 3) + 8 * (r >> 2) + 4 * hh];
        if (latent) {
            const int t = tok0 + j * 32 + l31;
#pragma unroll
            for (int i = 0; i < 2; ++i) {
                const int pos = i == 0 ? (t >> 6) : (t & 63);
#pragma unroll
                for (int r = 0; r < 8; ++r) {
                    const int f = (r & 3) + 8 * (r >> 2) + 4 * hh;
                    const float2 cs = ropeT[pos * 16 + f];
                    const float x1 = acc[i][j][r], x2 = acc[i][j][r + 8];
                    acc[i][j][r] = x1 * cs.x - x2 * cs.y; acc[i][j][r + 8] = x2 * cs.x + x1 * cs.y;
                }
            }
        }
    }
}

constexpr int VT_LD = S + CL;
__device__ __forceinline__ void store_vt_swapped(const f32x16 (&acc)[2][2], bf16* vt_head  , int key0, int l31, int hh, LAS unsigned char* wl) {
#pragma unroll
    for (int i = 0; i < 2; ++i)
#pragma unroll
        for (int j = 0; j < 2; ++j)
#pragma unroll
            for (int g = 0; g < 4; ++g) { u32x2 v = {pk2(acc[i][j][4 * g], acc[i][j][4 * g + 1]), pk2(acc[i][j][4 * g + 2], acc[i][j][4 * g + 3])}; *(LAS u32x2*)(wl + (32 * i + l31) * SG_P + (32 * j + 8 * g + 4 * hh) * 2) = v; }
    const int lane = l31 + 32 * hh, rr = lane >> 3, ch = lane & 7;
#pragma unroll
    for (int q = 0; q < 8; ++q) { const int R = 8 * q + rr; const u32x4 v = *(LAS u32x4*)(wl + R * SG_P + ch * 16); *(u32x4*)(vt_head + (size_t)R * VT_LD + key0 + ch * 8) = v; }
}
struct NoPre {};
template <bool SRC_BF> struct RmwPre { f32x4 xi[16]; };
template <> struct RmwPre<true> { u32x2 xi[16]; };
template <bool SRC_BF, class RowF>
__device__ __forceinline__ void rmw_prefetch(RmwPre<SRC_BF>& pre, const RowF& rowf, int l31, int hh) {
    const int lane = l31 + 32 * hh, rr = lane >> 4, ch = lane & 15;
#pragma unroll
    for (int q = 0; q < 16; ++q) {
        const void* sp; void* dp; const float* gp; int tk;
        if (rowf(4 * q + rr, sp, dp, gp, tk)) {
            if constexpr (SRC_BF) pre.xi[q] = *(const u32x2*)((const bf16*)sp + ch * 4); else pre.xi[q] = *(const f32x4*)((const float*)sp + ch * 4);
        }
    }
}
template <bool SRC_BF, bool DST_BF, bool SS, class RowF>
__device__ __forceinline__ void rmw_finish(const f32x16 (&acc)[2][2], const RmwPre<SRC_BF>& pre, const RowF& rowf, int l31, int hh, LAS unsigned char* wl, float* rss = nullptr) {
    const int lane = l31 + 32 * hh, rr = lane >> 4, ch = lane & 15;
#pragma unroll
    for (int j = 0; j < 2; ++j)
#pragma unroll
        for (int i = 0; i < 2; ++i)
#pragma unroll
            for (int g = 0; g < 4; ++g) { f32x4 v = {acc[i][j][4 * g], acc[i][j][4 * g + 1], acc[i][j][4 * g + 2], acc[i][j][4 * g + 3]};
                const int R = 32 * j + l31; *(LAS f32x4*)(wl + R * 256 + (((8 * i + 2 * g + hh) ^ (R & 15)) * 16)) = v; }
    float ssr[16];
#pragma unroll
    for (int q = 0; q < 16; ++q) {
        const void* sp; void* dp; const float* gp; int tk = 0;
        const bool ok = rowf(4 * q + rr, sp, dp, gp, tk);
        float ssq = 0.f;
        if (ok) {
            f32x4 x;
            if constexpr (SRC_BF) { const u32x2 w = pre.xi[q]; f32x4 t = {__uint_as_float(w.x << 16), __uint_as_float(w.x & 0xffff0000u), __uint_as_float(w.y << 16), __uint_as_float(w.y & 0xffff0000u)}; x = t; } else x = pre.xi[q];
            const int R = 4 * q + rr; const f32x4 a = *(LAS f32x4*)(wl + R * 256 + ((ch ^ (R & 15)) * 16)); const f32x4 gt = *(const f32x4*)(gp + ch * 4);
            const f32x4 v = {x.x + gt.x * a.x, x.y + gt.y * a.y, x.z + gt.z * a.z, x.w + gt.w * a.w};
            if (DST_BF) { u32x2 o = {pk2(v.x, v.y), pk2(v.z, v.w)}; *(u32x2*)((bf16*)dp + ch * 4) = o;
                if (SS) { const float r0 = __uint_as_float(o.x << 16), r1 = __uint_as_float(o.x & 0xffff0000u), r2 = __uint_as_float(o.y << 16), r3 = __uint_as_float(o.y & 0xffff0000u); ssq = (r0 * r0 + r1 * r1) + (r2 * r2 + r3 * r3); } }
            else *(f32x4*)((float*)dp + ch * 4) = v;
        }
        if (SS) { ssq += __shfl_xor(ssq, 1); ssq += __shfl_xor(ssq, 2); ssq += __shfl_xor(ssq, 4); ssq += __shfl_xor(ssq, 8); ssr[q] = ssq; }
    }
    if (SS) {
        if (ch == 0) {
#pragma unroll
            for (int q = 0; q < 16; ++q) *(LAS float*)(wl + (4 * q + rr) * 4) = ssr[q];
        }
        const float sv = *(LAS float*)(wl + lane * 4);
        const void* sp; void* dp; const float* gp; int tk = 0;
        if (rowf(lane, sp, dp, gp, tk)) atomicAdd(rss + tk, sv);
    }
}
struct EpiEvenIn {
    typedef NoPre Pre;
    __device__ __forceinline__ void prefetch(Pre&, int, int, int, int) const {}
    unsigned char* r3; const float* qn; const float* kn; const float2* ropeT; int mt, nt;
    __device__ __forceinline__ bool swapped() const { return nt == 17 || (nt >= 4 && nt < 8); }
    __device__ __forceinline__ void operator()(f32x16 (&acc)[2][2], int fb, int tb, int l31, int hh, LAS unsigned char* wl, const Pre& pre) const {
        const size_t trow0 = (size_t)mt * 128 + tb; const bool latent = mt < NL / 128; const int tok0 = (int)(trow0 & (S - 1));
        if (swapped()) {
            const int b = latent ? (int)(trow0 / S) : (int)((trow0 - NL) / CL); const int key0 = latent ? tok0 : S + (int)((trow0 - NL) % CL);
            const size_t off = nt == 17 ? R3_AV + (size_t)(b * 2 + fb / 64) * 64 * VT_LD * 2 : R3_GV + ((size_t)(b * 4 + nt - 4) * 128 + fb) * VT_LD * 2;
            store_vt_swapped(acc, (bf16*)(r3 + off), key0, l31, hh, wl);
        } else if (nt == 18) {
            if (fb == 0) {
                float* LR = (float*)(r3 + R3_LR);
#pragma unroll
                for (int j = 0; j < 2; ++j)
#pragma unroll
                    for (int g = 0; g < 4; ++g) { f32x4 v = {acc[0][j][4 * g], acc[0][j][4 * g + 1], acc[0][j][4 * g + 2], acc[0][j][4 * g + 3]}; *(f32x4*)(LR + (trow0 + j * 32 + l31) * 32 + 8 * g + 4 * hh) = v; }
            }
        } else {
            size_t off; int ld, col;
            if (nt < 2) { off = R3_GQ; ld = 256; col = nt * 128; }
            else if (nt < 4) { off = R3_GK; ld = 256; col = (nt - 2) * 128; }
            else if (nt < 12) { off = R3_GR; ld = 512; col = (nt - 8) * 128; }
            else if (nt < 16) { off = R3_AQ; ld = 512; col = (nt - 12) * 128; }
            else { off = R3_AK; ld = 128; col = 0; }
            if (nt >= 12) qknorm_rope_T(acc, nt < 16 ? qn : kn, ropeT, latent, tok0, l31, hh, nt < 16 ? QSCALE : 1.f);
            store_bf16_T(acc, (bf16*)(r3 + off), ld, trow0, col + fb, l31, hh, wl);
        }
    }
};
__device__ __forceinline__ int xcd_vid(int bid, int nb) { return (nb % 8 == 0) ? (bid % 8) * (nb / 8) + bid / 8 : bid; }

__device__ __forceinline__ void ph_even_inproj(const Ptrs& P, LAS unsigned char* smem, int bid, int nblk) {
    unsigned char* ws = P.ws;
    const int lrow = threadIdx.x >> 3, kc = threadIdx.x & 7;
    const int vid = xcd_vid(bid, nblk);
    for (int tile = vid; tile < (NT / 128) * 19; tile += nblk) {
        const int mt = tile / 19, nt = tile % 19;
        AffineRows af((const bf16*)(ws + WS_R1) + (size_t)mt * 128 * D, D);
        AffineRows bf_((const bf16*)(ws + WS_WINE) + (size_t)nt * 128 * D, D);
        EpiEvenIn epi{ws + WS_R3, P.in[13], P.in[14], (const float2*)(ws + WS_ROPE), mt, nt};
        if (epi.swapped()) gemm_tile<true>(af, bf_, D / 64, smem, epi); else gemm_tile<false>(af, bf_, D / 64, smem, epi);
    }
}

template <int LAYER>
struct EpiOutProj {
    typedef RmwPre<LAYER != 0> Pre;
    const float* modv_layer; const float* xin_lat; const float* xin_ctx; bf16* xs; int mt, nt;
    __device__ __forceinline__ bool swapped() const { return false; }
    __device__ __forceinline__ auto rowfn(int fb, int tb) const {
        const size_t trow0 = (size_t)mt * 128 + tb; const bool latent = mt < NL / 128;
        const int c0 = nt * 128 + fb;
        const float* gate = modv_layer + (size_t)(latent ? trow0 / S : 4) * 6144 + 2 * 1024 + c0;
        bf16* xo = xs + trow0 * D + c0;
        const float* xin = LAYER == 0 ? (latent ? xin_lat + trow0 * D : xin_ctx + (trow0 - NL) * D) + c0 : nullptr;
        return [=](int R, const void*& sp, void*& dp, const float*& gp, int& tk) { if (LAYER == 0) sp = xin + (size_t)R * D; else sp = xo + (size_t)R * D; dp = xo + (size_t)R * D; gp = gate; tk = (int)trow0 + R; return true; };
    }
    __device__ __forceinline__ void prefetch(Pre& pre, int fb, int tb, int l31, int hh) const { rmw_prefetch<LAYER != 0>(pre, rowfn(fb, tb), l31, hh); }
    __device__ __forceinline__ void operator()(f32x16 (&acc)[2][2], int fb, int tb, int l31, int hh, LAS unsigned char* wl, const Pre& pre) const {
        rmw_finish<LAYER != 0, true, false>(acc, pre, rowfn(fb, tb), l31, hh, wl);
    }
};
__device__ __forceinline__ void ph_outproj(const Ptrs& P, LAS unsigned char* smem, int bid, int nblk, int layer, int nrows) {
    unsigned char* ws = P.ws;
    const int lrow = threadIdx.x >> 3, kc = threadIdx.x & 7;
    const int vid = xcd_vid(bid, nblk);
    const float* modv_layer = (const float*)(ws + WS_MODV) + (size_t)layer * 5 * 6144;
    for (int tile = vid; tile < (nrows / 128) * 8; tile += nblk) {
        const int mt = tile / 8, nt = tile % 8;
        AffineRows af((const bf16*)(ws + WS_R2) + (size_t)mt * 128 * D, D);
        AffineRows bf_((const bf16*)(ws + (layer ? WS_WOUTO : WS_WOUTE)) + (size_t)nt * 128 * D, D);
        if (layer == 0) { EpiOutProj<0> epi{modv_layer, P.in[0], P.in[2], (bf16*)(ws + WS_R4), mt, nt}; gemm_tile<false>(af, bf_, D / 64, smem, epi); }
        else { EpiOutProj<1> epi{modv_layer, nullptr, nullptr, (bf16*)(ws + WS_R4), mt, nt}; gemm_tile<false>(af, bf_, D / 64, smem, epi); }
    }
}

struct EpiOddIn {
    typedef NoPre Pre;
    __device__ __forceinline__ void prefetch(Pre&, int, int, int, int) const {}
    unsigned char* r3; const float* qn; const float* kn; const float2* ropeT; const float* rss; const float* bi; int mt, nt;
    __device__ __forceinline__ bool swapped() const { return nt == 9; }
    __device__ __forceinline__ void operator()(f32x16 (&acc)[2][2], int fb, int tb, int l31, int hh, LAS unsigned char* wl, const Pre& pre) const {
        const size_t trow0 = (size_t)mt * 128 + tb; const bool latent = mt < NL / 128; const int tok0 = (int)(trow0 & (S - 1));
        if (!swapped()) {
#pragma unroll
            for (int j = 0; j < 2; ++j) {
                const float rs = rsqrtf(rss[trow0 + 32 * j + l31] * (1.f / D) + EPS);
#pragma unroll
                for (int i = 0; i < 2; ++i)
#pragma unroll
                    for (int g = 0; g < 4; ++g) { const f32x4 b4 = *(const f32x4*)(bi + nt * 128 + fb + 32 * i + 8 * g + 4 * hh);
                        acc[i][j][4 * g] = acc[i][j][4 * g] * rs + b4.x; acc[i][j][4 * g + 1] = acc[i][j][4 * g + 1] * rs + b4.y; acc[i][j][4 * g + 2] = acc[i][j][4 * g + 2] * rs + b4.z; acc[i][j][4 * g + 3] = acc[i][j][4 * g + 3] * rs + b4.w; }
            }
        } else {
#pragma unroll
            for (int j = 0; j < 2; ++j)
#pragma unroll
                for (int g = 0; g < 4; ++g) { const f32x4 q4 = *(const f32x4*)(rss + trow0 + 32 * j + 8 * g + 4 * hh);
                    const float r0 = rsqrtf(q4.x * (1.f / D) + EPS), r1 = rsqrtf(q4.y * (1.f / D) + EPS), r2 = rsqrtf(q4.z * (1.f / D) + EPS), r3_ = rsqrtf(q4.w * (1.f / D) + EPS);
#pragma unroll
                    for (int i = 0; i < 2; ++i) { const float bb = bi[nt * 128 + fb + 32 * i + l31];
                        acc[i][j][4 * g] = acc[i][j][4 * g] * r0 + bb; acc[i][j][4 * g + 1] = acc[i][j][4 * g + 1] * r1 + bb; acc[i][j][4 * g + 2] = acc[i][j][4 * g + 2] * r2 + bb; acc[i][j][4 * g + 3] = acc[i][j][4 * g + 3] * r3_ + bb; } }
        }
        if (nt < 8) { if (latent) { qknorm_rope_T(acc, qn, ropeT, true, tok0, l31, hh, QSCALE); store_bf16_T(acc, (bf16*)(r3 + R3_OQ), 1024, trow0, nt * 128 + fb, l31, hh, wl); } }
        else if (nt == 8) { qknorm_rope_T(acc, kn, ropeT, latent, tok0, l31, hh); store_bf16_T(acc, (bf16*)(r3 + R3_OK), 128, trow0, fb, l31, hh, wl); }
        else {
            const int b = latent ? (int)(trow0 / S) : (int)((trow0 - NL) / CL); const int key0 = latent ? tok0 : S + (int)((trow0 - NL) % CL);
            store_vt_swapped(acc, (bf16*)(r3 + R3_OV) + (size_t)(b * 2 + fb / 64) * 64 * VT_LD, key0, l31, hh, wl);
        }
    }
};
__device__ __forceinline__ void ph_odd_inproj(const Ptrs& P, LAS unsigned char* smem, int bid, int nblk) {
    unsigned char* ws = P.ws;
    const int lrow = threadIdx.x >> 3, kc = threadIdx.x & 7;
    const int vid = xcd_vid(bid, nblk);
    constexpr int T_LAT = (NL / 128) * 10, T_ALL = T_LAT + (NC / 128) * 2;
    for (int tile = vid; tile < T_ALL; tile += nblk) {
        int mt, nt;
        if (tile < T_LAT) { mt = tile / 10; nt = tile % 10; } else { mt = NL / 128 + (tile - T_LAT) / 2; nt = 8 + (tile - T_LAT) % 2; }
        const int brow = mt < NL / 128 ? mt / (S / 128) : 4;
        AffineRows af((const bf16*)(ws + WS_R4) + (size_t)mt * 128 * D, D);
        AffineRows bf_((const bf16*)(ws + WS_WINOF) + ((size_t)brow * 1280 + nt * 128) * D, D);
        EpiOddIn epi{ws + WS_R3, P.in[18], P.in[19], (const float2*)(ws + WS_ROPE), (const float*)(ws + WS_RSS), (const float*)(ws + WS_BI) + brow * 1280, mt, nt};
        if (epi.swapped()) gemm_tile<true>(af, bf_, D / 64, smem, epi); else gemm_tile<false>(af, bf_, D / 64, smem, epi);
    }
}

constexpr int AT_KP = 144, AT_VP = 136;
constexpr int AT_STAGE = 64 * AT_KP + 64 * AT_VP;
constexpr int ATTN_LDS = 2 * AT_STAGE;
struct AttnArgs {
    const bf16* Q; int ldq; size_t qrow0; int qcol;
    const bf16* K; size_t klat0, kctx0;
    const bf16* Vt;
    int nctx, tlo, nlat;
    int banded, tq0;
    const float* sinkp;
    int sink0;
    int wrow, wcol;
    float m0;
    bf16* out;
};
__device__ __forceinline__ float xhalf_max(float x) {
    auto t = __builtin_amdgcn_permlane32_swap(__float_as_uint(x), __float_as_uint(x), false, false);
    return fmaxf(__uint_as_float(t[0]), __uint_as_float(t[1]));
}
__device__ __forceinline__ void attn_block(const AttnArgs& a, LAS unsigned char* smem) {
    int tid_ = threadIdx.x; asm volatile("" : "+v"(tid_));
    const int tid = tid_, lane = tid & 63, wave = tid >> 6, l31 = lane & 31, hh = lane >> 5;
    bf16x8 qf[2][4];
#pragma unroll
    for (int u = 0; u < 2; ++u) { const bf16* qp = a.Q + (a.qrow0 + wave * a.wrow + u * 32 + l31) * a.ldq + a.qcol + wave * a.wcol + hh * 8;
#pragma unroll
      for (int s = 0; s < 4; ++s) qf[u][s] = *(const bf16x8*)(qp + 16 * s); }
    f32x16 o[2][2], minit;
#pragma unroll
    for (int r = 0; r < 16; ++r) { o[0][0][r] = 0.f; o[0][1][r] = 0.f; o[1][0][r] = 0.f; o[1][1][r] = 0.f; minit[r] = -a.m0; }
    float ls[2][2] = {{0.f, 0.f}, {0.f, 0.f}};
    const int ntile = a.nctx + a.nlat;
    const int lr0 = tid >> 3, kc = tid & 7;
    const bf16* kbase = a.K + (size_t)lr0 * 128 + kc * 8;
    const bf16* vbase = a.Vt + (size_t)lr0 * VT_LD + kc * 8;
    const int kwoff = lr0 * AT_KP + kc * 16, vwoff = 64 * AT_KP + lr0 * AT_VP + kc * 16;
    const int kroff = l31 * AT_KP + hh * 16, vroff = 64 * AT_KP + l31 * AT_VP + hh * 8;
    u32x4 rk[2], rv[2];
#define AT_ISSUE(n) do { const int t_ = __builtin_amdgcn_readfirstlane((n) < a.nctx ? 64 + (n) : a.tlo + (n) - a.nctx); \
        const size_t kr_ = (t_ < 64 ? a.klat0 + 64 * t_ : a.kctx0 + 64 * (t_ - 64)); \
        const bf16* kq_ = kbase + kr_ * 128; const bf16* vq_ = vbase + 64 * t_; \
        rk[0] = *(const u32x4*)kq_; rk[1] = *(const u32x4*)(kq_ + 32 * 128); rv[0] = *(const u32x4*)vq_; rv[1] = *(const u32x4*)(vq_ + (size_t)32 * VT_LD); } while (0)
#define AT_COMMIT(ST) do { LAS unsigned char* sb_ = smem + (ST) * AT_STAGE; \
        _Pragma("unroll") for (int i = 0; i < 2; ++i) { *(LAS u32x4*)(sb_ + kwoff + i * 32 * AT_KP) = rk[i]; \
            u32x2 lo_ = {rv[i].x, rv[i].y}, hi_ = {rv[i].z, rv[i].w}; *(LAS u32x2*)(sb_ + vwoff + i * 32 * AT_VP) = lo_; *(LAS u32x2*)(sb_ + vwoff + i * 32 * AT_VP + 8) = hi_; } } while (0)
#define AT_BODY(ST, n) do { \
        if ((n) + 1 < ntile) AT_ISSUE((n) + 1); \
        __builtin_amdgcn_sched_barrier(0); \
        LAS unsigned char* sb = smem + (ST) * AT_STAGE; \
        bool skip = false, edge = false; \
        if (a.banded && (n) >= a.nctx) { const int k0 = 64 * (a.tlo + (n) - a.nctx), q0w = a.tq0 + wave * a.wrow; skip = (k0 + 63 < q0w - 128) || (k0 > q0w + 63 + 128); \
            edge = __builtin_amdgcn_readfirstlane((k0 + 63 > q0w + 128) || (k0 < q0w + 63 - 128)); }       \
        if (!skip) { \
            _Pragma("unroll") for (int kt = 0; kt < 2; ++kt) { \
                f32x16 sc[2]; \
                _Pragma("unroll") for (int s = 0; s < 4; ++s) { \
                    const bf16x8 kf = *(LAS bf16x8*)(sb + kroff + kt * 32 * AT_KP + s * 32); \
                    sc[0] = __builtin_amdgcn_mfma_f32_32x32x16_bf16(kf, qf[0][s], s == 0 ? minit : sc[0], 0, 0, 0); \
                    sc[1] = __builtin_amdgcn_mfma_f32_32x32x16_bf16(kf, qf[1][s], s == 0 ? minit : sc[1], 0, 0, 0); } \
                if (edge) { \
                    _Pragma("unroll") for (int u = 0; u < 2; ++u) { \
                        const int dbase = 64 * (a.tlo + (n) - a.nctx) + 32 * kt + 4 * hh - (a.tq0 + wave * a.wrow + u * 32 + l31); \
                        _Pragma("unroll") for (int r = 0; r < 16; ++r) { const int df = dbase + (r & 3) + 8 * (r >> 2); if (df > 128 || df < -128) sc[u][r] = -1e30f; } } } \
                _Pragma("unroll") for (int u = 0; u < 2; ++u) _Pragma("unroll") for (int r = 0; r < 16; r += 4) { \
                    sc[u][r] = __builtin_amdgcn_exp2f(sc[u][r]); ls[u][0] += sc[u][r]; sc[u][r + 1] = __builtin_amdgcn_exp2f(sc[u][r + 1]); ls[u][1] += sc[u][r + 1]; \
                    sc[u][r + 2] = __builtin_amdgcn_exp2f(sc[u][r + 2]); ls[u][0] += sc[u][r + 2]; sc[u][r + 3] = __builtin_amdgcn_exp2f(sc[u][r + 3]); ls[u][1] += sc[u][r + 3]; } \
                _Pragma("unroll") for (int s2 = 0; s2 < 2; ++s2) { \
                    bf16x8 pf[2]; \
                    _Pragma("unroll") for (int u = 0; u < 2; ++u) { \
                        u32x4 pw = {pk2(sc[u][8 * s2], sc[u][8 * s2 + 1]), pk2(sc[u][8 * s2 + 2], sc[u][8 * s2 + 3]), pk2(sc[u][8 * s2 + 4], sc[u][8 * s2 + 5]), pk2(sc[u][8 * s2 + 6], sc[u][8 * s2 + 7])}; \
                        pf[u] = __builtin_bit_cast(bf16x8, pw); } \
                    _Pragma("unroll") for (int dt = 0; dt < 2; ++dt) { \
                        LAS unsigned char* vp = sb + vroff + dt * 32 * AT_VP + (32 * kt + 16 * s2) * 2; \
                        const u32x2 v0 = *(LAS u32x2*)vp, v1 = *(LAS u32x2*)(vp + 16); u32x4 vw = {v0.x, v0.y, v1.x, v1.y}; const bf16x8 vf = __builtin_bit_cast(bf16x8, vw); \
                        _Pragma("unroll") for (int u = 0; u < 2; ++u) o[u][dt] = __builtin_amdgcn_mfma_f32_32x32x16_bf16(vf, pf[u], o[u][dt], 0, 0, 0); } } \
                __builtin_amdgcn_sched_barrier(0); \
            } \
        } \
        __builtin_amdgcn_sched_barrier(0); \
        if ((n) + 1 < ntile) AT_COMMIT((ST) ^ 1); \
        __syncthreads(); } while (0)
    AT_ISSUE(0); AT_COMMIT(0);
    __syncthreads();
#pragma unroll 1
    for (int n = 0; n < ntile; n += 2) {
        AT_BODY(0, n);
        if (n + 1 < ntile) AT_BODY(1, n + 1);
    }
#undef AT_ISSUE
#undef AT_COMMIT
#undef AT_BODY
#pragma unroll
    for (int u = 0; u < 2; ++u) {
        const float l = xhalf_sum(ls[u][0] + ls[u][1]) + (a.sinkp ? __builtin_amdgcn_exp2f(a.sinkp[a.sink0 + wave * (a.wcol >> 6)] * 1.4426950408889634f - a.m0) : 0.f);
        const float inv = 1.f / l;
        bf16* op = a.out + (a.qrow0 + wave * a.wrow + u * 32 + l31) * 1024 + wave * a.wcol + 4 * hh;
#pragma unroll
        for (int dt = 0; dt < 2; ++dt)
#pragma unroll
            for (int g = 0; g < 4; ++g) { u32x2 v = {pk2(o[u][dt][4 * g] * inv, o[u][dt][4 * g + 1] * inv), pk2(o[u][dt][4 * g + 2] * inv, o[u][dt][4 * g + 3] * inv)}; *(u32x2*)(op + dt * 32 + 8 * g) = v; }
    }
}

__device__ __forceinline__ void ph_dense_attn(const Ptrs& P, LAS unsigned char* smem, int bid, int nblk) {
    unsigned char* r3 = P.ws + WS_R3;
    const int vid = xcd_vid(bid, nblk);
    for (int item = vid; item < 512 + 32; item += nblk) {
        AttnArgs a;
        int bh, qb; bool isctx = item >= 512;
        if (!isctx) { bh = item >> 4; qb = item & 15; } else { bh = item - 512; qb = 0; }
        const int hq = bh & 7, b = bh >> 3, kv = hq >> 2;
        a.Q = (const bf16*)(r3 + R3_AQ); a.ldq = 512; a.qcol = hq * 64;
        a.qrow0 = isctx ? (size_t)NL + b * CL : (size_t)b * S + qb * 256;
        a.K = (const bf16*)(r3 + R3_AK) + kv * 64; a.klat0 = (size_t)b * S; a.kctx0 = (size_t)NL + b * CL;
        a.Vt = (const bf16*)(r3 + R3_AV) + (size_t)(b * 2 + kv) * 64 * VT_LD;
        a.nctx = 4; a.tlo = 0; a.nlat = isctx ? 0 : 64; a.banded = 0; a.tq0 = 0; a.sinkp = nullptr; a.sink0 = 0; a.wrow = 64; a.wcol = 0; a.m0 = ((const float*)(P.ws + WS_ROPE + 8192))[0];
        a.out = (bf16*)(P.ws + WS_R2) + 512 + hq * 64;
        attn_block(a, smem);
    }
}
__device__ __forceinline__ void ph_swa_attn(const Ptrs& P, LAS unsigned char* smem, int bid, int nblk) {
    unsigned char* r3 = P.ws + WS_R3;
    const int vid = xcd_vid(bid, nblk);
    for (int item = vid; item < 1024; item += nblk) {
        AttnArgs a;
        const int hg = item & 1, qb = (item >> 1) & 63, kv = (item >> 7) & 1, b = item >> 8, hq = kv * 8 + hg * 4;
        a.Q = (const bf16*)(r3 + R3_OQ); a.ldq = 1024; a.qcol = hq * 64; a.qrow0 = (size_t)b * S + qb * 64;
        a.K = (const bf16*)(r3 + R3_OK) + kv * 64; a.klat0 = (size_t)b * S; a.kctx0 = (size_t)NL + b * CL;
        a.Vt = (const bf16*)(r3 + R3_OV) + (size_t)(b * 2 + kv) * 64 * VT_LD;
        const int tlo = qb - 2 < 0 ? 0 : qb - 2, thi = qb + 2 > 63 ? 63 : qb + 2;
        a.nctx = 4; a.tlo = tlo; a.nlat = thi - tlo + 1; a.banded = 1; a.tq0 = qb * 64; a.sinkp = P.in[17]; a.sink0 = hq; a.wrow = 0; a.wcol = 64; a.m0 = ((const float*)(P.ws + WS_ROPE + 8192))[1];
        a.out = (bf16*)(P.ws + WS_R2) + hq * 64;
        attn_block(a, smem);
    }
}

constexpr size_t WS_LIST = 247 * MiB;
constexpr size_t WS_WTS = WS_LIST + (size_t)24 * NT * 4;
constexpr size_t WS_END_ALL = WS_WTS + (size_t)NT * 2 * 4;
static_assert(WS_R3 + R3_END <= WS_LIST && WS_END_ALL <= 256 * MiB, "ws map tail");
constexpr int CTL_CNT = 8192;
constexpr int MOE_MAXT = NT / 128 + 24;


typedef float f32x4v __attribute__((ext_vector_type(4)));
__device__ __forceinline__ void route_tables(const Ptrs& P, int layer, int bid, int nblk) {
    unsigned char* ws = P.ws;
    const float* mvl = (const float*)(ws + WS_MODV) + (size_t)layer * 5 * 6144;
    const float* gain = P.in[7] + layer * D;
    const float* wg = P.in[20] + (size_t)layer * D * 4; const float* bg = P.in[21] + layer * 4;
    const float* we = P.in[22] + (size_t)layer * D * 16; const float* be = P.in[23] + layer * 16;
    bf16* wrt = (bf16*)(ws + WS_WRT + layer * WRT_STRIDE);
    for (int e = bid * 256 + threadIdx.x; e < 5 * 32 * 1024; e += nblk * 256) {
        const int k = e & 1023, r = (e >> 10) & 31, br = e >> 15;
        const float a = gain[k] * (1.f + mvl[(size_t)br * 6144 + 4 * 1024 + k]);
        const float w = (r < 16 ? wg[k * 4 + (r & 3)] : we[k * 16 + r - 16]) * a;
        const bf16 hi = f2bf(w); const bf16 lo = f2bf(w - bf2f(hi));
        wrt[((size_t)(br * 2 + 0) * 32 + r) * 1024 + k] = hi; wrt[((size_t)(br * 2 + 1) * 32 + r) * 1024 + k] = lo;
    }
    const int gw = bid * 4 + (threadIdx.x >> 6), lane = threadIdx.x & 63;
    if (gw < 160) {
        const int r = gw & 31, br = gw >> 5; float s = 0.f;
        for (int k = lane; k < 1024; k += 64) s += mvl[(size_t)br * 6144 + 3 * 1024 + k] * (r < 16 ? wg[k * 4 + (r & 3)] : we[k * 16 + r - 16]);
        s = wave_sum(s);
        if (lane == 0) ((float*)(ws + WS_SL))[layer * 256 + br * 32 + r] = s + (r < 16 ? bg[r & 3] : be[r - 16]);
    }
}
__device__ __forceinline__ void fold_odd_inproj(const Ptrs& P, int bid, int nblk) {
    unsigned char* ws = P.ws;
    const float* mv1 = (const float*)(ws + WS_MODV) + (size_t)5 * 6144; const float* gain = P.in[6] + D;
    const bf16* wt = (const bf16*)(ws + WS_WINO); bf16* wf = (bf16*)(ws + WS_WINOF);
    for (int e = bid * 256 + threadIdx.x; e < 5 * 80 * 128; e += nblk * 256) {
        const int k8 = (e & 127) * 8, n0 = ((e >> 7) % 80) * 16, b = e / (80 * 128);
        const f32x4 g0 = *(const f32x4*)(gain + k8), g1 = *(const f32x4*)(gain + k8 + 4), s0 = *(const f32x4*)(mv1 + (size_t)b * 6144 + 1024 + k8), s1 = *(const f32x4*)(mv1 + (size_t)b * 6144 + 1024 + k8 + 4);
        const float a0 = g0.x * (1.f + s0.x), a1 = g0.y * (1.f + s0.y), a2 = g0.z * (1.f + s0.z), a3 = g0.w * (1.f + s0.w), a4 = g1.x * (1.f + s1.x), a5 = g1.y * (1.f + s1.y), a6 = g1.z * (1.f + s1.z), a7 = g1.w * (1.f + s1.w);
        u32x4 w[16];
#pragma unroll
        for (int i = 0; i < 16; ++i) w[i] = *(const u32x4*)(wt + (size_t)(n0 + i) * 1024 + k8);
#pragma unroll
        for (int i = 0; i < 16; ++i) {
            u32x4 o;
            o.x = pk2(__uint_as_float(w[i].x << 16) * a0, __uint_as_float(w[i].x & 0xffff0000u) * a1); o.y = pk2(__uint_as_float(w[i].y << 16) * a2, __uint_as_float(w[i].y & 0xffff0000u) * a3);
            o.z = pk2(__uint_as_float(w[i].z << 16) * a4, __uint_as_float(w[i].z & 0xffff0000u) * a5); o.w = pk2(__uint_as_float(w[i].w << 16) * a6, __uint_as_float(w[i].w & 0xffff0000u) * a7);
            *(u32x4*)(wf + ((size_t)b * 1280 + n0 + i) * 1024 + k8) = o;
        }
    }
    const int gw = bid * 4 + (threadIdx.x >> 6), NGW = nblk * 4, lane = threadIdx.x & 63;
    for (int t = gw; t < 5 * 1280; t += NGW) {
        const int n = t % 1280, b = t / 1280;
        const u32x4 w0 = *(const u32x4*)(wt + (size_t)n * 1024 + 8 * lane), w1 = *(const u32x4*)(wt + (size_t)n * 1024 + 512 + 8 * lane);
        const float* sh = mv1 + (size_t)b * 6144;
        const f32x4 p0 = *(const f32x4*)(sh + 8 * lane), p1 = *(const f32x4*)(sh + 8 * lane + 4), p2 = *(const f32x4*)(sh + 512 + 8 * lane), p3 = *(const f32x4*)(sh + 512 + 8 * lane + 4);
        float s = p0.x * __uint_as_float(w0.x << 16) + p0.y * __uint_as_float(w0.x & 0xffff0000u) + p0.z * __uint_as_float(w0.y << 16) + p0.w * __uint_as_float(w0.y & 0xffff0000u)
                + p1.x * __uint_as_float(w0.z << 16) + p1.y * __uint_as_float(w0.z & 0xffff0000u) + p1.z * __uint_as_float(w0.w << 16) + p1.w * __uint_as_float(w0.w & 0xffff0000u)
                + p2.x * __uint_as_float(w1.x << 16) + p2.y * __uint_as_float(w1.x & 0xffff0000u) + p2.z * __uint_as_float(w1.y << 16) + p2.w * __uint_as_float(w1.y & 0xffff0000u)
                + p3.x * __uint_as_float(w1.z << 16) + p3.y * __uint_as_float(w1.z & 0xffff0000u) + p3.z * __uint_as_float(w1.w << 16) + p3.w * __uint_as_float(w1.w & 0xffff0000u);
        s = wave_sum(s);
        if (lane == 0) ((float*)(ws + WS_BI))[t] = s;
    }
}
typedef float f32x4a __attribute__((ext_vector_type(4)));
__device__ __forceinline__ float xq_sum(float x) {
    x += __shfl_xor(x, 16); x += __shfl_xor(x, 32); return x;
}
__device__ __forceinline__ void ph_moe_route(const Ptrs& P, LAS unsigned char* smem, int bid, int nblk, int layer, int nrows) {
    unsigned char* ws = P.ws;
    const int tid = threadIdx.x, lane = tid & 63, wave = tid >> 6, tk = lane & 15, kq = lane >> 4;
    const float* modv_layer = (const float*)(ws + WS_MODV) + (size_t)layer * 5 * 6144;
    const float* gain = P.in[7] + layer * D;
    const bf16* xs = (const bf16*)(ws + WS_R4);
    bf16* H = (bf16*)(ws + WS_R1);
    int* cnt = (int*)(ws + WS_CTL) + CTL_CNT + layer * 2048; int* list = (int*)(ws + WS_LIST); float* wts = (float*)(ws + WS_WTS);
    LAS float* part = (LAS float*)smem;
    for (int task = xcd_vid(bid, nblk); task < nrows / 16; task += nblk) {
        const int row0 = task * 16; const int row = row0 + tk;
        const int br = row0 < NL ? row0 / S : 4;
        const bf16* xr = xs + (size_t)row * D;
        const bf16* wt = (const bf16*)(ws + WS_WRT + layer * WRT_STRIDE) + (size_t)br * 2 * 32 * 1024;
        f32x4a acc0 = {0.f, 0.f, 0.f, 0.f}, acc1 = {0.f, 0.f, 0.f, 0.f};
        float ss = 0.f;
#pragma unroll 4
        for (int s = 8 * wave; s < 8 * wave + 8; ++s) {
            const int k = 32 * s + 8 * kq;
            const u32x4 xh = *(const u32x4*)(xr + k);
            { const float f0 = __uint_as_float(xh.x << 16), f1 = __uint_as_float(xh.x & 0xffff0000u), f2 = __uint_as_float(xh.y << 16), f3 = __uint_as_float(xh.y & 0xffff0000u);
              const float f4 = __uint_as_float(xh.z << 16), f5 = __uint_as_float(xh.z & 0xffff0000u), f6 = __uint_as_float(xh.w << 16), f7 = __uint_as_float(xh.w & 0xffff0000u);
              ss += (f0 * f0 + f1 * f1) + (f2 * f2 + f3 * f3) + (f4 * f4 + f5 * f5) + (f6 * f6 + f7 * f7); }
            const bf16x8 bh = __builtin_bit_cast(bf16x8, xh);
            const bf16x8 a0h = *(const bf16x8*)(wt + (size_t)tk * 1024 + k), a1h = *(const bf16x8*)(wt + (size_t)(16 + tk) * 1024 + k);
            const bf16x8 a0l = *(const bf16x8*)(wt + (size_t)(32 + tk) * 1024 + k), a1l = *(const bf16x8*)(wt + (size_t)(48 + tk) * 1024 + k);
            acc0 = __builtin_amdgcn_mfma_f32_16x16x32_bf16(a0h, bh, acc0, 0, 0, 0); acc1 = __builtin_amdgcn_mfma_f32_16x16x32_bf16(a1h, bh, acc1, 0, 0, 0);
            acc0 = __builtin_amdgcn_mfma_f32_16x16x32_bf16(a0l, bh, acc0, 0, 0, 0); acc1 = __builtin_amdgcn_mfma_f32_16x16x32_bf16(a1l, bh, acc1, 0, 0, 0);
        }
#pragma unroll
        for (int j = 0; j < 4; ++j) { part[(wave * 9 + j) * 64 + lane] = acc0[j]; part[(wave * 9 + 4 + j) * 64 + lane] = acc1[j]; }
        part[(wave * 9 + 8) * 64 + lane] = ss;
        __syncthreads();
        float tot[9];
#pragma unroll
        for (int j = 0; j < 9; ++j) tot[j] = (part[j * 64 + lane] + part[(9 + j) * 64 + lane]) + (part[(18 + j) * 64 + lane] + part[(27 + j) * 64 + lane]);
        const float rstd = rsqrtf(xq_sum(tot[8]) * (1.f / D) + EPS);
        if (wave == 0) {
            const float* sl = (const float*)(ws + WS_SL) + layer * 256 + br * 32;
            float gl[4], el[4];
#pragma unroll
            for (int j = 0; j < 4; ++j) { gl[j] = tot[j] * rstd + sl[j]; el[j] = tot[4 + j] * rstd + sl[16 + 4 * kq + j]; }
            int gi = 0; float gm = gl[0];
#pragma unroll
            for (int j = 1; j < 4; ++j) if (gl[j] > gm) { gm = gl[j]; gi = j; }
            if (gi == kq) {
                float gs = 0.f;
#pragma unroll
                for (int j = 0; j < 4; ++j) gs += expf(gl[j] - gm);
                const float gwt = 1.f / gs;
                int i0 = 0; float e0 = el[0];
#pragma unroll
                for (int j = 1; j < 4; ++j) if (el[j] > e0) { e0 = el[j]; i0 = j; }
                int i1 = -1; float e1 = -INFINITY;
#pragma unroll
                for (int j = 0; j < 4; ++j) if (j != i0 && el[j] > e1) { e1 = el[j]; i1 = j; }
                const float p1 = expf(e1 - e0); const float w0 = gwt / (1.f + p1), w1 = gwt * p1 / (1.f + p1);
                const int ea = i0 < i1 ? i0 : i1, eb = i0 < i1 ? i1 : i0;
                const int pidx = ea == 0 ? eb - 1 : (ea == 1 ? eb + 1 : 5);
                const int cls = gi * 6 + pidx;
                wts[(size_t)row * 2] = i0 < i1 ? w0 : w1; wts[(size_t)row * 2 + 1] = i0 < i1 ? w1 : w0;
                const int pos = atomicAdd(&cnt[cls * 64], 1);
                list[(size_t)cls * NT + pos] = row;
            }
        }
        const float* mv = modv_layer + (size_t)br * 6144;
        float rs[4];
#pragma unroll
        for (int r = 0; r < 4; ++r) rs[r] = __shfl(rstd, 4 * wave + r);
        u32x2 xv[4][4];
#pragma unroll
        for (int r = 0; r < 4; ++r) {
            const bf16* xp = xs + (size_t)(row0 + 4 * wave + r) * D + 4 * lane;
#pragma unroll
            for (int jq = 0; jq < 4; ++jq) xv[r][jq] = *(const u32x2*)(xp + 256 * jq);
        }
#pragma unroll
        for (int jq = 0; jq < 4; ++jq) {
            const int k = 4 * lane + 256 * jq;
            const f32x4 g = *(const f32x4*)(gain + k), sc = *(const f32x4*)(mv + 4 * 1024 + k), sh = *(const f32x4*)(mv + 3 * 1024 + k);
            const f32x4 a = {g.x * (1.f + sc.x), g.y * (1.f + sc.y), g.z * (1.f + sc.z), g.w * (1.f + sc.w)};
#pragma unroll
            for (int r = 0; r < 4; ++r) {
                const u32x2 xw = xv[r][jq]; const f32x4 x = {__uint_as_float(xw.x << 16), __uint_as_float(xw.x & 0xffff0000u), __uint_as_float(xw.y << 16), __uint_as_float(xw.y & 0xffff0000u)};
                u32x2 o = {pk2(x.x * rs[r] * a.x + sh.x, x.y * rs[r] * a.y + sh.y), pk2(x.z * rs[r] * a.z + sh.z, x.w * rs[r] * a.w + sh.w)};
                *(u32x2*)(H + (size_t)(row0 + 4 * wave + r) * D + k) = o;
            }
        }
        __syncthreads();
    }
}

__device__ __forceinline__ void moe_tiles_init(const int* cnt, LAS int* tile0) {
    __syncthreads();
    if (threadIdx.x < 24) tile0[192 + threadIdx.x] = cnt[threadIdx.x * 64];
    __syncthreads();
    if (threadIdx.x == 0) { int a = 0; for (int c = 0; c < 24; ++c) { tile0[c] = a; a += (tile0[192 + c] + 127) >> 7; } tile0[24] = a; }
    __syncthreads();
}
struct GatherRows {
    const bf16* H; const int* lst; int n; unsigned vo[4];
    __device__ __forceinline__ void init(int w, int rl, const int (&co)[4]) {
#pragma unroll
        for (int i = 0; i < 4; ++i) { const int r = 32 * w + 8 * i + rl; vo[i] = (unsigned)(((size_t)lst[r < n ? r : 0] * D + co[i]) * 2); }
    }
    __device__ __forceinline__ const bf16* sb(int i, int kt) const { return H + kt * 64; }
};
struct SplitKRows {
    const bf16* b0; const bf16* b1; size_t ld; int ksplit; int w; unsigned vo[4];
    __device__ __forceinline__ SplitKRows(const bf16* b0_, const bf16* b1_, size_t ld_, int ksplit_) : b0(b0_), b1(b1_), ld(ld_), ksplit(ksplit_), w(0) {}
    __device__ __forceinline__ void init(int w_, int rl, const int (&co)[4]) { w = w_;
#pragma unroll
        for (int i = 0; i < 4; ++i) vo[i] = (unsigned)((rl * ld + co[i]) * 2); }
    __device__ __forceinline__ const bf16* sb(int i, int kt) const { return (kt < ksplit ? b0 + kt * 64 : b1 + (kt - ksplit) * 64) + (size_t)(32 * w + 8 * i) * ld; }
};
struct EpiMoe1 {
    typedef NoPre Pre;
    __device__ __forceinline__ void prefetch(Pre&, int, int, int, int) const {}
    bf16* hid; const int* lst; int n; const float* wts; int nt;
    __device__ __forceinline__ bool swapped() const { return false; }
    __device__ __forceinline__ void operator()(f32x16 (&acc)[2][2], int fb, int tb, int l31, int hh, LAS unsigned char* wl, const Pre& pre) const {
        const int col = (nt >> 2) * 256 + 32 * (2 * (nt & 3) + (fb >> 6));
#pragma unroll 1
        for (int j = 0; j < 2; ++j) {
            const int r = tb + j * 32 + l31;
            const int tok = lst[r < n ? r : 0];
            const float w = wts[(size_t)tok * 2 + (nt >> 2)];
#pragma unroll
            for (int g = 0; g < 4; ++g) {
                float hv[4];
#pragma unroll
                for (int e = 0; e < 4; ++e) { const float a_ = j ? acc[0][1][4 * g + e] : acc[0][0][4 * g + e], u_ = j ? acc[1][1][4 * g + e] : acc[1][0][4 * g + e]; hv[e] = a_ / (1.f + __expf(-a_)) * u_ * w; }
                u32x2 v = {pk2(hv[0], hv[1]), pk2(hv[2], hv[3])}; *(LAS u32x2*)(wl + (32 * j + l31) * 80 + (8 * g + 4 * hh) * 2) = v;
            }
        }
        const int lane = l31 + 32 * hh, rr = lane >> 2, ch = lane & 3;
#pragma unroll
        for (int q = 0; q < 4; ++q) { const int R = 16 * q + rr; const u32x4 v = *(LAS u32x4*)(wl + R * 80 + ch * 16); *(u32x4*)(hid + (size_t)(tb + R) * 512 + col + ch * 8) = v; }
    }
};
__device__ __forceinline__ void ph_moe_stage1(const Ptrs& P, LAS unsigned char* smem, int bid, int nblk, int layer) {
    unsigned char* ws = P.ws;
    const int* cnt = (const int*)(ws + WS_CTL) + CTL_CNT + layer * 2048; const int* list = (const int*)(ws + WS_LIST);
    LAS int* tile0 = (LAS int*)(smem + GEMM_LDS);
    moe_tiles_init(cnt, tile0);
    const int lrow = threadIdx.x >> 3, kc = threadIdx.x & 7;
    const bf16* H = (const bf16*)(ws + WS_R1);
    const int nitems = tile0[24] * 8;
    for (int item = xcd_vid(bid, nblk); item < nitems; item += nblk) {
        const int tt = item >> 3, nt = item & 7;
        int c = 0; while (tile0[c + 1] <= tt) ++c;
        const int lt = tt - tile0[c], n = min(128, tile0[192 + c] - lt * 128);
        const int* lst = list + (size_t)c * NT + lt * 128;
        const int g = c / 6, pidx = c % 6; const int ea = pidx < 3 ? 0 : (pidx < 5 ? 1 : 2), eb = pidx < 3 ? pidx + 1 : (pidx < 5 ? pidx - 1 : 3);
        const int expert = g * 4 + (nt < 4 ? ea : eb);
        GatherRows af{H, lst, n, {0u, 0u, 0u, 0u}};
        AffineRows bf_((const bf16*)(ws + WS_WGU) + ((size_t)(layer * 16 + expert) * 512 + (nt & 3) * 128) * D, D);
        EpiMoe1 epi{(bf16*)(ws + WS_R3) + (size_t)tt * 128 * 512, lst, n, (const float*)(ws + WS_WTS), nt};
        gemm_tile<false>(af, bf_, D / 64, smem, epi);
    }
}
template <int LAYER>
struct EpiMoe2 {
    typedef RmwPre<true> Pre;
    bf16* xs; float* out; float* rss; const float* modv_layer; LAS const int* lst; int n; int nt;
    __device__ __forceinline__ bool swapped() const { return false; }
    __device__ __forceinline__ auto rowfn(int fb, int tb) const {
        const int c0 = nt * 128 + fb; const EpiMoe2 e = *this;
        return [=](int R, const void*& sp, void*& dp, const float*& gp, int& tk) {
            const int r = tb + R; if (r >= e.n) return false;
            const int tok = e.lst[r]; tk = tok;
            sp = e.xs + (size_t)tok * D + c0;
            if (LAYER == 0) dp = e.xs + (size_t)tok * D + c0; else dp = e.out + (size_t)tok * D + c0;
            gp = e.modv_layer + (size_t)(tok < NL ? tok / S : 4) * 6144 + 5 * 1024 + c0; return true; };
    }
    __device__ __forceinline__ void prefetch(Pre& pre, int fb, int tb, int l31, int hh) const { rmw_prefetch<true>(pre, rowfn(fb, tb), l31, hh); }
    __device__ __forceinline__ void operator()(f32x16 (&acc)[2][2], int fb, int tb, int l31, int hh, LAS unsigned char* wl, const Pre& pre) const {
        rmw_finish<true, LAYER == 0, LAYER == 0>(acc, pre, rowfn(fb, tb), l31, hh, wl, rss);
    }
};
__device__ __forceinline__ void ph_moe_stage2(const Ptrs& P, LAS unsigned char* smem, int bid, int nblk, int layer) {
    unsigned char* ws = P.ws;
    const int* cnt = (const int*)(ws + WS_CTL) + CTL_CNT + layer * 2048; const int* list = (const int*)(ws + WS_LIST);
    LAS int* tile0 = (LAS int*)(smem + GEMM_LDS);
    moe_tiles_init(cnt, tile0);
    const int lrow = threadIdx.x >> 3, kc = threadIdx.x & 7;
    const int nitems = tile0[24] * 8;
    for (int item = xcd_vid(bid, nblk); item < nitems; item += nblk) {
        const int tt = item >> 3, nt = item & 7;
        int c = 0; while (tile0[c + 1] <= tt) ++c;
        const int lt = tt - tile0[c], n = min(128, tile0[192 + c] - lt * 128);
        const int* lst = list + (size_t)c * NT + lt * 128;
        const int g = c / 6, pidx = c % 6; const int ea = pidx < 3 ? 0 : (pidx < 5 ? 1 : 2), eb = pidx < 3 ? pidx + 1 : (pidx < 5 ? pidx - 1 : 3);
        AffineRows af((const bf16*)(ws + WS_R3) + (size_t)tt * 128 * 512, 512);
        const bf16* wd = (const bf16*)(ws + WS_WD);
        SplitKRows bf_(wd + ((size_t)(layer * 16 + g * 4 + ea) * 1024 + nt * 128) * 256, wd + ((size_t)(layer * 16 + g * 4 + eb) * 1024 + nt * 128) * 256, 256, 4);
        LAS int* toks = (LAS int*)(smem + GEMM_LDS + 256);
        __syncthreads();
        if (threadIdx.x < 128) toks[threadIdx.x] = lst[threadIdx.x < n ? threadIdx.x : 0];
        if (layer == 0) { EpiMoe2<0> epi{(bf16*)(ws + WS_R4), P.out, (float*)(ws + WS_RSS), (const float*)(ws + WS_MODV), toks, n, nt}; gemm_tile<false>(af, bf_, 8, smem, epi); }
        else { EpiMoe2<1> epi{(bf16*)(ws + WS_R4), P.out, nullptr, (const float*)(ws + WS_MODV) + (size_t)5 * 6144, toks, n, nt}; gemm_tile<false>(af, bf_, 8, smem, epi); }
    }
}

constexpr size_t GLA_ST = 8192;
constexpr size_t WS_DEC = WS_WTS + (size_t)NT * 2 * 4;
static_assert(WS_DEC + (size_t)32 * 68 * 64 * 4 <= 256 * MiB, "ws dec");
__device__ __forceinline__ void gla_chunk_geom(int b, int M, size_t& row0, int& vcol0, int& c0, int& c1) {
    if (M < 4) { row0 = (size_t)NL + b * CL + 64 * M; vcol0 = S + 64 * M; c0 = M; c1 = 3 - M; }
    else { const int Ml = M - 4; row0 = (size_t)b * S + 64 * Ml; vcol0 = 64 * Ml; c0 = 4 + Ml; c1 = 4 + 63 - Ml; }
}
template <bool PASS_C>
__device__ __forceinline__ float gla_prep(const float (&gw)[16], float gb, int dir, LAS unsigned char* out, LAS const unsigned char* qraw, LAS const unsigned char* kraw, LAS const float* lrs, LAS float* tot) {
    const int tid = threadIdx.x, k = tid & 63, grp = tid >> 6;
    float gl[16];
#pragma unroll
    for (int j = 0; j < 16; ++j) {
        const int p = 16 * grp + j; float z = gb;
#pragma unroll
        for (int r4 = 0; r4 < 4; ++r4) { const f32x4 l4 = *(LAS const f32x4*)(lrs + p * 16 + r4 * 4); z += l4.x * gw[4 * r4] + l4.y * gw[4 * r4 + 1] + l4.z * gw[4 * r4 + 2] + l4.w * gw[4 * r4 + 3]; }
        gl[j] = (fminf(z, 0.f) - __logf(1.f + __expf(-fabsf(z)))) * (1.f / 16.f);
    }
    if (dir == 0) {
#pragma unroll
        for (int j = 1; j < 16; ++j) gl[j] += gl[j - 1];
        tot[grp * 64 + k] = gl[15];
    } else {
#pragma unroll
        for (int j = 14; j >= 0; --j) gl[j] += gl[j + 1];
        tot[grp * 64 + k] = gl[0];
    }
    __syncthreads();
    const float t0 = tot[k], t1 = tot[64 + k], t2 = tot[128 + k], t3 = tot[192 + k];
    const float bend = t0 + t1 + t2 + t3;
    float offs;
    if (dir == 0) offs = grp == 0 ? 0.f : grp == 1 ? t0 : grp == 2 ? t0 + t1 : t0 + t1 + t2;
    else offs = grp == 3 ? 0.f : grp == 2 ? t3 : grp == 1 ? t3 + t2 : t3 + t2 + t1;
    if (PASS_C) {
#pragma unroll
        for (int j = 0; j < 16; ++j) {
            const int p = 16 * grp + j; const float bp = gl[j] + offs;
            const float q = bf2f(*(LAS const bf16*)(qraw + p * 128 + k * 2)) * 0.125f, kk = bf2f(*(LAS const bf16*)(kraw + p * 128 + k * 2));
            *(LAS bf16*)(out + p * 144 + k * 2) = f2bf(q * __expf(bp));
            *(LAS bf16*)(out + 9216 + p * 144 + k * 2) = f2bf(q * __expf(bp - bend));
            *(LAS bf16*)(out + 18432 + p * 144 + k * 2) = f2bf(kk * __expf(bend - bp));
        }
    } else {
        float kt[16];
#pragma unroll
        for (int j = 0; j < 16; ++j) { const int p = 16 * grp + j; const float bp = gl[j] + offs; kt[j] = bf2f(*(LAS const bf16*)(kraw + p * 128 + k * 2)) * __expf(bend - bp); }
        u32x4 w0 = {pk2(kt[0], kt[1]), pk2(kt[2], kt[3]), pk2(kt[4], kt[5]), pk2(kt[6], kt[7])}, w1 = {pk2(kt[8], kt[9]), pk2(kt[10], kt[11]), pk2(kt[12], kt[13]), pk2(kt[14], kt[15])};
        *(LAS u32x4*)(out + k * 144 + grp * 32) = w0; *(LAS u32x4*)(out + k * 144 + grp * 32 + 16) = w1;
    }
    return __expf(bend);
}
#define GLA_LOAD_GW(gw, gb, dir, h) do { _Pragma("unroll") for (int r_ = 0; r_ < 16; ++r_) gw[r_] = P.in[10][((dir) * 16 + r_) * 256 + (h) * 64 + (threadIdx.x & 63)]; gb = P.in[11][(dir) * 256 + (h) * 64 + (threadIdx.x & 63)]; } while (0)

constexpr int GA_KTT = 0, GA_VT = 9216, GA_KRAW = GA_VT + 128 * 144, GA_LRS = GA_KRAW + 8192, GA_TOT = GA_LRS + 4096, GLA_A_LDS = GA_TOT + 1024;
__device__ __forceinline__ void gla_pass_a_item(const Ptrs& P, int item, LAS unsigned char* lds) {
    const int tid = threadIdx.x, lane = tid & 63, wave = tid >> 6, l31 = lane & 31, hh = lane >> 5;
    const int M = item % 68, dir = (item / 68) & 1, h = (item / 136) & 3, b = item / 544;
    size_t row0; int vcol0, c0, c1; gla_chunk_geom(b, M, row0, vcol0, c0, c1);
    const int sidx = ((b * 4 + h) * 2 + dir) * 68 + (dir ? c1 : c0);
    const unsigned char* r3 = P.ws + WS_R3;
    u32x4 vt[4], kr[2]; f32x4 lr; float gw[16], gb;
    { const bf16* gvt = (const bf16*)(r3 + R3_GV) + (size_t)(b * 4 + h) * 128 * VT_LD + vcol0;
#pragma unroll
      for (int i = 0; i < 4; ++i) { const int c = tid + 256 * i; vt[i] = *(const u32x4*)(gvt + (size_t)(c >> 3) * VT_LD + (c & 7) * 8); }
      const bf16* gk = (const bf16*)(r3 + R3_GK) + row0 * 256 + h * 64;
#pragma unroll
      for (int i = 0; i < 2; ++i) { const int c = tid + 256 * i; kr[i] = *(const u32x4*)(gk + (size_t)(c >> 3) * 256 + (c & 7) * 8); }
      lr = *(const f32x4*)((const float*)(r3 + R3_LR) + (row0 + (tid >> 2)) * 32 + dir * 16 + (tid & 3) * 4);
      GLA_LOAD_GW(gw, gb, dir, h); }
#pragma unroll
    for (int i = 0; i < 4; ++i) { const int c = tid + 256 * i; *(LAS u32x4*)(lds + GA_VT + (c >> 3) * 144 + (c & 7) * 16) = vt[i]; }
#pragma unroll
    for (int i = 0; i < 2; ++i) { const int c = tid + 256 * i; *(LAS u32x4*)(lds + GA_KRAW + (c >> 3) * 128 + (c & 7) * 16) = kr[i]; }
    *(LAS f32x4*)(lds + GA_LRS + tid * 16) = lr;
    __syncthreads();
    const float dec = gla_prep<false>(gw, gb, dir, lds + GA_KTT, lds + GA_KRAW, lds + GA_KRAW, (LAS const float*)(lds + GA_LRS), (LAS float*)(lds + GA_TOT));
    if (tid < 64) ((float*)(P.ws + WS_DEC))[(size_t)sidx * 64 + tid] = dec;
    __syncthreads();
    f32x16 acc[2];
#pragma unroll
    for (int kt = 0; kt < 2; ++kt)
#pragma unroll
        for (int r = 0; r < 16; ++r) acc[kt][r] = 0.f;
#pragma unroll
    for (int ps = 0; ps < 4; ++ps) {
        const bf16x8 vf = *(LAS bf16x8*)(lds + GA_VT + (32 * wave + l31) * 144 + ps * 32 + hh * 16);
#pragma unroll
        for (int kt = 0; kt < 2; ++kt) { const bf16x8 kf = *(LAS bf16x8*)(lds + GA_KTT + (32 * kt + l31) * 144 + ps * 32 + hh * 16); acc[kt] = __builtin_amdgcn_mfma_f32_32x32x16_bf16(kf, vf, acc[kt], 0, 0, 0); }
    }
    bf16* ds = (bf16*)(P.ws + WS_R1) + (size_t)sidx * GLA_ST + (size_t)(32 * wave + l31) * 64 + 4 * hh;
#pragma unroll
    for (int kt = 0; kt < 2; ++kt)
#pragma unroll
        for (int g = 0; g < 4; ++g) { u32x2 v = {pk2(acc[kt][4 * g], acc[kt][4 * g + 1]), pk2(acc[kt][4 * g + 2], acc[kt][4 * g + 3])}; *(u32x2*)(ds + kt * 32 + 8 * g) = v; }
    __syncthreads();
}
__device__ __forceinline__ void ph_gla_a(const Ptrs& P, LAS unsigned char* smem, int bid, int nblk) {
    for (int item = bid; item < 4 * 4 * 2 * 68; item += nblk) gla_pass_a_item(P, item, smem);
}
__device__ __forceinline__ void gla_pass_b(const Ptrs& P, int gtid, int nthreads) {
    const bf16* DS = (const bf16*)(P.ws + WS_R1); bf16* SIN = (bf16*)(P.ws + WS_R4); const float* DEC = (const float*)(P.ws + WS_DEC);
    for (int idx = gtid; idx < 32 * 2048; idx += nthreads) {
        const int bhd = idx >> 11, e4 = idx & 2047, k4 = (e4 & 15) * 4;
        float s0 = 0.f, s1 = 0.f, s2 = 0.f, s3 = 0.f;
#pragma unroll 17
        for (int c = 0; c < 68; ++c) {
            const size_t sidx = (size_t)bhd * 68 + c;
            u32x2 o = {pk2(s0, s1), pk2(s2, s3)};
            *(u32x2*)(SIN + sidx * GLA_ST + e4 * 4) = o;
            const f32x4 d = *(const f32x4*)(DEC + sidx * 64 + k4);
            const u32x2 w = *(const u32x2*)(DS + sidx * GLA_ST + e4 * 4);
            s0 = s0 * d.x + __uint_as_float(w.x << 16); s1 = s1 * d.y + __uint_as_float(w.x & 0xffff0000u);
            s2 = s2 * d.z + __uint_as_float(w.y << 16); s3 = s3 * d.w + __uint_as_float(w.y & 0xffff0000u);
        }
    }
}

constexpr int GC_QT = 0, GC_QA = 9216, GC_KT = 18432, GC_VT = 27648, GC_QRAW = GC_VT + 128 * 136, GC_KRAW = GC_QRAW + 8192, GC_LRS = GC_KRAW + 8192, GC_TOT = GEMM_LDS + 256, GC_XCH = GC_TOT + 1024;
static_assert(GC_LRS + 4096 <= GEMM_LDS, "gla c lds");
__device__ __forceinline__ void gla_pass_c_item(const Ptrs& P, int item, LAS unsigned char* lds) {
    const int tid = threadIdx.x, lane = tid & 63, wave = tid >> 6, l31 = lane & 31, hh = lane >> 5, pt = wave & 1, vh = wave >> 1;
    const int M = item % 68, h = (item / 68) & 3, b = item / 272;
    size_t row0; int vcol0, c0, c1; gla_chunk_geom(b, M, row0, vcol0, c0, c1);
    const unsigned char* r3 = P.ws + WS_R3;
    u32x4 vt[4], qr[2], kr[2]; f32x4 lr0, lr1; float gw[16], gb;
    { const bf16* gvt = (const bf16*)(r3 + R3_GV) + (size_t)(b * 4 + h) * 128 * VT_LD + vcol0;
#pragma unroll
      for (int i = 0; i < 4; ++i) { const int c = tid + 256 * i; vt[i] = *(const u32x4*)(gvt + (size_t)(c >> 3) * VT_LD + (c & 7) * 8); }
      const bf16* gq = (const bf16*)(r3 + R3_GQ) + row0 * 256 + h * 64; const bf16* gk = (const bf16*)(r3 + R3_GK) + row0 * 256 + h * 64;
#pragma unroll
      for (int i = 0; i < 2; ++i) { const int c = tid + 256 * i; qr[i] = *(const u32x4*)(gq + (size_t)(c >> 3) * 256 + (c & 7) * 8); kr[i] = *(const u32x4*)(gk + (size_t)(c >> 3) * 256 + (c & 7) * 8); }
      const float* lrp = (const float*)(r3 + R3_LR) + (row0 + (tid >> 2)) * 32 + (tid & 3) * 4;
      lr0 = *(const f32x4*)lrp; lr1 = *(const f32x4*)(lrp + 16);
      GLA_LOAD_GW(gw, gb, 0, h); }
#pragma unroll
    for (int i = 0; i < 4; ++i) { const int c = tid + 256 * i; LAS unsigned char* vp = lds + GC_VT + (c >> 3) * 136 + (c & 7) * 16; u32x2 lo = {vt[i].x, vt[i].y}, hi = {vt[i].z, vt[i].w}; *(LAS u32x2*)vp = lo; *(LAS u32x2*)(vp + 8) = hi; }
#pragma unroll
    for (int i = 0; i < 2; ++i) { const int c = tid + 256 * i; *(LAS u32x4*)(lds + GC_QRAW + (c >> 3) * 128 + (c & 7) * 16) = qr[i]; *(LAS u32x4*)(lds + GC_KRAW + (c >> 3) * 128 + (c & 7) * 16) = kr[i]; }
    *(LAS f32x4*)(lds + GC_LRS + tid * 16) = lr0;
    f32x16 o[2];
#pragma unroll
    for (int i = 0; i < 2; ++i)
#pragma unroll
        for (int r = 0; r < 16; ++r) o[i][r] = 0.f;
    const bf16* SIN = (const bf16*)(P.ws + WS_R4);
    __syncthreads();
#pragma unroll 1
    for (int dir = 0; dir < 2; ++dir) {
        const int sidx = ((b * 4 + h) * 2 + dir) * 68 + (dir ? c1 : c0);
        (void)gla_prep<true>(gw, gb, dir, lds + GC_QT, lds + GC_QRAW, lds + GC_KRAW, (LAS const float*)(lds + GC_LRS), (LAS float*)(lds + GC_TOT));
        bf16x8 sf[2][4];
#pragma unroll
        for (int i = 0; i < 2; ++i)
#pragma unroll
            for (int ks = 0; ks < 4; ++ks) sf[i][ks] = *(const bf16x8*)(SIN + (size_t)sidx * GLA_ST + (size_t)(64 * vh + 32 * i + l31) * 64 + 16 * ks + 8 * hh);
        if (dir == 0) { *(LAS f32x4*)(lds + GC_LRS + tid * 16) = lr1; GLA_LOAD_GW(gw, gb, 1, h); }
        __syncthreads();
        f32x16 at[2];
#pragma unroll
        for (int st = 0; st < 2; ++st) {
#pragma unroll
            for (int r = 0; r < 16; ++r) at[st][r] = 0.f;
#pragma unroll
            for (int ks = 0; ks < 4; ++ks) {
                const bf16x8 ka = *(LAS bf16x8*)(lds + GC_KT + (32 * st + l31) * 144 + ks * 32 + hh * 16);
                const bf16x8 qa = *(LAS bf16x8*)(lds + GC_QA + (32 * pt + l31) * 144 + ks * 32 + hh * 16);
                at[st] = __builtin_amdgcn_mfma_f32_32x32x16_bf16(ka, qa, at[st], 0, 0, 0);
            }
            const int pq = 32 * pt + l31;
#pragma unroll
            for (int r = 0; r < 16; ++r) { const int s_ = 32 * st + (r & 3) + 8 * (r >> 2) + 4 * hh; const bool ok = dir ? (s_ >= pq) : (s_ <= pq); if (!ok) at[st][r] = 0.f; }
        }
#pragma unroll
        for (int ks = 0; ks < 4; ++ks) {
            const bf16x8 qt = *(LAS bf16x8*)(lds + GC_QT + (32 * pt + l31) * 144 + ks * 32 + hh * 16);
#pragma unroll
            for (int i = 0; i < 2; ++i) o[i] = __builtin_amdgcn_mfma_f32_32x32x16_bf16(sf[i][ks], qt, o[i], 0, 0, 0);
        }
#pragma unroll
        for (int st = 0; st < 2; ++st)
#pragma unroll
            for (int s2 = 0; s2 < 2; ++s2) {
                u32x4 pw = {pk2(at[st][8 * s2], at[st][8 * s2 + 1]), pk2(at[st][8 * s2 + 2], at[st][8 * s2 + 3]), pk2(at[st][8 * s2 + 4], at[st][8 * s2 + 5]), pk2(at[st][8 * s2 + 6], at[st][8 * s2 + 7])};
                const bf16x8 pf = __builtin_bit_cast(bf16x8, pw);
#pragma unroll
                for (int i = 0; i < 2; ++i) {
                    LAS unsigned char* vp = lds + GC_VT + (64 * vh + 32 * i + l31) * 136 + (32 * st + 16 * s2 + 4 * hh) * 2;
                    const u32x2 v0 = *(LAS u32x2*)vp, v1 = *(LAS u32x2*)(vp + 16);
                    u32x4 vw = {v0.x, v0.y, v1.x, v1.y};
                    o[i] = __builtin_amdgcn_mfma_f32_32x32x16_bf16(__builtin_bit_cast(bf16x8, vw), pf, o[i], 0, 0, 0);
                }
            }
        __syncthreads();
    }
    float ss = 0.f;
#pragma unroll
    for (int i = 0; i < 2; ++i)
#pragma unroll
        for (int r = 0; r < 16; ++r) ss += o[i][r] * o[i][r];
    ss = xhalf_sum(ss);
    LAS float* xch = (LAS float*)(lds + GC_XCH);
    if (hh == 0) xch[(pt * 2 + vh) * 32 + l31] = ss;
    __syncthreads();
    ss += xch[(pt * 2 + (1 - vh)) * 32 + l31];
    const float rstd = rsqrtf(ss * (1.f / 128.f) + EPS);
    const size_t trow = row0 + 32 * pt + l31;
    const bf16* gr = (const bf16*)(P.ws + WS_R3 + R3_GR) + trow * 512 + h * 128 + 64 * vh + 4 * hh;
    bf16* mx = (bf16*)(P.ws + WS_R2) + trow * 1024 + h * 128 + 64 * vh + 4 * hh;
    const float* gn = P.in[12] + 64 * vh + 4 * hh;
#pragma unroll
    for (int i = 0; i < 2; ++i)
#pragma unroll
        for (int g = 0; g < 4; ++g) {
            const u32x2 rw = *(const u32x2*)(gr + i * 32 + 8 * g); const f32x4 gg = *(const f32x4*)(gn + i * 32 + 8 * g);
            const float r0 = __uint_as_float(rw.x << 16), r1 = __uint_as_float(rw.x & 0xffff0000u), r2 = __uint_as_float(rw.y << 16), r3_ = __uint_as_float(rw.y & 0xffff0000u);
            const float y0 = o[i][4 * g] * rstd * gg.x * (r0 / (1.f + __expf(-r0))), y1 = o[i][4 * g + 1] * rstd * gg.y * (r1 / (1.f + __expf(-r1)));
            const float y2 = o[i][4 * g + 2] * rstd * gg.z * (r2 / (1.f + __expf(-r2))), y3 = o[i][4 * g + 3] * rstd * gg.w * (r3_ / (1.f + __expf(-r3_)));
            u32x2 v = {pk2(y0, y1), pk2(y2, y3)}; *(u32x2*)(mx + i * 32 + 8 * g) = v;
        }
    __syncthreads();
}
__device__ __forceinline__ void ph_gla_c(const Ptrs& P, LAS unsigned char* smem, int bid, int nblk) {
    for (int item = bid; item < 4 * 4 * 68; item += nblk) gla_pass_c_item(P, item, smem);
}

#define XB_TMO      128
#define XB_XCNT(j)  (256  + 64 * (j))
#define XB_XSUB(j)  (1280 + 64 * (j))
#define XB_XGEN(j)  (2304 + 64 * (j))
#define XB_TOP      3328
#define XB_TOPGEN   3392
#define XB_SPIN_CAP (1u << 20)
constexpr int CTL_BAR = 4096;
__device__ __forceinline__ unsigned xb_ld(unsigned* p) { return __hip_atomic_load(p, __ATOMIC_RELAXED, __HIP_MEMORY_SCOPE_AGENT); }
__device__ __forceinline__ unsigned xb_add(unsigned* p, unsigned v) { return __hip_atomic_fetch_add(p, v, __ATOMIC_RELAXED, __HIP_MEMORY_SCOPE_AGENT); }
__device__ __forceinline__ unsigned xb_xcc_id() { return (unsigned)__builtin_amdgcn_s_getreg((3 << 11) | 20) & 0xFu; }
#define XB_SPIN(cond, bar) do { unsigned _sp = 0; while (cond) { __builtin_amdgcn_s_sleep(1); \
    if ((++_sp & 255u) == 0u) { if (xb_ld(&(bar)[XB_TMO])) break; if (_sp > XB_SPIN_CAP) { atomicAdd(&(bar)[XB_TMO], 1u); break; } } } } while (0)
struct XcdBarrier { unsigned* bar; unsigned x; volatile LAS unsigned* st; };
__device__ __forceinline__ XcdBarrier xcd_barrier_post(unsigned* bar, volatile LAS unsigned* st) {
    XcdBarrier b; b.bar = bar; b.x = xb_xcc_id(); b.st = st;
    if (threadIdx.x == 0) (void)xb_add(&bar[XB_XCNT(b.x)], 1u);
    return b;
}
__device__ __forceinline__ void xcd_barrier_complete(unsigned* bar, unsigned x, unsigned& nloc, unsigned& nx) {
    const unsigned G = gridDim.x * gridDim.y * gridDim.z;
    unsigned sum, cnt, mine, sp = 0u;
    for (;;) {
        sum = 0u; cnt = 0u; mine = 0u;
#pragma unroll
        for (unsigned j = 0; j < 16; ++j) { const unsigned c = xb_ld(&bar[XB_XCNT(j)]); sum += c; cnt += (c > 0u) ? 1u : 0u; mine = (j == x) ? c : mine; }
        if (sum == G) break;
        __builtin_amdgcn_s_sleep(1);
        if ((++sp & 255u) == 0u) { if (xb_ld(&bar[XB_TMO])) break; if (sp > XB_SPIN_CAP) { atomicAdd(&bar[XB_TMO], 1u); break; } }
    }
    nloc = mine > 0u ? mine : 1u; nx = cnt > 0u ? cnt : 1u;
}
__device__ __forceinline__ void xcd_barrier(const XcdBarrier& b) {
    asm volatile("s_waitcnt vmcnt(0)" ::: "memory");
    __syncthreads();
    if (threadIdx.x == 0) {
        unsigned* bar = b.bar;
        __builtin_amdgcn_s_waitcnt(0);
        unsigned nloc = b.st[0], nx = b.st[1];
        if (nloc == 0u) { xcd_barrier_complete(bar, b.x, nloc, nx); b.st[0] = nloc; b.st[1] = nx; }
        const unsigned old = xb_add(&bar[XB_XSUB(b.x)], 1u);
        const unsigned gen = old / nloc;
        if (old + 1u == (gen + 1u) * nloc) {
            __builtin_amdgcn_fence(__ATOMIC_RELEASE, "agent");
            asm volatile("s_waitcnt vmcnt(0)" ::: "memory");
            const unsigned og = xb_add(&bar[XB_TOP], 1u);
            const unsigned tg = og / nx;
            if (og + 1u == (tg + 1u) * nx) xb_add(&bar[XB_TOPGEN], 1u);
            else XB_SPIN(xb_ld(&bar[XB_TOPGEN]) == tg, bar);
            __builtin_amdgcn_fence(__ATOMIC_ACQUIRE, "agent");
            xb_add(&bar[XB_XGEN(b.x)], 1u);
            asm volatile("s_waitcnt vmcnt(0)" ::: "memory");
        } else {
            XB_SPIN(xb_ld(&bar[XB_XGEN(b.x)]) == gen, bar);
            __builtin_amdgcn_fence(__ATOMIC_ACQUIRE, "agent");
            asm volatile("s_waitcnt vmcnt(0)" ::: "memory");
        }
    }
    __syncthreads();
}

__device__ __forceinline__ void xcd_arrive(const XcdBarrier& b) {
    asm volatile("s_waitcnt vmcnt(0)" ::: "memory");
    __syncthreads();
    if (threadIdx.x == 0) {
        unsigned* bar = b.bar;
        __builtin_amdgcn_s_waitcnt(0);
        unsigned nloc = b.st[0], nx = b.st[1];
        if (nloc == 0u) { xcd_barrier_complete(bar, b.x, nloc, nx); b.st[0] = nloc; b.st[1] = nx; }
        const unsigned old = xb_add(&bar[XB_XSUB(b.x)], 1u);
        const unsigned gen = old / nloc;
        b.st[2] = gen;
        if (old + 1u == (gen + 1u) * nloc) {
            __builtin_amdgcn_fence(__ATOMIC_RELEASE, "agent");
            asm volatile("s_waitcnt vmcnt(0)" ::: "memory");
            const unsigned og = xb_add(&bar[XB_TOP], 1u);
            const unsigned tg = og / nx;
            if (og + 1u == (tg + 1u) * nx) xb_add(&bar[XB_TOPGEN], 1u);
            xb_add(&bar[XB_XGEN(b.x)], 1u);
            asm volatile("s_waitcnt vmcnt(0)" ::: "memory");
        }
    }
}
__device__ __forceinline__ void xcd_wait(const XcdBarrier& b) {
    __syncthreads();
    if (threadIdx.x == 0) {
        const unsigned gen = b.st[2];
        XB_SPIN(xb_ld(&b.bar[XB_TOPGEN]) == gen, b.bar);
        __builtin_amdgcn_fence(__ATOMIC_ACQUIRE, "agent");
        asm volatile("s_waitcnt vmcnt(0)" ::: "memory");
    }
    __syncthreads();
}

constexpr int N_PHASES = 18;
constexpr int SMEM_BYTES = GEMM_LDS + 2048;
struct Args { Ptrs P; int ph_lo, ph_hi; };
__global__ void __launch_bounds__(256, 2) fwd_megakernel(Args args) {
    __shared__ __attribute__((aligned(16))) unsigned char smem_raw[SMEM_BYTES];
    LAS unsigned char* smem = (LAS unsigned char*)smem_raw;
    const Ptrs& P = args.P;
    const int bid = blockIdx.x, nblk = gridDim.x;
    volatile LAS unsigned* bst = (volatile LAS unsigned*)(smem + GEMM_LDS + 128);
    if (threadIdx.x < 3) bst[threadIdx.x] = 0u;
    __syncthreads();
    XcdBarrier bar; bar.bar = (unsigned*)(P.ws + WS_CTL) + CTL_BAR; bar.x = 0; bar.st = bst;
    const bool multi = args.ph_hi - args.ph_lo > 1;
    if (multi) bar = xcd_barrier_post((unsigned*)(P.ws + WS_CTL) + CTL_BAR, bst);
    const int lo = args.ph_lo, hi = args.ph_hi;
#define PHASE(k, call) if (lo <= (k) && (k) < hi) { if ((k) > lo) xcd_barrier(bar); call; }
    PHASE(0, ph_prologue(P, smem, bid, nblk))
    PHASE(1, ph_modulate(P, 0, bid, nblk))
    PHASE(2, ph_even_inproj(P, smem, bid, nblk))
    PHASE(3, ph_gla_a(P, smem, bid, nblk))
    PHASE(4, gla_pass_b(P, bid * 256 + threadIdx.x, nblk * 256))
    if (lo <= 5 && 5 < hi) {
        if (5 > lo) xcd_arrive(bar);
        ph_dense_attn(P, smem, bid, nblk);
        if (5 > lo) xcd_wait(bar); else __syncthreads();
        ph_gla_c(P, smem, (bid + nblk - 128) % nblk, nblk);
    }
    PHASE(7, ph_outproj(P, smem, bid, nblk, 0, NT))
    PHASE(8, (ph_moe_route(P, smem, bid, nblk, 0, NT), fold_odd_inproj(P, bid, nblk), route_tables(P, 1, bid, nblk)))
    PHASE(9, ph_moe_stage1(P, smem, bid, nblk, 0))
    PHASE(10, ph_moe_stage2(P, smem, bid, nblk, 0))
    PHASE(12, ph_odd_inproj(P, smem, bid, nblk))
    PHASE(13, ph_swa_attn(P, smem, bid, nblk))
    PHASE(14, ph_outproj(P, smem, bid, nblk, 1, NL))
    PHASE(15, ph_moe_route(P, smem, bid, nblk, 1, NL))
    PHASE(16, ph_moe_stage1(P, smem, bid, nblk, 1))
    PHASE(17, ph_moe_stage2(P, smem, bid, nblk, 1))
#undef PHASE
}

#ifndef MK_LAUNCHES
#define MK_LAUNCHES 1
#endif
extern "C" void kernel_launch(void* const* d_in, const int* in_sizes, int n_in, void* d_out, int out_size, void* d_ws, size_t ws_size, hipStream_t stream) {
    static int grid = 0;
    if (grid == 0) {
        int dev = 0, cus = 0, per_cu = 0;
        hipGetDevice(&dev);
        hipDeviceGetAttribute(&cus, hipDeviceAttributeMultiprocessorCount, dev);
        hipOccupancyMaxActiveBlocksPerMultiprocessor(&per_cu, (const void*)fwd_megakernel, 256, 0);
        if (per_cu > 2) per_cu = 2;
        if (per_cu < 1) per_cu = 1;
        grid = cus * per_cu;
    }
    hipMemsetAsync((unsigned char*)d_ws + WS_CTL, 0, 65536, stream);
    Args a{};
    for (int i = 0; i < 27; ++i) a.P.in[i] = (const float*)d_in[i];
    a.P.out = (float*)d_out; a.P.ws = (unsigned char*)d_ws;
#if MK_LAUNCHES == 1
    a.ph_lo = 0; a.ph_hi = N_PHASES;
    void* kargs[] = {&a};
    hipLaunchCooperativeKernel((const void*)fwd_megakernel, dim3(grid), dim3(256), kargs, 0, stream);
#else
    for (int ph = 0; ph < N_PHASES; ++ph) { a.ph_lo = ph; a.ph_hi = ph + 1; hipLaunchKernelGGL(fwd_megakernel, dim3(grid), dim3(256), 0, stream, a); }
#endif
}
```

```cpp
#include <hip/hip_runtime.h>
#include <stdint.h>

typedef unsigned short bf16;
__device__ __forceinline__ float bf2f(bf16 v) { return __uint_as_float(((unsigned)v) << 16); }
__device__ __forceinline__ bf16 f2bf(float f) { unsigned u = __float_as_uint(f); return (bf16)((u + 0x7fffu + ((u >> 16) & 1u)) >> 16); }

constexpr int D = 1024, NB = 4, S = 4096, CL = 256, NL = NB * S, NC = NB * CL, NT = NL + NC;
constexpr int EVEN_IN = 2336, ODD_IN = 1280;
constexpr float EPS = 1e-6f;

__device__ __forceinline__ float silu(float x) { return x / (1.f + expf(-x)); }
__device__ __forceinline__ float wave_sum(float v) {
#pragma unroll
    for (int o = 1; o < 64; o <<= 1) v += __shfl_xor(v, o);
    return v;
}

#define LAS __attribute__((address_space(3)))
typedef short bf16x8 __attribute__((ext_vector_type(8)));
typedef float f32x16 __attribute__((ext_vector_type(16)));
typedef float f32x4 __attribute__((ext_vector_type(4)));
typedef unsigned u32x4 __attribute__((ext_vector_type(4)));
typedef unsigned u32x2 __attribute__((ext_vector_type(2)));
typedef __bf16 bf16x2_t __attribute__((ext_vector_type(2)));
typedef float f32x2_t __attribute__((ext_vector_type(2)));
__device__ __forceinline__ unsigned pk2(float lo, float hi) { f32x2_t v = {lo, hi}; bf16x2_t b = __builtin_convertvector(v, bf16x2_t); return __builtin_bit_cast(unsigned, b); }
__device__ __forceinline__ float xhalf_sum(float x) {
    auto t = __builtin_amdgcn_permlane32_swap(__float_as_uint(x), __float_as_uint(x), false, false);
    return __uint_as_float(t[0]) + __uint_as_float(t[1]);
}

constexpr float QSCALE = 0.125f * 1.4426950408889634f;
constexpr int NPAD_E = 2432;
constexpr int TILE_LDS = 128 * 128;
constexpr int GEMM_LDS = 4 * TILE_LDS;

__device__ __forceinline__ void transpose_item(const float* W, int K, int N, bf16* WT, int dst_row0, int k0, int n0, LAS float* scr, int lane) {
    float tv[32];
#pragma unroll
    for (int i = 0; i < 32; ++i) tv[i] = W[(size_t)(k0 + 2 * i + (lane >> 5)) * N + n0 + (lane & 31)];
#pragma unroll
    for (int i = 0; i < 32; ++i) scr[(2 * i + (lane >> 5)) * 33 + (lane & 31)] = tv[i];
    asm volatile("s_waitcnt lgkmcnt(0)" ::: "memory");
    const int c = lane & 7;
#pragma unroll
    for (int j = 0; j < 4; ++j) {
        const int n = (lane >> 3) + 8 * j; const LAS float* s = scr + (8 * c) * 33 + n;
        u32x4 o; o.x = pk2(s[0 * 33], s[1 * 33]); o.y = pk2(s[2 * 33], s[3 * 33]); o.z = pk2(s[4 * 33], s[5 * 33]); o.w = pk2(s[6 * 33], s[7 * 33]);
        *(u32x4*)(WT + (size_t)(dst_row0 + n) * K + k0 + 8 * c) = o;
    }
    asm volatile("s_waitcnt lgkmcnt(0)" ::: "memory");
}

struct Ptrs {
    const float* in[27];
    float* out;
    unsigned char* ws;
};

constexpr size_t MiB = 1u << 20;
constexpr size_t WS_CTL = 0;
constexpr size_t WS_MODV = 1 * MiB;
constexpr size_t WS_ROPE = WS_MODV + 256 * 1024;
constexpr size_t WS_WINE = 2 * MiB;
constexpr size_t WS_WOUTE = WS_WINE + (size_t)NPAD_E * 1024 * 2;
constexpr size_t WS_WINO = WS_WOUTE + 2 * MiB;
constexpr size_t WS_WOUTO = WS_WINO + (size_t)1280 * 1024 * 2;
constexpr size_t WS_WGU = WS_WOUTO + 2 * MiB;
constexpr size_t WS_WD = WS_WGU + 32 * MiB;
constexpr size_t WS_CTXS = WS_WD + 16 * MiB;
constexpr size_t WS_R1 = 66 * MiB;
constexpr size_t WS_R4 = WS_R1 + 34 * MiB;
constexpr size_t WS_R2 = WS_R4 + 34 * MiB;
constexpr size_t WS_R3 = WS_R2 + 34 * MiB;
static_assert(WS_CTXS + 4 * MiB <= WS_R1, "ws map");
constexpr size_t R3_GQ = 0, R3_GK = R3_GQ + (size_t)NT * 256 * 2, R3_GV = R3_GK + (size_t)NT * 256 * 2, R3_GR = R3_GV + (size_t)NT * 512 * 2,
                 R3_LR = R3_GR + (size_t)NT * 512 * 2, R3_AQ = R3_LR + (size_t)NT * 32 * 4, R3_AK = R3_AQ + (size_t)NT * 512 * 2, R3_AV = R3_AK + (size_t)NT * 128 * 2,
                 R3_END = R3_AV + (size_t)NT * 128 * 2;
static_assert(WS_R3 + R3_END <= 256 * MiB, "ws map end");
constexpr size_t R3_OQ = 0, R3_OK = R3_OQ + (size_t)NL * 1024 * 2, R3_OV = R3_OK + (size_t)NT * 128 * 2;
constexpr size_t WS_WRT = 250 * MiB, WS_SL = 252 * MiB;
constexpr size_t WRT_STRIDE = 768 * 1024;
constexpr size_t WS_RSS = 253 * MiB;
constexpr size_t WS_BI = WS_RSS + 128 * 1024;
constexpr size_t WS_WINOF = WS_R3 + 48 * MiB;
static_assert(WS_WINOF + (size_t)5 * 1280 * 1024 * 2 <= WS_R3 + R3_END && WS_BI + 5 * 1280 * 4 <= 254 * MiB && WS_WRT + 2 * WRT_STRIDE <= WS_SL, "fold buffers");

__device__ __forceinline__ void ph_prologue_gemv(const Ptrs& P, LAS unsigned char* smem, int bid, int nblk) {
    const int lane = threadIdx.x & 63, wave = __builtin_amdgcn_readfirstlane(threadIdx.x >> 6);
    unsigned char* ws = P.ws;
    constexpr int N_MODV_ITEMS = 2 * 192;
    for (int it = bid; it < N_MODV_ITEMS; it += nblk) {
        LAS float* sc = (LAS float*)smem;
        LAS float* red = (LAS float*)smem + 5 * 1024;
        __syncthreads();
        for (int i = threadIdx.x; i < 5 * 1024; i += 256) { const float cv = i < 4096 ? P.in[1][i] : P.in[3][i - 4096]; sc[i] = cv / (1.f + expf(-cv)); }
        const int layer = it / 192, n0 = (it % 192) * 32, c8 = lane & 7, rg = lane >> 3;
        const float* w = P.in[4] + (size_t)layer * D * 6144 + n0 + 4 * c8 + (size_t)(256 * wave + rg) * 6144;
        f32x4 wv[32];
#pragma unroll
        for (int i = 0; i < 32; ++i) wv[i] = __builtin_nontemporal_load((const f32x4*)(w + (size_t)(8 * i) * 6144));
        __builtin_amdgcn_sched_barrier(0);
        __syncthreads();
        f32x4 acc[5];
#pragma unroll
        for (int r = 0; r < 5; ++r) { f32x4 z = {0.f, 0.f, 0.f, 0.f}; acc[r] = z; }
#pragma unroll
        for (int i = 0; i < 32; ++i)
#pragma unroll
            for (int r = 0; r < 5; ++r) { const float s = sc[r * 1024 + 256 * wave + 8 * i + rg]; acc[r] += s * wv[i]; }
#pragma unroll
        for (int r = 0; r < 5; ++r)
#pragma unroll
            for (int c = 0; c < 4; ++c) { float a = acc[r][c]; a += __shfl_xor(a, 8); a += __shfl_xor(a, 16); a += __shfl_xor(a, 32); acc[r][c] = a; }
        if (rg == 0) {
#pragma unroll
            for (int r = 0; r < 5; ++r) *(LAS f32x4*)(red + (wave * 5 + r) * 32 + 4 * c8) = acc[r];
        }
        __syncthreads();
        if (threadIdx.x < 160) { const int row = threadIdx.x >> 5, cl = threadIdx.x & 31;
            ((float*)(ws + WS_MODV))[((size_t)layer * 5 + row) * 6144 + n0 + cl] = red[row * 32 + cl] + red[(5 + row) * 32 + cl] + red[(10 + row) * 32 + cl] + red[(15 + row) * 32 + cl] + P.in[5][layer * 6144 + n0 + cl]; }
    }
}
constexpr int I_WINE = 16 * 73, I_SQ = 16 * 32, I_WINO = 16 * 40, I_EXP_GU = 16 * 8, I_EXP_D = 4 * 32;
constexpr int T_WINE = I_WINE, T_WOUTE = T_WINE + I_SQ, T_WINO = T_WOUTE + I_WINO, T_WOUTO = T_WINO + I_SQ,
              T_G = T_WOUTO + 32 * I_EXP_GU, T_U = T_G + 32 * I_EXP_GU, T_D = T_U + 32 * I_EXP_D;
constexpr int HALF_E = 16 * I_EXP_GU;
static_assert(I_EXP_GU == I_EXP_D, "expert item counts");
constexpr int NT_L0 = T_WINO + 3 * HALF_E, NT_L1 = I_SQ + 3 * HALF_E;
struct TrItem { const float* W; bf16* WT; int K, N, dst, k0, n0; };
__device__ __forceinline__ void transpose_load(const TrItem& t, float (&tv)[32], int lane) {
#pragma unroll
    for (int i = 0; i < 32; ++i) tv[i] = __builtin_nontemporal_load(t.W + (size_t)(t.k0 + 2 * i + (lane >> 5)) * t.N + t.n0 + (lane & 31));
}
__device__ __forceinline__ void transpose_store(const TrItem& t, const float (&tv)[32], LAS float* scr, int lane) {
#pragma unroll
    for (int i = 0; i < 32; ++i) scr[(2 * i + (lane >> 5)) * 33 + (lane & 31)] = tv[i];
    asm volatile("s_waitcnt lgkmcnt(0)" ::: "memory");
    const int c = lane & 7;
#pragma unroll
    for (int j = 0; j < 4; ++j) {
        const int n = (lane >> 3) + 8 * j; const LAS float* s = scr + (8 * c) * 33 + n;
        u32x4 o; o.x = pk2(s[0 * 33], s[1 * 33]); o.y = pk2(s[2 * 33], s[3 * 33]); o.z = pk2(s[4 * 33], s[5 * 33]); o.w = pk2(s[6 * 33], s[7 * 33]);
        *(u32x4*)(t.WT + (size_t)(t.dst + n) * t.K + t.k0 + 8 * c) = o;
    }
    asm volatile("s_waitcnt lgkmcnt(0)" ::: "memory");
}
__device__ __forceinline__ TrItem transpose_decode(const Ptrs& P, int it) {
    unsigned char* ws = P.ws; TrItem t;
    if (it < T_WINE) { const int kb = it / 73, nb = it % 73, n0 = nb * 32; t.W = P.in[8]; t.K = 1024; t.N = EVEN_IN; t.WT = (bf16*)(ws + WS_WINE); t.dst = n0 < 1536 ? n0 : (n0 < 1568 ? n0 + 768 : n0 - 32); t.k0 = kb * 64; t.n0 = n0; }
    else if (it < T_WOUTE) { const int r = it - T_WINE; t.W = P.in[9]; t.K = 1024; t.N = 1024; t.WT = (bf16*)(ws + WS_WOUTE); t.dst = (r % 32) * 32; t.k0 = (r / 32) * 64; t.n0 = (r % 32) * 32; }
    else if (it < T_WINO) { const int r = it - T_WOUTE; t.W = P.in[15]; t.K = 1024; t.N = 1280; t.WT = (bf16*)(ws + WS_WINO); t.dst = (r % 40) * 32; t.k0 = (r / 40) * 64; t.n0 = (r % 40) * 32; }
    else if (it < T_WOUTO) { const int r = it - T_WINO; t.W = P.in[16]; t.K = 1024; t.N = 1024; t.WT = (bf16*)(ws + WS_WOUTO); t.dst = (r % 32) * 32; t.k0 = (r / 32) * 64; t.n0 = (r % 32) * 32; }
    else if (it < T_U) { const bool up = it >= T_G; int r = it - (up ? T_G : T_WOUTO); const int le = r / I_EXP_GU; r %= I_EXP_GU; const int kb = r / 8, hb = r % 8;
        t.W = (up ? P.in[25] : P.in[24]) + (size_t)le * 1024 * 256; t.K = 1024; t.N = 256; t.WT = (bf16*)(ws + WS_WGU) + (size_t)le * 512 * 1024; t.dst = 64 * hb + (up ? 32 : 0); t.k0 = kb * 64; t.n0 = hb * 32; }
    else { int r = it - T_U; const int le = r / I_EXP_D; r %= I_EXP_D; const int kb = r / 32, nb = r % 32;
        t.W = P.in[26] + (size_t)le * 256 * 1024; t.K = 256; t.N = 1024; t.WT = (bf16*)(ws + WS_WD) + (size_t)le * 1024 * 256; t.dst = nb * 32; t.k0 = kb * 64; t.n0 = nb * 32; }
    return t;
}
template <class MAP>
__device__ __forceinline__ void transpose_run(const Ptrs& P, int j0, int j1, int stride, MAP map, LAS float* scr, int lane) {
    float va[32], vb[32]; TrItem ta, tb;
    int j = j0;
    if (j < j1) { ta = transpose_decode(P, map(j)); transpose_load(ta, va, lane); }
#pragma unroll 1
    while (j < j1) {
        int jn = j + stride;
        if (jn < j1) { tb = transpose_decode(P, map(jn)); transpose_load(tb, vb, lane); }
        __builtin_amdgcn_sched_barrier(0);
        transpose_store(ta, va, scr, lane);
        j = jn; if (j >= j1) break;
        jn = j + stride;
        if (jn < j1) { ta = transpose_decode(P, map(jn)); transpose_load(ta, va, lane); }
        __builtin_amdgcn_sched_barrier(0);
        transpose_store(tb, vb, scr, lane);
        j = jn;
    }
}
__device__ __forceinline__ void transpose_dispatch(const Ptrs& P, int it, LAS float* scr, int lane) {
    unsigned char* ws = P.ws;
    if (it < T_WINE) {
        int kb = it / 73, nb = it % 73, n0 = nb * 32;
        int dst = n0 < 1536 ? n0 : (n0 < 1568 ? n0 + 768 : n0 - 32);
        transpose_item(P.in[8], 1024, EVEN_IN, (bf16*)(ws + WS_WINE), dst, kb * 64, n0, scr, lane);
    } else if (it < T_WOUTE) { int r = it - T_WINE; transpose_item(P.in[9], 1024, 1024, (bf16*)(ws + WS_WOUTE), (r % 32) * 32, (r / 32) * 64, (r % 32) * 32, scr, lane); }
    else if (it < T_WINO) { int r = it - T_WOUTE; transpose_item(P.in[15], 1024, 1280, (bf16*)(ws + WS_WINO), (r % 40) * 32, (r / 40) * 64, (r % 40) * 32, scr, lane); }
    else if (it < T_WOUTO) { int r = it - T_WINO; transpose_item(P.in[16], 1024, 1024, (bf16*)(ws + WS_WOUTO), (r % 32) * 32, (r / 32) * 64, (r % 32) * 32, scr, lane); }
    else if (it < T_U) {
        bool up = it >= T_G; int r = it - (up ? T_G : T_WOUTO); int le = r / I_EXP_GU; r %= I_EXP_GU; int kb = r / 8, hb = r % 8;
        const float* W = (up ? P.in[25] : P.in[24]) + (size_t)le * 1024 * 256;
        transpose_item(W, 1024, 256, (bf16*)(ws + WS_WGU) + (size_t)le * 512 * 1024, 64 * hb + (up ? 32 : 0), kb * 64, hb * 32, scr, lane);
    } else {
        int r = it - T_U; int le = r / I_EXP_D; r %= I_EXP_D; int kb = r / 32, nb = r % 32;
        transpose_item(P.in[26] + (size_t)le * 256 * 1024, 256, 1024, (bf16*)(ws + WS_WD) + (size_t)le * 1024 * 256, nb * 32, kb * 64, nb * 32, scr, lane);
    }
}
__device__ __forceinline__ void transposes_layer1(const Ptrs& P, LAS unsigned char* smem, int vb, int nvb) {
    const int lane = threadIdx.x & 63, wave = threadIdx.x >> 6;
    LAS float* scr = (LAS float*)smem + wave * 64 * 33;
    __syncthreads();
    transpose_run(P, vb * 4 + wave, NT_L1, nvb * 4, [](int j) { return j < I_SQ ? T_WINO + j : j < I_SQ + HALF_E ? T_WOUTO + HALF_E + (j - I_SQ) : j < I_SQ + 2 * HALF_E ? T_G + HALF_E + (j - I_SQ - HALF_E) : T_U + HALF_E + (j - I_SQ - 2 * HALF_E); }, scr, lane);
}
__device__ __forceinline__ void ph_prologue_rest(const Ptrs& P, LAS unsigned char* smem, int bid, int nblk, bool defer_l1) {
    const int lane = threadIdx.x & 63, wave = threadIdx.x >> 6;
    LAS float* scr = (LAS float*)smem + wave * 64 * 33;
    const int gw = bid * 4 + wave, NGW = nblk * 4;
    unsigned char* ws = P.ws;
    if (defer_l1) transpose_run(P, gw, NT_L0, NGW, [](int j) { return j < T_WINO ? j : j < T_WINO + HALF_E ? T_WOUTO + (j - T_WINO) : j < T_WINO + 2 * HALF_E ? T_G + (j - T_WINO - HALF_E) : T_U + (j - T_WINO - 2 * HALF_E); }, scr, lane);
    else transpose_run(P, gw, T_D, NGW, [](int j) { return j; }, scr, lane);
    { u32x4 z = {0, 0, 0, 0}; u32x4* p = (u32x4*)((bf16*)(ws + WS_WINE) + (size_t)EVEN_IN * 1024);
      for (int i = bid * 256 + threadIdx.x; i < 96 * 1024 * 2 / 16; i += nblk * 256) p[i] = z; }
    for (int i = bid * 256 + threadIdx.x; i < 1024; i += nblk * 256) {
        int pos = i >> 4, f = i & 15; float inv = powf(10000.f, -(float)(2 * f) / 32.f); float ang = (float)pos * inv;
        ((float2*)(ws + WS_ROPE))[i] = make_float2(cosf(ang), sinf(ang));
    }
    for (int i = bid * 256 + threadIdx.x; i < NT; i += nblk * 256) ((float*)(ws + WS_RSS))[i] = 0.f;
    if (bid == 0 && threadIdx.x < 2) {
        const float* gq = threadIdx.x ? P.in[18] : P.in[13]; const float* gk = threadIdx.x ? P.in[19] : P.in[14];
        float mq = 0.f, mk = 0.f; for (int d = 0; d < 64; ++d) { mq = fmaxf(mq, fabsf(gq[d])); mk = fmaxf(mk, fabsf(gk[d])); }
        ((float*)(ws + WS_ROPE + 8192))[threadIdx.x] = 8.f * mq * mk * 1.4426950408889634f;
    }
}

template <bool SRC_BF>
__device__ __forceinline__ void modulate_rows(const float* xlat, const float* xctx, const bf16* xs, const float* modv_layer, const float* gain, int which, bf16* H, int nrows, int gw, int NGW, int lane) {
    const int row0 = (int)(((long long)gw * nrows) / NGW), row1 = (int)(((long long)(gw + 1) * nrows) / NGW);
    int cur_b = -1; f32x4 a[4], shv[4];
    for (int row = row0; row < row1; ++row) {
        const int b = row < NL ? row / S : 4;
        if (b != cur_b) {
            const float* mv = modv_layer + (size_t)b * 6144;
#pragma unroll
            for (int j = 0; j < 4; ++j) { const int k = 8 * lane + 512 * (j >> 1) + 4 * (j & 1);
                const f32x4 g = *(const f32x4*)(gain + k), sc = *(const f32x4*)(mv + (which + 1) * 1024 + k);
                const f32x4 t = {g.x * (1.f + sc.x), g.y * (1.f + sc.y), g.z * (1.f + sc.z), g.w * (1.f + sc.w)}; a[j] = t; shv[j] = *(const f32x4*)(mv + which * 1024 + k); }
            cur_b = b;
        }
        f32x4 v[4]; float ss = 0.f;
#pragma unroll
        for (int j = 0; j < 4; ++j) { const int k = 8 * lane + 512 * (j >> 1) + 4 * (j & 1);
            if (SRC_BF) { const u32x2 w = *(const u32x2*)(xs + (size_t)row * D + k); f32x4 t = {__uint_as_float(w.x << 16), __uint_as_float(w.x & 0xffff0000u), __uint_as_float(w.y << 16), __uint_as_float(w.y & 0xffff0000u)}; v[j] = t; }
            else { const float* xr = row < NL ? xlat + (size_t)row * D : xctx + (size_t)(row - NL) * D; v[j] = __builtin_nontemporal_load((const f32x4*)(xr + k)); }
            ss += v[j].x * v[j].x + v[j].y * v[j].y + v[j].z * v[j].z + v[j].w * v[j].w;
        }
        const float rstd = rsqrtf(wave_sum(ss) / D + EPS);
#pragma unroll
        for (int j2 = 0; j2 < 2; ++j2) {
            u32x4 o;
            { const f32x4 x = v[2 * j2], aa = a[2 * j2], s = shv[2 * j2]; o.x = pk2(x.x * rstd * aa.x + s.x, x.y * rstd * aa.y + s.y); o.y = pk2(x.z * rstd * aa.z + s.z, x.w * rstd * aa.w + s.w); }
            { const f32x4 x = v[2 * j2 + 1], aa = a[2 * j2 + 1], s = shv[2 * j2 + 1]; o.z = pk2(x.x * rstd * aa.x + s.x, x.y * rstd * aa.y + s.y); o.w = pk2(x.z * rstd * aa.z + s.z, x.w * rstd * aa.w + s.w); }
            *(u32x4*)(H + (size_t)row * D + 8 * lane + 512 * j2) = o;
        }
    }
}
__device__ __forceinline__ void route_tables(const Ptrs& P, int layer, int bid, int nblk);
__device__ __forceinline__ void ph_modulate(const Ptrs& P, int layer, int bid, int nblk) {
    if (layer != 0 || nblk != 512) route_tables(P, layer, bid, nblk);
    if (layer == 0) modulate_rows<false>(P.in[0], P.in[2], nullptr, (const float*)(P.ws + WS_MODV), P.in[6], 0, (bf16*)(P.ws + WS_R1), NT, bid * 4 + (threadIdx.x >> 6), nblk * 4, threadIdx.x & 63);
    else modulate_rows<true>(nullptr, nullptr, (const bf16*)(P.ws + WS_R4), (const float*)(P.ws + WS_MODV) + (size_t)5 * 6144, P.in[6] + D, 0, (bf16*)(P.ws + WS_R1), NT, bid * 4 + (threadIdx.x >> 6), nblk * 4, threadIdx.x & 63);
}

struct AffineRows {
    const bf16* base; size_t ld; int w; unsigned vo[4];
    __device__ __forceinline__ AffineRows(const bf16* b, size_t ld_) : base(b), ld(ld_), w(0) {}
    __device__ __forceinline__ void init(int w_, int rl, const int (&co)[4]) { w = w_;
#pragma unroll
        for (int i = 0; i < 4; ++i) vo[i] = (unsigned)((rl * ld + co[i]) * 2); }
    __device__ __forceinline__ const bf16* sb(int i, int kt) const { return base + (size_t)(32 * w + 8 * i) * ld + kt * 64; }
};
template <bool SWP, class AF, class BF, class Epi>
__device__ __forceinline__ void gemm_tile(AF af, BF bf, int nk, LAS unsigned char* smem, const Epi& epi) {
    const int tid = threadIdx.x, lane = tid & 63, wave = __builtin_amdgcn_readfirstlane(tid >> 6), wn = wave & 1, wm = wave >> 1, l31 = lane & 31, hh = lane >> 5;
    const int r0 = wave * 32 + (lane >> 3);
    __syncthreads();
    typename Epi::Pre pre; epi.prefetch(pre, wn * 64, wm * 64, l31, hh);
    __builtin_amdgcn_sched_barrier(0);
    int coff[4];
#pragma unroll
    for (int i = 0; i < 4; ++i) coff[i] = ((lane & 7) ^ (((r0 >> 1) + 4 * i) & 7)) * 8;
    af.init(wave, lane >> 3, coff); bf.init(wave, lane >> 3, coff);
#define GT_STAGE(st, kt) do { _Pragma("unroll") for (int i = 0; i < 4; ++i) { \
        __builtin_amdgcn_global_load_lds((const unsigned*)((const char*)af.sb(i, (kt)) + af.vo[i]), (LAS unsigned*)(smem + (st) * 2 * TILE_LDS + (wave * 4 + i) * 1024), 16, 0, 0); \
        __builtin_amdgcn_global_load_lds((const unsigned*)((const char*)bf.sb(i, (kt)) + bf.vo[i]), (LAS unsigned*)(smem + (st) * 2 * TILE_LDS + TILE_LDS + (wave * 4 + i) * 1024), 16, 0, 0); } } while (0)
    GT_STAGE(0, 0);
    f32x16 acc[2][2];
#pragma unroll
    for (int i = 0; i < 2; ++i)
#pragma unroll
        for (int j = 0; j < 2; ++j)
#pragma unroll
            for (int r = 0; r < 16; ++r) acc[i][j][r] = 0.f;
    const int sw = (l31 >> 1) & 7;
    int xo[4], wo[4];
#pragma unroll
    for (int s = 0; s < 4; ++s) { const int cs = ((2 * s + hh) ^ sw) * 16; xo[s] = (wm * 64 + l31) * 128 + cs; wo[s] = TILE_LDS + (wn * 64 + l31) * 128 + cs; }
    asm volatile("s_waitcnt vmcnt(0)" ::: "memory");
    __syncthreads();
    for (int kt = 0; kt < nk; ++kt) {
        const int st = kt & 1;
        if (kt + 1 < nk) GT_STAGE(st ^ 1, kt + 1);
        LAS unsigned char* sb = smem + st * 2 * TILE_LDS;
#pragma unroll
        for (int s = 0; s < 4; ++s) {
            bf16x8 wf[2], xf[2];
#pragma unroll
            for (int i = 0; i < 2; ++i) wf[i] = *(LAS bf16x8*)(sb + wo[s] + i * 4096);
#pragma unroll
            for (int j = 0; j < 2; ++j) xf[j] = *(LAS bf16x8*)(sb + xo[s] + j * 4096);
#pragma unroll
            for (int i = 0; i < 2; ++i)
#pragma unroll
                for (int j = 0; j < 2; ++j) acc[i][j] = SWP ? __builtin_amdgcn_mfma_f32_32x32x16_bf16(xf[j], wf[i], acc[i][j], 0, 0, 0)
                                                            : __builtin_amdgcn_mfma_f32_32x32x16_bf16(wf[i], xf[j], acc[i][j], 0, 0, 0);
        }
        asm volatile("s_waitcnt vmcnt(0)" ::: "memory");
        __syncthreads();
    }
#undef GT_STAGE
    { int l31e = l31, hhe = hh, we = wave; asm volatile("" : "+v"(l31e), "+v"(hhe), "+v"(we));
      epi(acc, (we & 1) * 64, (we >> 1) * 64, l31e, hhe, smem + we * 16384, pre); }
}

constexpr int SG_P = 144;
__device__ __forceinline__ void store_bf16_T(const f32x16 (&acc)[2][2], bf16* out, size_t ld, size_t trow0, int col0, int l31, int hh, LAS unsigned char* wl) {
#pragma unroll
    for (int j = 0; j < 2; ++j)
#pragma unroll
        for (int i = 0; i < 2; ++i)
#pragma unroll
            for (int g = 0; g < 4; ++g) { u32x2 v = {pk2(acc[i][j][4 * g], acc[i][j][4 * g + 1]), pk2(acc[i][j][4 * g + 2], acc[i][j][4 * g + 3])}; *(LAS u32x2*)(wl + (32 * j + l31) * SG_P + (32 * i + 8 * g + 4 * hh) * 2) = v; }
    const int lane = l31 + 32 * hh, rr = lane >> 3, ch = lane & 7;
#pragma unroll
    for (int q = 0; q < 8; ++q) { const int R = 8 * q + rr; const u32x4 v = *(LAS u32x4*)(wl + R * SG_P + ch * 16); *(u32x4*)(out + (trow0 + R) * ld + col0 + ch * 8) = v; }
}
__device__ __forceinline__ void qknorm_rope_T(f32x16 (&acc)[2][2], const float* gain, const float2* ropeT, bool latent, int tok0  , int l31, int hh, float oscale = 1.f) {
#pragma unroll
    for (int j = 0; j < 2; ++j) {
        float ss = 0.f;
#pragma unroll
        for (int i = 0; i < 2; ++i)
#pragma unroll
            for (int r = 0; r < 16; ++r) ss += acc[i][j][r] * acc[i][j][r];
        ss = xhalf_sum(ss);
        const float rstd = rsqrtf(ss * (1.f / 64.f) + EPS) * oscale;
#pragma unroll
        for (int i = 0; i < 2; ++i)
#pragma unroll
            for (int r = 0; r < 16; ++r) acc[i][j][r] *= rstd * gain[i * 32 + (r & 3) + 8 * (r >> 2) + 4 * hh];
        if (latent) {
            const int t = tok0 + j * 32 + l31;
#pragma unroll
            for (int i = 0; i < 2; ++i) {
                const int pos = i == 0 ? (t >> 6) : (t & 63);
#pragma unroll
                for (int r = 0; r < 8; ++r) {
                    const int f = (r & 3) + 8 * (r >> 2) + 4 * hh;
                    const float2 cs = ropeT[pos * 16 + f];
                    const float x1 = acc[i][j][r], x2 = acc[i][j][r + 8];
                    acc[i][j][r] = x1 * cs.x - x2 * cs.y; acc[i][j][r + 8] = x2 * cs.x + x1 * cs.y;
                }
            }
        }
    }
}

constexpr int VT_LD = S + CL;
__device__ __forceinline__ void store_vt_swapped(const f32x16 (&acc)[2][2], bf16* vt_head  , int key0, int l31, int hh, LAS unsigned char* wl) {
#pragma unroll
    for (int i = 0; i < 2; ++i)
#pragma unroll
        for (int j = 0; j < 2; ++j)
#pragma unroll
            for (int g = 0; g < 4; ++g) { u32x2 v = {pk2(acc[i][j][4 * g], acc[i][j][4 * g + 1]), pk2(acc[i][j][4 * g + 2], acc[i][j][4 * g + 3])}; *(LAS u32x2*)(wl + (32 * i + l31) * SG_P + (32 * j + 8 * g + 4 * hh) * 2) = v; }
    const int lane = l31 + 32 * hh, rr = lane >> 3, ch = lane & 7;
#pragma unroll
    for (int q = 0; q < 8; ++q) { const int R = 8 * q + rr; const u32x4 v = *(LAS u32x4*)(wl + R * SG_P + ch * 16); *(u32x4*)(vt_head + (size_t)R * VT_LD + key0 + ch * 8) = v; }
}
struct NoPre {};
template <bool SRC_BF> struct RmwPre { f32x4 xi[16]; };
template <> struct RmwPre<true> { u32x4 xi[8]; };
template <bool SRC_BF, class RowF>
__device__ __forceinline__ void rmw_prefetch(RmwPre<SRC_BF>& pre, const RowF& rowf, int l31, int hh) {
    const int lane = l31 + 32 * hh, rr = lane >> 3, c8 = lane & 7;
#pragma unroll
    for (int q = 0; q < 8; ++q) {
        const void* sp; void* dp; const float* gp; int tk;
        if (rowf(8 * q + rr, sp, dp, gp, tk)) {
            if constexpr (SRC_BF) pre.xi[q] = *(const u32x4*)((const bf16*)sp + c8 * 8);
            else { pre.xi[2 * q] = __builtin_nontemporal_load((const f32x4*)((const float*)sp + c8 * 8)); pre.xi[2 * q + 1] = __builtin_nontemporal_load((const f32x4*)((const float*)sp + c8 * 8 + 4)); }
        }
    }
}
template <bool SRC_BF, bool DST_BF, bool SS, class RowF>
__device__ __forceinline__ void rmw_finish(const f32x16 (&acc)[2][2], const RmwPre<SRC_BF>& pre, const RowF& rowf, int l31, int hh, LAS unsigned char* wl, float* rss = nullptr) {
    const int lane = l31 + 32 * hh, rr = lane >> 3, c8 = lane & 7;
#pragma unroll
    for (int j = 0; j < 2; ++j)
#pragma unroll
        for (int i = 0; i < 2; ++i)
#pragma unroll
            for (int g = 0; g < 4; ++g) { f32x4 v = {acc[i][j][4 * g], acc[i][j][4 * g + 1], acc[i][j][4 * g + 2], acc[i][j][4 * g + 3]};
                const int R = 32 * j + l31; *(LAS f32x4*)(wl + R * 256 + (((8 * i + 2 * g + hh) ^ (R & 15)) * 16)) = v; }
    float ssr[8];
    f32x4 gts[8][2];
#pragma unroll
    for (int q = 0; q < 8; ++q) {
        const void* sp; void* dp; const float* gp; int tk = 0;
        const bool ok = rowf(8 * q + rr, sp, dp, gp, tk);
        f32x4 z = {0.f, 0.f, 0.f, 0.f};
        gts[q][0] = ok ? *(const f32x4*)(gp + c8 * 8) : z; gts[q][1] = ok ? *(const f32x4*)(gp + c8 * 8 + 4) : z;
    }
    __builtin_amdgcn_sched_barrier(0);
#pragma unroll
    for (int q = 0; q < 8; ++q) {
        const void* sp; void* dp; const float* gp; int tk = 0;
        const bool ok = rowf(8 * q + rr, sp, dp, gp, tk);
        float ssq = 0.f;
        if (ok) {
            f32x4 x0, x1;
            if constexpr (SRC_BF) { const u32x4 w = pre.xi[q];
                f32x4 t0 = {__uint_as_float(w.x << 16), __uint_as_float(w.x & 0xffff0000u), __uint_as_float(w.y << 16), __uint_as_float(w.y & 0xffff0000u)};
                f32x4 t1 = {__uint_as_float(w.z << 16), __uint_as_float(w.z & 0xffff0000u), __uint_as_float(w.w << 16), __uint_as_float(w.w & 0xffff0000u)}; x0 = t0; x1 = t1; }
            else { x0 = pre.xi[2 * q]; x1 = pre.xi[2 * q + 1]; }
            const int R = 8 * q + rr;
            const f32x4 a0 = *(LAS f32x4*)(wl + R * 256 + (((2 * c8) ^ (R & 15)) * 16)), a1 = *(LAS f32x4*)(wl + R * 256 + (((2 * c8 + 1) ^ (R & 15)) * 16));
            const f32x4 g0 = gts[q][0], g1 = gts[q][1];
            const f32x4 v0 = {x0.x + g0.x * a0.x, x0.y + g0.y * a0.y, x0.z + g0.z * a0.z, x0.w + g0.w * a0.w};
            const f32x4 v1 = {x1.x + g1.x * a1.x, x1.y + g1.y * a1.y, x1.z + g1.z * a1.z, x1.w + g1.w * a1.w};
            if (DST_BF) { u32x4 o = {pk2(v0.x, v0.y), pk2(v0.z, v0.w), pk2(v1.x, v1.y), pk2(v1.z, v1.w)}; *(u32x4*)((bf16*)dp + c8 * 8) = o;
                if (SS) { const float r0 = __uint_as_float(o.x << 16), r1 = __uint_as_float(o.x & 0xffff0000u), r2 = __uint_as_float(o.y << 16), r3 = __uint_as_float(o.y & 0xffff0000u);
                          const float r4 = __uint_as_float(o.z << 16), r5 = __uint_as_float(o.z & 0xffff0000u), r6 = __uint_as_float(o.w << 16), r7 = __uint_as_float(o.w & 0xffff0000u);
                          ssq = ((r0 * r0 + r1 * r1) + (r2 * r2 + r3 * r3)) + ((r4 * r4 + r5 * r5) + (r6 * r6 + r7 * r7)); } }
            else { *(f32x4*)((float*)dp + c8 * 8) = v0; *(f32x4*)((float*)dp + c8 * 8 + 4) = v1; }
        }
        if (SS) { ssq += __shfl_xor(ssq, 1); ssq += __shfl_xor(ssq, 2); ssq += __shfl_xor(ssq, 4); ssr[q] = ssq; }
    }
    if (SS) {
        if (c8 == 0) {
#pragma unroll
            for (int q = 0; q < 8; ++q) *(LAS float*)(wl + (8 * q + rr) * 4) = ssr[q];
        }
        const float sv = *(LAS float*)(wl + lane * 4);
        const void* sp; void* dp; const float* gp; int tk = 0;
        if (rowf(lane, sp, dp, gp, tk)) rss[tk] = sv;
    }
}
struct EpiEvenIn {
    typedef NoPre Pre;
    __device__ __forceinline__ void prefetch(Pre&, int, int, int, int) const {}
    unsigned char* r3; const float* qn; const float* kn; const float2* ropeT; int mt, nt;
    __device__ __forceinline__ bool swapped() const { return nt == 17 || (nt >= 4 && nt < 8); }
    __device__ __forceinline__ void operator()(f32x16 (&acc)[2][2], int fb, int tb, int l31, int hh, LAS unsigned char* wl, const Pre& pre) const {
        const size_t trow0 = (size_t)mt * 128 + tb; const bool latent = mt < NL / 128; const int tok0 = (int)(trow0 & (S - 1));
        if (swapped()) {
            const int b = latent ? (int)(trow0 / S) : (int)((trow0 - NL) / CL); const int key0 = latent ? tok0 : S + (int)((trow0 - NL) % CL);
            const size_t off = nt == 17 ? R3_AV + (size_t)(b * 2 + fb / 64) * 64 * VT_LD * 2 : R3_GV + ((size_t)(b * 4 + nt - 4) * 128 + fb) * VT_LD * 2;
            store_vt_swapped(acc, (bf16*)(r3 + off), key0, l31, hh, wl);
        } else if (nt == 18) {
            if (fb == 0) {
                float* LR = (float*)(r3 + R3_LR);
#pragma unroll
                for (int j = 0; j < 2; ++j)
#pragma unroll
                    for (int g = 0; g < 4; ++g) { f32x4 v = {acc[0][j][4 * g], acc[0][j][4 * g + 1], acc[0][j][4 * g + 2], acc[0][j][4 * g + 3]}; *(f32x4*)(LR + (trow0 + j * 32 + l31) * 32 + 8 * g + 4 * hh) = v; }
            }
        } else {
            size_t off; int ld, col;
            if (nt < 2) { off = R3_GQ; ld = 256; col = nt * 128; }
            else if (nt < 4) { off = R3_GK; ld = 256; col = (nt - 2) * 128; }
            else if (nt < 12) { off = R3_GR; ld = 512; col = (nt - 8) * 128; }
            else if (nt < 16) { off = R3_AQ; ld = 512; col = (nt - 12) * 128; }
            else { off = R3_AK; ld = 128; col = 0; }
            if (nt >= 12) qknorm_rope_T(acc, nt < 16 ? qn : kn, ropeT, latent, tok0, l31, hh, nt < 16 ? QSCALE : 1.f);
            store_bf16_T(acc, (bf16*)(r3 + off), ld, trow0, col + fb, l31, hh, wl);
        }
    }
};
__device__ __forceinline__ int xcd_vid(int bid, int nb) { return (nb % 8 == 0) ? (bid % 8) * (nb / 8) + bid / 8 : bid; }
__device__ __forceinline__ int round_item(int r, int n, int bid, int nb) {
    const int base = r * nb, rem = n - base;
    if (rem <= 0) return -1;
    const int idx = rem >= nb ? xcd_vid(bid, nb) : bid;
    return idx < rem ? base + idx : -1;
}

__device__ __forceinline__ void ph_even_inproj(const Ptrs& P, LAS unsigned char* smem, int bid, int nblk) {
    unsigned char* ws = P.ws;
    const int lrow = threadIdx.x >> 3, kc = threadIdx.x & 7;
    const int vid = xcd_vid(bid, nblk);
    for (int r_ = 0, tile; (tile = round_item(r_, (NT / 128) * 19, bid, nblk)) >= 0; ++r_) {
        const int g8 = tile / 152, rem = tile - g8 * 152; const int nt = rem >> 3, mt = g8 * 8 + (rem & 7);
        AffineRows af((const bf16*)(ws + WS_R1) + (size_t)mt * 128 * D, D);
        AffineRows bf_((const bf16*)(ws + WS_WINE) + (size_t)nt * 128 * D, D);
        EpiEvenIn epi{ws + WS_R3, P.in[13], P.in[14], (const float2*)(ws + WS_ROPE), mt, nt};
        if (epi.swapped()) gemm_tile<true>(af, bf_, D / 64, smem, epi); else gemm_tile<false>(af, bf_, D / 64, smem, epi);
    }
}

template <int LAYER>
struct EpiOutProj {
    typedef RmwPre<LAYER != 0> Pre;
    const float* modv_layer; const float* xin_lat; const float* xin_ctx; bf16* xs; int mt, nt;
    __device__ __forceinline__ bool swapped() const { return false; }
    __device__ __forceinline__ auto rowfn(int fb, int tb) const {
        const size_t trow0 = (size_t)mt * 128 + tb; const bool latent = mt < NL / 128;
        const int c0 = nt * 128 + fb;
        const float* gate = modv_layer + (size_t)(latent ? trow0 / S : 4) * 6144 + 2 * 1024 + c0;
        bf16* xo = xs + trow0 * D + c0;
        const float* xin = LAYER == 0 ? (latent ? xin_lat + trow0 * D : xin_ctx + (trow0 - NL) * D) + c0 : nullptr;
        return [=](int R, const void*& sp, void*& dp, const float*& gp, int& tk) { if (LAYER == 0) sp = xin + (size_t)R * D; else sp = xo + (size_t)R * D; dp = xo + (size_t)R * D; gp = gate; tk = (int)trow0 + R; return true; };
    }
    __device__ __forceinline__ void prefetch(Pre& pre, int fb, int tb, int l31, int hh) const { rmw_prefetch<LAYER != 0>(pre, rowfn(fb, tb), l31, hh); }
    __device__ __forceinline__ void operator()(f32x16 (&acc)[2][2], int fb, int tb, int l31, int hh, LAS unsigned char* wl, const Pre& pre) const {
        rmw_finish<LAYER != 0, true, false>(acc, pre, rowfn(fb, tb), l31, hh, wl);
    }
};
__device__ __forceinline__ void ph_outproj(const Ptrs& P, LAS unsigned char* smem, int bid, int nblk, int layer, int nrows) {
    unsigned char* ws = P.ws;
    const int lrow = threadIdx.x >> 3, kc = threadIdx.x & 7;
    const int vid = xcd_vid(bid, nblk);
    const float* modv_layer = (const float*)(ws + WS_MODV) + (size_t)layer * 5 * 6144;
    for (int r_ = 0, tile; (tile = round_item(r_, (nrows / 128) * 8, bid, nblk)) >= 0; ++r_) {
        const int mt = tile / 8, nt = tile % 8;
        AffineRows af((const bf16*)(ws + WS_R2) + (size_t)mt * 128 * D, D);
        AffineRows bf_((const bf16*)(ws + (layer ? WS_WOUTO : WS_WOUTE)) + (size_t)nt * 128 * D, D);
        if (layer == 0) { EpiOutProj<0> epi{modv_layer, P.in[0], P.in[2], (bf16*)(ws + WS_R4), mt, nt}; gemm_tile<false>(af, bf_, D / 64, smem, epi); }
        else { EpiOutProj<1> epi{modv_layer, nullptr, nullptr, (bf16*)(ws + WS_R4), mt, nt}; gemm_tile<false>(af, bf_, D / 64, smem, epi); }
    }
}

struct EpiOddIn {
    typedef NoPre Pre;
    __device__ __forceinline__ void prefetch(Pre&, int, int, int, int) const {}
    unsigned char* r3; const float* qn; const float* kn; const float2* ropeT; LAS const float* rss; const float* bi; int mt, nt;
    __device__ __forceinline__ bool swapped() const { return nt == 9; }
    __device__ __forceinline__ void operator()(f32x16 (&acc)[2][2], int fb, int tb, int l31, int hh, LAS unsigned char* wl, const Pre& pre) const {
        const size_t trow0 = (size_t)mt * 128 + tb; const bool latent = mt < NL / 128; const int tok0 = (int)(trow0 & (S - 1));
        if (!swapped()) {
#pragma unroll
            for (int j = 0; j < 2; ++j) {
                const float rs = rsqrtf(rss[tb + 32 * j + l31] * (1.f / D) + EPS);
#pragma unroll
                for (int i = 0; i < 2; ++i)
#pragma unroll
                    for (int g = 0; g < 4; ++g) { const f32x4 b4 = *(const f32x4*)(bi + nt * 128 + fb + 32 * i + 8 * g + 4 * hh);
                        acc[i][j][4 * g] = acc[i][j][4 * g] * rs + b4.x; acc[i][j][4 * g + 1] = acc[i][j][4 * g + 1] * rs + b4.y; acc[i][j][4 * g + 2] = acc[i][j][4 * g + 2] * rs + b4.z; acc[i][j][4 * g + 3] = acc[i][j][4 * g + 3] * rs + b4.w; }
            }
        } else {
#pragma unroll
            for (int j = 0; j < 2; ++j)
#pragma unroll
                for (int g = 0; g < 4; ++g) { const f32x4 q4 = *(LAS const f32x4*)(rss + tb + 32 * j + 8 * g + 4 * hh);
                    const float r0 = rsqrtf(q4.x * (1.f / D) + EPS), r1 = rsqrtf(q4.y * (1.f / D) + EPS), r2 = rsqrtf(q4.z * (1.f / D) + EPS), r3_ = rsqrtf(q4.w * (1.f / D) + EPS);
#pragma unroll
                    for (int i = 0; i < 2; ++i) { const float bb = bi[nt * 128 + fb + 32 * i + l31];
                        acc[i][j][4 * g] = acc[i][j][4 * g] * r0 + bb; acc[i][j][4 * g + 1] = acc[i][j][4 * g + 1] * r1 + bb; acc[i][j][4 * g + 2] = acc[i][j][4 * g + 2] * r2 + bb; acc[i][j][4 * g + 3] = acc[i][j][4 * g + 3] * r3_ + bb; } }
        }
        if (nt < 8) { if (latent) { qknorm_rope_T(acc, qn, ropeT, true, tok0, l31, hh, QSCALE); store_bf16_T(acc, (bf16*)(r3 + R3_OQ), 1024, trow0, nt * 128 + fb, l31, hh, wl); } }
        else if (nt == 8) { qknorm_rope_T(acc, kn, ropeT, latent, tok0, l31, hh); store_bf16_T(acc, (bf16*)(r3 + R3_OK), 128, trow0, fb, l31, hh, wl); }
        else {
            const int b = latent ? (int)(trow0 / S) : (int)((trow0 - NL) / CL); const int key0 = latent ? tok0 : S + (int)((trow0 - NL) % CL);
            store_vt_swapped(acc, (bf16*)(r3 + R3_OV) + (size_t)(b * 2 + fb / 64) * 64 * VT_LD, key0, l31, hh, wl);
        }
    }
};
__device__ __forceinline__ void ph_odd_inproj(const Ptrs& P, LAS unsigned char* smem, int bid, int nblk) {
    unsigned char* ws = P.ws;
    const int lrow = threadIdx.x >> 3, kc = threadIdx.x & 7;
    const int vid = xcd_vid(bid, nblk);
    constexpr int T_LAT = (NL / 128) * 10, T_ALL = T_LAT + (NC / 128) * 2;
    for (int r_ = 0, tile; (tile = round_item(r_, T_ALL, bid, nblk)) >= 0; ++r_) {
        int mt, nt;
        if (tile < T_LAT) { mt = tile / 10; nt = tile % 10; } else { mt = NL / 128 + (tile - T_LAT) / 2; nt = 8 + (tile - T_LAT) % 2; }
        const int brow = mt < NL / 128 ? mt / (S / 128) : 4;
        AffineRows af((const bf16*)(ws + WS_R4) + (size_t)mt * 128 * D, D);
        AffineRows bf_((const bf16*)(ws + WS_WINOF) + ((size_t)brow * 1280 + nt * 128) * D, D);
        LAS float* trs = (LAS float*)(smem + GEMM_LDS + 256);
        __syncthreads();
        if (threadIdx.x < 128) { const float* pp = (const float*)(ws + WS_CTXS) + (size_t)mt * 128 + threadIdx.x; float s_ = 0.f;
#pragma unroll
            for (int q = 0; q < 16; ++q) s_ += pp[(size_t)q * NT];
            trs[threadIdx.x] = s_; }
        EpiOddIn epi{ws + WS_R3, P.in[18], P.in[19], (const float2*)(ws + WS_ROPE), trs, (const float*)(ws + WS_BI) + brow * 1280, mt, nt};
        if (epi.swapped()) gemm_tile<true>(af, bf_, D / 64, smem, epi); else gemm_tile<false>(af, bf_, D / 64, smem, epi);
    }
}

constexpr int AT_KP = 144, AT_VP = 136;
constexpr int AT_STAGE = 64 * AT_KP + 64 * AT_VP;
constexpr int ATTN_LDS = 2 * AT_STAGE;
struct AttnArgs {
    const bf16* Q; int ldq; size_t qrow0; int qcol;
    const bf16* K; size_t klat0, kctx0;
    const bf16* Vt;
    int nctx, tlo, nlat;
    int banded, tq0;
    const float* sinkp;
    int sink0;
    int wrow, wcol;
    float m0;
    bf16* out;
};
__device__ __forceinline__ u32x4 widen_pair(u32x2 a, u32x2 b) {
    auto tx = __builtin_amdgcn_permlane32_swap(a.x, b.x, false, false);
    auto ty = __builtin_amdgcn_permlane32_swap(a.y, b.y, false, false);
    u32x4 r = {tx[0], ty[0], tx[1], ty[1]};
    return r;
}
__device__ __forceinline__ float xhalf_max(float x) {
    auto t = __builtin_amdgcn_permlane32_swap(__float_as_uint(x), __float_as_uint(x), false, false);
    return fmaxf(__uint_as_float(t[0]), __uint_as_float(t[1]));
}
__device__ __forceinline__ void attn_block(const AttnArgs& a, LAS unsigned char* smem) {
    int tid_ = threadIdx.x; asm volatile("" : "+v"(tid_));
    const int tid = tid_, lane = tid & 63, wave = tid >> 6, l31 = lane & 31, hh = lane >> 5;
    bf16x8 qf[2][4];
#pragma unroll
    for (int u = 0; u < 2; ++u) { const bf16* qp = a.Q + (a.qrow0 + wave * a.wrow + u * 32 + l31) * a.ldq + a.qcol + wave * a.wcol + hh * 8;
#pragma unroll
      for (int s = 0; s < 4; ++s) qf[u][s] = __builtin_nontemporal_load((const bf16x8*)(qp + 16 * s)); }
    f32x16 o[2][2], minit;
#pragma unroll
    for (int r = 0; r < 16; ++r) { o[0][0][r] = 0.f; o[0][1][r] = 0.f; o[1][0][r] = 0.f; o[1][1][r] = 0.f; minit[r] = -a.m0; }
    float ls[2][2] = {{0.f, 0.f}, {0.f, 0.f}};
    const int ntile = a.nctx + a.nlat;
    const int lr0 = tid >> 3, kc = tid & 7;
    const bf16* kbase = a.K + (size_t)lr0 * 128 + kc * 8;
    const bf16* vbase = a.Vt + (size_t)lr0 * VT_LD + kc * 8;
    const int kwoff = lr0 * AT_KP + kc * 16, vwoff = 64 * AT_KP + lr0 * AT_VP + kc * 16;
    const int kroff = l31 * AT_KP + hh * 16, vroff = 64 * AT_KP + l31 * AT_VP + hh * 8;
    u32x4 rk[2], rv[2];
#define AT_ISSUE(n) do { const int t_ = __builtin_amdgcn_readfirstlane((n) < a.nctx ? 64 + (n) : a.tlo + (n) - a.nctx); \
        const size_t kr_ = (t_ < 64 ? a.klat0 + 64 * t_ : a.kctx0 + 64 * (t_ - 64)); \
        const bf16* kq_ = kbase + kr_ * 128; const bf16* vq_ = vbase + 64 * t_; \
        rk[0] = *(const u32x4*)kq_; rk[1] = *(const u32x4*)(kq_ + 32 * 128); rv[0] = *(const u32x4*)vq_; rv[1] = *(const u32x4*)(vq_ + (size_t)32 * VT_LD); } while (0)
#define AT_COMMIT(ST) do { LAS unsigned char* sb_ = smem + (ST) * AT_STAGE; \
        _Pragma("unroll") for (int i = 0; i < 2; ++i) { *(LAS u32x4*)(sb_ + kwoff + i * 32 * AT_KP) = rk[i]; \
            u32x2 lo_ = {rv[i].x, rv[i].y}, hi_ = {rv[i].z, rv[i].w}; *(LAS u32x2*)(sb_ + vwoff + i * 32 * AT_VP) = lo_; *(LAS u32x2*)(sb_ + vwoff + i * 32 * AT_VP + 8) = hi_; } } while (0)
#define AT_BODY(ST, n) do { \
        if ((n) + 1 < ntile) AT_ISSUE((n) + 1); \
        __builtin_amdgcn_sched_barrier(0); \
        LAS unsigned char* sb = smem + (ST) * AT_STAGE; \
        bool skip = false, edge = false; \
        if (a.banded && (n) >= a.nctx) { const int k0 = 64 * (a.tlo + (n) - a.nctx), q0w = a.tq0 + wave * a.wrow; skip = (k0 + 63 < q0w - 128) || (k0 > q0w + 63 + 128); \
            edge = __builtin_amdgcn_readfirstlane((k0 + 63 > q0w + 128) || (k0 < q0w + 63 - 128)); }       \
        if (!skip) { \
            _Pragma("unroll") for (int kt = 0; kt < 2; ++kt) { \
                f32x16 sc[2]; \
                _Pragma("unroll") for (int s = 0; s < 4; ++s) { \
                    const bf16x8 kf = *(LAS bf16x8*)(sb + kroff + kt * 32 * AT_KP + s * 32); \
                    sc[0] = __builtin_amdgcn_mfma_f32_32x32x16_bf16(kf, qf[0][s], s == 0 ? minit : sc[0], 0, 0, 0); \
                    sc[1] = __builtin_amdgcn_mfma_f32_32x32x16_bf16(kf, qf[1][s], s == 0 ? minit : sc[1], 0, 0, 0); } \
                if (edge) { \
                    _Pragma("unroll") for (int u = 0; u < 2; ++u) { \
                        const int dbase = 64 * (a.tlo + (n) - a.nctx) + 32 * kt + 4 * hh - (a.tq0 + wave * a.wrow + u * 32 + l31); \
                        _Pragma("unroll") for (int r = 0; r < 16; ++r) { const int df = dbase + (r & 3) + 8 * (r >> 2); if (df > 128 || df < -128) sc[u][r] = -1e30f; } } } \
                _Pragma("unroll") for (int u = 0; u < 2; ++u) _Pragma("unroll") for (int r = 0; r < 16; r += 4) { \
                    sc[u][r] = __builtin_amdgcn_exp2f(sc[u][r]); ls[u][0] += sc[u][r]; sc[u][r + 1] = __builtin_amdgcn_exp2f(sc[u][r + 1]); ls[u][1] += sc[u][r + 1]; \
                    sc[u][r + 2] = __builtin_amdgcn_exp2f(sc[u][r + 2]); ls[u][0] += sc[u][r + 2]; sc[u][r + 3] = __builtin_amdgcn_exp2f(sc[u][r + 3]); ls[u][1] += sc[u][r + 3]; } \
                _Pragma("unroll") for (int s2 = 0; s2 < 2; ++s2) { \
                    bf16x8 pf[2]; \
                    _Pragma("unroll") for (int u = 0; u < 2; ++u) { \
                        u32x4 pw = {pk2(sc[u][8 * s2], sc[u][8 * s2 + 1]), pk2(sc[u][8 * s2 + 2], sc[u][8 * s2 + 3]), pk2(sc[u][8 * s2 + 4], sc[u][8 * s2 + 5]), pk2(sc[u][8 * s2 + 6], sc[u][8 * s2 + 7])}; \
                        pf[u] = __builtin_bit_cast(bf16x8, pw); } \
                    _Pragma("unroll") for (int dt = 0; dt < 2; ++dt) { \
                        LAS unsigned char* vp = sb + vroff + dt * 32 * AT_VP + (32 * kt + 16 * s2) * 2; \
                        const u32x2 v0 = *(LAS u32x2*)vp, v1 = *(LAS u32x2*)(vp + 16); u32x4 vw = {v0.x, v0.y, v1.x, v1.y}; const bf16x8 vf = __builtin_bit_cast(bf16x8, vw); \
                        _Pragma("unroll") for (int u = 0; u < 2; ++u) o[u][dt] = __builtin_amdgcn_mfma_f32_32x32x16_bf16(vf, pf[u], o[u][dt], 0, 0, 0); } } \
                __builtin_amdgcn_sched_barrier(0); \
            } \
        } \
        __builtin_amdgcn_sched_barrier(0); \
        if ((n) + 1 < ntile) AT_COMMIT((ST) ^ 1); \
        __syncthreads(); } while (0)
    AT_ISSUE(0); AT_COMMIT(0);
    __syncthreads();
#pragma unroll 1
    for (int n = 0; n < ntile; n += 2) {
        AT_BODY(0, n);
        if (n + 1 < ntile) AT_BODY(1, n + 1);
    }
#undef AT_ISSUE
#undef AT_COMMIT
#undef AT_BODY
#pragma unroll
    for (int u = 0; u < 2; ++u) {
        const float l = xhalf_sum(ls[u][0] + ls[u][1]) + (a.sinkp ? __builtin_amdgcn_exp2f(a.sinkp[a.sink0 + wave * (a.wcol >> 6)] * 1.4426950408889634f - a.m0) : 0.f);
        const float inv = 1.f / l;
        bf16* op = a.out + (a.qrow0 + wave * a.wrow + u * 32 + l31) * 1024 + wave * a.wcol + 8 * hh;
#pragma unroll
        for (int dt = 0; dt < 2; ++dt)
#pragma unroll
            for (int g = 0; g < 4; g += 2) {
                const u32x2 va = {pk2(o[u][dt][4 * g] * inv, o[u][dt][4 * g + 1] * inv), pk2(o[u][dt][4 * g + 2] * inv, o[u][dt][4 * g + 3] * inv)};
                const u32x2 vb = {pk2(o[u][dt][4 * g + 4] * inv, o[u][dt][4 * g + 5] * inv), pk2(o[u][dt][4 * g + 6] * inv, o[u][dt][4 * g + 7] * inv)};
                *(u32x4*)(op + dt * 32 + 8 * g) = widen_pair(va, vb);
            }
    }
}

__device__ __forceinline__ void ph_dense_attn(const Ptrs& P, LAS unsigned char* smem, int bid, int nblk) {
    unsigned char* r3 = P.ws + WS_R3;
    const int vid = xcd_vid(bid, nblk);
    for (int r_ = 0, item; (item = round_item(r_, 512 + 32, bid, nblk)) >= 0; ++r_) {
        AttnArgs a;
        int bh, qb; bool isctx = item >= 512;
        if (!isctx) { bh = item >> 4; qb = item & 15; } else { bh = item - 512; qb = 0; }
        const int hq = bh & 7, b = bh >> 3, kv = hq >> 2;
        a.Q = (const bf16*)(r3 + R3_AQ); a.ldq = 512; a.qcol = hq * 64;
        a.qrow0 = isctx ? (size_t)NL + b * CL : (size_t)b * S + qb * 256;
        a.K = (const bf16*)(r3 + R3_AK) + kv * 64; a.klat0 = (size_t)b * S; a.kctx0 = (size_t)NL + b * CL;
        a.Vt = (const bf16*)(r3 + R3_AV) + (size_t)(b * 2 + kv) * 64 * VT_LD;
        a.nctx = 4; a.tlo = 0; a.nlat = isctx ? 0 : 64; a.banded = 0; a.tq0 = 0; a.sinkp = nullptr; a.sink0 = 0; a.wrow = 64; a.wcol = 0; a.m0 = ((const float*)(P.ws + WS_ROPE + 8192))[0];
        a.out = (bf16*)(P.ws + WS_R2) + 512 + hq * 64;
        attn_block(a, smem);
    }
}
__device__ __forceinline__ void ph_swa_attn(const Ptrs& P, LAS unsigned char* smem, int bid, int nblk) {
    unsigned char* r3 = P.ws + WS_R3;
    const int vid = xcd_vid(bid, nblk);
    for (int item = vid; item < 1024; item += nblk) {
        AttnArgs a;
        const int hg = item & 1, qb = (item >> 1) & 63, kv = (item >> 7) & 1, b = item >> 8, hq = kv * 8 + hg * 4;
        a.Q = (const bf16*)(r3 + R3_OQ); a.ldq = 1024; a.qcol = hq * 64; a.qrow0 = (size_t)b * S + qb * 64;
        a.K = (const bf16*)(r3 + R3_OK) + kv * 64; a.klat0 = (size_t)b * S; a.kctx0 = (size_t)NL + b * CL;
        a.Vt = (const bf16*)(r3 + R3_OV) + (size_t)(b * 2 + kv) * 64 * VT_LD;
        const int tlo = qb - 2 < 0 ? 0 : qb - 2, thi = qb + 2 > 63 ? 63 : qb + 2;
        a.nctx = 4; a.tlo = tlo; a.nlat = thi - tlo + 1; a.banded = 1; a.tq0 = qb * 64; a.sinkp = P.in[17]; a.sink0 = hq; a.wrow = 0; a.wcol = 64; a.m0 = ((const float*)(P.ws + WS_ROPE + 8192))[1];
        a.out = (bf16*)(P.ws + WS_R2) + hq * 64;
        attn_block(a, smem);
    }
}

constexpr size_t WS_LIST = 247 * MiB;
constexpr size_t WS_WTS = WS_LIST + (size_t)24 * NT * 4;
constexpr size_t WS_END_ALL = WS_WTS + (size_t)NT * 2 * 4;
static_assert(WS_R3 + R3_END <= WS_LIST && WS_END_ALL <= 256 * MiB, "ws map tail");
constexpr int CTL_CNT = 8192;
constexpr int MOE_MAXT = NT / 128 + 24;


typedef float f32x4v __attribute__((ext_vector_type(4)));
__device__ __forceinline__ void route_tables(const Ptrs& P, int layer, int bid, int nblk) {
    unsigned char* ws = P.ws;
    const float* mvl = (const float*)(ws + WS_MODV) + (size_t)layer * 5 * 6144;
    const float* gain = P.in[7] + layer * D;
    const float* wg = P.in[20] + (size_t)layer * D * 4; const float* bg = P.in[21] + layer * 4;
    const float* we = P.in[22] + (size_t)layer * D * 16; const float* be = P.in[23] + layer * 16;
    bf16* wrt = (bf16*)(ws + WS_WRT + layer * WRT_STRIDE);
    for (int e = bid * 256 + threadIdx.x; e < 5 * 32 * 1024; e += nblk * 256) {
        const int k = e & 1023, r = (e >> 10) & 31, br = e >> 15;
        const float a = gain[k] * (1.f + mvl[(size_t)br * 6144 + 4 * 1024 + k]);
        const float w = (r < 16 ? wg[k * 4 + (r & 3)] : we[k * 16 + r - 16]) * a;
        const bf16 hi = f2bf(w); const bf16 lo = f2bf(w - bf2f(hi));
        wrt[((size_t)(br * 2 + 0) * 32 + r) * 1024 + k] = hi; wrt[((size_t)(br * 2 + 1) * 32 + r) * 1024 + k] = lo;
    }
    const int gw = bid * 4 + (threadIdx.x >> 6), lane = threadIdx.x & 63;
    if (gw < 160) {
        const int r = gw & 31, br = gw >> 5; float s = 0.f;
        for (int k = lane; k < 1024; k += 64) s += mvl[(size_t)br * 6144 + 3 * 1024 + k] * (r < 16 ? wg[k * 4 + (r & 3)] : we[k * 16 + r - 16]);
        s = wave_sum(s);
        if (lane == 0) ((float*)(ws + WS_SL))[layer * 256 + br * 32 + r] = s + (r < 16 ? bg[r & 3] : be[r - 16]);
    }
}
__device__ __forceinline__ void fold_odd_inproj(const Ptrs& P, int bid, int nblk) {
    unsigned char* ws = P.ws;
    const float* mv1 = (const float*)(ws + WS_MODV) + (size_t)5 * 6144; const float* gain = P.in[6] + D;
    const bf16* wt = (const bf16*)(ws + WS_WINO); bf16* wf = (bf16*)(ws + WS_WINOF);
    for (int e = bid * 256 + threadIdx.x; e < 5 * 80 * 128; e += nblk * 256) {
        const int k8 = (e & 127) * 8, n0 = ((e >> 7) % 80) * 16, b = e / (80 * 128);
        const f32x4 g0 = *(const f32x4*)(gain + k8), g1 = *(const f32x4*)(gain + k8 + 4), s0 = *(const f32x4*)(mv1 + (size_t)b * 6144 + 1024 + k8), s1 = *(const f32x4*)(mv1 + (size_t)b * 6144 + 1024 + k8 + 4);
        const float a0 = g0.x * (1.f + s0.x), a1 = g0.y * (1.f + s0.y), a2 = g0.z * (1.f + s0.z), a3 = g0.w * (1.f + s0.w), a4 = g1.x * (1.f + s1.x), a5 = g1.y * (1.f + s1.y), a6 = g1.z * (1.f + s1.z), a7 = g1.w * (1.f + s1.w);
        u32x4 w[16];
#pragma unroll
        for (int i = 0; i < 16; ++i) w[i] = *(const u32x4*)(wt + (size_t)(n0 + i) * 1024 + k8);
#pragma unroll
        for (int i = 0; i < 16; ++i) {
            u32x4 o;
            o.x = pk2(__uint_as_float(w[i].x << 16) * a0, __uint_as_float(w[i].x & 0xffff0000u) * a1); o.y = pk2(__uint_as_float(w[i].y << 16) * a2, __uint_as_float(w[i].y & 0xffff0000u) * a3);
            o.z = pk2(__uint_as_float(w[i].z << 16) * a4, __uint_as_float(w[i].z & 0xffff0000u) * a5); o.w = pk2(__uint_as_float(w[i].w << 16) * a6, __uint_as_float(w[i].w & 0xffff0000u) * a7);
            *(u32x4*)(wf + ((size_t)b * 1280 + n0 + i) * 1024 + k8) = o;
        }
    }
    const int gw = bid * 4 + (threadIdx.x >> 6), NGW = nblk * 4, lane = threadIdx.x & 63;
    for (int t = gw; t < 5 * 1280; t += NGW) {
        const int n = t % 1280, b = t / 1280;
        const u32x4 w0 = *(const u32x4*)(wt + (size_t)n * 1024 + 8 * lane), w1 = *(const u32x4*)(wt + (size_t)n * 1024 + 512 + 8 * lane);
        const float* sh = mv1 + (size_t)b * 6144;
        const f32x4 p0 = *(const f32x4*)(sh + 8 * lane), p1 = *(const f32x4*)(sh + 8 * lane + 4), p2 = *(const f32x4*)(sh + 512 + 8 * lane), p3 = *(const f32x4*)(sh + 512 + 8 * lane + 4);
        float s = p0.x * __uint_as_float(w0.x << 16) + p0.y * __uint_as_float(w0.x & 0xffff0000u) + p0.z * __uint_as_float(w0.y << 16) + p0.w * __uint_as_float(w0.y & 0xffff0000u)
                + p1.x * __uint_as_float(w0.z << 16) + p1.y * __uint_as_float(w0.z & 0xffff0000u) + p1.z * __uint_as_float(w0.w << 16) + p1.w * __uint_as_float(w0.w & 0xffff0000u)
                + p2.x * __uint_as_float(w1.x << 16) + p2.y * __uint_as_float(w1.x & 0xffff0000u) + p2.z * __uint_as_float(w1.y << 16) + p2.w * __uint_as_float(w1.y & 0xffff0000u)
                + p3.x * __uint_as_float(w1.z << 16) + p3.y * __uint_as_float(w1.z & 0xffff0000u) + p3.z * __uint_as_float(w1.w << 16) + p3.w * __uint_as_float(w1.w & 0xffff0000u);
        s = wave_sum(s);
        if (lane == 0) ((float*)(ws + WS_BI))[t] = s;
    }
}
typedef float f32x4a __attribute__((ext_vector_type(4)));
__device__ __forceinline__ float xq_sum(float x) {
    x += __shfl_xor(x, 16); x += __shfl_xor(x, 32); return x;
}
__device__ __forceinline__ void ph_moe_route(const Ptrs& P, LAS unsigned char* smem, int bid, int nblk, int layer, int nrows) {
    unsigned char* ws = P.ws;
    const int tid = threadIdx.x, lane = tid & 63, wave = tid >> 6, tk = lane & 15, kq = lane >> 4;
    const float* modv_layer = (const float*)(ws + WS_MODV) + (size_t)layer * 5 * 6144;
    const float* gain = P.in[7] + layer * D;
    const bf16* xs = (const bf16*)(ws + WS_R4);
    bf16* H = (bf16*)(ws + WS_R1);
    int* cnt = (int*)(ws + WS_CTL) + CTL_CNT + layer * 2048; int* list = (int*)(ws + WS_LIST); float* wts = (float*)(ws + WS_WTS);
    LAS float* part = (LAS float*)smem;
    for (int r_ = 0, task; (task = round_item(r_, nrows / 32, bid, nblk)) >= 0; ++r_) {
        const int row0 = task * 32;
        const int br = row0 < NL ? row0 / S : 4;
        const bf16* xrA = xs + (size_t)(row0 + tk) * D; const bf16* xrB = xrA + (size_t)16 * D;
        const bf16* wt = (const bf16*)(ws + WS_WRT + layer * WRT_STRIDE) + (size_t)br * 2 * 32 * 1024;
        f32x4a a0A = {0.f, 0.f, 0.f, 0.f}, a1A = {0.f, 0.f, 0.f, 0.f}, a0B = {0.f, 0.f, 0.f, 0.f}, a1B = {0.f, 0.f, 0.f, 0.f};
        float ssA = 0.f, ssB = 0.f;
#pragma unroll 4
        for (int s = 8 * wave; s < 8 * wave + 8; ++s) {
            const int k = 32 * s + 8 * kq;
            const u32x4 xa = *(const u32x4*)(xrA + k), xb = *(const u32x4*)(xrB + k);
            { const float f0 = __uint_as_float(xa.x << 16), f1 = __uint_as_float(xa.x & 0xffff0000u), f2 = __uint_as_float(xa.y << 16), f3 = __uint_as_float(xa.y & 0xffff0000u);
              const float f4 = __uint_as_float(xa.z << 16), f5 = __uint_as_float(xa.z & 0xffff0000u), f6 = __uint_as_float(xa.w << 16), f7 = __uint_as_float(xa.w & 0xffff0000u);
              ssA += (f0 * f0 + f1 * f1) + (f2 * f2 + f3 * f3) + (f4 * f4 + f5 * f5) + (f6 * f6 + f7 * f7); }
            { const float f0 = __uint_as_float(xb.x << 16), f1 = __uint_as_float(xb.x & 0xffff0000u), f2 = __uint_as_float(xb.y << 16), f3 = __uint_as_float(xb.y & 0xffff0000u);
              const float f4 = __uint_as_float(xb.z << 16), f5 = __uint_as_float(xb.z & 0xffff0000u), f6 = __uint_as_float(xb.w << 16), f7 = __uint_as_float(xb.w & 0xffff0000u);
              ssB += (f0 * f0 + f1 * f1) + (f2 * f2 + f3 * f3) + (f4 * f4 + f5 * f5) + (f6 * f6 + f7 * f7); }
            const bf16x8 bA = __builtin_bit_cast(bf16x8, xa), bB = __builtin_bit_cast(bf16x8, xb);
            const bf16x8 a0h = *(const bf16x8*)(wt + (size_t)tk * 1024 + k), a1h = *(const bf16x8*)(wt + (size_t)(16 + tk) * 1024 + k);
            const bf16x8 a0l = *(const bf16x8*)(wt + (size_t)(32 + tk) * 1024 + k), a1l = *(const bf16x8*)(wt + (size_t)(48 + tk) * 1024 + k);
            a0A = __builtin_amdgcn_mfma_f32_16x16x32_bf16(a0h, bA, a0A, 0, 0, 0); a1A = __builtin_amdgcn_mfma_f32_16x16x32_bf16(a1h, bA, a1A, 0, 0, 0);
            a0B = __builtin_amdgcn_mfma_f32_16x16x32_bf16(a0h, bB, a0B, 0, 0, 0); a1B = __builtin_amdgcn_mfma_f32_16x16x32_bf16(a1h, bB, a1B, 0, 0, 0);
            a0A = __builtin_amdgcn_mfma_f32_16x16x32_bf16(a0l, bA, a0A, 0, 0, 0); a1A = __builtin_amdgcn_mfma_f32_16x16x32_bf16(a1l, bA, a1A, 0, 0, 0);
            a0B = __builtin_amdgcn_mfma_f32_16x16x32_bf16(a0l, bB, a0B, 0, 0, 0); a1B = __builtin_amdgcn_mfma_f32_16x16x32_bf16(a1l, bB, a1B, 0, 0, 0);
        }
#pragma unroll
        for (int j = 0; j < 4; ++j) { part[(wave * 18 + j) * 64 + lane] = a0A[j]; part[(wave * 18 + 4 + j) * 64 + lane] = a1A[j]; part[(wave * 18 + 9 + j) * 64 + lane] = a0B[j]; part[(wave * 18 + 13 + j) * 64 + lane] = a1B[j]; }
        part[(wave * 18 + 8) * 64 + lane] = ssA; part[(wave * 18 + 17) * 64 + lane] = ssB;
        __syncthreads();
        float totA8 = (part[8 * 64 + lane] + part[(18 + 8) * 64 + lane]) + (part[(36 + 8) * 64 + lane] + part[(54 + 8) * 64 + lane]);
        float totB8 = (part[17 * 64 + lane] + part[(18 + 17) * 64 + lane]) + (part[(36 + 17) * 64 + lane] + part[(54 + 17) * 64 + lane]);
        const float rstdA = rsqrtf(xq_sum(totA8) * (1.f / D) + EPS), rstdB = rsqrtf(xq_sum(totB8) * (1.f / D) + EPS);
        if (wave < 2) {
            const int so = wave * 9; const float rstd = wave ? rstdB : rstdA; const int row = row0 + 16 * wave + tk;
            float tot[8];
#pragma unroll
            for (int j = 0; j < 8; ++j) tot[j] = (part[(so + j) * 64 + lane] + part[(18 + so + j) * 64 + lane]) + (part[(36 + so + j) * 64 + lane] + part[(54 + so + j) * 64 + lane]);
            const float* sl = (const float*)(ws + WS_SL) + layer * 256 + br * 32;
            float gl[4], el[4];
#pragma unroll
            for (int j = 0; j < 4; ++j) { gl[j] = tot[j] * rstd + sl[j]; el[j] = tot[4 + j] * rstd + sl[16 + 4 * kq + j]; }
            int gi = 0; float gm = gl[0];
#pragma unroll
            for (int j = 1; j < 4; ++j) if (gl[j] > gm) { gm = gl[j]; gi = j; }
            if (gi == kq) {
                float gs = 0.f;
#pragma unroll
                for (int j = 0; j < 4; ++j) gs += expf(gl[j] - gm);
                const float gwt = 1.f / gs;
                int i0 = 0; float e0 = el[0];
#pragma unroll
                for (int j = 1; j < 4; ++j) if (el[j] > e0) { e0 = el[j]; i0 = j; }
                int i1 = -1; float e1 = -INFINITY;
#pragma unroll
                for (int j = 0; j < 4; ++j) if (j != i0 && el[j] > e1) { e1 = el[j]; i1 = j; }
                const float p1 = expf(e1 - e0); const float w0 = gwt / (1.f + p1), w1 = gwt * p1 / (1.f + p1);
                const int ea = i0 < i1 ? i0 : i1, eb = i0 < i1 ? i1 : i0;
                const int pidx = ea == 0 ? eb - 1 : (ea == 1 ? eb + 1 : 5);
                const int cls = gi * 6 + pidx;
                wts[(size_t)row * 2] = i0 < i1 ? w0 : w1; wts[(size_t)row * 2 + 1] = i0 < i1 ? w1 : w0;
                const int pos = atomicAdd(&cnt[cls * 64], 1);
                list[(size_t)cls * NT + pos] = row;
            }
        }
        const float* mv = modv_layer + (size_t)br * 6144;
        f32x4 av[4], shv[4];
#pragma unroll
        for (int j = 0; j < 4; ++j) { const int k = 8 * lane + 512 * (j >> 1) + 4 * (j & 1);
            const f32x4 g = *(const f32x4*)(gain + k), sc = *(const f32x4*)(mv + 4 * 1024 + k);
            const f32x4 t = {g.x * (1.f + sc.x), g.y * (1.f + sc.y), g.z * (1.f + sc.z), g.w * (1.f + sc.w)}; av[j] = t; shv[j] = *(const f32x4*)(mv + 3 * 1024 + k); }
#pragma unroll
        for (int h2 = 0; h2 < 2; ++h2) {
            const int rb = 8 * wave + 4 * h2;
            float rs[4];
#pragma unroll
            for (int r = 0; r < 4; ++r) rs[r] = __shfl(wave < 2 ? rstdA : rstdB, (rb + r) & 15);
            u32x4 xv[4][2];
#pragma unroll
            for (int r = 0; r < 4; ++r) {
                const bf16* xp = xs + (size_t)(row0 + rb + r) * D + 8 * lane;
#pragma unroll
                for (int j2 = 0; j2 < 2; ++j2) xv[r][j2] = *(const u32x4*)(xp + 512 * j2);
            }
#pragma unroll
            for (int r = 0; r < 4; ++r)
#pragma unroll
                for (int j2 = 0; j2 < 2; ++j2) {
                    const u32x4 xw = xv[r][j2]; const float s_ = rs[r];
                    const f32x4 a0 = av[2 * j2], a1 = av[2 * j2 + 1], s0 = shv[2 * j2], s1 = shv[2 * j2 + 1];
                    u32x4 o;
                    o.x = pk2(__uint_as_float(xw.x << 16) * s_ * a0.x + s0.x, __uint_as_float(xw.x & 0xffff0000u) * s_ * a0.y + s0.y);
                    o.y = pk2(__uint_as_float(xw.y << 16) * s_ * a0.z + s0.z, __uint_as_float(xw.y & 0xffff0000u) * s_ * a0.w + s0.w);
                    o.z = pk2(__uint_as_float(xw.z << 16) * s_ * a1.x + s1.x, __uint_as_float(xw.z & 0xffff0000u) * s_ * a1.y + s1.y);
                    o.w = pk2(__uint_as_float(xw.w << 16) * s_ * a1.z + s1.z, __uint_as_float(xw.w & 0xffff0000u) * s_ * a1.w + s1.w);
                    *(u32x4*)(H + (size_t)(row0 + rb + r) * D + 8 * lane + 512 * j2) = o;
                }
        }
        __syncthreads();
    }
}

__device__ __forceinline__ void moe_tiles_init(const int* cnt, LAS int* tile0) {
    __syncthreads();
    if (threadIdx.x < 24) tile0[192 + threadIdx.x] = cnt[threadIdx.x * 64];
    __syncthreads();
    if (threadIdx.x == 0) { int a = 0; for (int c = 0; c < 24; ++c) { tile0[c] = a; a += (tile0[192 + c] + 127) >> 7; } tile0[24] = a; }
    __syncthreads();
}
struct GatherRows {
    const bf16* H; const int* lst; int n; unsigned vo[4];
    __device__ __forceinline__ void init(int w, int rl, const int (&co)[4]) {
#pragma unroll
        for (int i = 0; i < 4; ++i) { const int r = 32 * w + 8 * i + rl; vo[i] = (unsigned)(((size_t)lst[r < n ? r : 0] * D + co[i]) * 2); }
    }
    __device__ __forceinline__ const bf16* sb(int i, int kt) const { return H + kt * 64; }
};
struct SplitKRows {
    const bf16* b0; const bf16* b1; size_t ld; int ksplit; int w; unsigned vo[4];
    __device__ __forceinline__ SplitKRows(const bf16* b0_, const bf16* b1_, size_t ld_, int ksplit_) : b0(b0_), b1(b1_), ld(ld_), ksplit(ksplit_), w(0) {}
    __device__ __forceinline__ void init(int w_, int rl, const int (&co)[4]) { w = w_;
#pragma unroll
        for (int i = 0; i < 4; ++i) vo[i] = (unsigned)((rl * ld + co[i]) * 2); }
    __device__ __forceinline__ const bf16* sb(int i, int kt) const { return (kt < ksplit ? b0 + kt * 64 : b1 + (kt - ksplit) * 64) + (size_t)(32 * w + 8 * i) * ld; }
};
struct EpiMoe1 {
    typedef NoPre Pre;
    __device__ __forceinline__ void prefetch(Pre&, int, int, int, int) const {}
    bf16* hid; const int* lst; int n; const float* wts; int nt;
    __device__ __forceinline__ bool swapped() const { return false; }
    __device__ __forceinline__ void operator()(f32x16 (&acc)[2][2], int fb, int tb, int l31, int hh, LAS unsigned char* wl, const Pre& pre) const {
        const int col = (nt >> 2) * 256 + 32 * (2 * (nt & 3) + (fb >> 6));
#pragma unroll 1
        for (int j = 0; j < 2; ++j) {
            const int r = tb + j * 32 + l31;
            const int tok = lst[r < n ? r : 0];
            const float w = wts[(size_t)tok * 2 + (nt >> 2)];
#pragma unroll
            for (int g = 0; g < 4; ++g) {
                float hv[4];
#pragma unroll
                for (int e = 0; e < 4; ++e) { const float a_ = j ? acc[0][1][4 * g + e] : acc[0][0][4 * g + e], u_ = j ? acc[1][1][4 * g + e] : acc[1][0][4 * g + e]; hv[e] = a_ / (1.f + __expf(-a_)) * u_ * w; }
                u32x2 v = {pk2(hv[0], hv[1]), pk2(hv[2], hv[3])}; *(LAS u32x2*)(wl + (32 * j + l31) * 80 + (8 * g + 4 * hh) * 2) = v;
            }
        }
        const int lane = l31 + 32 * hh, rr = lane >> 2, ch = lane & 3;
#pragma unroll
        for (int q = 0; q < 4; ++q) { const int R = 16 * q + rr; const u32x4 v = *(LAS u32x4*)(wl + R * 80 + ch * 16); *(u32x4*)(hid + (size_t)(tb + R) * 512 + col + ch * 8) = v; }
    }
};
__device__ __forceinline__ void ph_moe_stage1(const Ptrs& P, LAS unsigned char* smem, int bid, int nblk, int layer) {
    unsigned char* ws = P.ws;
    const int* cnt = (const int*)(ws + WS_CTL) + CTL_CNT + layer * 2048; const int* list = (const int*)(ws + WS_LIST);
    LAS int* tile0 = (LAS int*)(smem + GEMM_LDS);
    moe_tiles_init(cnt, tile0);
    const int lrow = threadIdx.x >> 3, kc = threadIdx.x & 7;
    const bf16* H = (const bf16*)(ws + WS_R1);
    const int nitems = tile0[24] * 8;
    for (int r_ = 0, item; (item = round_item(r_, nitems, bid, nblk)) >= 0; ++r_) {
        const int tt = item >> 3, nt = item & 7;
        int c = 0; while (tile0[c + 1] <= tt) ++c;
        const int lt = tt - tile0[c], n = min(128, tile0[192 + c] - lt * 128);
        const int* lst = list + (size_t)c * NT + lt * 128;
        const int g = c / 6, pidx = c % 6; const int ea = pidx < 3 ? 0 : (pidx < 5 ? 1 : 2), eb = pidx < 3 ? pidx + 1 : (pidx < 5 ? pidx - 1 : 3);
        const int expert = g * 4 + (nt < 4 ? ea : eb);
        GatherRows af{H, lst, n, {0u, 0u, 0u, 0u}};
        AffineRows bf_((const bf16*)(ws + WS_WGU) + ((size_t)(layer * 16 + expert) * 512 + (nt & 3) * 128) * D, D);
        EpiMoe1 epi{(bf16*)(ws + WS_R3) + (size_t)tt * 128 * 512, lst, n, (const float*)(ws + WS_WTS), nt};
        gemm_tile<false>(af, bf_, D / 64, smem, epi);
    }
}
template <int LAYER>
struct EpiMoe2 {
    typedef RmwPre<true> Pre;
    bf16* xs; float* out; float* rss; const float* modv_layer; LAS const int* lst; int n; int nt;
    __device__ __forceinline__ bool swapped() const { return false; }
    __device__ __forceinline__ auto rowfn(int fb, int tb) const {
        const int c0 = nt * 128 + fb; const EpiMoe2 e = *this;
        return [=](int R, const void*& sp, void*& dp, const float*& gp, int& tk) {
            const int r = tb + R; if (r >= e.n) return false;
            const int tok = e.lst[r]; tk = tok;
            sp = e.xs + (size_t)tok * D + c0;
            if (LAYER == 0) dp = e.xs + (size_t)tok * D + c0; else dp = e.out + (size_t)tok * D + c0;
            gp = e.modv_layer + (size_t)(tok < NL ? tok / S : 4) * 6144 + 5 * 1024 + c0; return true; };
    }
    __device__ __forceinline__ void prefetch(Pre& pre, int fb, int tb, int l31, int hh) const { rmw_prefetch<true>(pre, rowfn(fb, tb), l31, hh); }
    __device__ __forceinline__ void operator()(f32x16 (&acc)[2][2], int fb, int tb, int l31, int hh, LAS unsigned char* wl, const Pre& pre) const {
        rmw_finish<true, LAYER == 0, LAYER == 0>(acc, pre, rowfn(fb, tb), l31, hh, wl, rss + (size_t)(nt * 2 + (fb >> 6)) * NT);
    }
};
__device__ __forceinline__ void ph_moe_stage2(const Ptrs& P, LAS unsigned char* smem, int bid, int nblk, int layer, bool have_tiles) {
    unsigned char* ws = P.ws;
    const int* cnt = (const int*)(ws + WS_CTL) + CTL_CNT + layer * 2048; const int* list = (const int*)(ws + WS_LIST);
    LAS int* tile0 = (LAS int*)(smem + GEMM_LDS);
    if (!have_tiles) moe_tiles_init(cnt, tile0);
    const int lrow = threadIdx.x >> 3, kc = threadIdx.x & 7;
    const int nitems = tile0[24] * 8;
    for (int r_ = 0, item; (item = round_item(r_, nitems, bid, nblk)) >= 0; ++r_) {
        const int tt = item >> 3, nt = item & 7;
        int c = 0; while (tile0[c + 1] <= tt) ++c;
        const int lt = tt - tile0[c], n = min(128, tile0[192 + c] - lt * 128);
        const int* lst = list + (size_t)c * NT + lt * 128;
        const int g = c / 6, pidx = c % 6; const int ea = pidx < 3 ? 0 : (pidx < 5 ? 1 : 2), eb = pidx < 3 ? pidx + 1 : (pidx < 5 ? pidx - 1 : 3);
        AffineRows af((const bf16*)(ws + WS_R3) + (size_t)tt * 128 * 512, 512);
        const bf16* wd = (const bf16*)(ws + WS_WD);
        SplitKRows bf_(wd + ((size_t)(layer * 16 + g * 4 + ea) * 1024 + nt * 128) * 256, wd + ((size_t)(layer * 16 + g * 4 + eb) * 1024 + nt * 128) * 256, 256, 4);
        LAS int* toks = (LAS int*)(smem + GEMM_LDS + 256);
        __syncthreads();
        if (threadIdx.x < 128) toks[threadIdx.x] = lst[threadIdx.x < n ? threadIdx.x : 0];
        if (layer == 0) { EpiMoe2<0> epi{(bf16*)(ws + WS_R4), P.out, (float*)(ws + WS_CTXS), (const float*)(ws + WS_MODV), toks, n, nt}; gemm_tile<false>(af, bf_, 8, smem, epi); }
        else { EpiMoe2<1> epi{(bf16*)(ws + WS_R4), P.out, nullptr, (const float*)(ws + WS_MODV) + (size_t)5 * 6144, toks, n, nt}; gemm_tile<false>(af, bf_, 8, smem, epi); }
    }
}

constexpr size_t GLA_ST = 8192;
constexpr size_t WS_DEC = WS_WTS + (size_t)NT * 2 * 4;
static_assert(WS_DEC + (size_t)32 * 68 * 64 * 4 <= 256 * MiB, "ws dec");
__device__ __forceinline__ void gla_chunk_geom(int b, int M, size_t& row0, int& vcol0, int& c0, int& c1) {
    if (M < 4) { row0 = (size_t)NL + b * CL + 64 * M; vcol0 = S + 64 * M; c0 = M; c1 = 3 - M; }
    else { const int Ml = M - 4; row0 = (size_t)b * S + 64 * Ml; vcol0 = 64 * Ml; c0 = 4 + Ml; c1 = 4 + 63 - Ml; }
}
template <bool PASS_C>
__device__ __forceinline__ float gla_prep(const float (&gw)[16], float gb, int dir, LAS unsigned char* out, LAS const unsigned char* qraw, LAS const unsigned char* kraw, LAS const float* lrs, LAS float* tot) {
    const int tid = threadIdx.x, k = tid & 63, grp = tid >> 6;
    float gl[16];
#pragma unroll
    for (int j = 0; j < 16; ++j) {
        const int p = 16 * grp + j; float z = gb;
#pragma unroll
        for (int r4 = 0; r4 < 4; ++r4) { const f32x4 l4 = *(LAS const f32x4*)(lrs + p * 16 + r4 * 4); z += l4.x * gw[4 * r4] + l4.y * gw[4 * r4 + 1] + l4.z * gw[4 * r4 + 2] + l4.w * gw[4 * r4 + 3]; }
        gl[j] = (fminf(z, 0.f) - __logf(1.f + __expf(-fabsf(z)))) * (1.f / 16.f);
    }
    if (dir == 0) {
#pragma unroll
        for (int j = 1; j < 16; ++j) gl[j] += gl[j - 1];
        tot[grp * 64 + k] = gl[15];
    } else {
#pragma unroll
        for (int j = 14; j >= 0; --j) gl[j] += gl[j + 1];
        tot[grp * 64 + k] = gl[0];
    }
    __syncthreads();
    const float t0 = tot[k], t1 = tot[64 + k], t2 = tot[128 + k], t3 = tot[192 + k];
    const float bend = t0 + t1 + t2 + t3;
    float offs;
    if (dir == 0) offs = grp == 0 ? 0.f : grp == 1 ? t0 : grp == 2 ? t0 + t1 : t0 + t1 + t2;
    else offs = grp == 3 ? 0.f : grp == 2 ? t3 : grp == 1 ? t3 + t2 : t3 + t2 + t1;
    if (PASS_C) {
#pragma unroll
        for (int j = 0; j < 16; ++j) {
            const int p = 16 * grp + j; const float bp = gl[j] + offs;
            const float q = bf2f(*(LAS const bf16*)(qraw + p * 128 + k * 2)) * 0.125f, kk = bf2f(*(LAS const bf16*)(kraw + p * 128 + k * 2));
            *(LAS bf16*)(out + p * 144 + k * 2) = f2bf(q * __expf(bp));
            *(LAS bf16*)(out + 9216 + p * 144 + k * 2) = f2bf(q * __expf(bp - bend));
            *(LAS bf16*)(out + 18432 + p * 144 + k * 2) = f2bf(kk * __expf(bend - bp));
        }
    } else {
        float kt[16];
#pragma unroll
        for (int j = 0; j < 16; ++j) { const int p = 16 * grp + j; const float bp = gl[j] + offs; kt[j] = bf2f(*(LAS const bf16*)(kraw + p * 128 + k * 2)) * __expf(bend - bp); }
        u32x4 w0 = {pk2(kt[0], kt[1]), pk2(kt[2], kt[3]), pk2(kt[4], kt[5]), pk2(kt[6], kt[7])}, w1 = {pk2(kt[8], kt[9]), pk2(kt[10], kt[11]), pk2(kt[12], kt[13]), pk2(kt[14], kt[15])};
        *(LAS u32x4*)(out + k * 144 + grp * 32) = w0; *(LAS u32x4*)(out + k * 144 + grp * 32 + 16) = w1;
    }
    return __expf(bend);
}
#define GLA_LOAD_GW(gw, gb, dir, h) do { _Pragma("unroll") for (int r_ = 0; r_ < 16; ++r_) gw[r_] = P.in[10][((dir) * 16 + r_) * 256 + (h) * 64 + (threadIdx.x & 63)]; gb = P.in[11][(dir) * 256 + (h) * 64 + (threadIdx.x & 63)]; } while (0)

constexpr int GA_KTT = 0, GA_VT = 9216, GA_KRAW = GA_VT + 128 * 144, GA_LRS = GA_KRAW + 8192, GA_TOT = GA_LRS + 4096, GLA_A_LDS = GA_TOT + 1024;
__device__ __forceinline__ void gla_pass_a_item(const Ptrs& P, int item, LAS unsigned char* lds) {
    const int tid = threadIdx.x, lane = tid & 63, wave = tid >> 6, l31 = lane & 31, hh = lane >> 5;
    const int M = item % 68, dir = (item / 68) & 1, h = (item / 136) & 3, b = item / 544;
    size_t row0; int vcol0, c0, c1; gla_chunk_geom(b, M, row0, vcol0, c0, c1);
    const int sidx = ((b * 4 + h) * 2 + dir) * 68 + (dir ? c1 : c0);
    const unsigned char* r3 = P.ws + WS_R3;
    u32x4 vt[4], kr[2]; f32x4 lr; float gw[16], gb;
    { const bf16* gvt = (const bf16*)(r3 + R3_GV) + (size_t)(b * 4 + h) * 128 * VT_LD + vcol0;
#pragma unroll
      for (int i = 0; i < 4; ++i) { const int c = tid + 256 * i; vt[i] = *(const u32x4*)(gvt + (size_t)(c >> 3) * VT_LD + (c & 7) * 8); }
      const bf16* gk = (const bf16*)(r3 + R3_GK) + row0 * 256 + h * 64;
#pragma unroll
      for (int i = 0; i < 2; ++i) { const int c = tid + 256 * i; kr[i] = *(const u32x4*)(gk + (size_t)(c >> 3) * 256 + (c & 7) * 8); }
      lr = *(const f32x4*)((const float*)(r3 + R3_LR) + (row0 + (tid >> 2)) * 32 + dir * 16 + (tid & 3) * 4);
      GLA_LOAD_GW(gw, gb, dir, h); }
#pragma unroll
    for (int i = 0; i < 4; ++i) { const int c = tid + 256 * i; *(LAS u32x4*)(lds + GA_VT + (c >> 3) * 144 + (c & 7) * 16) = vt[i]; }
#pragma unroll
    for (int i = 0; i < 2; ++i) { const int c = tid + 256 * i; *(LAS u32x4*)(lds + GA_KRAW + (c >> 3) * 128 + (c & 7) * 16) = kr[i]; }
    *(LAS f32x4*)(lds + GA_LRS + tid * 16) = lr;
    __syncthreads();
    const float dec = gla_prep<false>(gw, gb, dir, lds + GA_KTT, lds + GA_KRAW, lds + GA_KRAW, (LAS const float*)(lds + GA_LRS), (LAS float*)(lds + GA_TOT));
    if (tid < 64) ((float*)(P.ws + WS_DEC))[(size_t)sidx * 64 + tid] = dec;
    __syncthreads();
    f32x16 acc[2];
#pragma unroll
    for (int kt = 0; kt < 2; ++kt)
#pragma unroll
        for (int r = 0; r < 16; ++r) acc[kt][r] = 0.f;
#pragma unroll
    for (int ps = 0; ps < 4; ++ps) {
        const bf16x8 vf = *(LAS bf16x8*)(lds + GA_VT + (32 * wave + l31) * 144 + ps * 32 + hh * 16);
#pragma unroll
        for (int kt = 0; kt < 2; ++kt) { const bf16x8 kf = *(LAS bf16x8*)(lds + GA_KTT + (32 * kt + l31) * 144 + ps * 32 + hh * 16); acc[kt] = __builtin_amdgcn_mfma_f32_32x32x16_bf16(kf, vf, acc[kt], 0, 0, 0); }
    }
    bf16* ds = (bf16*)(P.ws + WS_R1) + (size_t)sidx * GLA_ST + (size_t)(32 * wave + l31) * 64 + 4 * hh;
#pragma unroll
    for (int kt = 0; kt < 2; ++kt)
#pragma unroll
        for (int g = 0; g < 4; ++g) { u32x2 v = {pk2(acc[kt][4 * g], acc[kt][4 * g + 1]), pk2(acc[kt][4 * g + 2], acc[kt][4 * g + 3])}; *(u32x2*)(ds + kt * 32 + 8 * g) = v; }
    __syncthreads();
}
__device__ __forceinline__ void ph_gla_a(const Ptrs& P, LAS unsigned char* smem, int bid, int nblk) {
    for (int item = bid; item < 4 * 4 * 2 * 68; item += nblk) gla_pass_a_item(P, item, smem);
}
__device__ __forceinline__ void gla_pass_b(const Ptrs& P, int gtid, int nthreads) {
    const bf16* DS = (const bf16*)(P.ws + WS_R1); bf16* SIN = (bf16*)(P.ws + WS_R4); const float* DEC = (const float*)(P.ws + WS_DEC);
    for (int idx = gtid; idx < 32 * 2048; idx += nthreads) {
        const int bhd = idx >> 11, e4 = idx & 2047, k4 = (e4 & 15) * 4;
        float s0 = 0.f, s1 = 0.f, s2 = 0.f, s3 = 0.f;
#pragma unroll 17
        for (int c = 0; c < 68; ++c) {
            const size_t sidx = (size_t)bhd * 68 + c;
            u32x2 o = {pk2(s0, s1), pk2(s2, s3)};
            *(u32x2*)(SIN + sidx * GLA_ST + e4 * 4) = o;
            const f32x4 d = *(const f32x4*)(DEC + sidx * 64 + k4);
            const u32x2 w = __builtin_nontemporal_load((const u32x2*)(DS + sidx * GLA_ST + e4 * 4));
            s0 = s0 * d.x + __uint_as_float(w.x << 16); s1 = s1 * d.y + __uint_as_float(w.x & 0xffff0000u);
            s2 = s2 * d.z + __uint_as_float(w.y << 16); s3 = s3 * d.w + __uint_as_float(w.y & 0xffff0000u);
        }
    }
}

constexpr int GC_QT = 0, GC_QA = 9216, GC_KT = 18432, GC_VT = 27648, GC_QRAW = GC_VT + 128 * 136, GC_KRAW = GC_QRAW + 8192, GC_LRS = GC_KRAW + 8192, GC_TOT = GEMM_LDS + 256, GC_XCH = GC_TOT + 1024;
static_assert(GC_LRS + 4096 <= GEMM_LDS, "gla c lds");
__device__ __forceinline__ void gla_pass_c_item(const Ptrs& P, int item, LAS unsigned char* lds) {
    const int tid = threadIdx.x, lane = tid & 63, wave = tid >> 6, l31 = lane & 31, hh = lane >> 5, pt = wave & 1, vh = wave >> 1;
    const int M = item % 68, h = (item / 68) & 3, b = item / 272;
    size_t row0; int vcol0, c0, c1; gla_chunk_geom(b, M, row0, vcol0, c0, c1);
    const unsigned char* r3 = P.ws + WS_R3;
    u32x4 vt[4], qr[2], kr[2]; f32x4 lr0, lr1; float gw[16], gb;
    { const bf16* gvt = (const bf16*)(r3 + R3_GV) + (size_t)(b * 4 + h) * 128 * VT_LD + vcol0;
#pragma unroll
      for (int i = 0; i < 4; ++i) { const int c = tid + 256 * i; vt[i] = *(const u32x4*)(gvt + (size_t)(c >> 3) * VT_LD + (c & 7) * 8); }
      const bf16* gq = (const bf16*)(r3 + R3_GQ) + row0 * 256 + h * 64; const bf16* gk = (const bf16*)(r3 + R3_GK) + row0 * 256 + h * 64;
#pragma unroll
      for (int i = 0; i < 2; ++i) { const int c = tid + 256 * i; qr[i] = *(const u32x4*)(gq + (size_t)(c >> 3) * 256 + (c & 7) * 8); kr[i] = *(const u32x4*)(gk + (size_t)(c >> 3) * 256 + (c & 7) * 8); }
      const float* lrp = (const float*)(r3 + R3_LR) + (row0 + (tid >> 2)) * 32 + (tid & 3) * 4;
      lr0 = *(const f32x4*)lrp; lr1 = *(const f32x4*)(lrp + 16);
      GLA_LOAD_GW(gw, gb, 0, h); }
    u32x2 rwp[2][4];
    { const bf16* gr0 = (const bf16*)(P.ws + WS_R3 + R3_GR) + (row0 + 32 * pt + l31) * 512 + h * 128 + 64 * vh + 4 * hh;
#pragma unroll
      for (int i = 0; i < 2; ++i)
#pragma unroll
          for (int g = 0; g < 4; ++g) rwp[i][g] = *(const u32x2*)(gr0 + i * 32 + 8 * g); }
#pragma unroll
    for (int i = 0; i < 4; ++i) { const int c = tid + 256 * i; LAS unsigned char* vp = lds + GC_VT + (c >> 3) * 136 + (c & 7) * 16; u32x2 lo = {vt[i].x, vt[i].y}, hi = {vt[i].z, vt[i].w}; *(LAS u32x2*)vp = lo; *(LAS u32x2*)(vp + 8) = hi; }
#pragma unroll
    for (int i = 0; i < 2; ++i) { const int c = tid + 256 * i; *(LAS u32x4*)(lds + GC_QRAW + (c >> 3) * 128 + (c & 7) * 16) = qr[i]; *(LAS u32x4*)(lds + GC_KRAW + (c >> 3) * 128 + (c & 7) * 16) = kr[i]; }
    *(LAS f32x4*)(lds + GC_LRS + tid * 16) = lr0;
    f32x16 o[2];
#pragma unroll
    for (int i = 0; i < 2; ++i)
#pragma unroll
        for (int r = 0; r < 16; ++r) o[i][r] = 0.f;
    const bf16* SIN = (const bf16*)(P.ws + WS_R4);
    __syncthreads();
#pragma unroll 1
    for (int dir = 0; dir < 2; ++dir) {
        const int sidx = ((b * 4 + h) * 2 + dir) * 68 + (dir ? c1 : c0);
        (void)gla_prep<true>(gw, gb, dir, lds + GC_QT, lds + GC_QRAW, lds + GC_KRAW, (LAS const float*)(lds + GC_LRS), (LAS float*)(lds + GC_TOT));
        bf16x8 sf[2][4];
#pragma unroll
        for (int i = 0; i < 2; ++i)
#pragma unroll
            for (int ks = 0; ks < 4; ++ks) sf[i][ks] = *(const bf16x8*)(SIN + (size_t)sidx * GLA_ST + (size_t)(64 * vh + 32 * i + l31) * 64 + 16 * ks + 8 * hh);
        if (dir == 0) { *(LAS f32x4*)(lds + GC_LRS + tid * 16) = lr1; GLA_LOAD_GW(gw, gb, 1, h); }
        __syncthreads();
        f32x16 at[2];
#pragma unroll
        for (int st = 0; st < 2; ++st) {
#pragma unroll
            for (int r = 0; r < 16; ++r) at[st][r] = 0.f;
#pragma unroll
            for (int ks = 0; ks < 4; ++ks) {
                const bf16x8 ka = *(LAS bf16x8*)(lds + GC_KT + (32 * st + l31) * 144 + ks * 32 + hh * 16);
                const bf16x8 qa = *(LAS bf16x8*)(lds + GC_QA + (32 * pt + l31) * 144 + ks * 32 + hh * 16);
                at[st] = __builtin_amdgcn_mfma_f32_32x32x16_bf16(ka, qa, at[st], 0, 0, 0);
            }
            const int pq = 32 * pt + l31;
#pragma unroll
            for (int r = 0; r < 16; ++r) { const int s_ = 32 * st + (r & 3) + 8 * (r >> 2) + 4 * hh; const bool ok = dir ? (s_ >= pq) : (s_ <= pq); if (!ok) at[st][r] = 0.f; }
        }
#pragma unroll
        for (int ks = 0; ks < 4; ++ks) {
            const bf16x8 qt = *(LAS bf16x8*)(lds + GC_QT + (32 * pt + l31) * 144 + ks * 32 + hh * 16);
#pragma unroll
            for (int i = 0; i < 2; ++i) o[i] = __builtin_amdgcn_mfma_f32_32x32x16_bf16(sf[i][ks], qt, o[i], 0, 0, 0);
        }
#pragma unroll
        for (int st = 0; st < 2; ++st)
#pragma unroll
            for (int s2 = 0; s2 < 2; ++s2) {
                u32x4 pw = {pk2(at[st][8 * s2], at[st][8 * s2 + 1]), pk2(at[st][8 * s2 + 2], at[st][8 * s2 + 3]), pk2(at[st][8 * s2 + 4], at[st][8 * s2 + 5]), pk2(at[st][8 * s2 + 6], at[st][8 * s2 + 7])};
                const bf16x8 pf = __builtin_bit_cast(bf16x8, pw);
#pragma unroll
                for (int i = 0; i < 2; ++i) {
                    LAS unsigned char* vp = lds + GC_VT + (64 * vh + 32 * i + l31) * 136 + (32 * st + 16 * s2 + 4 * hh) * 2;
                    const u32x2 v0 = *(LAS u32x2*)vp, v1 = *(LAS u32x2*)(vp + 16);
                    u32x4 vw = {v0.x, v0.y, v1.x, v1.y};
                    o[i] = __builtin_amdgcn_mfma_f32_32x32x16_bf16(__builtin_bit_cast(bf16x8, vw), pf, o[i], 0, 0, 0);
                }
            }
        __syncthreads();
    }
    float ss = 0.f;
#pragma unroll
    for (int i = 0; i < 2; ++i)
#pragma unroll
        for (int r = 0; r < 16; ++r) ss += o[i][r] * o[i][r];
    ss = xhalf_sum(ss);
    LAS float* xch = (LAS float*)(lds + GC_XCH);
    if (hh == 0) xch[(pt * 2 + vh) * 32 + l31] = ss;
    __syncthreads();
    ss += xch[(pt * 2 + (1 - vh)) * 32 + l31];
    const float rstd = rsqrtf(ss * (1.f / 128.f) + EPS);
    const size_t trow = row0 + 32 * pt + l31;
    const bf16* gr = (const bf16*)(P.ws + WS_R3 + R3_GR) + trow * 512 + h * 128 + 64 * vh + 4 * hh;
    bf16* mx = (bf16*)(P.ws + WS_R2) + trow * 1024 + h * 128 + 64 * vh + 8 * hh;
    const float* gn = P.in[12] + 64 * vh + 4 * hh;
#pragma unroll
    for (int i = 0; i < 2; ++i) {
      u32x2 vq[4];
#pragma unroll
        for (int g = 0; g < 4; ++g) {
            const u32x2 rw = rwp[i][g]; const f32x4 gg = *(const f32x4*)(gn + i * 32 + 8 * g);
            const float r0 = __uint_as_float(rw.x << 16), r1 = __uint_as_float(rw.x & 0xffff0000u), r2 = __uint_as_float(rw.y << 16), r3_ = __uint_as_float(rw.y & 0xffff0000u);
            const float y0 = o[i][4 * g] * rstd * gg.x * (r0 / (1.f + __expf(-r0))), y1 = o[i][4 * g + 1] * rstd * gg.y * (r1 / (1.f + __expf(-r1)));
            const float y2 = o[i][4 * g + 2] * rstd * gg.z * (r2 / (1.f + __expf(-r2))), y3 = o[i][4 * g + 3] * rstd * gg.w * (r3_ / (1.f + __expf(-r3_)));
            u32x2 v = {pk2(y0, y1), pk2(y2, y3)}; vq[g] = v;
        }
      *(u32x4*)(mx + i * 32) = widen_pair(vq[0], vq[1]); *(u32x4*)(mx + i * 32 + 16) = widen_pair(vq[2], vq[3]);
    }
    __syncthreads();
}
__device__ __forceinline__ void ph_gla_c(const Ptrs& P, LAS unsigned char* smem, int bid, int nblk) {
    for (int item = bid; item < 4 * 4 * 68; item += nblk) gla_pass_c_item(P, item, smem);
}

#define XB_TMO      128
#define XB_XCNT(j)  (256  + 64 * (j))
#define XB_XSUB(j)  (1280 + 64 * (j))
#define XB_XGEN(j)  (2304 + 64 * (j))
#define XB_TOP      3328
#define XB_TOPGEN   3392
#define XB_SPIN_CAP (1u << 20)
constexpr int CTL_BAR = 4096;
__device__ __forceinline__ unsigned xb_ld(unsigned* p) { return __hip_atomic_load(p, __ATOMIC_RELAXED, __HIP_MEMORY_SCOPE_AGENT); }
__device__ __forceinline__ unsigned xb_add(unsigned* p, unsigned v) { return __hip_atomic_fetch_add(p, v, __ATOMIC_RELAXED, __HIP_MEMORY_SCOPE_AGENT); }
__device__ __forceinline__ unsigned xb_xcc_id() { return (unsigned)__builtin_amdgcn_s_getreg((3 << 11) | 20) & 0xFu; }
#define XB_SPIN(cond, bar) do { unsigned _sp = 0; while (cond) { __builtin_amdgcn_s_sleep(1); \
    if ((++_sp & 255u) == 0u) { if (xb_ld(&(bar)[XB_TMO])) break; if (_sp > XB_SPIN_CAP) { atomicAdd(&(bar)[XB_TMO], 1u); break; } } } } while (0)
struct XcdBarrier { unsigned* bar; unsigned x; volatile LAS unsigned* st; };
__device__ __forceinline__ XcdBarrier xcd_barrier_post(unsigned* bar, volatile LAS unsigned* st) {
    XcdBarrier b; b.bar = bar; b.x = xb_xcc_id(); b.st = st;
    if (threadIdx.x == 0) (void)xb_add(&bar[XB_XCNT(b.x)], 1u);
    return b;
}
__device__ __forceinline__ void xcd_barrier_complete(unsigned* bar, unsigned x, unsigned& nloc, unsigned& nx) {
    const unsigned G = gridDim.x * gridDim.y * gridDim.z;
    unsigned sum, cnt, mine, sp = 0u;
    for (;;) {
        sum = 0u; cnt = 0u; mine = 0u;
#pragma unroll
        for (unsigned j = 0; j < 16; ++j) { const unsigned c = xb_ld(&bar[XB_XCNT(j)]); sum += c; cnt += (c > 0u) ? 1u : 0u; mine = (j == x) ? c : mine; }
        if (sum == G) break;
        __builtin_amdgcn_s_sleep(1);
        if ((++sp & 255u) == 0u) { if (xb_ld(&bar[XB_TMO])) break; if (sp > XB_SPIN_CAP) { atomicAdd(&bar[XB_TMO], 1u); break; } }
    }
    nloc = mine > 0u ? mine : 1u; nx = cnt > 0u ? cnt : 1u;
}
__device__ __forceinline__ void xcd_barrier(const XcdBarrier& b) {
    asm volatile("s_waitcnt vmcnt(0)" ::: "memory");
    __syncthreads();
    if (threadIdx.x == 0) {
        unsigned* bar = b.bar;
        __builtin_amdgcn_s_waitcnt(0);
        unsigned nloc = b.st[0], nx = b.st[1];
        if (nloc == 0u) { xcd_barrier_complete(bar, b.x, nloc, nx); b.st[0] = nloc; b.st[1] = nx; }
        asm volatile("buffer_inv sc1" ::: "memory");
        const unsigned old = xb_add(&bar[XB_XSUB(b.x)], 1u);
        const unsigned gen = old / nloc;
        if (old + 1u == (gen + 1u) * nloc) {
            __builtin_amdgcn_fence(__ATOMIC_RELEASE, "agent");
            asm volatile("s_waitcnt vmcnt(0)" ::: "memory");
            const unsigned og = xb_add(&bar[XB_TOP], 1u);
            const unsigned tg = og / nx;
            if (og + 1u == (tg + 1u) * nx) xb_add(&bar[XB_TOPGEN], 1u);
            else XB_SPIN(xb_ld(&bar[XB_TOPGEN]) == tg, bar);
            xb_add(&bar[XB_XGEN(b.x)], 1u);
            __builtin_amdgcn_fence(__ATOMIC_ACQUIRE, "agent");
            asm volatile("s_waitcnt vmcnt(0)" ::: "memory");
        } else {
            XB_SPIN(xb_ld(&bar[XB_XGEN(b.x)]) == gen, bar);
            asm volatile("s_waitcnt vmcnt(0)" ::: "memory");
        }
    }
    __syncthreads();
}

__device__ __forceinline__ void xcd_arrive(const XcdBarrier& b) {
    asm volatile("s_waitcnt vmcnt(0)" ::: "memory");
    __syncthreads();
    if (threadIdx.x == 0) {
        unsigned* bar = b.bar;
        __builtin_amdgcn_s_waitcnt(0);
        unsigned nloc = b.st[0], nx = b.st[1];
        if (nloc == 0u) { xcd_barrier_complete(bar, b.x, nloc, nx); b.st[0] = nloc; b.st[1] = nx; }
        const unsigned old = xb_add(&bar[XB_XSUB(b.x)], 1u);
        const unsigned gen = old / nloc;
        b.st[2] = gen;
        if (old + 1u == (gen + 1u) * nloc) {
            __builtin_amdgcn_fence(__ATOMIC_RELEASE, "agent");
            asm volatile("s_waitcnt vmcnt(0)" ::: "memory");
            const unsigned og = xb_add(&bar[XB_TOP], 1u);
            const unsigned tg = og / nx;
            if (og + 1u == (tg + 1u) * nx) xb_add(&bar[XB_TOPGEN], 1u);
            xb_add(&bar[XB_XGEN(b.x)], 1u);
            asm volatile("s_waitcnt vmcnt(0)" ::: "memory");
        }
    }
}
__device__ __forceinline__ void xcd_wait(const XcdBarrier& b) {
    __syncthreads();
    if (threadIdx.x == 0) {
        const unsigned gen = b.st[2];
        XB_SPIN(xb_ld(&b.bar[XB_TOPGEN]) == gen, b.bar);
        __builtin_amdgcn_fence(__ATOMIC_ACQUIRE, "agent");
        asm volatile("s_waitcnt vmcnt(0)" ::: "memory");
    }
    __syncthreads();
}

constexpr int N_PHASES = 18;
constexpr int SMEM_BYTES = GEMM_LDS + 2048;
struct Args { Ptrs P; int ph_lo, ph_hi; };
__global__ void __launch_bounds__(256, 2) fwd_megakernel(Args args) {
    __shared__ __attribute__((aligned(16))) unsigned char smem_raw[SMEM_BYTES];
    LAS unsigned char* smem = (LAS unsigned char*)smem_raw;
    const Ptrs& P = args.P;
    const int bid = blockIdx.x, nblk = gridDim.x;
    volatile LAS unsigned* bst = (volatile LAS unsigned*)(smem + GEMM_LDS + 128);
    if (threadIdx.x < 3) bst[threadIdx.x] = 0u;
    __syncthreads();
    XcdBarrier bar; bar.bar = (unsigned*)(P.ws + WS_CTL) + CTL_BAR; bar.x = 0; bar.st = bst;
    const bool multi = args.ph_hi - args.ph_lo > 1;
    if (multi) bar = xcd_barrier_post((unsigned*)(P.ws + WS_CTL) + CTL_BAR, bst);
    const int lo = args.ph_lo, hi = args.ph_hi;
#define PHASE(k, call) if (lo <= (k) && (k) < hi) { if ((k) > lo) xcd_barrier(bar); call; }
    if (lo <= 0 && 0 < hi) {
        ph_prologue_gemv(P, smem, bid, nblk);
        if (1 < hi) xcd_arrive(bar);
        __syncthreads();
        ph_prologue_rest(P, smem, bid, nblk, nblk == 512 && hi > 8);
    }
    if (lo <= 1 && 1 < hi) { if (1 > lo) xcd_wait(bar); ph_modulate(P, 0, bid, nblk); }
    PHASE(2, ph_even_inproj(P, smem, bid, nblk))
    PHASE(3, ph_gla_a(P, smem, bid, nblk))
    PHASE(4, gla_pass_b(P, bid * 256 + threadIdx.x, nblk * 256))
    if (lo <= 5 && 5 < hi) {
        if (5 > lo) xcd_arrive(bar);
        ph_dense_attn(P, smem, bid, nblk);
        if (5 > lo) xcd_wait(bar); else __syncthreads();
        ph_gla_c(P, smem, (bid + nblk - 128) % nblk, nblk);
        if (nblk == 512 && bid >= 192) route_tables(P, 0, bid - 192, 320);
    }
    PHASE(7, ph_outproj(P, smem, bid, nblk, 0, NT))
    if (lo <= 8 && 8 < hi) {
        if (8 > lo) xcd_barrier(bar);
        ph_moe_route(P, smem, bid, nblk, 0, NT);
        const int v8 = bid;
        if (nblk == 512) { if (v8 >= 32) { fold_odd_inproj(P, v8 - 32, 480); route_tables(P, 1, v8 - 32, 480); if (lo == 0) transposes_layer1(P, smem, v8 - 32, 480); } }
        else { fold_odd_inproj(P, bid, nblk); route_tables(P, 1, bid, nblk); }
    }
    PHASE(9, ph_moe_stage1(P, smem, bid, nblk, 0))
    PHASE(10, ph_moe_stage2(P, smem, bid, nblk, 0, lo <= 9))
    PHASE(12, ph_odd_inproj(P, smem, bid, nblk))
    PHASE(13, ph_swa_attn(P, smem, bid, nblk))
    PHASE(14, ph_outproj(P, smem, bid, nblk, 1, NL))
    PHASE(15, ph_moe_route(P, smem, bid, nblk, 1, NL))
    PHASE(16, ph_moe_stage1(P, smem, bid, nblk, 1))
    PHASE(17, ph_moe_stage2(P, smem, bid, nblk, 1, lo <= 16))
#undef PHASE
}

#ifndef MK_LAUNCHES
#define MK_LAUNCHES 1
#endif
extern "C" void kernel_launch(void* const* d_in, const int* in_sizes, int n_in, void* d_out, int out_size, void* d_ws, size_t ws_size, hipStream_t stream) {
    static int grid = 0;
    if (grid == 0) {
        int dev = 0, cus = 0, per_cu = 0;
        hipGetDevice(&dev);
        hipDeviceGetAttribute(&cus, hipDeviceAttributeMultiprocessorCount, dev);
        hipOccupancyMaxActiveBlocksPerMultiprocessor(&per_cu, (const void*)fwd_megakernel, 256, 0);
        if (per_cu > 2) per_cu = 2;
        if (per_cu < 1) per_cu = 1;
        grid = cus * per_cu;
    }
    hipMemsetAsync((unsigned char*)d_ws + WS_CTL, 0, 65536, stream);
    Args a{};
    for (int i = 0; i < 27; ++i) a.P.in[i] = (const float*)d_in[i];
    a.P.out = (float*)d_out; a.P.ws = (unsigned char*)d_ws;
#if MK_LAUNCHES == 1
    a.ph_lo = 0; a.ph_hi = N_PHASES;
    void* kargs[] = {&a};
    hipLaunchCooperativeKernel((const void*)fwd_megakernel, dim3(grid), dim3(256), kargs, 0, stream);
#else
    for (int ph = 0; ph < N_PHASES; ++ph) { a.ph_lo = ph; a.ph_hi = ph + 1; hipLaunchKernelGGL(fwd_megakernel, dim3(grid), dim3(256), 0, stream, a); }
#endif
}
```
